# Optimizing an MI355X kernel written in HIP

```python
import jax, jax.numpy as jnp
from jax import lax
import numpy as np

D_MODEL = 2048
BATCH = 1
SEQ = 8192
DEPTH = 2

CHUNK = 64
D_MIX = D_MODEL
A_WIDTH = D_MIX // 4
A_HEAD_DIM = 128
A_HEADS = A_WIDTH // A_HEAD_DIM
A_BLOCK = 128
B_WIDTH = D_MIX // 4
POOL_WINDOWS = (2, 4, 8, 16)
POOL_GROUPS = len(POOL_WINDOWS)
B_GROUP = B_WIDTH // POOL_GROUPS
C_WIDTH = D_MIX - A_WIDTH - B_WIDTH
C_HEAD_DIM = 128
C_HEADS = C_WIDTH // C_HEAD_DIM
Q_BLOCK = 128
N_IN = 2 * A_WIDTH + B_WIDTH + 3 * C_WIDTH + C_HEADS
SPLITS = (A_WIDTH, 2 * A_WIDTH, 2 * A_WIDTH + B_WIDTH,
          2 * A_WIDTH + B_WIDTH + C_WIDTH, 2 * A_WIDTH + B_WIDTH + 2 * C_WIDTH,
          2 * A_WIDTH + B_WIDTH + 3 * C_WIDTH)
N_EXPERTS = 16
N_GROUPS = 4
EXPERTS_PER_GROUP = N_EXPERTS // N_GROUPS
TOPK_GROUP = 1
TOP_K = 2
D_EXPERT = D_MODEL // 2
MOE_BLOCK = 128
EPS = 1e-6

kernel_name = 'hybrid_gmlp_pool_fox_moe_encoder'


def rms_norm(x, gain):
    xf = x.astype(jnp.float32)
    y = xf * lax.rsqrt(jnp.mean(xf * xf, axis=-1, keepdims=True) + EPS)
    return (y * gain.astype(jnp.float32)).astype(x.dtype)


def gmlp_mixer(u, v, ws, bs, vg):
    B, S, _ = u.shape
    u = jax.nn.gelu(u)
    v = rms_norm(jax.nn.gelu(v).reshape(B, S, A_HEADS, A_HEAD_DIM), vg)
    vb = v.reshape(B, S // A_BLOCK, A_BLOCK, A_HEADS, A_HEAD_DIM)
    cid = jnp.arange(A_BLOCK) // CHUNK
    mask = cid[None, :] <= cid[:, None]
    wm = jnp.where(mask[None], ws, 0).astype(v.dtype)
    sp = jnp.einsum('hts,bnshd->bnthd', wm, vb) + bs.T.astype(v.dtype)[None, None, :, :, None]
    return u * sp.reshape(B, S, A_WIDTH)


def pool_mixer(p, bw, bscale):
    B, S, _ = p.shape
    pf = p.astype(jnp.float32)
    cs = jnp.concatenate([jnp.zeros((B, 1, B_WIDTH), jnp.float32), jnp.cumsum(pf, axis=1)], axis=1)
    t1 = jnp.arange(1, S + 1)
    outs = []
    for g, w in enumerate(POOL_WINDOWS):
        sl = slice(g * B_GROUP, (g + 1) * B_GROUP)
        csg = cs[..., sl]
        lag = jnp.pad(csg, ((0, 0), (w, 0), (0, 0)))[:, :S + 1]
        win_sum = csg[:, 1:] - lag[:, 1:]
        cnt = jnp.minimum(t1, w).astype(jnp.float32)[None, :, None]
        outs.append(win_sum / cnt - pf[..., sl])
    d = jnp.stack(outs, axis=2).astype(p.dtype)
    y = jnp.einsum('bsgc,gce->bsge', d, bw)
    return y.reshape(B, S, B_WIDTH) * bscale


def forgetting_attention(q, k, v, fz, qg, kg, bf):
    B, S, _ = q.shape
    q = rms_norm(q.reshape(B, S, C_HEADS, C_HEAD_DIM), qg)
    k = rms_norm(k.reshape(B, S, C_HEADS, C_HEAD_DIM), kg)
    v = v.reshape(B, S, C_HEADS, C_HEAD_DIM)
    log_f = jax.nn.log_sigmoid(fz.astype(jnp.float32) + bf.astype(jnp.float32))
    F = jnp.cumsum(log_f, axis=1)
    Fk = jnp.transpose(F, (0, 2, 1))[:, :, None, :]
    nq = S // Q_BLOCK
    qb = q.reshape(B, nq, Q_BLOCK, C_HEADS, C_HEAD_DIM).transpose(1, 0, 2, 3, 4)
    Fq = F.reshape(B, nq, Q_BLOCK, C_HEADS).transpose(1, 0, 2, 3)
    kpos = jnp.arange(S)
    scale = C_HEAD_DIM ** -0.5

    def block(args):
        qi, Fi, i = args
        qpos = i * Q_BLOCK + jnp.arange(Q_BLOCK)
        s = jnp.einsum('bqhd,bkhd->bhqk', qi, k, preferred_element_type=jnp.float32) * scale
        s = s + jnp.transpose(Fi, (0, 2, 1))[..., None] - Fk
        s = jnp.where((kpos[None, :] <= qpos[:, None])[None, None], s, -jnp.inf)
        pr = jax.nn.softmax(s, axis=-1).astype(v.dtype)
        return jnp.einsum('bhqk,bkhd->bqhd', pr, v)

    out = lax.map(block, (qb, Fq, jnp.arange(nq)))
    return out.transpose(1, 0, 2, 3, 4).reshape(B, S, C_WIDTH)


def token_mixer(h, w_in, a_ws, a_bs, a_vg, b_w, b_scale, c_qg, c_kg, c_bf, w_out):
    z = h @ w_in
    u, v, p, q, k, va, fz = jnp.split(z, SPLITS, axis=-1)
    y_a = gmlp_mixer(u, v, a_ws, a_bs, a_vg)
    y_b = pool_mixer(p, b_w, b_scale)
    y_c = forgetting_attention(q, k, va, fz, c_qg, c_kg, c_bf)
    return jnp.concatenate([y_a, y_b, y_c], axis=-1) @ w_out


def route(ht, w_router, b_router):
    T = ht.shape[0]
    logits = jnp.einsum('td,de->te', ht, w_router, preferred_element_type=jnp.float32)
    scores = jax.nn.sigmoid(logits)
    sel = scores + b_router.astype(jnp.float32)
    grp = sel.reshape(T, N_GROUPS, EXPERTS_PER_GROUP)
    grp_score = lax.top_k(grp, TOP_K)[0].sum(-1)
    _, gidx = lax.top_k(grp_score, TOPK_GROUP)
    gmask = jnp.any(gidx[..., None] == jnp.arange(N_GROUPS), axis=1)
    sel = jnp.where(jnp.repeat(gmask, EXPERTS_PER_GROUP, axis=1), sel, -jnp.inf)
    _, eidx = lax.top_k(sel, TOP_K)
    gw = jnp.take_along_axis(scores, eidx, axis=1)
    gw = gw / jnp.sum(gw, axis=-1, keepdims=True)
    return eidx, gw


def moe_ffn(h, w_router, b_router, w_gate, w_up, w_down):
    B, S, D = h.shape
    T = B * S
    ht = h.reshape(T, D)
    eidx, gw = route(ht, w_router, b_router)
    A = T * TOP_K
    flat_e = eidx.reshape(A)
    flat_tok = jnp.repeat(jnp.arange(T, dtype=jnp.int32), TOP_K)
    flat_w = gw.reshape(A)
    order = jnp.argsort(flat_e)
    sorted_e = flat_e[order]
    counts = jnp.bincount(flat_e, length=N_EXPERTS)
    padded = (counts + MOE_BLOCK - 1) // MOE_BLOCK * MOE_BLOCK
    ends = jnp.cumsum(padded)
    pad_start = ends - padded
    start = jnp.cumsum(counts) - counts
    dest = pad_start[sorted_e] + jnp.arange(A) - start[sorted_e]
    P = A + N_EXPERTS * MOE_BLOCK
    n_blocks = P // MOE_BLOCK
    row_tok = jnp.zeros((P,), jnp.int32).at[dest].set(flat_tok[order])
    row_gate = jnp.zeros((P,), jnp.float32).at[dest].set(flat_w[order])
    block_start = jnp.arange(n_blocks) * MOE_BLOCK
    block_expert = jnp.minimum(jnp.searchsorted(ends, block_start, side='right'), N_EXPERTS - 1).astype(jnp.int32)
    xs = ht[row_tok].reshape(n_blocks, MOE_BLOCK, D)

    def run(args):
        xb, e = args
        hid = jax.nn.silu(xb @ w_gate[e]) * (xb @ w_up[e])
        return hid @ w_down[e]

    yb = lax.map(run, (xs, block_expert)).reshape(P, D)
    out = jnp.zeros((T, D), h.dtype).at[row_tok].add((yb * row_gate[:, None]).astype(h.dtype))
    return out.reshape(B, S, D)


def setup_inputs(seed: int = 0) -> dict:
    key = jax.random.key(seed)
    ks = jax.random.split(key, 24)
    f32 = jnp.float32
    L, D = DEPTH, D_MODEL

    def nrm(k, shape, scale):
        return jax.random.normal(k, shape, f32) * scale

    return {
        'x': nrm(ks[0], (BATCH, SEQ, D), 1.0),
        'c': nrm(ks[1], (BATCH, D), 1.0),
        'w_ada': nrm(ks[2], (L, D, 6 * D), 0.5 * D ** -0.5),
        'b_ada': nrm(ks[3], (L, 6 * D), 0.02),
        'g_mix': 1.0 + nrm(ks[4], (L, D), 0.02),
        'g_ffn': 1.0 + nrm(ks[5], (L, D), 0.02),
        'w_in': nrm(ks[6], (L, D, N_IN), D ** -0.5),
        'a_ws': nrm(ks[7], (L, A_HEADS, A_BLOCK, A_BLOCK), 0.5 * A_BLOCK ** -0.5),
        'a_bs': 1.0 + nrm(ks[8], (L, A_HEADS, A_BLOCK), 0.02),
        'a_vg': 1.0 + nrm(ks[9], (L, A_HEADS, A_HEAD_DIM), 0.02),
        'b_w': nrm(ks[10], (L, POOL_GROUPS, B_GROUP, B_GROUP), B_GROUP ** -0.5),
        'b_scale': 1.0 + nrm(ks[11], (L, B_WIDTH), 0.02),
        'c_qg': 1.0 + nrm(ks[12], (L, C_HEAD_DIM), 0.02),
        'c_kg': 1.0 + nrm(ks[13], (L, C_HEAD_DIM), 0.02),
        'c_bf': jnp.linspace(0.0, 5.0, C_HEADS, dtype=f32)[None, :] + nrm(ks[14], (L, C_HEADS), 0.1),
        'w_out': nrm(ks[15], (L, D_MIX, D), D_MIX ** -0.5),
        'w_router': nrm(ks[16], (D, N_EXPERTS), D ** -0.5),
        'b_router': nrm(ks[17], (N_EXPERTS,), 0.01),
        'e_gate': nrm(ks[18], (L, N_EXPERTS, D, D_EXPERT), D ** -0.5),
        'e_up': nrm(ks[19], (L, N_EXPERTS, D, D_EXPERT), D ** -0.5),
        'e_down': nrm(ks[20], (L, N_EXPERTS, D_EXPERT, D), D_EXPERT ** -0.5),
    }


def reference(x, c, w_ada, b_ada, g_mix, g_ffn, w_in, a_ws, a_bs, a_vg, b_w, b_scale,
              c_qg, c_kg, c_bf, w_out, w_router, b_router, e_gate, e_up, e_down):
    c_act = jax.nn.silu(c)
    for l in range(DEPTH):
        mod = c_act @ w_ada[l] + b_ada[l]
        sh1, sc1, g1, sh2, sc2, g2 = [m[:, None, :] for m in jnp.split(mod, 6, axis=-1)]
        h = rms_norm(x, g_mix[l]) * (1 + sc1) + sh1
        y = token_mixer(h, w_in[l], a_ws[l], a_bs[l], a_vg[l], b_w[l], b_scale[l],
                        c_qg[l], c_kg[l], c_bf[l], w_out[l])
        x = x + g1 * y
        h = rms_norm(x, g_ffn[l]) * (1 + sc2) + sh2
        x = x + g2 * moe_ffn(h, w_router, b_router, e_gate[l], e_up[l], e_down[l])
    return x
```

```cpp
#include <hip/hip_runtime.h>
#include <stdint.h>
#include <stdio.h>

#define GAS __attribute__((address_space(1)))
#define LAS __attribute__((address_space(3)))
typedef unsigned short bf16;
typedef short bf16x8 __attribute__((ext_vector_type(8)));
typedef short s16x4 __attribute__((ext_vector_type(4)));
typedef float f32x2 __attribute__((ext_vector_type(2)));
typedef float f32x4 __attribute__((ext_vector_type(4)));
typedef float f32x16 __attribute__((ext_vector_type(16)));
typedef unsigned u32x2 __attribute__((ext_vector_type(2)));
typedef unsigned u32x4 __attribute__((ext_vector_type(4)));
typedef GAS unsigned gu32;
#define RLX_AGENT __ATOMIC_RELAXED, __HIP_MEMORY_SCOPE_AGENT
#define LDS_WAIT() asm volatile("s_waitcnt lgkmcnt(0)" ::: "memory")
#define VM_WAIT() asm volatile("s_waitcnt vmcnt(0)" ::: "memory")

constexpr int DM = 2048, SEQ = 8192, NIN = 4616, NZ = 4608, DEX = 1024, NEXP = 16, NLAYER = 2;
constexpr float EPSN = 1e-6f;
constexpr float LOG2E = 1.4426950408889634f;
constexpr int NWAVES = 8, NTHR = 512;
constexpr int HIDROWS = 2 * SEQ + NEXP * 256;

constexpr size_t KiB = 1024, MiB = 1u << 20;
constexpr size_t WS_CTL = 0, CTL_ZERO_BYTES = 1 * MiB;
constexpr size_t WS_MOD = 1 * MiB;
constexpr size_t WS_FLOC = WS_MOD + 128 * KiB;
constexpr size_t WS_TOT = WS_FLOC + 256 * KiB;
constexpr size_t WS_FKL = WS_TOT + 8 * KiB;
constexpr size_t WS_TOKE = WS_FKL + 256 * KiB;
constexpr size_t WS_TOKP = WS_TOKE + 64 * KiB;
constexpr size_t WS_TOKW = WS_TOKP + 64 * KiB;
constexpr size_t WS_LIST = WS_TOKW + 64 * KiB;
constexpr size_t WS_WM = 4 * MiB;
constexpr size_t WS_BWT = WS_WM + 256 * KiB;
constexpr size_t WS_MODP = 6 * MiB;
constexpr size_t WS_WIN = 8 * MiB;
constexpr size_t WS_WOUT = WS_WIN + 2 * 18 * MiB;
constexpr size_t WS_WGU = WS_WOUT + 2 * 8 * MiB;
constexpr size_t WS_WD = WS_WGU + 2 * 16 * 8 * MiB;
constexpr size_t WS_H = WS_WD + 2 * 16 * 4 * MiB;
constexpr size_t WS_Z = WS_H + 32 * MiB;
constexpr size_t WS_QN = WS_Z + 72 * MiB;
constexpr size_t WS_KN = WS_QN + 16 * MiB;
constexpr size_t WS_VN = WS_KN + 16 * MiB;
constexpr size_t WS_DP = WS_VN + 8 * MiB;
constexpr size_t WS_YCAT = WS_DP + 8 * MiB;
constexpr size_t WS_X1 = WS_YCAT + 32 * MiB;
constexpr size_t WS_X2 = WS_X1 + 64 * MiB;
constexpr size_t WS_HID = WS_X2 + 64 * MiB;
constexpr size_t WS_YB = WS_HID + 40 * MiB;
constexpr size_t WS_PART = WS_YB + 80 * MiB;
constexpr size_t WS_ML = WS_PART + 128 * MiB;
constexpr size_t WS_END = WS_ML + 4 * MiB;
constexpr int CW_TMO = 0, CW_CODE = 1;
constexpr int CW_CNT = 64;
constexpr int CW_Q = 512;
constexpr int CW_BGT = 640;
constexpr int CW_ARR = 1024;
constexpr int CW_BAR = 4096;

constexpr int RING_BYTES = 131072;
constexpr int MISC_OFF = RING_BYTES + 320;
constexpr int AUX_OFF = RING_BYTES + 1024;
constexpr int LDS_BYTES = 163840;

template <class T> __device__ __forceinline__ T* opq(T* p) { asm volatile("" : "+s"(p)); return p; }
__device__ __forceinline__ int opq_tid() { int t = threadIdx.x; asm volatile("" : "+v"(t)); return t; }
__device__ __forceinline__ unsigned cvt_pk_bf16(float lo, float hi) { unsigned r; asm volatile("v_cvt_pk_bf16_f32 %0, %1, %2" : "=v"(r) : "v"(lo), "v"(hi)); return r; }
__device__ __forceinline__ float bf_lo(unsigned w) { return __uint_as_float(w << 16); }
__device__ __forceinline__ float bf_hi(unsigned w) { return __uint_as_float(w & 0xffff0000u); }
__device__ __forceinline__ float wave_sum(float v) {
#pragma unroll
    for (int o = 1; o < 64; o <<= 1) v += __shfl_xor(v, o);
    return v;
}
__device__ __forceinline__ float gelu_t(float x) {
    const float u2 = x * (1.5957691216057308f + 0.0713548162726f * x * x);
    return x * __builtin_amdgcn_rcpf(1.f + __builtin_amdgcn_exp2f(-LOG2E * u2));
}
__device__ __forceinline__ float silu_f(float x) { return x * __builtin_amdgcn_rcpf(1.f + __builtin_amdgcn_exp2f(-LOG2E * x)); }

#define XB_TMO      128
#define XB_XCNT(j)  (256  + 64 * (j))
#define XB_XSUB(j)  (1280 + 64 * (j))
#define XB_XGEN(j)  (2304 + 64 * (j))
#define XB_TOP      3328
#define XB_TOPGEN   3392
#define XCD_BAR_WORDS 3456
#define XB_SPIN_CAP (1u << 18)
__device__ __forceinline__ unsigned xb_ld(unsigned* p)              { return __hip_atomic_load(p, __ATOMIC_RELAXED, __HIP_MEMORY_SCOPE_AGENT); }
__device__ __forceinline__ unsigned xb_add(unsigned* p, unsigned v) { return __hip_atomic_fetch_add(p, v, __ATOMIC_RELAXED, __HIP_MEMORY_SCOPE_AGENT); }
__device__ __forceinline__ unsigned xb_xcc_id() { return (unsigned)__builtin_amdgcn_s_getreg((3 << 11) | 20) & 0xFu; }
#define XB_SPIN(cond, bar) do { unsigned _sp = 0; while (cond) { __builtin_amdgcn_s_sleep(1); \
    if ((++_sp & 255u) == 0u) { if (xb_ld(&(bar)[XB_TMO])) break; if (_sp > XB_SPIN_CAP) { atomicAdd(&(bar)[XB_TMO], 1u); break; } } } } while (0)
struct XcdBarrier { unsigned* bar; unsigned x; volatile LAS unsigned* st; };
__device__ __forceinline__ XcdBarrier xcd_barrier_post(unsigned* bar, volatile LAS unsigned* st) {
    XcdBarrier b; b.bar = bar; b.x = xb_xcc_id(); b.st = st;
    if (threadIdx.x == 0) (void)xb_add(&bar[XB_XCNT(b.x)], 1u);
    return b;
}
__device__ __forceinline__ void xcd_barrier_complete(unsigned* bar, unsigned x, unsigned& nloc, unsigned& nx) {
    const unsigned G = gridDim.x * gridDim.y * gridDim.z;
    unsigned sum, cnt, mine, sp = 0u;
    for (;;) {
        sum = 0u; cnt = 0u; mine = 0u;
#pragma unroll
        for (unsigned j = 0; j < 16; ++j) { const unsigned c = xb_ld(&bar[XB_XCNT(j)]); sum += c; cnt += (c > 0u) ? 1u : 0u; mine = (j == x) ? c : mine; }
        if (sum == G) break;
        __builtin_amdgcn_s_sleep(1);
        if ((++sp & 255u) == 0u) { if (xb_ld(&bar[XB_TMO])) break; if (sp > XB_SPIN_CAP) { atomicAdd(&bar[XB_TMO], 1u); break; } }
    }
    nloc = mine > 0u ? mine : 1u; nx = cnt > 0u ? cnt : 1u;
}
__device__ __forceinline__ void xcd_barrier(const XcdBarrier& b) {
    asm volatile("s_waitcnt vmcnt(0)" ::: "memory");
    __syncthreads();
    if (threadIdx.x == 0) {
        unsigned* bar = b.bar;
        __builtin_amdgcn_s_waitcnt(0);
        unsigned nloc = b.st[0], nx = b.st[1];
        if (nloc == 0u) { xcd_barrier_complete(bar, b.x, nloc, nx); b.st[0] = nloc; b.st[1] = nx; }
        const unsigned old = xb_add(&bar[XB_XSUB(b.x)], 1u);
        const unsigned gen = old / nloc;
        if (old + 1u == (gen + 1u) * nloc) {
            __builtin_amdgcn_fence(__ATOMIC_RELEASE, "agent");
            asm volatile("s_waitcnt vmcnt(0)" ::: "memory");
            const unsigned og = xb_add(&bar[XB_TOP], 1u);
            const unsigned tg = og / nx;
            if (og + 1u == (tg + 1u) * nx) xb_add(&bar[XB_TOPGEN], 1u);
            else XB_SPIN(xb_ld(&bar[XB_TOPGEN]) == tg, bar);
            __builtin_amdgcn_fence(__ATOMIC_ACQUIRE, "agent");
            xb_add(&bar[XB_XGEN(b.x)], 1u);
            asm volatile("s_waitcnt vmcnt(0)" ::: "memory");
        } else {
            XB_SPIN(xb_ld(&bar[XB_XGEN(b.x)]) == gen, bar);
            __builtin_amdgcn_fence(__ATOMIC_ACQUIRE, "agent");
            asm volatile("s_waitcnt vmcnt(0)" ::: "memory");
        }
    }
    __syncthreads();
}

namespace gm {
constexpr int BM = 256, BK = 64, HALF = 128, HTB = HALF * BK * 2, STAGE_BYTES = 8 * HTB, NXCD = 8, WGM = 8;
__host__ __device__ __forceinline__ int lds_byte(int r, int c) { const int st = (r >> 4) * 2 + (c >> 5), rr = r & 15, cc = c & 31, ob = rr * 64 + cc * 2; return st * 1024 + (ob ^ (((ob >> 9) & 1) << 5)); }
__host__ __device__ __forceinline__ void stage_rc(int b, int& R, int& C) { const int st = b / 1024, sb = b % 1024, swz = sb ^ (((sb >> 9) & 1) << 5); R = (st >> 1) * 16 + swz / 64; C = (st & 1) * 32 + (swz % 64) / 2; }
__host__ __device__ __forceinline__ int perm32(int rho) { const int n = rho >> 4, i = rho & 15; return 8 * (i >> 2) + 4 * n + (i & 3); }

struct Unit { int arow, orow, ocol, e, rt; const char* Bp; };

template <class Epi, class Sched, bool GATHER, bool ALIGN_EPI>
__device__ __forceinline__ void gemm_phase(LAS unsigned char* lds, const char* Abase, const int K, const Sched& S, const Epi& E) {
    const int tid = opq_tid(), wid = __builtin_amdgcn_readfirstlane(tid >> 6), lane = tid & 63, wr = wid >> 2, wc = wid & 3, fr = lane & 15, fq = lane >> 4;
    const int nt = K / BK;
    unsigned voffA[2], voffB[2]; int Rr[2], Cc[2];
#pragma unroll
    for (int i = 0; i < 2; ++i) { int R, C; stage_rc(tid * 16 + i * 8192, R, C); const int Rb = Epi::PERM ? ((R & ~31) + perm32(R & 31)) : R;
        Rr[i] = R; Cc[i] = C; voffA[i] = (unsigned)(R * K + C) * 2u; voffB[i] = (unsigned)(Rb * K + C) * 2u; }
    const size_t kstep = (size_t)(BK * 2);
    const size_t hstep = (size_t)HALF * K * 2;
    const unsigned ldsw = (unsigned)wid * 1024u;
    const int aoff = lds_byte(wr * 64 + fr, fq * 8), boff = lds_byte(wc * 32 + fr, fq * 8);
#define PG8_SA(b, h) (((b) * 2 + (h)) * HTB)
#define PG8_SB(b, h) ((4 + (b) * 2 + (h)) * HTB)
#define PG8_STAGE(bufoff, gbase, voff) do { _Pragma("unroll") for (int _i = 0; _i < 2; ++_i) \
        __builtin_amdgcn_global_load_lds((const unsigned*)((const char*)(gbase) + (voff)[_i]), (LAS unsigned*)(lds + (bufoff) + ldsw + _i * 8192), 16, 0, 0); } while (0)
#define PG8_STAGE_A(bufoff, ubase, h, kb, vg) do { if constexpr (GATHER) { PG8_STAGE(bufoff, Abase + (kb), (vg)[h]); } else { PG8_STAGE(bufoff, (ubase) + (h) * hstep + (kb), voffA); } } while (0)
#define PG8_LDA(dst, b, h) do { _Pragma("unroll") for (int m = 0; m < 4; ++m) _Pragma("unroll") for (int k = 0; k < 2; ++k) dst[m][k] = *(const LAS bf16x8*)(lds + PG8_SA(b, h) + aoff + m * 2048 + k * 1024); } while (0)
#define PG8_LDB(dst, b, h) do { _Pragma("unroll") for (int n = 0; n < 2; ++n) _Pragma("unroll") for (int k = 0; k < 2; ++k) dst[n][k] = *(const LAS bf16x8*)(lds + PG8_SB(b, h) + boff + n * 2048 + k * 1024); } while (0)
#define PG8_MMA(ai, bj, At, Bt) do { __builtin_amdgcn_s_setprio(1); _Pragma("unroll") for (int m = 0; m < 4; ++m) _Pragma("unroll") for (int n = 0; n < 2; ++n) _Pragma("unroll") for (int k = 0; k < 2; ++k) \
        acc[ai][bj][m][n] = __builtin_amdgcn_mfma_f32_16x16x32_bf16(Bt[n][k], At[m][k], acc[ai][bj][m][n], 0, 0, 0); __builtin_amdgcn_s_setprio(0); } while (0)
#define PG8_WAIT_V(n) asm volatile("s_waitcnt vmcnt(" #n ")" ::: "memory")
#define PG8_WAIT_L(n) asm volatile("s_waitcnt lgkmcnt(" #n ")" ::: "memory")
#define PG8_BAR __builtin_amdgcn_s_barrier()
#define PG8_SCHED __builtin_amdgcn_sched_barrier(0)
    Unit cur, nxt; int ui = 0;
    if (!S.next(0, cur)) return;
    f32x4 acc[2][2][4][2];
#pragma unroll
    for (int a = 0; a < 2; ++a)
#pragma unroll
        for (int b = 0; b < 2; ++b)
#pragma unroll
            for (int m = 0; m < 4; ++m)
#pragma unroll
                for (int n = 0; n < 2; ++n) acc[a][b][m][n] = (f32x4){0.f, 0.f, 0.f, 0.f};
    bf16x8 At[4][2], B0[2][2], B1[2][2];
    unsigned vgc[2][2], vgn[2][2];
    if constexpr (GATHER) {
#pragma unroll
        for (int h = 0; h < 2; ++h)
#pragma unroll
            for (int i = 0; i < 2; ++i) { vgc[h][i] = ((unsigned)S.row_of(cur, h * HALF + Rr[i]) * (unsigned)K + (unsigned)Cc[i]) * 2u; vgn[h][i] = vgc[h][i]; }
    }
    const char* cA = GATHER ? Abase : Abase + (size_t)cur.arow * K * 2; const char* cB = cur.Bp;
    PG8_STAGE(PG8_SB(0, 0), cB, voffB); PG8_STAGE(PG8_SB(0, 1), cB + hstep, voffB); PG8_STAGE_A(PG8_SA(0, 0), cA, 0, 0, vgc); PG8_STAGE_A(PG8_SA(0, 1), cA, 1, 0, vgc);
    if (wr == 1) PG8_BAR;
    PG8_WAIT_V(2); PG8_BAR;
    PG8_STAGE(PG8_SB(1, 0), cB + kstep, voffB); PG8_STAGE_A(PG8_SA(1, 0), cA, 0, kstep, vgc); PG8_STAGE(PG8_SB(1, 1), cB + hstep + kstep, voffB);
    PG8_WAIT_V(6); PG8_BAR;
    for (;;) {
        const bool has_next = S.next(ui + 1, nxt);
        const char* nA = has_next ? (GATHER ? Abase : Abase + (size_t)nxt.arow * K * 2) : cA; const char* nB = has_next ? nxt.Bp : cB;
        if constexpr (GATHER) {
            if (has_next) {
#pragma unroll
                for (int h = 0; h < 2; ++h)
#pragma unroll
                    for (int i = 0; i < 2; ++i) vgn[h][i] = ((unsigned)S.row_of(nxt, h * HALF + Rr[i]) * (unsigned)K + (unsigned)Cc[i]) * 2u;
            } else {
#pragma unroll
                for (int h = 0; h < 2; ++h)
#pragma unroll
                    for (int i = 0; i < 2; ++i) vgn[h][i] = vgc[h][i];
            }
        }
        for (int t = 0; t < nt; t += 2) {
            const bool last = (t == nt - 2);
            const size_t k1 = (size_t)(t + 1) * kstep;
            const char* a2 = last ? nA : cA; const char* b2 = last ? nB : cB + (size_t)(t + 2) * kstep;
            const size_t k2 = last ? 0 : (size_t)(t + 2) * kstep, k3 = k2 + kstep;
            const char* b3 = b2 + kstep;
            unsigned vg2[2][2];
            if constexpr (GATHER) {
#pragma unroll
                for (int h = 0; h < 2; ++h)
#pragma unroll
                    for (int i = 0; i < 2; ++i) vg2[h][i] = last ? vgn[h][i] : vgc[h][i];
            }
            PG8_LDB(B0, 0, 0); PG8_LDB(B1, 0, 1); PG8_SCHED; PG8_LDA(At, 0, 0); PG8_STAGE_A(PG8_SA(1, 1), cA, 1, k1, vgc);
            PG8_WAIT_V(8); PG8_WAIT_L(0); PG8_BAR; PG8_MMA(0, 0, At, B0); PG8_MMA(0, 1, At, B1); PG8_BAR; PG8_SCHED;
            PG8_LDA(At, 0, 1); PG8_STAGE(PG8_SB(0, 0), b2, voffB); PG8_STAGE(PG8_SB(0, 1), b2 + hstep, voffB); PG8_STAGE_A(PG8_SA(0, 0), a2, 0, k2, vg2);
            PG8_WAIT_V(8); PG8_WAIT_L(0); PG8_BAR; PG8_MMA(1, 0, At, B0); PG8_MMA(1, 1, At, B1); PG8_BAR; PG8_SCHED;
            PG8_LDB(B0, 1, 0); PG8_LDB(B1, 1, 1); PG8_SCHED; PG8_LDA(At, 1, 0); PG8_STAGE_A(PG8_SA(0, 1), a2, 1, k2, vg2);
            PG8_WAIT_V(8); PG8_WAIT_L(0); PG8_BAR; PG8_MMA(0, 0, At, B0); PG8_MMA(0, 1, At, B1); PG8_BAR; PG8_SCHED;
            PG8_LDA(At, 1, 1); PG8_STAGE(PG8_SB(1, 0), b3, voffB); PG8_STAGE(PG8_SB(1, 1), b3 + hstep, voffB); PG8_STAGE_A(PG8_SA(1, 0), a2, 0, k3, vg2);
            PG8_WAIT_V(8); PG8_WAIT_L(0); PG8_BAR; PG8_MMA(1, 0, At, B0); PG8_MMA(1, 1, At, B1); PG8_BAR; PG8_SCHED;
        }
        if constexpr (ALIGN_EPI) { if (wr == 0) PG8_BAR; }
        E(acc, cur, wr, wc, fr, fq);
        if (!has_next) break;
#pragma unroll
        for (int a = 0; a < 2; ++a)
#pragma unroll
            for (int b = 0; b < 2; ++b)
#pragma unroll
                for (int m = 0; m < 4; ++m)
#pragma unroll
                    for (int n = 0; n < 2; ++n) acc[a][b][m][n] = (f32x4){0.f, 0.f, 0.f, 0.f};
        cur = nxt; cA = nA; cB = nB; ++ui;
        if constexpr (GATHER) {
#pragma unroll
            for (int h = 0; h < 2; ++h)
#pragma unroll
                for (int i = 0; i < 2; ++i) vgc[h][i] = vgn[h][i];
        }
        if constexpr (ALIGN_EPI) { if (wr == 1) PG8_BAR; }
    }
    PG8_WAIT_V(0);
    if constexpr (!ALIGN_EPI) { if (wr == 0) PG8_BAR; }
    PG8_BAR;
#undef PG8_SA
#undef PG8_SB
#undef PG8_STAGE
#undef PG8_STAGE_A
#undef PG8_LDA
#undef PG8_LDB
#undef PG8_MMA
#undef PG8_WAIT_V
#undef PG8_WAIT_L
#undef PG8_BAR
#undef PG8_SCHED
}

struct RegOrder {
    int nM, nN, nwg, G, c, K; const char* Bt;
    __device__ __forceinline__ void init(int M, int N, int K_, const void* Bt_, int G_, int c_) { nM = M / BM; nN = N / BM; nwg = nM * nN; G = G_; c = c_; K = K_; Bt = (const char*)Bt_; }
    __device__ __forceinline__ bool next(int i, Unit& u) const {
        const long L = (long)i * G + c; if (L >= nwg) return false;
        int wgid = (int)L; { const int q = nwg / NXCD, r = nwg % NXCD, xcd = wgid % NXCD, off = wgid / NXCD; wgid = (xcd < r ? xcd * (q + 1) : r * (q + 1) + (xcd - r) * q) + off; }
        const int nig = WGM * nN, gid = wgid / nig, fm = gid * WGM, gsz = (nM - fm) < WGM ? (nM - fm) : WGM;
        const int pm = fm + ((wgid % nig) % gsz), pn = (wgid % nig) / gsz;
        u.arow = pm * BM; u.orow = pm * BM; u.ocol = pn * BM; u.e = 0; u.rt = 0; u.Bp = Bt + (size_t)pn * BM * K * 2; return true;
    }
    __device__ __forceinline__ int row_of(const Unit&, int) const { return 0; }
};
}
namespace at {
constexpr int NW = 8, QBLK = 32, KVBLK = 64, QB = NW * QBLK, D = 128;
constexpr int SHM_V = KVBLK * D * 2, SHM_K = KVBLK * D * 2;
constexpr int OFF_WS = 2 * SHM_V + 2 * SHM_K, OFF_NF = OFF_WS + NW * 64 * 4, ATT_LDS = OFF_NF + 2 * 64 * 4;
constexpr float SCALE = 0.08838834764831845f, C2 = 1.4426950408889634f * SCALE, THR = 8.f;
constexpr float ISCALE = 11.313708498984761f;
constexpr int QS = 128, KS = 128, VS = NZ, OS = DM;

#define KSWZ(row, colB) ((row) * 256 + ((colB) ^ (((row) & 7) << 4)))
#define SBAR() __builtin_amdgcn_sched_barrier(0)
__device__ __forceinline__ int v_st(int k, int c) { const int kk = (k & ~0xC) | ((k & 4) << 1) | ((k & 8) >> 1); return ((kk >> 3) * 4 + (c >> 5)) * 512 + ((kk & 7) * 32 + (c & 31)) * 2; }
__device__ __forceinline__ int v_rd_base(int lane) { return ((lane & 3) << 3) | (((lane >> 2) & 3) << 6) | (((lane >> 4) & 1) << 5) | (((lane >> 5) & 1) << 8); }
constexpr int v_rd_off(int d0, int ks, int half) { return d0 * 512 + ks * 4096 + half * 2048; }
__device__ __forceinline__ int crow(int r, int hi) { return (r & 3) + 8 * (r >> 2) + 4 * hi; }
__device__ __forceinline__ unsigned cvtpk(float lo, float hi) { unsigned r; asm volatile("v_cvt_pk_bf16_f32 %0, %1, %2" : "=v"(r) : "v"(lo), "v"(hi)); return r; }
__device__ __forceinline__ bf16x8 load8(const bf16* p) { return *(const GAS bf16x8*)p; }

__device__ __forceinline__ void mask_tile(f32x16& p0, f32x16& p1, int dq) {
    const float NEG = -__builtin_inff();
#pragma unroll
    for (int r = 0; r < 16; ++r) {
        const int c = (r & 3) + 8 * (r >> 2);
        if (dq - c < 0) p0[r] = NEG;
        if (dq - c - 32 < 0) p1[r] = NEG;
    }
}
__device__ __forceinline__ void partialSM(f32x16& p0, f32x16& p1, float& m_reg, float& mn, float& alpha) {
    float pmax = p0[0]; for (int r = 1; r < 16; ++r) pmax = fmaxf(pmax, p0[r]); for (int r = 0; r < 16; ++r) pmax = fmaxf(pmax, p1[r]);
    { auto rr = __builtin_amdgcn_permlane32_swap(__float_as_uint(pmax), __float_as_uint(pmax), false, false);
      pmax = fmaxf(__uint_as_float(rr[0]), __uint_as_float(rr[1])); }
    if (__builtin_expect(__all((pmax - m_reg) * SCALE <= THR), 1)) { mn = m_reg; alpha = 1.f; }
    else { mn = fmaxf(m_reg, pmax); alpha = __builtin_amdgcn_exp2f((m_reg - mn) * C2); m_reg = mn; }
    const float mnL = -mn * C2;
    for (int r = 0; r < 16; ++r) p0[r] = fmaf(p0[r], C2, mnL); for (int r = 0; r < 16; ++r) p1[r] = fmaf(p1[r], C2, mnL);
    for (int r = 0; r < 16; ++r) p0[r] = __builtin_amdgcn_exp2f(p0[r]);
}
__device__ __forceinline__ void finishSM(f32x16& p0, f32x16& p1, float alpha, float& l_reg, bf16x8& pa0, bf16x8& pa1, bf16x8& pa2, bf16x8& pa3) {
    for (int r = 0; r < 16; ++r) p1[r] = __builtin_amdgcn_exp2f(p1[r]);
    float ps = 0; for (int r = 0; r < 16; ++r) ps += p0[r]; for (int r = 0; r < 16; ++r) ps += p1[r];
    { auto rr = __builtin_amdgcn_permlane32_swap(__float_as_uint(ps), __float_as_uint(ps), false, false);
      ps = __uint_as_float(rr[0]) + __uint_as_float(rr[1]); }
    l_reg = l_reg * alpha + ps;
#define PK4(P, B_, OUT) do { unsigned a0 = cvtpk(P[B_+0], P[B_+1]), a1 = cvtpk(P[B_+2], P[B_+3]);                          \
        unsigned b0 = cvtpk(P[B_+4], P[B_+5]), b1 = cvtpk(P[B_+6], P[B_+7]);                                             \
        auto r0 = __builtin_amdgcn_permlane32_swap(a0, b0, false, false); auto r1 = __builtin_amdgcn_permlane32_swap(a1, b1, false, false); \
        u32x4 w = {r0[0], r1[0], r0[1], r1[1]}; OUT = *reinterpret_cast<bf16x8*>(&w); } while (0)
    PK4(p0, 0, pa0); PK4(p0, 8, pa1); PK4(p1, 0, pa2); PK4(p1, 8, pa3);
#undef PK4
}
template <int KB>
__device__ __forceinline__ void qkt(f32x16& p0, f32x16& p1, const char* K_lds, int r32, int hi, const bf16x8* qr) {
    { const float* nf = (const float*)(K_lds + 2 * SHM_K + NW * 64 * 4) + KB * 64 + 4 * hi;
#pragma unroll
      for (int g = 0; g < 4; ++g) { const f32x4 a = *(const f32x4*)(nf + 8 * g), b = *(const f32x4*)(nf + 32 + 8 * g);
#pragma unroll
          for (int j = 0; j < 4; ++j) { p0[4 * g + j] = a[j]; p1[4 * g + j] = b[j]; } } }
    const char* kb[4];
#pragma unroll
    for (int dd = 0; dd < 4; ++dd) kb[dd] = K_lds + KB * SHM_K + KSWZ(r32, (dd * 16 + hi * 8) * 2);
#pragma unroll
    for (int d0 = 0; d0 < 8; ++d0) { const char* a = kb[d0 & 3] + (d0 >> 2) * 128;
        bf16x8 b0 = *reinterpret_cast<const bf16x8*>(a);
        bf16x8 b1 = *reinterpret_cast<const bf16x8*>(a + 32 * 256);
        p0 = __builtin_amdgcn_mfma_f32_32x32x16_bf16(b0, qr[d0], p0, 0, 0, 0);
        p1 = __builtin_amdgcn_mfma_f32_32x32x16_bf16(b1, qr[d0], p1, 0, 0, 0); }
}
template <int VB>
__device__ __forceinline__ void pv_tile(f32x16* o, int vb0, bf16x8 pa0, bf16x8 pa1, bf16x8 pa2, bf16x8 pa3) {
#define TRRD(dst, off) asm volatile("ds_read_b64_tr_b16 %0, %1 offset:%2" : "=&v"(dst) : "v"(vb0), "i"(off) : "memory")
#define PV_D0(d0) do { s16x4 l0, l1, l2, l3, h0, h1, h2, h3; constexpr int b_ = VB * SHM_V + v_rd_off(d0, 0, 0); \
        TRRD(l0, b_); TRRD(h0, b_ + 2048); TRRD(l1, b_ + 4096); TRRD(h1, b_ + 6144); TRRD(l2, b_ + 8192); TRRD(h2, b_ + 10240); TRRD(l3, b_ + 12288); TRRD(h3, b_ + 14336); \
        asm volatile("s_waitcnt lgkmcnt(0)" ::: "memory"); SBAR();   \
        o[d0] = __builtin_amdgcn_mfma_f32_32x32x16_bf16(pa0, (bf16x8){l0[0], l0[1], l0[2], l0[3], h0[0], h0[1], h0[2], h0[3]}, o[d0], 0, 0, 0);   \
        o[d0] = __builtin_amdgcn_mfma_f32_32x32x16_bf16(pa1, (bf16x8){l1[0], l1[1], l1[2], l1[3], h1[0], h1[1], h1[2], h1[3]}, o[d0], 0, 0, 0);   \
        o[d0] = __builtin_amdgcn_mfma_f32_32x32x16_bf16(pa2, (bf16x8){l2[0], l2[1], l2[2], l2[3], h2[0], h2[1], h2[2], h2[3]}, o[d0], 0, 0, 0);   \
        o[d0] = __builtin_amdgcn_mfma_f32_32x32x16_bf16(pa3, (bf16x8){l3[0], l3[1], l3[2], l3[3], h3[0], h3[1], h3[2], h3[3]}, o[d0], 0, 0, 0); } while (0)
    PV_D0(0); PV_D0(1); PV_D0(2); PV_D0(3);
#undef PV_D0
#undef TRRD
}

struct BlockRef { const bf16* Q; const bf16* K; const bf16* V; bf16* O; const float* FK; int P0; };
#define ROWV(p, k0, rr) ((p) + (size_t)((k0) + (rr)) * VS + sc)
#define VMW() asm volatile("s_waitcnt vmcnt(0)" ::: "memory")
__device__ __forceinline__ void attn_block(const BlockRef& cur, int ja, int nt, bool fin, bf16* Opart, float* ML, char* lds, LAS unsigned char* ldsL) {
    const int tid = opq_tid(), wid = __builtin_amdgcn_readfirstlane(tid >> 6), lane = tid & 63, r32 = lane & 31, hi = lane >> 5;
    const int NT = nt;
    const int qlo = cur.P0 + wid * QBLK, qm = qlo + r32 - 4 * hi;
    char* V_lds = lds; char* K_lds = lds + 2 * SHM_V;
    float* ws = (float*)(lds + OFF_WS) + wid * 64; float* li_l = ws, * al_l = ws + 32;
    float m_reg = -1e30f, l_reg = 0; f32x16 o[4] = {};
    const int vb0 = (int)(uintptr_t)V_lds + v_rd_base(lane);
    const bf16* Kh = cur.K; const bf16* Vh = cur.V; const float* Fh = cur.FK;
    bf16x8 st_v0, st_v1; bf16x8 qr[8];
#define KDMA(bf, k0) do { int t_ = tid; asm volatile("" : "+v"(t_)); _Pragma("unroll") for (int i_ = 0; i_ < 2; ++i_) { const int p_ = i_ * 512 + t_, r_ = p_ >> 4, c_ = (p_ & 15) ^ (r_ & 7); \
        __builtin_amdgcn_global_load_lds((const unsigned*)((const char*)Kh + (size_t)(k0) * KS * 2 + (unsigned)(r_ * KS * 2 + c_ * 16)), (LAS unsigned*)(ldsL + 2 * SHM_V + (bf) * SHM_K + i_ * 8192 + wid * 1024), 16, 0, 0); } \
        if (wid == 0) __builtin_amdgcn_global_load_lds((const unsigned*)(Fh + (k0) + lane), (LAS unsigned*)(ldsL + OFF_NF + (bf) * 256), 4, 0, 0); } while (0)
#define SLOADV(k0) do { int t_ = tid; asm volatile("" : "+v"(t_)); const int sr = t_ >> 4, sc = (t_ & 15) * 8; st_v0 = load8(ROWV(Vh, k0, sr)); st_v1 = load8(ROWV(Vh, k0, 32 + sr)); } while (0)
#define SWRITE_HV(bf) do { int t_ = tid; asm volatile("" : "+v"(t_)); const int sr = t_ >> 4, sc = (t_ & 15) * 8; *(bf16x8*)(V_lds + (bf) * SHM_V + v_st(sr, sc)) = st_v0; *(bf16x8*)(V_lds + (bf) * SHM_V + v_st(32 + sr, sc)) = st_v1; } while (0)
#define RESC(a) do { if (__any((a) < 1.f)) { if (hi == 0) al_l[r32] = (a); asm volatile("s_waitcnt lgkmcnt(0)" ::: "memory");              \
                     for (int d_ = 0; d_ < 4; ++d_) for (int r = 0; r < 16; ++r) o[d_][r] *= al_l[crow(r, hi)]; } } while (0)
#define KBASE(t) ((ja + (t)) * KVBLK)
#define MASKT(P0_, P1_, t) do { const int kb_ = KBASE(t); if (kb_ + KVBLK - 1 > qlo) mask_tile(P0_, P1_, qm - kb_); } while (0)
    f32x16 pA0, pA1, pB0, pB1; float mnA, mnB, alA, alB; bf16x8 pa0, pa1, pa2, pa3;
    KDMA(0, KBASE(0)); SLOADV(KBASE(0));
#pragma unroll
    for (int d0 = 0; d0 < 8; ++d0) qr[d0] = load8(cur.Q + (size_t)(wid * QBLK + r32) * QS + d0 * 16 + hi * 8);
    VMW(); SWRITE_HV(0);
    __syncthreads();
    if (NT > 1) { KDMA(1, KBASE(1)); SLOADV(KBASE(1)); }
    SBAR(); qkt<0>(pA0, pA1, K_lds, r32, hi, qr);
    MASKT(pA0, pA1, 0); partialSM(pA0, pA1, m_reg, mnA, alA);
    if (NT > 1) { VMW(); SWRITE_HV(1); }
    __syncthreads();
#define HALF_STEP(PX0, PX1, mnX, alX, PY0, PY1, alY, t, KB, VB, SB) do {                                                      \
        SBAR(); qkt<KB>(PX0, PX1, K_lds, r32, hi, qr);                                                                        \
        finishSM(PY0, PY1, alY, l_reg, pa0, pa1, pa2, pa3); SBAR();                                                           \
        if ((t) + 1 < NT) { KDMA(SB, KBASE((t) + 1)); SLOADV(KBASE((t) + 1)); SBAR(); }                                       \
        pv_tile<VB>(o, vb0, pa0, pa1, pa2, pa3); MASKT(PX0, PX1, (t)); partialSM(PX0, PX1, m_reg, mnX, alX);                  \
        VMW(); __syncthreads();                                                                                               \
        if ((t) + 1 < NT) { SWRITE_HV(SB); }                                                                                  \
        RESC(alX); __syncthreads(); } while (0)
    for (int t = 1; t + 1 < NT; t += 2) {
        HALF_STEP(pB0, pB1, mnB, alB, pA0, pA1, alA, t, 1, 0, 0);
        HALF_STEP(pA0, pA1, mnA, alA, pB0, pB1, alB, t + 1, 0, 1, 1);
    }
    const bool even = (NT & 1) == 0;
    if (even) { SBAR(); qkt<1>(pB0, pB1, K_lds, r32, hi, qr); SBAR(); }
    finishSM(pA0, pA1, alA, l_reg, pa0, pa1, pa2, pa3); SBAR();
    pv_tile<0>(o, vb0, pa0, pa1, pa2, pa3);
    if (even) { MASKT(pB0, pB1, NT - 1); partialSM(pB0, pB1, m_reg, mnB, alB); __syncthreads(); RESC(alB);
        finishSM(pB0, pB1, alB, l_reg, pa0, pa1, pa2, pa3); SBAR(); pv_tile<1>(o, vb0, pa0, pa1, pa2, pa3); }
    SBAR();
    if (hi == 0) li_l[r32] = l_reg; asm volatile("s_waitcnt lgkmcnt(0)" ::: "memory");
    float rli[16];
#pragma unroll
    for (int r = 0; r < 16; ++r) rli[r] = __builtin_amdgcn_rcpf(li_l[crow(r, hi)]);
    const int ostr = fin ? OS : D;
    bf16* Ow = (fin ? cur.O : Opart) + (size_t)(wid * QBLK) * ostr;
#pragma unroll
    for (int r = 0; r < 16; ++r) { const int orow = crow(r, hi);
#pragma unroll
        for (int d0 = 0; d0 < 4; ++d0) { const float v = o[d0][r] * rli[r];
            const float vn = __shfl_xor(v, 1);
            if ((r32 & 1) == 0) *(GAS unsigned*)(Ow + (size_t)orow * ostr + d0 * 32 + r32) = cvtpk(v, vn); } }
    if (!fin && hi == 0) { f32x2 mlv; mlv.x = m_reg; mlv.y = l_reg; *(GAS f32x2*)(ML + (size_t)(wid * QBLK + r32) * 2) = mlv; }
    __syncthreads();
#undef KDMA
#undef SLOADV
#undef SWRITE_HV
#undef RESC
#undef KBASE
#undef MASKT
#undef HALF_STEP
}
#undef ROWV
#undef VMW
}
struct Frame {
    LAS unsigned char* lds; volatile LAS unsigned* MISC; gu32* ctl;
    int tid, lane, wave, vcu, G;
    unsigned char* ws;
};
#define CAS __attribute__((address_space(4)))
__device__ __forceinline__ const float* karg(int k) { const CAS char* p = (const CAS char*)__builtin_amdgcn_kernarg_segment_ptr(); asm volatile("" : "+s"(p)); return *(const float* const CAS*)(p + 8 * k); }

__device__ __forceinline__ void tr_item(const float* W, size_t ldw, bf16* WT, size_t ldk, LAS float* scr, int lane) {
    const int kr = lane >> 3, c4 = (lane & 7) * 4;
    f32x4 v[8];
#pragma unroll
    for (int i = 0; i < 8; ++i) v[i] = *(const GAS f32x4*)(W + (size_t)(8 * i + kr) * ldw + c4);
#pragma unroll
    for (int i = 0; i < 8; ++i) { LAS float* s = scr + (8 * i + kr) * 33 + c4; s[0] = v[i].x; s[1] = v[i].y; s[2] = v[i].z; s[3] = v[i].w; }
    LDS_WAIT();
    const int c = lane & 7;
#pragma unroll
    for (int j = 0; j < 4; ++j) { const int n = (lane >> 3) + 8 * j; const LAS float* s = scr + (8 * c) * 33 + n;
        u32x4 o; o.x = cvt_pk_bf16(s[0 * 33], s[1 * 33]); o.y = cvt_pk_bf16(s[2 * 33], s[3 * 33]); o.z = cvt_pk_bf16(s[4 * 33], s[5 * 33]); o.w = cvt_pk_bf16(s[6 * 33], s[7 * 33]);
        *(GAS u32x4*)(WT + (size_t)n * ldk + 8 * c) = o; }
    LDS_WAIT();
}
constexpr int I_IN = (DM / 64) * (NZ / 32), I_OUT = (DM / 64) * (DM / 32), I_GU = (DM / 64) * (DEX / 32), I_D = (DEX / 64) * (DM / 32);
constexpr int GV_FIRST = 43;
constexpr int BGI_SMALL = (NLAYER * 4 * 8) / 8, BGI_IN = I_IN / 8, BGI_GV0 = (128 - GV_FIRST) * 4, BGI_GV1 = 128 * 4, BGI_OUT = I_OUT / 8, BGI_GU = NEXP * 2 * I_GU / 8, BGI_D = NEXP * I_D / 8;
constexpr int BG_C0 = BGI_SMALL + BGI_IN;
constexpr int BG_C1 = BG_C0 + BGI_GV0 + BGI_OUT;
constexpr int BG_C2 = BG_C1 + BGI_GU;
constexpr int BG_C3 = BG_C2 + BGI_D;
constexpr int BG_C3B = BG_C3 + BGI_GV1;
constexpr int BG_C4 = BG_C3B + BGI_IN;
constexpr int BG_C5 = BG_C4 + BGI_OUT;
constexpr int BG_C6 = BG_C5 + BGI_GU;
constexpr int BG_C7 = BG_C6 + BGI_D;
__device__ __forceinline__ float mod_at(const unsigned char* ws, const float* b_ada, int l, int j) {
    const float* p = (const float*)(ws + WS_MODP) + (size_t)l * 6 * DM + j;
    return *(const GAS float*)(b_ada + (size_t)l * 6 * DM + j) + ((*(const GAS float*)p + *(const GAS float*)(p + 2 * 6 * DM)) + (*(const GAS float*)(p + 4 * 6 * DM) + *(const GAS float*)(p + 6 * 6 * DM)));
}
__device__ __forceinline__ void gemv_item(const Frame& F, unsigned char* ws, int w) {
    LAS float* sc = (LAS float*)F.lds; LAS f32x4* red = (LAS f32x4*)(F.lds + 8192);
    const int kq = w & 3, l = w >> 9, cb = (w >> 2) & 127, c4 = F.tid % 24, kg = F.tid / 24;
    if (F.tid < 512) sc[F.tid] = silu_f(*(const GAS float*)(karg(1) + kq * 512 + F.tid));
    __syncthreads();
    f32x4 acc = (f32x4){0.f, 0.f, 0.f, 0.f};
    if (kg < 21) {
        const float* wp = karg(2) + (size_t)l * DM * 6 * DM + (size_t)(kq * 512) * 6 * DM + cb * 96 + c4 * 4;
#pragma unroll 8
        for (int k = kg; k < 512; k += 21) { const f32x4 wv = *(const GAS f32x4*)(wp + (size_t)k * 6 * DM); acc += wv * sc[k]; }
        red[kg * 24 + c4] = acc;
    }
    __syncthreads();
    if (F.tid < 24) { f32x4 s = red[F.tid];
        for (int g = 1; g < 21; ++g) s += red[g * 24 + F.tid];
        *(GAS f32x4*)((float*)(ws + WS_MODP) + (size_t)kq * 2 * 6 * DM + (size_t)l * 6 * DM + cb * 96 + F.tid * 4) = s; }
    __syncthreads();
}
__device__ __forceinline__ void conv_wave_item(const Frame& F, unsigned char* ws, int r, int l, LAS float* scr) {
    if (r < I_IN) { const int kb = r / (NZ / 32), nb = r % (NZ / 32);
        tr_item(karg(6) + (size_t)l * DM * NIN + (size_t)(64 * kb) * NIN + 32 * nb, NIN, (bf16*)(ws + WS_WIN) + (size_t)l * NZ * DM + (size_t)(32 * nb) * DM + 64 * kb, DM, scr, F.lane); return; }
    r -= I_IN;
    if (r < I_OUT) { const int kb = r / (DM / 32), nb = r % (DM / 32);
        tr_item(karg(15) + (size_t)l * DM * DM + (size_t)(64 * kb) * DM + 32 * nb, DM, (bf16*)(ws + WS_WOUT) + (size_t)l * DM * DM + (size_t)(32 * nb) * DM + 64 * kb, DM, scr, F.lane); return; }
    r -= I_OUT;
    if (r < NEXP * 2 * I_GU) { const int e = r / (2 * I_GU); r -= e * 2 * I_GU; const int up = r >= I_GU; if (up) r -= I_GU; const int kb = r / (DEX / 32), nb = r % (DEX / 32), n0 = 32 * nb;
        const float* src = (up ? karg(19) : karg(18)) + ((size_t)l * NEXP + e) * DM * DEX + (size_t)(64 * kb) * DEX + n0;
        const int drow = (n0 >> 7) * 256 + (up ? 128 : 0) + (n0 & 127);
        tr_item(src, DEX, (bf16*)(ws + WS_WGU) + ((size_t)l * NEXP + e) * DM * DM + (size_t)drow * DM + 64 * kb, DM, scr, F.lane); return; }
    r -= NEXP * 2 * I_GU;
    { const int e = r / I_D; r -= e * I_D; const int kb = r / (DM / 32), nb = r % (DM / 32);
      tr_item(karg(20) + ((size_t)l * NEXP + e) * DEX * DM + (size_t)(64 * kb) * DM + 32 * nb, DM, (bf16*)(ws + WS_WD) + ((size_t)l * NEXP + e) * DM * DEX + (size_t)(32 * nb) * DEX + 64 * kb, DEX, scr, F.lane); }
}
__device__ __forceinline__ void bg_item(const Frame& F, unsigned char* ws, int t) {
    LAS float* scr = (LAS float*)(F.lds + 16384 + F.wave * 9216);
    if (t < BGI_SMALL) { const int r = t * 8 + F.wave, mat = r >> 3, q = r & 7, kb = q >> 2, nb = q & 3;
        tr_item(karg(10) + (size_t)mat * 128 * 128 + (size_t)(64 * kb) * 128 + 32 * nb, 128, (bf16*)(ws + WS_BWT) + (size_t)mat * 128 * 128 + (size_t)(32 * nb) * 128 + 64 * kb, 128, scr, F.lane); return; }
    t -= BGI_SMALL;
    if (t < BGI_IN) { conv_wave_item(F, ws, t * 8 + F.wave, 0, scr); return; }
    t -= BGI_IN;
    if (t < BGI_GV0) { gemv_item(F, ws, GV_FIRST * 4 + t); return; }
    t -= BGI_GV0;
    if (t < BGI_OUT + BGI_GU + BGI_D) { conv_wave_item(F, ws, I_IN + t * 8 + F.wave, 0, scr); return; }
    t -= BGI_OUT + BGI_GU + BGI_D;
    if (t < BGI_GV1) { gemv_item(F, ws, 512 + t); return; }
    t -= BGI_GV1;
    conv_wave_item(F, ws, t * 8 + F.wave, 1, scr);
}
__device__ __forceinline__ void bg_fill(const Frame& F0, int seam, int need) {
    unsigned char* const ws = opq(F0.ws); Frame F = F0; F.tid = opq_tid(); F.lane = F.tid & 63;
    LAS unsigned* slot = (LAS unsigned*)(F.lds + AUX_OFF + 24576);
    gu32* ticket = F.ctl + CW_BGT; gu32* arr = F.ctl + CW_ARR + 64 * seam;
    unsigned tn = 0xffffffffu; bool pre = false;
    if (F.tid == 0 && slot[1] == 0u) { (void)__hip_atomic_fetch_add(arr, 1u, RLX_AGENT); const unsigned cur = __hip_atomic_load(ticket, RLX_AGENT);
        if (cur >= (unsigned)BG_C7) slot[1] = 1u;
        else if (cur < (unsigned)need || __hip_atomic_load(arr, RLX_AGENT) < (unsigned)F.G) tn = __hip_atomic_fetch_add(ticket, 1u, RLX_AGENT); }
    for (;;) {
        if (F.tid == 0) slot[0] = tn;
        __syncthreads();
        const unsigned t = __builtin_amdgcn_readfirstlane(slot[0]);
        __syncthreads();
        if (t >= (unsigned)BG_C7) { if (F.tid == 0 && t != 0xffffffffu) slot[1] = 1u; break; }
        if (F.tid == 0) { tn = 0xffffffffu; pre = (t + 2u < (unsigned)need);
            if (pre) tn = __hip_atomic_fetch_add(ticket, 1u, RLX_AGENT); }
        bg_item(F, ws, (int)t);
        if (F.tid == 0 && !pre) { if (t + 1u < (unsigned)need || __hip_atomic_load(arr, RLX_AGENT) < (unsigned)F.G) tn = __hip_atomic_fetch_add(ticket, 1u, RLX_AGENT); }
    }
}
__device__ __forceinline__ void p0_prologue(const Frame& F0) {
    unsigned char* const ws = opq(F0.ws); Frame F = F0; F.tid = opq_tid(); F.lane = F.tid & 63;
    for (int w = F.vcu; w < GV_FIRST * 4; w += F.G) gemv_item(F, ws, w);
    for (int i = (F.vcu * NTHR + F.tid) * 2; i < NLAYER * 4 * 128 * 128; i += F.G * NTHR * 2) {
        const int t = (i >> 7) & 127, s = i & 127;
        const f32x2 w = *(const GAS f32x2*)(karg(7) + i);
        const bool keep = (s >> 6) <= (t >> 6);
        *(GAS unsigned*)((bf16*)(ws + WS_WM) + i) = keep ? cvt_pk_bf16(w.x, w.y) : 0u;
    }
}

template <int MODE>
__device__ __forceinline__ void phase_norm1(const Frame& F0, int l, const float* xin, float* xout, int lprev) {
    unsigned char* const ws = opq(F0.ws); Frame F = F0; F.tid = opq_tid(); F.lane = F.tid & 63;
    LAS float* wfT = (LAS float*)F.lds;
    LAS float* gaL = (LAS float*)(F.lds + 65536);
    LAS float* gbL = (LAS float*)(F.lds + 73728);
    LAS float* g2L = (LAS float*)(F.lds + 81920);
    LAS float* lf = (LAS float*)(F.lds + 90112);
    LAS int* hb = (LAS int*)(F.lds + 91136);
    if (MODE != 2) {
        for (int i = F.tid; i < DM * 2; i += NTHR) { const int d = i >> 1, half = i & 1;
            const f32x4 w = *(const GAS f32x4*)(karg(6) + (size_t)l * DM * NIN + (size_t)d * NIN + NZ + half * 4);
            wfT[(half * 4 + 0) * DM + d] = w.x; wfT[(half * 4 + 1) * DM + d] = w.y; wfT[(half * 4 + 2) * DM + d] = w.z; wfT[(half * 4 + 3) * DM + d] = w.w; }
        for (int d = F.tid; d < DM; d += NTHR) { gaL[d] = *(const GAS float*)(karg(4) + (size_t)l * DM + d) * (1.f + mod_at(ws, karg(3), l, DM + d)); gbL[d] = mod_at(ws, karg(3), l, d); }
    }
    if (MODE != 0) {
        for (int d = F.tid; d < DM; d += NTHR) g2L[d] = mod_at(ws, karg(3), lprev, 5 * DM + d);
        if (F.tid == 0) { int a = 0; for (int e = 0; e < NEXP; ++e) { hb[e] = a; a += ((int)__hip_atomic_load(F.ctl + CW_CNT + 64 * lprev + e, RLX_AGENT) + 255) & ~255; } }
    }
    __syncthreads();
    const bf16* YB = (const bf16*)(ws + WS_YB);
    for (int c = F.vcu; c < SEQ / 32; c += F.G) {
        for (int rr = 0; rr < 4; ++rr) {
            const int rl = F.wave * 4 + rr, t = c * 32 + rl;
            f32x4 v[8];
#pragma unroll
            for (int j = 0; j < 8; ++j) v[j] = *(const GAS f32x4*)(xin + (size_t)t * DM + 256 * j + 4 * F.lane);
            if (MODE != 0) {
                const int* te = (const int*)(ws + WS_TOKE) + 2 * t; const int* tp = (const int*)(ws + WS_TOKP) + 2 * t; const float* tw = (const float*)(ws + WS_TOKW) + 2 * t;
                const int r0 = hb[*(const GAS int*)te] + *(const GAS int*)tp, r1 = hb[*(const GAS int*)(te + 1)] + *(const GAS int*)(tp + 1); const float w0 = *(const GAS float*)tw, w1 = *(const GAS float*)(tw + 1);
#pragma unroll 2
                for (int j = 0; j < 8; ++j) { const int d = 256 * j + 4 * F.lane;
                    const u32x2 y0 = *(const GAS u32x2*)(YB + (size_t)r0 * DM + d), y1 = *(const GAS u32x2*)(YB + (size_t)r1 * DM + d);
                    const f32x4 g2 = *(const LAS f32x4*)(g2L + d);
                    f32x4 y; y.x = w0 * bf_lo(y0.x) + w1 * bf_lo(y1.x); y.y = w0 * bf_hi(y0.x) + w1 * bf_hi(y1.x); y.z = w0 * bf_lo(y0.y) + w1 * bf_lo(y1.y); y.w = w0 * bf_hi(y0.y) + w1 * bf_hi(y1.y);
                    v[j] = v[j] + g2 * y;
                    *(GAS f32x4*)(xout + (size_t)t * DM + d) = v[j]; }
            }
            if (MODE != 2) {
                float ss = 0.f;
#pragma unroll
                for (int j = 0; j < 8; ++j) ss += (v[j].x * v[j].x + v[j].y * v[j].y) + (v[j].z * v[j].z + v[j].w * v[j].w);
                const float rs = rsqrtf(wave_sum(ss) * (1.f / DM) + EPSN);
                float fz[8] = {0.f, 0.f, 0.f, 0.f, 0.f, 0.f, 0.f, 0.f};
                bf16* hrow = (bf16*)(ws + WS_H) + (size_t)t * DM;
#pragma unroll 2
                for (int j = 0; j < 8; ++j) { const int d = 256 * j + 4 * F.lane;
                    const f32x4 h = v[j] * rs * *(const LAS f32x4*)(gaL + d) + *(const LAS f32x4*)(gbL + d);
                    u32x2 o; o.x = cvt_pk_bf16(h.x, h.y); o.y = cvt_pk_bf16(h.z, h.w);
                    *(GAS u32x2*)(hrow + d) = o;
#pragma unroll
                    for (int q = 0; q < 8; ++q) { const f32x4 w = *(const LAS f32x4*)(wfT + q * DM + d); fz[q] += (h.x * w.x + h.y * w.y) + (h.z * w.z + h.w * w.w); } }
#pragma unroll
                for (int q = 0; q < 8; ++q) fz[q] = wave_sum(fz[q]);
                if (F.lane < 8) { float z = fz[0];
#pragma unroll
                    for (int q = 1; q < 8; ++q) z = (F.lane == q) ? fz[q] : z;
                    z += *(const GAS float*)(karg(14) + l * 8 + F.lane);
                    lf[rl * 8 + F.lane] = fminf(z, 0.f) - log1pf(__expf(-fabsf(z))); }
            }
        }
        if (MODE != 2) {
            __syncthreads();
            if (F.tid < 8) { float a = 0.f; float* floc = (float*)(ws + WS_FLOC);
                for (int r = 0; r < 32; ++r) { a += lf[r * 8 + F.tid]; *(GAS float*)(floc + (size_t)(c * 32 + r) * 8 + F.tid) = a; }
                *(GAS float*)((float*)(ws + WS_TOT) + c * 8 + F.tid) = a; }
            __syncthreads();
        }
    }
}

__device__ __forceinline__ void phase_prep(const Frame& F0, int l) {
    unsigned char* const ws = opq(F0.ws); Frame F = F0; F.tid = opq_tid(); F.lane = F.tid & 63;
    LAS float* pre = (LAS float*)F.lds;
    {
        const float* tot = (const float*)(ws + WS_TOT);
        const int h = F.wave; double v0 = *(const GAS float*)(tot + (4 * F.lane + 0) * 8 + h), v1 = *(const GAS float*)(tot + (4 * F.lane + 1) * 8 + h), v2 = *(const GAS float*)(tot + (4 * F.lane + 2) * 8 + h), v3 = *(const GAS float*)(tot + (4 * F.lane + 3) * 8 + h);
        double s = v0 + v1 + v2 + v3, inc = s;
#pragma unroll
        for (int o = 1; o < 64; o <<= 1) { const double u = __shfl_up(inc, o); if (F.lane >= o) inc += u; }
        const double ex = inc - s;
        pre[h * 256 + 4 * F.lane + 0] = (float)ex; pre[h * 256 + 4 * F.lane + 1] = (float)(ex + v0); pre[h * 256 + 4 * F.lane + 2] = (float)(ex + v0 + v1); pre[h * 256 + 4 * F.lane + 3] = (float)(ex + v0 + v1 + v2);
    }
    __syncthreads();
    const bf16* Z = (const bf16*)(ws + WS_Z);
    float qg[16], kg[16], vg[8];
#pragma unroll
    for (int i = 0; i < 16; ++i) { qg[i] = *(const GAS float*)(karg(12) + l * 128 + (F.lane & 7) * 16 + i); kg[i] = *(const GAS float*)(karg(13) + l * 128 + (F.lane & 7) * 16 + i); }
#pragma unroll
    for (int i = 0; i < 8; ++i) vg[i] = *(const GAS float*)(karg(9) + l * 512 + F.lane * 8 + i);
    const int gw = F.vcu * NWAVES + F.wave, NGW = F.G * NWAVES;
    for (int t = gw; t < SEQ; t += NGW) {
        const bf16* zr = Z + (size_t)t * NZ;
#pragma unroll
        for (int which = 0; which < 2; ++which) {
            const u32x4 a = *(const GAS u32x4*)(zr + 1536 + which * 1024 + 16 * F.lane), b = *(const GAS u32x4*)(zr + 1536 + which * 1024 + 16 * F.lane + 8);
            float f[16]; f[0] = bf_lo(a.x); f[1] = bf_hi(a.x); f[2] = bf_lo(a.y); f[3] = bf_hi(a.y); f[4] = bf_lo(a.z); f[5] = bf_hi(a.z); f[6] = bf_lo(a.w); f[7] = bf_hi(a.w);
            f[8] = bf_lo(b.x); f[9] = bf_hi(b.x); f[10] = bf_lo(b.y); f[11] = bf_hi(b.y); f[12] = bf_lo(b.z); f[13] = bf_hi(b.z); f[14] = bf_lo(b.w); f[15] = bf_hi(b.w);
            float ss = 0.f;
#pragma unroll
            for (int i = 0; i < 16; ++i) ss += f[i] * f[i];
            ss += __shfl_xor(ss, 1); ss += __shfl_xor(ss, 2); ss += __shfl_xor(ss, 4);
            const float rs = rsqrtf(ss * (1.f / 128.f) + EPSN);
            u32x4 o0, o1;
#define QK_G(i) ((which ? kg[i] : qg[i]) * rs * f[i])
            o0.x = cvt_pk_bf16(QK_G(0), QK_G(1)); o0.y = cvt_pk_bf16(QK_G(2), QK_G(3)); o0.z = cvt_pk_bf16(QK_G(4), QK_G(5)); o0.w = cvt_pk_bf16(QK_G(6), QK_G(7));
            o1.x = cvt_pk_bf16(QK_G(8), QK_G(9)); o1.y = cvt_pk_bf16(QK_G(10), QK_G(11)); o1.z = cvt_pk_bf16(QK_G(12), QK_G(13)); o1.w = cvt_pk_bf16(QK_G(14), QK_G(15));
#undef QK_G
            bf16* dst = (bf16*)(ws + (which ? WS_KN : WS_QN)) + ((size_t)(F.lane >> 3) * SEQ + t) * 128 + (F.lane & 7) * 16;
            *(GAS u32x4*)dst = o0; *(GAS u32x4*)(dst + 8) = o1;
        }
        {
            const u32x4 a = *(const GAS u32x4*)(zr + 512 + 8 * F.lane);
            float f[8]; f[0] = bf_lo(a.x); f[1] = bf_hi(a.x); f[2] = bf_lo(a.y); f[3] = bf_hi(a.y); f[4] = bf_lo(a.z); f[5] = bf_hi(a.z); f[6] = bf_lo(a.w); f[7] = bf_hi(a.w);
            float ss = 0.f;
#pragma unroll
            for (int i = 0; i < 8; ++i) ss += f[i] * f[i];
            ss += __shfl_xor(ss, 1); ss += __shfl_xor(ss, 2); ss += __shfl_xor(ss, 4); ss += __shfl_xor(ss, 8);
            const float rs = rsqrtf(ss * (1.f / 128.f) + EPSN);
            u32x4 o; o.x = cvt_pk_bf16(f[0] * rs * vg[0], f[1] * rs * vg[1]); o.y = cvt_pk_bf16(f[2] * rs * vg[2], f[3] * rs * vg[3]); o.z = cvt_pk_bf16(f[4] * rs * vg[4], f[5] * rs * vg[5]); o.w = cvt_pk_bf16(f[6] * rs * vg[6], f[7] * rs * vg[7]);
            *(GAS u32x4*)((bf16*)(ws + WS_VN) + (size_t)t * 512 + 8 * F.lane) = o;
        }
        {
            const int w = 2 << (F.lane >> 4);
            const u32x4 a = *(const GAS u32x4*)(zr + 1024 + 8 * F.lane);
            float p[8]; p[0] = bf_lo(a.x); p[1] = bf_hi(a.x); p[2] = bf_lo(a.y); p[3] = bf_hi(a.y); p[4] = bf_lo(a.z); p[5] = bf_hi(a.z); p[6] = bf_lo(a.w); p[7] = bf_hi(a.w);
            float s[8];
#pragma unroll
            for (int i = 0; i < 8; ++i) s[i] = p[i];
            for (int j = 1; j < 16; ++j) { if (j < w && t - j >= 0) { const u32x4 b = *(const GAS u32x4*)(zr - (size_t)j * NZ + 1024 + 8 * F.lane);
                s[0] += bf_lo(b.x); s[1] += bf_hi(b.x); s[2] += bf_lo(b.y); s[3] += bf_hi(b.y); s[4] += bf_lo(b.z); s[5] += bf_hi(b.z); s[6] += bf_lo(b.w); s[7] += bf_hi(b.w); } }
            const float ic = 1.f / (float)((t + 1 < w) ? (t + 1) : w);
            u32x4 o; o.x = cvt_pk_bf16(s[0] * ic - p[0], s[1] * ic - p[1]); o.y = cvt_pk_bf16(s[2] * ic - p[2], s[3] * ic - p[3]); o.z = cvt_pk_bf16(s[4] * ic - p[4], s[5] * ic - p[5]); o.w = cvt_pk_bf16(s[6] * ic - p[6], s[7] * ic - p[7]);
            *(GAS u32x4*)((bf16*)(ws + WS_DP) + (size_t)t * 512 + 8 * F.lane) = o;
        }
        if (F.lane < 8) *(GAS float*)((float*)(ws + WS_FKL) + (size_t)F.lane * SEQ + t) = (pre[F.lane * 256 + (t >> 5)] + *(const GAS float*)((const float*)(ws + WS_FLOC) + (size_t)t * 8 + F.lane)) * -11.313708498984761f;
    }
}

__device__ __forceinline__ void phase_small_item(const Frame& F0, int l, int item) {
    unsigned char* const ws = opq(F0.ws); Frame F = F0; F.tid = opq_tid(); F.lane = F.tid & 63;
    const int fr = F.lane & 15, fq = F.lane >> 4, w = F.wave;
    const bf16* Z = (const bf16*)(ws + WS_Z); bf16* YC = (bf16*)(ws + WS_YCAT);
    f32x4 acc[8];
#pragma unroll
    for (int m = 0; m < 8; ++m) acc[m] = (f32x4){0.f, 0.f, 0.f, 0.f};
    const float* a_bs_ = opq(karg(8)); const float* b_scale_ = opq(karg(11));
    if (item < 256) {
        const int blk = item >> 2, h = item & 3;
        const bf16* VN = (const bf16*)(ws + WS_VN) + (size_t)(blk * 128) * 512 + h * 128 + 16 * w + fr;
        const bf16* WM = (const bf16*)(ws + WS_WM) + ((size_t)(l * 4 + h) * 128) * 128;
        bf16x8 yb[4];
#pragma unroll
        for (int ks = 0; ks < 4; ++ks)
#pragma unroll
            for (int j = 0; j < 8; ++j) yb[ks][j] = (short)*(const GAS bf16*)(VN + (size_t)(ks * 32 + 8 * fq + j) * 512);
#pragma unroll
        for (int m = 0; m < 8; ++m)
#pragma unroll
            for (int ks = 0; ks < 4; ++ks) { const bf16x8 xa = *(const GAS bf16x8*)(WM + (size_t)(16 * m + fr) * 128 + ks * 32 + 8 * fq);
                acc[m] = __builtin_amdgcn_mfma_f32_16x16x32_bf16(yb[ks], xa, acc[m], 0, 0, 0); }
#pragma unroll
        for (int m = 0; m < 8; ++m) { const int tl = 16 * m + fr, t = blk * 128 + tl, col = h * 128 + 16 * w + 4 * fq;
            const float bsv = *(const GAS float*)(a_bs_ + l * 512 + h * 128 + tl);
            const u32x2 u = *(const GAS u32x2*)(Z + (size_t)t * NZ + col);
            u32x2 o; o.x = cvt_pk_bf16(bf_lo(u.x) * (acc[m][0] + bsv), bf_hi(u.x) * (acc[m][1] + bsv)); o.y = cvt_pk_bf16(bf_lo(u.y) * (acc[m][2] + bsv), bf_hi(u.y) * (acc[m][3] + bsv));
            *(GAS u32x2*)(YC + (size_t)t * DM + col) = o; }
    } else {
        const int rb = (item - 256) >> 2, g = (item - 256) & 3;
        const bf16* DP = (const bf16*)(ws + WS_DP) + (size_t)(rb * 128) * 512 + g * 128;
        const bf16* BWT = (const bf16*)(ws + WS_BWT) + ((size_t)(l * 4 + g) * 128) * 128;
        bf16x8 yb[4];
#pragma unroll
        for (int ks = 0; ks < 4; ++ks) yb[ks] = *(const GAS bf16x8*)(BWT + (size_t)(16 * w + fr) * 128 + ks * 32 + 8 * fq);
#pragma unroll
        for (int m = 0; m < 8; ++m)
#pragma unroll
            for (int ks = 0; ks < 4; ++ks) { const bf16x8 xa = *(const GAS bf16x8*)(DP + (size_t)(16 * m + fr) * 512 + ks * 32 + 8 * fq);
                acc[m] = __builtin_amdgcn_mfma_f32_16x16x32_bf16(yb[ks], xa, acc[m], 0, 0, 0); }
        const f32x4 bsc = *(const GAS f32x4*)(b_scale_ + l * 512 + g * 128 + 16 * w + 4 * fq);
#pragma unroll
        for (int m = 0; m < 8; ++m) { const int t = rb * 128 + 16 * m + fr, col = 512 + g * 128 + 16 * w + 4 * fq;
            u32x2 o; o.x = cvt_pk_bf16(acc[m][0] * bsc.x, acc[m][1] * bsc.y); o.y = cvt_pk_bf16(acc[m][2] * bsc.z, acc[m][3] * bsc.w);
            *(GAS u32x2*)(YC + (size_t)t * DM + col) = o; }
    }
}

__device__ __forceinline__ void phase_norm2_route(const Frame& F0, int l) {
    unsigned char* const ws = opq(F0.ws); Frame F = F0; F.tid = opq_tid(); F.lane = F.tid & 63;
    LAS float* wrT = (LAS float*)F.lds;
    LAS float* gaL = (LAS float*)(F.lds + AUX_OFF);
    LAS float* gbL = (LAS float*)(F.lds + AUX_OFF + 8192);
    LAS int* lcnt = (LAS int*)(F.lds + AUX_OFF + 16384);
    for (int i = F.tid; i < DM * 4; i += NTHR) { const int d = i >> 2, q = i & 3;
        const f32x4 w = *(const GAS f32x4*)(karg(16) + (size_t)d * 16 + q * 4);
        wrT[(q * 4 + 0) * DM + d] = w.x; wrT[(q * 4 + 1) * DM + d] = w.y; wrT[(q * 4 + 2) * DM + d] = w.z; wrT[(q * 4 + 3) * DM + d] = w.w; }
    for (int d = F.tid; d < DM; d += NTHR) { gaL[d] = *(const GAS float*)(karg(5) + (size_t)l * DM + d) * (1.f + mod_at(ws, karg(3), l, 4 * DM + d)); gbL[d] = mod_at(ws, karg(3), l, 3 * DM + d); }
    const float* X1 = (const float*)(ws + WS_X1);
    for (int c = F.vcu; c < SEQ / 32; c += F.G) {
        if (F.tid < 32) lcnt[F.tid] = 0;
        __syncthreads();
        int my_e0 = 0, my_e1 = 0, my_r0 = 0, my_r1 = 0; float my_w0 = 0.f, my_w1 = 0.f;
        for (int rr = 0; rr < 4; ++rr) {
            const int t = c * 32 + F.wave * 4 + rr;
            f32x4 v[8]; float ss = 0.f;
#pragma unroll
            for (int j = 0; j < 8; ++j) { v[j] = *(const GAS f32x4*)(X1 + (size_t)t * DM + 256 * j + 4 * F.lane); ss += (v[j].x * v[j].x + v[j].y * v[j].y) + (v[j].z * v[j].z + v[j].w * v[j].w); }
            const float rs = rsqrtf(wave_sum(ss) * (1.f / DM) + EPSN);
            float lg[16];
#pragma unroll
            for (int e = 0; e < 16; ++e) lg[e] = 0.f;
            bf16* hrow = (bf16*)(ws + WS_H) + (size_t)t * DM;
#pragma unroll 2
            for (int j = 0; j < 8; ++j) { const int d = 256 * j + 4 * F.lane;
                const f32x4 h = v[j] * rs * *(const LAS f32x4*)(gaL + d) + *(const LAS f32x4*)(gbL + d);
                u32x2 o; o.x = cvt_pk_bf16(h.x, h.y); o.y = cvt_pk_bf16(h.z, h.w);
                *(GAS u32x2*)(hrow + d) = o;
#pragma unroll
                for (int e = 0; e < 16; ++e) { const f32x4 w = *(const LAS f32x4*)(wrT + e * DM + d); lg[e] += (h.x * w.x + h.y * w.y) + (h.z * w.z + h.w * w.w); } }
#pragma unroll
            for (int e = 0; e < 16; ++e) lg[e] = wave_sum(lg[e]);
            float sc[16], sel[16];
#pragma unroll
            for (int e = 0; e < 16; ++e) { sc[e] = 1.f / (1.f + __expf(-lg[e])); sel[e] = sc[e] + *(const GAS float*)(karg(17) + e); }
            int bg = 0; float bgs = -INFINITY;
#pragma unroll
            for (int g = 0; g < 4; ++g) { float a = -INFINITY, b = -INFINITY;
#pragma unroll
                for (int i = 0; i < 4; ++i) { const float x = sel[g * 4 + i]; if (x > a) { b = a; a = x; } else if (x > b) b = x; }
                if (a + b > bgs) { bgs = a + b; bg = g; } }
            int e0 = 0, e1 = 0; float a = -INFINITY, b = -INFINITY, s0 = 0.f, s1 = 0.f;
#pragma unroll
            for (int g = 0; g < 4; ++g)
#pragma unroll
                for (int i = 0; i < 4; ++i) { const int e = g * 4 + i; const float x = sel[e];
                    if (g == bg) { if (x > a) { b = a; e1 = e0; s1 = s0; a = x; e0 = e; s0 = sc[e]; } else if (x > b) { b = x; e1 = e; s1 = sc[e]; } } }
            const float inv = 1.f / (s0 + s1);
            if (F.lane == rr) { my_e0 = e0; my_e1 = e1; my_w0 = s0 * inv; my_w1 = s1 * inv; }
        }
        if (F.lane < 4) { my_r0 = __hip_atomic_fetch_add(&lcnt[my_e0], 1, __ATOMIC_RELAXED, __HIP_MEMORY_SCOPE_WORKGROUP); my_r1 = __hip_atomic_fetch_add(&lcnt[my_e1], 1, __ATOMIC_RELAXED, __HIP_MEMORY_SCOPE_WORKGROUP); }
        __syncthreads();
        if (F.tid < 16) lcnt[16 + F.tid] = (int)__hip_atomic_fetch_add(F.ctl + CW_CNT + 64 * l + F.tid, (unsigned)lcnt[F.tid], RLX_AGENT);
        __syncthreads();
        if (F.lane < 4) { const int t = c * 32 + F.wave * 4 + F.lane;
            const int p0 = lcnt[16 + my_e0] + my_r0, p1 = lcnt[16 + my_e1] + my_r1;
            int* list = (int*)(ws + WS_LIST);
            *(GAS int*)(list + my_e0 * SEQ + p0) = t; *(GAS int*)(list + my_e1 * SEQ + p1) = t;
            *(GAS int*)((int*)(ws + WS_TOKE) + 2 * t) = my_e0; *(GAS int*)((int*)(ws + WS_TOKE) + 2 * t + 1) = my_e1;
            *(GAS int*)((int*)(ws + WS_TOKP) + 2 * t) = p0; *(GAS int*)((int*)(ws + WS_TOKP) + 2 * t + 1) = p1;
            *(GAS float*)((float*)(ws + WS_TOKW) + 2 * t) = my_w0; *(GAS float*)((float*)(ws + WS_TOKW) + 2 * t + 1) = my_w1; }
        __syncthreads();
    }
}

struct MoeOrder {
    int G, c, total, K, nct; const char* Bt; size_t estride; const int* list; LAS int* tab;
    __device__ __forceinline__ bool next(int i, gm::Unit& u) const {
        const int L = i * G + c; if (L >= total) return false;
        const int q = L / nct, ct = L - q * nct;
        int e = 0;
#pragma unroll
        for (int k = 1; k < NEXP; ++k) e += (q >= tab[k]) ? 1 : 0;
        e = __builtin_amdgcn_readfirstlane(e);
        const int rt = q - __builtin_amdgcn_readfirstlane(tab[e]);
        u.e = e; u.rt = rt; u.arow = (__builtin_amdgcn_readfirstlane(tab[e]) + rt) * 256; u.orow = u.arow; u.ocol = ct * 256;
        u.Bp = Bt + (size_t)e * estride + (size_t)ct * 256 * K * 2; return true;
    }
    __device__ __forceinline__ int row_of(const gm::Unit& u, int r) const {
        const int p = u.rt * 256 + r, n = tab[32 + u.e], pc = p < n ? p : n - 1;
        const int v = *(const GAS int*)(list + u.e * SEQ + pc);
        return (p < n) ? v : 0;
    }
};
__device__ __forceinline__ void moe_table(Frame& F, int l, LAS int* tab) {
    __syncthreads();
    if (F.tid == 0) { int a = 0;
        for (int e = 0; e < NEXP; ++e) { const int n = (int)__hip_atomic_load(F.ctl + CW_CNT + 64 * l + e, RLX_AGENT); tab[e] = a; tab[32 + e] = n; a += (n + 255) >> 8; }
        tab[16] = a; }
    __syncthreads();
}

constexpr int ATT_CH = 16;
struct MixTab { LAS int* jlo; LAS int* items; LAS int* nitems; LAS float* fend; LAS int* scan; };
__device__ __forceinline__ MixTab mix_tab_ptrs(LAS unsigned char* lds) {
    MixTab T; T.jlo = (LAS int*)(lds + 69632); T.items = (LAS int*)(lds + 69632 + 1024); T.nitems = (LAS int*)(lds + 69632 + 1024 + 8192); T.fend = (LAS float*)(lds + 69632 + 1024 + 8192 + 64);
    T.scan = (LAS int*)(lds + 69632 + 1024 + 8192 + 64 + 4096); return T;
}
__device__ __forceinline__ void mix_build_table(const Frame& F0, int l, const MixTab& T) {
    unsigned char* const ws = opq(F0.ws); const int tid = opq_tid();
    const float* FKL = (const float*)(ws + WS_FKL);
    for (int i = tid; i < 1024; i += NTHR) T.fend[i] = *(const GAS float*)(FKL + (size_t)(i >> 7) * SEQ + (i & 127) * 64 + 63);
    float gq = 0.f, gk = 0.f;
    for (int i = 0; i < 128; ++i) { gq = fmaxf(gq, fabsf(*(const GAS float*)(karg(12) + l * 128 + i))); gk = fmaxf(gk, fabsf(*(const GAS float*)(karg(13) + l * 128 + i))); }
    const float thr = (2.f * 1.01f * 11.313708498984761f * gq * gk + 30.f) * 11.313708498984761f;
    __syncthreads();
    int nfull = 0, nrem = 0, jl = 0, nt = 0;
    if (tid < 256) { const int h = tid >> 5, qb = tid & 31; const float f0 = *(const GAS float*)(FKL + (size_t)h * SEQ + qb * 256);
        for (int j = 0; j < 4 * qb; ++j) jl += (T.fend[h * 128 + j] - f0 <= -thr) ? 1 : 0;
        nt = 4 * (qb + 1) - jl; nfull = nt / ATT_CH; nrem = (nt % ATT_CH) ? 1 : 0; T.jlo[tid] = jl | ((nfull + nrem) << 8); }
    if (tid < 256) { T.scan[tid] = nfull; T.scan[256 + tid] = nrem; }
    __syncthreads();
    for (int o = 1; o < 256; o <<= 1) { int a = 0, b = 0; if (tid < 256 && tid >= o) { a = T.scan[tid - o]; b = T.scan[256 + tid - o]; } __syncthreads();
        if (tid < 256) { T.scan[tid] += a; T.scan[256 + tid] += b; } __syncthreads(); }
    if (tid < 256) { const int totf = T.scan[255], pf = T.scan[tid] - nfull, pr = totf + T.scan[256 + tid] - nrem, jb = 4 * ((tid & 31) + 1);
        for (int c = 0; c < nfull; ++c) T.items[pf + c] = tid | (c << 8) | ((jb - (c + 1) * ATT_CH) << 12) | (ATT_CH << 20);
        if (nrem) T.items[pr] = tid | (nfull << 8) | (jl << 12) | ((nt - nfull * ATT_CH) << 20);
        if (tid == 255) T.nitems[0] = totf + T.scan[511]; }
    __syncthreads();
}
__device__ __forceinline__ void phase_attn_combine(const Frame& F0, int l, const MixTab& T) {
    unsigned char* const ws = opq(F0.ws); const int tid = opq_tid();
    const bf16* PART = (const bf16*)(ws + WS_PART); const float* MLb = (const float*)(ws + WS_ML); bf16* YC = (bf16*)(ws + WS_YCAT);
    for (int b = F0.vcu; b < 256; b += F0.G) {
        const int nch = __builtin_amdgcn_readfirstlane(T.jlo[b]) >> 8; if (nch <= 1) continue;
        const int h = b >> 5, qb = b & 31, row = tid >> 1, half = tid & 1;
        float m[8], w[8], mx = -3.0e38f, ws_ = 0.f;
#pragma unroll
        for (int c = 0; c < 8; ++c) { if (c < nch) { const f32x2 v = *(const GAS f32x2*)(MLb + ((size_t)(b * 8 + c) * 256 + row) * 2); m[c] = v.x; w[c] = v.y; mx = fmaxf(mx, v.x); } else { m[c] = -3.0e38f; w[c] = 0.f; } }
#pragma unroll
        for (int c = 0; c < 8; ++c) { w[c] = (c < nch) ? w[c] * __builtin_amdgcn_exp2f((m[c] - mx) * at::C2) : 0.f; ws_ += w[c]; }
        const float inv = 1.f / ws_;
        float acc[64];
#pragma unroll
        for (int i = 0; i < 64; ++i) acc[i] = 0.f;
#pragma unroll
        for (int c = 0; c < 8; ++c) { if (c < nch) { const bf16* p = PART + ((size_t)(b * 8 + c) * 256 + row) * 128 + half * 64; const float wc = w[c] * inv;
#pragma unroll
            for (int q = 0; q < 8; ++q) { const u32x4 v = *(const GAS u32x4*)(p + q * 8);
                acc[q * 8 + 0] += wc * bf_lo(v.x); acc[q * 8 + 1] += wc * bf_hi(v.x); acc[q * 8 + 2] += wc * bf_lo(v.y); acc[q * 8 + 3] += wc * bf_hi(v.y);
                acc[q * 8 + 4] += wc * bf_lo(v.z); acc[q * 8 + 5] += wc * bf_hi(v.z); acc[q * 8 + 6] += wc * bf_lo(v.w); acc[q * 8 + 7] += wc * bf_hi(v.w); } } }
        bf16* o = YC + (size_t)(qb * 256 + row) * DM + 1024 + h * 128 + half * 64;
#pragma unroll
        for (int q = 0; q < 8; ++q) { u32x4 v; v.x = cvt_pk_bf16(acc[q * 8 + 0], acc[q * 8 + 1]); v.y = cvt_pk_bf16(acc[q * 8 + 2], acc[q * 8 + 3]); v.z = cvt_pk_bf16(acc[q * 8 + 4], acc[q * 8 + 5]); v.w = cvt_pk_bf16(acc[q * 8 + 6], acc[q * 8 + 7]);
            *(GAS u32x4*)(o + q * 8) = v; }
    }
}
struct EpiZ {
    static constexpr bool PERM = true;
    bf16* O;
    __device__ __forceinline__ void operator()(const f32x4 (&acc)[2][2][4][2], const gm::Unit& u, int wr, int wc, int fr, int fq) const {
        const int row0 = u.orow + wr * 64 + fr, col0 = u.ocol + wc * 32 + 8 * fq; const bool act = u.ocol < 1024;
#pragma unroll
        for (int ai = 0; ai < 2; ++ai)
#pragma unroll
            for (int m = 0; m < 4; ++m) { bf16* rowp = O + (size_t)(row0 + ai * 128 + m * 16) * NZ + col0;
#pragma unroll
                for (int bj = 0; bj < 2; ++bj) { f32x4 v0 = acc[ai][bj][m][0], v1 = acc[ai][bj][m][1];
                    if (act) {
#pragma unroll
                        for (int j = 0; j < 4; ++j) { v0[j] = gelu_t(v0[j]); v1[j] = gelu_t(v1[j]); } }
                    u32x4 w; w.x = cvt_pk_bf16(v0[0], v0[1]); w.y = cvt_pk_bf16(v0[2], v0[3]); w.z = cvt_pk_bf16(v1[0], v1[1]); w.w = cvt_pk_bf16(v1[2], v1[3]);
                    *(GAS u32x4*)(rowp + bj * 128) = w; } }
    }
};
struct EpiRes {
    static constexpr bool PERM = false;
    const float* xin; const LAS float* gate; float* out;
    __device__ __forceinline__ void operator()(const f32x4 (&acc)[2][2][4][2], const gm::Unit& u, int wr, int wc, int fr, int fq) const {
        const int row0 = u.orow + wr * 64 + fr, col0 = u.ocol + wc * 32 + 4 * fq;
        f32x4 gv[2][2];
#pragma unroll
        for (int bj = 0; bj < 2; ++bj)
#pragma unroll
            for (int n = 0; n < 2; ++n) gv[bj][n] = *(const LAS f32x4*)(gate + col0 + bj * 128 + n * 16);
#pragma unroll
        for (int ai = 0; ai < 2; ++ai)
#pragma unroll
            for (int m = 0; m < 4; ++m) { const size_t off = (size_t)(row0 + ai * 128 + m * 16) * DM + col0;
#pragma unroll
                for (int bj = 0; bj < 2; ++bj)
#pragma unroll
                    for (int n = 0; n < 2; ++n) { const f32x4 xv = *(const GAS f32x4*)(xin + off + bj * 128 + n * 16);
                        *(GAS f32x4*)(out + off + bj * 128 + n * 16) = xv + gv[bj][n] * acc[ai][bj][m][n]; } }
    }
};
struct EpiHid {
    static constexpr bool PERM = true;
    bf16* O;
    __device__ __forceinline__ void operator()(const f32x4 (&acc)[2][2][4][2], const gm::Unit& u, int wr, int wc, int fr, int fq) const {
        const int row0 = u.orow + wr * 64 + fr, col0 = (u.ocol >> 1) + wc * 32 + 8 * fq;
#pragma unroll
        for (int ai = 0; ai < 2; ++ai)
#pragma unroll
            for (int m = 0; m < 4; ++m) { bf16* rowp = O + (size_t)(row0 + ai * 128 + m * 16) * DEX + col0;
                f32x4 h0, h1;
#pragma unroll
                for (int j = 0; j < 4; ++j) { h0[j] = silu_f(acc[ai][0][m][0][j]) * acc[ai][1][m][0][j]; h1[j] = silu_f(acc[ai][0][m][1][j]) * acc[ai][1][m][1][j]; }
                u32x4 w; w.x = cvt_pk_bf16(h0[0], h0[1]); w.y = cvt_pk_bf16(h0[2], h0[3]); w.z = cvt_pk_bf16(h1[0], h1[1]); w.w = cvt_pk_bf16(h1[2], h1[3]);
                *(GAS u32x4*)rowp = w; }
    }
};
struct EpiYB {
    static constexpr bool PERM = true;
    bf16* O;
    __device__ __forceinline__ void operator()(const f32x4 (&acc)[2][2][4][2], const gm::Unit& u, int wr, int wc, int fr, int fq) const {
        const int row0 = u.orow + wr * 64 + fr, col0 = u.ocol + wc * 32 + 8 * fq;
#pragma unroll
        for (int ai = 0; ai < 2; ++ai)
#pragma unroll
            for (int m = 0; m < 4; ++m) { bf16* rowp = O + (size_t)(row0 + ai * 128 + m * 16) * DM + col0;
#pragma unroll
                for (int bj = 0; bj < 2; ++bj) { const f32x4 v0 = acc[ai][bj][m][0], v1 = acc[ai][bj][m][1];
                    u32x4 w; w.x = cvt_pk_bf16(v0[0], v0[1]); w.y = cvt_pk_bf16(v0[2], v0[3]); w.z = cvt_pk_bf16(v1[0], v1[1]); w.w = cvt_pk_bf16(v1[2], v1[3]);
                    *(GAS u32x4*)(rowp + bj * 128) = w; } }
    }
};

__device__ __forceinline__ int bg_need(int p) {
    if (p <= 1) return 0;
    if (p <= 5) return BG_C0;
    if (p <= 7) return BG_C1;
    if (p == 8) return BG_C2;
    if (p == 9) return BG_C3;
    if (p == 10) return BG_C3B;
    if (p <= 14) return BG_C4;
    if (p <= 16) return BG_C5;
    if (p == 17) return BG_C6;
    return BG_C7;
}
__device__ __forceinline__ bool bg_seam(int k) { if (k == 0) return true; const int j = (k - 1) % 9; return j != 2 && j != 5; }
struct Args { const float* in[21]; float* out; unsigned char* ws; int ph_lo, ph_hi; };
constexpr int N_PHASES = 1 + 9 * NLAYER + 1;

__global__ void __launch_bounds__(NTHR, 2) mk_fwd(Args args) {
    extern __shared__ __attribute__((aligned(16))) unsigned char lds[];
    Frame F;
    F.lds = (LAS unsigned char*)lds; F.MISC = (volatile LAS unsigned*)(F.lds + MISC_OFF);
    F.tid = threadIdx.x; F.lane = F.tid & 63; F.wave = __builtin_amdgcn_readfirstlane(F.tid >> 6);
    F.G = gridDim.x; { const int bx = blockIdx.x; F.vcu = (F.G % 8 == 0) ? (bx % 8) * (F.G / 8) + bx / 8 : bx; }
    F.ws = args.ws; F.ctl = (gu32*)(args.ws + WS_CTL);
    for (int u = F.tid; u < (LDS_BYTES - RING_BYTES) / 4; u += NTHR) ((LAS unsigned*)(F.lds + RING_BYTES))[u] = 0u;
    __syncthreads();
    const int lo = args.ph_lo, hi = args.ph_hi;
    const bool multi = (hi - lo) > 1;
    XcdBarrier bar; bar.bar = (unsigned*)(F.ctl + CW_BAR); bar.x = 0; bar.st = nullptr;
    if (multi) bar = xcd_barrier_post((unsigned*)(F.ctl + CW_BAR), F.MISC + 8);
#ifdef MK_ONLY
#define IN(k) (((k) == 0 ? 0 : (((k) - 1) % 9) + 1) == MK_ONLY && lo <= (k) && (k) < hi)
#else
#define IN(k) (lo <= (k) && (k) < hi)
#endif
#ifndef MK_REPEAT
#define MK_REPEAT -1
#endif
#define REPS(kind) ((MK_REPEAT == (kind)) ? 2 : 1)
#define SEAM(k) do { if (IN(k)) { if (bg_seam(k)) bg_fill(F, (k), bg_need((k) + 1)); if (IN((k) + 1)) xcd_barrier(bar); } } while (0)

    for (int rep_ = 0; rep_ < REPS(0); ++rep_) if (IN(0)) { if (rep_) xcd_barrier(bar); p0_prologue(F); } SEAM(0);

    for (int l = 0; l < NLAYER; ++l) {
        const int pb = 1 + 9 * l;

        for (int rep_ = 0; rep_ < REPS(1); ++rep_) if (IN(pb)) { if (rep_) xcd_barrier(bar); unsigned char* const wsl = opq(F.ws); if (l == 0) phase_norm1<0>(F, l, karg(0), nullptr, 0); else phase_norm1<1>(F, l, (const float*)(wsl + WS_X1), (float*)(wsl + WS_X2), l - 1); }
        SEAM(pb);
        for (int rep_ = 0; rep_ < REPS(2); ++rep_) if (IN(pb + 1)) { if (rep_) xcd_barrier(bar); unsigned char* const wsl = opq(F.ws); gm::RegOrder S; S.init(SEQ, NZ, DM, wsl + WS_WIN + (size_t)l * NZ * DM * 2, F.G, (int)blockIdx.x);
            EpiZ E{(bf16*)(wsl + WS_Z)};
            gm::gemm_phase<EpiZ, gm::RegOrder, false, true>(F.lds, (const char*)(wsl + WS_H), DM, S, E); }
        SEAM(pb + 1);
        for (int rep_ = 0; rep_ < REPS(3); ++rep_) if (IN(pb + 2)) { if (rep_) xcd_barrier(bar); unsigned char* const wsl = opq(F.ws); phase_prep(F, l); }
        SEAM(pb + 2);
        for (int rep_ = 0; rep_ < REPS(4); ++rep_) if (IN(pb + 3)) { if (rep_) xcd_barrier(bar); unsigned char* const wsl = opq(F.ws);
            const MixTab T = mix_tab_ptrs(F.lds);
            mix_build_table(F, l, T);
            const int natt = __builtin_amdgcn_readfirstlane(T.nitems[0]), ntot = natt + 512;
            LAS int* qslot = T.nitems + 1;
            int it = F.vcu;
            while (it < ntot) {
                if (it >= natt) { phase_small_item(F, l, it - natt); }
                else {
                    const int rec = __builtin_amdgcn_readfirstlane(T.items[it]), b = rec & 255, c = (rec >> 8) & 15, ja = (rec >> 12) & 255, n = (rec >> 20) & 31, h = b >> 5, qb = b & 31;
                    const bool fin = (__builtin_amdgcn_readfirstlane(T.jlo[b]) >> 8) <= 1; unsigned char* const ws = opq(wsl);
                    at::BlockRef cur;
                    cur.Q = (const bf16*)(ws + WS_QN) + ((size_t)h * SEQ + qb * 256) * 128; cur.K = (const bf16*)(ws + WS_KN) + (size_t)h * SEQ * 128;
                    cur.V = (const bf16*)(ws + WS_Z) + 3584 + h * 128; cur.O = (bf16*)(ws + WS_YCAT) + (size_t)(qb * 256) * DM + 1024 + h * 128;
                    cur.FK = (const float*)(ws + WS_FKL) + (size_t)h * SEQ; cur.P0 = qb * 256;
                    at::attn_block(cur, ja, n, fin, (bf16*)(ws + WS_PART) + (size_t)(b * 8 + c) * 256 * 128, (float*)(ws + WS_ML) + (size_t)(b * 8 + c) * 256 * 2, (char*)lds, F.lds);
                }
                if (F.tid == 0) qslot[0] = F.G + (int)__hip_atomic_fetch_add(F.ctl + CW_Q + 64 * l + 32 * rep_, 1u, RLX_AGENT);
                __syncthreads();
                it = __builtin_amdgcn_readfirstlane(qslot[0]);
                __syncthreads();
            }
        }
        SEAM(pb + 3);
        for (int rep_ = 0; rep_ < REPS(5); ++rep_) if (IN(pb + 4)) { if (rep_) xcd_barrier(bar); unsigned char* const wsl = opq(F.ws); const MixTab T = mix_tab_ptrs(F.lds); mix_build_table(F, l, T); phase_attn_combine(F, l, T); }
        SEAM(pb + 4);
        for (int rep_ = 0; rep_ < REPS(6); ++rep_) if (IN(pb + 5)) { if (rep_) xcd_barrier(bar); unsigned char* const wsl = opq(F.ws); gm::RegOrder S; S.init(SEQ, DM, DM, wsl + WS_WOUT + (size_t)l * DM * DM * 2, F.G, (int)blockIdx.x);
            LAS float* g1L = (LAS float*)(F.lds + AUX_OFF);
            for (int d = F.tid; d < DM; d += NTHR) g1L[d] = mod_at(wsl, karg(3), l, 2 * DM + d);
            __syncthreads();
            EpiRes E{(l == 0) ? karg(0) : (const float*)(wsl + WS_X2), g1L, (float*)(wsl + WS_X1)};
            gm::gemm_phase<EpiRes, gm::RegOrder, false, true>(F.lds, (const char*)(wsl + WS_YCAT), DM, S, E); }
        SEAM(pb + 5);
        for (int rep_ = 0; rep_ < REPS(7); ++rep_) if (IN(pb + 6)) { if (rep_) xcd_barrier(bar); unsigned char* const wsl = opq(F.ws); phase_norm2_route(F, l); }
        SEAM(pb + 6);
        for (int rep_ = 0; rep_ < REPS(8); ++rep_) if (IN(pb + 7)) { if (rep_) xcd_barrier(bar); unsigned char* const wsl = opq(F.ws); LAS int* tab = (LAS int*)(F.lds + AUX_OFF + 20480); moe_table(F, l, tab);
            MoeOrder S; S.G = F.G; S.c = F.vcu; S.total = 8 * tab[16]; S.K = DM; S.nct = 8; S.Bt = (const char*)(wsl + WS_WGU) + (size_t)l * NEXP * DM * DM * 2; S.estride = (size_t)DM * DM * 2;
            S.list = (const int*)(wsl + WS_LIST); S.tab = tab;
            EpiHid E{(bf16*)(wsl + WS_HID)};
            gm::gemm_phase<EpiHid, MoeOrder, true, true>(F.lds, (const char*)(wsl + WS_H), DM, S, E); }
        SEAM(pb + 7);
        for (int rep_ = 0; rep_ < REPS(9); ++rep_) if (IN(pb + 8)) { if (rep_) xcd_barrier(bar); unsigned char* const wsl = opq(F.ws); LAS int* tab = (LAS int*)(F.lds + AUX_OFF + 20480); moe_table(F, l, tab);
            MoeOrder S; S.G = F.G; S.c = F.vcu; S.total = 8 * tab[16]; S.K = DEX; S.nct = 8; S.Bt = (const char*)(wsl + WS_WD) + (size_t)l * NEXP * DM * DEX * 2; S.estride = (size_t)DM * DEX * 2;
            S.list = (const int*)(wsl + WS_LIST); S.tab = tab;
            EpiYB E{(bf16*)(wsl + WS_YB)};
            gm::gemm_phase<EpiYB, MoeOrder, false, true>(F.lds, (const char*)(wsl + WS_HID), DEX, S, E); }
        SEAM(pb + 8);
    }
    for (int rep_ = 0; rep_ < REPS(10); ++rep_) if (IN(N_PHASES - 1)) { if (rep_) xcd_barrier(bar); phase_norm1<2>(F, NLAYER - 1, (const float*)(F.ws + WS_X1), (float*)karg(21), NLAYER - 1); }
#undef IN
#undef SEAM
}

#ifndef MK_LAUNCHES
#define MK_LAUNCHES 1
#endif
extern "C" void kernel_launch(void* const* d_in, const int* in_sizes, int n_in, void* d_out, int out_size, void* d_ws, size_t ws_size, hipStream_t stream) {
    static int grid = 0;
    if (grid == 0) {
        int dev = 0, cus = 0, per_cu = 0;
        if (n_in != 21 || ws_size < WS_END) { fprintf(stderr, "kernel_launch: unexpected inputs (n_in %d, ws %zu)\n", n_in, ws_size); grid = -1; return; }
        if (hipGetDevice(&dev) != hipSuccess || hipDeviceGetAttribute(&cus, hipDeviceAttributeMultiprocessorCount, dev) != hipSuccess) { grid = -1; return; }
        if (hipFuncSetAttribute((const void*)mk_fwd, hipFuncAttributeMaxDynamicSharedMemorySize, LDS_BYTES) != hipSuccess) { fprintf(stderr, "kernel_launch: hipFuncSetAttribute failed\n"); grid = -1; return; }
        if (hipOccupancyMaxActiveBlocksPerMultiprocessor(&per_cu, (const void*)mk_fwd, NTHR, LDS_BYTES) != hipSuccess || per_cu < 1) fprintf(stderr, "kernel_launch: occupancy query says %d\n", per_cu);
        (void)hipGetLastError();
        grid = cus;
    }
    if (grid < 0) return;
    (void)hipMemsetAsync((char*)d_ws + WS_CTL, 0, CTL_ZERO_BYTES, stream);
    Args a{};
    for (int i = 0; i < 21; ++i) a.in[i] = (const float*)d_in[i];
    a.out = (float*)d_out; a.ws = (unsigned char*)d_ws;
#if MK_LAUNCHES == 1
    a.ph_lo = 0; a.ph_hi = N_PHASES;
    hipLaunchKernelGGL(mk_fwd, dim3(grid), dim3(NTHR), LDS_BYTES, stream, a);
#else
    for (int p = 0; p < N_PHASES; ++p) { a.ph_lo = p; a.ph_hi = p + 1; hipLaunchKernelGGL(mk_fwd, dim3(grid), dim3(NTHR), LDS_BYTES, stream, a); }
#endif
}
```

```cpp
#include <hip/hip_runtime.h>
#include <stdint.h>
#include <stdio.h>

#define GAS __attribute__((address_space(1)))
#define LAS __attribute__((address_space(3)))
typedef unsigned short bf16;
typedef short bf16x8 __attribute__((ext_vector_type(8)));
typedef short s16x4 __attribute__((ext_vector_type(4)));
typedef float f32x2 __attribute__((ext_vector_type(2)));
typedef float f32x4 __attribute__((ext_vector_type(4)));
typedef float f32x16 __attribute__((ext_vector_type(16)));
typedef unsigned u32x2 __attribute__((ext_vector_type(2)));
typedef unsigned u32x4 __attribute__((ext_vector_type(4)));
typedef GAS unsigned gu32;
#define RLX_AGENT __ATOMIC_RELAXED, __HIP_MEMORY_SCOPE_AGENT
#define LDS_WAIT() asm volatile("s_waitcnt lgkmcnt(0)" ::: "memory")
#define VM_WAIT() asm volatile("s_waitcnt vmcnt(0)" ::: "memory")

constexpr int DM = 2048, SEQ = 8192, NIN = 4616, NZ = 4608, DEX = 1024, NEXP = 16, NLAYER = 2;
constexpr float EPSN = 1e-6f;
constexpr float LOG2E = 1.4426950408889634f;
constexpr int NWAVES = 8, NTHR = 512;
constexpr int HIDROWS = 2 * SEQ + NEXP * 256;

constexpr size_t KiB = 1024, MiB = 1u << 20;
constexpr size_t WS_CTL = 0, CTL_ZERO_BYTES = 1 * MiB;
constexpr size_t WS_MOD = 1 * MiB;
constexpr size_t WS_FLOC = WS_MOD + 128 * KiB;
constexpr size_t WS_TOT = WS_FLOC + 256 * KiB;
constexpr size_t WS_FKL = WS_TOT + 8 * KiB;
constexpr size_t WS_TOKE = WS_FKL + 256 * KiB;
constexpr size_t WS_TOKP = WS_TOKE + 64 * KiB;
constexpr size_t WS_TOKW = WS_TOKP + 64 * KiB;
constexpr size_t WS_LIST = WS_TOKW + 64 * KiB;
constexpr size_t WS_WM = 4 * MiB;
constexpr size_t WS_BWT = WS_WM + 256 * KiB;
constexpr size_t WS_MODP = 6 * MiB;
constexpr size_t WS_WIN = 8 * MiB;
constexpr size_t WS_WOUT = WS_WIN + 2 * 18 * MiB;
constexpr size_t WS_WGU = WS_WOUT + 2 * 8 * MiB;
constexpr size_t WS_WD = WS_WGU + 2 * 16 * 8 * MiB;
constexpr size_t WS_H = WS_WD + 2 * 16 * 4 * MiB;
constexpr size_t WS_Z = WS_H + 32 * MiB;
constexpr size_t WS_QN = WS_Z + 72 * MiB;
constexpr size_t WS_KN = WS_QN + 16 * MiB;
constexpr size_t WS_VN = WS_KN + 16 * MiB;
constexpr size_t WS_DP = WS_VN + 8 * MiB;
constexpr size_t WS_YCAT = WS_DP + 8 * MiB;
constexpr size_t WS_X1 = WS_YCAT + 32 * MiB;
constexpr size_t WS_X2 = WS_X1 + 64 * MiB;
constexpr size_t WS_HID = WS_X2 + 64 * MiB;
constexpr size_t WS_YB = WS_HID + 40 * MiB;
constexpr size_t WS_PART = WS_YB + 80 * MiB;
constexpr size_t WS_ML = WS_PART + 128 * MiB;
constexpr size_t WS_END = WS_ML + 4 * MiB;
constexpr int CW_TMO = 0, CW_CODE = 1;
constexpr int CW_CNT = 64;
constexpr int CW_Q = 512;
constexpr int CW_BGT = 640;
constexpr int CW_ARR = 1024;
constexpr int CW_BAR = 4096;

constexpr int RING_BYTES = 131072;
constexpr int MISC_OFF = RING_BYTES + 320;
constexpr int AUX_OFF = RING_BYTES + 1024;
constexpr int LDS_BYTES = 163840;

template <class T> __device__ __forceinline__ T* opq(T* p) { asm volatile("" : "+s"(p)); return p; }
__device__ __forceinline__ int opq_tid() { int t = threadIdx.x; asm volatile("" : "+v"(t)); return t; }
__device__ __forceinline__ unsigned cvt_pk_bf16(float lo, float hi) { unsigned r; asm volatile("v_cvt_pk_bf16_f32 %0, %1, %2" : "=v"(r) : "v"(lo), "v"(hi)); return r; }
__device__ __forceinline__ float bf_lo(unsigned w) { return __uint_as_float(w << 16); }
__device__ __forceinline__ float bf_hi(unsigned w) { return __uint_as_float(w & 0xffff0000u); }
__device__ __forceinline__ float wave_sum(float v) {
#pragma unroll
    for (int o = 1; o < 64; o <<= 1) v += __shfl_xor(v, o);
    return v;
}
__device__ __forceinline__ float gelu_t(float x) {
    const float u2 = x * (1.5957691216057308f + 0.0713548162726f * x * x);
    return x * __builtin_amdgcn_rcpf(1.f + __builtin_amdgcn_exp2f(-LOG2E * u2));
}
__device__ __forceinline__ float silu_f(float x) { return x * __builtin_amdgcn_rcpf(1.f + __builtin_amdgcn_exp2f(-LOG2E * x)); }

#define XB_TMO      128
#define XB_XCNT(j)  (256  + 64 * (j))
#define XB_XSUB(j)  (1280 + 64 * (j))
#define XB_XGEN(j)  (2304 + 64 * (j))
#define XB_TOP      3328
#define XB_TOPGEN   3392
#define XCD_BAR_WORDS 3456
#define XB_SPIN_CAP (1u << 18)
__device__ __forceinline__ unsigned xb_ld(unsigned* p)              { return __hip_atomic_load(p, __ATOMIC_RELAXED, __HIP_MEMORY_SCOPE_AGENT); }
__device__ __forceinline__ unsigned xb_add(unsigned* p, unsigned v) { return __hip_atomic_fetch_add(p, v, __ATOMIC_RELAXED, __HIP_MEMORY_SCOPE_AGENT); }
__device__ __forceinline__ unsigned xb_xcc_id() { return (unsigned)__builtin_amdgcn_s_getreg((3 << 11) | 20) & 0xFu; }
#define XB_SPIN(cond, bar) do { unsigned _sp = 0; while (cond) { __builtin_amdgcn_s_sleep(1); \
    if ((++_sp & 255u) == 0u) { if (xb_ld(&(bar)[XB_TMO])) break; if (_sp > XB_SPIN_CAP) { atomicAdd(&(bar)[XB_TMO], 1u); break; } } } } while (0)
struct XcdBarrier { unsigned* bar; unsigned x; volatile LAS unsigned* st; };
__device__ __forceinline__ XcdBarrier xcd_barrier_post(unsigned* bar, volatile LAS unsigned* st) {
    XcdBarrier b; b.bar = bar; b.x = xb_xcc_id(); b.st = st;
    if (threadIdx.x == 0) (void)xb_add(&bar[XB_XCNT(b.x)], 1u);
    return b;
}
__device__ __forceinline__ void xcd_barrier_complete(unsigned* bar, unsigned x, unsigned& nloc, unsigned& nx) {
    const unsigned G = gridDim.x * gridDim.y * gridDim.z;
    unsigned sum, cnt, mine, sp = 0u;
    for (;;) {
        sum = 0u; cnt = 0u; mine = 0u;
#pragma unroll
        for (unsigned j = 0; j < 16; ++j) { const unsigned c = xb_ld(&bar[XB_XCNT(j)]); sum += c; cnt += (c > 0u) ? 1u : 0u; mine = (j == x) ? c : mine; }
        if (sum == G) break;
        __builtin_amdgcn_s_sleep(1);
        if ((++sp & 255u) == 0u) { if (xb_ld(&bar[XB_TMO])) break; if (sp > XB_SPIN_CAP) { atomicAdd(&bar[XB_TMO], 1u); break; } }
    }
    nloc = mine > 0u ? mine : 1u; nx = cnt > 0u ? cnt : 1u;
}
__device__ __forceinline__ void xcd_barrier(const XcdBarrier& b) {
    asm volatile("s_waitcnt vmcnt(0)" ::: "memory");
    __syncthreads();
    if (threadIdx.x == 0) {
        unsigned* bar = b.bar;
        __builtin_amdgcn_s_waitcnt(0);
        unsigned nloc = b.st[0], nx = b.st[1];
        if (nloc == 0u) { xcd_barrier_complete(bar, b.x, nloc, nx); b.st[0] = nloc; b.st[1] = nx; }
        const unsigned old = xb_add(&bar[XB_XSUB(b.x)], 1u);
        const unsigned gen = old / nloc;
        if (old + 1u == (gen + 1u) * nloc) {
            __builtin_amdgcn_fence(__ATOMIC_RELEASE, "agent");
            asm volatile("s_waitcnt vmcnt(0)" ::: "memory");
            const unsigned og = xb_add(&bar[XB_TOP], 1u);
            const unsigned tg = og / nx;
            if (og + 1u == (tg + 1u) * nx) xb_add(&bar[XB_TOPGEN], 1u);
            else XB_SPIN(xb_ld(&bar[XB_TOPGEN]) == tg, bar);
            __builtin_amdgcn_fence(__ATOMIC_ACQUIRE, "agent");
            xb_add(&bar[XB_XGEN(b.x)], 1u);
            asm volatile("s_waitcnt vmcnt(0)" ::: "memory");
        } else {
            XB_SPIN(xb_ld(&bar[XB_XGEN(b.x)]) == gen, bar);
            __builtin_amdgcn_fence(__ATOMIC_ACQUIRE, "agent");
            asm volatile("s_waitcnt vmcnt(0)" ::: "memory");
        }
    }
    __syncthreads();
}

namespace gm {
constexpr int BM = 256, BK = 64, HALF = 128, HTB = HALF * BK * 2, STAGE_BYTES = 8 * HTB, NXCD = 8, WGM = 8;
__host__ __device__ __forceinline__ int lds_byte(int r, int c) { const int st = (r >> 4) * 2 + (c >> 5), rr = r & 15, cc = c & 31, ob = rr * 64 + cc * 2; return st * 1024 + (ob ^ (((ob >> 9) & 1) << 5)); }
__host__ __device__ __forceinline__ void stage_rc(int b, int& R, int& C) { const int st = b / 1024, sb = b % 1024, swz = sb ^ (((sb >> 9) & 1) << 5); R = (st >> 1) * 16 + swz / 64; C = (st & 1) * 32 + (swz % 64) / 2; }
__host__ __device__ __forceinline__ int perm32(int rho) { const int n = rho >> 4, i = rho & 15; return 8 * (i >> 2) + 4 * n + (i & 3); }

struct Unit { int arow, orow, ocol, e, rt; const char* Bp; };

template <class Epi, class Sched, bool GATHER, bool ALIGN_EPI>
__device__ __forceinline__ void gemm_phase(LAS unsigned char* lds, const char* Abase, const int K, const Sched& S, const Epi& E) {
    const int tid = opq_tid(), wid = __builtin_amdgcn_readfirstlane(tid >> 6), lane = tid & 63, wr = wid >> 2, wc = wid & 3, fr = lane & 15, fq = lane >> 4;
    const int nt = K / BK;
    unsigned voffA[2], voffB[2]; int Rr[2], Cc[2];
#pragma unroll
    for (int i = 0; i < 2; ++i) { int R, C; stage_rc(tid * 16 + i * 8192, R, C); const int Rb = Epi::PERM ? ((R & ~31) + perm32(R & 31)) : R;
        Rr[i] = R; Cc[i] = C; voffA[i] = (unsigned)(R * K + C) * 2u; voffB[i] = (unsigned)(Rb * K + C) * 2u; }
    const size_t kstep = (size_t)(BK * 2);
    const size_t hstep = (size_t)HALF * K * 2;
    const unsigned ldsw = (unsigned)wid * 1024u;
    const int aoff = lds_byte(wr * 64 + fr, fq * 8), boff = lds_byte(wc * 32 + fr, fq * 8);
#define PG8_SA(b, h) (((b) * 2 + (h)) * HTB)
#define PG8_SB(b, h) ((4 + (b) * 2 + (h)) * HTB)
#define PG8_STAGE(bufoff, gbase, voff) do { _Pragma("unroll") for (int _i = 0; _i < 2; ++_i) \
        __builtin_amdgcn_global_load_lds((const unsigned*)((const char*)(gbase) + (voff)[_i]), (LAS unsigned*)(lds + (bufoff) + ldsw + _i * 8192), 16, 0, 0); } while (0)
#define PG8_STAGE_A(bufoff, ubase, h, kb, vg) do { if constexpr (GATHER) { PG8_STAGE(bufoff, Abase + (kb), (vg)[h]); } else { PG8_STAGE(bufoff, (ubase) + (h) * hstep + (kb), voffA); } } while (0)
#define PG8_LDA(dst, b, h) do { _Pragma("unroll") for (int m = 0; m < 4; ++m) _Pragma("unroll") for (int k = 0; k < 2; ++k) dst[m][k] = *(const LAS bf16x8*)(lds + PG8_SA(b, h) + aoff + m * 2048 + k * 1024); } while (0)
#define PG8_LDB(dst, b, h) do { _Pragma("unroll") for (int n = 0; n < 2; ++n) _Pragma("unroll") for (int k = 0; k < 2; ++k) dst[n][k] = *(const LAS bf16x8*)(lds + PG8_SB(b, h) + boff + n * 2048 + k * 1024); } while (0)
#define PG8_MMA(ai, bj, At, Bt) do { __builtin_amdgcn_s_setprio(1); _Pragma("unroll") for (int m = 0; m < 4; ++m) _Pragma("unroll") for (int n = 0; n < 2; ++n) _Pragma("unroll") for (int k = 0; k < 2; ++k) \
        acc[ai][bj][m][n] = __builtin_amdgcn_mfma_f32_16x16x32_bf16(Bt[n][k], At[m][k], acc[ai][bj][m][n], 0, 0, 0); __builtin_amdgcn_s_setprio(0); } while (0)
#define PG8_WAIT_V(n) asm volatile("s_waitcnt vmcnt(" #n ")" ::: "memory")
#define PG8_WAIT_L(n) asm volatile("s_waitcnt lgkmcnt(" #n ")" ::: "memory")
#define PG8_BAR __builtin_amdgcn_s_barrier()
#define PG8_SCHED __builtin_amdgcn_sched_barrier(0)
    Unit cur, nxt; int ui = 0;
    if (!S.next(0, cur)) return;
    f32x4 acc[2][2][4][2];
#pragma unroll
    for (int a = 0; a < 2; ++a)
#pragma unroll
        for (int b = 0; b < 2; ++b)
#pragma unroll
            for (int m = 0; m < 4; ++m)
#pragma unroll
                for (int n = 0; n < 2; ++n) acc[a][b][m][n] = (f32x4){0.f, 0.f, 0.f, 0.f};
    bf16x8 At[4][2], B0[2][2], B1[2][2];
    unsigned vgc[2][2], vgn[2][2];
    if constexpr (GATHER) {
#pragma unroll
        for (int h = 0; h < 2; ++h)
#pragma unroll
            for (int i = 0; i < 2; ++i) { vgc[h][i] = ((unsigned)S.row_of(cur, h * HALF + Rr[i]) * (unsigned)K + (unsigned)Cc[i]) * 2u; vgn[h][i] = vgc[h][i]; }
    }
    const char* cA = GATHER ? Abase : Abase + (size_t)cur.arow * K * 2; const char* cB = cur.Bp;
    PG8_STAGE(PG8_SB(0, 0), cB, voffB); PG8_STAGE(PG8_SB(0, 1), cB + hstep, voffB); PG8_STAGE_A(PG8_SA(0, 0), cA, 0, 0, vgc); PG8_STAGE_A(PG8_SA(0, 1), cA, 1, 0, vgc);
    if (wr == 1) PG8_BAR;
    PG8_WAIT_V(2); PG8_BAR;
    PG8_STAGE(PG8_SB(1, 0), cB + kstep, voffB); PG8_STAGE_A(PG8_SA(1, 0), cA, 0, kstep, vgc); PG8_STAGE(PG8_SB(1, 1), cB + hstep + kstep, voffB);
    PG8_WAIT_V(6); PG8_BAR;
    for (;;) {
        const bool has_next = S.next(ui + 1, nxt);
        const char* nA = has_next ? (GATHER ? Abase : Abase + (size_t)nxt.arow * K * 2) : cA; const char* nB = has_next ? nxt.Bp : cB;
        if constexpr (GATHER) {
            if (has_next) {
#pragma unroll
                for (int h = 0; h < 2; ++h)
#pragma unroll
                    for (int i = 0; i < 2; ++i) vgn[h][i] = ((unsigned)S.row_of(nxt, h * HALF + Rr[i]) * (unsigned)K + (unsigned)Cc[i]) * 2u;
            } else {
#pragma unroll
                for (int h = 0; h < 2; ++h)
#pragma unroll
                    for (int i = 0; i < 2; ++i) vgn[h][i] = vgc[h][i];
            }
        }
        for (int t = 0; t < nt; t += 2) {
            const bool last = (t == nt - 2);
            const size_t k1 = (size_t)(t + 1) * kstep;
            const char* a2 = last ? nA : cA; const char* b2 = last ? nB : cB + (size_t)(t + 2) * kstep;
            const size_t k2 = last ? 0 : (size_t)(t + 2) * kstep, k3 = k2 + kstep;
            const char* b3 = b2 + kstep;
            unsigned vg2[2][2];
            if constexpr (GATHER) {
#pragma unroll
                for (int h = 0; h < 2; ++h)
#pragma unroll
                    for (int i = 0; i < 2; ++i) vg2[h][i] = last ? vgn[h][i] : vgc[h][i];
            }
            PG8_LDB(B0, 0, 0); PG8_LDB(B1, 0, 1); PG8_SCHED; PG8_LDA(At, 0, 0); PG8_STAGE_A(PG8_SA(1, 1), cA, 1, k1, vgc);
            PG8_WAIT_V(8); PG8_WAIT_L(0); PG8_BAR; PG8_MMA(0, 0, At, B0); PG8_MMA(0, 1, At, B1); PG8_BAR; PG8_SCHED;
            PG8_LDA(At, 0, 1); PG8_STAGE(PG8_SB(0, 0), b2, voffB); PG8_STAGE(PG8_SB(0, 1), b2 + hstep, voffB); PG8_STAGE_A(PG8_SA(0, 0), a2, 0, k2, vg2);
            PG8_WAIT_V(8); PG8_WAIT_L(0); PG8_BAR; PG8_MMA(1, 0, At, B0); PG8_MMA(1, 1, At, B1); PG8_BAR; PG8_SCHED;
            PG8_LDB(B0, 1, 0); PG8_LDB(B1, 1, 1); PG8_SCHED; PG8_LDA(At, 1, 0); PG8_STAGE_A(PG8_SA(0, 1), a2, 1, k2, vg2);
            PG8_WAIT_V(8); PG8_WAIT_L(0); PG8_BAR; PG8_MMA(0, 0, At, B0); PG8_MMA(0, 1, At, B1); PG8_BAR; PG8_SCHED;
            PG8_LDA(At, 1, 1); PG8_STAGE(PG8_SB(1, 0), b3, voffB); PG8_STAGE(PG8_SB(1, 1), b3 + hstep, voffB); PG8_STAGE_A(PG8_SA(1, 0), a2, 0, k3, vg2);
            PG8_WAIT_V(8); PG8_WAIT_L(0); PG8_BAR; PG8_MMA(1, 0, At, B0); PG8_MMA(1, 1, At, B1); PG8_BAR; PG8_SCHED;
        }
        if constexpr (ALIGN_EPI) { if (wr == 0) PG8_BAR; }
        E(acc, cur, wr, wc, fr, fq);
        if (!has_next) break;
#pragma unroll
        for (int a = 0; a < 2; ++a)
#pragma unroll
            for (int b = 0; b < 2; ++b)
#pragma unroll
                for (int m = 0; m < 4; ++m)
#pragma unroll
                    for (int n = 0; n < 2; ++n) acc[a][b][m][n] = (f32x4){0.f, 0.f, 0.f, 0.f};
        cur = nxt; cA = nA; cB = nB; ++ui;
        if constexpr (GATHER) {
#pragma unroll
            for (int h = 0; h < 2; ++h)
#pragma unroll
                for (int i = 0; i < 2; ++i) vgc[h][i] = vgn[h][i];
        }
        if constexpr (ALIGN_EPI) { if (wr == 1) PG8_BAR; }
    }
    PG8_WAIT_V(0);
    if constexpr (!ALIGN_EPI) { if (wr == 0) PG8_BAR; }
    PG8_BAR;
#undef PG8_SA
#undef PG8_SB
#undef PG8_STAGE
#undef PG8_STAGE_A
#undef PG8_LDA
#undef PG8_LDB
#undef PG8_MMA
#undef PG8_WAIT_V
#undef PG8_WAIT_L
#undef PG8_BAR
#undef PG8_SCHED
}

struct RegOrder {
    int nM, nN, nwg, G, c, K; const char* Bt;
    __device__ __forceinline__ void init(int M, int N, int K_, const void* Bt_, int G_, int c_) { nM = M / BM; nN = N / BM; nwg = nM * nN; G = G_; c = c_; K = K_; Bt = (const char*)Bt_; }
    __device__ __forceinline__ bool next(int i, Unit& u) const {
        const long L = (long)i * G + c; if (L >= nwg) return false;
        int wgid = (int)L; { const int q = nwg / NXCD, r = nwg % NXCD, xcd = wgid % NXCD, off = wgid / NXCD; wgid = (xcd < r ? xcd * (q + 1) : r * (q + 1) + (xcd - r) * q) + off; }
        const int nig = WGM * nN, gid = wgid / nig, fm = gid * WGM, gsz = (nM - fm) < WGM ? (nM - fm) : WGM;
        const int pm = fm + ((wgid % nig) % gsz), pn = (wgid % nig) / gsz;
        u.arow = pm * BM; u.orow = pm * BM; u.ocol = pn * BM; u.e = 0; u.rt = 0; u.Bp = Bt + (size_t)pn * BM * K * 2; return true;
    }
    __device__ __forceinline__ int row_of(const Unit&, int) const { return 0; }
};
}
namespace at {
constexpr int NW = 8, QBLK = 32, KVBLK = 64, QB = NW * QBLK, D = 128;
constexpr int SHM_V = KVBLK * D * 2, SHM_K = KVBLK * D * 2;
constexpr int OFF_WS = 2 * SHM_V + 2 * SHM_K, OFF_NF = OFF_WS + NW * 64 * 4, ATT_LDS = OFF_NF + 2 * 64 * 4;
constexpr float SCALE = 0.08838834764831845f, C2 = 1.4426950408889634f * SCALE, THR = 8.f;
constexpr float ISCALE = 11.313708498984761f;
constexpr int QS = 128, KS = 128, VS = NZ, OS = DM;

#define KSWZ(row, colB) ((row) * 256 + ((colB) ^ (((row) & 7) << 4)))
#define SBAR() __builtin_amdgcn_sched_barrier(0)
__device__ __forceinline__ int v_st(int k, int c) { const int kk = (k & ~0xC) | ((k & 4) << 1) | ((k & 8) >> 1); return ((kk >> 3) * 4 + (c >> 5)) * 512 + ((kk & 7) * 32 + (c & 31)) * 2; }
__device__ __forceinline__ int v_rd_base(int lane) { return ((lane & 3) << 3) | (((lane >> 2) & 3) << 6) | (((lane >> 4) & 1) << 5) | (((lane >> 5) & 1) << 8); }
constexpr int v_rd_off(int d0, int ks, int half) { return d0 * 512 + ks * 4096 + half * 2048; }
__device__ __forceinline__ int crow(int r, int hi) { return (r & 3) + 8 * (r >> 2) + 4 * hi; }
__device__ __forceinline__ unsigned cvtpk(float lo, float hi) { unsigned r; asm volatile("v_cvt_pk_bf16_f32 %0, %1, %2" : "=v"(r) : "v"(lo), "v"(hi)); return r; }
__device__ __forceinline__ bf16x8 load8(const bf16* p) { return *(const GAS bf16x8*)p; }

__device__ __forceinline__ void mask_tile(f32x16& p0, f32x16& p1, int dq) {
    const float NEG = -__builtin_inff();
#pragma unroll
    for (int r = 0; r < 16; ++r) {
        const int c = (r & 3) + 8 * (r >> 2);
        if (dq - c < 0) p0[r] = NEG;
        if (dq - c - 32 < 0) p1[r] = NEG;
    }
}
__device__ __forceinline__ void partialSM(f32x16& p0, f32x16& p1, float& m_reg, float& mn, float& alpha) {
    float pmax = p0[0]; for (int r = 1; r < 16; ++r) pmax = fmaxf(pmax, p0[r]); for (int r = 0; r < 16; ++r) pmax = fmaxf(pmax, p1[r]);
    { auto rr = __builtin_amdgcn_permlane32_swap(__float_as_uint(pmax), __float_as_uint(pmax), false, false);
      pmax = fmaxf(__uint_as_float(rr[0]), __uint_as_float(rr[1])); }
    if (__builtin_expect(__all((pmax - m_reg) * SCALE <= THR), 1)) { mn = m_reg; alpha = 1.f; }
    else { mn = fmaxf(m_reg, pmax); alpha = __builtin_amdgcn_exp2f((m_reg - mn) * C2); m_reg = mn; }
    const float mnL = -mn * C2;
    for (int r = 0; r < 16; ++r) p0[r] = fmaf(p0[r], C2, mnL); for (int r = 0; r < 16; ++r) p1[r] = fmaf(p1[r], C2, mnL);
    for (int r = 0; r < 16; ++r) p0[r] = __builtin_amdgcn_exp2f(p0[r]);
}
__device__ __forceinline__ void finishSM(f32x16& p0, f32x16& p1, float alpha, float& l_reg, bf16x8& pa0, bf16x8& pa1, bf16x8& pa2, bf16x8& pa3) {
    for (int r = 0; r < 16; ++r) p1[r] = __builtin_amdgcn_exp2f(p1[r]);
    float ps = 0; for (int r = 0; r < 16; ++r) ps += p0[r]; for (int r = 0; r < 16; ++r) ps += p1[r];
    { auto rr = __builtin_amdgcn_permlane32_swap(__float_as_uint(ps), __float_as_uint(ps), false, false);
      ps = __uint_as_float(rr[0]) + __uint_as_float(rr[1]); }
    l_reg = l_reg * alpha + ps;
#define PK4(P, B_, OUT) do { unsigned a0 = cvtpk(P[B_+0], P[B_+1]), a1 = cvtpk(P[B_+2], P[B_+3]);                          \
        unsigned b0 = cvtpk(P[B_+4], P[B_+5]), b1 = cvtpk(P[B_+6], P[B_+7]);                                             \
        auto r0 = __builtin_amdgcn_permlane32_swap(a0, b0, false, false); auto r1 = __builtin_amdgcn_permlane32_swap(a1, b1, false, false); \
        u32x4 w = {r0[0], r1[0], r0[1], r1[1]}; OUT = *reinterpret_cast<bf16x8*>(&w); } while (0)
    PK4(p0, 0, pa0); PK4(p0, 8, pa1); PK4(p1, 0, pa2); PK4(p1, 8, pa3);
#undef PK4
}
template <int KB>
__device__ __forceinline__ void qkt(f32x16& p0, f32x16& p1, const char* K_lds, int r32, int hi, const bf16x8* qr) {
    { const float* nf = (const float*)(K_lds + 2 * SHM_K + NW * 64 * 4) + KB * 64 + 4 * hi;
#pragma unroll
      for (int g = 0; g < 4; ++g) { const f32x4 a = *(const f32x4*)(nf + 8 * g), b = *(const f32x4*)(nf + 32 + 8 * g);
#pragma unroll
          for (int j = 0; j < 4; ++j) { p0[4 * g + j] = a[j]; p1[4 * g + j] = b[j]; } } }
    const char* kb[4];
#pragma unroll
    for (int dd = 0; dd < 4; ++dd) kb[dd] = K_lds + KB * SHM_K + KSWZ(r32, (dd * 16 + hi * 8) * 2);
#pragma unroll
    for (int d0 = 0; d0 < 8; ++d0) { const char* a = kb[d0 & 3] + (d0 >> 2) * 128;
        bf16x8 b0 = *reinterpret_cast<const bf16x8*>(a);
        bf16x8 b1 = *reinterpret_cast<const bf16x8*>(a + 32 * 256);
        p0 = __builtin_amdgcn_mfma_f32_32x32x16_bf16(b0, qr[d0], p0, 0, 0, 0);
        p1 = __builtin_amdgcn_mfma_f32_32x32x16_bf16(b1, qr[d0], p1, 0, 0, 0); }
}
template <int VB>
__device__ __forceinline__ void pv_tile(f32x16* o, int vb0, bf16x8 pa0, bf16x8 pa1, bf16x8 pa2, bf16x8 pa3) {
#define TRRD(dst, off) asm volatile("ds_read_b64_tr_b16 %0, %1 offset:%2" : "=&v"(dst) : "v"(vb0), "i"(off) : "memory")
#define PV_D0(d0) do { s16x4 l0, l1, l2, l3, h0, h1, h2, h3; constexpr int b_ = VB * SHM_V + v_rd_off(d0, 0, 0); \
        TRRD(l0, b_); TRRD(h0, b_ + 2048); TRRD(l1, b_ + 4096); TRRD(h1, b_ + 6144); TRRD(l2, b_ + 8192); TRRD(h2, b_ + 10240); TRRD(l3, b_ + 12288); TRRD(h3, b_ + 14336); \
        asm volatile("s_waitcnt lgkmcnt(0)" ::: "memory"); SBAR();   \
        o[d0] = __builtin_amdgcn_mfma_f32_32x32x16_bf16(pa0, (bf16x8){l0[0], l0[1], l0[2], l0[3], h0[0], h0[1], h0[2], h0[3]}, o[d0], 0, 0, 0);   \
        o[d0] = __builtin_amdgcn_mfma_f32_32x32x16_bf16(pa1, (bf16x8){l1[0], l1[1], l1[2], l1[3], h1[0], h1[1], h1[2], h1[3]}, o[d0], 0, 0, 0);   \
        o[d0] = __builtin_amdgcn_mfma_f32_32x32x16_bf16(pa2, (bf16x8){l2[0], l2[1], l2[2], l2[3], h2[0], h2[1], h2[2], h2[3]}, o[d0], 0, 0, 0);   \
        o[d0] = __builtin_amdgcn_mfma_f32_32x32x16_bf16(pa3, (bf16x8){l3[0], l3[1], l3[2], l3[3], h3[0], h3[1], h3[2], h3[3]}, o[d0], 0, 0, 0); } while (0)
    PV_D0(0); PV_D0(1); PV_D0(2); PV_D0(3);
#undef PV_D0
#undef TRRD
}

struct BlockRef { const bf16* Q; const bf16* K; const bf16* V; bf16* O; const float* FK; int P0; };
#define ROWV(p, k0, rr) ((p) + (size_t)((k0) + (rr)) * VS + sc)
#define VMW() asm volatile("s_waitcnt vmcnt(0)" ::: "memory")
__device__ __forceinline__ void attn_block(const BlockRef& cur, int ja, int nt, bool fin, bf16* Opart, float* ML, char* lds, LAS unsigned char* ldsL) {
    const int tid = opq_tid(), wid = __builtin_amdgcn_readfirstlane(tid >> 6), lane = tid & 63, r32 = lane & 31, hi = lane >> 5;
    const int NT = nt;
    const int qlo = cur.P0 + wid * QBLK, qm = qlo + r32 - 4 * hi;
    char* V_lds = lds; char* K_lds = lds + 2 * SHM_V;
    float* ws = (float*)(lds + OFF_WS) + wid * 64; float* li_l = ws, * al_l = ws + 32;
    float m_reg = -1e30f, l_reg = 0; f32x16 o[4] = {};
    const int vb0 = (int)(uintptr_t)V_lds + v_rd_base(lane);
    const bf16* Kh = cur.K; const bf16* Vh = cur.V; const float* Fh = cur.FK;
    bf16x8 st_v0, st_v1; bf16x8 qr[8];
#define KDMA(bf, k0) do { int t_ = tid; asm volatile("" : "+v"(t_)); _Pragma("unroll") for (int i_ = 0; i_ < 2; ++i_) { const int p_ = i_ * 512 + t_, r_ = p_ >> 4, c_ = (p_ & 15) ^ (r_ & 7); \
        __builtin_amdgcn_global_load_lds((const unsigned*)((const char*)Kh + (size_t)(k0) * KS * 2 + (unsigned)(r_ * KS * 2 + c_ * 16)), (LAS unsigned*)(ldsL + 2 * SHM_V + (bf) * SHM_K + i_ * 8192 + wid * 1024), 16, 0, 0); } \
        if (wid == 0) __builtin_amdgcn_global_load_lds((const unsigned*)(Fh + (k0) + lane), (LAS unsigned*)(ldsL + OFF_NF + (bf) * 256), 4, 0, 0); } while (0)
#define SLOADV(k0) do { int t_ = tid; asm volatile("" : "+v"(t_)); const int sr = t_ >> 4, sc = (t_ & 15) * 8; st_v0 = load8(ROWV(Vh, k0, sr)); st_v1 = load8(ROWV(Vh, k0, 32 + sr)); } while (0)
#define SWRITE_HV(bf) do { int t_ = tid; asm volatile("" : "+v"(t_)); const int sr = t_ >> 4, sc = (t_ & 15) * 8; *(bf16x8*)(V_lds + (bf) * SHM_V + v_st(sr, sc)) = st_v0; *(bf16x8*)(V_lds + (bf) * SHM_V + v_st(32 + sr, sc)) = st_v1; } while (0)
#define RESC(a) do { if (__any((a) < 1.f)) { if (hi == 0) al_l[r32] = (a); asm volatile("s_waitcnt lgkmcnt(0)" ::: "memory");              \
                     for (int d_ = 0; d_ < 4; ++d_) for (int r = 0; r < 16; ++r) o[d_][r] *= al_l[crow(r, hi)]; } } while (0)
#define KBASE(t) ((ja + (t)) * KVBLK)
#define MASKT(P0_, P1_, t) do { const int kb_ = KBASE(t); if (kb_ + KVBLK - 1 > qlo) mask_tile(P0_, P1_, qm - kb_); } while (0)
    f32x16 pA0, pA1, pB0, pB1; float mnA, mnB, alA, alB; bf16x8 pa0, pa1, pa2, pa3;
    KDMA(0, KBASE(0)); SLOADV(KBASE(0));
#pragma unroll
    for (int d0 = 0; d0 < 8; ++d0) qr[d0] = load8(cur.Q + (size_t)(wid * QBLK + r32) * QS + d0 * 16 + hi * 8);
    VMW(); SWRITE_HV(0);
    __syncthreads();
    if (NT > 1) { KDMA(1, KBASE(1)); SLOADV(KBASE(1)); }
    SBAR(); qkt<0>(pA0, pA1, K_lds, r32, hi, qr);
    MASKT(pA0, pA1, 0); partialSM(pA0, pA1, m_reg, mnA, alA);
    if (NT > 1) { VMW(); SWRITE_HV(1); }
    __syncthreads();
#define HALF_STEP(PX0, PX1, mnX, alX, PY0, PY1, alY, t, KB, VB, SB) do {                                                      \
        SBAR(); qkt<KB>(PX0, PX1, K_lds, r32, hi, qr);                                                                        \
        finishSM(PY0, PY1, alY, l_reg, pa0, pa1, pa2, pa3); SBAR();                                                           \
        if ((t) + 1 < NT) { KDMA(SB, KBASE((t) + 1)); SLOADV(KBASE((t) + 1)); SBAR(); }                                       \
        pv_tile<VB>(o, vb0, pa0, pa1, pa2, pa3); MASKT(PX0, PX1, (t)); partialSM(PX0, PX1, m_reg, mnX, alX);                  \
        VMW(); __syncthreads();                                                                                               \
        if ((t) + 1 < NT) { SWRITE_HV(SB); }                                                                                  \
        RESC(alX); __syncthreads(); } while (0)
    for (int t = 1; t + 1 < NT; t += 2) {
        HALF_STEP(pB0, pB1, mnB, alB, pA0, pA1, alA, t, 1, 0, 0);
        HALF_STEP(pA0, pA1, mnA, alA, pB0, pB1, alB, t + 1, 0, 1, 1);
    }
    const bool even = (NT & 1) == 0;
    if (even) { SBAR(); qkt<1>(pB0, pB1, K_lds, r32, hi, qr); SBAR(); }
    finishSM(pA0, pA1, alA, l_reg, pa0, pa1, pa2, pa3); SBAR();
    pv_tile<0>(o, vb0, pa0, pa1, pa2, pa3);
    if (even) { MASKT(pB0, pB1, NT - 1); partialSM(pB0, pB1, m_reg, mnB, alB); __syncthreads(); RESC(alB);
        finishSM(pB0, pB1, alB, l_reg, pa0, pa1, pa2, pa3); SBAR(); pv_tile<1>(o, vb0, pa0, pa1, pa2, pa3); }
    SBAR();
    if (hi == 0) li_l[r32] = l_reg; asm volatile("s_waitcnt lgkmcnt(0)" ::: "memory");
    float rli[16];
#pragma unroll
    for (int r = 0; r < 16; ++r) rli[r] = __builtin_amdgcn_rcpf(li_l[crow(r, hi)]);
    const int ostr = fin ? OS : D;
    bf16* Ow = (fin ? cur.O : Opart) + (size_t)(wid * QBLK) * ostr;
#pragma unroll
    for (int r = 0; r < 16; ++r) { const int orow = crow(r, hi);
#pragma unroll
        for (int d0 = 0; d0 < 4; ++d0) { const float v = o[d0][r] * rli[r];
            const float vn = __shfl_xor(v, 1);
            if ((r32 & 1) == 0) *(GAS unsigned*)(Ow + (size_t)orow * ostr + d0 * 32 + r32) = cvtpk(v, vn); } }
    if (!fin && hi == 0) { f32x2 mlv; mlv.x = m_reg; mlv.y = l_reg; *(GAS f32x2*)(ML + (size_t)(wid * QBLK + r32) * 2) = mlv; }
    __syncthreads();
#undef KDMA
#undef SLOADV
#undef SWRITE_HV
#undef RESC
#undef KBASE
#undef MASKT
#undef HALF_STEP
}
#undef ROWV
#undef VMW
}
struct Frame {
    LAS unsigned char* lds; volatile LAS unsigned* MISC; gu32* ctl;
    int tid, lane, wave, vcu, G;
    unsigned char* ws;
};
#define CAS __attribute__((address_space(4)))
__device__ __forceinline__ const float* karg(int k) { const CAS char* p = (const CAS char*)__builtin_amdgcn_kernarg_segment_ptr(); asm volatile("" : "+s"(p)); return *(const float* const CAS*)(p + 8 * k); }

__device__ __forceinline__ void tr_item(const float* W, size_t ldw, bf16* WT, size_t ldk, LAS float* scr, int lane) {
    const int kr = lane >> 3, c4 = (lane & 7) * 4;
    f32x4 v[8];
#pragma unroll
    for (int i = 0; i < 8; ++i) v[i] = *(const GAS f32x4*)(W + (size_t)(8 * i + kr) * ldw + c4);
#pragma unroll
    for (int i = 0; i < 8; ++i) { LAS float* s = scr + (8 * i + kr) * 33 + c4; s[0] = v[i].x; s[1] = v[i].y; s[2] = v[i].z; s[3] = v[i].w; }
    LDS_WAIT();
    const int c = lane & 7;
#pragma unroll
    for (int j = 0; j < 4; ++j) { const int n = (lane >> 3) + 8 * j; const LAS float* s = scr + (8 * c) * 33 + n;
        u32x4 o; o.x = cvt_pk_bf16(s[0 * 33], s[1 * 33]); o.y = cvt_pk_bf16(s[2 * 33], s[3 * 33]); o.z = cvt_pk_bf16(s[4 * 33], s[5 * 33]); o.w = cvt_pk_bf16(s[6 * 33], s[7 * 33]);
        *(GAS u32x4*)(WT + (size_t)n * ldk + 8 * c) = o; }
    LDS_WAIT();
}
constexpr int I_IN = (DM / 64) * (NZ / 32), I_OUT = (DM / 64) * (DM / 32), I_GU = (DM / 64) * (DEX / 32), I_D = (DEX / 64) * (DM / 32);
constexpr int GV_FIRST = 43;
constexpr int BGI_SMALL = (NLAYER * 4 * 8) / 8, BGI_IN = I_IN / 8, BGI_GV0 = (128 - GV_FIRST) * 4, BGI_GV1 = 128 * 4, BGI_OUT = I_OUT / 8, BGI_GU = NEXP * 2 * I_GU / 8, BGI_D = NEXP * I_D / 8;
constexpr int BG_C0 = BGI_SMALL + BGI_IN;
constexpr int BG_C1 = BG_C0 + BGI_GV0 + BGI_OUT;
constexpr int BG_C2 = BG_C1 + BGI_GU;
constexpr int BG_C3 = BG_C2 + BGI_D;
constexpr int BG_C3B = BG_C3 + BGI_GV1;
constexpr int BG_C4 = BG_C3B + BGI_IN;
constexpr int BG_C5 = BG_C4 + BGI_OUT;
constexpr int BG_C6 = BG_C5 + BGI_GU;
constexpr int BG_C7 = BG_C6 + BGI_D;
__device__ __forceinline__ float mod_at(const unsigned char* ws, const float* b_ada, int l, int j) {
    const float* p = (const float*)(ws + WS_MODP) + (size_t)l * 6 * DM + j;
    return *(const GAS float*)(b_ada + (size_t)l * 6 * DM + j) + ((*(const GAS float*)p + *(const GAS float*)(p + 2 * 6 * DM)) + (*(const GAS float*)(p + 4 * 6 * DM) + *(const GAS float*)(p + 6 * 6 * DM)));
}
__device__ __forceinline__ void gemv_item(const Frame& F, unsigned char* ws, int w) {
    LAS float* sc = (LAS float*)F.lds; LAS f32x4* red = (LAS f32x4*)(F.lds + 8192);
    const int kq = w & 3, l = w >> 9, cb = (w >> 2) & 127, c4 = F.tid % 24, kg = F.tid / 24;
    if (F.tid < 512) sc[F.tid] = silu_f(*(const GAS float*)(karg(1) + kq * 512 + F.tid));
    __syncthreads();
    f32x4 acc = (f32x4){0.f, 0.f, 0.f, 0.f};
    if (kg < 21) {
        const float* wp = karg(2) + (size_t)l * DM * 6 * DM + (size_t)(kq * 512) * 6 * DM + cb * 96 + c4 * 4;
#pragma unroll 8
        for (int k = kg; k < 512; k += 21) { const f32x4 wv = *(const GAS f32x4*)(wp + (size_t)k * 6 * DM); acc += wv * sc[k]; }
        red[kg * 24 + c4] = acc;
    }
    __syncthreads();
    if (F.tid < 24) { f32x4 s = red[F.tid];
        for (int g = 1; g < 21; ++g) s += red[g * 24 + F.tid];
        *(GAS f32x4*)((float*)(ws + WS_MODP) + (size_t)kq * 2 * 6 * DM + (size_t)l * 6 * DM + cb * 96 + F.tid * 4) = s; }
    __syncthreads();
}
__device__ __forceinline__ void conv_wave_item(const Frame& F, unsigned char* ws, int r, int l, LAS float* scr) {
    if (r < I_IN) { const int kb = r / (NZ / 32), nb = r % (NZ / 32);
        tr_item(karg(6) + (size_t)l * DM * NIN + (size_t)(64 * kb) * NIN + 32 * nb, NIN, (bf16*)(ws + WS_WIN) + (size_t)l * NZ * DM + (size_t)(32 * nb) * DM + 64 * kb, DM, scr, F.lane); return; }
    r -= I_IN;
    if (r < I_OUT) { const int kb = r / (DM / 32), nb = r % (DM / 32);
        tr_item(karg(15) + (size_t)l * DM * DM + (size_t)(64 * kb) * DM + 32 * nb, DM, (bf16*)(ws + WS_WOUT) + (size_t)l * DM * DM + (size_t)(32 * nb) * DM + 64 * kb, DM, scr, F.lane); return; }
    r -= I_OUT;
    if (r < NEXP * 2 * I_GU) { const int e = r / (2 * I_GU); r -= e * 2 * I_GU; const int up = r >= I_GU; if (up) r -= I_GU; const int kb = r / (DEX / 32), nb = r % (DEX / 32), n0 = 32 * nb;
        const float* src = (up ? karg(19) : karg(18)) + ((size_t)l * NEXP + e) * DM * DEX + (size_t)(64 * kb) * DEX + n0;
        const int drow = (n0 >> 7) * 256 + (up ? 128 : 0) + (n0 & 127);
        tr_item(src, DEX, (bf16*)(ws + WS_WGU) + ((size_t)l * NEXP + e) * DM * DM + (size_t)drow * DM + 64 * kb, DM, scr, F.lane); return; }
    r -= NEXP * 2 * I_GU;
    { const int e = r / I_D; r -= e * I_D; const int kb = r / (DM / 32), nb = r % (DM / 32);
      tr_item(karg(20) + ((size_t)l * NEXP + e) * DEX * DM + (size_t)(64 * kb) * DM + 32 * nb, DM, (bf16*)(ws + WS_WD) + ((size_t)l * NEXP + e) * DM * DEX + (size_t)(32 * nb) * DEX + 64 * kb, DEX, scr, F.lane); }
}
__device__ __forceinline__ void bg_item(const Frame& F, unsigned char* ws, int t) {
    LAS float* scr = (LAS float*)(F.lds + 16384 + F.wave * 9216);
    if (t < BGI_SMALL) { const int r = t * 8 + F.wave, mat = r >> 3, q = r & 7, kb = q >> 2, nb = q & 3;
        tr_item(karg(10) + (size_t)mat * 128 * 128 + (size_t)(64 * kb) * 128 + 32 * nb, 128, (bf16*)(ws + WS_BWT) + (size_t)mat * 128 * 128 + (size_t)(32 * nb) * 128 + 64 * kb, 128, scr, F.lane); return; }
    t -= BGI_SMALL;
    if (t < BGI_IN) { conv_wave_item(F, ws, t * 8 + F.wave, 0, scr); return; }
    t -= BGI_IN;
    if (t < BGI_GV0) { gemv_item(F, ws, GV_FIRST * 4 + t); return; }
    t -= BGI_GV0;
    if (t < BGI_OUT + BGI_GU + BGI_D) { conv_wave_item(F, ws, I_IN + t * 8 + F.wave, 0, scr); return; }
    t -= BGI_OUT + BGI_GU + BGI_D;
    if (t < BGI_GV1) { gemv_item(F, ws, 512 + t); return; }
    t -= BGI_GV1;
    conv_wave_item(F, ws, t * 8 + F.wave, 1, scr);
}
__device__ __forceinline__ void bg_fill(const Frame& F0, int seam, int need) {
    unsigned char* const ws = opq(F0.ws); Frame F = F0; F.tid = opq_tid(); F.lane = F.tid & 63; F.lds = opq(F0.lds);
    LAS unsigned* slot = (LAS unsigned*)(F.lds + AUX_OFF + 24576);
    gu32* ticket = F.ctl + CW_BGT; gu32* arr = F.ctl + CW_ARR + 64 * seam;
    unsigned tn = 0xffffffffu; bool pre = false;
    if (F.tid == 0 && slot[1] == 0u) { (void)__hip_atomic_fetch_add(arr, 1u, RLX_AGENT); const unsigned cur = __hip_atomic_load(ticket, RLX_AGENT);
        if (cur >= (unsigned)BG_C7) slot[1] = 1u;
        else if (cur < (unsigned)need || __hip_atomic_load(arr, RLX_AGENT) < (unsigned)F.G) tn = __hip_atomic_fetch_add(ticket, 1u, RLX_AGENT); }
    for (;;) {
        if (F.tid == 0) slot[0] = tn;
        __syncthreads();
        const unsigned t = __builtin_amdgcn_readfirstlane(slot[0]);
        __syncthreads();
        if (t >= (unsigned)BG_C7) { if (F.tid == 0 && t != 0xffffffffu) slot[1] = 1u; break; }
        if (F.tid == 0) { tn = 0xffffffffu; pre = (t + 2u < (unsigned)need);
            if (pre) tn = __hip_atomic_fetch_add(ticket, 1u, RLX_AGENT); }
        bg_item(F, ws, (int)t);
        if (F.tid == 0 && !pre) { if (t + 1u < (unsigned)need || __hip_atomic_load(arr, RLX_AGENT) < (unsigned)F.G) tn = __hip_atomic_fetch_add(ticket, 1u, RLX_AGENT); }
    }
}
__device__ __forceinline__ void p0_prologue(const Frame& F0) {
    unsigned char* const ws = opq(F0.ws); Frame F = F0; F.tid = opq_tid(); F.lane = F.tid & 63; F.lds = opq(F0.lds);
    for (int w = F.vcu; w < GV_FIRST * 4; w += F.G) gemv_item(F, ws, w);
    const float* const a_ws_ = karg(7);
    for (int i = (F.vcu * NTHR + F.tid) * 2; i < NLAYER * 4 * 128 * 128; i += F.G * NTHR * 2) {
        const int t = (i >> 7) & 127, s = i & 127;
        const f32x2 w = *(const GAS f32x2*)(a_ws_ + i);
        const bool keep = (s >> 6) <= (t >> 6);
        *(GAS unsigned*)((bf16*)(ws + WS_WM) + i) = keep ? cvt_pk_bf16(w.x, w.y) : 0u;
    }
}

template <int MODE>
__device__ __forceinline__ void phase_norm1(const Frame& F0, int l, const float* xin, float* xout, int lprev) {
    unsigned char* const ws = opq(F0.ws); Frame F = F0; F.tid = opq_tid(); F.lane = F.tid & 63; F.lds = opq(F0.lds);
    LAS float* wfT = (LAS float*)F.lds;
    LAS float* gaL = (LAS float*)(F.lds + 65536);
    LAS float* gbL = (LAS float*)(F.lds + 73728);
    LAS float* g2L = (LAS float*)(F.lds + 81920);
    LAS float* lf = (LAS float*)(F.lds + 90112);
    LAS int* hb = (LAS int*)(F.lds + 91136);
    const float* const b_ada_ = karg(3); const float* const c_bf_ = karg(14);
    if (MODE != 2) {
        const float* const w_in_ = karg(6); const float* const g_mix_ = karg(4);
        for (int i = F.tid; i < DM * 2; i += NTHR) { const int d = i >> 1, half = i & 1;
            const f32x4 w = *(const GAS f32x4*)(w_in_ + (size_t)l * DM * NIN + (size_t)d * NIN + NZ + half * 4);
            wfT[(half * 4 + 0) * DM + d] = w.x; wfT[(half * 4 + 1) * DM + d] = w.y; wfT[(half * 4 + 2) * DM + d] = w.z; wfT[(half * 4 + 3) * DM + d] = w.w; }
        for (int d = F.tid; d < DM; d += NTHR) { gaL[d] = *(const GAS float*)(g_mix_ + (size_t)l * DM + d) * (1.f + mod_at(ws, b_ada_, l, DM + d)); gbL[d] = mod_at(ws, b_ada_, l, d); }
    }
    if (MODE != 0) {
        for (int d = F.tid; d < DM; d += NTHR) g2L[d] = mod_at(ws, b_ada_, lprev, 5 * DM + d);
        if (F.tid == 0) { int a = 0; for (int e = 0; e < NEXP; ++e) { hb[e] = a; a += ((int)__hip_atomic_load(F.ctl + CW_CNT + 64 * lprev + e, RLX_AGENT) + 255) & ~255; } }
    }
    __syncthreads();
    const bf16* YB = (const bf16*)(ws + WS_YB);
    for (int c = F.vcu; c < SEQ / 32; c += F.G) {
        for (int rr = 0; rr < 4; ++rr) {
            const int rl = F.wave * 4 + rr, t = c * 32 + rl;
            f32x4 v[8];
#pragma unroll
            for (int j = 0; j < 8; ++j) v[j] = *(const GAS f32x4*)(xin + (size_t)t * DM + 256 * j + 4 * F.lane);
            if (MODE != 0) {
                const int* te = (const int*)(ws + WS_TOKE) + 2 * t; const int* tp = (const int*)(ws + WS_TOKP) + 2 * t; const float* tw = (const float*)(ws + WS_TOKW) + 2 * t;
                const int r0 = hb[*(const GAS int*)te] + *(const GAS int*)tp, r1 = hb[*(const GAS int*)(te + 1)] + *(const GAS int*)(tp + 1); const float w0 = *(const GAS float*)tw, w1 = *(const GAS float*)(tw + 1);
#pragma unroll 2
                for (int j = 0; j < 8; ++j) { const int d = 256 * j + 4 * F.lane;
                    const u32x2 y0 = *(const GAS u32x2*)(YB + (size_t)r0 * DM + d), y1 = *(const GAS u32x2*)(YB + (size_t)r1 * DM + d);
                    const f32x4 g2 = *(const LAS f32x4*)(g2L + d);
                    f32x4 y; y.x = w0 * bf_lo(y0.x) + w1 * bf_lo(y1.x); y.y = w0 * bf_hi(y0.x) + w1 * bf_hi(y1.x); y.z = w0 * bf_lo(y0.y) + w1 * bf_lo(y1.y); y.w = w0 * bf_hi(y0.y) + w1 * bf_hi(y1.y);
                    v[j] = v[j] + g2 * y;
                    *(GAS f32x4*)(xout + (size_t)t * DM + d) = v[j]; }
            }
            if (MODE != 2) {
                float ss = 0.f;
#pragma unroll
                for (int j = 0; j < 8; ++j) ss += (v[j].x * v[j].x + v[j].y * v[j].y) + (v[j].z * v[j].z + v[j].w * v[j].w);
                const float rs = rsqrtf(wave_sum(ss) * (1.f / DM) + EPSN);
                float fz[8] = {0.f, 0.f, 0.f, 0.f, 0.f, 0.f, 0.f, 0.f};
                bf16* hrow = (bf16*)(ws + WS_H) + (size_t)t * DM;
#pragma unroll 2
                for (int j = 0; j < 8; ++j) { const int d = 256 * j + 4 * F.lane;
                    const f32x4 h = v[j] * rs * *(const LAS f32x4*)(gaL + d) + *(const LAS f32x4*)(gbL + d);
                    u32x2 o; o.x = cvt_pk_bf16(h.x, h.y); o.y = cvt_pk_bf16(h.z, h.w);
                    *(GAS u32x2*)(hrow + d) = o;
#pragma unroll
                    for (int q = 0; q < 8; ++q) { const f32x4 w = *(const LAS f32x4*)(wfT + q * DM + d); fz[q] += (h.x * w.x + h.y * w.y) + (h.z * w.z + h.w * w.w); } }
#pragma unroll
                for (int q = 0; q < 8; ++q) fz[q] = wave_sum(fz[q]);
                if (F.lane < 8) { float z = fz[0];
#pragma unroll
                    for (int q = 1; q < 8; ++q) z = (F.lane == q) ? fz[q] : z;
                    z += *(const GAS float*)(c_bf_ + l * 8 + F.lane);
                    lf[rl * 8 + F.lane] = fminf(z, 0.f) - log1pf(__expf(-fabsf(z))); }
            }
        }
        if (MODE != 2) {
            __syncthreads();
            if (F.tid < 8) { float a = 0.f; float* floc = (float*)(ws + WS_FLOC);
                for (int r = 0; r < 32; ++r) { a += lf[r * 8 + F.tid]; *(GAS float*)(floc + (size_t)(c * 32 + r) * 8 + F.tid) = a; }
                *(GAS float*)((float*)(ws + WS_TOT) + c * 8 + F.tid) = a; }
            __syncthreads();
        }
    }
}

__device__ __forceinline__ void phase_prep(const Frame& F0, int l) {
    unsigned char* const ws = opq(F0.ws); Frame F = F0; F.tid = opq_tid(); F.lane = F.tid & 63; F.lds = opq(F0.lds);
    LAS float* pre = (LAS float*)F.lds;
    {
        const float* tot = (const float*)(ws + WS_TOT);
        const int h = F.wave; double v0 = *(const GAS float*)(tot + (4 * F.lane + 0) * 8 + h), v1 = *(const GAS float*)(tot + (4 * F.lane + 1) * 8 + h), v2 = *(const GAS float*)(tot + (4 * F.lane + 2) * 8 + h), v3 = *(const GAS float*)(tot + (4 * F.lane + 3) * 8 + h);
        double s = v0 + v1 + v2 + v3, inc = s;
#pragma unroll
        for (int o = 1; o < 64; o <<= 1) { const double u = __shfl_up(inc, o); if (F.lane >= o) inc += u; }
        const double ex = inc - s;
        pre[h * 256 + 4 * F.lane + 0] = (float)ex; pre[h * 256 + 4 * F.lane + 1] = (float)(ex + v0); pre[h * 256 + 4 * F.lane + 2] = (float)(ex + v0 + v1); pre[h * 256 + 4 * F.lane + 3] = (float)(ex + v0 + v1 + v2);
    }
    __syncthreads();
    const bf16* Z = (const bf16*)(ws + WS_Z);
    float qg[16], kg[16], vg[8]; const float* const c_qg_ = karg(12); const float* const c_kg_ = karg(13); const float* const a_vg_ = karg(9);
#pragma unroll
    for (int i = 0; i < 16; ++i) { qg[i] = *(const GAS float*)(c_qg_ + l * 128 + (F.lane & 7) * 16 + i); kg[i] = *(const GAS float*)(c_kg_ + l * 128 + (F.lane & 7) * 16 + i); }
#pragma unroll
    for (int i = 0; i < 8; ++i) vg[i] = *(const GAS float*)(a_vg_ + l * 512 + F.lane * 8 + i);
    const int gw = F.vcu * NWAVES + F.wave, NGW = F.G * NWAVES;
    for (int t = gw; t < SEQ; t += NGW) {
        const bf16* zr = Z + (size_t)t * NZ;
#pragma unroll
        for (int which = 0; which < 2; ++which) {
            const u32x4 a = *(const GAS u32x4*)(zr + 1536 + which * 1024 + 16 * F.lane), b = *(const GAS u32x4*)(zr + 1536 + which * 1024 + 16 * F.lane + 8);
            float f[16]; f[0] = bf_lo(a.x); f[1] = bf_hi(a.x); f[2] = bf_lo(a.y); f[3] = bf_hi(a.y); f[4] = bf_lo(a.z); f[5] = bf_hi(a.z); f[6] = bf_lo(a.w); f[7] = bf_hi(a.w);
            f[8] = bf_lo(b.x); f[9] = bf_hi(b.x); f[10] = bf_lo(b.y); f[11] = bf_hi(b.y); f[12] = bf_lo(b.z); f[13] = bf_hi(b.z); f[14] = bf_lo(b.w); f[15] = bf_hi(b.w);
            float ss = 0.f;
#pragma unroll
            for (int i = 0; i < 16; ++i) ss += f[i] * f[i];
            ss += __shfl_xor(ss, 1); ss += __shfl_xor(ss, 2); ss += __shfl_xor(ss, 4);
            const float rs = rsqrtf(ss * (1.f / 128.f) + EPSN);
            u32x4 o0, o1;
#define QK_G(i) ((which ? kg[i] : qg[i]) * rs * f[i])
            o0.x = cvt_pk_bf16(QK_G(0), QK_G(1)); o0.y = cvt_pk_bf16(QK_G(2), QK_G(3)); o0.z = cvt_pk_bf16(QK_G(4), QK_G(5)); o0.w = cvt_pk_bf16(QK_G(6), QK_G(7));
            o1.x = cvt_pk_bf16(QK_G(8), QK_G(9)); o1.y = cvt_pk_bf16(QK_G(10), QK_G(11)); o1.z = cvt_pk_bf16(QK_G(12), QK_G(13)); o1.w = cvt_pk_bf16(QK_G(14), QK_G(15));
#undef QK_G
            bf16* dst = (bf16*)(ws + (which ? WS_KN : WS_QN)) + ((size_t)(F.lane >> 3) * SEQ + t) * 128 + (F.lane & 7) * 16;
            *(GAS u32x4*)dst = o0; *(GAS u32x4*)(dst + 8) = o1;
        }
        {
            const u32x4 a = *(const GAS u32x4*)(zr + 512 + 8 * F.lane);
            float f[8]; f[0] = bf_lo(a.x); f[1] = bf_hi(a.x); f[2] = bf_lo(a.y); f[3] = bf_hi(a.y); f[4] = bf_lo(a.z); f[5] = bf_hi(a.z); f[6] = bf_lo(a.w); f[7] = bf_hi(a.w);
            float ss = 0.f;
#pragma unroll
            for (int i = 0; i < 8; ++i) ss += f[i] * f[i];
            ss += __shfl_xor(ss, 1); ss += __shfl_xor(ss, 2); ss += __shfl_xor(ss, 4); ss += __shfl_xor(ss, 8);
            const float rs = rsqrtf(ss * (1.f / 128.f) + EPSN);
            u32x4 o; o.x = cvt_pk_bf16(f[0] * rs * vg[0], f[1] * rs * vg[1]); o.y = cvt_pk_bf16(f[2] * rs * vg[2], f[3] * rs * vg[3]); o.z = cvt_pk_bf16(f[4] * rs * vg[4], f[5] * rs * vg[5]); o.w = cvt_pk_bf16(f[6] * rs * vg[6], f[7] * rs * vg[7]);
            *(GAS u32x4*)((bf16*)(ws + WS_VN) + (size_t)t * 512 + 8 * F.lane) = o;
        }
        {
            const int w = 2 << (F.lane >> 4);
            const u32x4 a = *(const GAS u32x4*)(zr + 1024 + 8 * F.lane);
            float p[8]; p[0] = bf_lo(a.x); p[1] = bf_hi(a.x); p[2] = bf_lo(a.y); p[3] = bf_hi(a.y); p[4] = bf_lo(a.z); p[5] = bf_hi(a.z); p[6] = bf_lo(a.w); p[7] = bf_hi(a.w);
            float s[8];
#pragma unroll
            for (int i = 0; i < 8; ++i) s[i] = p[i];
            for (int j = 1; j < 16; ++j) { if (j < w && t - j >= 0) { const u32x4 b = *(const GAS u32x4*)(zr - (size_t)j * NZ + 1024 + 8 * F.lane);
                s[0] += bf_lo(b.x); s[1] += bf_hi(b.x); s[2] += bf_lo(b.y); s[3] += bf_hi(b.y); s[4] += bf_lo(b.z); s[5] += bf_hi(b.z); s[6] += bf_lo(b.w); s[7] += bf_hi(b.w); } }
            const float ic = 1.f / (float)((t + 1 < w) ? (t + 1) : w);
            u32x4 o; o.x = cvt_pk_bf16(s[0] * ic - p[0], s[1] * ic - p[1]); o.y = cvt_pk_bf16(s[2] * ic - p[2], s[3] * ic - p[3]); o.z = cvt_pk_bf16(s[4] * ic - p[4], s[5] * ic - p[5]); o.w = cvt_pk_bf16(s[6] * ic - p[6], s[7] * ic - p[7]);
            *(GAS u32x4*)((bf16*)(ws + WS_DP) + (size_t)t * 512 + 8 * F.lane) = o;
        }
        if (F.lane < 8) *(GAS float*)((float*)(ws + WS_FKL) + (size_t)F.lane * SEQ + t) = (pre[F.lane * 256 + (t >> 5)] + *(const GAS float*)((const float*)(ws + WS_FLOC) + (size_t)t * 8 + F.lane)) * -11.313708498984761f;
    }
}

__device__ __forceinline__ void phase_small_item(const Frame& F0, int l, int item) {
    unsigned char* const ws = opq(F0.ws); Frame F = F0; F.tid = opq_tid(); F.lane = F.tid & 63; F.lds = opq(F0.lds);
    const int fr = F.lane & 15, fq = F.lane >> 4, w = F.wave;
    const bf16* Z = (const bf16*)(ws + WS_Z); bf16* YC = (bf16*)(ws + WS_YCAT);
    f32x4 acc[8];
#pragma unroll
    for (int m = 0; m < 8; ++m) acc[m] = (f32x4){0.f, 0.f, 0.f, 0.f};
    const float* a_bs_ = opq(karg(8)); const float* b_scale_ = opq(karg(11));
    if (item < 256) {
        const int blk = item >> 2, h = item & 3;
        const bf16* VN = (const bf16*)(ws + WS_VN) + (size_t)(blk * 128) * 512 + h * 128 + 16 * w + fr;
        const bf16* WM = (const bf16*)(ws + WS_WM) + ((size_t)(l * 4 + h) * 128) * 128;
        bf16x8 yb[4];
#pragma unroll
        for (int ks = 0; ks < 4; ++ks)
#pragma unroll
            for (int j = 0; j < 8; ++j) yb[ks][j] = (short)*(const GAS bf16*)(VN + (size_t)(ks * 32 + 8 * fq + j) * 512);
#pragma unroll
        for (int m = 0; m < 8; ++m)
#pragma unroll
            for (int ks = 0; ks < 4; ++ks) { const bf16x8 xa = *(const GAS bf16x8*)(WM + (size_t)(16 * m + fr) * 128 + ks * 32 + 8 * fq);
                acc[m] = __builtin_amdgcn_mfma_f32_16x16x32_bf16(yb[ks], xa, acc[m], 0, 0, 0); }
#pragma unroll
        for (int m = 0; m < 8; ++m) { const int tl = 16 * m + fr, t = blk * 128 + tl, col = h * 128 + 16 * w + 4 * fq;
            const float bsv = *(const GAS float*)(a_bs_ + l * 512 + h * 128 + tl);
            const u32x2 u = *(const GAS u32x2*)(Z + (size_t)t * NZ + col);
            u32x2 o; o.x = cvt_pk_bf16(bf_lo(u.x) * (acc[m][0] + bsv), bf_hi(u.x) * (acc[m][1] + bsv)); o.y = cvt_pk_bf16(bf_lo(u.y) * (acc[m][2] + bsv), bf_hi(u.y) * (acc[m][3] + bsv));
            *(GAS u32x2*)(YC + (size_t)t * DM + col) = o; }
    } else {
        const int rb = (item - 256) >> 2, g = (item - 256) & 3;
        const bf16* DP = (const bf16*)(ws + WS_DP) + (size_t)(rb * 128) * 512 + g * 128;
        const bf16* BWT = (const bf16*)(ws + WS_BWT) + ((size_t)(l * 4 + g) * 128) * 128;
        bf16x8 yb[4];
#pragma unroll
        for (int ks = 0; ks < 4; ++ks) yb[ks] = *(const GAS bf16x8*)(BWT + (size_t)(16 * w + fr) * 128 + ks * 32 + 8 * fq);
#pragma unroll
        for (int m = 0; m < 8; ++m)
#pragma unroll
            for (int ks = 0; ks < 4; ++ks) { const bf16x8 xa = *(const GAS bf16x8*)(DP + (size_t)(16 * m + fr) * 512 + ks * 32 + 8 * fq);
                acc[m] = __builtin_amdgcn_mfma_f32_16x16x32_bf16(yb[ks], xa, acc[m], 0, 0, 0); }
        const f32x4 bsc = *(const GAS f32x4*)(b_scale_ + l * 512 + g * 128 + 16 * w + 4 * fq);
#pragma unroll
        for (int m = 0; m < 8; ++m) { const int t = rb * 128 + 16 * m + fr, col = 512 + g * 128 + 16 * w + 4 * fq;
            u32x2 o; o.x = cvt_pk_bf16(acc[m][0] * bsc.x, acc[m][1] * bsc.y); o.y = cvt_pk_bf16(acc[m][2] * bsc.z, acc[m][3] * bsc.w);
            *(GAS u32x2*)(YC + (size_t)t * DM + col) = o; }
    }
}

__device__ __forceinline__ void phase_norm2_route(const Frame& F0, int l) {
    unsigned char* const ws = opq(F0.ws); Frame F = F0; F.tid = opq_tid(); F.lane = F.tid & 63; F.lds = opq(F0.lds);
    LAS float* wrT = (LAS float*)F.lds;
    LAS float* gaL = (LAS float*)(F.lds + AUX_OFF);
    LAS float* gbL = (LAS float*)(F.lds + AUX_OFF + 8192);
    LAS int* lcnt = (LAS int*)(F.lds + AUX_OFF + 16384);
    const float* const w_router_ = karg(16); const float* const g_ffn_ = karg(5); const float* const b_ada_ = karg(3); const float* const b_router_ = karg(17);
    for (int i = F.tid; i < DM * 4; i += NTHR) { const int d = i >> 2, q = i & 3;
        const f32x4 w = *(const GAS f32x4*)(w_router_ + (size_t)d * 16 + q * 4);
        wrT[(q * 4 + 0) * DM + d] = w.x; wrT[(q * 4 + 1) * DM + d] = w.y; wrT[(q * 4 + 2) * DM + d] = w.z; wrT[(q * 4 + 3) * DM + d] = w.w; }
    for (int d = F.tid; d < DM; d += NTHR) { gaL[d] = *(const GAS float*)(g_ffn_ + (size_t)l * DM + d) * (1.f + mod_at(ws, b_ada_, l, 4 * DM + d)); gbL[d] = mod_at(ws, b_ada_, l, 3 * DM + d); }
    const float* X1 = (const float*)(ws + WS_X1);
    for (int c = F.vcu; c < SEQ / 32; c += F.G) {
        if (F.tid < 32) lcnt[F.tid] = 0;
        __syncthreads();
        int my_e0 = 0, my_e1 = 0, my_r0 = 0, my_r1 = 0; float my_w0 = 0.f, my_w1 = 0.f;
        for (int rr = 0; rr < 4; ++rr) {
            const int t = c * 32 + F.wave * 4 + rr;
            f32x4 v[8]; float ss = 0.f;
#pragma unroll
            for (int j = 0; j < 8; ++j) { v[j] = *(const GAS f32x4*)(X1 + (size_t)t * DM + 256 * j + 4 * F.lane); ss += (v[j].x * v[j].x + v[j].y * v[j].y) + (v[j].z * v[j].z + v[j].w * v[j].w); }
            const float rs = rsqrtf(wave_sum(ss) * (1.f / DM) + EPSN);
            float lg[16];
#pragma unroll
            for (int e = 0; e < 16; ++e) lg[e] = 0.f;
            bf16* hrow = (bf16*)(ws + WS_H) + (size_t)t * DM;
#pragma unroll 2
            for (int j = 0; j < 8; ++j) { const int d = 256 * j + 4 * F.lane;
                const f32x4 h = v[j] * rs * *(const LAS f32x4*)(gaL + d) + *(const LAS f32x4*)(gbL + d);
                u32x2 o; o.x = cvt_pk_bf16(h.x, h.y); o.y = cvt_pk_bf16(h.z, h.w);
                *(GAS u32x2*)(hrow + d) = o;
#pragma unroll
                for (int e = 0; e < 16; ++e) { const f32x4 w = *(const LAS f32x4*)(wrT + e * DM + d); lg[e] += (h.x * w.x + h.y * w.y) + (h.z * w.z + h.w * w.w); } }
#pragma unroll
            for (int e = 0; e < 16; ++e) lg[e] = wave_sum(lg[e]);
            float sc[16], sel[16];
#pragma unroll
            for (int e = 0; e < 16; ++e) { sc[e] = 1.f / (1.f + __expf(-lg[e])); sel[e] = sc[e] + *(const GAS float*)(b_router_ + e); }
            int bg = 0; float bgs = -INFINITY;
#pragma unroll
            for (int g = 0; g < 4; ++g) { float a = -INFINITY, b = -INFINITY;
#pragma unroll
                for (int i = 0; i < 4; ++i) { const float x = sel[g * 4 + i]; if (x > a) { b = a; a = x; } else if (x > b) b = x; }
                if (a + b > bgs) { bgs = a + b; bg = g; } }
            int e0 = 0, e1 = 0; float a = -INFINITY, b = -INFINITY, s0 = 0.f, s1 = 0.f;
#pragma unroll
            for (int g = 0; g < 4; ++g)
#pragma unroll
                for (int i = 0; i < 4; ++i) { const int e = g * 4 + i; const float x = sel[e];
                    if (g == bg) { if (x > a) { b = a; e1 = e0; s1 = s0; a = x; e0 = e; s0 = sc[e]; } else if (x > b) { b = x; e1 = e; s1 = sc[e]; } } }
            const float inv = 1.f / (s0 + s1);
            if (F.lane == rr) { my_e0 = e0; my_e1 = e1; my_w0 = s0 * inv; my_w1 = s1 * inv; }
        }
        if (F.lane < 4) { my_r0 = __hip_atomic_fetch_add(&lcnt[my_e0], 1, __ATOMIC_RELAXED, __HIP_MEMORY_SCOPE_WORKGROUP); my_r1 = __hip_atomic_fetch_add(&lcnt[my_e1], 1, __ATOMIC_RELAXED, __HIP_MEMORY_SCOPE_WORKGROUP); }
        __syncthreads();
        if (F.tid < 16) lcnt[16 + F.tid] = (int)__hip_atomic_fetch_add(F.ctl + CW_CNT + 64 * l + F.tid, (unsigned)lcnt[F.tid], RLX_AGENT);
        __syncthreads();
        if (F.lane < 4) { const int t = c * 32 + F.wave * 4 + F.lane;
            const int p0 = lcnt[16 + my_e0] + my_r0, p1 = lcnt[16 + my_e1] + my_r1;
            int* list = (int*)(ws + WS_LIST);
            *(GAS int*)(list + my_e0 * SEQ + p0) = t; *(GAS int*)(list + my_e1 * SEQ + p1) = t;
            *(GAS int*)((int*)(ws + WS_TOKE) + 2 * t) = my_e0; *(GAS int*)((int*)(ws + WS_TOKE) + 2 * t + 1) = my_e1;
            *(GAS int*)((int*)(ws + WS_TOKP) + 2 * t) = p0; *(GAS int*)((int*)(ws + WS_TOKP) + 2 * t + 1) = p1;
            *(GAS float*)((float*)(ws + WS_TOKW) + 2 * t) = my_w0; *(GAS float*)((float*)(ws + WS_TOKW) + 2 * t + 1) = my_w1; }
        __syncthreads();
    }
}

struct MoeOrder {
    int G, c, total, K, nct; const char* Bt; size_t estride; const int* list; LAS int* tab;
    __device__ __forceinline__ bool next(int i, gm::Unit& u) const {
        const int L = i * G + c; if (L >= total) return false;
        const int q = L / nct, ct = L - q * nct;
        int e = 0;
#pragma unroll
        for (int k = 1; k < NEXP; ++k) e += (q >= tab[k]) ? 1 : 0;
        e = __builtin_amdgcn_readfirstlane(e);
        const int rt = q - __builtin_amdgcn_readfirstlane(tab[e]);
        u.e = e; u.rt = rt; u.arow = (__builtin_amdgcn_readfirstlane(tab[e]) + rt) * 256; u.orow = u.arow; u.ocol = ct * 256;
        u.Bp = Bt + (size_t)e * estride + (size_t)ct * 256 * K * 2; return true;
    }
    __device__ __forceinline__ int row_of(const gm::Unit& u, int r) const {
        const int p = u.rt * 256 + r, n = tab[32 + u.e], pc = p < n ? p : n - 1;
        const int v = *(const GAS int*)(list + u.e * SEQ + pc);
        return (p < n) ? v : 0;
    }
};
__device__ __forceinline__ void moe_table(Frame& F, int l, LAS int* tab) {
    __syncthreads();
    if (F.tid == 0) { int a = 0;
        for (int e = 0; e < NEXP; ++e) { const int n = (int)__hip_atomic_load(F.ctl + CW_CNT + 64 * l + e, RLX_AGENT); tab[e] = a; tab[32 + e] = n; a += (n + 255) >> 8; }
        tab[16] = a; }
    __syncthreads();
}

constexpr int ATT_CH = 16;
struct MixTab { LAS int* jlo; LAS int* items; LAS int* nitems; LAS float* fend; LAS int* scan; };
__device__ __forceinline__ MixTab mix_tab_ptrs(LAS unsigned char* lds) {
    MixTab T; T.jlo = (LAS int*)(lds + 69632); T.items = (LAS int*)(lds + 69632 + 1024); T.nitems = (LAS int*)(lds + 69632 + 1024 + 8192); T.fend = (LAS float*)(lds + 69632 + 1024 + 8192 + 64);
    T.scan = (LAS int*)(lds + 69632 + 1024 + 8192 + 64 + 4096); return T;
}
__device__ __forceinline__ void mix_build_table(const Frame& F0, int l, const MixTab& T) {
    unsigned char* const ws = opq(F0.ws); const int tid = opq_tid();
    const float* FKL = (const float*)(ws + WS_FKL);
    for (int i = tid; i < 1024; i += NTHR) T.fend[i] = *(const GAS float*)(FKL + (size_t)(i >> 7) * SEQ + (i & 127) * 64 + 63);
    float gq = 0.f, gk = 0.f; const float* const c_qg_ = karg(12); const float* const c_kg_ = karg(13);
    { const int ln = tid & 63; gq = fmaxf(fabsf(*(const GAS float*)(c_qg_ + l * 128 + ln)), fabsf(*(const GAS float*)(c_qg_ + l * 128 + 64 + ln))); gk = fmaxf(fabsf(*(const GAS float*)(c_kg_ + l * 128 + ln)), fabsf(*(const GAS float*)(c_kg_ + l * 128 + 64 + ln)));
#pragma unroll
      for (int o = 1; o < 64; o <<= 1) { gq = fmaxf(gq, __shfl_xor(gq, o)); gk = fmaxf(gk, __shfl_xor(gk, o)); } }
    const float thr = (2.f * 1.01f * 11.313708498984761f * gq * gk + 30.f) * 11.313708498984761f;
    __syncthreads();
    int nfull = 0, nrem = 0, jl = 0, nt = 0;
    if (tid < 256) { const int h = tid >> 5, qb = tid & 31; const float f0 = *(const GAS float*)(FKL + (size_t)h * SEQ + qb * 256);
        for (int j = 0; j < 4 * qb; ++j) jl += (T.fend[h * 128 + j] - f0 <= -thr) ? 1 : 0;
        nt = 4 * (qb + 1) - jl; nfull = nt / ATT_CH; nrem = (nt % ATT_CH) ? 1 : 0; T.jlo[tid] = jl | ((nfull + nrem) << 8); }
    if (tid < 256) { T.scan[tid] = nfull; T.scan[256 + tid] = nrem; }
    __syncthreads();
    for (int o = 1; o < 256; o <<= 1) { int a = 0, b = 0; if (tid < 256 && tid >= o) { a = T.scan[tid - o]; b = T.scan[256 + tid - o]; } __syncthreads();
        if (tid < 256) { T.scan[tid] += a; T.scan[256 + tid] += b; } __syncthreads(); }
    if (tid < 256) { const int totf = T.scan[255], pf = T.scan[tid] - nfull, pr = totf + T.scan[256 + tid] - nrem, jb = 4 * ((tid & 31) + 1);
        for (int c = 0; c < nfull; ++c) T.items[pf + c] = tid | (c << 8) | ((jb - (c + 1) * ATT_CH) << 12) | (ATT_CH << 20);
        if (nrem) T.items[pr] = tid | (nfull << 8) | (jl << 12) | ((nt - nfull * ATT_CH) << 20);
        if (tid == 255) T.nitems[0] = totf + T.scan[511]; }
    __syncthreads();
}
__device__ __forceinline__ void phase_attn_combine(const Frame& F0, int l, const MixTab& T) {
    unsigned char* const ws = opq(F0.ws); const int tid = opq_tid();
    const bf16* PART = (const bf16*)(ws + WS_PART); const float* MLb = (const float*)(ws + WS_ML); bf16* YC = (bf16*)(ws + WS_YCAT);
    for (int b = F0.vcu; b < 256; b += F0.G) {
        const int nch = __builtin_amdgcn_readfirstlane(T.jlo[b]) >> 8; if (nch <= 1) continue;
        const int h = b >> 5, qb = b & 31, row = tid >> 1, half = tid & 1;
        float m[8], w[8], mx = -3.0e38f, ws_ = 0.f;
#pragma unroll
        for (int c = 0; c < 8; ++c) { if (c < nch) { const f32x2 v = *(const GAS f32x2*)(MLb + ((size_t)(b * 8 + c) * 256 + row) * 2); m[c] = v.x; w[c] = v.y; mx = fmaxf(mx, v.x); } else { m[c] = -3.0e38f; w[c] = 0.f; } }
#pragma unroll
        for (int c = 0; c < 8; ++c) { w[c] = (c < nch) ? w[c] * __builtin_amdgcn_exp2f((m[c] - mx) * at::C2) : 0.f; ws_ += w[c]; }
        const float inv = 1.f / ws_;
        float acc[64];
#pragma unroll
        for (int i = 0; i < 64; ++i) acc[i] = 0.f;
#pragma unroll
        for (int c = 0; c < 8; ++c) { if (c < nch) { const bf16* p = PART + ((size_t)(b * 8 + c) * 256 + row) * 128 + half * 64; const float wc = w[c] * inv;
#pragma unroll
            for (int q = 0; q < 8; ++q) { const u32x4 v = *(const GAS u32x4*)(p + q * 8);
                acc[q * 8 + 0] += wc * bf_lo(v.x); acc[q * 8 + 1] += wc * bf_hi(v.x); acc[q * 8 + 2] += wc * bf_lo(v.y); acc[q * 8 + 3] += wc * bf_hi(v.y);
                acc[q * 8 + 4] += wc * bf_lo(v.z); acc[q * 8 + 5] += wc * bf_hi(v.z); acc[q * 8 + 6] += wc * bf_lo(v.w); acc[q * 8 + 7] += wc * bf_hi(v.w); } } }
        bf16* o = YC + (size_t)(qb * 256 + row) * DM + 1024 + h * 128 + half * 64;
#pragma unroll
        for (int q = 0; q < 8; ++q) { u32x4 v; v.x = cvt_pk_bf16(acc[q * 8 + 0], acc[q * 8 + 1]); v.y = cvt_pk_bf16(acc[q * 8 + 2], acc[q * 8 + 3]); v.z = cvt_pk_bf16(acc[q * 8 + 4], acc[q * 8 + 5]); v.w = cvt_pk_bf16(acc[q * 8 + 6], acc[q * 8 + 7]);
            *(GAS u32x4*)(o + q * 8) = v; }
    }
}
struct EpiZ {
    static constexpr bool PERM = true;
    bf16* O;
    __device__ __forceinline__ void operator()(const f32x4 (&acc)[2][2][4][2], const gm::Unit& u, int wr, int wc, int fr, int fq) const {
        const int row0 = u.orow + wr * 64 + fr, col0 = u.ocol + wc * 32 + 8 * fq; const bool act = u.ocol < 1024;
#pragma unroll
        for (int ai = 0; ai < 2; ++ai)
#pragma unroll
            for (int m = 0; m < 4; ++m) { bf16* rowp = O + (size_t)(row0 + ai * 128 + m * 16) * NZ + col0;
#pragma unroll
                for (int bj = 0; bj < 2; ++bj) { f32x4 v0 = acc[ai][bj][m][0], v1 = acc[ai][bj][m][1];
                    if (act) {
#pragma unroll
                        for (int j = 0; j < 4; ++j) { v0[j] = gelu_t(v0[j]); v1[j] = gelu_t(v1[j]); } }
                    u32x4 w; w.x = cvt_pk_bf16(v0[0], v0[1]); w.y = cvt_pk_bf16(v0[2], v0[3]); w.z = cvt_pk_bf16(v1[0], v1[1]); w.w = cvt_pk_bf16(v1[2], v1[3]);
                    *(GAS u32x4*)(rowp + bj * 128) = w; } }
    }
};
struct EpiRes {
    static constexpr bool PERM = false;
    const float* xin; const LAS float* gate; float* out;
    __device__ __forceinline__ void operator()(const f32x4 (&acc)[2][2][4][2], const gm::Unit& u, int wr, int wc, int fr, int fq) const {
        const int row0 = u.orow + wr * 64 + fr, col0 = u.ocol + wc * 32 + 4 * fq;
        f32x4 gv[2][2];
#pragma unroll
        for (int bj = 0; bj < 2; ++bj)
#pragma unroll
            for (int n = 0; n < 2; ++n) gv[bj][n] = *(const LAS f32x4*)(gate + col0 + bj * 128 + n * 16);
#pragma unroll
        for (int ai = 0; ai < 2; ++ai)
#pragma unroll
            for (int m = 0; m < 4; ++m) { const size_t off = (size_t)(row0 + ai * 128 + m * 16) * DM + col0;
#pragma unroll
                for (int bj = 0; bj < 2; ++bj)
#pragma unroll
                    for (int n = 0; n < 2; ++n) { const f32x4 xv = *(const GAS f32x4*)(xin + off + bj * 128 + n * 16);
                        *(GAS f32x4*)(out + off + bj * 128 + n * 16) = xv + gv[bj][n] * acc[ai][bj][m][n]; } }
    }
};
struct EpiHid {
    static constexpr bool PERM = true;
    bf16* O;
    __device__ __forceinline__ void operator()(const f32x4 (&acc)[2][2][4][2], const gm::Unit& u, int wr, int wc, int fr, int fq) const {
        const int row0 = u.orow + wr * 64 + fr, col0 = (u.ocol >> 1) + wc * 32 + 8 * fq;
#pragma unroll
        for (int ai = 0; ai < 2; ++ai)
#pragma unroll
            for (int m = 0; m < 4; ++m) { bf16* rowp = O + (size_t)(row0 + ai * 128 + m * 16) * DEX + col0;
                f32x4 h0, h1;
#pragma unroll
                for (int j = 0; j < 4; ++j) { h0[j] = silu_f(acc[ai][0][m][0][j]) * acc[ai][1][m][0][j]; h1[j] = silu_f(acc[ai][0][m][1][j]) * acc[ai][1][m][1][j]; }
                u32x4 w; w.x = cvt_pk_bf16(h0[0], h0[1]); w.y = cvt_pk_bf16(h0[2], h0[3]); w.z = cvt_pk_bf16(h1[0], h1[1]); w.w = cvt_pk_bf16(h1[2], h1[3]);
                *(GAS u32x4*)rowp = w; }
    }
};
struct EpiYB {
    static constexpr bool PERM = true;
    bf16* O;
    __device__ __forceinline__ void operator()(const f32x4 (&acc)[2][2][4][2], const gm::Unit& u, int wr, int wc, int fr, int fq) const {
        const int row0 = u.orow + wr * 64 + fr, col0 = u.ocol + wc * 32 + 8 * fq;
#pragma unroll
        for (int ai = 0; ai < 2; ++ai)
#pragma unroll
            for (int m = 0; m < 4; ++m) { bf16* rowp = O + (size_t)(row0 + ai * 128 + m * 16) * DM + col0;
#pragma unroll
                for (int bj = 0; bj < 2; ++bj) { const f32x4 v0 = acc[ai][bj][m][0], v1 = acc[ai][bj][m][1];
                    u32x4 w; w.x = cvt_pk_bf16(v0[0], v0[1]); w.y = cvt_pk_bf16(v0[2], v0[3]); w.z = cvt_pk_bf16(v1[0], v1[1]); w.w = cvt_pk_bf16(v1[2], v1[3]);
                    *(GAS u32x4*)(rowp + bj * 128) = w; } }
    }
};

__device__ __forceinline__ int bg_need(int p) {
    if (p <= 1) return 0;
    if (p <= 5) return BG_C0;
    if (p <= 7) return BG_C1;
    if (p == 8) return BG_C2;
    if (p == 9) return BG_C3;
    if (p == 10) return BG_C3B;
    if (p <= 14) return BG_C4;
    if (p <= 16) return BG_C5;
    if (p == 17) return BG_C6;
    return BG_C7;
}
__device__ __forceinline__ bool bg_seam(int k) { if (k == 0) return true; const int j = (k - 1) % 9; return j != 2 && j != 5; }
struct Args { const float* in[21]; float* out; unsigned char* ws; int ph_lo, ph_hi; };
constexpr int N_PHASES = 1 + 9 * NLAYER + 1;

__global__ void __launch_bounds__(NTHR, 2) mk_fwd(Args args) {
    extern __shared__ __attribute__((aligned(16))) unsigned char lds[];
    Frame F;
    F.lds = (LAS unsigned char*)lds; F.MISC = (volatile LAS unsigned*)(F.lds + MISC_OFF);
    F.tid = threadIdx.x; F.lane = F.tid & 63; F.wave = __builtin_amdgcn_readfirstlane(F.tid >> 6);
    F.G = gridDim.x; { const int bx = blockIdx.x; F.vcu = (F.G % 8 == 0) ? (bx % 8) * (F.G / 8) + bx / 8 : bx; }
    F.ws = args.ws; F.ctl = (gu32*)(args.ws + WS_CTL);
    for (int u = F.tid; u < (LDS_BYTES - RING_BYTES) / 4; u += NTHR) ((LAS unsigned*)(F.lds + RING_BYTES))[u] = 0u;
    __syncthreads();
    const int lo = args.ph_lo, hi = args.ph_hi;
    const bool multi = (hi - lo) > 1;
    XcdBarrier bar; bar.bar = (unsigned*)(F.ctl + CW_BAR); bar.x = 0; bar.st = nullptr;
    if (multi) bar = xcd_barrier_post((unsigned*)(F.ctl + CW_BAR), F.MISC + 8);
#ifdef MK_ONLY
#define IN(k) (((k) == 0 ? 0 : (((k) - 1) % 9) + 1) == MK_ONLY && lo <= (k) && (k) < hi)
#else
#define IN(k) (lo <= (k) && (k) < hi)
#endif
#ifndef MK_REPEAT
#define MK_REPEAT -1
#endif
#define REPS(kind) ((MK_REPEAT == (kind)) ? 2 : 1)
#define SEAM(k) do { if (IN(k)) { if (bg_seam(k)) bg_fill(F, (k), bg_need((k) + 1)); if (IN((k) + 1)) xcd_barrier(bar); } } while (0)

    for (int rep_ = 0; rep_ < REPS(0); ++rep_) if (IN(0)) { if (rep_) xcd_barrier(bar); p0_prologue(F); } SEAM(0);

    for (int l = 0; l < NLAYER; ++l) {
        const int pb = 1 + 9 * l;

        for (int rep_ = 0; rep_ < REPS(1); ++rep_) if (IN(pb)) { if (rep_) xcd_barrier(bar); unsigned char* const wsl = opq(F.ws); LAS unsigned char* const ldl = opq(F.lds); if (l == 0) phase_norm1<0>(F, l, karg(0), nullptr, 0); else phase_norm1<1>(F, l, (const float*)(wsl + WS_X1), (float*)(wsl + WS_X2), l - 1); }
        SEAM(pb);
        for (int rep_ = 0; rep_ < REPS(2); ++rep_) if (IN(pb + 1)) { if (rep_) xcd_barrier(bar); unsigned char* const wsl = opq(F.ws); LAS unsigned char* const ldl = opq(F.lds); gm::RegOrder S; S.init(SEQ, NZ, DM, wsl + WS_WIN + (size_t)l * NZ * DM * 2, F.G, (int)blockIdx.x);
            EpiZ E{(bf16*)(wsl + WS_Z)};
            gm::gemm_phase<EpiZ, gm::RegOrder, false, true>(ldl, (const char*)(wsl + WS_H), DM, S, E); }
        SEAM(pb + 1);
        for (int rep_ = 0; rep_ < REPS(3); ++rep_) if (IN(pb + 2)) { if (rep_) xcd_barrier(bar); unsigned char* const wsl = opq(F.ws); LAS unsigned char* const ldl = opq(F.lds); phase_prep(F, l); }
        SEAM(pb + 2);
        for (int rep_ = 0; rep_ < REPS(4); ++rep_) if (IN(pb + 3)) { if (rep_) xcd_barrier(bar); unsigned char* const wsl = opq(F.ws); LAS unsigned char* const ldl = opq(F.lds);
            const MixTab T = mix_tab_ptrs(ldl);
            mix_build_table(F, l, T);
            const int natt = __builtin_amdgcn_readfirstlane(T.nitems[0]), ntot = natt + 512;
            LAS int* qslot = T.nitems + 1;
            int it = F.vcu;
            while (it < ntot) {
                if (it >= natt) { phase_small_item(F, l, it - natt); }
                else {
                    const int rec = __builtin_amdgcn_readfirstlane(T.items[it]), b = rec & 255, c = (rec >> 8) & 15, ja = (rec >> 12) & 255, n = (rec >> 20) & 31, h = b >> 5, qb = b & 31;
                    const bool fin = (__builtin_amdgcn_readfirstlane(T.jlo[b]) >> 8) <= 1; unsigned char* const ws = opq(wsl);
                    at::BlockRef cur;
                    cur.Q = (const bf16*)(ws + WS_QN) + ((size_t)h * SEQ + qb * 256) * 128; cur.K = (const bf16*)(ws + WS_KN) + (size_t)h * SEQ * 128;
                    cur.V = (const bf16*)(ws + WS_Z) + 3584 + h * 128; cur.O = (bf16*)(ws + WS_YCAT) + (size_t)(qb * 256) * DM + 1024 + h * 128;
                    cur.FK = (const float*)(ws + WS_FKL) + (size_t)h * SEQ; cur.P0 = qb * 256;
                    at::attn_block(cur, ja, n, fin, (bf16*)(ws + WS_PART) + (size_t)(b * 8 + c) * 256 * 128, (float*)(ws + WS_ML) + (size_t)(b * 8 + c) * 256 * 2, (char*)ldl, ldl);
                }
                if (F.tid == 0) qslot[0] = F.G + (int)__hip_atomic_fetch_add(F.ctl + CW_Q + 64 * l + 32 * rep_, 1u, RLX_AGENT);
                __syncthreads();
                it = __builtin_amdgcn_readfirstlane(qslot[0]);
                __syncthreads();
            }
        }
        SEAM(pb + 3);
        for (int rep_ = 0; rep_ < REPS(5); ++rep_) if (IN(pb + 4)) { if (rep_) xcd_barrier(bar); unsigned char* const wsl = opq(F.ws); LAS unsigned char* const ldl = opq(F.lds); const MixTab T = mix_tab_ptrs(ldl); mix_build_table(F, l, T); phase_attn_combine(F, l, T); }
        SEAM(pb + 4);
        for (int rep_ = 0; rep_ < REPS(6); ++rep_) if (IN(pb + 5)) { if (rep_) xcd_barrier(bar); unsigned char* const wsl = opq(F.ws); LAS unsigned char* const ldl = opq(F.lds); gm::RegOrder S; S.init(SEQ, DM, DM, wsl + WS_WOUT + (size_t)l * DM * DM * 2, F.G, (int)blockIdx.x);
            LAS float* g1L = (LAS float*)(ldl + AUX_OFF);
            { const float* const b_ada_ = karg(3); for (int d = opq_tid(); d < DM; d += NTHR) g1L[d] = mod_at(wsl, b_ada_, l, 2 * DM + d); }
            __syncthreads();
            EpiRes E{(l == 0) ? karg(0) : (const float*)(wsl + WS_X2), g1L, (float*)(wsl + WS_X1)};
            gm::gemm_phase<EpiRes, gm::RegOrder, false, true>(ldl, (const char*)(wsl + WS_YCAT), DM, S, E); }
        SEAM(pb + 5);
        for (int rep_ = 0; rep_ < REPS(7); ++rep_) if (IN(pb + 6)) { if (rep_) xcd_barrier(bar); unsigned char* const wsl = opq(F.ws); LAS unsigned char* const ldl = opq(F.lds); phase_norm2_route(F, l); }
        SEAM(pb + 6);
        for (int rep_ = 0; rep_ < REPS(8); ++rep_) if (IN(pb + 7)) { if (rep_) xcd_barrier(bar); unsigned char* const wsl = opq(F.ws); LAS unsigned char* const ldl = opq(F.lds); LAS int* tab = (LAS int*)(ldl + AUX_OFF + 20480); moe_table(F, l, tab);
            MoeOrder S; S.G = F.G; S.c = F.vcu; S.total = 8 * tab[16]; S.K = DM; S.nct = 8; S.Bt = (const char*)(wsl + WS_WGU) + (size_t)l * NEXP * DM * DM * 2; S.estride = (size_t)DM * DM * 2;
            S.list = (const int*)(wsl + WS_LIST); S.tab = tab;
            EpiHid E{(bf16*)(wsl + WS_HID)};
            gm::gemm_phase<EpiHid, MoeOrder, true, true>(ldl, (const char*)(wsl + WS_H), DM, S, E); }
        SEAM(pb + 7);
        for (int rep_ = 0; rep_ < REPS(9); ++rep_) if (IN(pb + 8)) { if (rep_) xcd_barrier(bar); unsigned char* const wsl = opq(F.ws); LAS unsigned char* const ldl = opq(F.lds); LAS int* tab = (LAS int*)(ldl + AUX_OFF + 20480); moe_table(F, l, tab);
            MoeOrder S; S.G = F.G; S.c = F.vcu; S.total = 8 * tab[16]; S.K = DEX; S.nct = 8; S.Bt = (const char*)(wsl + WS_WD) + (size_t)l * NEXP * DM * DEX * 2; S.estride = (size_t)DM * DEX * 2;
            S.list = (const int*)(wsl + WS_LIST); S.tab = tab;
            EpiYB E{(bf16*)(wsl + WS_YB)};
            gm::gemm_phase<EpiYB, MoeOrder, false, true>(ldl, (const char*)(wsl + WS_HID), DEX, S, E); }
        SEAM(pb + 8);
    }
    for (int rep_ = 0; rep_ < REPS(10); ++rep_) if (IN(N_PHASES - 1)) { if (rep_) xcd_barrier(bar); phase_norm1<2>(F, NLAYER - 1, (const float*)(F.ws + WS_X1), (float*)karg(21), NLAYER - 1); }
#undef IN
#undef SEAM
}

#ifndef MK_LAUNCHES
#define MK_LAUNCHES 1
#endif
extern "C" void kernel_launch(void* const* d_in, const int* in_sizes, int n_in, void* d_out, int out_size, void* d_ws, size_t ws_size, hipStream_t stream) {
    static int grid = 0;
    if (grid == 0) {
        int dev = 0, cus = 0, per_cu = 0;
        if (n_in != 21 || ws_size < WS_END) { fprintf(stderr, "kernel_launch: unexpected inputs (n_in %d, ws %zu)\n", n_in, ws_size); grid = -1; return; }
        if (hipGetDevice(&dev) != hipSuccess || hipDeviceGetAttribute(&cus, hipDeviceAttributeMultiprocessorCount, dev) != hipSuccess) { grid = -1; return; }
        if (hipFuncSetAttribute((const void*)mk_fwd, hipFuncAttributeMaxDynamicSharedMemorySize, LDS_BYTES) != hipSuccess) { fprintf(stderr, "kernel_launch: hipFuncSetAttribute failed\n"); grid = -1; return; }
        if (hipOccupancyMaxActiveBlocksPerMultiprocessor(&per_cu, (const void*)mk_fwd, NTHR, LDS_BYTES) != hipSuccess || per_cu < 1) fprintf(stderr, "kernel_launch: occupancy query says %d\n", per_cu);
        (void)hipGetLastError();
        grid = cus;
    }
    if (grid < 0) return;
    (void)hipMemsetAsync((char*)d_ws + WS_CTL, 0, CTL_ZERO_BYTES, stream);
    Args a{};
    for (int i = 0; i < 21; ++i) a.in[i] = (const float*)d_in[i];
    a.out = (float*)d_out; a.ws = (unsigned char*)d_ws;
#if MK_LAUNCHES == 1
    a.ph_lo = 0; a.ph_hi = N_PHASES;
    hipLaunchKernelGGL(mk_fwd, dim3(grid), dim3(NTHR), LDS_BYTES, stream, a);
#else
    for (int p = 0; p < N_PHASES; ++p) { a.ph_lo = p; a.ph_hi = p + 1; hipLaunchKernelGGL(mk_fwd, dim3(grid), dim3(NTHR), LDS_BYTES, stream, a); }
#endif
}
```

```cpp
#include <hip/hip_runtime.h>
#include <stdint.h>
#include <stdio.h>

#define GAS __attribute__((address_space(1)))
#define LAS __attribute__((address_space(3)))
typedef unsigned short bf16;
typedef short bf16x8 __attribute__((ext_vector_type(8)));
typedef short s16x4 __attribute__((ext_vector_type(4)));
typedef float f32x2 __attribute__((ext_vector_type(2)));
typedef float f32x4 __attribute__((ext_vector_type(4)));
typedef float f32x16 __attribute__((ext_vector_type(16)));
typedef unsigned u32x2 __attribute__((ext_vector_type(2)));
typedef unsigned u32x4 __attribute__((ext_vector_type(4)));
typedef GAS unsigned gu32;
#define RLX_AGENT __ATOMIC_RELAXED, __HIP_MEMORY_SCOPE_AGENT
#define LDS_WAIT() asm volatile("s_waitcnt lgkmcnt(0)" ::: "memory")
#define VM_WAIT() asm volatile("s_waitcnt vmcnt(0)" ::: "memory")

constexpr int DM = 2048, SEQ = 8192, NIN = 4616, NZ = 4608, DEX = 1024, NEXP = 16, NLAYER = 2;
constexpr float EPSN = 1e-6f;
constexpr float LOG2E = 1.4426950408889634f;
constexpr int NWAVES = 8, NTHR = 512;
constexpr int HIDROWS = 2 * SEQ + NEXP * 256;

constexpr size_t KiB = 1024, MiB = 1u << 20;
constexpr size_t WS_CTL = 0, CTL_ZERO_BYTES = 1 * MiB;
constexpr size_t WS_MOD = 1 * MiB;
constexpr size_t WS_FLOC = WS_MOD + 128 * KiB;
constexpr size_t WS_TOT = WS_FLOC + 256 * KiB;
constexpr size_t WS_FKL = WS_TOT + 8 * KiB;
constexpr size_t WS_TOKE = WS_FKL + 256 * KiB;
constexpr size_t WS_TOKP = WS_TOKE + 64 * KiB;
constexpr size_t WS_TOKW = WS_TOKP + 64 * KiB;
constexpr size_t WS_LIST = WS_TOKW + 64 * KiB;
constexpr size_t WS_WM = 4 * MiB;
constexpr size_t WS_BWT = WS_WM + 256 * KiB;
constexpr size_t WS_MODP = 6 * MiB;
constexpr size_t WS_WIN = 8 * MiB;
constexpr size_t WS_WOUT = WS_WIN + 2 * 18 * MiB;
constexpr size_t WS_WGU = WS_WOUT + 2 * 8 * MiB;
constexpr size_t WS_WD = WS_WGU + 2 * 16 * 8 * MiB;
constexpr size_t WS_H = WS_WD + 2 * 16 * 4 * MiB;
constexpr size_t WS_Z = WS_H + 32 * MiB;
constexpr size_t WS_QN = WS_Z + 72 * MiB;
constexpr size_t WS_KN = WS_QN + 16 * MiB;
constexpr size_t WS_VN = WS_KN + 16 * MiB;
constexpr size_t WS_DP = WS_VN + 8 * MiB;
constexpr size_t WS_YCAT = WS_DP + 8 * MiB;
constexpr size_t WS_X1 = WS_YCAT + 32 * MiB;
constexpr size_t WS_X2 = WS_X1 + 64 * MiB;
constexpr size_t WS_HID = WS_X2 + 64 * MiB;
constexpr size_t WS_YB = WS_HID + 40 * MiB;
constexpr size_t WS_PART = WS_YB + 80 * MiB;
constexpr size_t WS_ML = WS_PART + 128 * MiB;
constexpr size_t WS_HID1 = WS_ML + 4 * MiB;
constexpr size_t WS_END = WS_HID1 + 40 * MiB;
constexpr int CW_TMO = 0, CW_CODE = 1;
constexpr int CW_CNT = 64;
constexpr int CW_Q = 512;
constexpr int CW_BGT = 640;
constexpr int CW_ARR = 1024;
constexpr int CW_MT = 768;
constexpr int CW_BAR = 4096;
constexpr int CW_RDY = 8192;

constexpr int RING_BYTES = 131072;
constexpr int MISC_OFF = RING_BYTES + 320;
constexpr int AUX_OFF = RING_BYTES + 1024;
constexpr int LDS_BYTES = 163840;

template <class T> __device__ __forceinline__ T* opq(T* p) { asm volatile("" : "+s"(p)); return p; }
__device__ __forceinline__ int opq_tid() { int t = threadIdx.x; asm volatile("" : "+v"(t)); return t; }
__device__ __forceinline__ unsigned cvt_pk_bf16(float lo, float hi) { unsigned r; asm volatile("v_cvt_pk_bf16_f32 %0, %1, %2" : "=v"(r) : "v"(lo), "v"(hi)); return r; }
__device__ __forceinline__ float bf_lo(unsigned w) { return __uint_as_float(w << 16); }
__device__ __forceinline__ float bf_hi(unsigned w) { return __uint_as_float(w & 0xffff0000u); }
__device__ __forceinline__ float wave_sum(float v) {
#pragma unroll
    for (int o = 1; o < 64; o <<= 1) v += __shfl_xor(v, o);
    return v;
}
__device__ __forceinline__ float gelu_t(float x) {
    const float u2 = x * (1.5957691216057308f + 0.0713548162726f * x * x);
    return x * __builtin_amdgcn_rcpf(1.f + __builtin_amdgcn_exp2f(-LOG2E * u2));
}
__device__ __forceinline__ float silu_f(float x) { return x * __builtin_amdgcn_rcpf(1.f + __builtin_amdgcn_exp2f(-LOG2E * x)); }

#define XB_TMO      128
#define XB_XCNT(j)  (256  + 64 * (j))
#define XB_XSUB(j)  (1280 + 64 * (j))
#define XB_XGEN(j)  (2304 + 64 * (j))
#define XB_TOP      3328
#define XB_TOPGEN   3392
#define XCD_BAR_WORDS 3456
#define XB_SPIN_CAP (1u << 18)
__device__ __forceinline__ unsigned xb_ld(unsigned* p)              { return __hip_atomic_load(p, __ATOMIC_RELAXED, __HIP_MEMORY_SCOPE_AGENT); }
__device__ __forceinline__ unsigned xb_add(unsigned* p, unsigned v) { return __hip_atomic_fetch_add(p, v, __ATOMIC_RELAXED, __HIP_MEMORY_SCOPE_AGENT); }
__device__ __forceinline__ unsigned xb_xcc_id() { return (unsigned)__builtin_amdgcn_s_getreg((3 << 11) | 20) & 0xFu; }
#define XB_SPIN(cond, bar) do { unsigned _sp = 0; while (cond) { __builtin_amdgcn_s_sleep(1); \
    if ((++_sp & 255u) == 0u) { if (xb_ld(&(bar)[XB_TMO])) break; if (_sp > XB_SPIN_CAP) { atomicAdd(&(bar)[XB_TMO], 1u); break; } } } } while (0)
struct XcdBarrier { unsigned* bar; unsigned x; volatile LAS unsigned* st; };
__device__ __forceinline__ XcdBarrier xcd_barrier_post(unsigned* bar, volatile LAS unsigned* st) {
    XcdBarrier b; b.bar = bar; b.x = xb_xcc_id(); b.st = st;
    if (threadIdx.x == 0) (void)xb_add(&bar[XB_XCNT(b.x)], 1u);
    return b;
}
__device__ __forceinline__ void xcd_barrier_complete(unsigned* bar, unsigned x, unsigned& nloc, unsigned& nx) {
    const unsigned G = gridDim.x * gridDim.y * gridDim.z;
    unsigned sum, cnt, mine, sp = 0u;
    for (;;) {
        sum = 0u; cnt = 0u; mine = 0u;
#pragma unroll
        for (unsigned j = 0; j < 16; ++j) { const unsigned c = xb_ld(&bar[XB_XCNT(j)]); sum += c; cnt += (c > 0u) ? 1u : 0u; mine = (j == x) ? c : mine; }
        if (sum == G) break;
        __builtin_amdgcn_s_sleep(1);
        if ((++sp & 255u) == 0u) { if (xb_ld(&bar[XB_TMO])) break; if (sp > XB_SPIN_CAP) { atomicAdd(&bar[XB_TMO], 1u); break; } }
    }
    nloc = mine > 0u ? mine : 1u; nx = cnt > 0u ? cnt : 1u;
}
__device__ __forceinline__ void xcd_barrier(const XcdBarrier& b) {
    asm volatile("s_waitcnt vmcnt(0)" ::: "memory");
    __syncthreads();
    if (threadIdx.x == 0) {
        unsigned* bar = b.bar; asm volatile("" : "+s"(bar));
        __builtin_amdgcn_s_waitcnt(0);
        unsigned nloc = b.st[0], nx = b.st[1];
        if (nloc == 0u) { xcd_barrier_complete(bar, b.x, nloc, nx); b.st[0] = nloc; b.st[1] = nx; }
        const unsigned old = xb_add(&bar[XB_XSUB(b.x)], 1u);
        const unsigned gen = old / nloc;
        if (old + 1u == (gen + 1u) * nloc) {
            __builtin_amdgcn_fence(__ATOMIC_RELEASE, "agent");
            asm volatile("s_waitcnt vmcnt(0)" ::: "memory");
            const unsigned og = xb_add(&bar[XB_TOP], 1u);
            const unsigned tg = og / nx;
            if (og + 1u == (tg + 1u) * nx) xb_add(&bar[XB_TOPGEN], 1u);
            else XB_SPIN(xb_ld(&bar[XB_TOPGEN]) == tg, bar);
            __builtin_amdgcn_fence(__ATOMIC_ACQUIRE, "agent");
            xb_add(&bar[XB_XGEN(b.x)], 1u);
            asm volatile("s_waitcnt vmcnt(0)" ::: "memory");
        } else {
            XB_SPIN(xb_ld(&bar[XB_XGEN(b.x)]) == gen, bar);
            __builtin_amdgcn_fence(__ATOMIC_ACQUIRE, "agent");
            asm volatile("s_waitcnt vmcnt(0)" ::: "memory");
        }
    }
    __syncthreads();
}

namespace gm {
constexpr int BM = 256, BK = 64, HALF = 128, HTB = HALF * BK * 2, STAGE_BYTES = 8 * HTB, NXCD = 8, WGM = 8;
__host__ __device__ __forceinline__ int lds_byte(int r, int c) { const int st = (r >> 4) * 2 + (c >> 5), rr = r & 15, cc = c & 31, ob = rr * 64 + cc * 2; return st * 1024 + (ob ^ (((ob >> 9) & 1) << 5)); }
__host__ __device__ __forceinline__ void stage_rc(int b, int& R, int& C) { const int st = b / 1024, sb = b % 1024, swz = sb ^ (((sb >> 9) & 1) << 5); R = (st >> 1) * 16 + swz / 64; C = (st & 1) * 32 + (swz % 64) / 2; }
__host__ __device__ __forceinline__ int perm32(int rho) { const int n = rho >> 4, i = rho & 15; return 8 * (i >> 2) + 4 * n + (i & 3); }

struct Unit { int arow, orow, ocol, e, rt; const char* Bp; };

template <class Epi, class Sched, bool GATHER, bool ALIGN_EPI>
__device__ __forceinline__ void gemm_phase(LAS unsigned char* lds, const char* Abase, const int K, const Sched& S, const Epi& E) {
    const int tid = opq_tid(), wid = __builtin_amdgcn_readfirstlane(tid >> 6), lane = tid & 63, wr = wid >> 2, wc = wid & 3, fr = lane & 15, fq = lane >> 4;
    const int nt = K / BK;
    unsigned voffA[2], voffB[2]; int Rr[2], Cc[2];
#pragma unroll
    for (int i = 0; i < 2; ++i) { int R, C; stage_rc(tid * 16 + i * 8192, R, C); const int Rb = Epi::PERM ? ((R & ~31) + perm32(R & 31)) : R;
        Rr[i] = R; Cc[i] = C; voffA[i] = (unsigned)(R * K + C) * 2u; voffB[i] = (unsigned)(Rb * K + C) * 2u; }
    const size_t kstep = (size_t)(BK * 2);
    const size_t hstep = (size_t)HALF * K * 2;
    const unsigned ldsw = (unsigned)wid * 1024u;
    const int aoff = lds_byte(wr * 64 + fr, fq * 8), boff = lds_byte(wc * 32 + fr, fq * 8);
#define PG8_SA(b, h) (((b) * 2 + (h)) * HTB)
#define PG8_SB(b, h) ((4 + (b) * 2 + (h)) * HTB)
#define PG8_STAGE(bufoff, gbase, voff) do { _Pragma("unroll") for (int _i = 0; _i < 2; ++_i) \
        __builtin_amdgcn_global_load_lds((const unsigned*)((const char*)(gbase) + (voff)[_i]), (LAS unsigned*)(lds + (bufoff) + ldsw + _i * 8192), 16, 0, 0); } while (0)
#define PG8_STAGE_A(bufoff, ubase, h, kb, vg) do { if constexpr (GATHER) { PG8_STAGE(bufoff, Abase + (kb), (vg)[h]); } else { PG8_STAGE(bufoff, (ubase) + (h) * hstep + (kb), voffA); } } while (0)
#define PG8_LDA(dst, b, h) do { _Pragma("unroll") for (int m = 0; m < 4; ++m) _Pragma("unroll") for (int k = 0; k < 2; ++k) dst[m][k] = *(const LAS bf16x8*)(lds + PG8_SA(b, h) + aoff + m * 2048 + k * 1024); } while (0)
#define PG8_LDB(dst, b, h) do { _Pragma("unroll") for (int n = 0; n < 2; ++n) _Pragma("unroll") for (int k = 0; k < 2; ++k) dst[n][k] = *(const LAS bf16x8*)(lds + PG8_SB(b, h) + boff + n * 2048 + k * 1024); } while (0)
#define PG8_MMA(ai, bj, At, Bt) do { __builtin_amdgcn_s_setprio(1); _Pragma("unroll") for (int m = 0; m < 4; ++m) _Pragma("unroll") for (int n = 0; n < 2; ++n) _Pragma("unroll") for (int k = 0; k < 2; ++k) \
        acc[ai][bj][m][n] = __builtin_amdgcn_mfma_f32_16x16x32_bf16(Bt[n][k], At[m][k], acc[ai][bj][m][n], 0, 0, 0); __builtin_amdgcn_s_setprio(0); } while (0)
#define PG8_WAIT_V(n) asm volatile("s_waitcnt vmcnt(" #n ")" ::: "memory")
#define PG8_WAIT_L(n) asm volatile("s_waitcnt lgkmcnt(" #n ")" ::: "memory")
#define PG8_BAR __builtin_amdgcn_s_barrier()
#define PG8_SCHED __builtin_amdgcn_sched_barrier(0)
    Unit cur, nxt; int ui = 0;
    if (!S.next(0, cur)) return;
    f32x4 acc[2][2][4][2];
#pragma unroll
    for (int a = 0; a < 2; ++a)
#pragma unroll
        for (int b = 0; b < 2; ++b)
#pragma unroll
            for (int m = 0; m < 4; ++m)
#pragma unroll
                for (int n = 0; n < 2; ++n) acc[a][b][m][n] = (f32x4){0.f, 0.f, 0.f, 0.f};
    bf16x8 At[4][2], B0[2][2], B1[2][2];
    unsigned vgc[2][2], vgn[2][2];
    if constexpr (GATHER) {
#pragma unroll
        for (int h = 0; h < 2; ++h)
#pragma unroll
            for (int i = 0; i < 2; ++i) { vgc[h][i] = ((unsigned)S.row_of(cur, h * HALF + Rr[i]) * (unsigned)K + (unsigned)Cc[i]) * 2u; vgn[h][i] = vgc[h][i]; }
    }
    const char* cA = GATHER ? Abase : Abase + (size_t)cur.arow * K * 2; const char* cB = cur.Bp;
    PG8_STAGE(PG8_SB(0, 0), cB, voffB); PG8_STAGE(PG8_SB(0, 1), cB + hstep, voffB); PG8_STAGE_A(PG8_SA(0, 0), cA, 0, 0, vgc); PG8_STAGE_A(PG8_SA(0, 1), cA, 1, 0, vgc);
    if (wr == 1) PG8_BAR;
    PG8_WAIT_V(2); PG8_BAR;
    PG8_STAGE(PG8_SB(1, 0), cB + kstep, voffB); PG8_STAGE_A(PG8_SA(1, 0), cA, 0, kstep, vgc); PG8_STAGE(PG8_SB(1, 1), cB + hstep + kstep, voffB);
    PG8_WAIT_V(6); PG8_BAR;
    for (;;) {
        bool has_next = false;
        const char* nA = cA; const char* nB = cB;
        if constexpr (GATHER) {
#pragma unroll
            for (int h = 0; h < 2; ++h)
#pragma unroll
                for (int i = 0; i < 2; ++i) vgn[h][i] = vgc[h][i];
        }
        for (int t = 0; t < nt; t += 2) {
            const bool last = (t == nt - 2);
            if (last) { has_next = S.next(ui + 1, nxt);
                if (has_next) { nA = GATHER ? Abase : Abase + (size_t)nxt.arow * K * 2; nB = nxt.Bp;
                    if constexpr (GATHER) {
#pragma unroll
                        for (int h = 0; h < 2; ++h)
#pragma unroll
                            for (int i = 0; i < 2; ++i) vgn[h][i] = ((unsigned)S.row_of(nxt, h * HALF + Rr[i]) * (unsigned)K + (unsigned)Cc[i]) * 2u;
                    } } }
            const size_t k1 = (size_t)(t + 1) * kstep;
            const char* a2 = last ? nA : cA; const char* b2 = last ? nB : cB + (size_t)(t + 2) * kstep;
            const size_t k2 = last ? 0 : (size_t)(t + 2) * kstep, k3 = k2 + kstep;
            const char* b3 = b2 + kstep;
            unsigned vg2[2][2];
            if constexpr (GATHER) {
#pragma unroll
                for (int h = 0; h < 2; ++h)
#pragma unroll
                    for (int i = 0; i < 2; ++i) vg2[h][i] = last ? vgn[h][i] : vgc[h][i];
            }
            PG8_LDB(B0, 0, 0); PG8_LDB(B1, 0, 1); PG8_SCHED; PG8_LDA(At, 0, 0); PG8_STAGE_A(PG8_SA(1, 1), cA, 1, k1, vgc);
            PG8_WAIT_V(8); PG8_WAIT_L(0); PG8_BAR; PG8_MMA(0, 0, At, B0); PG8_MMA(0, 1, At, B1); PG8_BAR; PG8_SCHED;
            PG8_LDA(At, 0, 1); PG8_STAGE(PG8_SB(0, 0), b2, voffB); PG8_STAGE(PG8_SB(0, 1), b2 + hstep, voffB); PG8_STAGE_A(PG8_SA(0, 0), a2, 0, k2, vg2);
            PG8_WAIT_V(8); PG8_WAIT_L(0); PG8_BAR; PG8_MMA(1, 0, At, B0); PG8_MMA(1, 1, At, B1); PG8_BAR; PG8_SCHED;
            PG8_LDB(B0, 1, 0); PG8_LDB(B1, 1, 1); PG8_SCHED; PG8_LDA(At, 1, 0); PG8_STAGE_A(PG8_SA(0, 1), a2, 1, k2, vg2);
            PG8_WAIT_V(8); PG8_WAIT_L(0); PG8_BAR; PG8_MMA(0, 0, At, B0); PG8_MMA(0, 1, At, B1); PG8_BAR; PG8_SCHED;
            PG8_LDA(At, 1, 1); PG8_STAGE(PG8_SB(1, 0), b3, voffB); PG8_STAGE(PG8_SB(1, 1), b3 + hstep, voffB); PG8_STAGE_A(PG8_SA(1, 0), a2, 0, k3, vg2);
            PG8_WAIT_V(8); PG8_WAIT_L(0); PG8_BAR; PG8_MMA(1, 0, At, B0); PG8_MMA(1, 1, At, B1); PG8_BAR; PG8_SCHED;
        }
        if constexpr (ALIGN_EPI) { if (wr == 0) PG8_BAR; }
        E(acc, cur, wr, wc, fr, fq);
        if (!has_next) break;
#pragma unroll
        for (int a = 0; a < 2; ++a)
#pragma unroll
            for (int b = 0; b < 2; ++b)
#pragma unroll
                for (int m = 0; m < 4; ++m)
#pragma unroll
                    for (int n = 0; n < 2; ++n) acc[a][b][m][n] = (f32x4){0.f, 0.f, 0.f, 0.f};
        cur = nxt; cA = nA; cB = nB; ++ui;
        if constexpr (GATHER) {
#pragma unroll
            for (int h = 0; h < 2; ++h)
#pragma unroll
                for (int i = 0; i < 2; ++i) vgc[h][i] = vgn[h][i];
        }
        if constexpr (ALIGN_EPI) { if (wr == 1) PG8_BAR; }
    }
    PG8_WAIT_V(0);
    if constexpr (!ALIGN_EPI) { if (wr == 0) PG8_BAR; }
    PG8_BAR;
#undef PG8_SA
#undef PG8_SB
#undef PG8_STAGE
#undef PG8_STAGE_A
#undef PG8_LDA
#undef PG8_LDB
#undef PG8_MMA
#undef PG8_WAIT_V
#undef PG8_WAIT_L
#undef PG8_BAR
#undef PG8_SCHED
}

struct RegOrder {
    int nM, nN, nwg, G, c, K; const char* Bt;
    __device__ __forceinline__ void init(int M, int N, int K_, const void* Bt_, int G_, int c_) { nM = M / BM; nN = N / BM; nwg = nM * nN; G = G_; c = c_; K = K_; Bt = (const char*)Bt_; }
    __device__ __forceinline__ bool next(int i, Unit& u) const {
        const long L = (long)i * G + c; if (L >= nwg) return false;
        int wgid = (int)L; { const int q = nwg / NXCD, r = nwg % NXCD, xcd = wgid % NXCD, off = wgid / NXCD; wgid = (xcd < r ? xcd * (q + 1) : r * (q + 1) + (xcd - r) * q) + off; }
        const int nig = WGM * nN, gid = wgid / nig, fm = gid * WGM, gsz = (nM - fm) < WGM ? (nM - fm) : WGM;
        const int pm = fm + ((wgid % nig) % gsz), pn = (wgid % nig) / gsz;
        u.arow = pm * BM; u.orow = pm * BM; u.ocol = pn * BM; u.e = 0; u.rt = 0; u.Bp = Bt + (size_t)pn * BM * K * 2; return true;
    }
    __device__ __forceinline__ int row_of(const Unit&, int) const { return 0; }
};
}
namespace at {
constexpr int NW = 8, QBLK = 32, KVBLK = 64, QB = NW * QBLK, D = 128;
constexpr int SHM_V = KVBLK * D * 2, SHM_K = KVBLK * D * 2;
constexpr int OFF_WS = 2 * SHM_V + 2 * SHM_K, OFF_NF = OFF_WS + NW * 64 * 4, ATT_LDS = OFF_NF + 2 * 64 * 4;
constexpr float SCALE = 0.08838834764831845f, C2 = 1.4426950408889634f * SCALE, THR = 8.f;
constexpr float ISCALE = 11.313708498984761f;
constexpr int QS = 128, KS = 128, VS = NZ, OS = DM;

#define KSWZ(row, colB) ((row) * 256 + ((colB) ^ (((row) & 7) << 4)))
#define SBAR() __builtin_amdgcn_sched_barrier(0)
__device__ __forceinline__ int v_st(int k, int c) { const int kk = (k & ~0xC) | ((k & 4) << 1) | ((k & 8) >> 1); return ((kk >> 3) * 4 + (c >> 5)) * 512 + ((kk & 7) * 32 + (c & 31)) * 2; }
__device__ __forceinline__ int v_rd_base(int lane) { return ((lane & 3) << 3) | (((lane >> 2) & 3) << 6) | (((lane >> 4) & 1) << 5) | (((lane >> 5) & 1) << 8); }
constexpr int v_rd_off(int d0, int ks, int half) { return d0 * 512 + ks * 4096 + half * 2048; }
__device__ __forceinline__ int crow(int r, int hi) { return (r & 3) + 8 * (r >> 2) + 4 * hi; }
__device__ __forceinline__ unsigned cvtpk(float lo, float hi) { unsigned r; asm volatile("v_cvt_pk_bf16_f32 %0, %1, %2" : "=v"(r) : "v"(lo), "v"(hi)); return r; }
__device__ __forceinline__ bf16x8 load8(const bf16* p) { return *(const GAS bf16x8*)p; }

__device__ __forceinline__ void mask_tile(f32x16& p0, f32x16& p1, int dq) {
    const float NEG = -__builtin_inff();
#pragma unroll
    for (int r = 0; r < 16; ++r) {
        const int c = (r & 3) + 8 * (r >> 2);
        if (dq - c < 0) p0[r] = NEG;
        if (dq - c - 32 < 0) p1[r] = NEG;
    }
}
__device__ __forceinline__ void partialSM(f32x16& p0, f32x16& p1, float& m_reg, float& mn, float& alpha) {
    float pmax = p0[0]; for (int r = 1; r < 16; ++r) pmax = fmaxf(pmax, p0[r]); for (int r = 0; r < 16; ++r) pmax = fmaxf(pmax, p1[r]);
    { auto rr = __builtin_amdgcn_permlane32_swap(__float_as_uint(pmax), __float_as_uint(pmax), false, false);
      pmax = fmaxf(__uint_as_float(rr[0]), __uint_as_float(rr[1])); }
    if (__builtin_expect(__all((pmax - m_reg) * SCALE <= THR), 1)) { mn = m_reg; alpha = 1.f; }
    else { mn = fmaxf(m_reg, pmax); alpha = __builtin_amdgcn_exp2f((m_reg - mn) * C2); m_reg = mn; }
    const float mnL = -mn * C2;
    for (int r = 0; r < 16; ++r) p0[r] = fmaf(p0[r], C2, mnL); for (int r = 0; r < 16; ++r) p1[r] = fmaf(p1[r], C2, mnL);
    for (int r = 0; r < 16; ++r) p0[r] = __builtin_amdgcn_exp2f(p0[r]);
}
__device__ __forceinline__ void finishSM(f32x16& p0, f32x16& p1, float alpha, float& l_reg, bf16x8& pa0, bf16x8& pa1, bf16x8& pa2, bf16x8& pa3) {
    for (int r = 0; r < 16; ++r) p1[r] = __builtin_amdgcn_exp2f(p1[r]);
    float ps = 0; for (int r = 0; r < 16; ++r) ps += p0[r]; for (int r = 0; r < 16; ++r) ps += p1[r];
    { auto rr = __builtin_amdgcn_permlane32_swap(__float_as_uint(ps), __float_as_uint(ps), false, false);
      ps = __uint_as_float(rr[0]) + __uint_as_float(rr[1]); }
    l_reg = l_reg * alpha + ps;
#define PK4(P, B_, OUT) do { unsigned a0 = cvtpk(P[B_+0], P[B_+1]), a1 = cvtpk(P[B_+2], P[B_+3]);                          \
        unsigned b0 = cvtpk(P[B_+4], P[B_+5]), b1 = cvtpk(P[B_+6], P[B_+7]);                                             \
        auto r0 = __builtin_amdgcn_permlane32_swap(a0, b0, false, false); auto r1 = __builtin_amdgcn_permlane32_swap(a1, b1, false, false); \
        u32x4 w = {r0[0], r1[0], r0[1], r1[1]}; OUT = *reinterpret_cast<bf16x8*>(&w); } while (0)
    PK4(p0, 0, pa0); PK4(p0, 8, pa1); PK4(p1, 0, pa2); PK4(p1, 8, pa3);
#undef PK4
}
template <int KB>
__device__ __forceinline__ void qkt(f32x16& p0, f32x16& p1, const char* K_lds, int r32, int hi, const bf16x8* qr) {
    { const float* nf = (const float*)(K_lds + 2 * SHM_K + NW * 64 * 4) + KB * 64 + 4 * hi;
#pragma unroll
      for (int g = 0; g < 4; ++g) { const f32x4 a = *(const f32x4*)(nf + 8 * g), b = *(const f32x4*)(nf + 32 + 8 * g);
#pragma unroll
          for (int j = 0; j < 4; ++j) { p0[4 * g + j] = a[j]; p1[4 * g + j] = b[j]; } } }
    const char* kb[4];
#pragma unroll
    for (int dd = 0; dd < 4; ++dd) kb[dd] = K_lds + KB * SHM_K + KSWZ(r32, (dd * 16 + hi * 8) * 2);
#pragma unroll
    for (int d0 = 0; d0 < 8; ++d0) { const char* a = kb[d0 & 3] + (d0 >> 2) * 128;
        bf16x8 b0 = *reinterpret_cast<const bf16x8*>(a);
        bf16x8 b1 = *reinterpret_cast<const bf16x8*>(a + 32 * 256);
        p0 = __builtin_amdgcn_mfma_f32_32x32x16_bf16(b0, qr[d0], p0, 0, 0, 0);
        p1 = __builtin_amdgcn_mfma_f32_32x32x16_bf16(b1, qr[d0], p1, 0, 0, 0); }
}
template <int VB>
__device__ __forceinline__ void pv_tile(f32x16* o, int vb0, bf16x8 pa0, bf16x8 pa1, bf16x8 pa2, bf16x8 pa3) {
#define TRRD(dst, off) asm volatile("ds_read_b64_tr_b16 %0, %1 offset:%2" : "=&v"(dst) : "v"(vb0), "i"(off) : "memory")
#define PV_D0(d0) do { s16x4 l0, l1, l2, l3, h0, h1, h2, h3; constexpr int b_ = VB * SHM_V + v_rd_off(d0, 0, 0); \
        TRRD(l0, b_); TRRD(h0, b_ + 2048); TRRD(l1, b_ + 4096); TRRD(h1, b_ + 6144); TRRD(l2, b_ + 8192); TRRD(h2, b_ + 10240); TRRD(l3, b_ + 12288); TRRD(h3, b_ + 14336); \
        asm volatile("s_waitcnt lgkmcnt(0)" ::: "memory"); SBAR();   \
        o[d0] = __builtin_amdgcn_mfma_f32_32x32x16_bf16(pa0, (bf16x8){l0[0], l0[1], l0[2], l0[3], h0[0], h0[1], h0[2], h0[3]}, o[d0], 0, 0, 0);   \
        o[d0] = __builtin_amdgcn_mfma_f32_32x32x16_bf16(pa1, (bf16x8){l1[0], l1[1], l1[2], l1[3], h1[0], h1[1], h1[2], h1[3]}, o[d0], 0, 0, 0);   \
        o[d0] = __builtin_amdgcn_mfma_f32_32x32x16_bf16(pa2, (bf16x8){l2[0], l2[1], l2[2], l2[3], h2[0], h2[1], h2[2], h2[3]}, o[d0], 0, 0, 0);   \
        o[d0] = __builtin_amdgcn_mfma_f32_32x32x16_bf16(pa3, (bf16x8){l3[0], l3[1], l3[2], l3[3], h3[0], h3[1], h3[2], h3[3]}, o[d0], 0, 0, 0); } while (0)
    PV_D0(0); PV_D0(1); PV_D0(2); PV_D0(3);
#undef PV_D0
#undef TRRD
}

struct BlockRef { const bf16* Q; const bf16* K; const bf16* V; bf16* O; const float* FK; int P0; };
#define ROWV(p, k0, rr) ((p) + (size_t)((k0) + (rr)) * VS + sc)
#define VMW() asm volatile("s_waitcnt vmcnt(0)" ::: "memory")
__device__ __forceinline__ void attn_block(const BlockRef& cur, int ja, int nt, bool fin, bf16* Opart, float* ML, char* lds, LAS unsigned char* ldsL) {
    const int tid = opq_tid(), wid = __builtin_amdgcn_readfirstlane(tid >> 6), lane = tid & 63, r32 = lane & 31, hi = lane >> 5;
    const int NT = nt;
    const int qlo = cur.P0 + wid * QBLK, qm = qlo + r32 - 4 * hi;
    char* V_lds = lds; char* K_lds = lds + 2 * SHM_V;
    float* ws = (float*)(lds + OFF_WS) + wid * 64; float* li_l = ws, * al_l = ws + 32;
    float m_reg = -1e30f, l_reg = 0; f32x16 o[4] = {};
    const int vb0 = (int)(uintptr_t)V_lds + v_rd_base(lane);
    const bf16* Kh = cur.K; const bf16* Vh = cur.V; const float* Fh = cur.FK;
    bf16x8 st_v0, st_v1; bf16x8 qr[8];
#define KDMA(bf, k0) do { int t_ = tid; asm volatile("" : "+v"(t_)); _Pragma("unroll") for (int i_ = 0; i_ < 2; ++i_) { const int p_ = i_ * 512 + t_, r_ = p_ >> 4, c_ = (p_ & 15) ^ (r_ & 7); \
        __builtin_amdgcn_global_load_lds((const unsigned*)((const char*)Kh + (size_t)(k0) * KS * 2 + (unsigned)(r_ * KS * 2 + c_ * 16)), (LAS unsigned*)(ldsL + 2 * SHM_V + (bf) * SHM_K + i_ * 8192 + wid * 1024), 16, 0, 0); } \
        if (wid == 0) __builtin_amdgcn_global_load_lds((const unsigned*)(Fh + (k0) + lane), (LAS unsigned*)(ldsL + OFF_NF + (bf) * 256), 4, 0, 0); } while (0)
#define SLOADV(k0) do { int t_ = tid; asm volatile("" : "+v"(t_)); const int sr = t_ >> 4, sc = (t_ & 15) * 8; st_v0 = load8(ROWV(Vh, k0, sr)); st_v1 = load8(ROWV(Vh, k0, 32 + sr)); } while (0)
#define SWRITE_HV(bf) do { int t_ = tid; asm volatile("" : "+v"(t_)); const int sr = t_ >> 4, sc = (t_ & 15) * 8; *(bf16x8*)(V_lds + (bf) * SHM_V + v_st(sr, sc)) = st_v0; *(bf16x8*)(V_lds + (bf) * SHM_V + v_st(32 + sr, sc)) = st_v1; } while (0)
#define RESC(a) do { if (__any((a) < 1.f)) { if (hi == 0) al_l[r32] = (a); asm volatile("s_waitcnt lgkmcnt(0)" ::: "memory");              \
                     for (int d_ = 0; d_ < 4; ++d_) for (int r = 0; r < 16; ++r) o[d_][r] *= al_l[crow(r, hi)]; } } while (0)
#define KBASE(t) ((ja + (t)) * KVBLK)
#define MASKT(P0_, P1_, t) do { const int kb_ = KBASE(t); if (kb_ + KVBLK - 1 > qlo) mask_tile(P0_, P1_, qm - kb_); } while (0)
    f32x16 pA0, pA1, pB0, pB1; float mnA, mnB, alA, alB; bf16x8 pa0, pa1, pa2, pa3;
    KDMA(0, KBASE(0)); SLOADV(KBASE(0));
#pragma unroll
    for (int d0 = 0; d0 < 8; ++d0) qr[d0] = load8(cur.Q + (size_t)(wid * QBLK + r32) * QS + d0 * 16 + hi * 8);
    VMW(); SWRITE_HV(0);
    __syncthreads();
    if (NT > 1) { KDMA(1, KBASE(1)); SLOADV(KBASE(1)); }
    SBAR(); qkt<0>(pA0, pA1, K_lds, r32, hi, qr);
    MASKT(pA0, pA1, 0); partialSM(pA0, pA1, m_reg, mnA, alA);
    if (NT > 1) { VMW(); SWRITE_HV(1); }
    __syncthreads();
#define HALF_STEP(PX0, PX1, mnX, alX, PY0, PY1, alY, t, KB, VB, SB) do {                                                      \
        SBAR(); qkt<KB>(PX0, PX1, K_lds, r32, hi, qr);                                                                        \
        finishSM(PY0, PY1, alY, l_reg, pa0, pa1, pa2, pa3); SBAR();                                                           \
        if ((t) + 1 < NT) { KDMA(SB, KBASE((t) + 1)); SLOADV(KBASE((t) + 1)); SBAR(); }                                       \
        pv_tile<VB>(o, vb0, pa0, pa1, pa2, pa3); MASKT(PX0, PX1, (t)); partialSM(PX0, PX1, m_reg, mnX, alX);                  \
        VMW(); __syncthreads();                                                                                               \
        if ((t) + 1 < NT) { SWRITE_HV(SB); }                                                                                  \
        RESC(alX); __syncthreads(); } while (0)
    for (int t = 1; t + 1 < NT; t += 2) {
        HALF_STEP(pB0, pB1, mnB, alB, pA0, pA1, alA, t, 1, 0, 0);
        HALF_STEP(pA0, pA1, mnA, alA, pB0, pB1, alB, t + 1, 0, 1, 1);
    }
    const bool even = (NT & 1) == 0;
    if (even) { SBAR(); qkt<1>(pB0, pB1, K_lds, r32, hi, qr); SBAR(); }
    finishSM(pA0, pA1, alA, l_reg, pa0, pa1, pa2, pa3); SBAR();
    pv_tile<0>(o, vb0, pa0, pa1, pa2, pa3);
    if (even) { MASKT(pB0, pB1, NT - 1); partialSM(pB0, pB1, m_reg, mnB, alB); __syncthreads(); RESC(alB);
        finishSM(pB0, pB1, alB, l_reg, pa0, pa1, pa2, pa3); SBAR(); pv_tile<1>(o, vb0, pa0, pa1, pa2, pa3); }
    SBAR();
    if (hi == 0) li_l[r32] = l_reg; asm volatile("s_waitcnt lgkmcnt(0)" ::: "memory");
    float rli[16];
#pragma unroll
    for (int r = 0; r < 16; ++r) rli[r] = __builtin_amdgcn_rcpf(li_l[crow(r, hi)]);
    const int ostr = fin ? OS : D;
    bf16* Ow = (fin ? cur.O : Opart) + (size_t)(wid * QBLK) * ostr;
#pragma unroll
    for (int r = 0; r < 16; ++r) { const int orow = crow(r, hi);
#pragma unroll
        for (int d0 = 0; d0 < 4; ++d0) { const float v = o[d0][r] * rli[r];
            const float vn = __shfl_xor(v, 1);
            if ((r32 & 1) == 0) *(GAS unsigned*)(Ow + (size_t)orow * ostr + d0 * 32 + r32) = cvtpk(v, vn); } }
    if (!fin && hi == 0) { f32x2 mlv; mlv.x = m_reg; mlv.y = l_reg; *(GAS f32x2*)(ML + (size_t)(wid * QBLK + r32) * 2) = mlv; }
    __syncthreads();
#undef KDMA
#undef SLOADV
#undef SWRITE_HV
#undef RESC
#undef KBASE
#undef MASKT
#undef HALF_STEP
}
#undef ROWV
#undef VMW
}
struct Frame {
    LAS unsigned char* lds; volatile LAS unsigned* MISC; gu32* ctl;
    int tid, lane, wave, vcu, G;
    unsigned char* ws;
};
#define CAS __attribute__((address_space(4)))
__device__ __forceinline__ const float* karg(int k) { const CAS char* p = (const CAS char*)__builtin_amdgcn_kernarg_segment_ptr(); asm volatile("" : "+s"(p)); return *(const float* const CAS*)(p + 8 * k); }

__device__ __forceinline__ void tr_item(const float* W, size_t ldw, bf16* WT, size_t ldk, LAS float* scr, int lane) {
    const int kr = lane >> 3, c4 = (lane & 7) * 4;
    f32x4 v[8];
#pragma unroll
    for (int i = 0; i < 8; ++i) v[i] = __builtin_nontemporal_load((const GAS f32x4*)(W + (size_t)(8 * i + kr) * ldw + c4));
#pragma unroll
    for (int i = 0; i < 8; ++i) { LAS float* s = scr + (8 * i + kr) * 33 + c4; s[0] = v[i].x; s[1] = v[i].y; s[2] = v[i].z; s[3] = v[i].w; }
    LDS_WAIT();
    const int c = lane & 7;
#pragma unroll
    for (int j = 0; j < 4; ++j) { const int n = (lane >> 3) + 8 * j; const LAS float* s = scr + (8 * c) * 33 + n;
        u32x4 o; o.x = cvt_pk_bf16(s[0 * 33], s[1 * 33]); o.y = cvt_pk_bf16(s[2 * 33], s[3 * 33]); o.z = cvt_pk_bf16(s[4 * 33], s[5 * 33]); o.w = cvt_pk_bf16(s[6 * 33], s[7 * 33]);
        *(GAS u32x4*)(WT + (size_t)n * ldk + 8 * c) = o; }
    LDS_WAIT();
}
constexpr int I_IN = (DM / 64) * (NZ / 32), I_OUT = (DM / 64) * (DM / 32), I_GU = (DM / 64) * (DEX / 32), I_D = (DEX / 64) * (DM / 32);
constexpr int GV_FIRST = 43;
constexpr int BGI_SMALL = (NLAYER * 4 * 8) / 8, BGI_IN = I_IN / 8, BGI_GV0 = (128 - GV_FIRST) * 4, BGI_GV1 = 128 * 4, BGI_OUT = I_OUT / 8, BGI_GU = NEXP * 2 * I_GU / 8, BGI_D = NEXP * I_D / 8;
constexpr int BG_C0 = BGI_SMALL + BGI_IN;
constexpr int BG_C1 = BG_C0 + BGI_GV0 + BGI_OUT;
constexpr int BG_C2 = BG_C1 + BGI_GU;
constexpr int BG_C3 = BG_C2 + BGI_D;
constexpr int BG_C3B = BG_C3 + BGI_GV1;
constexpr int BG_C4 = BG_C3B + BGI_IN;
constexpr int BG_C5 = BG_C4 + BGI_OUT;
constexpr int BG_C6 = BG_C5 + BGI_GU;
constexpr int BG_C7 = BG_C6 + BGI_D;
__device__ __forceinline__ float mod_at(const unsigned char* ws, const float* b_ada, int l, int j) {
    const float* p = (const float*)(ws + WS_MODP) + (size_t)l * 6 * DM + j;
    return *(const GAS float*)(b_ada + (size_t)l * 6 * DM + j) + ((*(const GAS float*)p + *(const GAS float*)(p + 2 * 6 * DM)) + (*(const GAS float*)(p + 4 * 6 * DM) + *(const GAS float*)(p + 6 * 6 * DM)));
}
__device__ __forceinline__ void gemv_item(const Frame& F, unsigned char* ws, int w) {
    LAS float* sc = (LAS float*)F.lds; LAS f32x4* red = (LAS f32x4*)(F.lds + 8192);
    const int kq = w & 3, l = w >> 9, cb = (w >> 2) & 127, c4 = F.tid % 24, kg = F.tid / 24;
    if (F.tid < 512) sc[F.tid] = silu_f(*(const GAS float*)(karg(1) + kq * 512 + F.tid));
    __syncthreads();
    f32x4 acc = (f32x4){0.f, 0.f, 0.f, 0.f};
    if (kg < 21) {
        const float* wp = karg(2) + (size_t)l * DM * 6 * DM + (size_t)(kq * 512) * 6 * DM + cb * 96 + c4 * 4;
#pragma unroll 8
        for (int k = kg; k < 512; k += 21) { const f32x4 wv = __builtin_nontemporal_load((const GAS f32x4*)(wp + (size_t)k * 6 * DM)); acc += wv * sc[k]; }
        red[kg * 24 + c4] = acc;
    }
    __syncthreads();
    if (F.tid < 24) { f32x4 s = red[F.tid];
        for (int g = 1; g < 21; ++g) s += red[g * 24 + F.tid];
        *(GAS f32x4*)((float*)(ws + WS_MODP) + (size_t)kq * 2 * 6 * DM + (size_t)l * 6 * DM + cb * 96 + F.tid * 4) = s; }
    __syncthreads();
}
__device__ __forceinline__ void conv_wave_item(const Frame& F, unsigned char* ws, int r, int l, LAS float* scr) {
    if (r < I_IN) { const int kb = r / (NZ / 32), nb = r % (NZ / 32);
        tr_item(karg(6) + (size_t)l * DM * NIN + (size_t)(64 * kb) * NIN + 32 * nb, NIN, (bf16*)(ws + WS_WIN) + (size_t)l * NZ * DM + (size_t)(32 * nb) * DM + 64 * kb, DM, scr, F.lane); return; }
    r -= I_IN;
    if (r < I_OUT) { const int kb = r / (DM / 32), nb = r % (DM / 32);
        tr_item(karg(15) + (size_t)l * DM * DM + (size_t)(64 * kb) * DM + 32 * nb, DM, (bf16*)(ws + WS_WOUT) + (size_t)l * DM * DM + (size_t)(32 * nb) * DM + 64 * kb, DM, scr, F.lane); return; }
    r -= I_OUT;
    if (r < NEXP * 2 * I_GU) { const int e = r / (2 * I_GU); r -= e * 2 * I_GU; const int up = r >= I_GU; if (up) r -= I_GU; const int kb = r / (DEX / 32), nb = r % (DEX / 32), n0 = 32 * nb;
        const float* src = (up ? karg(19) : karg(18)) + ((size_t)l * NEXP + e) * DM * DEX + (size_t)(64 * kb) * DEX + n0;
        const int drow = (n0 >> 7) * 256 + (up ? 128 : 0) + (n0 & 127);
        tr_item(src, DEX, (bf16*)(ws + WS_WGU) + ((size_t)l * NEXP + e) * DM * DM + (size_t)drow * DM + 64 * kb, DM, scr, F.lane); return; }
    r -= NEXP * 2 * I_GU;
    { const int e = r / I_D; r -= e * I_D; const int kb = r / (DM / 32), nb = r % (DM / 32);
      tr_item(karg(20) + ((size_t)l * NEXP + e) * DEX * DM + (size_t)(64 * kb) * DM + 32 * nb, DM, (bf16*)(ws + WS_WD) + ((size_t)l * NEXP + e) * DM * DEX + (size_t)(32 * nb) * DEX + 64 * kb, DEX, scr, F.lane); }
}
__device__ __forceinline__ void bg_item(const Frame& F, unsigned char* ws, int t) {
    LAS float* scr = (LAS float*)(F.lds + 16384 + F.wave * 9216);
    if (t < BGI_SMALL) { const int r = t * 8 + F.wave, mat = r >> 3, q = r & 7, kb = q >> 2, nb = q & 3;
        tr_item(karg(10) + (size_t)mat * 128 * 128 + (size_t)(64 * kb) * 128 + 32 * nb, 128, (bf16*)(ws + WS_BWT) + (size_t)mat * 128 * 128 + (size_t)(32 * nb) * 128 + 64 * kb, 128, scr, F.lane); return; }
    t -= BGI_SMALL;
    if (t < BGI_IN) { conv_wave_item(F, ws, t * 8 + F.wave, 0, scr); return; }
    t -= BGI_IN;
    if (t < BGI_GV0) { gemv_item(F, ws, GV_FIRST * 4 + t); return; }
    t -= BGI_GV0;
    if (t < BGI_OUT + BGI_GU + BGI_D) { conv_wave_item(F, ws, I_IN + t * 8 + F.wave, 0, scr); return; }
    t -= BGI_OUT + BGI_GU + BGI_D;
    if (t < BGI_GV1) { gemv_item(F, ws, 512 + t); return; }
    t -= BGI_GV1;
    conv_wave_item(F, ws, t * 8 + F.wave, 1, scr);
}
__device__ __forceinline__ void bg_fill(const Frame& F0, int seam, int need) {
    unsigned char* const ws = opq(F0.ws); Frame F = F0; F.tid = opq_tid(); F.lane = F.tid & 63; F.lds = opq(F0.lds);
    LAS unsigned* slot = (LAS unsigned*)(F.lds + AUX_OFF + 24576);
    gu32* const ctl_ = opq(F0.ctl); gu32* ticket = ctl_ + CW_BGT; gu32* arr = ctl_ + CW_ARR + 64 * seam;
    unsigned tn = 0xffffffffu; bool pre = false;
    if (F.tid == 0 && slot[1] == 0u) { (void)__hip_atomic_fetch_add(arr, 1u, RLX_AGENT); const unsigned cur = __hip_atomic_load(ticket, RLX_AGENT);
        if (cur >= (unsigned)BG_C7) slot[1] = 1u;
        else if (cur < (unsigned)need || __hip_atomic_load(arr, RLX_AGENT) < (unsigned)F.G) tn = __hip_atomic_fetch_add(ticket, 1u, RLX_AGENT); }
    for (;;) {
        if (F.tid == 0) slot[0] = tn;
        __syncthreads();
        const unsigned t = __builtin_amdgcn_readfirstlane(slot[0]);
        __syncthreads();
        if (t >= (unsigned)BG_C7) { if (F.tid == 0 && t != 0xffffffffu) slot[1] = 1u; break; }
        if (F.tid == 0) { tn = 0xffffffffu; pre = (t + 2u < (unsigned)need);
            if (pre) tn = __hip_atomic_fetch_add(ticket, 1u, RLX_AGENT); }
        bg_item(F, ws, (int)t);
        if (F.tid == 0 && !pre) { if (t + 1u < (unsigned)need || __hip_atomic_load(arr, RLX_AGENT) < (unsigned)F.G) tn = __hip_atomic_fetch_add(ticket, 1u, RLX_AGENT); }
    }
}
__device__ __forceinline__ void p0_prologue(const Frame& F0) {
    unsigned char* const ws = opq(F0.ws); Frame F = F0; F.tid = opq_tid(); F.lane = F.tid & 63; F.lds = opq(F0.lds);
    for (int w = F.vcu; w < GV_FIRST * 4; w += F.G) gemv_item(F, ws, w);
    const float* const a_ws_ = karg(7);
    for (int i = (F.vcu * NTHR + F.tid) * 2; i < NLAYER * 4 * 128 * 128; i += F.G * NTHR * 2) {
        const int t = (i >> 7) & 127, s = i & 127;
        const f32x2 w = *(const GAS f32x2*)(a_ws_ + i);
        const bool keep = (s >> 6) <= (t >> 6);
        *(GAS unsigned*)((bf16*)(ws + WS_WM) + i) = keep ? cvt_pk_bf16(w.x, w.y) : 0u;
    }
}

template <int MODE>
__device__ __forceinline__ void phase_norm1(const Frame& F0, int l, const float* xin, float* xout, int lprev) {
    unsigned char* const ws = opq(F0.ws); Frame F = F0; F.tid = opq_tid(); F.lane = F.tid & 63; F.lds = opq(F0.lds);
    LAS float* wfT = (LAS float*)F.lds;
    LAS float* gaL = (LAS float*)(F.lds + 65536);
    LAS float* gbL = (LAS float*)(F.lds + 73728);
    LAS float* g2L = (LAS float*)(F.lds + 81920);
    LAS float* lf = (LAS float*)(F.lds + 90112);
    LAS int* hb = (LAS int*)(F.lds + 91136);
    const float* const b_ada_ = karg(3); const float* const c_bf_ = karg(14);
    if (MODE != 2) {
        const float* const w_in_ = karg(6); const float* const g_mix_ = karg(4);
        for (int i = F.tid; i < DM * 2; i += NTHR) { const int d = i >> 1, half = i & 1;
            const f32x4 w = *(const GAS f32x4*)(w_in_ + (size_t)l * DM * NIN + (size_t)d * NIN + NZ + half * 4);
            wfT[(half * 4 + 0) * DM + d] = w.x; wfT[(half * 4 + 1) * DM + d] = w.y; wfT[(half * 4 + 2) * DM + d] = w.z; wfT[(half * 4 + 3) * DM + d] = w.w; }
        for (int d = F.tid; d < DM; d += NTHR) { gaL[d] = *(const GAS float*)(g_mix_ + (size_t)l * DM + d) * (1.f + mod_at(ws, b_ada_, l, DM + d)); gbL[d] = mod_at(ws, b_ada_, l, d); }
    }
    if (MODE != 0) {
        for (int d = F.tid; d < DM; d += NTHR) g2L[d] = mod_at(ws, b_ada_, lprev, 5 * DM + d);
        if (F.tid == 0) { int a = 0; for (int e = 0; e < NEXP; ++e) { hb[e] = a; a += ((int)__hip_atomic_load(F.ctl + CW_CNT + 64 * lprev + e, RLX_AGENT) + 255) & ~255; } }
    }
    __syncthreads();
    const bf16* YB = (const bf16*)(ws + WS_YB);
    for (int c = F.vcu; c < SEQ / 32; c += F.G) {
        for (int rr = 0; rr < 4; ++rr) {
            const int rl = F.wave * 4 + rr, t = c * 32 + rl;
            f32x4 v[8];
#pragma unroll
            for (int j = 0; j < 8; ++j) v[j] = *(const GAS f32x4*)(xin + (size_t)t * DM + 256 * j + 4 * F.lane);
            if (MODE != 0) {
                const int* te = (const int*)(ws + WS_TOKE) + 2 * t; const int* tp = (const int*)(ws + WS_TOKP) + 2 * t; const float* tw = (const float*)(ws + WS_TOKW) + 2 * t;
                const int r0 = hb[*(const GAS int*)te] + *(const GAS int*)tp, r1 = hb[*(const GAS int*)(te + 1)] + *(const GAS int*)(tp + 1); const float w0 = *(const GAS float*)tw, w1 = *(const GAS float*)(tw + 1);
#pragma unroll 2
                for (int j = 0; j < 8; ++j) { const int d = 256 * j + 4 * F.lane;
                    const u32x2 y0 = *(const GAS u32x2*)(YB + (size_t)r0 * DM + d), y1 = *(const GAS u32x2*)(YB + (size_t)r1 * DM + d);
                    const f32x4 g2 = *(const LAS f32x4*)(g2L + d);
                    f32x4 y; y.x = w0 * bf_lo(y0.x) + w1 * bf_lo(y1.x); y.y = w0 * bf_hi(y0.x) + w1 * bf_hi(y1.x); y.z = w0 * bf_lo(y0.y) + w1 * bf_lo(y1.y); y.w = w0 * bf_hi(y0.y) + w1 * bf_hi(y1.y);
                    v[j] = v[j] + g2 * y;
                    *(GAS f32x4*)(xout + (size_t)t * DM + d) = v[j]; }
            }
            if (MODE != 2) {
                float ss = 0.f;
#pragma unroll
                for (int j = 0; j < 8; ++j) ss += (v[j].x * v[j].x + v[j].y * v[j].y) + (v[j].z * v[j].z + v[j].w * v[j].w);
                const float rs = rsqrtf(wave_sum(ss) * (1.f / DM) + EPSN);
                float fz[8] = {0.f, 0.f, 0.f, 0.f, 0.f, 0.f, 0.f, 0.f};
                bf16* hrow = (bf16*)(ws + WS_H) + (size_t)t * DM;
#pragma unroll 2
                for (int j = 0; j < 8; ++j) { const int d = 256 * j + 4 * F.lane;
                    const f32x4 h = v[j] * rs * *(const LAS f32x4*)(gaL + d) + *(const LAS f32x4*)(gbL + d);
                    u32x2 o; o.x = cvt_pk_bf16(h.x, h.y); o.y = cvt_pk_bf16(h.z, h.w);
                    *(GAS u32x2*)(hrow + d) = o;
#pragma unroll
                    for (int q = 0; q < 8; ++q) { const f32x4 w = *(const LAS f32x4*)(wfT + q * DM + d); fz[q] += (h.x * w.x + h.y * w.y) + (h.z * w.z + h.w * w.w); } }
#pragma unroll
                for (int q = 0; q < 8; ++q) fz[q] = wave_sum(fz[q]);
                if (F.lane < 8) { float z = fz[0];
#pragma unroll
                    for (int q = 1; q < 8; ++q) z = (F.lane == q) ? fz[q] : z;
                    z += *(const GAS float*)(c_bf_ + l * 8 + F.lane);
                    lf[rl * 8 + F.lane] = fminf(z, 0.f) - log1pf(__expf(-fabsf(z))); }
            }
        }
        if (MODE != 2) {
            __syncthreads();
            if (F.tid < 8) { float a = 0.f; float* floc = (float*)(ws + WS_FLOC);
                for (int r = 0; r < 32; ++r) { a += lf[r * 8 + F.tid]; *(GAS float*)(floc + (size_t)(c * 32 + r) * 8 + F.tid) = a; }
                *(GAS float*)((float*)(ws + WS_TOT) + c * 8 + F.tid) = a; }
            __syncthreads();
        }
    }
}

__device__ __forceinline__ void phase_prep(const Frame& F0, int l) {
    unsigned char* const ws = opq(F0.ws); Frame F = F0; F.tid = opq_tid(); F.lane = F.tid & 63; F.lds = opq(F0.lds);
    LAS float* pre = (LAS float*)F.lds;
    {
        const float* tot = (const float*)(ws + WS_TOT);
        const int h = F.wave; double v0 = *(const GAS float*)(tot + (4 * F.lane + 0) * 8 + h), v1 = *(const GAS float*)(tot + (4 * F.lane + 1) * 8 + h), v2 = *(const GAS float*)(tot + (4 * F.lane + 2) * 8 + h), v3 = *(const GAS float*)(tot + (4 * F.lane + 3) * 8 + h);
        double s = v0 + v1 + v2 + v3, inc = s;
#pragma unroll
        for (int o = 1; o < 64; o <<= 1) { const double u = __shfl_up(inc, o); if (F.lane >= o) inc += u; }
        const double ex = inc - s;
        pre[h * 256 + 4 * F.lane + 0] = (float)ex; pre[h * 256 + 4 * F.lane + 1] = (float)(ex + v0); pre[h * 256 + 4 * F.lane + 2] = (float)(ex + v0 + v1); pre[h * 256 + 4 * F.lane + 3] = (float)(ex + v0 + v1 + v2);
    }
    __syncthreads();
    const bf16* Z = (const bf16*)(ws + WS_Z);
    float qg[16], kg[16], vg[8]; const float* const c_qg_ = karg(12); const float* const c_kg_ = karg(13); const float* const a_vg_ = karg(9);
#pragma unroll
    for (int i = 0; i < 16; ++i) { qg[i] = *(const GAS float*)(c_qg_ + l * 128 + (F.lane & 7) * 16 + i); kg[i] = *(const GAS float*)(c_kg_ + l * 128 + (F.lane & 7) * 16 + i); }
#pragma unroll
    for (int i = 0; i < 8; ++i) vg[i] = *(const GAS float*)(a_vg_ + l * 512 + F.lane * 8 + i);
    const int gw = F.vcu * NWAVES + F.wave, NGW = F.G * NWAVES;
    for (int t = gw; t < SEQ; t += NGW) {
        const bf16* zr = Z + (size_t)t * NZ;
#pragma unroll
        for (int which = 0; which < 2; ++which) {
            const u32x4 a = *(const GAS u32x4*)(zr + 1536 + which * 1024 + 16 * F.lane), b = *(const GAS u32x4*)(zr + 1536 + which * 1024 + 16 * F.lane + 8);
            float f[16]; f[0] = bf_lo(a.x); f[1] = bf_hi(a.x); f[2] = bf_lo(a.y); f[3] = bf_hi(a.y); f[4] = bf_lo(a.z); f[5] = bf_hi(a.z); f[6] = bf_lo(a.w); f[7] = bf_hi(a.w);
            f[8] = bf_lo(b.x); f[9] = bf_hi(b.x); f[10] = bf_lo(b.y); f[11] = bf_hi(b.y); f[12] = bf_lo(b.z); f[13] = bf_hi(b.z); f[14] = bf_lo(b.w); f[15] = bf_hi(b.w);
            float ss = 0.f;
#pragma unroll
            for (int i = 0; i < 16; ++i) ss += f[i] * f[i];
            ss += __shfl_xor(ss, 1); ss += __shfl_xor(ss, 2); ss += __shfl_xor(ss, 4);
            const float rs = rsqrtf(ss * (1.f / 128.f) + EPSN);
            u32x4 o0, o1;
#define QK_G(i) ((which ? kg[i] : qg[i]) * rs * f[i])
            o0.x = cvt_pk_bf16(QK_G(0), QK_G(1)); o0.y = cvt_pk_bf16(QK_G(2), QK_G(3)); o0.z = cvt_pk_bf16(QK_G(4), QK_G(5)); o0.w = cvt_pk_bf16(QK_G(6), QK_G(7));
            o1.x = cvt_pk_bf16(QK_G(8), QK_G(9)); o1.y = cvt_pk_bf16(QK_G(10), QK_G(11)); o1.z = cvt_pk_bf16(QK_G(12), QK_G(13)); o1.w = cvt_pk_bf16(QK_G(14), QK_G(15));
#undef QK_G
            bf16* dst = (bf16*)(ws + (which ? WS_KN : WS_QN)) + ((size_t)(F.lane >> 3) * SEQ + t) * 128 + (F.lane & 7) * 16;
            *(GAS u32x4*)dst = o0; *(GAS u32x4*)(dst + 8) = o1;
        }
        {
            const u32x4 a = *(const GAS u32x4*)(zr + 512 + 8 * F.lane);
            float f[8]; f[0] = bf_lo(a.x); f[1] = bf_hi(a.x); f[2] = bf_lo(a.y); f[3] = bf_hi(a.y); f[4] = bf_lo(a.z); f[5] = bf_hi(a.z); f[6] = bf_lo(a.w); f[7] = bf_hi(a.w);
            float ss = 0.f;
#pragma unroll
            for (int i = 0; i < 8; ++i) ss += f[i] * f[i];
            ss += __shfl_xor(ss, 1); ss += __shfl_xor(ss, 2); ss += __shfl_xor(ss, 4); ss += __shfl_xor(ss, 8);
            const float rs = rsqrtf(ss * (1.f / 128.f) + EPSN);
            u32x4 o; o.x = cvt_pk_bf16(f[0] * rs * vg[0], f[1] * rs * vg[1]); o.y = cvt_pk_bf16(f[2] * rs * vg[2], f[3] * rs * vg[3]); o.z = cvt_pk_bf16(f[4] * rs * vg[4], f[5] * rs * vg[5]); o.w = cvt_pk_bf16(f[6] * rs * vg[6], f[7] * rs * vg[7]);
            *(GAS u32x4*)((bf16*)(ws + WS_VN) + (size_t)t * 512 + 8 * F.lane) = o;
        }
        {
            const int w = 2 << (F.lane >> 4);
            const u32x4 a = *(const GAS u32x4*)(zr + 1024 + 8 * F.lane);
            float p[8]; p[0] = bf_lo(a.x); p[1] = bf_hi(a.x); p[2] = bf_lo(a.y); p[3] = bf_hi(a.y); p[4] = bf_lo(a.z); p[5] = bf_hi(a.z); p[6] = bf_lo(a.w); p[7] = bf_hi(a.w);
            float s[8];
#pragma unroll
            for (int i = 0; i < 8; ++i) s[i] = p[i];
            for (int j = 1; j < 16; ++j) { if (j < w && t - j >= 0) { const u32x4 b = *(const GAS u32x4*)(zr - (size_t)j * NZ + 1024 + 8 * F.lane);
                s[0] += bf_lo(b.x); s[1] += bf_hi(b.x); s[2] += bf_lo(b.y); s[3] += bf_hi(b.y); s[4] += bf_lo(b.z); s[5] += bf_hi(b.z); s[6] += bf_lo(b.w); s[7] += bf_hi(b.w); } }
            const float ic = 1.f / (float)((t + 1 < w) ? (t + 1) : w);
            u32x4 o; o.x = cvt_pk_bf16(s[0] * ic - p[0], s[1] * ic - p[1]); o.y = cvt_pk_bf16(s[2] * ic - p[2], s[3] * ic - p[3]); o.z = cvt_pk_bf16(s[4] * ic - p[4], s[5] * ic - p[5]); o.w = cvt_pk_bf16(s[6] * ic - p[6], s[7] * ic - p[7]);
            *(GAS u32x4*)((bf16*)(ws + WS_DP) + (size_t)t * 512 + 8 * F.lane) = o;
        }
        if (F.lane < 8) *(GAS float*)((float*)(ws + WS_FKL) + (size_t)F.lane * SEQ + t) = (pre[F.lane * 256 + (t >> 5)] + *(const GAS float*)((const float*)(ws + WS_FLOC) + (size_t)t * 8 + F.lane)) * -11.313708498984761f;
    }
}

__device__ __forceinline__ void phase_small_item(const Frame& F0, int l, int item) {
    unsigned char* const ws = opq(F0.ws); Frame F = F0; F.tid = opq_tid(); F.lane = F.tid & 63; F.lds = opq(F0.lds);
    const int fr = F.lane & 15, fq = F.lane >> 4, w = F.wave;
    const bf16* Z = (const bf16*)(ws + WS_Z); bf16* YC = (bf16*)(ws + WS_YCAT);
    f32x4 acc[8];
#pragma unroll
    for (int m = 0; m < 8; ++m) acc[m] = (f32x4){0.f, 0.f, 0.f, 0.f};
    const float* a_bs_ = opq(karg(8)); const float* b_scale_ = opq(karg(11));
    if (item < 256) {
        const int blk = item >> 2, h = item & 3;
        const bf16* VN = (const bf16*)(ws + WS_VN) + (size_t)(blk * 128) * 512 + h * 128 + 16 * w + fr;
        const bf16* WM = (const bf16*)(ws + WS_WM) + ((size_t)(l * 4 + h) * 128) * 128;
        bf16x8 yb[4];
#pragma unroll
        for (int ks = 0; ks < 4; ++ks)
#pragma unroll
            for (int j = 0; j < 8; ++j) yb[ks][j] = (short)*(const GAS bf16*)(VN + (size_t)(ks * 32 + 8 * fq + j) * 512);
#pragma unroll
        for (int m = 0; m < 8; ++m)
#pragma unroll
            for (int ks = 0; ks < 4; ++ks) { const bf16x8 xa = *(const GAS bf16x8*)(WM + (size_t)(16 * m + fr) * 128 + ks * 32 + 8 * fq);
                acc[m] = __builtin_amdgcn_mfma_f32_16x16x32_bf16(yb[ks], xa, acc[m], 0, 0, 0); }
#pragma unroll
        for (int m = 0; m < 8; ++m) { const int tl = 16 * m + fr, t = blk * 128 + tl, col = h * 128 + 16 * w + 4 * fq;
            const float bsv = *(const GAS float*)(a_bs_ + l * 512 + h * 128 + tl);
            const u32x2 u = *(const GAS u32x2*)(Z + (size_t)t * NZ + col);
            u32x2 o; o.x = cvt_pk_bf16(bf_lo(u.x) * (acc[m][0] + bsv), bf_hi(u.x) * (acc[m][1] + bsv)); o.y = cvt_pk_bf16(bf_lo(u.y) * (acc[m][2] + bsv), bf_hi(u.y) * (acc[m][3] + bsv));
            *(GAS u32x2*)(YC + (size_t)t * DM + col) = o; }
    } else {
        const int rb = (item - 256) >> 2, g = (item - 256) & 3;
        const bf16* DP = (const bf16*)(ws + WS_DP) + (size_t)(rb * 128) * 512 + g * 128;
        const bf16* BWT = (const bf16*)(ws + WS_BWT) + ((size_t)(l * 4 + g) * 128) * 128;
        bf16x8 yb[4];
#pragma unroll
        for (int ks = 0; ks < 4; ++ks) yb[ks] = *(const GAS bf16x8*)(BWT + (size_t)(16 * w + fr) * 128 + ks * 32 + 8 * fq);
#pragma unroll
        for (int m = 0; m < 8; ++m)
#pragma unroll
            for (int ks = 0; ks < 4; ++ks) { const bf16x8 xa = *(const GAS bf16x8*)(DP + (size_t)(16 * m + fr) * 512 + ks * 32 + 8 * fq);
                acc[m] = __builtin_amdgcn_mfma_f32_16x16x32_bf16(yb[ks], xa, acc[m], 0, 0, 0); }
        const f32x4 bsc = *(const GAS f32x4*)(b_scale_ + l * 512 + g * 128 + 16 * w + 4 * fq);
#pragma unroll
        for (int m = 0; m < 8; ++m) { const int t = rb * 128 + 16 * m + fr, col = 512 + g * 128 + 16 * w + 4 * fq;
            u32x2 o; o.x = cvt_pk_bf16(acc[m][0] * bsc.x, acc[m][1] * bsc.y); o.y = cvt_pk_bf16(acc[m][2] * bsc.z, acc[m][3] * bsc.w);
            *(GAS u32x2*)(YC + (size_t)t * DM + col) = o; }
    }
}

__device__ __forceinline__ void phase_norm2_route(const Frame& F0, int l) {
    unsigned char* const ws = opq(F0.ws); Frame F = F0; F.tid = opq_tid(); F.lane = F.tid & 63; F.lds = opq(F0.lds);
    LAS float* wrT = (LAS float*)F.lds;
    LAS float* gaL = (LAS float*)(F.lds + AUX_OFF);
    LAS float* gbL = (LAS float*)(F.lds + AUX_OFF + 8192);
    LAS int* lcnt = (LAS int*)(F.lds + AUX_OFF + 16384);
    const float* const w_router_ = karg(16); const float* const g_ffn_ = karg(5); const float* const b_ada_ = karg(3); const float* const b_router_ = karg(17);
    for (int i = F.tid; i < DM * 4; i += NTHR) { const int d = i >> 2, q = i & 3;
        const f32x4 w = *(const GAS f32x4*)(w_router_ + (size_t)d * 16 + q * 4);
        wrT[(q * 4 + 0) * DM + d] = w.x; wrT[(q * 4 + 1) * DM + d] = w.y; wrT[(q * 4 + 2) * DM + d] = w.z; wrT[(q * 4 + 3) * DM + d] = w.w; }
    for (int d = F.tid; d < DM; d += NTHR) { gaL[d] = *(const GAS float*)(g_ffn_ + (size_t)l * DM + d) * (1.f + mod_at(ws, b_ada_, l, 4 * DM + d)); gbL[d] = mod_at(ws, b_ada_, l, 3 * DM + d); }
    const float* X1 = (const float*)(ws + WS_X1);
    for (int c = F.vcu; c < SEQ / 32; c += F.G) {
        if (F.tid < 32) lcnt[F.tid] = 0;
        __syncthreads();
        int my_e0 = 0, my_e1 = 0, my_r0 = 0, my_r1 = 0; float my_w0 = 0.f, my_w1 = 0.f;
        for (int rr = 0; rr < 4; ++rr) {
            const int t = c * 32 + F.wave * 4 + rr;
            f32x4 v[8]; float ss = 0.f;
#pragma unroll
            for (int j = 0; j < 8; ++j) { v[j] = *(const GAS f32x4*)(X1 + (size_t)t * DM + 256 * j + 4 * F.lane); ss += (v[j].x * v[j].x + v[j].y * v[j].y) + (v[j].z * v[j].z + v[j].w * v[j].w); }
            const float rs = rsqrtf(wave_sum(ss) * (1.f / DM) + EPSN);
            float lg[16];
#pragma unroll
            for (int e = 0; e < 16; ++e) lg[e] = 0.f;
            bf16* hrow = (bf16*)(ws + WS_H) + (size_t)t * DM;
#pragma unroll 2
            for (int j = 0; j < 8; ++j) { const int d = 256 * j + 4 * F.lane;
                const f32x4 h = v[j] * rs * *(const LAS f32x4*)(gaL + d) + *(const LAS f32x4*)(gbL + d);
                u32x2 o; o.x = cvt_pk_bf16(h.x, h.y); o.y = cvt_pk_bf16(h.z, h.w);
                *(GAS u32x2*)(hrow + d) = o;
#pragma unroll
                for (int e = 0; e < 16; ++e) { const f32x4 w = *(const LAS f32x4*)(wrT + e * DM + d); lg[e] += (h.x * w.x + h.y * w.y) + (h.z * w.z + h.w * w.w); } }
#pragma unroll
            for (int e = 0; e < 16; ++e) lg[e] = wave_sum(lg[e]);
            float sc[16], sel[16];
#pragma unroll
            for (int e = 0; e < 16; ++e) { sc[e] = 1.f / (1.f + __expf(-lg[e])); sel[e] = sc[e] + *(const GAS float*)(b_router_ + e); }
            int bg = 0; float bgs = -INFINITY;
#pragma unroll
            for (int g = 0; g < 4; ++g) { float a = -INFINITY, b = -INFINITY;
#pragma unroll
                for (int i = 0; i < 4; ++i) { const float x = sel[g * 4 + i]; if (x > a) { b = a; a = x; } else if (x > b) b = x; }
                if (a + b > bgs) { bgs = a + b; bg = g; } }
            int e0 = 0, e1 = 0; float a = -INFINITY, b = -INFINITY, s0 = 0.f, s1 = 0.f;
#pragma unroll
            for (int g = 0; g < 4; ++g)
#pragma unroll
                for (int i = 0; i < 4; ++i) { const int e = g * 4 + i; const float x = sel[e];
                    if (g == bg) { if (x > a) { b = a; e1 = e0; s1 = s0; a = x; e0 = e; s0 = sc[e]; } else if (x > b) { b = x; e1 = e; s1 = sc[e]; } } }
            const float inv = 1.f / (s0 + s1);
            if (F.lane == rr) { my_e0 = e0; my_e1 = e1; my_w0 = s0 * inv; my_w1 = s1 * inv; }
        }
        if (F.lane < 4) { my_r0 = __hip_atomic_fetch_add(&lcnt[my_e0], 1, __ATOMIC_RELAXED, __HIP_MEMORY_SCOPE_WORKGROUP); my_r1 = __hip_atomic_fetch_add(&lcnt[my_e1], 1, __ATOMIC_RELAXED, __HIP_MEMORY_SCOPE_WORKGROUP); }
        __syncthreads();
        if (F.tid < 16) lcnt[16 + F.tid] = (int)__hip_atomic_fetch_add(F.ctl + CW_CNT + 64 * l + F.tid, (unsigned)lcnt[F.tid], RLX_AGENT);
        __syncthreads();
        if (F.lane < 4) { const int t = c * 32 + F.wave * 4 + F.lane;
            const int p0 = lcnt[16 + my_e0] + my_r0, p1 = lcnt[16 + my_e1] + my_r1;
            int* list = (int*)(ws + WS_LIST);
            *(GAS int*)(list + my_e0 * SEQ + p0) = t; *(GAS int*)(list + my_e1 * SEQ + p1) = t;
            *(GAS int*)((int*)(ws + WS_TOKE) + 2 * t) = my_e0; *(GAS int*)((int*)(ws + WS_TOKE) + 2 * t + 1) = my_e1;
            *(GAS int*)((int*)(ws + WS_TOKP) + 2 * t) = p0; *(GAS int*)((int*)(ws + WS_TOKP) + 2 * t + 1) = p1;
            *(GAS float*)((float*)(ws + WS_TOKW) + 2 * t) = my_w0; *(GAS float*)((float*)(ws + WS_TOKW) + 2 * t + 1) = my_w1; }
        __syncthreads();
    }
}

struct MoeOrder {
    int G, c, total, K, nct; const char* Bt; size_t estride; const int* list; LAS int* tab;
    __device__ __forceinline__ bool next(int i, gm::Unit& u) const {
        const int L = i * G + c; if (L >= total) return false;
        const int q = L / nct, ct = L - q * nct;
        int e = 0;
#pragma unroll
        for (int k = 1; k < NEXP; ++k) e += (q >= tab[k]) ? 1 : 0;
        e = __builtin_amdgcn_readfirstlane(e);
        const int rt = q - __builtin_amdgcn_readfirstlane(tab[e]);
        u.e = e; u.rt = rt; u.arow = (__builtin_amdgcn_readfirstlane(tab[e]) + rt) * 256; u.orow = u.arow; u.ocol = ct * 256;
        u.Bp = Bt + (size_t)e * estride + (size_t)ct * 256 * K * 2; return true;
    }
    __device__ __forceinline__ int row_of(const gm::Unit& u, int r) const {
        const int p = u.rt * 256 + r, n = tab[32 + u.e], pc = p < n ? p : n - 1;
        const int v = *(const GAS int*)(list + u.e * SEQ + pc);
        return (p < n) ? v : 0;
    }
};
__device__ __forceinline__ void moe_table(Frame& F, int l, LAS int* tab) {
    __syncthreads();
    if (F.tid == 0) { int a = 0;
        for (int e = 0; e < NEXP; ++e) { const int n = (int)__hip_atomic_load(F.ctl + CW_CNT + 64 * l + e, RLX_AGENT); tab[e] = a; tab[32 + e] = n; a += (n + 255) >> 8; }
        tab[16] = a; }
    __syncthreads();
}

constexpr int ATT_CH = 16;
struct MixTab { LAS int* jlo; LAS int* items; LAS int* nitems; LAS float* fend; LAS int* scan; };
__device__ __forceinline__ MixTab mix_tab_ptrs(LAS unsigned char* lds) {
    MixTab T; T.jlo = (LAS int*)(lds + 69632); T.items = (LAS int*)(lds + 69632 + 1024); T.nitems = (LAS int*)(lds + 69632 + 1024 + 8192); T.fend = (LAS float*)(lds + 69632 + 1024 + 8192 + 64);
    T.scan = (LAS int*)(lds + 69632 + 1024 + 8192 + 64 + 4096); return T;
}
__device__ __forceinline__ void mix_build_table(const Frame& F0, int l, const MixTab& T) {
    unsigned char* const ws = opq(F0.ws); const int tid = opq_tid();
    const float* FKL = (const float*)(ws + WS_FKL);
    for (int i = tid; i < 1024; i += NTHR) T.fend[i] = *(const GAS float*)(FKL + (size_t)(i >> 7) * SEQ + (i & 127) * 64 + 63);
    float gq = 0.f, gk = 0.f; const float* const c_qg_ = karg(12); const float* const c_kg_ = karg(13);
    { const int ln = tid & 63; gq = fmaxf(fabsf(*(const GAS float*)(c_qg_ + l * 128 + ln)), fabsf(*(const GAS float*)(c_qg_ + l * 128 + 64 + ln))); gk = fmaxf(fabsf(*(const GAS float*)(c_kg_ + l * 128 + ln)), fabsf(*(const GAS float*)(c_kg_ + l * 128 + 64 + ln)));
#pragma unroll
      for (int o = 1; o < 64; o <<= 1) { gq = fmaxf(gq, __shfl_xor(gq, o)); gk = fmaxf(gk, __shfl_xor(gk, o)); } }
    const float thr = (2.f * 1.01f * 11.313708498984761f * gq * gk + 30.f) * 11.313708498984761f;
    __syncthreads();
    int nfull = 0, nrem = 0, jl = 0, nt = 0;
    if (tid < 256) { const int h = tid >> 5, qb = tid & 31; const float f0 = *(const GAS float*)(FKL + (size_t)h * SEQ + qb * 256);
        for (int j = 0; j < 4 * qb; ++j) jl += (T.fend[h * 128 + j] - f0 <= -thr) ? 1 : 0;
        nt = 4 * (qb + 1) - jl; nfull = nt / ATT_CH; nrem = (nt % ATT_CH) ? 1 : 0; T.jlo[tid] = jl | ((nfull + nrem) << 8); }
    if (tid < 256) { T.scan[tid] = nfull; T.scan[256 + tid] = nrem; }
    __syncthreads();
    for (int o = 1; o < 256; o <<= 1) { int a = 0, b = 0; if (tid < 256 && tid >= o) { a = T.scan[tid - o]; b = T.scan[256 + tid - o]; } __syncthreads();
        if (tid < 256) { T.scan[tid] += a; T.scan[256 + tid] += b; } __syncthreads(); }
    if (tid < 256) { const int totf = T.scan[255], pf = T.scan[tid] - nfull, pr = totf + T.scan[256 + tid] - nrem, jb = 4 * ((tid & 31) + 1);
        for (int c = 0; c < nfull; ++c) T.items[pf + c] = tid | (c << 8) | ((jb - (c + 1) * ATT_CH) << 12) | (ATT_CH << 20);
        if (nrem) T.items[pr] = tid | (nfull << 8) | (jl << 12) | ((nt - nfull * ATT_CH) << 20);
        if (tid == 255) T.nitems[0] = totf + T.scan[511]; }
    __syncthreads();
}
__device__ __forceinline__ void phase_attn_combine(const Frame& F0, int l, const MixTab& T) {
    unsigned char* const ws = opq(F0.ws); const int tid = opq_tid();
    const bf16* PART = (const bf16*)(ws + WS_PART); const float* MLb = (const float*)(ws + WS_ML); bf16* YC = (bf16*)(ws + WS_YCAT);
    for (int b = F0.vcu; b < 256; b += F0.G) {
        const int nch = __builtin_amdgcn_readfirstlane(T.jlo[b]) >> 8; if (nch <= 1) continue;
        const int h = b >> 5, qb = b & 31, row = tid >> 1, half = tid & 1;
        float m[8], w[8], mx = -3.0e38f, ws_ = 0.f;
#pragma unroll
        for (int c = 0; c < 8; ++c) { if (c < nch) { const f32x2 v = *(const GAS f32x2*)(MLb + ((size_t)(b * 8 + c) * 256 + row) * 2); m[c] = v.x; w[c] = v.y; mx = fmaxf(mx, v.x); } else { m[c] = -3.0e38f; w[c] = 0.f; } }
#pragma unroll
        for (int c = 0; c < 8; ++c) { w[c] = (c < nch) ? w[c] * __builtin_amdgcn_exp2f((m[c] - mx) * at::C2) : 0.f; ws_ += w[c]; }
        const float inv = 1.f / ws_;
        float acc[64];
#pragma unroll
        for (int i = 0; i < 64; ++i) acc[i] = 0.f;
#pragma unroll
        for (int c = 0; c < 8; ++c) { if (c < nch) { const bf16* p = PART + ((size_t)(b * 8 + c) * 256 + row) * 128 + half * 64; const float wc = w[c] * inv;
#pragma unroll
            for (int q = 0; q < 8; ++q) { const u32x4 v = *(const GAS u32x4*)(p + q * 8);
                acc[q * 8 + 0] += wc * bf_lo(v.x); acc[q * 8 + 1] += wc * bf_hi(v.x); acc[q * 8 + 2] += wc * bf_lo(v.y); acc[q * 8 + 3] += wc * bf_hi(v.y);
                acc[q * 8 + 4] += wc * bf_lo(v.z); acc[q * 8 + 5] += wc * bf_hi(v.z); acc[q * 8 + 6] += wc * bf_lo(v.w); acc[q * 8 + 7] += wc * bf_hi(v.w); } } }
        bf16* o = YC + (size_t)(qb * 256 + row) * DM + 1024 + h * 128 + half * 64;
#pragma unroll
        for (int q = 0; q < 8; ++q) { u32x4 v; v.x = cvt_pk_bf16(acc[q * 8 + 0], acc[q * 8 + 1]); v.y = cvt_pk_bf16(acc[q * 8 + 2], acc[q * 8 + 3]); v.z = cvt_pk_bf16(acc[q * 8 + 4], acc[q * 8 + 5]); v.w = cvt_pk_bf16(acc[q * 8 + 6], acc[q * 8 + 7]);
            *(GAS u32x4*)(o + q * 8) = v; }
    }
}

struct MoeDynOrder {
    int total, K; const char* Bt; size_t estride; LAS int* tab; gu32* ticket; gu32* ready; gu32* tmo; LAS unsigned* slot;
    __device__ __forceinline__ bool next(int, gm::Unit& u) const {
        if (__builtin_amdgcn_readfirstlane(threadIdx.x >> 6) == 0) {
            unsigned T = 0u;
            if ((threadIdx.x & 63) == 0) T = __hip_atomic_fetch_add(ticket, 1u, RLX_AGENT);
            T = __builtin_amdgcn_readfirstlane(T);
            if (T < (unsigned)total) {
                gu32* w = ready + 16 * (T >> 3); unsigned sp = 0u;
                while ((unsigned)__builtin_amdgcn_readfirstlane(__hip_atomic_load(w, RLX_AGENT)) < 64u) {
                    __builtin_amdgcn_s_sleep(2);
                    if ((++sp & 255u) == 0u) { if (__hip_atomic_load(tmo, RLX_AGENT) != 0u) break; if (sp > (1u << 20)) { __hip_atomic_store(tmo, 1u, RLX_AGENT); break; } } }
                __builtin_amdgcn_fence(__ATOMIC_ACQUIRE, "agent");
                asm volatile("s_waitcnt vmcnt(0)" ::: "memory");
            }
            if ((threadIdx.x & 63) == 0) slot[0] = T;
        }
        asm volatile("s_waitcnt lgkmcnt(0)" ::: "memory"); __builtin_amdgcn_s_barrier(); asm volatile("" ::: "memory");
        const unsigned T = (unsigned)__builtin_amdgcn_readfirstlane((int)slot[0]);
        if (T >= (unsigned)total) return false;
        const int q = (int)(T >> 3), ct = (int)(T & 7);
        int e = 0;
#pragma unroll
        for (int k = 1; k < NEXP; ++k) e += (q >= tab[k]) ? 1 : 0;
        e = __builtin_amdgcn_readfirstlane(e);
        u.e = e; u.rt = q - __builtin_amdgcn_readfirstlane(tab[e]); u.arow = q * 256; u.orow = u.arow; u.ocol = ct * 256;
        u.Bp = Bt + (size_t)e * estride + (size_t)ct * 256 * K * 2; return true;
    }
    __device__ __forceinline__ int row_of(const gm::Unit&, int) const { return 0; }
};
struct EpiZ {
    static constexpr bool PERM = true;
    bf16* O;
    __device__ __forceinline__ void operator()(const f32x4 (&acc)[2][2][4][2], const gm::Unit& u, int wr, int wc, int fr, int fq) const {
        const int row0 = u.orow + wr * 64 + fr, col0 = u.ocol + wc * 32 + 8 * fq; const bool act = u.ocol < 1024;
#pragma unroll
        for (int ai = 0; ai < 2; ++ai)
#pragma unroll
            for (int m = 0; m < 4; ++m) { bf16* rowp = O + (size_t)(row0 + ai * 128 + m * 16) * NZ + col0;
#pragma unroll
                for (int bj = 0; bj < 2; ++bj) { f32x4 v0 = acc[ai][bj][m][0], v1 = acc[ai][bj][m][1];
                    if (act) {
#pragma unroll
                        for (int j = 0; j < 4; ++j) { v0[j] = gelu_t(v0[j]); v1[j] = gelu_t(v1[j]); } }
                    u32x4 w; w.x = cvt_pk_bf16(v0[0], v0[1]); w.y = cvt_pk_bf16(v0[2], v0[3]); w.z = cvt_pk_bf16(v1[0], v1[1]); w.w = cvt_pk_bf16(v1[2], v1[3]);
                    *(GAS u32x4*)(rowp + bj * 128) = w; } }
    }
};
struct EpiRes {
    static constexpr bool PERM = false;
    const float* xin; const LAS float* gate; float* out;
    __device__ __forceinline__ void operator()(const f32x4 (&acc)[2][2][4][2], const gm::Unit& u, int wr, int wc, int fr, int fq) const {
        const int row0 = u.orow + wr * 64 + fr, col0 = u.ocol + wc * 32 + 4 * fq;
        f32x4 gv[2][2];
#pragma unroll
        for (int bj = 0; bj < 2; ++bj)
#pragma unroll
            for (int n = 0; n < 2; ++n) gv[bj][n] = *(const LAS f32x4*)(gate + col0 + bj * 128 + n * 16);
#pragma unroll
        for (int ai = 0; ai < 2; ++ai)
#pragma unroll
            for (int m = 0; m < 4; ++m) { const size_t off = (size_t)(row0 + ai * 128 + m * 16) * DM + col0;
#pragma unroll
                for (int bj = 0; bj < 2; ++bj)
#pragma unroll
                    for (int n = 0; n < 2; ++n) { const f32x4 xv = *(const GAS f32x4*)(xin + off + bj * 128 + n * 16);
                        *(GAS f32x4*)(out + off + bj * 128 + n * 16) = xv + gv[bj][n] * acc[ai][bj][m][n]; } }
    }
};
struct EpiHid {
    static constexpr bool PERM = true;
    bf16* O;
    __device__ __forceinline__ void operator()(const f32x4 (&acc)[2][2][4][2], const gm::Unit& u, int wr, int wc, int fr, int fq) const {
        const int row0 = u.orow + wr * 64 + fr, col0 = (u.ocol >> 1) + wc * 32 + 8 * fq;
#pragma unroll
        for (int ai = 0; ai < 2; ++ai)
#pragma unroll
            for (int m = 0; m < 4; ++m) { bf16* rowp = O + (size_t)(row0 + ai * 128 + m * 16) * DEX + col0;
                f32x4 h0, h1;
#pragma unroll
                for (int j = 0; j < 4; ++j) { h0[j] = silu_f(acc[ai][0][m][0][j]) * acc[ai][1][m][0][j]; h1[j] = silu_f(acc[ai][0][m][1][j]) * acc[ai][1][m][1][j]; }
                u32x4 w; w.x = cvt_pk_bf16(h0[0], h0[1]); w.y = cvt_pk_bf16(h0[2], h0[3]); w.z = cvt_pk_bf16(h1[0], h1[1]); w.w = cvt_pk_bf16(h1[2], h1[3]);
                *(GAS u32x4*)rowp = w; }
    }
};
struct EpiHidPub {
    static constexpr bool PERM = true;
    unsigned char* O; gu32* ready;
    __device__ __forceinline__ void operator()(const f32x4 (&acc)[2][2][4][2], const gm::Unit& u, int wr, int wc, int fr, int fq) const {
        const __amdgpu_buffer_rsrc_t rs = __builtin_amdgcn_make_buffer_rsrc(O, (short)0, (int)(HIDROWS * DEX * 2), 0x00020000);
        const int row0 = u.orow + wr * 64 + fr, col0 = (u.ocol >> 1) + wc * 32 + 8 * fq;
#pragma unroll
        for (int ai = 0; ai < 2; ++ai)
#pragma unroll
            for (int m = 0; m < 4; ++m) { const int off = ((row0 + ai * 128 + m * 16) * DEX + col0) * 2;
                f32x4 h0, h1;
#pragma unroll
                for (int j = 0; j < 4; ++j) { h0[j] = silu_f(acc[ai][0][m][0][j]) * acc[ai][1][m][0][j]; h1[j] = silu_f(acc[ai][0][m][1][j]) * acc[ai][1][m][1][j]; }
                u32x4 w; w.x = cvt_pk_bf16(h0[0], h0[1]); w.y = cvt_pk_bf16(h0[2], h0[3]); w.z = cvt_pk_bf16(h1[0], h1[1]); w.w = cvt_pk_bf16(h1[2], h1[3]);
                __builtin_amdgcn_raw_buffer_store_b128(w, rs, off, 0, 16); }
        asm volatile("s_waitcnt vmcnt(0)" ::: "memory");
        if (fr == 0 && fq == 0) (void)__hip_atomic_fetch_add(ready + 16 * (u.orow >> 8), 1u, RLX_AGENT);
    }
};
struct EpiYB {
    static constexpr bool PERM = true;
    bf16* O;
    __device__ __forceinline__ void operator()(const f32x4 (&acc)[2][2][4][2], const gm::Unit& u, int wr, int wc, int fr, int fq) const {
        const int row0 = u.orow + wr * 64 + fr, col0 = u.ocol + wc * 32 + 8 * fq;
#pragma unroll
        for (int ai = 0; ai < 2; ++ai)
#pragma unroll
            for (int m = 0; m < 4; ++m) { bf16* rowp = O + (size_t)(row0 + ai * 128 + m * 16) * DM + col0;
#pragma unroll
                for (int bj = 0; bj < 2; ++bj) { const f32x4 v0 = acc[ai][bj][m][0], v1 = acc[ai][bj][m][1];
                    u32x4 w; w.x = cvt_pk_bf16(v0[0], v0[1]); w.y = cvt_pk_bf16(v0[2], v0[3]); w.z = cvt_pk_bf16(v1[0], v1[1]); w.w = cvt_pk_bf16(v1[2], v1[3]);
                    *(GAS u32x4*)(rowp + bj * 128) = w; } }
    }
};

__device__ __forceinline__ int bg_need(int p) {
    if (p <= 1) return 0;
    if (p <= 5) return BG_C0;
    if (p <= 7) return BG_C1;
    if (p == 8) return BG_C3;
    if (p <= 10) return BG_C3B;
    if (p <= 14) return BG_C4;
    if (p <= 16) return BG_C5;
    return BG_C7;
}
__device__ __forceinline__ bool bg_seam(int k) { if (k == 0) return true; const int j = (k - 1) % 9; return j != 2 && j != 5 && j != 8; }
struct Args { const float* in[21]; float* out; unsigned char* ws; int ph_lo, ph_hi; };
constexpr int N_PHASES = 1 + 9 * NLAYER + 1;

__global__ void __launch_bounds__(NTHR, 2) mk_fwd(Args args) {
    extern __shared__ __attribute__((aligned(16))) unsigned char lds[];
    Frame F;
    F.lds = (LAS unsigned char*)lds; F.MISC = (volatile LAS unsigned*)(F.lds + MISC_OFF);
    F.tid = threadIdx.x; F.lane = F.tid & 63; F.wave = __builtin_amdgcn_readfirstlane(F.tid >> 6);
    F.G = gridDim.x; { const int bx = blockIdx.x; F.vcu = (F.G % 8 == 0) ? (bx % 8) * (F.G / 8) + bx / 8 : bx; }
    F.ws = args.ws; F.ctl = (gu32*)(args.ws + WS_CTL);
    for (int u = F.tid; u < (LDS_BYTES - RING_BYTES) / 4; u += NTHR) ((LAS unsigned*)(F.lds + RING_BYTES))[u] = 0u;
    __syncthreads();
    const int lo = args.ph_lo, hi = args.ph_hi;
    const bool multi = (hi - lo) > 1;
    XcdBarrier bar; bar.bar = (unsigned*)(F.ctl + CW_BAR); bar.x = 0; bar.st = nullptr;
    if (multi) bar = xcd_barrier_post((unsigned*)(F.ctl + CW_BAR), F.MISC + 8);
#ifdef MK_ONLY
#define IN(k) (((k) == 0 ? 0 : (((k) - 1) % 9) + 1) == MK_ONLY && lo <= (k) && (k) < hi)
#else
#define IN(k) (lo <= (k) && (k) < hi)
#endif
#ifndef MK_REPEAT
#define MK_REPEAT -1
#endif
#define REPS(kind) ((MK_REPEAT == (kind)) ? 2 : 1)
#define SEAM(k) do { if (IN(k)) { if (bg_seam(k)) bg_fill(F, (k), bg_need((k) + 1)); if (IN((k) + 1)) xcd_barrier(bar); } } while (0)

    for (int rep_ = 0; rep_ < REPS(0); ++rep_) if (IN(0)) { if (rep_) xcd_barrier(bar); p0_prologue(F); } SEAM(0);

    for (int l = 0; l < NLAYER; ++l) {
        const int pb = 1 + 9 * l;

        for (int rep_ = 0; rep_ < REPS(1); ++rep_) if (IN(pb)) { if (rep_) xcd_barrier(bar); unsigned char* const wsl = opq(F.ws); LAS unsigned char* const ldl = opq(F.lds); if (l == 0) phase_norm1<0>(F, l, karg(0), nullptr, 0); else phase_norm1<1>(F, l, (const float*)(wsl + WS_X1), (float*)(wsl + WS_X2), l - 1); }
        SEAM(pb);
        for (int rep_ = 0; rep_ < REPS(2); ++rep_) if (IN(pb + 1)) { if (rep_) xcd_barrier(bar); unsigned char* const wsl = opq(F.ws); LAS unsigned char* const ldl = opq(F.lds); gm::RegOrder S; S.init(SEQ, NZ, DM, wsl + WS_WIN + (size_t)l * NZ * DM * 2, F.G, (int)blockIdx.x);
            EpiZ E{(bf16*)(wsl + WS_Z)};
            gm::gemm_phase<EpiZ, gm::RegOrder, false, true>(ldl, (const char*)(wsl + WS_H), DM, S, E); }
        SEAM(pb + 1);
        for (int rep_ = 0; rep_ < REPS(3); ++rep_) if (IN(pb + 2)) { if (rep_) xcd_barrier(bar); unsigned char* const wsl = opq(F.ws); LAS unsigned char* const ldl = opq(F.lds); phase_prep(F, l); }
        SEAM(pb + 2);
        for (int rep_ = 0; rep_ < REPS(4); ++rep_) if (IN(pb + 3)) { if (rep_) xcd_barrier(bar); unsigned char* const wsl = opq(F.ws); LAS unsigned char* const ldl = opq(F.lds);
            const MixTab T = mix_tab_ptrs(ldl);
            mix_build_table(F, l, T);
            const int natt = __builtin_amdgcn_readfirstlane(T.nitems[0]), ntot = natt + 512;
            LAS int* qslot = T.nitems + 1;
            int it = F.vcu;
            while (it < ntot) {
                if (it >= natt) { phase_small_item(F, l, it - natt); }
                else {
                    const int rec = __builtin_amdgcn_readfirstlane(T.items[it]), b = rec & 255, c = (rec >> 8) & 15, ja = (rec >> 12) & 255, n = (rec >> 20) & 31, h = b >> 5, qb = b & 31;
                    const bool fin = (__builtin_amdgcn_readfirstlane(T.jlo[b]) >> 8) <= 1; unsigned char* const ws = opq(wsl);
                    at::BlockRef cur;
                    cur.Q = (const bf16*)(ws + WS_QN) + ((size_t)h * SEQ + qb * 256) * 128; cur.K = (const bf16*)(ws + WS_KN) + (size_t)h * SEQ * 128;
                    cur.V = (const bf16*)(ws + WS_Z) + 3584 + h * 128; cur.O = (bf16*)(ws + WS_YCAT) + (size_t)(qb * 256) * DM + 1024 + h * 128;
                    cur.FK = (const float*)(ws + WS_FKL) + (size_t)h * SEQ; cur.P0 = qb * 256;
                    at::attn_block(cur, ja, n, fin, (bf16*)(ws + WS_PART) + (size_t)(b * 8 + c) * 256 * 128, (float*)(ws + WS_ML) + (size_t)(b * 8 + c) * 256 * 2, (char*)ldl, ldl);
                }
                if (F.tid == 0) qslot[0] = F.G + (int)__hip_atomic_fetch_add(F.ctl + CW_Q + 64 * l + 32 * rep_, 1u, RLX_AGENT);
                __syncthreads();
                it = __builtin_amdgcn_readfirstlane(qslot[0]);
                __syncthreads();
            }
        }
        SEAM(pb + 3);
        for (int rep_ = 0; rep_ < REPS(5); ++rep_) if (IN(pb + 4)) { if (rep_) xcd_barrier(bar); unsigned char* const wsl = opq(F.ws); LAS unsigned char* const ldl = opq(F.lds); const MixTab T = mix_tab_ptrs(ldl); mix_build_table(F, l, T); phase_attn_combine(F, l, T); }
        SEAM(pb + 4);
        for (int rep_ = 0; rep_ < REPS(6); ++rep_) if (IN(pb + 5)) { if (rep_) xcd_barrier(bar); unsigned char* const wsl = opq(F.ws); LAS unsigned char* const ldl = opq(F.lds); gm::RegOrder S; S.init(SEQ, DM, DM, wsl + WS_WOUT + (size_t)l * DM * DM * 2, F.G, (int)blockIdx.x);
            LAS float* g1L = (LAS float*)(ldl + AUX_OFF);
            { const float* const b_ada_ = karg(3); for (int d = opq_tid(); d < DM; d += NTHR) g1L[d] = mod_at(wsl, b_ada_, l, 2 * DM + d); }
            __syncthreads();
            EpiRes E{(l == 0) ? karg(0) : (const float*)(wsl + WS_X2), g1L, (float*)(wsl + WS_X1)};
            gm::gemm_phase<EpiRes, gm::RegOrder, false, true>(ldl, (const char*)(wsl + WS_YCAT), DM, S, E); }
        SEAM(pb + 5);
        for (int rep_ = 0; rep_ < REPS(7); ++rep_) if (IN(pb + 6)) { if (rep_) xcd_barrier(bar); unsigned char* const wsl = opq(F.ws); LAS unsigned char* const ldl = opq(F.lds); phase_norm2_route(F, l); }
        SEAM(pb + 6);
        for (int rep_ = 0; rep_ < REPS(8); ++rep_) if (IN(pb + 7)) { if (rep_) xcd_barrier(bar); unsigned char* const wsl = opq(F.ws); LAS unsigned char* const ldl = opq(F.lds); LAS int* tab = (LAS int*)(ldl + AUX_OFF + 20480); moe_table(F, l, tab);
            gu32* const rdy = F.ctl + CW_RDY + 4096 * l + 2048 * rep_;
            { MoeOrder S; S.G = F.G; S.c = F.vcu; S.total = 8 * tab[16]; S.K = DM; S.nct = 8; S.Bt = (const char*)(wsl + WS_WGU) + (size_t)l * NEXP * DM * DM * 2; S.estride = (size_t)DM * DM * 2;
              S.list = (const int*)(wsl + WS_LIST); S.tab = tab;
              EpiHidPub E{wsl + (l ? WS_HID1 : WS_HID), rdy};
              gm::gemm_phase<EpiHidPub, MoeOrder, true, true>(ldl, (const char*)(wsl + WS_H), DM, S, E); }
            { MoeDynOrder S; S.total = 8 * tab[16]; S.K = DEX; S.Bt = (const char*)(wsl + WS_WD) + (size_t)l * NEXP * DM * DEX * 2; S.estride = (size_t)DM * DEX * 2; S.tab = tab;
              S.ticket = F.ctl + CW_MT + 64 * l + 32 * rep_; S.ready = rdy; S.tmo = F.ctl + CW_TMO; S.slot = (LAS unsigned*)(ldl + AUX_OFF + 24576 + 64);
              EpiYB E{(bf16*)(wsl + WS_YB)};
              gm::gemm_phase<EpiYB, MoeDynOrder, false, true>(ldl, (const char*)(wsl + (l ? WS_HID1 : WS_HID)), DEX, S, E); }
        }
        SEAM(pb + 7);
    }
    for (int rep_ = 0; rep_ < REPS(10); ++rep_) if (IN(N_PHASES - 1)) { if (rep_) xcd_barrier(bar); phase_norm1<2>(F, NLAYER - 1, (const float*)(F.ws + WS_X1), (float*)karg(21), NLAYER - 1); }
#undef IN
#undef SEAM
}

#ifndef MK_LAUNCHES
#define MK_LAUNCHES 1
#endif
extern "C" void kernel_launch(void* const* d_in, const int* in_sizes, int n_in, void* d_out, int out_size, void* d_ws, size_t ws_size, hipStream_t stream) {
    static int grid = 0;
    if (grid == 0) {
        int dev = 0, cus = 0, per_cu = 0;
        if (n_in != 21 || ws_size < WS_END) { fprintf(stderr, "kernel_launch: unexpected inputs (n_in %d, ws %zu)\n", n_in, ws_size); grid = -1; return; }
        if (hipGetDevice(&dev) != hipSuccess || hipDeviceGetAttribute(&cus, hipDeviceAttributeMultiprocessorCount, dev) != hipSuccess) { grid = -1; return; }
        if (hipFuncSetAttribute((const void*)mk_fwd, hipFuncAttributeMaxDynamicSharedMemorySize, LDS_BYTES) != hipSuccess) { fprintf(stderr, "kernel_launch: hipFuncSetAttribute failed\n"); grid = -1; return; }
        if (hipOccupancyMaxActiveBlocksPerMultiprocessor(&per_cu, (const void*)mk_fwd, NTHR, LDS_BYTES) != hipSuccess || per_cu < 1) fprintf(stderr, "kernel_launch: occupancy query says %d\n", per_cu);
        (void)hipGetLastError();
        grid = cus;
    }
    if (grid < 0) return;
    (void)hipMemsetAsync((char*)d_ws + WS_CTL, 0, CTL_ZERO_BYTES, stream);
    Args a{};
    for (int i = 0; i < 21; ++i) a.in[i] = (const float*)d_in[i];
    a.out = (float*)d_out; a.ws = (unsigned char*)d_ws;
#if MK_LAUNCHES == 1
    a.ph_lo = 0; a.ph_hi = N_PHASES;
    hipLaunchKernelGGL(mk_fwd, dim3(grid), dim3(NTHR), LDS_BYTES, stream, a);
#else
    for (int p = 0; p < N_PHASES; ++p) { a.ph_lo = p; a.ph_hi = p + 1; hipLaunchKernelGGL(mk_fwd, dim3(grid), dim3(NTHR), LDS_BYTES, stream, a); }
#endif
}
```

```cpp
#include <hip/hip_runtime.h>
#include <stdint.h>
#include <stdio.h>

#define GAS __attribute__((address_space(1)))
#define LAS __attribute__((address_space(3)))
typedef unsigned short bf16;
typedef short bf16x8 __attribute__((ext_vector_type(8)));
typedef short s16x4 __attribute__((ext_vector_type(4)));
typedef float f32x2 __attribute__((ext_vector_type(2)));
typedef float f32x4 __attribute__((ext_vector_type(4)));
typedef float f32x16 __attribute__((ext_vector_type(16)));
typedef unsigned u32x2 __attribute__((ext_vector_type(2)));
typedef unsigned u32x4 __attribute__((ext_vector_type(4)));
typedef GAS unsigned gu32;
#define RLX_AGENT __ATOMIC_RELAXED, __HIP_MEMORY_SCOPE_AGENT
#define LDS_WAIT() asm volatile("s_waitcnt lgkmcnt(0)" ::: "memory")
#define VM_WAIT() asm volatile("s_waitcnt vmcnt(0)" ::: "memory")

constexpr int DM = 2048, SEQ = 8192, NIN = 4616, NZ = 4608, DEX = 1024, NEXP = 16, NLAYER = 2;
constexpr float EPSN = 1e-6f;
constexpr float LOG2E = 1.4426950408889634f;
constexpr int NWAVES = 8, NTHR = 512;
constexpr int HIDROWS = 2 * SEQ + NEXP * 256;

constexpr size_t KiB = 1024, MiB = 1u << 20;
constexpr size_t WS_CTL = 0, CTL_ZERO_BYTES = 1 * MiB;
constexpr size_t WS_MOD = 1 * MiB;
constexpr size_t WS_FLOC = WS_MOD + 128 * KiB;
constexpr size_t WS_TOT = WS_FLOC + 256 * KiB;
constexpr size_t WS_FKL = WS_TOT + 8 * KiB;
constexpr size_t WS_TOKE = WS_FKL + 256 * KiB;
constexpr size_t WS_TOKP = WS_TOKE + 64 * KiB;
constexpr size_t WS_TOKW = WS_TOKP + 64 * KiB;
constexpr size_t WS_LIST = WS_TOKW + 64 * KiB;
constexpr size_t WS_WM = 4 * MiB;
constexpr size_t WS_BWT = WS_WM + 256 * KiB;
constexpr size_t WS_MODP = 6 * MiB;
constexpr size_t WS_WIN = 8 * MiB;
constexpr size_t WS_WOUT = WS_WIN + 2 * 18 * MiB;
constexpr size_t WS_WGU = WS_WOUT + 2 * 8 * MiB;
constexpr size_t WS_WD = WS_WGU + 2 * 16 * 8 * MiB;
constexpr size_t WS_H = WS_WD + 2 * 16 * 4 * MiB;
constexpr size_t WS_Z = WS_H + 32 * MiB;
constexpr size_t WS_QN = WS_Z + 72 * MiB;
constexpr size_t WS_KN = WS_QN + 16 * MiB;
constexpr size_t WS_VN = WS_KN + 16 * MiB;
constexpr size_t WS_DP = WS_VN + 8 * MiB;
constexpr size_t WS_YCAT = WS_DP + 8 * MiB;
constexpr size_t WS_X1 = WS_YCAT + 32 * MiB;
constexpr size_t WS_X2 = WS_X1 + 64 * MiB;
constexpr size_t WS_HID = WS_X2 + 64 * MiB;
constexpr size_t WS_YB = WS_HID + 40 * MiB;
constexpr size_t WS_PART = WS_YB + 80 * MiB;
constexpr size_t WS_ML = WS_PART + 128 * MiB;
constexpr size_t WS_HID1 = WS_ML + 4 * MiB;
constexpr size_t WS_END = WS_HID1 + 40 * MiB;
constexpr int CW_TMO = 0, CW_CODE = 1;
constexpr int CW_CNT = 64;
constexpr int CW_Q = 512;
constexpr int CW_BGT = 640;
constexpr int CW_ARR = 1024;
constexpr int CW_MT = 768;
constexpr int CW_BAR = 4096;
constexpr int CW_RDY = 8192;

constexpr int RING_BYTES = 131072;
constexpr int MISC_OFF = RING_BYTES + 320;
constexpr int AUX_OFF = RING_BYTES + 1024;
constexpr int LDS_BYTES = 163840;

template <class T> __device__ __forceinline__ T* opq(T* p) { asm volatile("" : "+s"(p)); return p; }
__device__ __forceinline__ int opq_tid() { int t = threadIdx.x; asm volatile("" : "+v"(t)); return t; }
__device__ __forceinline__ unsigned cvt_pk_bf16(float lo, float hi) { unsigned r; asm volatile("v_cvt_pk_bf16_f32 %0, %1, %2" : "=v"(r) : "v"(lo), "v"(hi)); return r; }
__device__ __forceinline__ float bf_lo(unsigned w) { return __uint_as_float(w << 16); }
__device__ __forceinline__ float bf_hi(unsigned w) { return __uint_as_float(w & 0xffff0000u); }
__device__ __forceinline__ float wave_sum(float v) {
#pragma unroll
    for (int o = 1; o < 64; o <<= 1) v += __shfl_xor(v, o);
    return v;
}
__device__ __forceinline__ float gelu_t(float x) {
    const float u2 = x * (1.5957691216057308f + 0.0713548162726f * x * x);
    return x * __builtin_amdgcn_rcpf(1.f + __builtin_amdgcn_exp2f(-LOG2E * u2));
}
__device__ __forceinline__ float silu_f(float x) { return x * __builtin_amdgcn_rcpf(1.f + __builtin_amdgcn_exp2f(-LOG2E * x)); }

#define XB_TMO      128
#define XB_XCNT(j)  (256  + 64 * (j))
#define XB_XSUB(j)  (1280 + 64 * (j))
#define XB_XGEN(j)  (2304 + 64 * (j))
#define XB_TOP      3328
#define XB_TOPGEN   3392
#define XCD_BAR_WORDS 3456
#define XB_SPIN_CAP (1u << 18)
__device__ __forceinline__ unsigned xb_ld(unsigned* p)              { return __hip_atomic_load(p, __ATOMIC_RELAXED, __HIP_MEMORY_SCOPE_AGENT); }
__device__ __forceinline__ unsigned xb_add(unsigned* p, unsigned v) { return __hip_atomic_fetch_add(p, v, __ATOMIC_RELAXED, __HIP_MEMORY_SCOPE_AGENT); }
__device__ __forceinline__ unsigned xb_xcc_id() { return (unsigned)__builtin_amdgcn_s_getreg((3 << 11) | 20) & 0xFu; }
#define XB_SPIN(cond, bar) do { unsigned _sp = 0; while (cond) { __builtin_amdgcn_s_sleep(1); \
    if ((++_sp & 255u) == 0u) { if (xb_ld(&(bar)[XB_TMO])) break; if (_sp > XB_SPIN_CAP) { atomicAdd(&(bar)[XB_TMO], 1u); break; } } } } while (0)
struct XcdBarrier { unsigned* bar; unsigned x; volatile LAS unsigned* st; };
__device__ __forceinline__ XcdBarrier xcd_barrier_post(unsigned* bar, volatile LAS unsigned* st) {
    XcdBarrier b; b.bar = bar; b.x = xb_xcc_id(); b.st = st;
    if (threadIdx.x == 0) (void)xb_add(&bar[XB_XCNT(b.x)], 1u);
    return b;
}
__device__ __forceinline__ void xcd_barrier_complete(unsigned* bar, unsigned x, unsigned& nloc, unsigned& nx) {
    const unsigned G = gridDim.x * gridDim.y * gridDim.z;
    unsigned sum, cnt, mine, sp = 0u;
    for (;;) {
        sum = 0u; cnt = 0u; mine = 0u;
#pragma unroll
        for (unsigned j = 0; j < 16; ++j) { const unsigned c = xb_ld(&bar[XB_XCNT(j)]); sum += c; cnt += (c > 0u) ? 1u : 0u; mine = (j == x) ? c : mine; }
        if (sum == G) break;
        __builtin_amdgcn_s_sleep(1);
        if ((++sp & 255u) == 0u) { if (xb_ld(&bar[XB_TMO])) break; if (sp > XB_SPIN_CAP) { atomicAdd(&bar[XB_TMO], 1u); break; } }
    }
    nloc = mine > 0u ? mine : 1u; nx = cnt > 0u ? cnt : 1u;
}
__device__ __forceinline__ void xcd_barrier(const XcdBarrier& b) {
    asm volatile("s_waitcnt vmcnt(0)" ::: "memory");
    __syncthreads();
    if (threadIdx.x == 0) {
        unsigned* bar = b.bar; asm volatile("" : "+s"(bar));
        __builtin_amdgcn_s_waitcnt(0);
        unsigned nloc = b.st[0], nx = b.st[1];
        if (nloc == 0u) { xcd_barrier_complete(bar, b.x, nloc, nx); b.st[0] = nloc; b.st[1] = nx; }
        const unsigned old = xb_add(&bar[XB_XSUB(b.x)], 1u);
        const unsigned gen = old / nloc;
        if (old + 1u == (gen + 1u) * nloc) {
            __builtin_amdgcn_fence(__ATOMIC_RELEASE, "agent");
            asm volatile("s_waitcnt vmcnt(0)" ::: "memory");
            const unsigned og = xb_add(&bar[XB_TOP], 1u);
            const unsigned tg = og / nx;
            if (og + 1u == (tg + 1u) * nx) xb_add(&bar[XB_TOPGEN], 1u);
            else XB_SPIN(xb_ld(&bar[XB_TOPGEN]) == tg, bar);
            __builtin_amdgcn_fence(__ATOMIC_ACQUIRE, "agent");
            xb_add(&bar[XB_XGEN(b.x)], 1u);
            asm volatile("s_waitcnt vmcnt(0)" ::: "memory");
        } else {
            XB_SPIN(xb_ld(&bar[XB_XGEN(b.x)]) == gen, bar);
            __builtin_amdgcn_fence(__ATOMIC_ACQUIRE, "agent");
            asm volatile("s_waitcnt vmcnt(0)" ::: "memory");
        }
    }
    __syncthreads();
}

namespace gm {
constexpr int BM = 256, BK = 64, HALF = 128, HTB = HALF * BK * 2, STAGE_BYTES = 8 * HTB, NXCD = 8, WGM = 8;
__host__ __device__ __forceinline__ int lds_byte(int r, int c) { const int st = (r >> 4) * 2 + (c >> 5), rr = r & 15, cc = c & 31, ob = rr * 64 + cc * 2; return st * 1024 + (ob ^ (((ob >> 9) & 1) << 5)); }
__host__ __device__ __forceinline__ void stage_rc(int b, int& R, int& C) { const int st = b / 1024, sb = b % 1024, swz = sb ^ (((sb >> 9) & 1) << 5); R = (st >> 1) * 16 + swz / 64; C = (st & 1) * 32 + (swz % 64) / 2; }
__host__ __device__ __forceinline__ int perm32(int rho) { const int n = rho >> 4, i = rho & 15; return 8 * (i >> 2) + 4 * n + (i & 3); }

struct Unit { int arow, orow, ocol, e, rt; const char* Bp; };

template <class Epi, class Sched, bool GATHER, bool ALIGN_EPI>
__device__ __forceinline__ void gemm_phase(LAS unsigned char* lds, const char* Abase, const int K, const Sched& S, const Epi& E) {
    const int tid = opq_tid(), wid = __builtin_amdgcn_readfirstlane(tid >> 6), lane = tid & 63, wr = wid >> 2, wc = wid & 3, fr = lane & 15, fq = lane >> 4;
    const int nt = K / BK;
    unsigned voffA[2], voffB[2]; int Rr[2], Cc[2];
#pragma unroll
    for (int i = 0; i < 2; ++i) { int R, C; stage_rc(tid * 16 + i * 8192, R, C); const int Rb = Epi::PERM ? ((R & ~31) + perm32(R & 31)) : R;
        Rr[i] = R; Cc[i] = C; voffA[i] = (unsigned)(R * K + C) * 2u; voffB[i] = (unsigned)(Rb * K + C) * 2u; }
    const size_t kstep = (size_t)(BK * 2);
    const size_t hstep = (size_t)HALF * K * 2;
    const unsigned ldsw = (unsigned)wid * 1024u;
    const int aoff = lds_byte(wr * 64 + fr, fq * 8), boff = lds_byte(wc * 32 + fr, fq * 8);
#define PG8_SA(b, h) (((b) * 2 + (h)) * HTB)
#define PG8_SB(b, h) ((4 + (b) * 2 + (h)) * HTB)
#define PG8_STAGE(bufoff, gbase, voff) do { _Pragma("unroll") for (int _i = 0; _i < 2; ++_i) \
        __builtin_amdgcn_global_load_lds((const unsigned*)((const char*)(gbase) + (voff)[_i]), (LAS unsigned*)(lds + (bufoff) + ldsw + _i * 8192), 16, 0, 0); } while (0)
#define PG8_STAGE_A(bufoff, ubase, h, kb, vg) do { if constexpr (GATHER) { PG8_STAGE(bufoff, Abase + (kb), (vg)[h]); } else { PG8_STAGE(bufoff, (ubase) + (h) * hstep + (kb), voffA); } } while (0)
#define PG8_LDA(dst, b, h) do { _Pragma("unroll") for (int m = 0; m < 4; ++m) _Pragma("unroll") for (int k = 0; k < 2; ++k) dst[m][k] = *(const LAS bf16x8*)(lds + PG8_SA(b, h) + aoff + m * 2048 + k * 1024); } while (0)
#define PG8_LDB(dst, b, h) do { _Pragma("unroll") for (int n = 0; n < 2; ++n) _Pragma("unroll") for (int k = 0; k < 2; ++k) dst[n][k] = *(const LAS bf16x8*)(lds + PG8_SB(b, h) + boff + n * 2048 + k * 1024); } while (0)
#define PG8_MMA(ai, bj, At, Bt) do { __builtin_amdgcn_s_setprio(1); _Pragma("unroll") for (int m = 0; m < 4; ++m) _Pragma("unroll") for (int n = 0; n < 2; ++n) _Pragma("unroll") for (int k = 0; k < 2; ++k) \
        acc[ai][bj][m][n] = __builtin_amdgcn_mfma_f32_16x16x32_bf16(Bt[n][k], At[m][k], acc[ai][bj][m][n], 0, 0, 0); __builtin_amdgcn_s_setprio(0); } while (0)
#define PG8_WAIT_V(n) asm volatile("s_waitcnt vmcnt(" #n ")" ::: "memory")
#define PG8_WAIT_L(n) asm volatile("s_waitcnt lgkmcnt(" #n ")" ::: "memory")
#define PG8_BAR __builtin_amdgcn_s_barrier()
#define PG8_SCHED __builtin_amdgcn_sched_barrier(0)
    Unit cur, nxt; int ui = 0;
    if (!S.next(0, cur)) return;
    f32x4 acc[2][2][4][2];
#pragma unroll
    for (int a = 0; a < 2; ++a)
#pragma unroll
        for (int b = 0; b < 2; ++b)
#pragma unroll
            for (int m = 0; m < 4; ++m)
#pragma unroll
                for (int n = 0; n < 2; ++n) acc[a][b][m][n] = (f32x4){0.f, 0.f, 0.f, 0.f};
    bf16x8 At[4][2], B0[2][2], B1[2][2];
    unsigned vgc[2][2], vgn[2][2];
    if constexpr (GATHER) {
#pragma unroll
        for (int h = 0; h < 2; ++h)
#pragma unroll
            for (int i = 0; i < 2; ++i) { vgc[h][i] = ((unsigned)S.row_of(cur, h * HALF + Rr[i]) * (unsigned)K + (unsigned)Cc[i]) * 2u; vgn[h][i] = vgc[h][i]; }
    }
    const char* cA = GATHER ? Abase : Abase + (size_t)cur.arow * K * 2; const char* cB = cur.Bp;
    PG8_STAGE(PG8_SB(0, 0), cB, voffB); PG8_STAGE(PG8_SB(0, 1), cB + hstep, voffB); PG8_STAGE_A(PG8_SA(0, 0), cA, 0, 0, vgc); PG8_STAGE_A(PG8_SA(0, 1), cA, 1, 0, vgc);
    if (wr == 1) PG8_BAR;
    PG8_WAIT_V(2); PG8_BAR;
    PG8_STAGE(PG8_SB(1, 0), cB + kstep, voffB); PG8_STAGE_A(PG8_SA(1, 0), cA, 0, kstep, vgc); PG8_STAGE(PG8_SB(1, 1), cB + hstep + kstep, voffB);
    PG8_WAIT_V(6); PG8_BAR;
    for (;;) {
        bool has_next = false;
        const char* nA = cA; const char* nB = cB;
        if constexpr (GATHER) {
#pragma unroll
            for (int h = 0; h < 2; ++h)
#pragma unroll
                for (int i = 0; i < 2; ++i) vgn[h][i] = vgc[h][i];
        }
        for (int t = 0; t < nt; t += 2) {
            const bool last = (t == nt - 2);
            if (last) { has_next = S.next(ui + 1, nxt);
                if (has_next) { nA = GATHER ? Abase : Abase + (size_t)nxt.arow * K * 2; nB = nxt.Bp;
                    if constexpr (GATHER) {
#pragma unroll
                        for (int h = 0; h < 2; ++h)
#pragma unroll
                            for (int i = 0; i < 2; ++i) vgn[h][i] = ((unsigned)S.row_of(nxt, h * HALF + Rr[i]) * (unsigned)K + (unsigned)Cc[i]) * 2u;
                    } } }
            const size_t k1 = (size_t)(t + 1) * kstep;
            const char* a2 = last ? nA : cA; const char* b2 = last ? nB : cB + (size_t)(t + 2) * kstep;
            const size_t k2 = last ? 0 : (size_t)(t + 2) * kstep, k3 = k2 + kstep;
            const char* b3 = b2 + kstep;
            unsigned vg2[2][2];
            if constexpr (GATHER) {
#pragma unroll
                for (int h = 0; h < 2; ++h)
#pragma unroll
                    for (int i = 0; i < 2; ++i) vg2[h][i] = last ? vgn[h][i] : vgc[h][i];
            }
            PG8_LDB(B0, 0, 0); PG8_LDB(B1, 0, 1); PG8_SCHED; PG8_LDA(At, 0, 0); PG8_STAGE_A(PG8_SA(1, 1), cA, 1, k1, vgc);
            PG8_WAIT_V(8); PG8_WAIT_L(0); PG8_BAR; PG8_MMA(0, 0, At, B0); PG8_MMA(0, 1, At, B1); PG8_BAR; PG8_SCHED;
            PG8_LDA(At, 0, 1); PG8_STAGE(PG8_SB(0, 0), b2, voffB); PG8_STAGE(PG8_SB(0, 1), b2 + hstep, voffB); PG8_STAGE_A(PG8_SA(0, 0), a2, 0, k2, vg2);
            PG8_WAIT_V(8); PG8_WAIT_L(0); PG8_BAR; PG8_MMA(1, 0, At, B0); PG8_MMA(1, 1, At, B1); PG8_BAR; PG8_SCHED;
            PG8_LDB(B0, 1, 0); PG8_LDB(B1, 1, 1); PG8_SCHED; PG8_LDA(At, 1, 0); PG8_STAGE_A(PG8_SA(0, 1), a2, 1, k2, vg2);
            PG8_WAIT_V(8); PG8_WAIT_L(0); PG8_BAR; PG8_MMA(0, 0, At, B0); PG8_MMA(0, 1, At, B1); PG8_BAR; PG8_SCHED;
            PG8_LDA(At, 1, 1); PG8_STAGE(PG8_SB(1, 0), b3, voffB); PG8_STAGE(PG8_SB(1, 1), b3 + hstep, voffB); PG8_STAGE_A(PG8_SA(1, 0), a2, 0, k3, vg2);
            PG8_WAIT_V(8); PG8_WAIT_L(0); PG8_BAR; PG8_MMA(1, 0, At, B0); PG8_MMA(1, 1, At, B1); PG8_BAR; PG8_SCHED;
        }
        if constexpr (ALIGN_EPI) { if (wr == 0) PG8_BAR; }
        E(acc, cur, wr, wc, fr, fq);
        if (!has_next) break;
#pragma unroll
        for (int a = 0; a < 2; ++a)
#pragma unroll
            for (int b = 0; b < 2; ++b)
#pragma unroll
                for (int m = 0; m < 4; ++m)
#pragma unroll
                    for (int n = 0; n < 2; ++n) acc[a][b][m][n] = (f32x4){0.f, 0.f, 0.f, 0.f};
        cur = nxt; cA = nA; cB = nB; ++ui;
        if constexpr (GATHER) {
#pragma unroll
            for (int h = 0; h < 2; ++h)
#pragma unroll
                for (int i = 0; i < 2; ++i) vgc[h][i] = vgn[h][i];
        }
        if constexpr (ALIGN_EPI) { if (wr == 1) PG8_BAR; }
    }
    PG8_WAIT_V(0);
    if constexpr (!ALIGN_EPI) { if (wr == 0) PG8_BAR; }
    PG8_BAR;
#undef PG8_SA
#undef PG8_SB
#undef PG8_STAGE
#undef PG8_STAGE_A
#undef PG8_LDA
#undef PG8_LDB
#undef PG8_MMA
#undef PG8_WAIT_V
#undef PG8_WAIT_L
#undef PG8_BAR
#undef PG8_SCHED
}

struct RegOrder {
    int nM, nN, nwg, G, c, K; const char* Bt;
    __device__ __forceinline__ void init(int M, int N, int K_, const void* Bt_, int G_, int c_) { nM = M / BM; nN = N / BM; nwg = nM * nN; G = G_; c = c_; K = K_; Bt = (const char*)Bt_; }
    __device__ __forceinline__ bool next(int i, Unit& u) const {
        const long L = (long)i * G + c; if (L >= nwg) return false;
        int wgid = (int)L; { const int q = nwg / NXCD, r = nwg % NXCD, xcd = wgid % NXCD, off = wgid / NXCD; wgid = (xcd < r ? xcd * (q + 1) : r * (q + 1) + (xcd - r) * q) + off; }
        const int nig = WGM * nN, gid = wgid / nig, fm = gid * WGM, gsz = (nM - fm) < WGM ? (nM - fm) : WGM;
        const int pm = fm + ((wgid % nig) % gsz), pn = (wgid % nig) / gsz;
        u.arow = pm * BM; u.orow = pm * BM; u.ocol = pn * BM; u.e = 0; u.rt = 0; u.Bp = Bt + (size_t)pn * BM * K * 2; return true;
    }
    __device__ __forceinline__ int row_of(const Unit&, int) const { return 0; }
};
}
namespace at {
constexpr int NW = 8, QBLK = 32, KVBLK = 64, QB = NW * QBLK, D = 128;
constexpr int SHM_V = KVBLK * D * 2, SHM_K = KVBLK * D * 2;
constexpr int OFF_WS = 2 * SHM_V + 2 * SHM_K, OFF_NF = OFF_WS + NW * 64 * 4, ATT_LDS = OFF_NF + 2 * 64 * 4;
constexpr float SCALE = 0.08838834764831845f, C2 = 1.4426950408889634f * SCALE, THR = 8.f;
constexpr float ISCALE = 11.313708498984761f;
constexpr int QS = 128, KS = 128, VS = NZ, OS = DM;

#define KSWZ(row, colB) ((row) * 256 + ((colB) ^ (((row) & 7) << 4)))
#define SBAR() __builtin_amdgcn_sched_barrier(0)
__device__ __forceinline__ int v_st(int k, int c) { const int kk = (k & ~0xC) | ((k & 4) << 1) | ((k & 8) >> 1); return ((kk >> 3) * 4 + (c >> 5)) * 512 + ((kk & 7) * 32 + (c & 31)) * 2; }
__device__ __forceinline__ int v_rd_base(int lane) { return ((lane & 3) << 3) | (((lane >> 2) & 3) << 6) | (((lane >> 4) & 1) << 5) | (((lane >> 5) & 1) << 8); }
constexpr int v_rd_off(int d0, int ks, int half) { return d0 * 512 + ks * 4096 + half * 2048; }
__device__ __forceinline__ int crow(int r, int hi) { return (r & 3) + 8 * (r >> 2) + 4 * hi; }
__device__ __forceinline__ unsigned cvtpk(float lo, float hi) { unsigned r; asm volatile("v_cvt_pk_bf16_f32 %0, %1, %2" : "=v"(r) : "v"(lo), "v"(hi)); return r; }
__device__ __forceinline__ bf16x8 load8(const bf16* p) { return *(const GAS bf16x8*)p; }

__device__ __forceinline__ void mask_tile(f32x16& p0, f32x16& p1, int dq) {
    const float NEG = -__builtin_inff();
#pragma unroll
    for (int r = 0; r < 16; ++r) {
        const int c = (r & 3) + 8 * (r >> 2);
        if (dq - c < 0) p0[r] = NEG;
        if (dq - c - 32 < 0) p1[r] = NEG;
    }
}
__device__ __forceinline__ void partialSM(f32x16& p0, f32x16& p1, float& m_reg, float& mn, float& alpha) {
    float pmax = p0[0]; for (int r = 1; r < 16; ++r) pmax = fmaxf(pmax, p0[r]); for (int r = 0; r < 16; ++r) pmax = fmaxf(pmax, p1[r]);
    { auto rr = __builtin_amdgcn_permlane32_swap(__float_as_uint(pmax), __float_as_uint(pmax), false, false);
      pmax = fmaxf(__uint_as_float(rr[0]), __uint_as_float(rr[1])); }
    if (__builtin_expect(__all((pmax - m_reg) * SCALE <= THR), 1)) { mn = m_reg; alpha = 1.f; }
    else { mn = fmaxf(m_reg, pmax); alpha = __builtin_amdgcn_exp2f((m_reg - mn) * C2); m_reg = mn; }
    const float mnL = -mn * C2;
    for (int r = 0; r < 16; ++r) p0[r] = fmaf(p0[r], C2, mnL); for (int r = 0; r < 16; ++r) p1[r] = fmaf(p1[r], C2, mnL);
    for (int r = 0; r < 16; ++r) p0[r] = __builtin_amdgcn_exp2f(p0[r]);
}
__device__ __forceinline__ void finishSM(f32x16& p0, f32x16& p1, float alpha, float& l_reg, bf16x8& pa0, bf16x8& pa1, bf16x8& pa2, bf16x8& pa3) {
    for (int r = 0; r < 16; ++r) p1[r] = __builtin_amdgcn_exp2f(p1[r]);
    float ps = 0; for (int r = 0; r < 16; ++r) ps += p0[r]; for (int r = 0; r < 16; ++r) ps += p1[r];
    { auto rr = __builtin_amdgcn_permlane32_swap(__float_as_uint(ps), __float_as_uint(ps), false, false);
      ps = __uint_as_float(rr[0]) + __uint_as_float(rr[1]); }
    l_reg = l_reg * alpha + ps;
#define PK4(P, B_, OUT) do { unsigned a0 = cvtpk(P[B_+0], P[B_+1]), a1 = cvtpk(P[B_+2], P[B_+3]);                          \
        unsigned b0 = cvtpk(P[B_+4], P[B_+5]), b1 = cvtpk(P[B_+6], P[B_+7]);                                             \
        auto r0 = __builtin_amdgcn_permlane32_swap(a0, b0, false, false); auto r1 = __builtin_amdgcn_permlane32_swap(a1, b1, false, false); \
        u32x4 w = {r0[0], r1[0], r0[1], r1[1]}; OUT = *reinterpret_cast<bf16x8*>(&w); } while (0)
    PK4(p0, 0, pa0); PK4(p0, 8, pa1); PK4(p1, 0, pa2); PK4(p1, 8, pa3);
#undef PK4
}
template <int KB>
__device__ __forceinline__ void qkt(f32x16& p0, f32x16& p1, const char* K_lds, int r32, int hi, const bf16x8* qr) {
    { const float* nf = (const float*)(K_lds + 2 * SHM_K + NW * 64 * 4) + KB * 64 + 4 * hi;
#pragma unroll
      for (int g = 0; g < 4; ++g) { const f32x4 a = *(const f32x4*)(nf + 8 * g), b = *(const f32x4*)(nf + 32 + 8 * g);
#pragma unroll
          for (int j = 0; j < 4; ++j) { p0[4 * g + j] = a[j]; p1[4 * g + j] = b[j]; } } }
    const char* kb[4];
#pragma unroll
    for (int dd = 0; dd < 4; ++dd) kb[dd] = K_lds + KB * SHM_K + KSWZ(r32, (dd * 16 + hi * 8) * 2);
#pragma unroll
    for (int d0 = 0; d0 < 8; ++d0) { const char* a = kb[d0 & 3] + (d0 >> 2) * 128;
        bf16x8 b0 = *reinterpret_cast<const bf16x8*>(a);
        bf16x8 b1 = *reinterpret_cast<const bf16x8*>(a + 32 * 256);
        p0 = __builtin_amdgcn_mfma_f32_32x32x16_bf16(b0, qr[d0], p0, 0, 0, 0);
        p1 = __builtin_amdgcn_mfma_f32_32x32x16_bf16(b1, qr[d0], p1, 0, 0, 0); }
}
template <int VB>
__device__ __forceinline__ void pv_tile(f32x16* o, int vb0, bf16x8 pa0, bf16x8 pa1, bf16x8 pa2, bf16x8 pa3) {
#define TRRD(dst, off) asm volatile("ds_read_b64_tr_b16 %0, %1 offset:%2" : "=&v"(dst) : "v"(vb0), "i"(off) : "memory")
#define PV_D0(d0) do { s16x4 l0, l1, l2, l3, h0, h1, h2, h3; constexpr int b_ = VB * SHM_V + v_rd_off(d0, 0, 0); \
        TRRD(l0, b_); TRRD(h0, b_ + 2048); TRRD(l1, b_ + 4096); TRRD(h1, b_ + 6144); TRRD(l2, b_ + 8192); TRRD(h2, b_ + 10240); TRRD(l3, b_ + 12288); TRRD(h3, b_ + 14336); \
        asm volatile("s_waitcnt lgkmcnt(0)" ::: "memory"); SBAR();   \
        o[d0] = __builtin_amdgcn_mfma_f32_32x32x16_bf16(pa0, (bf16x8){l0[0], l0[1], l0[2], l0[3], h0[0], h0[1], h0[2], h0[3]}, o[d0], 0, 0, 0);   \
        o[d0] = __builtin_amdgcn_mfma_f32_32x32x16_bf16(pa1, (bf16x8){l1[0], l1[1], l1[2], l1[3], h1[0], h1[1], h1[2], h1[3]}, o[d0], 0, 0, 0);   \
        o[d0] = __builtin_amdgcn_mfma_f32_32x32x16_bf16(pa2, (bf16x8){l2[0], l2[1], l2[2], l2[3], h2[0], h2[1], h2[2], h2[3]}, o[d0], 0, 0, 0);   \
        o[d0] = __builtin_amdgcn_mfma_f32_32x32x16_bf16(pa3, (bf16x8){l3[0], l3[1], l3[2], l3[3], h3[0], h3[1], h3[2], h3[3]}, o[d0], 0, 0, 0); } while (0)
    PV_D0(0); PV_D0(1); PV_D0(2); PV_D0(3);
#undef PV_D0
#undef TRRD
}

struct BlockRef { const bf16* Q; const bf16* K; const bf16* V; bf16* O; const float* FK; int P0; };
#define ROWV(p, k0, rr) ((p) + (size_t)((k0) + (rr)) * VS + sc)
#define VMW() asm volatile("s_waitcnt vmcnt(0)" ::: "memory")
__device__ __forceinline__ void attn_block(const BlockRef& cur, int ja, int nt, bool fin, bf16* Opart, float* ML, char* lds, LAS unsigned char* ldsL) {
    const int tid = opq_tid(), wid = __builtin_amdgcn_readfirstlane(tid >> 6), lane = tid & 63, r32 = lane & 31, hi = lane >> 5;
    const int NT = nt;
    const int qlo = cur.P0 + wid * QBLK, qm = qlo + r32 - 4 * hi;
    char* V_lds = lds; char* K_lds = lds + 2 * SHM_V;
    float* ws = (float*)(lds + OFF_WS) + wid * 64; float* li_l = ws, * al_l = ws + 32;
    float m_reg = -1e30f, l_reg = 0; f32x16 o[4] = {};
    const int vb0 = (int)(uintptr_t)V_lds + v_rd_base(lane);
    const bf16* Kh = cur.K; const bf16* Vh = cur.V; const float* Fh = cur.FK;
    bf16x8 st_v0, st_v1; bf16x8 qr[8];
#define KDMA(bf, k0) do { int t_ = tid; asm volatile("" : "+v"(t_)); _Pragma("unroll") for (int i_ = 0; i_ < 2; ++i_) { const int p_ = i_ * 512 + t_, r_ = p_ >> 4, c_ = (p_ & 15) ^ (r_ & 7); \
        __builtin_amdgcn_global_load_lds((const unsigned*)((const char*)Kh + (size_t)(k0) * KS * 2 + (unsigned)(r_ * KS * 2 + c_ * 16)), (LAS unsigned*)(ldsL + 2 * SHM_V + (bf) * SHM_K + i_ * 8192 + wid * 1024), 16, 0, 0); } \
        if (wid == 0) __builtin_amdgcn_global_load_lds((const unsigned*)(Fh + (k0) + lane), (LAS unsigned*)(ldsL + OFF_NF + (bf) * 256), 4, 0, 0); } while (0)
#define SLOADV(k0) do { int t_ = tid; asm volatile("" : "+v"(t_)); const int sr = t_ >> 4, sc = (t_ & 15) * 8; st_v0 = load8(ROWV(Vh, k0, sr)); st_v1 = load8(ROWV(Vh, k0, 32 + sr)); } while (0)
#define SWRITE_HV(bf) do { int t_ = tid; asm volatile("" : "+v"(t_)); const int sr = t_ >> 4, sc = (t_ & 15) * 8; *(bf16x8*)(V_lds + (bf) * SHM_V + v_st(sr, sc)) = st_v0; *(bf16x8*)(V_lds + (bf) * SHM_V + v_st(32 + sr, sc)) = st_v1; } while (0)
#define RESC(a) do { if (__any((a) < 1.f)) { if (hi == 0) al_l[r32] = (a); asm volatile("s_waitcnt lgkmcnt(0)" ::: "memory");              \
                     for (int d_ = 0; d_ < 4; ++d_) for (int r = 0; r < 16; ++r) o[d_][r] *= al_l[crow(r, hi)]; } } while (0)
#define KBASE(t) ((ja + (t)) * KVBLK)
#define MASKT(P0_, P1_, t) do { const int kb_ = KBASE(t); if (kb_ + KVBLK - 1 > qlo) mask_tile(P0_, P1_, qm - kb_); } while (0)
    f32x16 pA0, pA1, pB0, pB1; float mnA, mnB, alA, alB; bf16x8 pa0, pa1, pa2, pa3;
    KDMA(0, KBASE(0)); SLOADV(KBASE(0));
#pragma unroll
    for (int d0 = 0; d0 < 8; ++d0) qr[d0] = load8(cur.Q + (size_t)(wid * QBLK + r32) * QS + d0 * 16 + hi * 8);
    VMW(); SWRITE_HV(0);
    __syncthreads();
    if (NT > 1) { KDMA(1, KBASE(1)); SLOADV(KBASE(1)); }
    SBAR(); qkt<0>(pA0, pA1, K_lds, r32, hi, qr);
    MASKT(pA0, pA1, 0); partialSM(pA0, pA1, m_reg, mnA, alA);
    if (NT > 1) { VMW(); SWRITE_HV(1); }
    __syncthreads();
#define HALF_STEP(PX0, PX1, mnX, alX, PY0, PY1, alY, t, KB, VB, SB) do {                                                      \
        SBAR(); qkt<KB>(PX0, PX1, K_lds, r32, hi, qr);                                                                        \
        finishSM(PY0, PY1, alY, l_reg, pa0, pa1, pa2, pa3); SBAR();                                                           \
        if ((t) + 1 < NT) { KDMA(SB, KBASE((t) + 1)); SLOADV(KBASE((t) + 1)); SBAR(); }                                       \
        pv_tile<VB>(o, vb0, pa0, pa1, pa2, pa3); MASKT(PX0, PX1, (t)); partialSM(PX0, PX1, m_reg, mnX, alX);                  \
        VMW(); __syncthreads();                                                                                               \
        if ((t) + 1 < NT) { SWRITE_HV(SB); }                                                                                  \
        RESC(alX); __syncthreads(); } while (0)
    for (int t = 1; t + 1 < NT; t += 2) {
        HALF_STEP(pB0, pB1, mnB, alB, pA0, pA1, alA, t, 1, 0, 0);
        HALF_STEP(pA0, pA1, mnA, alA, pB0, pB1, alB, t + 1, 0, 1, 1);
    }
    const bool even = (NT & 1) == 0;
    if (even) { SBAR(); qkt<1>(pB0, pB1, K_lds, r32, hi, qr); SBAR(); }
    finishSM(pA0, pA1, alA, l_reg, pa0, pa1, pa2, pa3); SBAR();
    pv_tile<0>(o, vb0, pa0, pa1, pa2, pa3);
    if (even) { MASKT(pB0, pB1, NT - 1); partialSM(pB0, pB1, m_reg, mnB, alB); __syncthreads(); RESC(alB);
        finishSM(pB0, pB1, alB, l_reg, pa0, pa1, pa2, pa3); SBAR(); pv_tile<1>(o, vb0, pa0, pa1, pa2, pa3); }
    SBAR();
    if (hi == 0) li_l[r32] = l_reg; asm volatile("s_waitcnt lgkmcnt(0)" ::: "memory");
    float rli[16];
#pragma unroll
    for (int r = 0; r < 16; ++r) rli[r] = __builtin_amdgcn_rcpf(li_l[crow(r, hi)]);
    const int ostr = fin ? OS : D;
    bf16* Ow = (fin ? cur.O : Opart) + (size_t)(wid * QBLK) * ostr;
#pragma unroll
    for (int r = 0; r < 16; ++r) { const int orow = crow(r, hi);
#pragma unroll
        for (int d0 = 0; d0 < 4; ++d0) { const float v = o[d0][r] * rli[r];
            const float vn = __shfl_xor(v, 1);
            if ((r32 & 1) == 0) *(GAS unsigned*)(Ow + (size_t)orow * ostr + d0 * 32 + r32) = cvtpk(v, vn); } }
    if (!fin && hi == 0) { f32x2 mlv; mlv.x = m_reg; mlv.y = l_reg; *(GAS f32x2*)(ML + (size_t)(wid * QBLK + r32) * 2) = mlv; }
    __syncthreads();
#undef KDMA
#undef SLOADV
#undef SWRITE_HV
#undef RESC
#undef KBASE
#undef MASKT
#undef HALF_STEP
}
#undef ROWV
#undef VMW
}
struct Frame {
    LAS unsigned char* lds; volatile LAS unsigned* MISC; gu32* ctl;
    int tid, lane, wave, vcu, G;
    unsigned char* ws;
};
#define CAS __attribute__((address_space(4)))
__device__ __forceinline__ const float* karg(int k) { const CAS char* p = (const CAS char*)__builtin_amdgcn_kernarg_segment_ptr(); asm volatile("" : "+s"(p)); return *(const float* const CAS*)(p + 8 * k); }

__device__ __forceinline__ void tr_item(const float* W, size_t ldw, bf16* WT, size_t ldk, LAS float* scr, int lane) {
    const int kr = lane >> 3, c4 = (lane & 7) * 4;
    f32x4 v[8];
#pragma unroll
    for (int i = 0; i < 8; ++i) v[i] = __builtin_nontemporal_load((const GAS f32x4*)(W + (size_t)(8 * i + kr) * ldw + c4));
#pragma unroll
    for (int i = 0; i < 8; ++i) { LAS float* s = scr + (8 * i + kr) * 33 + c4; s[0] = v[i].x; s[1] = v[i].y; s[2] = v[i].z; s[3] = v[i].w; }
    LDS_WAIT();
    const int c = lane & 7;
#pragma unroll
    for (int j = 0; j < 4; ++j) { const int n = (lane >> 3) + 8 * j; const LAS float* s = scr + (8 * c) * 33 + n;
        u32x4 o; o.x = cvt_pk_bf16(s[0 * 33], s[1 * 33]); o.y = cvt_pk_bf16(s[2 * 33], s[3 * 33]); o.z = cvt_pk_bf16(s[4 * 33], s[5 * 33]); o.w = cvt_pk_bf16(s[6 * 33], s[7 * 33]);
        *(GAS u32x4*)(WT + (size_t)n * ldk + 8 * c) = o; }
    LDS_WAIT();
}
constexpr int I_IN = (DM / 64) * (NZ / 32), I_OUT = (DM / 64) * (DM / 32), I_GU = (DM / 64) * (DEX / 32), I_D = (DEX / 64) * (DM / 32);
constexpr int GV_FIRST = 43;
constexpr int BGI_SMALL = (NLAYER * 4 * 8) / 8, BGI_IN = I_IN / 8, BGI_GV0 = (128 - GV_FIRST) * 4, BGI_GV1 = 128 * 4, BGI_OUT = I_OUT / 8, BGI_GU = NEXP * 2 * I_GU / 8, BGI_D = NEXP * I_D / 8;
constexpr int BG_C0 = BGI_SMALL + BGI_IN;
constexpr int BG_C1 = BG_C0 + BGI_GV0 + BGI_OUT;
constexpr int BG_C2 = BG_C1 + BGI_GU;
constexpr int BG_C3 = BG_C2 + BGI_D;
constexpr int BG_C3B = BG_C3 + BGI_GV1;
constexpr int BG_C4 = BG_C3B + BGI_IN;
constexpr int BG_C5 = BG_C4 + BGI_OUT;
constexpr int BG_C6 = BG_C5 + BGI_GU;
constexpr int BG_C7 = BG_C6 + BGI_D;
__device__ __forceinline__ float mod_at(const unsigned char* ws, const float* b_ada, int l, int j) {
    const float* p = (const float*)(ws + WS_MODP) + (size_t)l * 6 * DM + j;
    return *(const GAS float*)(b_ada + (size_t)l * 6 * DM + j) + ((*(const GAS float*)p + *(const GAS float*)(p + 2 * 6 * DM)) + (*(const GAS float*)(p + 4 * 6 * DM) + *(const GAS float*)(p + 6 * 6 * DM)));
}
__device__ __forceinline__ void gemv_item(const Frame& F, unsigned char* ws, int w) {
    LAS float* sc = (LAS float*)F.lds; LAS f32x4* red = (LAS f32x4*)(F.lds + 8192);
    const int kq = w & 3, l = w >> 9, cb = (w >> 2) & 127, c4 = F.tid % 24, kg = F.tid / 24;
    if (F.tid < 512) sc[F.tid] = silu_f(*(const GAS float*)(karg(1) + kq * 512 + F.tid));
    __syncthreads();
    f32x4 acc = (f32x4){0.f, 0.f, 0.f, 0.f};
    if (kg < 21) {
        const float* wp = karg(2) + (size_t)l * DM * 6 * DM + (size_t)(kq * 512) * 6 * DM + cb * 96 + c4 * 4;
#pragma unroll 8
        for (int k = kg; k < 512; k += 21) { const f32x4 wv = __builtin_nontemporal_load((const GAS f32x4*)(wp + (size_t)k * 6 * DM)); acc += wv * sc[k]; }
        red[kg * 24 + c4] = acc;
    }
    __syncthreads();
    if (F.tid < 24) { f32x4 s = red[F.tid];
        for (int g = 1; g < 21; ++g) s += red[g * 24 + F.tid];
        *(GAS f32x4*)((float*)(ws + WS_MODP) + (size_t)kq * 2 * 6 * DM + (size_t)l * 6 * DM + cb * 96 + F.tid * 4) = s; }
    __syncthreads();
}
__device__ __forceinline__ void conv_wave_item(const Frame& F, unsigned char* ws, int r, int l, LAS float* scr) {
    if (r < I_IN) { const int kb = r / (NZ / 32), nb = r % (NZ / 32);
        tr_item(karg(6) + (size_t)l * DM * NIN + (size_t)(64 * kb) * NIN + 32 * nb, NIN, (bf16*)(ws + WS_WIN) + (size_t)l * NZ * DM + (size_t)(32 * nb) * DM + 64 * kb, DM, scr, F.lane); return; }
    r -= I_IN;
    if (r < I_OUT) { const int kb = r / (DM / 32), nb = r % (DM / 32);
        tr_item(karg(15) + (size_t)l * DM * DM + (size_t)(64 * kb) * DM + 32 * nb, DM, (bf16*)(ws + WS_WOUT) + (size_t)l * DM * DM + (size_t)(32 * nb) * DM + 64 * kb, DM, scr, F.lane); return; }
    r -= I_OUT;
    if (r < NEXP * 2 * I_GU) { const int e = r / (2 * I_GU); r -= e * 2 * I_GU; const int up = r >= I_GU; if (up) r -= I_GU; const int kb = r / (DEX / 32), nb = r % (DEX / 32), n0 = 32 * nb;
        const float* src = (up ? karg(19) : karg(18)) + ((size_t)l * NEXP + e) * DM * DEX + (size_t)(64 * kb) * DEX + n0;
        const int drow = (n0 >> 7) * 256 + (up ? 128 : 0) + (n0 & 127);
        tr_item(src, DEX, (bf16*)(ws + WS_WGU) + ((size_t)l * NEXP + e) * DM * DM + (size_t)drow * DM + 64 * kb, DM, scr, F.lane); return; }
    r -= NEXP * 2 * I_GU;
    { const int e = r / I_D; r -= e * I_D; const int kb = r / (DM / 32), nb = r % (DM / 32);
      tr_item(karg(20) + ((size_t)l * NEXP + e) * DEX * DM + (size_t)(64 * kb) * DM + 32 * nb, DM, (bf16*)(ws + WS_WD) + ((size_t)l * NEXP + e) * DM * DEX + (size_t)(32 * nb) * DEX + 64 * kb, DEX, scr, F.lane); }
}
__device__ __forceinline__ void bg_item(const Frame& F, unsigned char* ws, int t) {
    LAS float* scr = (LAS float*)(F.lds + 16384 + F.wave * 9216);
    if (t < BGI_SMALL) { const int r = t * 8 + F.wave, mat = r >> 3, q = r & 7, kb = q >> 2, nb = q & 3;
        tr_item(karg(10) + (size_t)mat * 128 * 128 + (size_t)(64 * kb) * 128 + 32 * nb, 128, (bf16*)(ws + WS_BWT) + (size_t)mat * 128 * 128 + (size_t)(32 * nb) * 128 + 64 * kb, 128, scr, F.lane); return; }
    t -= BGI_SMALL;
    if (t < BGI_IN) { conv_wave_item(F, ws, t * 8 + F.wave, 0, scr); return; }
    t -= BGI_IN;
    if (t < BGI_GV0) { gemv_item(F, ws, GV_FIRST * 4 + t); return; }
    t -= BGI_GV0;
    if (t < BGI_OUT + BGI_GU + BGI_D) { conv_wave_item(F, ws, I_IN + t * 8 + F.wave, 0, scr); return; }
    t -= BGI_OUT + BGI_GU + BGI_D;
    if (t < BGI_GV1) { gemv_item(F, ws, 512 + t); return; }
    t -= BGI_GV1;
    conv_wave_item(F, ws, t * 8 + F.wave, 1, scr);
}
__device__ __forceinline__ void bg_fill(const Frame& F0, int seam, int need) {
    unsigned char* const ws = opq(F0.ws); Frame F = F0; F.tid = opq_tid(); F.lane = F.tid & 63; F.lds = opq(F0.lds);
    LAS unsigned* slot = (LAS unsigned*)(F.lds + AUX_OFF + 24576);
    gu32* const ctl_ = opq(F0.ctl); gu32* ticket = ctl_ + CW_BGT; gu32* arr = ctl_ + CW_ARR + 64 * seam;
    unsigned tn = 0xffffffffu; bool pre = false;
    if (F.tid == 0 && slot[1] == 0u) { (void)__hip_atomic_fetch_add(arr, 1u, RLX_AGENT); const unsigned cur = __hip_atomic_load(ticket, RLX_AGENT);
        if (cur >= (unsigned)BG_C7) slot[1] = 1u;
        else if (cur < (unsigned)need || __hip_atomic_load(arr, RLX_AGENT) < (unsigned)F.G) tn = __hip_atomic_fetch_add(ticket, 1u, RLX_AGENT); }
    for (;;) {
        if (F.tid == 0) slot[0] = tn;
        __syncthreads();
        const unsigned t = __builtin_amdgcn_readfirstlane(slot[0]);
        __syncthreads();
        if (t >= (unsigned)BG_C7) { if (F.tid == 0 && t != 0xffffffffu) slot[1] = 1u; break; }
        if (F.tid == 0) { tn = 0xffffffffu; pre = (t + 2u < (unsigned)need);
            if (pre) tn = __hip_atomic_fetch_add(ticket, 1u, RLX_AGENT); }
        bg_item(F, ws, (int)t);
        if (F.tid == 0 && !pre) { if (t + 1u < (unsigned)need || __hip_atomic_load(arr, RLX_AGENT) < (unsigned)F.G) tn = __hip_atomic_fetch_add(ticket, 1u, RLX_AGENT); }
    }
}
__device__ __forceinline__ void p0_prologue(const Frame& F0) {
    unsigned char* const ws = opq(F0.ws); Frame F = F0; F.tid = opq_tid(); F.lane = F.tid & 63; F.lds = opq(F0.lds);
    for (int w = F.vcu; w < GV_FIRST * 4; w += F.G) gemv_item(F, ws, w);
    const float* const a_ws_ = karg(7);
    for (int i = (F.vcu * NTHR + F.tid) * 2; i < NLAYER * 4 * 128 * 128; i += F.G * NTHR * 2) {
        const int t = (i >> 7) & 127, s = i & 127;
        const f32x2 w = *(const GAS f32x2*)(a_ws_ + i);
        const bool keep = (s >> 6) <= (t >> 6);
        *(GAS unsigned*)((bf16*)(ws + WS_WM) + i) = keep ? cvt_pk_bf16(w.x, w.y) : 0u;
    }
}

template <int MODE>
__device__ __forceinline__ void phase_norm1(const Frame& F0, int l, const float* xin, float* xout, int lprev) {
    unsigned char* const ws = opq(F0.ws); Frame F = F0; F.tid = opq_tid(); F.lane = F.tid & 63; F.lds = opq(F0.lds);
    LAS float* wfT = (LAS float*)F.lds;
    LAS float* gaL = (LAS float*)(F.lds + 65536);
    LAS float* gbL = (LAS float*)(F.lds + 73728);
    LAS float* g2L = (LAS float*)(F.lds + 81920);
    LAS float* lf = (LAS float*)(F.lds + 90112);
    LAS int* hb = (LAS int*)(F.lds + 91136);
    const float* const b_ada_ = karg(3); const float* const c_bf_ = karg(14);
    if (MODE != 2) {
        const float* const w_in_ = karg(6); const float* const g_mix_ = karg(4);
        for (int i = F.tid; i < DM * 2; i += NTHR) { const int d = i >> 1, half = i & 1;
            const f32x4 w = *(const GAS f32x4*)(w_in_ + (size_t)l * DM * NIN + (size_t)d * NIN + NZ + half * 4);
            wfT[(half * 4 + 0) * DM + d] = w.x; wfT[(half * 4 + 1) * DM + d] = w.y; wfT[(half * 4 + 2) * DM + d] = w.z; wfT[(half * 4 + 3) * DM + d] = w.w; }
        for (int d = F.tid; d < DM; d += NTHR) { gaL[d] = *(const GAS float*)(g_mix_ + (size_t)l * DM + d) * (1.f + mod_at(ws, b_ada_, l, DM + d)); gbL[d] = mod_at(ws, b_ada_, l, d); }
    }
    if (MODE != 0) {
        for (int d = F.tid; d < DM; d += NTHR) g2L[d] = mod_at(ws, b_ada_, lprev, 5 * DM + d);
        if (F.tid == 0) { int a = 0; for (int e = 0; e < NEXP; ++e) { hb[e] = a; a += ((int)__hip_atomic_load(F.ctl + CW_CNT + 64 * lprev + e, RLX_AGENT) + 255) & ~255; } }
    }
    __syncthreads();
    const bf16* YB = (const bf16*)(ws + WS_YB);
    f32x4 vA[8], vB[8]; u32x2 yA0[8], yA1[8], yB0[8], yB1[8];
#define N1_LOAD(V, Y0, Y1, rr) do { const int t_ = c * 32 + F.wave * 4 + (rr);                                                                 \
        _Pragma("unroll") for (int j = 0; j < 8; ++j) V[j] = *(const GAS f32x4*)(xin + (size_t)t_ * DM + 256 * j + 4 * F.lane);                   \
        if (MODE != 0) { const int r0_ = __builtin_amdgcn_readlane(rowA, (rr)), r1_ = __builtin_amdgcn_readlane(rowB, (rr));                      \
            _Pragma("unroll") for (int j = 0; j < 8; ++j) { const int d = 256 * j + 4 * F.lane;                                                    \
                Y0[j] = *(const GAS u32x2*)(YB + (size_t)r0_ * DM + d); Y1[j] = *(const GAS u32x2*)(YB + (size_t)r1_ * DM + d); } } } while (0)
#define N1_PROC(V, Y0, Y1, rr) do { const int rl = F.wave * 4 + (rr), t = c * 32 + rl;                                                          \
        if (MODE != 0) { const float w0 = __builtin_bit_cast(float, __builtin_amdgcn_readlane(__builtin_bit_cast(int, gwA), (rr))), w1 = __builtin_bit_cast(float, __builtin_amdgcn_readlane(__builtin_bit_cast(int, gwB), (rr))); \
            _Pragma("unroll") for (int j = 0; j < 8; ++j) { const int d = 256 * j + 4 * F.lane;                                                    \
                const f32x4 g2 = *(const LAS f32x4*)(g2L + d); const u32x2 y0 = Y0[j], y1 = Y1[j];                                                 \
                f32x4 y; y.x = w0 * bf_lo(y0.x) + w1 * bf_lo(y1.x); y.y = w0 * bf_hi(y0.x) + w1 * bf_hi(y1.x); y.z = w0 * bf_lo(y0.y) + w1 * bf_lo(y1.y); y.w = w0 * bf_hi(y0.y) + w1 * bf_hi(y1.y); \
                V[j] = V[j] + g2 * y;                                                                                                               \
                *(GAS f32x4*)(xout + (size_t)t * DM + d) = V[j]; } }                                                                               \
        if (MODE != 2) {                                                                                                                           \
            float ss = 0.f;                                                                                                                        \
            _Pragma("unroll") for (int j = 0; j < 8; ++j) ss += (V[j].x * V[j].x + V[j].y * V[j].y) + (V[j].z * V[j].z + V[j].w * V[j].w);         \
            const float rs = rsqrtf(wave_sum(ss) * (1.f / DM) + EPSN);                                                                             \
            float fz[8] = {0.f, 0.f, 0.f, 0.f, 0.f, 0.f, 0.f, 0.f};                                                                                \
            bf16* hrow = (bf16*)(ws + WS_H) + (size_t)t * DM;                                                                                      \
            _Pragma("unroll") for (int j = 0; j < 8; ++j) { const int d = 256 * j + 4 * F.lane;                                                    \
                const f32x4 h = V[j] * rs * *(const LAS f32x4*)(gaL + d) + *(const LAS f32x4*)(gbL + d);                                           \
                u32x2 o; o.x = cvt_pk_bf16(h.x, h.y); o.y = cvt_pk_bf16(h.z, h.w);                                                                 \
                *(GAS u32x2*)(hrow + d) = o;                                                                                                       \
                _Pragma("unroll") for (int q = 0; q < 8; ++q) { const f32x4 w = *(const LAS f32x4*)(wfT + q * DM + d); fz[q] += (h.x * w.x + h.y * w.y) + (h.z * w.z + h.w * w.w); } } \
            _Pragma("unroll") for (int q = 0; q < 8; ++q) fz[q] = wave_sum(fz[q]);                                                                 \
            if (F.lane < 8) { float z = fz[0];                                                                                                     \
                _Pragma("unroll") for (int q = 1; q < 8; ++q) z = (F.lane == q) ? fz[q] : z;                                                       \
                z += *(const GAS float*)(c_bf_ + l * 8 + F.lane);                                                                                  \
                lf[rl * 8 + F.lane] = fminf(z, 0.f) - log1pf(__expf(-fabsf(z))); } } } while (0)
    for (int c = F.vcu; c < SEQ / 32; c += F.G) {
        int rowA = 0, rowB = 0; float gwA = 0.f, gwB = 0.f;
        if (MODE != 0) { const int t_ = c * 32 + F.wave * 4 + (F.lane & 3);
            const int* te = (const int*)(ws + WS_TOKE) + 2 * t_; const int* tp = (const int*)(ws + WS_TOKP) + 2 * t_; const float* tw = (const float*)(ws + WS_TOKW) + 2 * t_;
            rowA = hb[*(const GAS int*)te] + *(const GAS int*)tp; rowB = hb[*(const GAS int*)(te + 1)] + *(const GAS int*)(tp + 1); gwA = *(const GAS float*)tw; gwB = *(const GAS float*)(tw + 1); }
        N1_LOAD(vA, yA0, yA1, 0); N1_LOAD(vB, yB0, yB1, 1);
        N1_PROC(vA, yA0, yA1, 0); N1_LOAD(vA, yA0, yA1, 2);
        N1_PROC(vB, yB0, yB1, 1); N1_LOAD(vB, yB0, yB1, 3);
        N1_PROC(vA, yA0, yA1, 2); N1_PROC(vB, yB0, yB1, 3);
        if (MODE != 2) {
            __syncthreads();
            if (F.tid < 8) { float a = 0.f; float* floc = (float*)(ws + WS_FLOC);
                for (int r = 0; r < 32; ++r) { a += lf[r * 8 + F.tid]; *(GAS float*)(floc + (size_t)(c * 32 + r) * 8 + F.tid) = a; }
                *(GAS float*)((float*)(ws + WS_TOT) + c * 8 + F.tid) = a; }
            __syncthreads();
        }
    }
#undef N1_LOAD
#undef N1_PROC
}

__device__ __forceinline__ void phase_prep(const Frame& F0, int l) {
    unsigned char* const ws = opq(F0.ws); Frame F = F0; F.tid = opq_tid(); F.lane = F.tid & 63; F.lds = opq(F0.lds);
    LAS float* pre = (LAS float*)F.lds;
    {
        const float* tot = (const float*)(ws + WS_TOT);
        const int h = F.wave; double v0 = *(const GAS float*)(tot + (4 * F.lane + 0) * 8 + h), v1 = *(const GAS float*)(tot + (4 * F.lane + 1) * 8 + h), v2 = *(const GAS float*)(tot + (4 * F.lane + 2) * 8 + h), v3 = *(const GAS float*)(tot + (4 * F.lane + 3) * 8 + h);
        double s = v0 + v1 + v2 + v3, inc = s;
#pragma unroll
        for (int o = 1; o < 64; o <<= 1) { const double u = __shfl_up(inc, o); if (F.lane >= o) inc += u; }
        const double ex = inc - s;
        pre[h * 256 + 4 * F.lane + 0] = (float)ex; pre[h * 256 + 4 * F.lane + 1] = (float)(ex + v0); pre[h * 256 + 4 * F.lane + 2] = (float)(ex + v0 + v1); pre[h * 256 + 4 * F.lane + 3] = (float)(ex + v0 + v1 + v2);
    }
    __syncthreads();
    const bf16* Z = (const bf16*)(ws + WS_Z);
    float qg[16], kg[16], vg[8]; const float* const c_qg_ = karg(12); const float* const c_kg_ = karg(13); const float* const a_vg_ = karg(9);
#pragma unroll
    for (int i = 0; i < 16; ++i) { qg[i] = *(const GAS float*)(c_qg_ + l * 128 + (F.lane & 7) * 16 + i); kg[i] = *(const GAS float*)(c_kg_ + l * 128 + (F.lane & 7) * 16 + i); }
#pragma unroll
    for (int i = 0; i < 8; ++i) vg[i] = *(const GAS float*)(a_vg_ + l * 512 + F.lane * 8 + i);
    const int gw = F.vcu * NWAVES + F.wave, NGW = F.G * NWAVES;
    for (int t = gw; t < SEQ; t += NGW) {
        const bf16* zr = Z + (size_t)t * NZ;
#pragma unroll
        for (int which = 0; which < 2; ++which) {
            const u32x4 a = *(const GAS u32x4*)(zr + 1536 + which * 1024 + 16 * F.lane), b = *(const GAS u32x4*)(zr + 1536 + which * 1024 + 16 * F.lane + 8);
            float f[16]; f[0] = bf_lo(a.x); f[1] = bf_hi(a.x); f[2] = bf_lo(a.y); f[3] = bf_hi(a.y); f[4] = bf_lo(a.z); f[5] = bf_hi(a.z); f[6] = bf_lo(a.w); f[7] = bf_hi(a.w);
            f[8] = bf_lo(b.x); f[9] = bf_hi(b.x); f[10] = bf_lo(b.y); f[11] = bf_hi(b.y); f[12] = bf_lo(b.z); f[13] = bf_hi(b.z); f[14] = bf_lo(b.w); f[15] = bf_hi(b.w);
            float ss = 0.f;
#pragma unroll
            for (int i = 0; i < 16; ++i) ss += f[i] * f[i];
            ss += __shfl_xor(ss, 1); ss += __shfl_xor(ss, 2); ss += __shfl_xor(ss, 4);
            const float rs = rsqrtf(ss * (1.f / 128.f) + EPSN);
            u32x4 o0, o1;
#define QK_G(i) ((which ? kg[i] : qg[i]) * rs * f[i])
            o0.x = cvt_pk_bf16(QK_G(0), QK_G(1)); o0.y = cvt_pk_bf16(QK_G(2), QK_G(3)); o0.z = cvt_pk_bf16(QK_G(4), QK_G(5)); o0.w = cvt_pk_bf16(QK_G(6), QK_G(7));
            o1.x = cvt_pk_bf16(QK_G(8), QK_G(9)); o1.y = cvt_pk_bf16(QK_G(10), QK_G(11)); o1.z = cvt_pk_bf16(QK_G(12), QK_G(13)); o1.w = cvt_pk_bf16(QK_G(14), QK_G(15));
#undef QK_G
            bf16* dst = (bf16*)(ws + (which ? WS_KN : WS_QN)) + ((size_t)(F.lane >> 3) * SEQ + t) * 128 + (F.lane & 7) * 16;
            *(GAS u32x4*)dst = o0; *(GAS u32x4*)(dst + 8) = o1;
        }
        {
            const u32x4 a = *(const GAS u32x4*)(zr + 512 + 8 * F.lane);
            float f[8]; f[0] = bf_lo(a.x); f[1] = bf_hi(a.x); f[2] = bf_lo(a.y); f[3] = bf_hi(a.y); f[4] = bf_lo(a.z); f[5] = bf_hi(a.z); f[6] = bf_lo(a.w); f[7] = bf_hi(a.w);
            float ss = 0.f;
#pragma unroll
            for (int i = 0; i < 8; ++i) ss += f[i] * f[i];
            ss += __shfl_xor(ss, 1); ss += __shfl_xor(ss, 2); ss += __shfl_xor(ss, 4); ss += __shfl_xor(ss, 8);
            const float rs = rsqrtf(ss * (1.f / 128.f) + EPSN);
            u32x4 o; o.x = cvt_pk_bf16(f[0] * rs * vg[0], f[1] * rs * vg[1]); o.y = cvt_pk_bf16(f[2] * rs * vg[2], f[3] * rs * vg[3]); o.z = cvt_pk_bf16(f[4] * rs * vg[4], f[5] * rs * vg[5]); o.w = cvt_pk_bf16(f[6] * rs * vg[6], f[7] * rs * vg[7]);
            *(GAS u32x4*)((bf16*)(ws + WS_VN) + (size_t)t * 512 + 8 * F.lane) = o;
        }
        {
            const int w = 2 << (F.lane >> 4);
            const u32x4 a = *(const GAS u32x4*)(zr + 1024 + 8 * F.lane);
            float p[8]; p[0] = bf_lo(a.x); p[1] = bf_hi(a.x); p[2] = bf_lo(a.y); p[3] = bf_hi(a.y); p[4] = bf_lo(a.z); p[5] = bf_hi(a.z); p[6] = bf_lo(a.w); p[7] = bf_hi(a.w);
            float s[8];
#pragma unroll
            for (int i = 0; i < 8; ++i) s[i] = p[i];
            for (int j = 1; j < 16; ++j) { if (j < w && t - j >= 0) { const u32x4 b = *(const GAS u32x4*)(zr - (size_t)j * NZ + 1024 + 8 * F.lane);
                s[0] += bf_lo(b.x); s[1] += bf_hi(b.x); s[2] += bf_lo(b.y); s[3] += bf_hi(b.y); s[4] += bf_lo(b.z); s[5] += bf_hi(b.z); s[6] += bf_lo(b.w); s[7] += bf_hi(b.w); } }
            const float ic = 1.f / (float)((t + 1 < w) ? (t + 1) : w);
            u32x4 o; o.x = cvt_pk_bf16(s[0] * ic - p[0], s[1] * ic - p[1]); o.y = cvt_pk_bf16(s[2] * ic - p[2], s[3] * ic - p[3]); o.z = cvt_pk_bf16(s[4] * ic - p[4], s[5] * ic - p[5]); o.w = cvt_pk_bf16(s[6] * ic - p[6], s[7] * ic - p[7]);
            *(GAS u32x4*)((bf16*)(ws + WS_DP) + (size_t)t * 512 + 8 * F.lane) = o;
        }
        if (F.lane < 8) *(GAS float*)((float*)(ws + WS_FKL) + (size_t)F.lane * SEQ + t) = (pre[F.lane * 256 + (t >> 5)] + *(const GAS float*)((const float*)(ws + WS_FLOC) + (size_t)t * 8 + F.lane)) * -11.313708498984761f;
    }
}

__device__ __forceinline__ void phase_small_item(const Frame& F0, int l, int item) {
    unsigned char* const ws = opq(F0.ws); Frame F = F0; F.tid = opq_tid(); F.lane = F.tid & 63; F.lds = opq(F0.lds);
    const int fr = F.lane & 15, fq = F.lane >> 4, w = F.wave;
    const bf16* Z = (const bf16*)(ws + WS_Z); bf16* YC = (bf16*)(ws + WS_YCAT);
    f32x4 acc[8];
#pragma unroll
    for (int m = 0; m < 8; ++m) acc[m] = (f32x4){0.f, 0.f, 0.f, 0.f};
    const float* a_bs_ = opq(karg(8)); const float* b_scale_ = opq(karg(11));
    if (item < 256) {
        const int blk = item >> 2, h = item & 3;
        const bf16* VN = (const bf16*)(ws + WS_VN) + (size_t)(blk * 128) * 512 + h * 128 + 16 * w + fr;
        const bf16* WM = (const bf16*)(ws + WS_WM) + ((size_t)(l * 4 + h) * 128) * 128;
        bf16x8 yb[4];
#pragma unroll
        for (int ks = 0; ks < 4; ++ks)
#pragma unroll
            for (int j = 0; j < 8; ++j) yb[ks][j] = (short)*(const GAS bf16*)(VN + (size_t)(ks * 32 + 8 * fq + j) * 512);
#pragma unroll
        for (int m = 0; m < 8; ++m)
#pragma unroll
            for (int ks = 0; ks < 4; ++ks) { const bf16x8 xa = *(const GAS bf16x8*)(WM + (size_t)(16 * m + fr) * 128 + ks * 32 + 8 * fq);
                acc[m] = __builtin_amdgcn_mfma_f32_16x16x32_bf16(yb[ks], xa, acc[m], 0, 0, 0); }
#pragma unroll
        for (int m = 0; m < 8; ++m) { const int tl = 16 * m + fr, t = blk * 128 + tl, col = h * 128 + 16 * w + 4 * fq;
            const float bsv = *(const GAS float*)(a_bs_ + l * 512 + h * 128 + tl);
            const u32x2 u = *(const GAS u32x2*)(Z + (size_t)t * NZ + col);
            u32x2 o; o.x = cvt_pk_bf16(bf_lo(u.x) * (acc[m][0] + bsv), bf_hi(u.x) * (acc[m][1] + bsv)); o.y = cvt_pk_bf16(bf_lo(u.y) * (acc[m][2] + bsv), bf_hi(u.y) * (acc[m][3] + bsv));
            *(GAS u32x2*)(YC + (size_t)t * DM + col) = o; }
    } else {
        const int rb = (item - 256) >> 2, g = (item - 256) & 3;
        const bf16* DP = (const bf16*)(ws + WS_DP) + (size_t)(rb * 128) * 512 + g * 128;
        const bf16* BWT = (const bf16*)(ws + WS_BWT) + ((size_t)(l * 4 + g) * 128) * 128;
        bf16x8 yb[4];
#pragma unroll
        for (int ks = 0; ks < 4; ++ks) yb[ks] = *(const GAS bf16x8*)(BWT + (size_t)(16 * w + fr) * 128 + ks * 32 + 8 * fq);
#pragma unroll
        for (int m = 0; m < 8; ++m)
#pragma unroll
            for (int ks = 0; ks < 4; ++ks) { const bf16x8 xa = *(const GAS bf16x8*)(DP + (size_t)(16 * m + fr) * 512 + ks * 32 + 8 * fq);
                acc[m] = __builtin_amdgcn_mfma_f32_16x16x32_bf16(yb[ks], xa, acc[m], 0, 0, 0); }
        const f32x4 bsc = *(const GAS f32x4*)(b_scale_ + l * 512 + g * 128 + 16 * w + 4 * fq);
#pragma unroll
        for (int m = 0; m < 8; ++m) { const int t = rb * 128 + 16 * m + fr, col = 512 + g * 128 + 16 * w + 4 * fq;
            u32x2 o; o.x = cvt_pk_bf16(acc[m][0] * bsc.x, acc[m][1] * bsc.y); o.y = cvt_pk_bf16(acc[m][2] * bsc.z, acc[m][3] * bsc.w);
            *(GAS u32x2*)(YC + (size_t)t * DM + col) = o; }
    }
}

__device__ __forceinline__ void phase_norm2_route(const Frame& F0, int l) {
    unsigned char* const ws = opq(F0.ws); Frame F = F0; F.tid = opq_tid(); F.lane = F.tid & 63; F.lds = opq(F0.lds);
    LAS float* wrT = (LAS float*)F.lds;
    LAS float* gaL = (LAS float*)(F.lds + AUX_OFF);
    LAS float* gbL = (LAS float*)(F.lds + AUX_OFF + 8192);
    LAS int* lcnt = (LAS int*)(F.lds + AUX_OFF + 16384);
    const float* const w_router_ = karg(16); const float* const g_ffn_ = karg(5); const float* const b_ada_ = karg(3); const float* const b_router_ = karg(17);
    for (int i = F.tid; i < DM * 4; i += NTHR) { const int d = i >> 2, q = i & 3;
        const f32x4 w = *(const GAS f32x4*)(w_router_ + (size_t)d * 16 + q * 4);
        wrT[(q * 4 + 0) * DM + d] = w.x; wrT[(q * 4 + 1) * DM + d] = w.y; wrT[(q * 4 + 2) * DM + d] = w.z; wrT[(q * 4 + 3) * DM + d] = w.w; }
    for (int d = F.tid; d < DM; d += NTHR) { gaL[d] = *(const GAS float*)(g_ffn_ + (size_t)l * DM + d) * (1.f + mod_at(ws, b_ada_, l, 4 * DM + d)); gbL[d] = mod_at(ws, b_ada_, l, 3 * DM + d); }
    const float* X1 = (const float*)(ws + WS_X1);
    float brt[16];
#pragma unroll
    for (int e = 0; e < 16; ++e) brt[e] = *(const GAS float*)(b_router_ + e);
    for (int c = F.vcu; c < SEQ / 32; c += F.G) {
        if (F.tid < 32) lcnt[F.tid] = 0;
        __syncthreads();
        int my_e0 = 0, my_e1 = 0, my_r0 = 0, my_r1 = 0; float my_w0 = 0.f, my_w1 = 0.f;
        f32x4 vA[8], vB[8];
#define N2_LOAD(V, rr) do { const int t_ = c * 32 + F.wave * 4 + (rr); _Pragma("unroll") for (int j = 0; j < 8; ++j) V[j] = *(const GAS f32x4*)(X1 + (size_t)t_ * DM + 256 * j + 4 * F.lane); } while (0)
#define N2_PROC(V, rr) do { const int t = c * 32 + F.wave * 4 + (rr);                                                                           \
            float ss = 0.f;                                                                                                                        \
            _Pragma("unroll") for (int j = 0; j < 8; ++j) ss += (V[j].x * V[j].x + V[j].y * V[j].y) + (V[j].z * V[j].z + V[j].w * V[j].w);         \
            const float rs = rsqrtf(wave_sum(ss) * (1.f / DM) + EPSN);                                                                             \
            float lg[16];                                                                                                                          \
            _Pragma("unroll") for (int e = 0; e < 16; ++e) lg[e] = 0.f;                                                                            \
            bf16* hrow = (bf16*)(ws + WS_H) + (size_t)t * DM;                                                                                      \
            _Pragma("unroll") for (int j = 0; j < 8; ++j) { const int d = 256 * j + 4 * F.lane;                                                    \
                const f32x4 h = V[j] * rs * *(const LAS f32x4*)(gaL + d) + *(const LAS f32x4*)(gbL + d);                                           \
                u32x2 o; o.x = cvt_pk_bf16(h.x, h.y); o.y = cvt_pk_bf16(h.z, h.w);                                                                 \
                *(GAS u32x2*)(hrow + d) = o;                                                                                                       \
                _Pragma("unroll") for (int e = 0; e < 16; ++e) { const f32x4 w = *(const LAS f32x4*)(wrT + e * DM + d); lg[e] += (h.x * w.x + h.y * w.y) + (h.z * w.z + h.w * w.w); } } \
            _Pragma("unroll") for (int e = 0; e < 16; ++e) lg[e] = wave_sum(lg[e]);                                                                \
            float sc[16], sel[16];                                                                                                                 \
            _Pragma("unroll") for (int e = 0; e < 16; ++e) { sc[e] = 1.f / (1.f + __expf(-lg[e])); sel[e] = sc[e] + brt[e]; }                      \
            int bg = 0; float bgs = -INFINITY;                                                                                                     \
            _Pragma("unroll") for (int g = 0; g < 4; ++g) { float a = -INFINITY, b = -INFINITY;                                                    \
                _Pragma("unroll") for (int i = 0; i < 4; ++i) { const float x = sel[g * 4 + i]; if (x > a) { b = a; a = x; } else if (x > b) b = x; } \
                if (a + b > bgs) { bgs = a + b; bg = g; } }                                                                                        \
            int e0 = 0, e1 = 0; float a = -INFINITY, b = -INFINITY, s0 = 0.f, s1 = 0.f;                                                            \
            _Pragma("unroll") for (int g = 0; g < 4; ++g)                                                                                          \
                _Pragma("unroll") for (int i = 0; i < 4; ++i) { const int e = g * 4 + i; const float x = sel[e];                                   \
                    if (g == bg) { if (x > a) { b = a; e1 = e0; s1 = s0; a = x; e0 = e; s0 = sc[e]; } else if (x > b) { b = x; e1 = e; s1 = sc[e]; } } } \
            const float inv = 1.f / (s0 + s1);                                                                                                     \
            if (F.lane == (rr)) { my_e0 = e0; my_e1 = e1; my_w0 = s0 * inv; my_w1 = s1 * inv; } } while (0)
        N2_LOAD(vA, 0);
#pragma unroll 1
        for (int rp = 0; rp < 2; ++rp) {
            N2_LOAD(vB, 2 * rp + 1);
            N2_PROC(vA, 2 * rp);
            if (rp == 0) N2_LOAD(vA, 2);
            N2_PROC(vB, 2 * rp + 1);
        }
        if (F.lane < 4) { my_r0 = __hip_atomic_fetch_add(&lcnt[my_e0], 1, __ATOMIC_RELAXED, __HIP_MEMORY_SCOPE_WORKGROUP); my_r1 = __hip_atomic_fetch_add(&lcnt[my_e1], 1, __ATOMIC_RELAXED, __HIP_MEMORY_SCOPE_WORKGROUP); }
        __syncthreads();
        if (F.tid < 16) lcnt[16 + F.tid] = (int)__hip_atomic_fetch_add(F.ctl + CW_CNT + 64 * l + F.tid, (unsigned)lcnt[F.tid], RLX_AGENT);
        __syncthreads();
        if (F.lane < 4) { const int t = c * 32 + F.wave * 4 + F.lane;
            const int p0 = lcnt[16 + my_e0] + my_r0, p1 = lcnt[16 + my_e1] + my_r1;
            int* list = (int*)(ws + WS_LIST);
            *(GAS int*)(list + my_e0 * SEQ + p0) = t; *(GAS int*)(list + my_e1 * SEQ + p1) = t;
            *(GAS int*)((int*)(ws + WS_TOKE) + 2 * t) = my_e0; *(GAS int*)((int*)(ws + WS_TOKE) + 2 * t + 1) = my_e1;
            *(GAS int*)((int*)(ws + WS_TOKP) + 2 * t) = p0; *(GAS int*)((int*)(ws + WS_TOKP) + 2 * t + 1) = p1;
            *(GAS float*)((float*)(ws + WS_TOKW) + 2 * t) = my_w0; *(GAS float*)((float*)(ws + WS_TOKW) + 2 * t + 1) = my_w1; }
        __syncthreads();
    }
#undef N2_LOAD
#undef N2_PROC
}

struct MoeOrder {
    int G, c, total, K, nct; const char* Bt; size_t estride; const int* list; LAS int* tab;
    __device__ __forceinline__ bool next(int i, gm::Unit& u) const {
        const int L = i * G + c; if (L >= total) return false;
        const int q = L / nct, ct = L - q * nct;
        int e = 0;
#pragma unroll
        for (int k = 1; k < NEXP; ++k) e += (q >= tab[k]) ? 1 : 0;
        e = __builtin_amdgcn_readfirstlane(e);
        const int rt = q - __builtin_amdgcn_readfirstlane(tab[e]);
        u.e = e; u.rt = rt; u.arow = (__builtin_amdgcn_readfirstlane(tab[e]) + rt) * 256; u.orow = u.arow; u.ocol = ct * 256;
        u.Bp = Bt + (size_t)e * estride + (size_t)ct * 256 * K * 2; return true;
    }
    __device__ __forceinline__ int row_of(const gm::Unit& u, int r) const {
        const int p = u.rt * 256 + r, n = tab[32 + u.e], pc = p < n ? p : n - 1;
        const int v = *(const GAS int*)(list + u.e * SEQ + pc);
        return (p < n) ? v : 0;
    }
};
__device__ __forceinline__ void moe_table(Frame& F, int l, LAS int* tab) {
    __syncthreads();
    if (F.tid == 0) { int a = 0;
        for (int e = 0; e < NEXP; ++e) { const int n = (int)__hip_atomic_load(F.ctl + CW_CNT + 64 * l + e, RLX_AGENT); tab[e] = a; tab[32 + e] = n; a += (n + 255) >> 8; }
        tab[16] = a; }
    __syncthreads();
}

constexpr int ATT_CH = 16;
struct MixTab { LAS int* jlo; LAS int* items; LAS int* nitems; LAS float* fend; LAS int* scan; };
__device__ __forceinline__ MixTab mix_tab_ptrs(LAS unsigned char* lds) {
    MixTab T; T.jlo = (LAS int*)(lds + 69632); T.items = (LAS int*)(lds + 69632 + 1024); T.nitems = (LAS int*)(lds + 69632 + 1024 + 8192); T.fend = (LAS float*)(lds + 69632 + 1024 + 8192 + 64);
    T.scan = (LAS int*)(lds + 69632 + 1024 + 8192 + 64 + 4096); return T;
}
__device__ __forceinline__ void mix_build_table(const Frame& F0, int l, const MixTab& T) {
    unsigned char* const ws = opq(F0.ws); const int tid = opq_tid();
    const float* FKL = (const float*)(ws + WS_FKL);
    for (int i = tid; i < 1024; i += NTHR) T.fend[i] = *(const GAS float*)(FKL + (size_t)(i >> 7) * SEQ + (i & 127) * 64 + 63);
    float gq = 0.f, gk = 0.f; const float* const c_qg_ = karg(12); const float* const c_kg_ = karg(13);
    { const int ln = tid & 63; gq = fmaxf(fabsf(*(const GAS float*)(c_qg_ + l * 128 + ln)), fabsf(*(const GAS float*)(c_qg_ + l * 128 + 64 + ln))); gk = fmaxf(fabsf(*(const GAS float*)(c_kg_ + l * 128 + ln)), fabsf(*(const GAS float*)(c_kg_ + l * 128 + 64 + ln)));
#pragma unroll
      for (int o = 1; o < 64; o <<= 1) { gq = fmaxf(gq, __shfl_xor(gq, o)); gk = fmaxf(gk, __shfl_xor(gk, o)); } }
    const float thr = (2.f * 1.01f * 11.313708498984761f * gq * gk + 30.f) * 11.313708498984761f;
    __syncthreads();
    int nfull = 0, nrem = 0, jl = 0, nt = 0;
    if (tid < 256) { const int h = tid >> 5, qb = tid & 31; const float f0 = *(const GAS float*)(FKL + (size_t)h * SEQ + qb * 256);
        for (int j = 0; j < 4 * qb; ++j) jl += (T.fend[h * 128 + j] - f0 <= -thr) ? 1 : 0;
        nt = 4 * (qb + 1) - jl; nfull = nt / ATT_CH; nrem = (nt % ATT_CH) ? 1 : 0; T.jlo[tid] = jl | ((nfull + nrem) << 8); }
    if (tid < 256) { T.scan[tid] = nfull; T.scan[256 + tid] = nrem; }
    __syncthreads();
    for (int o = 1; o < 256; o <<= 1) { int a = 0, b = 0; if (tid < 256 && tid >= o) { a = T.scan[tid - o]; b = T.scan[256 + tid - o]; } __syncthreads();
        if (tid < 256) { T.scan[tid] += a; T.scan[256 + tid] += b; } __syncthreads(); }
    if (tid < 256) { const int totf = T.scan[255], pf = T.scan[tid] - nfull, pr = totf + T.scan[256 + tid] - nrem, jb = 4 * ((tid & 31) + 1);
        for (int c = 0; c < nfull; ++c) T.items[pf + c] = tid | (c << 8) | ((jb - (c + 1) * ATT_CH) << 12) | (ATT_CH << 20);
        if (nrem) T.items[pr] = tid | (nfull << 8) | (jl << 12) | ((nt - nfull * ATT_CH) << 20);
        if (tid == 255) T.nitems[0] = totf + T.scan[511]; }
    __syncthreads();
}
__device__ __forceinline__ void phase_attn_combine(const Frame& F0, int l, const MixTab& T) {
    unsigned char* const ws = opq(F0.ws); const int tid = opq_tid();
    const bf16* PART = (const bf16*)(ws + WS_PART); const float* MLb = (const float*)(ws + WS_ML); bf16* YC = (bf16*)(ws + WS_YCAT);
    for (int b = F0.vcu; b < 256; b += F0.G) {
        const int nch = __builtin_amdgcn_readfirstlane(T.jlo[b]) >> 8; if (nch <= 1) continue;
        const int h = b >> 5, qb = b & 31, row = tid >> 1, half = tid & 1;
        float m[8], w[8], mx = -3.0e38f, ws_ = 0.f;
#pragma unroll
        for (int c = 0; c < 8; ++c) { if (c < nch) { const f32x2 v = *(const GAS f32x2*)(MLb + ((size_t)(b * 8 + c) * 256 + row) * 2); m[c] = v.x; w[c] = v.y; mx = fmaxf(mx, v.x); } else { m[c] = -3.0e38f; w[c] = 0.f; } }
#pragma unroll
        for (int c = 0; c < 8; ++c) { w[c] = (c < nch) ? w[c] * __builtin_amdgcn_exp2f((m[c] - mx) * at::C2) : 0.f; ws_ += w[c]; }
        const float inv = 1.f / ws_;
        float acc[64];
#pragma unroll
        for (int i = 0; i < 64; ++i) acc[i] = 0.f;
#pragma unroll
        for (int c = 0; c < 8; ++c) { if (c < nch) { const bf16* p = PART + ((size_t)(b * 8 + c) * 256 + row) * 128 + half * 64; const float wc = w[c] * inv;
#pragma unroll
            for (int q = 0; q < 8; ++q) { const u32x4 v = *(const GAS u32x4*)(p + q * 8);
                acc[q * 8 + 0] += wc * bf_lo(v.x); acc[q * 8 + 1] += wc * bf_hi(v.x); acc[q * 8 + 2] += wc * bf_lo(v.y); acc[q * 8 + 3] += wc * bf_hi(v.y);
                acc[q * 8 + 4] += wc * bf_lo(v.z); acc[q * 8 + 5] += wc * bf_hi(v.z); acc[q * 8 + 6] += wc * bf_lo(v.w); acc[q * 8 + 7] += wc * bf_hi(v.w); } } }
        bf16* o = YC + (size_t)(qb * 256 + row) * DM + 1024 + h * 128 + half * 64;
#pragma unroll
        for (int q = 0; q < 8; ++q) { u32x4 v; v.x = cvt_pk_bf16(acc[q * 8 + 0], acc[q * 8 + 1]); v.y = cvt_pk_bf16(acc[q * 8 + 2], acc[q * 8 + 3]); v.z = cvt_pk_bf16(acc[q * 8 + 4], acc[q * 8 + 5]); v.w = cvt_pk_bf16(acc[q * 8 + 6], acc[q * 8 + 7]);
            *(GAS u32x4*)(o + q * 8) = v; }
    }
}

struct MoeDynOrder {
    int total, K; const char* Bt; size_t estride; LAS int* tab; gu32* ticket; gu32* ready; gu32* tmo; LAS unsigned* slot;
    __device__ __forceinline__ bool next(int, gm::Unit& u) const {
        if (__builtin_amdgcn_readfirstlane(threadIdx.x >> 6) == 0) {
            unsigned T = 0u;
            if ((threadIdx.x & 63) == 0) T = __hip_atomic_fetch_add(ticket, 1u, RLX_AGENT);
            T = __builtin_amdgcn_readfirstlane(T);
            if (T < (unsigned)total) {
                gu32* w = ready + 16 * (T >> 3); unsigned sp = 0u;
                while ((unsigned)__builtin_amdgcn_readfirstlane(__hip_atomic_load(w, RLX_AGENT)) < 64u) {
                    __builtin_amdgcn_s_sleep(2);
                    if ((++sp & 255u) == 0u) { if (__hip_atomic_load(tmo, RLX_AGENT) != 0u) break; if (sp > (1u << 20)) { __hip_atomic_store(tmo, 1u, RLX_AGENT); break; } } }
                __builtin_amdgcn_fence(__ATOMIC_ACQUIRE, "agent");
                asm volatile("s_waitcnt vmcnt(0)" ::: "memory");
            }
            if ((threadIdx.x & 63) == 0) slot[0] = T;
        }
        asm volatile("s_waitcnt lgkmcnt(0)" ::: "memory"); __builtin_amdgcn_s_barrier(); asm volatile("" ::: "memory");
        const unsigned T = (unsigned)__builtin_amdgcn_readfirstlane((int)slot[0]);
        if (T >= (unsigned)total) return false;
        const int q = (int)(T >> 3), ct = (int)(T & 7);
        int e = 0;
#pragma unroll
        for (int k = 1; k < NEXP; ++k) e += (q >= tab[k]) ? 1 : 0;
        e = __builtin_amdgcn_readfirstlane(e);
        u.e = e; u.rt = q - __builtin_amdgcn_readfirstlane(tab[e]); u.arow = q * 256; u.orow = u.arow; u.ocol = ct * 256;
        u.Bp = Bt + (size_t)e * estride + (size_t)ct * 256 * K * 2; return true;
    }
    __device__ __forceinline__ int row_of(const gm::Unit&, int) const { return 0; }
};
struct EpiZ {
    static constexpr bool PERM = true;
    bf16* O;
    __device__ __forceinline__ void operator()(const f32x4 (&acc)[2][2][4][2], const gm::Unit& u, int wr, int wc, int fr, int fq) const {
        const int row0 = u.orow + wr * 64 + fr, col0 = u.ocol + wc * 32 + 8 * fq; const bool act = u.ocol < 1024;
#pragma unroll
        for (int ai = 0; ai < 2; ++ai)
#pragma unroll
            for (int m = 0; m < 4; ++m) { bf16* rowp = O + (size_t)(row0 + ai * 128 + m * 16) * NZ + col0;
#pragma unroll
                for (int bj = 0; bj < 2; ++bj) { f32x4 v0 = acc[ai][bj][m][0], v1 = acc[ai][bj][m][1];
                    if (act) {
#pragma unroll
                        for (int j = 0; j < 4; ++j) { v0[j] = gelu_t(v0[j]); v1[j] = gelu_t(v1[j]); } }
                    u32x4 w; w.x = cvt_pk_bf16(v0[0], v0[1]); w.y = cvt_pk_bf16(v0[2], v0[3]); w.z = cvt_pk_bf16(v1[0], v1[1]); w.w = cvt_pk_bf16(v1[2], v1[3]);
                    *(GAS u32x4*)(rowp + bj * 128) = w; } }
    }
};
struct EpiRes {
    static constexpr bool PERM = false;
    const float* xin; const LAS float* gate; float* out;
    __device__ __forceinline__ void operator()(const f32x4 (&acc)[2][2][4][2], const gm::Unit& u, int wr, int wc, int fr, int fq) const {
        const int row0 = u.orow + wr * 64 + fr, col0 = u.ocol + wc * 32 + 4 * fq;
        f32x4 gv[2][2];
#pragma unroll
        for (int bj = 0; bj < 2; ++bj)
#pragma unroll
            for (int n = 0; n < 2; ++n) gv[bj][n] = *(const LAS f32x4*)(gate + col0 + bj * 128 + n * 16);
#pragma unroll
        for (int ai = 0; ai < 2; ++ai)
#pragma unroll
            for (int m = 0; m < 4; ++m) { const size_t off = (size_t)(row0 + ai * 128 + m * 16) * DM + col0;
#pragma unroll
                for (int bj = 0; bj < 2; ++bj)
#pragma unroll
                    for (int n = 0; n < 2; ++n) { const f32x4 xv = *(const GAS f32x4*)(xin + off + bj * 128 + n * 16);
                        *(GAS f32x4*)(out + off + bj * 128 + n * 16) = xv + gv[bj][n] * acc[ai][bj][m][n]; } }
    }
};
struct EpiHid {
    static constexpr bool PERM = true;
    bf16* O;
    __device__ __forceinline__ void operator()(const f32x4 (&acc)[2][2][4][2], const gm::Unit& u, int wr, int wc, int fr, int fq) const {
        const int row0 = u.orow + wr * 64 + fr, col0 = (u.ocol >> 1) + wc * 32 + 8 * fq;
#pragma unroll
        for (int ai = 0; ai < 2; ++ai)
#pragma unroll
            for (int m = 0; m < 4; ++m) { bf16* rowp = O + (size_t)(row0 + ai * 128 + m * 16) * DEX + col0;
                f32x4 h0, h1;
#pragma unroll
                for (int j = 0; j < 4; ++j) { h0[j] = silu_f(acc[ai][0][m][0][j]) * acc[ai][1][m][0][j]; h1[j] = silu_f(acc[ai][0][m][1][j]) * acc[ai][1][m][1][j]; }
                u32x4 w; w.x = cvt_pk_bf16(h0[0], h0[1]); w.y = cvt_pk_bf16(h0[2], h0[3]); w.z = cvt_pk_bf16(h1[0], h1[1]); w.w = cvt_pk_bf16(h1[2], h1[3]);
                *(GAS u32x4*)rowp = w; }
    }
};
struct EpiHidPub {
    static constexpr bool PERM = true;
    unsigned char* O; gu32* ready;
    __device__ __forceinline__ void operator()(const f32x4 (&acc)[2][2][4][2], const gm::Unit& u, int wr, int wc, int fr, int fq) const {
        const __amdgpu_buffer_rsrc_t rs = __builtin_amdgcn_make_buffer_rsrc(O, (short)0, (int)(HIDROWS * DEX * 2), 0x00020000);
        const int row0 = u.orow + wr * 64 + fr, col0 = (u.ocol >> 1) + wc * 32 + 8 * fq;
#pragma unroll
        for (int ai = 0; ai < 2; ++ai)
#pragma unroll
            for (int m = 0; m < 4; ++m) { const int off = ((row0 + ai * 128 + m * 16) * DEX + col0) * 2;
                f32x4 h0, h1;
#pragma unroll
                for (int j = 0; j < 4; ++j) { h0[j] = silu_f(acc[ai][0][m][0][j]) * acc[ai][1][m][0][j]; h1[j] = silu_f(acc[ai][0][m][1][j]) * acc[ai][1][m][1][j]; }
                u32x4 w; w.x = cvt_pk_bf16(h0[0], h0[1]); w.y = cvt_pk_bf16(h0[2], h0[3]); w.z = cvt_pk_bf16(h1[0], h1[1]); w.w = cvt_pk_bf16(h1[2], h1[3]);
                __builtin_amdgcn_raw_buffer_store_b128(w, rs, off, 0, 16); }
        asm volatile("s_waitcnt vmcnt(0)" ::: "memory");
        if (fr == 0 && fq == 0) (void)__hip_atomic_fetch_add(ready + 16 * (u.orow >> 8), 1u, RLX_AGENT);
    }
};
struct EpiYB {
    static constexpr bool PERM = true;
    bf16* O;
    __device__ __forceinline__ void operator()(const f32x4 (&acc)[2][2][4][2], const gm::Unit& u, int wr, int wc, int fr, int fq) const {
        const int row0 = u.orow + wr * 64 + fr, col0 = u.ocol + wc * 32 + 8 * fq;
#pragma unroll
        for (int ai = 0; ai < 2; ++ai)
#pragma unroll
            for (int m = 0; m < 4; ++m) { bf16* rowp = O + (size_t)(row0 + ai * 128 + m * 16) * DM + col0;
#pragma unroll
                for (int bj = 0; bj < 2; ++bj) { const f32x4 v0 = acc[ai][bj][m][0], v1 = acc[ai][bj][m][1];
                    u32x4 w; w.x = cvt_pk_bf16(v0[0], v0[1]); w.y = cvt_pk_bf16(v0[2], v0[3]); w.z = cvt_pk_bf16(v1[0], v1[1]); w.w = cvt_pk_bf16(v1[2], v1[3]);
                    *(GAS u32x4*)(rowp + bj * 128) = w; } }
    }
};

__device__ __forceinline__ int bg_need(int p) {
    if (p <= 1) return 0;
    if (p <= 5) return BG_C0;
    if (p <= 7) return BG_C1;
    if (p == 8) return BG_C3;
    if (p <= 10) return BG_C3B;
    if (p <= 14) return BG_C4;
    if (p <= 16) return BG_C5;
    return BG_C7;
}
__device__ __forceinline__ bool bg_seam(int k) { if (k == 0) return true; const int j = (k - 1) % 9; return j != 2 && j != 5 && j != 8; }
struct Args { const float* in[21]; float* out; unsigned char* ws; int ph_lo, ph_hi; };
constexpr int N_PHASES = 1 + 9 * NLAYER + 1;

__global__ void __launch_bounds__(NTHR, 2) mk_fwd(Args args) {
    extern __shared__ __attribute__((aligned(16))) unsigned char lds[];
    Frame F;
    F.lds = (LAS unsigned char*)lds; F.MISC = (volatile LAS unsigned*)(F.lds + MISC_OFF);
    F.tid = threadIdx.x; F.lane = F.tid & 63; F.wave = __builtin_amdgcn_readfirstlane(F.tid >> 6);
    F.G = gridDim.x; { const int bx = blockIdx.x; F.vcu = (F.G % 8 == 0) ? (bx % 8) * (F.G / 8) + bx / 8 : bx; }
    F.ws = args.ws; F.ctl = (gu32*)(args.ws + WS_CTL);
    for (int u = F.tid; u < (LDS_BYTES - RING_BYTES) / 4; u += NTHR) ((LAS unsigned*)(F.lds + RING_BYTES))[u] = 0u;
    __syncthreads();
    const int lo = args.ph_lo, hi = args.ph_hi;
    const bool multi = (hi - lo) > 1;
    XcdBarrier bar; bar.bar = (unsigned*)(F.ctl + CW_BAR); bar.x = 0; bar.st = nullptr;
    if (multi) bar = xcd_barrier_post((unsigned*)(F.ctl + CW_BAR), F.MISC + 8);
#ifdef MK_ONLY
#define IN(k) (((k) == 0 ? 0 : (((k) - 1) % 9) + 1) == MK_ONLY && lo <= (k) && (k) < hi)
#else
#define IN(k) (lo <= (k) && (k) < hi)
#endif
#ifndef MK_REPEAT
#define MK_REPEAT -1
#endif
#define REPS(kind) ((MK_REPEAT == (kind)) ? 2 : 1)
#define SEAM(k) do { if (IN(k)) { if (bg_seam(k)) bg_fill(F, (k), bg_need((k) + 1)); if (IN((k) + 1)) xcd_barrier(bar); } } while (0)

    for (int rep_ = 0; rep_ < REPS(0); ++rep_) if (IN(0)) { if (rep_) xcd_barrier(bar); p0_prologue(F); } SEAM(0);

    for (int l = 0; l < NLAYER; ++l) {
        const int pb = 1 + 9 * l;

        for (int rep_ = 0; rep_ < REPS(1); ++rep_) if (IN(pb)) { if (rep_) xcd_barrier(bar); unsigned char* const wsl = opq(F.ws); LAS unsigned char* const ldl = opq(F.lds); if (l == 0) phase_norm1<0>(F, l, karg(0), nullptr, 0); else phase_norm1<1>(F, l, (const float*)(wsl + WS_X1), (float*)(wsl + WS_X2), l - 1); }
        SEAM(pb);
        for (int rep_ = 0; rep_ < REPS(2); ++rep_) if (IN(pb + 1)) { if (rep_) xcd_barrier(bar); unsigned char* const wsl = opq(F.ws); LAS unsigned char* const ldl = opq(F.lds); gm::RegOrder S; S.init(SEQ, NZ, DM, wsl + WS_WIN + (size_t)l * NZ * DM * 2, F.G, (int)blockIdx.x);
            EpiZ E{(bf16*)(wsl + WS_Z)};
            gm::gemm_phase<EpiZ, gm::RegOrder, false, true>(ldl, (const char*)(wsl + WS_H), DM, S, E); }
        SEAM(pb + 1);
        for (int rep_ = 0; rep_ < REPS(3); ++rep_) if (IN(pb + 2)) { if (rep_) xcd_barrier(bar); unsigned char* const wsl = opq(F.ws); LAS unsigned char* const ldl = opq(F.lds); phase_prep(F, l); }
        SEAM(pb + 2);
        for (int rep_ = 0; rep_ < REPS(4); ++rep_) if (IN(pb + 3)) { if (rep_) xcd_barrier(bar); unsigned char* const wsl = opq(F.ws); LAS unsigned char* const ldl = opq(F.lds);
            const MixTab T = mix_tab_ptrs(ldl);
            mix_build_table(F, l, T);
            const int natt = __builtin_amdgcn_readfirstlane(T.nitems[0]), ntot = natt + 512;
            LAS int* qslot = T.nitems + 1;
            int it = F.vcu;
            while (it < ntot) {
                if (it >= natt) { phase_small_item(F, l, it - natt); }
                else {
                    const int rec = __builtin_amdgcn_readfirstlane(T.items[it]), b = rec & 255, c = (rec >> 8) & 15, ja = (rec >> 12) & 255, n = (rec >> 20) & 31, h = b >> 5, qb = b & 31;
                    const bool fin = (__builtin_amdgcn_readfirstlane(T.jlo[b]) >> 8) <= 1; unsigned char* const ws = opq(wsl);
                    at::BlockRef cur;
                    cur.Q = (const bf16*)(ws + WS_QN) + ((size_t)h * SEQ + qb * 256) * 128; cur.K = (const bf16*)(ws + WS_KN) + (size_t)h * SEQ * 128;
                    cur.V = (const bf16*)(ws + WS_Z) + 3584 + h * 128; cur.O = (bf16*)(ws + WS_YCAT) + (size_t)(qb * 256) * DM + 1024 + h * 128;
                    cur.FK = (const float*)(ws + WS_FKL) + (size_t)h * SEQ; cur.P0 = qb * 256;
                    at::attn_block(cur, ja, n, fin, (bf16*)(ws + WS_PART) + (size_t)(b * 8 + c) * 256 * 128, (float*)(ws + WS_ML) + (size_t)(b * 8 + c) * 256 * 2, (char*)ldl, ldl);
                }
                if (F.tid == 0) qslot[0] = F.G + (int)__hip_atomic_fetch_add(F.ctl + CW_Q + 64 * l + 32 * rep_, 1u, RLX_AGENT);
                __syncthreads();
                it = __builtin_amdgcn_readfirstlane(qslot[0]);
                __syncthreads();
            }
        }
        SEAM(pb + 3);
        for (int rep_ = 0; rep_ < REPS(5); ++rep_) if (IN(pb + 4)) { if (rep_) xcd_barrier(bar); unsigned char* const wsl = opq(F.ws); LAS unsigned char* const ldl = opq(F.lds); const MixTab T = mix_tab_ptrs(ldl); mix_build_table(F, l, T); phase_attn_combine(F, l, T); }
        SEAM(pb + 4);
        for (int rep_ = 0; rep_ < REPS(6); ++rep_) if (IN(pb + 5)) { if (rep_) xcd_barrier(bar); unsigned char* const wsl = opq(F.ws); LAS unsigned char* const ldl = opq(F.lds); gm::RegOrder S; S.init(SEQ, DM, DM, wsl + WS_WOUT + (size_t)l * DM * DM * 2, F.G, (int)blockIdx.x);
            LAS float* g1L = (LAS float*)(ldl + AUX_OFF);
            { const float* const b_ada_ = karg(3); for (int d = opq_tid(); d < DM; d += NTHR) g1L[d] = mod_at(wsl, b_ada_, l, 2 * DM + d); }
            __syncthreads();
            EpiRes E{(l == 0) ? karg(0) : (const float*)(wsl + WS_X2), g1L, (float*)(wsl + WS_X1)};
            gm::gemm_phase<EpiRes, gm::RegOrder, false, true>(ldl, (const char*)(wsl + WS_YCAT), DM, S, E); }
        SEAM(pb + 5);
        for (int rep_ = 0; rep_ < REPS(7); ++rep_) if (IN(pb + 6)) { if (rep_) xcd_barrier(bar); unsigned char* const wsl = opq(F.ws); LAS unsigned char* const ldl = opq(F.lds); phase_norm2_route(F, l); }
        SEAM(pb + 6);
        for (int rep_ = 0; rep_ < REPS(8); ++rep_) if (IN(pb + 7)) { if (rep_) xcd_barrier(bar); unsigned char* const wsl = opq(F.ws); LAS unsigned char* const ldl = opq(F.lds); LAS int* tab = (LAS int*)(ldl + AUX_OFF + 20480); moe_table(F, l, tab);
            gu32* const rdy = F.ctl + CW_RDY + 4096 * l + 2048 * rep_;
            { MoeOrder S; S.G = F.G; S.c = F.vcu; S.total = 8 * tab[16]; S.K = DM; S.nct = 8; S.Bt = (const char*)(wsl + WS_WGU) + (size_t)l * NEXP * DM * DM * 2; S.estride = (size_t)DM * DM * 2;
              S.list = (const int*)(wsl + WS_LIST); S.tab = tab;
              EpiHidPub E{wsl + (l ? WS_HID1 : WS_HID), rdy};
              gm::gemm_phase<EpiHidPub, MoeOrder, true, true>(ldl, (const char*)(wsl + WS_H), DM, S, E); }
            { MoeDynOrder S; S.total = 8 * tab[16]; S.K = DEX; S.Bt = (const char*)(wsl + WS_WD) + (size_t)l * NEXP * DM * DEX * 2; S.estride = (size_t)DM * DEX * 2; S.tab = tab;
              S.ticket = F.ctl + CW_MT + 64 * l + 32 * rep_; S.ready = rdy; S.tmo = F.ctl + CW_TMO; S.slot = (LAS unsigned*)(ldl + AUX_OFF + 24576 + 64);
              EpiYB E{(bf16*)(wsl + WS_YB)};
              gm::gemm_phase<EpiYB, MoeDynOrder, false, true>(ldl, (const char*)(wsl + (l ? WS_HID1 : WS_HID)), DEX, S, E); }
        }
        SEAM(pb + 7);
    }
    for (int rep_ = 0; rep_ < REPS(10); ++rep_) if (IN(N_PHASES - 1)) { if (rep_) xcd_barrier(bar); phase_norm1<2>(F, NLAYER - 1, (const float*)(F.ws + WS_X1), (float*)karg(21), NLAYER - 1); }
#undef IN
#undef SEAM
}

#ifndef MK_LAUNCHES
#define MK_LAUNCHES 1
#endif
extern "C" void kernel_launch(void* const* d_in, const int* in_sizes, int n_in, void* d_out, int out_size, void* d_ws, size_t ws_size, hipStream_t stream) {
    static int grid = 0;
    if (grid == 0) {
        int dev = 0, cus = 0, per_cu = 0;
        if (n_in != 21 || ws_size < WS_END) { fprintf(stderr, "kernel_launch: unexpected inputs (n_in %d, ws %zu)\n", n_in, ws_size); grid = -1; return; }
        if (hipGetDevice(&dev) != hipSuccess || hipDeviceGetAttribute(&cus, hipDeviceAttributeMultiprocessorCount, dev) != hipSuccess) { grid = -1; return; }
        if (hipFuncSetAttribute((const void*)mk_fwd, hipFuncAttributeMaxDynamicSharedMemorySize, LDS_BYTES) != hipSuccess) { fprintf(stderr, "kernel_launch: hipFuncSetAttribute failed\n"); grid = -1; return; }
        if (hipOccupancyMaxActiveBlocksPerMultiprocessor(&per_cu, (const void*)mk_fwd, NTHR, LDS_BYTES) != hipSuccess || per_cu < 1) fprintf(stderr, "kernel_launch: occupancy query says %d\n", per_cu);
        (void)hipGetLastError();
        grid = cus;
    }
    if (grid < 0) return;
    (void)hipMemsetAsync((char*)d_ws + WS_CTL, 0, CTL_ZERO_BYTES, stream);
    Args a{};
    for (int i = 0; i < 21; ++i) a.in[i] = (const float*)d_in[i];
    a.out = (float*)d_out; a.ws = (unsigned char*)d_ws;
#if MK_LAUNCHES == 1
    a.ph_lo = 0; a.ph_hi = N_PHASES;
    hipLaunchKernelGGL(mk_fwd, dim3(grid), dim3(NTHR), LDS_BYTES, stream, a);
#else
    for (int p = 0; p < N_PHASES; ++p) { a.ph_lo = p; a.ph_hi = p + 1; hipLaunchKernelGGL(mk_fwd, dim3(grid), dim3(NTHR), LDS_BYTES, stream, a); }
#endif
}
```

```cpp
#include <hip/hip_runtime.h>
#include <stdint.h>
#include <stdio.h>

#define GAS __attribute__((address_space(1)))
#define LAS __attribute__((address_space(3)))
typedef unsigned short bf16;
typedef short bf16x8 __attribute__((ext_vector_type(8)));
typedef short s16x4 __attribute__((ext_vector_type(4)));
typedef float f32x2 __attribute__((ext_vector_type(2)));
typedef float f32x4 __attribute__((ext_vector_type(4)));
typedef float f32x16 __attribute__((ext_vector_type(16)));
typedef unsigned u32x2 __attribute__((ext_vector_type(2)));
typedef unsigned u32x4 __attribute__((ext_vector_type(4)));
typedef int i32x8 __attribute__((ext_vector_type(8)));
typedef int i32x4 __attribute__((ext_vector_type(4)));
typedef GAS unsigned gu32;
#define RLX_AGENT __ATOMIC_RELAXED, __HIP_MEMORY_SCOPE_AGENT
#define LDS_WAIT() asm volatile("s_waitcnt lgkmcnt(0)" ::: "memory")
#define VM_WAIT() asm volatile("s_waitcnt vmcnt(0)" ::: "memory")

constexpr int DM = 2048, SEQ = 8192, NIN = 4616, NZ = 4608, DEX = 1024, NEXP = 16, NLAYER = 2;
constexpr float EPSN = 1e-6f;
constexpr float LOG2E = 1.4426950408889634f;
constexpr int NWAVES = 8, NTHR = 512;
constexpr int HIDROWS = 2 * SEQ + NEXP * 256;

constexpr size_t KiB = 1024, MiB = 1u << 20;
constexpr size_t WS_CTL = 0, CTL_ZERO_BYTES = 1 * MiB;
constexpr size_t WS_MOD = 1 * MiB;
constexpr size_t WS_FLOC = WS_MOD + 128 * KiB;
constexpr size_t WS_TOT = WS_FLOC + 256 * KiB;
constexpr size_t WS_FKL = WS_TOT + 8 * KiB;
constexpr size_t WS_TOKE = WS_FKL + 256 * KiB;
constexpr size_t WS_TOKP = WS_TOKE + 64 * KiB;
constexpr size_t WS_TOKW = WS_TOKP + 64 * KiB;
constexpr size_t WS_LIST = WS_TOKW + 64 * KiB;
constexpr size_t WS_WM = 4 * MiB;
constexpr size_t WS_BWT = WS_WM + 256 * KiB;
constexpr size_t WS_MODP = 6 * MiB;
constexpr size_t WS_WIN = 8 * MiB;
constexpr size_t WS_WOUT = WS_WIN + 2 * 18 * MiB;
constexpr size_t WS_WGU = WS_WOUT + 2 * 8 * MiB;
constexpr size_t WS_WD = WS_WGU + 2 * 16 * 8 * MiB;
constexpr size_t WS_H = WS_WD + 2 * 16 * 4 * MiB;
constexpr size_t WS_Z = WS_H + 32 * MiB;
constexpr size_t WS_QN = WS_Z + 72 * MiB;
constexpr size_t WS_KN = WS_QN + 16 * MiB;
constexpr size_t WS_VN = WS_KN + 16 * MiB;
constexpr size_t WS_DP = WS_VN + 8 * MiB;
constexpr size_t WS_YCAT = WS_DP + 8 * MiB;
constexpr size_t WS_X1 = WS_YCAT + 32 * MiB;
constexpr size_t WS_X2 = WS_X1 + 64 * MiB;
constexpr size_t WS_HID = WS_X2 + 64 * MiB;
constexpr size_t WS_YB = WS_HID + 40 * MiB;
constexpr size_t WS_PART = WS_YB + 80 * MiB;
constexpr size_t WS_ML = WS_PART + 128 * MiB;
constexpr size_t WS_HID1 = WS_ML + 4 * MiB;
constexpr size_t WS_END = WS_HID1 + 40 * MiB;
constexpr int CW_TMO = 0, CW_CODE = 1;
constexpr int CW_CNT = 64;
constexpr int CW_Q = 512;
constexpr int CW_BGT = 640;
constexpr int CW_ARR = 1024;
constexpr int CW_MT = 768;
constexpr int CW_BAR = 4096;
constexpr int CW_RDY = 8192;

constexpr int RING_BYTES = 131072;
constexpr int MISC_OFF = RING_BYTES + 320;
constexpr int AUX_OFF = RING_BYTES + 1024;
constexpr int LDS_BYTES = 163840;

template <class T> __device__ __forceinline__ T* opq(T* p) { asm volatile("" : "+s"(p)); return p; }
__device__ __forceinline__ int opq_tid(int wave) { int t = (wave << 6) | (int)__builtin_amdgcn_mbcnt_hi(~0u, __builtin_amdgcn_mbcnt_lo(~0u, 0u)); asm volatile("" : "+v"(t)); return t; }
__device__ __forceinline__ unsigned cvt_pk_bf16(float lo, float hi) { unsigned r; asm volatile("v_cvt_pk_bf16_f32 %0, %1, %2" : "=v"(r) : "v"(lo), "v"(hi)); return r; }
__device__ __forceinline__ unsigned cvt_pk4_fp8(float a, float b, float c, float d) {
    a = fminf(fmaxf(a, -440.f), 440.f); b = fminf(fmaxf(b, -440.f), 440.f); c = fminf(fmaxf(c, -440.f), 440.f); d = fminf(fmaxf(d, -440.f), 440.f);
    unsigned w; asm volatile("v_cvt_pk_fp8_f32 %0, %1, %2" : "=v"(w) : "v"(a), "v"(b)); asm volatile("v_cvt_pk_fp8_f32 %0, %1, %2 op_sel:[0,0,1]" : "+v"(w) : "v"(c), "v"(d)); return w; }
constexpr float H8_SCALE = 4.f, HID8_SCALE = 4.f, W8_SCALE = 64.f;
constexpr int SC_H8 = 0x7b7b7b7b, SC_HID8 = 0x7b7b7b7b, SC_W8 = 0x7b7b7b7b;
__device__ __forceinline__ float bf_lo(unsigned w) { return __uint_as_float(w << 16); }
__device__ __forceinline__ float bf_hi(unsigned w) { return __uint_as_float(w & 0xffff0000u); }
template <int M> __device__ __forceinline__ float xor_f(float v) {
    static_assert(M < 32, "xor_f: masks below 32 only");
    return __uint_as_float((unsigned)__builtin_amdgcn_ds_swizzle((int)__float_as_uint(v), (M << 10) | 0x1f));
}
__device__ __forceinline__ float wave_sum(float v) {
    v += xor_f<1>(v); v += xor_f<2>(v); v += xor_f<4>(v); v += xor_f<8>(v); v += xor_f<16>(v);
    { auto rr = __builtin_amdgcn_permlane32_swap(__float_as_uint(v), __float_as_uint(v), false, false); v = __uint_as_float(rr[0]) + __uint_as_float(rr[1]); }
    return v;
}
__device__ __forceinline__ float wave_max(float v) {
    v = fmaxf(v, xor_f<1>(v)); v = fmaxf(v, xor_f<2>(v)); v = fmaxf(v, xor_f<4>(v)); v = fmaxf(v, xor_f<8>(v)); v = fmaxf(v, xor_f<16>(v));
    { auto rr = __builtin_amdgcn_permlane32_swap(__float_as_uint(v), __float_as_uint(v), false, false); v = fmaxf(__uint_as_float(rr[0]), __uint_as_float(rr[1])); }
    return v;
}
__device__ __forceinline__ float gelu_t(float x) {
    const float u2 = x * (1.5957691216057308f + 0.0713548162726f * x * x);
    return x * __builtin_amdgcn_rcpf(1.f + __builtin_amdgcn_exp2f(-LOG2E * u2));
}
__device__ __forceinline__ float silu_f(float x) { return x * __builtin_amdgcn_rcpf(1.f + __builtin_amdgcn_exp2f(-LOG2E * x)); }

#define XB_TMO      128
#define XB_XCNT(j)  (256  + 64 * (j))
#define XB_XSUB(j)  (1280 + 64 * (j))
#define XB_XGEN(j)  (2304 + 64 * (j))
#define XB_TOP      3328
#define XB_TOPGEN   3392
#define XCD_BAR_WORDS 3456
#define XB_SPIN_CAP (1u << 18)
__device__ __forceinline__ unsigned xb_ld(unsigned* p)              { return __hip_atomic_load(p, __ATOMIC_RELAXED, __HIP_MEMORY_SCOPE_AGENT); }
__device__ __forceinline__ unsigned xb_add(unsigned* p, unsigned v) { return __hip_atomic_fetch_add(p, v, __ATOMIC_RELAXED, __HIP_MEMORY_SCOPE_AGENT); }
__device__ __forceinline__ unsigned xb_xcc_id() { return (unsigned)__builtin_amdgcn_s_getreg((3 << 11) | 20) & 0xFu; }
#define XB_SPIN(cond, bar) do { unsigned _sp = 0; while (cond) { __builtin_amdgcn_s_sleep(1); \
    if ((++_sp & 255u) == 0u) { if (xb_ld(&(bar)[XB_TMO])) break; if (_sp > XB_SPIN_CAP) { atomicAdd(&(bar)[XB_TMO], 1u); break; } } } } while (0)
struct XcdBarrier { unsigned* bar; unsigned x; volatile LAS unsigned* st; };
__device__ __forceinline__ XcdBarrier xcd_barrier_post(unsigned* bar, volatile LAS unsigned* st) {
    XcdBarrier b; b.bar = bar; b.x = xb_xcc_id(); b.st = st;
    if (threadIdx.x == 0) (void)xb_add(&bar[XB_XCNT(b.x)], 1u);
    return b;
}
__device__ __forceinline__ void xcd_barrier_complete(unsigned* bar, unsigned x, unsigned& nloc, unsigned& nx) {
    const unsigned G = gridDim.x * gridDim.y * gridDim.z;
    unsigned sum, cnt, mine, sp = 0u;
    for (;;) {
        sum = 0u; cnt = 0u; mine = 0u;
#pragma unroll
        for (unsigned j = 0; j < 16; ++j) { const unsigned c = xb_ld(&bar[XB_XCNT(j)]); sum += c; cnt += (c > 0u) ? 1u : 0u; mine = (j == x) ? c : mine; }
        if (sum == G) break;
        __builtin_amdgcn_s_sleep(1);
        if ((++sp & 255u) == 0u) { if (xb_ld(&bar[XB_TMO])) break; if (sp > XB_SPIN_CAP) { atomicAdd(&bar[XB_TMO], 1u); break; } }
    }
    nloc = mine > 0u ? mine : 1u; nx = cnt > 0u ? cnt : 1u;
}
__device__ __forceinline__ void xcd_barrier(const XcdBarrier& b) {
    asm volatile("s_waitcnt vmcnt(0)" ::: "memory");
    __syncthreads();
    if (threadIdx.x == 0) {
        unsigned* bar = b.bar; asm volatile("" : "+s"(bar));
        __builtin_amdgcn_s_waitcnt(0);
        unsigned nloc = b.st[0], nx = b.st[1];
        if (nloc == 0u) { xcd_barrier_complete(bar, b.x, nloc, nx); b.st[0] = nloc; b.st[1] = nx; }
        const unsigned old = xb_add(&bar[XB_XSUB(b.x)], 1u);
        const unsigned gen = old / nloc;
        if (old + 1u == (gen + 1u) * nloc) {
            __builtin_amdgcn_fence(__ATOMIC_RELEASE, "agent");
            asm volatile("s_waitcnt vmcnt(0)" ::: "memory");
            const unsigned og = xb_add(&bar[XB_TOP], 1u);
            const unsigned tg = og / nx;
            if (og + 1u == (tg + 1u) * nx) xb_add(&bar[XB_TOPGEN], 1u);
            else XB_SPIN(xb_ld(&bar[XB_TOPGEN]) == tg, bar);
            __builtin_amdgcn_fence(__ATOMIC_ACQUIRE, "agent");
            xb_add(&bar[XB_XGEN(b.x)], 1u);
            asm volatile("s_waitcnt vmcnt(0)" ::: "memory");
        } else {
            XB_SPIN(xb_ld(&bar[XB_XGEN(b.x)]) == gen, bar);
            __builtin_amdgcn_fence(__ATOMIC_ACQUIRE, "agent");
            asm volatile("s_waitcnt vmcnt(0)" ::: "memory");
        }
    }
    __syncthreads();
}

namespace gm {
constexpr int BM = 256, BK = 64, HALF = 128, HTB = HALF * BK * 2, STAGE_BYTES = 8 * HTB, NXCD = 8, WGM = 8;
__host__ __device__ __forceinline__ int lds_byte(int r, int c) { const int st = (r >> 4) * 2 + (c >> 5), rr = r & 15, cc = c & 31, ob = rr * 64 + cc * 2; return st * 1024 + (ob ^ (((ob >> 9) & 1) << 5)); }
__host__ __device__ __forceinline__ void stage_rc(int b, int& R, int& C) { const int st = b / 1024, sb = b % 1024, swz = sb ^ (((sb >> 9) & 1) << 5); R = (st >> 1) * 16 + swz / 64; C = (st & 1) * 32 + (swz % 64) / 2; }
__host__ __device__ __forceinline__ int perm32(int rho) { const int n = rho >> 4, i = rho & 15; return 8 * (i >> 2) + 4 * n + (i & 3); }

struct Unit { int arow, orow, ocol, e, rt; const char* Bp; };

template <class Epi, class Sched, bool GATHER, bool ALIGN_EPI, bool FP8 = false, int SCA = 0x7f7f7f7f, int SCB = 0x7f7f7f7f>
__device__ __forceinline__ void gemm_phase(LAS unsigned char* lds, const char* Abase, const int Kel, const Sched& S, const Epi& E, const int wv) {
    const int K = FP8 ? (Kel >> 1) : Kel;
    const int tid = opq_tid(wv), wid = wv, lane = tid & 63, wr = wid >> 2, wc = wid & 3, fr = lane & 15, fq = lane >> 4;
    const int nt = K / BK;
    unsigned voffA[2], voffB[2];
#pragma unroll
    for (int i = 0; i < 2; ++i) { int R, C; stage_rc(tid * 16 + i * 8192, R, C); const int Rb = Epi::PERM ? ((R & ~31) + perm32(R & 31)) : R;
        voffA[i] = (unsigned)(R * K + C) * 2u; voffB[i] = (unsigned)(Rb * K + C) * 2u; }
    const size_t kstep = (size_t)(BK * 2);
    const size_t hstep = (size_t)HALF * K * 2;
    const unsigned ldsw = (unsigned)wid * 1024u;
    const int aoff = FP8 ? lds_byte(wr * 64 + fr, fq * 16) : lds_byte(wr * 64 + fr, fq * 8), boff = FP8 ? lds_byte(wc * 32 + fr, fq * 16) : lds_byte(wc * 32 + fr, fq * 8);
#define PG8_SA(b, h) (((b) * 2 + (h)) * HTB)
#define PG8_SB(b, h) ((4 + (b) * 2 + (h)) * HTB)
#define PG8_STAGE(bufoff, gbase, voff) do { _Pragma("unroll") for (int _i = 0; _i < 2; ++_i) { unsigned vo_ = (voff)[_i]; asm volatile("" : "+v"(vo_));     \
        __builtin_amdgcn_global_load_lds((const unsigned*)((const char*)(gbase) + vo_), (LAS unsigned*)(lds + (bufoff) + ldsw + _i * 8192), 16, 0, 0); } } while (0)
#define PG8_STAGE_A(bufoff, ubase, h, kb, vg) do { if constexpr (GATHER) { PG8_STAGE(bufoff, Abase + (kb), (vg)[h]); } else { PG8_STAGE(bufoff, (ubase) + (h) * hstep + (kb), voffA); } } while (0)
#define PG8_STAGE_A2(bufoff, ubase, h, kb) PG8_STAGE_A(bufoff, ubase, h, kb, vgc)
#define PG8_LDA(dst, b, h) do { _Pragma("unroll") for (int m = 0; m < 4; ++m) { if constexpr (FP8) { dst##8[m].lo = *(const LAS i32x4*)(lds + PG8_SA(b, h) + aoff + m * 2048); dst##8[m].hi = *(const LAS i32x4*)(lds + PG8_SA(b, h) + aoff + 16 + m * 2048); } \
        else { dst[m][0] = *(const LAS bf16x8*)(lds + PG8_SA(b, h) + aoff + m * 2048); dst[m][1] = *(const LAS bf16x8*)(lds + PG8_SA(b, h) + aoff + 1024 + m * 2048); } } } while (0)
#define PG8_LDB(dst, b, h) do { _Pragma("unroll") for (int n = 0; n < 2; ++n) { if constexpr (FP8) { dst##8[n].lo = *(const LAS i32x4*)(lds + PG8_SB(b, h) + boff + n * 2048); dst##8[n].hi = *(const LAS i32x4*)(lds + PG8_SB(b, h) + boff + 16 + n * 2048); } \
        else { dst[n][0] = *(const LAS bf16x8*)(lds + PG8_SB(b, h) + boff + n * 2048); dst[n][1] = *(const LAS bf16x8*)(lds + PG8_SB(b, h) + boff + 1024 + n * 2048); } } } while (0)
#define PG8_F8(x) __builtin_shufflevector(__builtin_bit_cast(i32x4, (x)[0]), __builtin_bit_cast(i32x4, (x)[1]), 0, 1, 2, 3, 4, 5, 6, 7)
#define PG8_MMA(ai, bj, At, Bt) do { __builtin_amdgcn_s_setprio(1); _Pragma("unroll") for (int m = 0; m < 4; ++m) _Pragma("unroll") for (int n = 0; n < 2; ++n) { \
        if constexpr (FP8) { acc[ai][bj][m][n] = __builtin_amdgcn_mfma_scale_f32_16x16x128_f8f6f4(Bt##8[n], At##8[m], acc[ai][bj][m][n], 0, 0, 0, SCB, 0, SCA); } \
        else { _Pragma("unroll") for (int k = 0; k < 2; ++k) acc[ai][bj][m][n] = __builtin_amdgcn_mfma_f32_16x16x32_bf16(Bt[n][k], At[m][k], acc[ai][bj][m][n], 0, 0, 0); } } \
        __builtin_amdgcn_s_setprio(0); } while (0)
#define PG8_WAIT_V(n) asm volatile("s_waitcnt vmcnt(" #n ")" ::: "memory")
#define PG8_WAIT_L(n) asm volatile("s_waitcnt lgkmcnt(" #n ")" ::: "memory")
#define PG8_BAR __builtin_amdgcn_s_barrier()
#define PG8_SCHED __builtin_amdgcn_sched_barrier(0)
    Unit cur, nxt; int ui = 0;
    if (!S.next(0, cur)) return;
    f32x4 acc[2][2][4][2];
#pragma unroll
    for (int a = 0; a < 2; ++a)
#pragma unroll
        for (int b = 0; b < 2; ++b)
#pragma unroll
            for (int m = 0; m < 4; ++m)
#pragma unroll
                for (int n = 0; n < 2; ++n) acc[a][b][m][n] = (f32x4){0.f, 0.f, 0.f, 0.f};
    bf16x8 At[4][2], B0[2][2], B1[2][2];
    i32x8 At8[4], B08[2], B18[2];
    unsigned vgc[2][2];
    if constexpr (GATHER) {
#pragma unroll
        for (int h = 0; h < 2; ++h)
#pragma unroll
            for (int i = 0; i < 2; ++i) { int R_, C_; stage_rc(opq_tid(wv) * 16 + i * 8192, R_, C_); vgc[h][i] = ((unsigned)S.row_of(cur, h * HALF + R_) * (unsigned)K + (unsigned)C_) * 2u; }
    }
    const char* cA = GATHER ? Abase : Abase + (size_t)cur.arow * K * 2; const char* cB = cur.Bp;
    PG8_STAGE(PG8_SB(0, 0), cB, voffB); PG8_STAGE(PG8_SB(0, 1), cB + hstep, voffB); PG8_STAGE_A(PG8_SA(0, 0), cA, 0, 0, vgc); PG8_STAGE_A(PG8_SA(0, 1), cA, 1, 0, vgc);
    if (wr == 1) PG8_BAR;
    PG8_WAIT_V(2); PG8_BAR;
    PG8_STAGE(PG8_SB(1, 0), cB + kstep, voffB); PG8_STAGE_A(PG8_SA(1, 0), cA, 0, kstep, vgc); PG8_STAGE(PG8_SB(1, 1), cB + hstep + kstep, voffB);
    PG8_WAIT_V(6); PG8_BAR;
    for (;;) {
        bool has_next = false;
        const char* nA = cA; const char* nB = cB;
        for (int t = 0; t < nt; t += 2) {
            const bool last = (t == nt - 2);
            if (last) { has_next = S.next(ui + 1, nxt); if (has_next) { nA = GATHER ? Abase : Abase + (size_t)nxt.arow * K * 2; nB = nxt.Bp; } }
            const size_t k1 = (size_t)(t + 1) * kstep;
            const char* a2 = last ? nA : cA; const char* b2 = last ? nB : cB + (size_t)(t + 2) * kstep;
            const size_t k2 = last ? 0 : (size_t)(t + 2) * kstep, k3 = k2 + kstep;
            const char* b3 = b2 + kstep;
            PG8_LDB(B0, 0, 0); PG8_LDB(B1, 0, 1); PG8_SCHED; PG8_LDA(At, 0, 0); PG8_STAGE_A(PG8_SA(1, 1), cA, 1, k1, vgc);
            if constexpr (GATHER) { if (last && has_next) {
#pragma unroll
                for (int h = 0; h < 2; ++h)
#pragma unroll
                    for (int i = 0; i < 2; ++i) { int R_, C_; stage_rc(opq_tid(wv) * 16 + i * 8192, R_, C_); vgc[h][i] = ((unsigned)S.row_of(nxt, h * HALF + R_) * (unsigned)K + (unsigned)C_) * 2u; } } }
            PG8_WAIT_V(8); PG8_WAIT_L(0); PG8_BAR; PG8_MMA(0, 0, At, B0); PG8_MMA(0, 1, At, B1); PG8_BAR; PG8_SCHED;
            PG8_LDA(At, 0, 1); PG8_STAGE(PG8_SB(0, 0), b2, voffB); PG8_STAGE(PG8_SB(0, 1), b2 + hstep, voffB); PG8_STAGE_A2(PG8_SA(0, 0), a2, 0, k2);
            PG8_WAIT_V(8); PG8_WAIT_L(0); PG8_BAR; PG8_MMA(1, 0, At, B0); PG8_MMA(1, 1, At, B1); PG8_BAR; PG8_SCHED;
            PG8_LDB(B0, 1, 0); PG8_LDB(B1, 1, 1); PG8_SCHED; PG8_LDA(At, 1, 0); PG8_STAGE_A2(PG8_SA(0, 1), a2, 1, k2);
            PG8_WAIT_V(8); PG8_WAIT_L(0); PG8_BAR; PG8_MMA(0, 0, At, B0); PG8_MMA(0, 1, At, B1); PG8_BAR; PG8_SCHED;
            PG8_LDA(At, 1, 1); PG8_STAGE(PG8_SB(1, 0), b3, voffB); PG8_STAGE(PG8_SB(1, 1), b3 + hstep, voffB); PG8_STAGE_A2(PG8_SA(1, 0), a2, 0, k3);
            PG8_WAIT_V(8); PG8_WAIT_L(0); PG8_BAR; PG8_MMA(1, 0, At, B0); PG8_MMA(1, 1, At, B1); PG8_BAR; PG8_SCHED;
        }
        if constexpr (ALIGN_EPI) { if (wr == 0) PG8_BAR; }
        E(acc, cur, wr, wc, fr, fq);
        if (!has_next) break;
#pragma unroll
        for (int a = 0; a < 2; ++a)
#pragma unroll
            for (int b = 0; b < 2; ++b)
#pragma unroll
                for (int m = 0; m < 4; ++m)
#pragma unroll
                    for (int n = 0; n < 2; ++n) acc[a][b][m][n] = (f32x4){0.f, 0.f, 0.f, 0.f};
        cur = nxt; cA = nA; cB = nB; ++ui;
        if constexpr (ALIGN_EPI) { if (wr == 1) PG8_BAR; }
    }
    PG8_WAIT_V(0);
    if constexpr (!ALIGN_EPI) { if (wr == 0) PG8_BAR; }
    PG8_BAR;
#undef PG8_SA
#undef PG8_SB
#undef PG8_STAGE
#undef PG8_STAGE_A
#undef PG8_STAGE_A2
#undef PG8_LDA
#undef PG8_LDB
#undef PG8_MMA
#undef PG8_F8
#undef PG8_WAIT_V
#undef PG8_WAIT_L
#undef PG8_BAR
#undef PG8_SCHED
}

struct RegOrder {
    int nM, nN, nwg, G, c, K; const char* Bt;
    __device__ __forceinline__ void init(int M, int N, int K_, const void* Bt_, int G_, int c_) { nM = M / BM; nN = N / BM; nwg = nM * nN; G = G_; c = c_; K = K_; Bt = (const char*)Bt_; }
    __device__ __forceinline__ bool next(int i, Unit& u) const {
        const long L = (long)i * G + c; if (L >= nwg) return false;
        int wgid = (int)L; { const int q = nwg / NXCD, r = nwg % NXCD, xcd = wgid % NXCD, off = wgid / NXCD; wgid = (xcd < r ? xcd * (q + 1) : r * (q + 1) + (xcd - r) * q) + off; }
        const int nig = WGM * nN, gid = wgid / nig, fm = gid * WGM, gsz = (nM - fm) < WGM ? (nM - fm) : WGM;
        const int pm = fm + ((wgid % nig) % gsz), pn = (wgid % nig) / gsz;
        u.arow = pm * BM; u.orow = pm * BM; u.ocol = pn * BM; u.e = 0; u.rt = 0; u.Bp = Bt + (size_t)pn * BM * K * 2; return true;
    }
    __device__ __forceinline__ int row_of(const Unit&, int) const { return 0; }
};
}
namespace at {
constexpr int NW = 8, QBLK = 32, KVBLK = 64, QB = NW * QBLK, D = 128;
constexpr int SHM_V = KVBLK * D * 2, SHM_K = KVBLK * D * 2;
constexpr int OFF_WS = 2 * SHM_V + 2 * SHM_K, OFF_NF = OFF_WS + NW * 64 * 4, ATT_LDS = OFF_NF + 2 * 64 * 4;
constexpr float SCALE = 0.08838834764831845f, C2 = 1.4426950408889634f * SCALE, THR = 8.f;
constexpr float ISCALE = 11.313708498984761f;
constexpr int QS = 128, KS = 128, VS = NZ, OS = DM;

#define KSWZ(row, colB) ((row) * 256 + ((colB) ^ (((row) & 7) << 4)))
#define SBAR() __builtin_amdgcn_sched_barrier(0)
__device__ __forceinline__ int v_st(int k, int c) { const int kk = (k & ~0xC) | ((k & 4) << 1) | ((k & 8) >> 1); return ((kk >> 3) * 4 + (c >> 5)) * 512 + ((kk & 7) * 32 + (c & 31)) * 2; }
__device__ __forceinline__ int v_rd_base(int lane) { return ((lane & 3) << 3) | (((lane >> 2) & 3) << 6) | (((lane >> 4) & 1) << 5) | (((lane >> 5) & 1) << 8); }
constexpr int v_rd_off(int d0, int ks, int half) { return d0 * 512 + ks * 4096 + half * 2048; }
__device__ __forceinline__ int crow(int r, int hi) { return (r & 3) + 8 * (r >> 2) + 4 * hi; }
__device__ __forceinline__ unsigned cvtpk(float lo, float hi) { unsigned r; asm volatile("v_cvt_pk_bf16_f32 %0, %1, %2" : "=v"(r) : "v"(lo), "v"(hi)); return r; }
__device__ __forceinline__ bf16x8 load8(const bf16* p) { return *(const GAS bf16x8*)p; }

__device__ __forceinline__ void mask_tile(f32x16& p0, f32x16& p1, int dq) {
    const float NEG = -__builtin_inff();
#pragma unroll
    for (int r = 0; r < 16; ++r) {
        const int c = (r & 3) + 8 * (r >> 2);
        if (dq - c < 0) p0[r] = NEG;
        if (dq - c - 32 < 0) p1[r] = NEG;
    }
}
__device__ __forceinline__ void partialSM(f32x16& p0, f32x16& p1, float& m_reg, float& mn, float& alpha) {
    float pmax = p0[0]; for (int r = 1; r < 16; ++r) pmax = fmaxf(pmax, p0[r]); for (int r = 0; r < 16; ++r) pmax = fmaxf(pmax, p1[r]);
    { auto rr = __builtin_amdgcn_permlane32_swap(__float_as_uint(pmax), __float_as_uint(pmax), false, false);
      pmax = fmaxf(__uint_as_float(rr[0]), __uint_as_float(rr[1])); }
    if (__builtin_expect(__all((pmax - m_reg) * SCALE <= THR), 1)) { mn = m_reg; alpha = 1.f; }
    else { mn = fmaxf(m_reg, pmax); alpha = __builtin_amdgcn_exp2f((m_reg - mn) * C2); m_reg = mn; }
    const float mnL = -mn * C2;
    for (int r = 0; r < 16; ++r) p0[r] = fmaf(p0[r], C2, mnL); for (int r = 0; r < 16; ++r) p1[r] = fmaf(p1[r], C2, mnL);
    for (int r = 0; r < 16; ++r) p0[r] = __builtin_amdgcn_exp2f(p0[r]);
}
__device__ __forceinline__ void finishSM(f32x16& p0, f32x16& p1, float alpha, float& l_reg, bf16x8& pa0, bf16x8& pa1, bf16x8& pa2, bf16x8& pa3) {
    for (int r = 0; r < 16; ++r) p1[r] = __builtin_amdgcn_exp2f(p1[r]);
    float ps = 0; for (int r = 0; r < 16; ++r) ps += p0[r]; for (int r = 0; r < 16; ++r) ps += p1[r];
    { auto rr = __builtin_amdgcn_permlane32_swap(__float_as_uint(ps), __float_as_uint(ps), false, false);
      ps = __uint_as_float(rr[0]) + __uint_as_float(rr[1]); }
    l_reg = l_reg * alpha + ps;
#define PK4(P, B_, OUT) do { unsigned a0 = cvtpk(P[B_+0], P[B_+1]), a1 = cvtpk(P[B_+2], P[B_+3]);                          \
        unsigned b0 = cvtpk(P[B_+4], P[B_+5]), b1 = cvtpk(P[B_+6], P[B_+7]);                                             \
        auto r0 = __builtin_amdgcn_permlane32_swap(a0, b0, false, false); auto r1 = __builtin_amdgcn_permlane32_swap(a1, b1, false, false); \
        u32x4 w = {r0[0], r1[0], r0[1], r1[1]}; OUT = *reinterpret_cast<bf16x8*>(&w); } while (0)
    PK4(p0, 0, pa0); PK4(p0, 8, pa1); PK4(p1, 0, pa2); PK4(p1, 8, pa3);
#undef PK4
}
template <int KB>
__device__ __forceinline__ void qkt(f32x16& p0, f32x16& p1, const char* K_lds, int r32, int hi, const bf16x8* qr) {
    { const float* nf = (const float*)(K_lds + 2 * SHM_K + NW * 64 * 4) + KB * 64 + 4 * hi;
#pragma unroll
      for (int g = 0; g < 4; ++g) { const f32x4 a = *(const f32x4*)(nf + 8 * g), b = *(const f32x4*)(nf + 32 + 8 * g);
#pragma unroll
          for (int j = 0; j < 4; ++j) { p0[4 * g + j] = a[j]; p1[4 * g + j] = b[j]; } } }
    const char* kb[4];
#pragma unroll
    for (int dd = 0; dd < 4; ++dd) kb[dd] = K_lds + KB * SHM_K + KSWZ(r32, (dd * 16 + hi * 8) * 2);
#pragma unroll
    for (int d0 = 0; d0 < 8; ++d0) { const char* a = kb[d0 & 3] + (d0 >> 2) * 128;
        bf16x8 b0 = *reinterpret_cast<const bf16x8*>(a);
        bf16x8 b1 = *reinterpret_cast<const bf16x8*>(a + 32 * 256);
        p0 = __builtin_amdgcn_mfma_f32_32x32x16_bf16(b0, qr[d0], p0, 0, 0, 0);
        p1 = __builtin_amdgcn_mfma_f32_32x32x16_bf16(b1, qr[d0], p1, 0, 0, 0); }
}
template <int VB>
__device__ __forceinline__ void pv_tile(f32x16* o, int vb0, bf16x8 pa0, bf16x8 pa1, bf16x8 pa2, bf16x8 pa3) {
#define TRRD(dst, off) asm volatile("ds_read_b64_tr_b16 %0, %1 offset:%2" : "=&v"(dst) : "v"(vb0), "i"(off) : "memory")
#define PV_D0(d0) do { s16x4 l0, l1, l2, l3, h0, h1, h2, h3; constexpr int b_ = VB * SHM_V + v_rd_off(d0, 0, 0); \
        TRRD(l0, b_); TRRD(h0, b_ + 2048); TRRD(l1, b_ + 4096); TRRD(h1, b_ + 6144); TRRD(l2, b_ + 8192); TRRD(h2, b_ + 10240); TRRD(l3, b_ + 12288); TRRD(h3, b_ + 14336); \
        asm volatile("s_waitcnt lgkmcnt(0)" ::: "memory"); SBAR();   \
        o[d0] = __builtin_amdgcn_mfma_f32_32x32x16_bf16(pa0, (bf16x8){l0[0], l0[1], l0[2], l0[3], h0[0], h0[1], h0[2], h0[3]}, o[d0], 0, 0, 0);   \
        o[d0] = __builtin_amdgcn_mfma_f32_32x32x16_bf16(pa1, (bf16x8){l1[0], l1[1], l1[2], l1[3], h1[0], h1[1], h1[2], h1[3]}, o[d0], 0, 0, 0);   \
        o[d0] = __builtin_amdgcn_mfma_f32_32x32x16_bf16(pa2, (bf16x8){l2[0], l2[1], l2[2], l2[3], h2[0], h2[1], h2[2], h2[3]}, o[d0], 0, 0, 0);   \
        o[d0] = __builtin_amdgcn_mfma_f32_32x32x16_bf16(pa3, (bf16x8){l3[0], l3[1], l3[2], l3[3], h3[0], h3[1], h3[2], h3[3]}, o[d0], 0, 0, 0); } while (0)
    PV_D0(0); PV_D0(1); PV_D0(2); PV_D0(3);
#undef PV_D0
#undef TRRD
}

struct BlockRef { const bf16* Q; const bf16* K; const bf16* V; bf16* O; const float* FK; int P0; };
#define ROWV(p, k0, rr) ((p) + (size_t)((k0) + (rr)) * VS + sc)
#define VMW() asm volatile("s_waitcnt vmcnt(0)" ::: "memory")
__device__ __forceinline__ void attn_block(const BlockRef& cur, int ja, int nt, bool fin, bf16* Opart, float* ML, char* lds, LAS unsigned char* ldsL, const int wv) {
    const int tid = opq_tid(wv), wid = wv, lane = tid & 63, r32 = lane & 31, hi = lane >> 5;
    const int NT = nt;
    const int qlo = cur.P0 + wid * QBLK, qm = qlo + r32 - 4 * hi;
    char* V_lds = lds; char* K_lds = lds + 2 * SHM_V;
    float* ws = (float*)(lds + OFF_WS) + wid * 64; float* li_l = ws, * al_l = ws + 32;
    float m_reg = -1e30f, l_reg = 0; f32x16 o[4] = {};
    const int vb0 = (int)(uintptr_t)V_lds + v_rd_base(lane);
    const bf16* Kh = cur.K; const bf16* Vh = cur.V; const float* Fh = cur.FK;
    bf16x8 st_v0, st_v1; bf16x8 qr[8];
#define KDMA(bf, k0) do { int t_ = tid; asm volatile("" : "+v"(t_)); _Pragma("unroll") for (int i_ = 0; i_ < 2; ++i_) { const int p_ = i_ * 512 + t_, r_ = p_ >> 4, c_ = (p_ & 15) ^ (r_ & 7); \
        __builtin_amdgcn_global_load_lds((const unsigned*)((const char*)Kh + (size_t)(k0) * KS * 2 + (unsigned)(r_ * KS * 2 + c_ * 16)), (LAS unsigned*)(ldsL + 2 * SHM_V + (bf) * SHM_K + i_ * 8192 + wid * 1024), 16, 0, 0); } \
        if (wid == 0) __builtin_amdgcn_global_load_lds((const unsigned*)(Fh + (k0) + lane), (LAS unsigned*)(ldsL + OFF_NF + (bf) * 256), 4, 0, 0); } while (0)
#define SLOADV(k0) do { int t_ = tid; asm volatile("" : "+v"(t_)); const int sr = t_ >> 4, sc = (t_ & 15) * 8; st_v0 = load8(ROWV(Vh, k0, sr)); st_v1 = load8(ROWV(Vh, k0, 32 + sr)); } while (0)
#define SWRITE_HV(bf) do { int t_ = tid; asm volatile("" : "+v"(t_)); const int sr = t_ >> 4, sc = (t_ & 15) * 8; *(bf16x8*)(V_lds + (bf) * SHM_V + v_st(sr, sc)) = st_v0; *(bf16x8*)(V_lds + (bf) * SHM_V + v_st(32 + sr, sc)) = st_v1; } while (0)
#define RESC(a) do { if (__any((a) < 1.f)) { if (hi == 0) al_l[r32] = (a); asm volatile("s_waitcnt lgkmcnt(0)" ::: "memory");              \
                     for (int d_ = 0; d_ < 4; ++d_) for (int r = 0; r < 16; ++r) o[d_][r] *= al_l[crow(r, hi)]; } } while (0)
#define KBASE(t) ((ja + (t)) * KVBLK)
#define MASKT(P0_, P1_, t) do { const int kb_ = KBASE(t); if (kb_ + KVBLK - 1 > qlo) mask_tile(P0_, P1_, qm - kb_); } while (0)
    f32x16 pA0, pA1, pB0, pB1; float mnA, mnB, alA, alB; bf16x8 pa0, pa1, pa2, pa3;
    KDMA(0, KBASE(0)); SLOADV(KBASE(0));
#pragma unroll
    for (int d0 = 0; d0 < 8; ++d0) qr[d0] = load8(cur.Q + (size_t)(wid * QBLK + r32) * QS + d0 * 16 + hi * 8);
    VMW(); SWRITE_HV(0);
    __syncthreads();
    if (NT > 1) { KDMA(1, KBASE(1)); SLOADV(KBASE(1)); }
    SBAR(); qkt<0>(pA0, pA1, K_lds, r32, hi, qr);
    MASKT(pA0, pA1, 0); partialSM(pA0, pA1, m_reg, mnA, alA);
    if (NT > 1) { VMW(); SWRITE_HV(1); }
    __syncthreads();
#define HALF_STEP(PX0, PX1, mnX, alX, PY0, PY1, alY, t, KB, VB, SB) do {                                                      \
        SBAR(); qkt<KB>(PX0, PX1, K_lds, r32, hi, qr);                                                                        \
        finishSM(PY0, PY1, alY, l_reg, pa0, pa1, pa2, pa3); SBAR();                                                           \
        if ((t) + 1 < NT) { KDMA(SB, KBASE((t) + 1)); SLOADV(KBASE((t) + 1)); SBAR(); }                                       \
        pv_tile<VB>(o, vb0, pa0, pa1, pa2, pa3); MASKT(PX0, PX1, (t)); partialSM(PX0, PX1, m_reg, mnX, alX);                  \
        VMW(); __syncthreads();                                                                                               \
        if ((t) + 1 < NT) { SWRITE_HV(SB); }                                                                                  \
        RESC(alX); __syncthreads(); } while (0)
    for (int t = 1; t + 1 < NT; t += 2) {
        HALF_STEP(pB0, pB1, mnB, alB, pA0, pA1, alA, t, 1, 0, 0);
        HALF_STEP(pA0, pA1, mnA, alA, pB0, pB1, alB, t + 1, 0, 1, 1);
    }
    const bool even = (NT & 1) == 0;
    if (even) { SBAR(); qkt<1>(pB0, pB1, K_lds, r32, hi, qr); SBAR(); }
    finishSM(pA0, pA1, alA, l_reg, pa0, pa1, pa2, pa3); SBAR();
    pv_tile<0>(o, vb0, pa0, pa1, pa2, pa3);
    if (even) { MASKT(pB0, pB1, NT - 1); partialSM(pB0, pB1, m_reg, mnB, alB); __syncthreads(); RESC(alB);
        finishSM(pB0, pB1, alB, l_reg, pa0, pa1, pa2, pa3); SBAR(); pv_tile<1>(o, vb0, pa0, pa1, pa2, pa3); }
    SBAR();
    if (hi == 0) li_l[r32] = l_reg; asm volatile("s_waitcnt lgkmcnt(0)" ::: "memory");
    float rli[16];
#pragma unroll
    for (int r = 0; r < 16; ++r) rli[r] = __builtin_amdgcn_rcpf(li_l[crow(r, hi)]);
    const int ostr = fin ? OS : D;
    bf16* Ow = (fin ? cur.O : Opart) + (size_t)(wid * QBLK) * ostr;
#pragma unroll
    for (int r = 0; r < 16; ++r) { const int orow = crow(r, hi);
#pragma unroll
        for (int d0 = 0; d0 < 4; ++d0) { const float v = o[d0][r] * rli[r];
            const float vn = xor_f<1>(v);
            if ((r32 & 1) == 0) *(GAS unsigned*)(Ow + (size_t)orow * ostr + d0 * 32 + r32) = cvtpk(v, vn); } }
    if (!fin && hi == 0) { f32x2 mlv; mlv.x = m_reg; mlv.y = l_reg; *(GAS f32x2*)(ML + (size_t)(wid * QBLK + r32) * 2) = mlv; }
    __syncthreads();
#undef KDMA
#undef SLOADV
#undef SWRITE_HV
#undef RESC
#undef KBASE
#undef MASKT
#undef HALF_STEP
}
#undef ROWV
#undef VMW
}
struct Frame {
    LAS unsigned char* lds; volatile LAS unsigned* MISC; gu32* ctl;
    int tid, lane, wave, vcu, G;
    unsigned char* ws;
};
#define CAS __attribute__((address_space(4)))
__device__ __forceinline__ const float* karg(int k) { const CAS char* p = (const CAS char*)__builtin_amdgcn_kernarg_segment_ptr(); asm volatile("" : "+s"(p)); return *(const float* const CAS*)(p + 8 * k); }

__device__ __forceinline__ void tr_item(const float* W, size_t ldw, bf16* WT, size_t ldk, LAS float* scr, int lane) {
    const int kr = lane >> 3, c4 = (lane & 7) * 4;
    f32x4 v[8];
#pragma unroll
    for (int i = 0; i < 8; ++i) v[i] = __builtin_nontemporal_load((const GAS f32x4*)(W + (size_t)(8 * i + kr) * ldw + c4));
#pragma unroll
    for (int i = 0; i < 8; ++i) { LAS float* s = scr + (8 * i + kr) * 33 + c4; s[0] = v[i].x; s[1] = v[i].y; s[2] = v[i].z; s[3] = v[i].w; }
    LDS_WAIT();
    const int c = lane & 7;
#pragma unroll
    for (int j = 0; j < 4; ++j) { const int n = (lane >> 3) + 8 * j; const LAS float* s = scr + (8 * c) * 33 + n;
        u32x4 o; o.x = cvt_pk_bf16(s[0 * 33], s[1 * 33]); o.y = cvt_pk_bf16(s[2 * 33], s[3 * 33]); o.z = cvt_pk_bf16(s[4 * 33], s[5 * 33]); o.w = cvt_pk_bf16(s[6 * 33], s[7 * 33]);
        *(GAS u32x4*)(WT + (size_t)n * ldk + 8 * c) = o; }
    LDS_WAIT();
}
__device__ __forceinline__ void tr_item8(const float* W, size_t ldw, unsigned char* WT, size_t ldk, LAS float* scr, int lane) {
    const int kr = lane >> 3, c4 = (lane & 7) * 4;
    f32x4 v[8];
#pragma unroll
    for (int i = 0; i < 8; ++i) v[i] = __builtin_nontemporal_load((const GAS f32x4*)(W + (size_t)(8 * i + kr) * ldw + c4));
#pragma unroll
    for (int i = 0; i < 8; ++i) { LAS float* s = scr + (8 * i + kr) * 33 + c4; s[0] = v[i].x; s[1] = v[i].y; s[2] = v[i].z; s[3] = v[i].w; }
    LDS_WAIT();
    const int c = lane & 3;
#pragma unroll
    for (int j = 0; j < 2; ++j) { const int n = (lane >> 2) + 16 * j; const LAS float* s = scr + (16 * c) * 33 + n;
        u32x4 o;
        o.x = cvt_pk4_fp8(s[0 * 33] * W8_SCALE, s[1 * 33] * W8_SCALE, s[2 * 33] * W8_SCALE, s[3 * 33] * W8_SCALE); o.y = cvt_pk4_fp8(s[4 * 33] * W8_SCALE, s[5 * 33] * W8_SCALE, s[6 * 33] * W8_SCALE, s[7 * 33] * W8_SCALE);
        o.z = cvt_pk4_fp8(s[8 * 33] * W8_SCALE, s[9 * 33] * W8_SCALE, s[10 * 33] * W8_SCALE, s[11 * 33] * W8_SCALE); o.w = cvt_pk4_fp8(s[12 * 33] * W8_SCALE, s[13 * 33] * W8_SCALE, s[14 * 33] * W8_SCALE, s[15 * 33] * W8_SCALE);
        *(GAS u32x4*)(WT + (size_t)n * ldk + 16 * c) = o; }
    LDS_WAIT();
}
constexpr int I_IN = (DM / 64) * (NZ / 32), I_OUT = (DM / 64) * (DM / 32), I_GU = (DM / 64) * (DEX / 32), I_D = (DEX / 64) * (DM / 32);
constexpr int GV_FIRST = 43;
constexpr int BGI_SMALL = (NLAYER * 4 * 8) / 8, BGI_IN = I_IN / 8, BGI_GV0 = (128 - GV_FIRST) * 4, BGI_GV1 = 128 * 4, BGI_OUT = I_OUT / 8, BGI_GU = NEXP * 2 * I_GU / 8, BGI_D = NEXP * I_D / 8;
constexpr int BG_C0 = BGI_SMALL + BGI_IN;
constexpr int BG_C1 = BG_C0 + BGI_GV0 + BGI_OUT;
constexpr int BG_C2 = BG_C1 + BGI_GU;
constexpr int BG_C3 = BG_C2 + BGI_D;
constexpr int BG_C3B = BG_C3 + BGI_GV1;
constexpr int BG_C4 = BG_C3B + BGI_IN;
constexpr int BG_C5 = BG_C4 + BGI_OUT;
constexpr int BG_C6 = BG_C5 + BGI_GU;
constexpr int BG_C7 = BG_C6 + BGI_D;
__device__ __forceinline__ float mod_at(const unsigned char* ws, const float* b_ada, int l, int j) {
    const float* p = (const float*)(ws + WS_MODP) + (size_t)l * 6 * DM + j;
    return *(const GAS float*)(b_ada + (size_t)l * 6 * DM + j) + ((*(const GAS float*)p + *(const GAS float*)(p + 2 * 6 * DM)) + (*(const GAS float*)(p + 4 * 6 * DM) + *(const GAS float*)(p + 6 * 6 * DM)));
}
__device__ __forceinline__ void gemv_item(const Frame& F, unsigned char* ws, int w) {
    LAS float* sc = (LAS float*)F.lds; LAS f32x4* red = (LAS f32x4*)(F.lds + 8192);
    const int kq = w & 3, l = w >> 9, cb = (w >> 2) & 127, c4 = F.tid % 24, kg = F.tid / 24;
    if (F.tid < 512) sc[F.tid] = silu_f(*(const GAS float*)(karg(1) + kq * 512 + F.tid));
    __syncthreads();
    f32x4 acc = (f32x4){0.f, 0.f, 0.f, 0.f};
    if (kg < 21) {
        const float* wp = karg(2) + (size_t)l * DM * 6 * DM + (size_t)(kq * 512) * 6 * DM + cb * 96 + c4 * 4;
#pragma unroll 8
        for (int k = kg; k < 512; k += 21) { const f32x4 wv = __builtin_nontemporal_load((const GAS f32x4*)(wp + (size_t)k * 6 * DM)); acc += wv * sc[k]; }
        red[kg * 24 + c4] = acc;
    }
    __syncthreads();
    if (F.tid < 24) { f32x4 s = red[F.tid];
        for (int g = 1; g < 21; ++g) s += red[g * 24 + F.tid];
        *(GAS f32x4*)((float*)(ws + WS_MODP) + (size_t)kq * 2 * 6 * DM + (size_t)l * 6 * DM + cb * 96 + F.tid * 4) = s; }
    __syncthreads();
}
__device__ __forceinline__ void conv_wave_item(const Frame& F, unsigned char* ws, int r, int l, LAS float* scr) {
    if (r < I_IN) { const int kb = r / (NZ / 32), nb = r % (NZ / 32);
        tr_item(karg(6) + (size_t)l * DM * NIN + (size_t)(64 * kb) * NIN + 32 * nb, NIN, (bf16*)(ws + WS_WIN) + (size_t)l * NZ * DM + (size_t)(32 * nb) * DM + 64 * kb, DM, scr, F.lane); return; }
    r -= I_IN;
    if (r < I_OUT) { const int kb = r / (DM / 32), nb = r % (DM / 32);
        tr_item(karg(15) + (size_t)l * DM * DM + (size_t)(64 * kb) * DM + 32 * nb, DM, (bf16*)(ws + WS_WOUT) + (size_t)l * DM * DM + (size_t)(32 * nb) * DM + 64 * kb, DM, scr, F.lane); return; }
    r -= I_OUT;
    if (r < NEXP * 2 * I_GU) { const int e = r / (2 * I_GU); r -= e * 2 * I_GU; const int up = r >= I_GU; if (up) r -= I_GU; const int kb = r / (DEX / 32), nb = r % (DEX / 32), n0 = 32 * nb;
        const float* src = (up ? karg(19) : karg(18)) + ((size_t)l * NEXP + e) * DM * DEX + (size_t)(64 * kb) * DEX + n0;
        const int drow = (n0 >> 7) * 256 + (up ? 128 : 0) + (n0 & 127);
        tr_item8(src, DEX, ws + WS_WGU + ((size_t)l * NEXP + e) * DM * DM + (size_t)drow * DM + 64 * kb, DM, scr, F.lane); return; }
    r -= NEXP * 2 * I_GU;
    { const int e = r / I_D; r -= e * I_D; const int kb = r / (DM / 32), nb = r % (DM / 32);
      tr_item8(karg(20) + ((size_t)l * NEXP + e) * DEX * DM + (size_t)(64 * kb) * DM + 32 * nb, DM, ws + WS_WD + ((size_t)l * NEXP + e) * DM * DEX + (size_t)(32 * nb) * DEX + 64 * kb, DEX, scr, F.lane); }
}
__device__ __forceinline__ void bg_item(const Frame& F, unsigned char* ws, int t) {
    LAS float* scr = (LAS float*)(F.lds + 16384 + F.wave * 9216);
    if (t < BGI_SMALL) { const int r = t * 8 + F.wave, mat = r >> 3, q = r & 7, kb = q >> 2, nb = q & 3;
        tr_item(karg(10) + (size_t)mat * 128 * 128 + (size_t)(64 * kb) * 128 + 32 * nb, 128, (bf16*)(ws + WS_BWT) + (size_t)mat * 128 * 128 + (size_t)(32 * nb) * 128 + 64 * kb, 128, scr, F.lane); return; }
    t -= BGI_SMALL;
    if (t < BGI_IN) { conv_wave_item(F, ws, t * 8 + F.wave, 0, scr); return; }
    t -= BGI_IN;
    if (t < BGI_GV0) { gemv_item(F, ws, GV_FIRST * 4 + t); return; }
    t -= BGI_GV0;
    if (t < BGI_OUT + BGI_GU + BGI_D) { conv_wave_item(F, ws, I_IN + t * 8 + F.wave, 0, scr); return; }
    t -= BGI_OUT + BGI_GU + BGI_D;
    if (t < BGI_GV1) { gemv_item(F, ws, 512 + t); return; }
    t -= BGI_GV1;
    conv_wave_item(F, ws, t * 8 + F.wave, 1, scr);
}
__device__ __forceinline__ void bg_fill(const Frame& F0, int seam, int need) {
    unsigned char* const ws = opq(F0.ws); Frame F = F0; F.tid = opq_tid(F0.wave); F.lane = F.tid & 63; F.lds = opq(F0.lds);
    LAS unsigned* slot = (LAS unsigned*)(F.lds + AUX_OFF + 24576);
    gu32* const ctl_ = opq(F0.ctl); gu32* ticket = ctl_ + CW_BGT; gu32* arr = ctl_ + CW_ARR + 64 * seam;
    unsigned tn = 0xffffffffu; bool pre = false;
    if (F.tid == 0 && slot[1] == 0u) { (void)__hip_atomic_fetch_add(arr, 1u, RLX_AGENT); const unsigned cur = __hip_atomic_load(ticket, RLX_AGENT);
        if (cur >= (unsigned)BG_C7) slot[1] = 1u;
        else if (cur < (unsigned)need || __hip_atomic_load(arr, RLX_AGENT) < (unsigned)F.G) tn = __hip_atomic_fetch_add(ticket, 1u, RLX_AGENT); }
    for (;;) {
        if (F.tid == 0) slot[0] = tn;
        __syncthreads();
        const unsigned t = __builtin_amdgcn_readfirstlane(slot[0]);
        __syncthreads();
        if (t >= (unsigned)BG_C7) { if (F.tid == 0 && t != 0xffffffffu) slot[1] = 1u; break; }
        if (F.tid == 0) { tn = 0xffffffffu; pre = (t + 2u < (unsigned)need);
            if (pre) tn = __hip_atomic_fetch_add(ticket, 1u, RLX_AGENT); }
        bg_item(F, ws, (int)t);
        if (F.tid == 0 && !pre) { if (t + 1u < (unsigned)need || __hip_atomic_load(arr, RLX_AGENT) < (unsigned)F.G) tn = __hip_atomic_fetch_add(ticket, 1u, RLX_AGENT); }
    }
}
__device__ __forceinline__ void p0_prologue(const Frame& F0) {
    unsigned char* const ws = opq(F0.ws); Frame F = F0; F.tid = opq_tid(F0.wave); F.lane = F.tid & 63; F.lds = opq(F0.lds);
    for (int w = F.vcu; w < GV_FIRST * 4; w += F.G) gemv_item(F, ws, w);
    const float* const a_ws_ = karg(7);
    for (int i = (F.vcu * NTHR + F.tid) * 2; i < NLAYER * 4 * 128 * 128; i += F.G * NTHR * 2) {
        const int t = (i >> 7) & 127, s = i & 127;
        const f32x2 w = *(const GAS f32x2*)(a_ws_ + i);
        const bool keep = (s >> 6) <= (t >> 6);
        *(GAS unsigned*)((bf16*)(ws + WS_WM) + i) = keep ? cvt_pk_bf16(w.x, w.y) : 0u;
    }
}

template <int MODE>
__device__ __forceinline__ void phase_norm1(const Frame& F0, int l, const float* xin, float* xout, int lprev) {
    unsigned char* const ws = opq(F0.ws); Frame F = F0; F.tid = opq_tid(F0.wave); F.lane = F.tid & 63; F.lds = opq(F0.lds);
    LAS float* wfT = (LAS float*)F.lds;
    LAS float* gaL = (LAS float*)(F.lds + 65536);
    LAS float* gbL = (LAS float*)(F.lds + 73728);
    LAS float* g2L = (LAS float*)(F.lds + 81920);
    LAS float* lf = (LAS float*)(F.lds + 90112);
    LAS int* hb = (LAS int*)(F.lds + 91136);
    const float* const b_ada_ = karg(3); const float* const c_bf_ = karg(14);
    if (MODE != 2) {
        const float* const w_in_ = karg(6); const float* const g_mix_ = karg(4);
        for (int i = F.tid; i < DM * 2; i += NTHR) { const int d = i >> 1, half = i & 1;
            const f32x4 w = *(const GAS f32x4*)(w_in_ + (size_t)l * DM * NIN + (size_t)d * NIN + NZ + half * 4);
            wfT[(half * 4 + 0) * DM + d] = w.x; wfT[(half * 4 + 1) * DM + d] = w.y; wfT[(half * 4 + 2) * DM + d] = w.z; wfT[(half * 4 + 3) * DM + d] = w.w; }
        for (int d = F.tid; d < DM; d += NTHR) { gaL[d] = *(const GAS float*)(g_mix_ + (size_t)l * DM + d) * (1.f + mod_at(ws, b_ada_, l, DM + d)); gbL[d] = mod_at(ws, b_ada_, l, d); }
    }
    if (MODE != 0) {
        for (int d = F.tid; d < DM; d += NTHR) g2L[d] = mod_at(ws, b_ada_, lprev, 5 * DM + d);
        if (F.tid == 0) { int a = 0; for (int e = 0; e < NEXP; ++e) { hb[e] = a; a += ((int)__hip_atomic_load(F.ctl + CW_CNT + 64 * lprev + e, RLX_AGENT) + 255) & ~255; } }
    }
    __syncthreads();
    const bf16* YB = (const bf16*)(ws + WS_YB);
    f32x4 vA[8], vB[8]; u32x2 yA0[8], yA1[8], yB0[8], yB1[8];
#define N1_LOAD(V, Y0, Y1, rr) do { const int t_ = c * 32 + F.wave * 4 + (rr);                                                                 \
        _Pragma("unroll") for (int j = 0; j < 8; ++j) V[j] = *(const GAS f32x4*)(xin + (size_t)t_ * DM + 256 * j + 4 * F.lane);                   \
        if (MODE != 0) { const int r0_ = __builtin_amdgcn_readlane(rowA, (rr)), r1_ = __builtin_amdgcn_readlane(rowB, (rr));                      \
            _Pragma("unroll") for (int j = 0; j < 8; ++j) { const int d = 256 * j + 4 * F.lane;                                                    \
                Y0[j] = *(const GAS u32x2*)(YB + (size_t)r0_ * DM + d); Y1[j] = *(const GAS u32x2*)(YB + (size_t)r1_ * DM + d); } } } while (0)
#define N1_PROC(V, Y0, Y1, rr) do { const int rl = F.wave * 4 + (rr), t = c * 32 + rl;                                                          \
        if (MODE != 0) { const float w0 = __builtin_bit_cast(float, __builtin_amdgcn_readlane(__builtin_bit_cast(int, gwA), (rr))), w1 = __builtin_bit_cast(float, __builtin_amdgcn_readlane(__builtin_bit_cast(int, gwB), (rr))); \
            _Pragma("unroll") for (int j = 0; j < 8; ++j) { const int d = 256 * j + 4 * F.lane;                                                    \
                const f32x4 g2 = *(const LAS f32x4*)(g2L + d); const u32x2 y0 = Y0[j], y1 = Y1[j];                                                 \
                f32x4 y; y.x = w0 * bf_lo(y0.x) + w1 * bf_lo(y1.x); y.y = w0 * bf_hi(y0.x) + w1 * bf_hi(y1.x); y.z = w0 * bf_lo(y0.y) + w1 * bf_lo(y1.y); y.w = w0 * bf_hi(y0.y) + w1 * bf_hi(y1.y); \
                V[j] = V[j] + g2 * y;                                                                                                               \
                *(GAS f32x4*)(xout + (size_t)t * DM + d) = V[j]; } }                                                                               \
        if (MODE != 2) {                                                                                                                           \
            float ss = 0.f;                                                                                                                        \
            _Pragma("unroll") for (int j = 0; j < 8; ++j) ss += (V[j].x * V[j].x + V[j].y * V[j].y) + (V[j].z * V[j].z + V[j].w * V[j].w);         \
            const float rs = rsqrtf(wave_sum(ss) * (1.f / DM) + EPSN);                                                                             \
            float fz[8] = {0.f, 0.f, 0.f, 0.f, 0.f, 0.f, 0.f, 0.f};                                                                                \
            bf16* hrow = (bf16*)(ws + WS_H) + (size_t)t * DM;                                                                                      \
            _Pragma("unroll") for (int j = 0; j < 8; ++j) { const int d = 256 * j + 4 * F.lane;                                                    \
                const f32x4 h = V[j] * rs * *(const LAS f32x4*)(gaL + d) + *(const LAS f32x4*)(gbL + d);                                           \
                u32x2 o; o.x = cvt_pk_bf16(h.x, h.y); o.y = cvt_pk_bf16(h.z, h.w);                                                                 \
                *(GAS u32x2*)(hrow + d) = o;                                                                                                       \
                _Pragma("unroll") for (int q = 0; q < 8; ++q) { const f32x4 w = *(const LAS f32x4*)(wfT + q * DM + d); fz[q] += (h.x * w.x + h.y * w.y) + (h.z * w.z + h.w * w.w); } } \
            _Pragma("unroll") for (int q = 0; q < 8; ++q) fz[q] = wave_sum(fz[q]);                                                                 \
            if (F.lane < 8) { float z = fz[0];                                                                                                     \
                _Pragma("unroll") for (int q = 1; q < 8; ++q) z = (F.lane == q) ? fz[q] : z;                                                       \
                z += *(const GAS float*)(c_bf_ + l * 8 + F.lane);                                                                                  \
                lf[rl * 8 + F.lane] = fminf(z, 0.f) - 0.6931471805599453f * __builtin_amdgcn_logf(1.f + __builtin_amdgcn_exp2f(-LOG2E * fabsf(z))); } } } while (0)
    for (int c = F.vcu; c < SEQ / 32; c += F.G) {
        int rowA = 0, rowB = 0; float gwA = 0.f, gwB = 0.f;
        if (MODE != 0) { const int t_ = c * 32 + F.wave * 4 + (F.lane & 3);
            const int* te = (const int*)(ws + WS_TOKE) + 2 * t_; const int* tp = (const int*)(ws + WS_TOKP) + 2 * t_; const float* tw = (const float*)(ws + WS_TOKW) + 2 * t_;
            rowA = hb[*(const GAS int*)te] + *(const GAS int*)tp; rowB = hb[*(const GAS int*)(te + 1)] + *(const GAS int*)(tp + 1); gwA = *(const GAS float*)tw; gwB = *(const GAS float*)(tw + 1); }
        N1_LOAD(vA, yA0, yA1, 0); N1_LOAD(vB, yB0, yB1, 1);
        N1_PROC(vA, yA0, yA1, 0); N1_LOAD(vA, yA0, yA1, 2);
        N1_PROC(vB, yB0, yB1, 1); N1_LOAD(vB, yB0, yB1, 3);
        N1_PROC(vA, yA0, yA1, 2); N1_PROC(vB, yB0, yB1, 3);
        if (MODE != 2) {
            __syncthreads();
            if (F.tid < 8) { float a = 0.f; float* floc = (float*)(ws + WS_FLOC);
                for (int r = 0; r < 32; ++r) { a += lf[r * 8 + F.tid]; *(GAS float*)(floc + (size_t)(c * 32 + r) * 8 + F.tid) = a; }
                *(GAS float*)((float*)(ws + WS_TOT) + c * 8 + F.tid) = a; }
            __syncthreads();
        }
    }
#undef N1_LOAD
#undef N1_PROC
}

__device__ __forceinline__ void phase_prep(const Frame& F0, int l) {
    unsigned char* const ws = opq(F0.ws); Frame F = F0; F.tid = opq_tid(F0.wave); F.lane = F.tid & 63; F.lds = opq(F0.lds);
    LAS float* pre = (LAS float*)F.lds;
    {
        const float* tot = (const float*)(ws + WS_TOT);
        const int h = F.wave; double v0 = *(const GAS float*)(tot + (4 * F.lane + 0) * 8 + h), v1 = *(const GAS float*)(tot + (4 * F.lane + 1) * 8 + h), v2 = *(const GAS float*)(tot + (4 * F.lane + 2) * 8 + h), v3 = *(const GAS float*)(tot + (4 * F.lane + 3) * 8 + h);
        const double s = v0 + v1 + v2 + v3;
        LAS float* part = (LAS float*)(F.lds + 16384) + h * 64;
        part[F.lane] = (float)s;
        LDS_WAIT();
        double ex = 0.0;
        for (int i = 0; i < 64; ++i) { const float pv = part[i]; ex += (i < F.lane) ? (double)pv : 0.0; }
        pre[h * 256 + 4 * F.lane + 0] = (float)ex; pre[h * 256 + 4 * F.lane + 1] = (float)(ex + v0); pre[h * 256 + 4 * F.lane + 2] = (float)(ex + v0 + v1); pre[h * 256 + 4 * F.lane + 3] = (float)(ex + v0 + v1 + v2);
    }
    __syncthreads();
    const bf16* Z = (const bf16*)(ws + WS_Z);
    float qg[16], kg[16], vg[8]; const float* const c_qg_ = karg(12); const float* const c_kg_ = karg(13); const float* const a_vg_ = karg(9);
#pragma unroll
    for (int i = 0; i < 16; ++i) { qg[i] = *(const GAS float*)(c_qg_ + l * 128 + (F.lane & 7) * 16 + i); kg[i] = *(const GAS float*)(c_kg_ + l * 128 + (F.lane & 7) * 16 + i); }
#pragma unroll
    for (int i = 0; i < 8; ++i) vg[i] = *(const GAS float*)(a_vg_ + l * 512 + F.lane * 8 + i);
    const int gw = F.vcu * NWAVES + F.wave, NGW = F.G * NWAVES;
    for (int t = gw; t < SEQ; t += NGW) {
        const bf16* zr = Z + (size_t)t * NZ;
#pragma unroll
        for (int which = 0; which < 2; ++which) {
            const u32x4 a = *(const GAS u32x4*)(zr + 1536 + which * 1024 + 16 * F.lane), b = *(const GAS u32x4*)(zr + 1536 + which * 1024 + 16 * F.lane + 8);
            float f[16]; f[0] = bf_lo(a.x); f[1] = bf_hi(a.x); f[2] = bf_lo(a.y); f[3] = bf_hi(a.y); f[4] = bf_lo(a.z); f[5] = bf_hi(a.z); f[6] = bf_lo(a.w); f[7] = bf_hi(a.w);
            f[8] = bf_lo(b.x); f[9] = bf_hi(b.x); f[10] = bf_lo(b.y); f[11] = bf_hi(b.y); f[12] = bf_lo(b.z); f[13] = bf_hi(b.z); f[14] = bf_lo(b.w); f[15] = bf_hi(b.w);
            float ss = 0.f;
#pragma unroll
            for (int i = 0; i < 16; ++i) ss += f[i] * f[i];
            ss += xor_f<1>(ss); ss += xor_f<2>(ss); ss += xor_f<4>(ss);
            const float rs = rsqrtf(ss * (1.f / 128.f) + EPSN);
            u32x4 o0, o1;
#define QK_G(i) ((which ? kg[i] : qg[i]) * rs * f[i])
            o0.x = cvt_pk_bf16(QK_G(0), QK_G(1)); o0.y = cvt_pk_bf16(QK_G(2), QK_G(3)); o0.z = cvt_pk_bf16(QK_G(4), QK_G(5)); o0.w = cvt_pk_bf16(QK_G(6), QK_G(7));
            o1.x = cvt_pk_bf16(QK_G(8), QK_G(9)); o1.y = cvt_pk_bf16(QK_G(10), QK_G(11)); o1.z = cvt_pk_bf16(QK_G(12), QK_G(13)); o1.w = cvt_pk_bf16(QK_G(14), QK_G(15));
#undef QK_G
            bf16* dst = (bf16*)(ws + (which ? WS_KN : WS_QN)) + ((size_t)(F.lane >> 3) * SEQ + t) * 128 + (F.lane & 7) * 16;
            *(GAS u32x4*)dst = o0; *(GAS u32x4*)(dst + 8) = o1;
        }
        {
            const u32x4 a = *(const GAS u32x4*)(zr + 512 + 8 * F.lane);
            float f[8]; f[0] = bf_lo(a.x); f[1] = bf_hi(a.x); f[2] = bf_lo(a.y); f[3] = bf_hi(a.y); f[4] = bf_lo(a.z); f[5] = bf_hi(a.z); f[6] = bf_lo(a.w); f[7] = bf_hi(a.w);
            float ss = 0.f;
#pragma unroll
            for (int i = 0; i < 8; ++i) ss += f[i] * f[i];
            ss += xor_f<1>(ss); ss += xor_f<2>(ss); ss += xor_f<4>(ss); ss += xor_f<8>(ss);
            const float rs = rsqrtf(ss * (1.f / 128.f) + EPSN);
            u32x4 o; o.x = cvt_pk_bf16(f[0] * rs * vg[0], f[1] * rs * vg[1]); o.y = cvt_pk_bf16(f[2] * rs * vg[2], f[3] * rs * vg[3]); o.z = cvt_pk_bf16(f[4] * rs * vg[4], f[5] * rs * vg[5]); o.w = cvt_pk_bf16(f[6] * rs * vg[6], f[7] * rs * vg[7]);
            *(GAS u32x4*)((bf16*)(ws + WS_VN) + (size_t)t * 512 + 8 * F.lane) = o;
        }
        {
            const int w = 2 << (F.lane >> 4);
            const u32x4 a = *(const GAS u32x4*)(zr + 1024 + 8 * F.lane);
            float p[8]; p[0] = bf_lo(a.x); p[1] = bf_hi(a.x); p[2] = bf_lo(a.y); p[3] = bf_hi(a.y); p[4] = bf_lo(a.z); p[5] = bf_hi(a.z); p[6] = bf_lo(a.w); p[7] = bf_hi(a.w);
            float s[8];
#pragma unroll
            for (int i = 0; i < 8; ++i) s[i] = p[i];
            for (int j = 1; j < 16; ++j) { if (j < w && t - j >= 0) { const u32x4 b = *(const GAS u32x4*)(zr - (size_t)j * NZ + 1024 + 8 * F.lane);
                s[0] += bf_lo(b.x); s[1] += bf_hi(b.x); s[2] += bf_lo(b.y); s[3] += bf_hi(b.y); s[4] += bf_lo(b.z); s[5] += bf_hi(b.z); s[6] += bf_lo(b.w); s[7] += bf_hi(b.w); } }
            const float ic = 1.f / (float)((t + 1 < w) ? (t + 1) : w);
            u32x4 o; o.x = cvt_pk_bf16(s[0] * ic - p[0], s[1] * ic - p[1]); o.y = cvt_pk_bf16(s[2] * ic - p[2], s[3] * ic - p[3]); o.z = cvt_pk_bf16(s[4] * ic - p[4], s[5] * ic - p[5]); o.w = cvt_pk_bf16(s[6] * ic - p[6], s[7] * ic - p[7]);
            *(GAS u32x4*)((bf16*)(ws + WS_DP) + (size_t)t * 512 + 8 * F.lane) = o;
        }
        if (F.lane < 8) *(GAS float*)((float*)(ws + WS_FKL) + (size_t)F.lane * SEQ + t) = (pre[F.lane * 256 + (t >> 5)] + *(const GAS float*)((const float*)(ws + WS_FLOC) + (size_t)t * 8 + F.lane)) * -11.313708498984761f;
    }
}

__device__ __forceinline__ void phase_small_item(const Frame& F0, int l, int item) {
    unsigned char* const ws = opq(F0.ws); Frame F = F0; F.tid = opq_tid(F0.wave); F.lane = F.tid & 63; F.lds = opq(F0.lds);
    const int fr = F.lane & 15, fq = F.lane >> 4, w = F.wave;
    const bf16* Z = (const bf16*)(ws + WS_Z); bf16* YC = (bf16*)(ws + WS_YCAT);
    f32x4 acc[8];
#pragma unroll
    for (int m = 0; m < 8; ++m) acc[m] = (f32x4){0.f, 0.f, 0.f, 0.f};
    const float* a_bs_ = opq(karg(8)); const float* b_scale_ = opq(karg(11));
    if (item < 256) {
        const int blk = item >> 2, h = item & 3;
        const bf16* VN = (const bf16*)(ws + WS_VN) + (size_t)(blk * 128) * 512 + h * 128 + 16 * w + fr;
        const bf16* WM = (const bf16*)(ws + WS_WM) + ((size_t)(l * 4 + h) * 128) * 128;
        bf16x8 yb[4];
#pragma unroll
        for (int ks = 0; ks < 4; ++ks)
#pragma unroll
            for (int j = 0; j < 8; ++j) yb[ks][j] = (short)*(const GAS bf16*)(VN + (size_t)(ks * 32 + 8 * fq + j) * 512);
#pragma unroll
        for (int m = 0; m < 8; ++m)
#pragma unroll
            for (int ks = 0; ks < 4; ++ks) { const bf16x8 xa = *(const GAS bf16x8*)(WM + (size_t)(16 * m + fr) * 128 + ks * 32 + 8 * fq);
                acc[m] = __builtin_amdgcn_mfma_f32_16x16x32_bf16(yb[ks], xa, acc[m], 0, 0, 0); }
#pragma unroll
        for (int m = 0; m < 8; ++m) { const int tl = 16 * m + fr, t = blk * 128 + tl, col = h * 128 + 16 * w + 4 * fq;
            const float bsv = *(const GAS float*)(a_bs_ + l * 512 + h * 128 + tl);
            const u32x2 u = *(const GAS u32x2*)(Z + (size_t)t * NZ + col);
            u32x2 o; o.x = cvt_pk_bf16(bf_lo(u.x) * (acc[m][0] + bsv), bf_hi(u.x) * (acc[m][1] + bsv)); o.y = cvt_pk_bf16(bf_lo(u.y) * (acc[m][2] + bsv), bf_hi(u.y) * (acc[m][3] + bsv));
            *(GAS u32x2*)(YC + (size_t)t * DM + col) = o; }
    } else {
        const int rb = (item - 256) >> 2, g = (item - 256) & 3;
        const bf16* DP = (const bf16*)(ws + WS_DP) + (size_t)(rb * 128) * 512 + g * 128;
        const bf16* BWT = (const bf16*)(ws + WS_BWT) + ((size_t)(l * 4 + g) * 128) * 128;
        bf16x8 yb[4];
#pragma unroll
        for (int ks = 0; ks < 4; ++ks) yb[ks] = *(const GAS bf16x8*)(BWT + (size_t)(16 * w + fr) * 128 + ks * 32 + 8 * fq);
#pragma unroll
        for (int m = 0; m < 8; ++m)
#pragma unroll
            for (int ks = 0; ks < 4; ++ks) { const bf16x8 xa = *(const GAS bf16x8*)(DP + (size_t)(16 * m + fr) * 512 + ks * 32 + 8 * fq);
                acc[m] = __builtin_amdgcn_mfma_f32_16x16x32_bf16(yb[ks], xa, acc[m], 0, 0, 0); }
        const f32x4 bsc = *(const GAS f32x4*)(b_scale_ + l * 512 + g * 128 + 16 * w + 4 * fq);
#pragma unroll
        for (int m = 0; m < 8; ++m) { const int t = rb * 128 + 16 * m + fr, col = 512 + g * 128 + 16 * w + 4 * fq;
            u32x2 o; o.x = cvt_pk_bf16(acc[m][0] * bsc.x, acc[m][1] * bsc.y); o.y = cvt_pk_bf16(acc[m][2] * bsc.z, acc[m][3] * bsc.w);
            *(GAS u32x2*)(YC + (size_t)t * DM + col) = o; }
    }
}

__device__ __forceinline__ void phase_norm2_route(const Frame& F0, int l) {
    unsigned char* const ws = opq(F0.ws); Frame F = F0; F.tid = opq_tid(F0.wave); F.lane = F.tid & 63; F.lds = opq(F0.lds);
    LAS float* wrT = (LAS float*)F.lds;
    LAS float* gaL = (LAS float*)(F.lds + AUX_OFF);
    LAS float* gbL = (LAS float*)(F.lds + AUX_OFF + 8192);
    LAS int* lcnt = (LAS int*)(F.lds + AUX_OFF + 16384);
    const float* const w_router_ = karg(16); const float* const g_ffn_ = karg(5); const float* const b_ada_ = karg(3); const float* const b_router_ = karg(17);
    for (int i = F.tid; i < DM * 4; i += NTHR) { const int d = i >> 2, q = i & 3;
        const f32x4 w = *(const GAS f32x4*)(w_router_ + (size_t)d * 16 + q * 4);
        wrT[(q * 4 + 0) * DM + d] = w.x; wrT[(q * 4 + 1) * DM + d] = w.y; wrT[(q * 4 + 2) * DM + d] = w.z; wrT[(q * 4 + 3) * DM + d] = w.w; }
    for (int d = F.tid; d < DM; d += NTHR) { gaL[d] = *(const GAS float*)(g_ffn_ + (size_t)l * DM + d) * (1.f + mod_at(ws, b_ada_, l, 4 * DM + d)); gbL[d] = mod_at(ws, b_ada_, l, 3 * DM + d); }
    const float* X1 = (const float*)(ws + WS_X1);
    float brt[16];
#pragma unroll
    for (int e = 0; e < 16; ++e) brt[e] = *(const GAS float*)(b_router_ + e);
    for (int c = F.vcu; c < SEQ / 32; c += F.G) {
        if (F.tid < 32) lcnt[F.tid] = 0;
        __syncthreads();
        int my_e0 = 0, my_e1 = 0, my_r0 = 0, my_r1 = 0; float my_w0 = 0.f, my_w1 = 0.f;
        f32x4 vA[8], vB[8];
#define N2_LOAD(V, rr) do { const int t_ = c * 32 + F.wave * 4 + (rr); _Pragma("unroll") for (int j = 0; j < 8; ++j) V[j] = *(const GAS f32x4*)(X1 + (size_t)t_ * DM + 256 * j + 4 * F.lane); } while (0)
#define N2_PROC(V, rr) do { const int t = c * 32 + F.wave * 4 + (rr);                                                                           \
            float ss = 0.f;                                                                                                                        \
            _Pragma("unroll") for (int j = 0; j < 8; ++j) ss += (V[j].x * V[j].x + V[j].y * V[j].y) + (V[j].z * V[j].z + V[j].w * V[j].w);         \
            const float rs = rsqrtf(wave_sum(ss) * (1.f / DM) + EPSN);                                                                             \
            float lg[16];                                                                                                                          \
            _Pragma("unroll") for (int e = 0; e < 16; ++e) lg[e] = 0.f;                                                                            \
            unsigned char* hrow = ws + WS_H + (size_t)t * DM;                          \
            _Pragma("unroll") for (int j = 0; j < 8; ++j) { const int d = 256 * j + 4 * F.lane;                                                    \
                const f32x4 h = V[j] * rs * *(const LAS f32x4*)(gaL + d) + *(const LAS f32x4*)(gbL + d);                                           \
                *(GAS unsigned*)(hrow + d) = cvt_pk4_fp8(h.x * H8_SCALE, h.y * H8_SCALE, h.z * H8_SCALE, h.w * H8_SCALE);                          \
                _Pragma("unroll") for (int e = 0; e < 16; ++e) { const f32x4 w = *(const LAS f32x4*)(wrT + e * DM + d); lg[e] += (h.x * w.x + h.y * w.y) + (h.z * w.z + h.w * w.w); } } \
            _Pragma("unroll") for (int e = 0; e < 16; ++e) lg[e] = wave_sum(lg[e]);                                                                \
            float sc[16], sel[16];                                                                                                                 \
            _Pragma("unroll") for (int e = 0; e < 16; ++e) { sc[e] = __builtin_amdgcn_rcpf(1.f + __builtin_amdgcn_exp2f(-LOG2E * lg[e])); sel[e] = sc[e] + brt[e]; }                      \
            int bg = 0; float bgs = -INFINITY;                                                                                                     \
            _Pragma("unroll") for (int g = 0; g < 4; ++g) { float a = -INFINITY, b = -INFINITY;                                                    \
                _Pragma("unroll") for (int i = 0; i < 4; ++i) { const float x = sel[g * 4 + i]; if (x > a) { b = a; a = x; } else if (x > b) b = x; } \
                if (a + b > bgs) { bgs = a + b; bg = g; } }                                                                                        \
            int e0 = 0, e1 = 0; float a = -INFINITY, b = -INFINITY, s0 = 0.f, s1 = 0.f;                                                            \
            _Pragma("unroll") for (int g = 0; g < 4; ++g)                                                                                          \
                _Pragma("unroll") for (int i = 0; i < 4; ++i) { const int e = g * 4 + i; const float x = sel[e];                                   \
                    if (g == bg) { if (x > a) { b = a; e1 = e0; s1 = s0; a = x; e0 = e; s0 = sc[e]; } else if (x > b) { b = x; e1 = e; s1 = sc[e]; } } } \
            const float inv = 1.f / (s0 + s1);                                                                                                     \
            if (F.lane == (rr)) { my_e0 = e0; my_e1 = e1; my_w0 = s0 * inv; my_w1 = s1 * inv; } } while (0)
        N2_LOAD(vA, 0);
#pragma unroll 1
        for (int rp = 0; rp < 2; ++rp) {
            N2_LOAD(vB, 2 * rp + 1);
            N2_PROC(vA, 2 * rp);
            if (rp == 0) N2_LOAD(vA, 2);
            N2_PROC(vB, 2 * rp + 1);
        }
        if (F.lane < 4) { my_r0 = __hip_atomic_fetch_add(&lcnt[my_e0], 1, __ATOMIC_RELAXED, __HIP_MEMORY_SCOPE_WORKGROUP); my_r1 = __hip_atomic_fetch_add(&lcnt[my_e1], 1, __ATOMIC_RELAXED, __HIP_MEMORY_SCOPE_WORKGROUP); }
        __syncthreads();
        if (F.tid < 16) lcnt[16 + F.tid] = (int)__hip_atomic_fetch_add(F.ctl + CW_CNT + 64 * l + F.tid, (unsigned)lcnt[F.tid], RLX_AGENT);
        __syncthreads();
        if (F.lane < 4) { const int t = c * 32 + F.wave * 4 + F.lane;
            const int p0 = lcnt[16 + my_e0] + my_r0, p1 = lcnt[16 + my_e1] + my_r1;
            int* list = (int*)(ws + WS_LIST);
            *(GAS int*)(list + my_e0 * SEQ + p0) = t; *(GAS int*)(list + my_e1 * SEQ + p1) = t;
            *(GAS int*)((int*)(ws + WS_TOKE) + 2 * t) = my_e0; *(GAS int*)((int*)(ws + WS_TOKE) + 2 * t + 1) = my_e1;
            *(GAS int*)((int*)(ws + WS_TOKP) + 2 * t) = p0; *(GAS int*)((int*)(ws + WS_TOKP) + 2 * t + 1) = p1;
            *(GAS float*)((float*)(ws + WS_TOKW) + 2 * t) = my_w0; *(GAS float*)((float*)(ws + WS_TOKW) + 2 * t + 1) = my_w1; }
        __syncthreads();
    }
#undef N2_LOAD
#undef N2_PROC
}

struct MoeOrder {
    int G, c, total, K, nct; const char* Bt; size_t estride; const int* list; LAS int* tab;
    __device__ __forceinline__ bool next(int i, gm::Unit& u) const {
        const int L = i * G + c; if (L >= total) return false;
        const int q = L / nct, ct = L - q * nct;
        int e = 0;
#pragma unroll
        for (int k = 1; k < NEXP; ++k) e += (q >= tab[k]) ? 1 : 0;
        e = __builtin_amdgcn_readfirstlane(e);
        const int rt = q - __builtin_amdgcn_readfirstlane(tab[e]);
        u.e = e; u.rt = rt; u.arow = (__builtin_amdgcn_readfirstlane(tab[e]) + rt) * 256; u.orow = u.arow; u.ocol = ct * 256;
        u.Bp = Bt + (size_t)e * estride + (size_t)ct * 256 * K * 2; return true;
    }
    __device__ __forceinline__ int row_of(const gm::Unit& u, int r) const {
        const int p = u.rt * 256 + r, n = tab[32 + u.e], pc = p < n ? p : n - 1;
        const int v = *(const GAS int*)(list + u.e * SEQ + pc);
        return (p < n) ? v : 0;
    }
};
__device__ __forceinline__ void moe_table(const Frame& F, int l, LAS int* tab) {
    __syncthreads();
    if (F.tid == 0) { int a = 0;
        for (int e = 0; e < NEXP; ++e) { const int n = (int)__hip_atomic_load(F.ctl + CW_CNT + 64 * l + e, RLX_AGENT); tab[e] = a; tab[32 + e] = n; a += (n + 255) >> 8; }
        tab[16] = a; }
    __syncthreads();
}

constexpr int ATT_CH = 16;
struct MixTab { LAS int* jlo; LAS int* items; LAS int* nitems; LAS float* fend; LAS int* scan; };
__device__ __forceinline__ MixTab mix_tab_ptrs(LAS unsigned char* lds) {
    MixTab T; T.jlo = (LAS int*)(lds + 69632); T.items = (LAS int*)(lds + 69632 + 1024); T.nitems = (LAS int*)(lds + 69632 + 1024 + 8192); T.fend = (LAS float*)(lds + 69632 + 1024 + 8192 + 64);
    T.scan = (LAS int*)(lds + 69632 + 1024 + 8192 + 64 + 4096); return T;
}
__device__ __forceinline__ void mix_build_table(const Frame& F0, int l, const MixTab& T) {
    unsigned char* const ws = opq(F0.ws); const int tid = opq_tid(F0.wave);
    const float* FKL = (const float*)(ws + WS_FKL);
    for (int i = tid; i < 1024; i += NTHR) T.fend[i] = *(const GAS float*)(FKL + (size_t)(i >> 7) * SEQ + (i & 127) * 64 + 63);
    float gq = 0.f, gk = 0.f; const float* const c_qg_ = karg(12); const float* const c_kg_ = karg(13);
    { const int ln = tid & 63; gq = fmaxf(fabsf(*(const GAS float*)(c_qg_ + l * 128 + ln)), fabsf(*(const GAS float*)(c_qg_ + l * 128 + 64 + ln))); gk = fmaxf(fabsf(*(const GAS float*)(c_kg_ + l * 128 + ln)), fabsf(*(const GAS float*)(c_kg_ + l * 128 + 64 + ln)));
      gq = wave_max(gq); gk = wave_max(gk); }
    const float thr = (2.f * 1.01f * 11.313708498984761f * gq * gk + 30.f) * 11.313708498984761f;
    __syncthreads();
    int nfull = 0, nrem = 0, jl = 0, nt = 0;
    if (tid < 256) { const int h = tid >> 5, qb = tid & 31; const float f0 = *(const GAS float*)(FKL + (size_t)h * SEQ + qb * 256);
        for (int j = 0; j < 4 * qb; ++j) jl += (T.fend[h * 128 + j] - f0 <= -thr) ? 1 : 0;
        nt = 4 * (qb + 1) - jl; nfull = nt / ATT_CH; nrem = (nt % ATT_CH) ? 1 : 0; T.jlo[tid] = jl | ((nfull + nrem) << 8); }
    if (tid < 256) { T.scan[tid] = nfull; T.scan[256 + tid] = nrem; }
    __syncthreads();
    for (int o = 1; o < 256; o <<= 1) { int a = 0, b = 0; if (tid < 256 && tid >= o) { a = T.scan[tid - o]; b = T.scan[256 + tid - o]; } __syncthreads();
        if (tid < 256) { T.scan[tid] += a; T.scan[256 + tid] += b; } __syncthreads(); }
    if (tid < 256) { const int totf = T.scan[255], pf = T.scan[tid] - nfull, pr = totf + T.scan[256 + tid] - nrem, jb = 4 * ((tid & 31) + 1);
        for (int c = 0; c < nfull; ++c) T.items[pf + c] = tid | (c << 8) | ((jb - (c + 1) * ATT_CH) << 12) | (ATT_CH << 20);
        if (nrem) T.items[pr] = tid | (nfull << 8) | (jl << 12) | ((nt - nfull * ATT_CH) << 20);
        if (tid == 255) T.nitems[0] = totf + T.scan[511]; }
    __syncthreads();
}
__device__ __forceinline__ void phase_attn_combine(const Frame& F0, int l, const MixTab& T) {
    unsigned char* const ws = opq(F0.ws); const int tid = opq_tid(F0.wave);
    const bf16* PART = (const bf16*)(ws + WS_PART); const float* MLb = (const float*)(ws + WS_ML); bf16* YC = (bf16*)(ws + WS_YCAT);
    for (int b = F0.vcu; b < 256; b += F0.G) {
        const int nch = __builtin_amdgcn_readfirstlane(T.jlo[b]) >> 8; if (nch <= 1) continue;
        const int h = b >> 5, qb = b & 31, row = tid >> 1, half = tid & 1;
        float m[8], w[8], mx = -3.0e38f, ws_ = 0.f;
#pragma unroll
        for (int c = 0; c < 8; ++c) { if (c < nch) { const f32x2 v = *(const GAS f32x2*)(MLb + ((size_t)(b * 8 + c) * 256 + row) * 2); m[c] = v.x; w[c] = v.y; mx = fmaxf(mx, v.x); } else { m[c] = -3.0e38f; w[c] = 0.f; } }
#pragma unroll
        for (int c = 0; c < 8; ++c) { w[c] = (c < nch) ? w[c] * __builtin_amdgcn_exp2f((m[c] - mx) * at::C2) : 0.f; ws_ += w[c]; }
        const float inv = 1.f / ws_;
        float acc[64];
#pragma unroll
        for (int i = 0; i < 64; ++i) acc[i] = 0.f;
#pragma unroll
        for (int c = 0; c < 8; ++c) { if (c < nch) { const bf16* p = PART + ((size_t)(b * 8 + c) * 256 + row) * 128 + half * 64; const float wc = w[c] * inv;
#pragma unroll
            for (int q = 0; q < 8; ++q) { const u32x4 v = *(const GAS u32x4*)(p + q * 8);
                acc[q * 8 + 0] += wc * bf_lo(v.x); acc[q * 8 + 1] += wc * bf_hi(v.x); acc[q * 8 + 2] += wc * bf_lo(v.y); acc[q * 8 + 3] += wc * bf_hi(v.y);
                acc[q * 8 + 4] += wc * bf_lo(v.z); acc[q * 8 + 5] += wc * bf_hi(v.z); acc[q * 8 + 6] += wc * bf_lo(v.w); acc[q * 8 + 7] += wc * bf_hi(v.w); } } }
        bf16* o = YC + (size_t)(qb * 256 + row) * DM + 1024 + h * 128 + half * 64;
#pragma unroll
        for (int q = 0; q < 8; ++q) { u32x4 v; v.x = cvt_pk_bf16(acc[q * 8 + 0], acc[q * 8 + 1]); v.y = cvt_pk_bf16(acc[q * 8 + 2], acc[q * 8 + 3]); v.z = cvt_pk_bf16(acc[q * 8 + 4], acc[q * 8 + 5]); v.w = cvt_pk_bf16(acc[q * 8 + 6], acc[q * 8 + 7]);
            *(GAS u32x4*)(o + q * 8) = v; }
    }
}

struct MoeDynOrder {
    int total, K; const char* Bt; size_t estride; LAS int* tab; gu32* ticket; gu32* ready; gu32* tmo; LAS unsigned* slot;
    __device__ __forceinline__ bool next(int, gm::Unit& u) const {
        if (__builtin_amdgcn_readfirstlane(threadIdx.x >> 6) == 0) {
            unsigned T = 0u;
            if ((threadIdx.x & 63) == 0) T = __hip_atomic_fetch_add(ticket, 1u, RLX_AGENT);
            T = __builtin_amdgcn_readfirstlane(T);
            if (T < (unsigned)total) {
                gu32* w = ready + 16 * (T >> 3); unsigned sp = 0u;
                while ((unsigned)__builtin_amdgcn_readfirstlane(__hip_atomic_load(w, RLX_AGENT)) < 64u) {
                    __builtin_amdgcn_s_sleep(2);
                    if ((++sp & 255u) == 0u) { if (__hip_atomic_load(tmo, RLX_AGENT) != 0u) break; if (sp > (1u << 20)) { __hip_atomic_store(tmo, 1u, RLX_AGENT); break; } } }
                __builtin_amdgcn_fence(__ATOMIC_ACQUIRE, "agent");
                asm volatile("s_waitcnt vmcnt(0)" ::: "memory");
            }
            if ((threadIdx.x & 63) == 0) slot[0] = T;
        }
        asm volatile("s_waitcnt lgkmcnt(0)" ::: "memory"); __builtin_amdgcn_s_barrier(); asm volatile("" ::: "memory");
        const unsigned T = (unsigned)__builtin_amdgcn_readfirstlane((int)slot[0]);
        if (T >= (unsigned)total) return false;
        const int q = (int)(T >> 3), ct = (int)(T & 7);
        int e = 0;
#pragma unroll
        for (int k = 1; k < NEXP; ++k) e += (q >= tab[k]) ? 1 : 0;
        e = __builtin_amdgcn_readfirstlane(e);
        u.e = e; u.rt = q - __builtin_amdgcn_readfirstlane(tab[e]); u.arow = q * 256; u.orow = u.arow; u.ocol = ct * 256;
        u.Bp = Bt + (size_t)e * estride + (size_t)ct * 256 * K * 2; return true;
    }
    __device__ __forceinline__ int row_of(const gm::Unit&, int) const { return 0; }
};
struct EpiZ {
    static constexpr bool PERM = true;
    bf16* O;
    __device__ __forceinline__ void operator()(const f32x4 (&acc)[2][2][4][2], const gm::Unit& u, int wr, int wc, int fr, int fq) const {
        const int row0 = u.orow + wr * 64 + fr, col0 = u.ocol + wc * 32 + 8 * fq; const bool act = u.ocol < 1024;
#pragma unroll
        for (int ai = 0; ai < 2; ++ai)
#pragma unroll
            for (int m = 0; m < 4; ++m) { bf16* rowp = O + (size_t)(row0 + ai * 128 + m * 16) * NZ + col0;
#pragma unroll
                for (int bj = 0; bj < 2; ++bj) { f32x4 v0 = acc[ai][bj][m][0], v1 = acc[ai][bj][m][1];
                    if (act) {
#pragma unroll
                        for (int j = 0; j < 4; ++j) { v0[j] = gelu_t(v0[j]); v1[j] = gelu_t(v1[j]); } }
                    u32x4 w; w.x = cvt_pk_bf16(v0[0], v0[1]); w.y = cvt_pk_bf16(v0[2], v0[3]); w.z = cvt_pk_bf16(v1[0], v1[1]); w.w = cvt_pk_bf16(v1[2], v1[3]);
                    *(GAS u32x4*)(rowp + bj * 128) = w; } }
    }
};
struct EpiRes {
    static constexpr bool PERM = false;
    const float* xin; const LAS float* gate; float* out;
    __device__ __forceinline__ void operator()(const f32x4 (&acc)[2][2][4][2], const gm::Unit& u, int wr, int wc, int fr, int fq) const {
        const int row0 = u.orow + wr * 64 + fr, col0 = u.ocol + wc * 32 + 4 * fq;
        f32x4 gv[2][2];
#pragma unroll
        for (int bj = 0; bj < 2; ++bj)
#pragma unroll
            for (int n = 0; n < 2; ++n) gv[bj][n] = *(const LAS f32x4*)(gate + col0 + bj * 128 + n * 16);
#pragma unroll
        for (int ai = 0; ai < 2; ++ai)
#pragma unroll
            for (int m = 0; m < 4; ++m) { const size_t off = (size_t)(row0 + ai * 128 + m * 16) * DM + col0;
#pragma unroll
                for (int bj = 0; bj < 2; ++bj)
#pragma unroll
                    for (int n = 0; n < 2; ++n) { const f32x4 xv = *(const GAS f32x4*)(xin + off + bj * 128 + n * 16);
                        *(GAS f32x4*)(out + off + bj * 128 + n * 16) = xv + gv[bj][n] * acc[ai][bj][m][n]; } }
    }
};
struct EpiHid {
    static constexpr bool PERM = true;
    bf16* O;
    __device__ __forceinline__ void operator()(const f32x4 (&acc)[2][2][4][2], const gm::Unit& u, int wr, int wc, int fr, int fq) const {
        const int row0 = u.orow + wr * 64 + fr, col0 = (u.ocol >> 1) + wc * 32 + 8 * fq;
#pragma unroll
        for (int ai = 0; ai < 2; ++ai)
#pragma unroll
            for (int m = 0; m < 4; ++m) { bf16* rowp = O + (size_t)(row0 + ai * 128 + m * 16) * DEX + col0;
                f32x4 h0, h1;
#pragma unroll
                for (int j = 0; j < 4; ++j) { h0[j] = silu_f(acc[ai][0][m][0][j]) * acc[ai][1][m][0][j]; h1[j] = silu_f(acc[ai][0][m][1][j]) * acc[ai][1][m][1][j]; }
                u32x4 w; w.x = cvt_pk_bf16(h0[0], h0[1]); w.y = cvt_pk_bf16(h0[2], h0[3]); w.z = cvt_pk_bf16(h1[0], h1[1]); w.w = cvt_pk_bf16(h1[2], h1[3]);
                *(GAS u32x4*)rowp = w; }
    }
};
struct EpiHidPub {
    static constexpr bool PERM = true;
    unsigned char* O; gu32* ready;
    __device__ __forceinline__ void operator()(const f32x4 (&acc)[2][2][4][2], const gm::Unit& u, int wr, int wc, int fr, int fq) const {
        const __amdgpu_buffer_rsrc_t rs = __builtin_amdgcn_make_buffer_rsrc(O, (short)0, (int)(HIDROWS * DEX), 0x00020000);
        const int row0 = u.orow + wr * 64 + fr, col0 = (u.ocol >> 1) + wc * 32 + 8 * fq;
#pragma unroll
        for (int ai = 0; ai < 2; ++ai)
#pragma unroll
            for (int m = 0; m < 4; ++m) { const int off = (row0 + ai * 128 + m * 16) * DEX + col0;
                f32x4 h0, h1;
#pragma unroll
                for (int j = 0; j < 4; ++j) { h0[j] = HID8_SCALE * silu_f(acc[ai][0][m][0][j]) * acc[ai][1][m][0][j]; h1[j] = HID8_SCALE * silu_f(acc[ai][0][m][1][j]) * acc[ai][1][m][1][j]; }
                u32x2 w; w.x = cvt_pk4_fp8(h0[0], h0[1], h0[2], h0[3]); w.y = cvt_pk4_fp8(h1[0], h1[1], h1[2], h1[3]);
                __builtin_amdgcn_raw_buffer_store_b64(w, rs, off, 0, 16); }
        asm volatile("s_waitcnt vmcnt(0)" ::: "memory");
        if (fr == 0 && fq == 0) (void)__hip_atomic_fetch_add(ready + 16 * (u.orow >> 8), 1u, RLX_AGENT);
    }
};
struct EpiYB {
    static constexpr bool PERM = true;
    bf16* O;
    __device__ __forceinline__ void operator()(const f32x4 (&acc)[2][2][4][2], const gm::Unit& u, int wr, int wc, int fr, int fq) const {
        const int row0 = u.orow + wr * 64 + fr, col0 = u.ocol + wc * 32 + 8 * fq;
#pragma unroll
        for (int ai = 0; ai < 2; ++ai)
#pragma unroll
            for (int m = 0; m < 4; ++m) { bf16* rowp = O + (size_t)(row0 + ai * 128 + m * 16) * DM + col0;
#pragma unroll
                for (int bj = 0; bj < 2; ++bj) { const f32x4 v0 = acc[ai][bj][m][0], v1 = acc[ai][bj][m][1];
                    u32x4 w; w.x = cvt_pk_bf16(v0[0], v0[1]); w.y = cvt_pk_bf16(v0[2], v0[3]); w.z = cvt_pk_bf16(v1[0], v1[1]); w.w = cvt_pk_bf16(v1[2], v1[3]);
                    *(GAS u32x4*)(rowp + bj * 128) = w; } }
    }
};

#ifdef MK_SELFTEST
#include "selftest.h"
#endif
__device__ __forceinline__ int bg_need(int p) {
    if (p <= 1) return 0;
    if (p <= 5) return BG_C0;
    if (p <= 7) return BG_C1;
    if (p == 8) return BG_C3;
    if (p <= 10) return BG_C3B;
    if (p <= 14) return BG_C4;
    if (p <= 16) return BG_C5;
    return BG_C7;
}
__device__ __forceinline__ bool bg_seam(int k) { if (k == 0) return true; const int j = (k - 1) % 9; return j != 2 && j != 5 && j != 8; }
struct Args { const float* in[21]; float* out; unsigned char* ws; int ph_lo, ph_hi; };
constexpr int N_PHASES = 1 + 9 * NLAYER + 1;

#ifdef MK_ONLY
#define IN(k) (((k) == 0 ? 0 : (((k) - 1) % 9) + 1) == MK_ONLY && lo <= (k) && (k) < hi)
#else
#define IN(k) (lo <= (k) && (k) < hi)
#endif
#ifndef MK_REPEAT
#define MK_REPEAT -1
#endif
#define REPS(kind) ((MK_REPEAT == (kind)) ? 2 : 1)
#define SEAM(k) do { if (IN(k)) { if (bg_seam(k)) bg_fill(F, (k), bg_need((k) + 1)); if (IN((k) + 1)) xcd_barrier(bar); } } while (0)


template <int l> __device__ __forceinline__ void layer_body(const Frame& F, const XcdBarrier& bar, const int lo, const int hi) {
    constexpr int pb = 1 + 9 * l;

        for (int rep_ = 0; rep_ < REPS(1); ++rep_) if (IN(pb)) { if (rep_) xcd_barrier(bar); unsigned char* const wsl = opq(F.ws); LAS unsigned char* const ldl = opq(F.lds); if (l == 0) phase_norm1<0>(F, l, karg(0), nullptr, 0); else phase_norm1<1>(F, l, (const float*)(wsl + WS_X1), (float*)(wsl + WS_X2), l - 1); }
        SEAM(pb);
        for (int rep_ = 0; rep_ < REPS(2); ++rep_) if (IN(pb + 1)) { if (rep_) xcd_barrier(bar); unsigned char* const wsl = opq(F.ws); LAS unsigned char* const ldl = opq(F.lds); gm::RegOrder S; S.init(SEQ, NZ, DM, wsl + WS_WIN + (size_t)l * NZ * DM * 2, F.G, (int)blockIdx.x);
            EpiZ E{(bf16*)(wsl + WS_Z)};
            gm::gemm_phase<EpiZ, gm::RegOrder, false, true>(ldl, (const char*)(wsl + WS_H), DM, S, E, F.wave); }
        SEAM(pb + 1);
        for (int rep_ = 0; rep_ < REPS(3); ++rep_) if (IN(pb + 2)) { if (rep_) xcd_barrier(bar); unsigned char* const wsl = opq(F.ws); LAS unsigned char* const ldl = opq(F.lds); phase_prep(F, l); }
        SEAM(pb + 2);
        for (int rep_ = 0; rep_ < REPS(4); ++rep_) if (IN(pb + 3)) { if (rep_) xcd_barrier(bar); unsigned char* const wsl = opq(F.ws); LAS unsigned char* const ldl = opq(F.lds);
            const MixTab T = mix_tab_ptrs(ldl);
            mix_build_table(F, l, T);
            const int natt = __builtin_amdgcn_readfirstlane(T.nitems[0]), ntot = natt + 512;
            LAS int* qslot = T.nitems + 1;
            int it = F.vcu;
            while (it < ntot) {
                if (it >= natt) { phase_small_item(F, l, it - natt); }
                else {
                    const int rec = __builtin_amdgcn_readfirstlane(T.items[it]), b = rec & 255, c = (rec >> 8) & 15, ja = (rec >> 12) & 255, n = (rec >> 20) & 31, h = b >> 5, qb = b & 31;
                    const bool fin = (__builtin_amdgcn_readfirstlane(T.jlo[b]) >> 8) <= 1; unsigned char* const ws = opq(wsl);
                    at::BlockRef cur;
                    cur.Q = (const bf16*)(ws + WS_QN) + ((size_t)h * SEQ + qb * 256) * 128; cur.K = (const bf16*)(ws + WS_KN) + (size_t)h * SEQ * 128;
                    cur.V = (const bf16*)(ws + WS_Z) + 3584 + h * 128; cur.O = (bf16*)(ws + WS_YCAT) + (size_t)(qb * 256) * DM + 1024 + h * 128;
                    cur.FK = (const float*)(ws + WS_FKL) + (size_t)h * SEQ; cur.P0 = qb * 256;
                    at::attn_block(cur, ja, n, fin, (bf16*)(ws + WS_PART) + (size_t)(b * 8 + c) * 256 * 128, (float*)(ws + WS_ML) + (size_t)(b * 8 + c) * 256 * 2, (char*)ldl, ldl, F.wave);
                }
                if (opq_tid(F.wave) == 0) qslot[0] = F.G + (int)__hip_atomic_fetch_add(F.ctl + CW_Q + 64 * l + 32 * rep_, 1u, RLX_AGENT);
                __syncthreads();
                it = __builtin_amdgcn_readfirstlane(qslot[0]);
                __syncthreads();
            }
        }
        SEAM(pb + 3);
        for (int rep_ = 0; rep_ < REPS(5); ++rep_) if (IN(pb + 4)) { if (rep_) xcd_barrier(bar); unsigned char* const wsl = opq(F.ws); LAS unsigned char* const ldl = opq(F.lds); const MixTab T = mix_tab_ptrs(ldl); mix_build_table(F, l, T); phase_attn_combine(F, l, T); }
        SEAM(pb + 4);
        for (int rep_ = 0; rep_ < REPS(6); ++rep_) if (IN(pb + 5)) { if (rep_) xcd_barrier(bar); unsigned char* const wsl = opq(F.ws); LAS unsigned char* const ldl = opq(F.lds); gm::RegOrder S; S.init(SEQ, DM, DM, wsl + WS_WOUT + (size_t)l * DM * DM * 2, F.G, (int)blockIdx.x);
            LAS float* g1L = (LAS float*)(ldl + AUX_OFF);
            { const float* const b_ada_ = karg(3); for (int d = opq_tid(F.wave); d < DM; d += NTHR) g1L[d] = mod_at(wsl, b_ada_, l, 2 * DM + d); }
            __syncthreads();
            EpiRes E{(l == 0) ? karg(0) : (const float*)(wsl + WS_X2), g1L, (float*)(wsl + WS_X1)};
            gm::gemm_phase<EpiRes, gm::RegOrder, false, true>(ldl, (const char*)(wsl + WS_YCAT), DM, S, E, F.wave); }
        SEAM(pb + 5);
        for (int rep_ = 0; rep_ < REPS(7); ++rep_) if (IN(pb + 6)) { if (rep_) xcd_barrier(bar); unsigned char* const wsl = opq(F.ws); LAS unsigned char* const ldl = opq(F.lds); phase_norm2_route(F, l); }
        SEAM(pb + 6);
        for (int rep_ = 0; rep_ < REPS(8); ++rep_) if (IN(pb + 7)) { if (rep_) xcd_barrier(bar); unsigned char* const wsl = opq(F.ws); LAS unsigned char* const ldl = opq(F.lds); LAS int* tab = (LAS int*)(ldl + AUX_OFF + 20480); moe_table(F, l, tab);
            gu32* const rdy = F.ctl + CW_RDY + 4096 * l + 2048 * rep_;
            { MoeOrder S; S.G = F.G; S.c = F.vcu; S.total = 8 * tab[16]; S.K = DM / 2; S.nct = 8; S.Bt = (const char*)(wsl + WS_WGU) + (size_t)l * NEXP * DM * DM; S.estride = (size_t)DM * DM;
              S.list = (const int*)(wsl + WS_LIST); S.tab = tab;
              EpiHidPub E{wsl + (l ? WS_HID1 : WS_HID), rdy};
              gm::gemm_phase<EpiHidPub, MoeOrder, true, true, true, SC_H8, SC_W8>(ldl, (const char*)(wsl + WS_H), DM, S, E, F.wave); }
            { MoeDynOrder S; S.total = 8 * tab[16]; S.K = DEX / 2; S.Bt = (const char*)(wsl + WS_WD) + (size_t)l * NEXP * DM * DEX; S.estride = (size_t)DM * DEX; S.tab = tab;
              S.ticket = F.ctl + CW_MT + 64 * l + 32 * rep_; S.ready = rdy; S.tmo = F.ctl + CW_TMO; S.slot = (LAS unsigned*)(ldl + AUX_OFF + 24576 + 64);
              EpiYB E{(bf16*)(wsl + WS_YB)};
              gm::gemm_phase<EpiYB, MoeDynOrder, false, true, true, SC_HID8, SC_W8>(ldl, (const char*)(wsl + (l ? WS_HID1 : WS_HID)), DEX, S, E, F.wave); }
        }
        SEAM(pb + 7);
    }

__global__ void __launch_bounds__(NTHR, 2) mk_fwd(Args args) {
    extern __shared__ __attribute__((aligned(16))) unsigned char lds[];
    Frame F;
    F.lds = (LAS unsigned char*)lds; F.MISC = (volatile LAS unsigned*)(F.lds + MISC_OFF);
    F.tid = 0; F.lane = 0; F.wave = __builtin_amdgcn_readfirstlane((int)threadIdx.x >> 6);
    F.G = gridDim.x; { const int bx = blockIdx.x; F.vcu = (F.G % 8 == 0) ? (bx % 8) * (F.G / 8) + bx / 8 : bx; }
    F.ws = args.ws; F.ctl = (gu32*)(args.ws + WS_CTL);
    for (int u = threadIdx.x; u < (LDS_BYTES - RING_BYTES) / 4; u += NTHR) ((LAS unsigned*)(F.lds + RING_BYTES))[u] = 0u;
    __syncthreads();
    const int lo = args.ph_lo, hi = args.ph_hi;
    const bool multi = (hi - lo) > 1;
    XcdBarrier bar; bar.bar = (unsigned*)(F.ctl + CW_BAR); bar.x = 0; bar.st = nullptr;
    if (multi) bar = xcd_barrier_post((unsigned*)(F.ctl + CW_BAR), F.MISC + 8);
    for (int rep_ = 0; rep_ < REPS(0); ++rep_) if (IN(0)) { if (rep_) xcd_barrier(bar); p0_prologue(F); } SEAM(0);

    layer_body<0>(F, bar, lo, hi);
    layer_body<1>(F, bar, lo, hi);
    for (int rep_ = 0; rep_ < REPS(10); ++rep_) if (IN(N_PHASES - 1)) { if (rep_) xcd_barrier(bar); phase_norm1<2>(F, NLAYER - 1, (const float*)(F.ws + WS_X1), (float*)karg(21), NLAYER - 1); }
#ifdef MK_SELFTEST
    {
        const bool h0 = st_run(0, 1.f, 0x7f7f7f7f), h0s = st_run(0, 64.f, 0x79797979), h1 = st_run(1, 1.f, 0x7f7f7f7f);
        xcd_barrier(bar);
        float* o = (float*)karg(21);
        if (!(h0 && h0s)) { const float val = h0 ? 0.f : (h1 ? 1000.f : __builtin_nanf(""));
            for (size_t i = (size_t)blockIdx.x * NTHR + threadIdx.x; i < (size_t)SEQ * DM; i += (size_t)gridDim.x * NTHR) o[i] = val; }
    }
#endif
#undef IN
#undef SEAM
}

#ifndef MK_LAUNCHES
#define MK_LAUNCHES 1
#endif
extern "C" void kernel_launch(void* const* d_in, const int* in_sizes, int n_in, void* d_out, int out_size, void* d_ws, size_t ws_size, hipStream_t stream) {
    static int grid = 0;
    if (grid == 0) {
        int dev = 0, cus = 0, per_cu = 0;
        if (n_in != 21 || ws_size < WS_END) { fprintf(stderr, "kernel_launch: unexpected inputs (n_in %d, ws %zu)\n", n_in, ws_size); grid = -1; return; }
        if (hipGetDevice(&dev) != hipSuccess || hipDeviceGetAttribute(&cus, hipDeviceAttributeMultiprocessorCount, dev) != hipSuccess) { grid = -1; return; }
        if (hipFuncSetAttribute((const void*)mk_fwd, hipFuncAttributeMaxDynamicSharedMemorySize, LDS_BYTES) != hipSuccess) { fprintf(stderr, "kernel_launch: hipFuncSetAttribute failed\n"); grid = -1; return; }
        if (hipOccupancyMaxActiveBlocksPerMultiprocessor(&per_cu, (const void*)mk_fwd, NTHR, LDS_BYTES) != hipSuccess || per_cu < 1) fprintf(stderr, "kernel_launch: occupancy query says %d\n", per_cu);
        (void)hipGetLastError();
        grid = cus;
    }
    if (grid < 0) return;
    (void)hipMemsetAsync((char*)d_ws + WS_CTL, 0, CTL_ZERO_BYTES, stream);
    Args a{};
    for (int i = 0; i < 21; ++i) a.in[i] = (const float*)d_in[i];
    a.out = (float*)d_out; a.ws = (unsigned char*)d_ws;
#if MK_LAUNCHES == 1
    a.ph_lo = 0; a.ph_hi = N_PHASES;
    hipLaunchKernelGGL(mk_fwd, dim3(grid), dim3(NTHR), LDS_BYTES, stream, a);
#else
    for (int p = 0; p < N_PHASES; ++p) { a.ph_lo = p; a.ph_hi = p + 1; hipLaunchKernelGGL(mk_fwd, dim3(grid), dim3(NTHR), LDS_BYTES, stream, a); }
#endif
}
```

```cpp
#include <hip/hip_runtime.h>
#include <stdint.h>
#include <stdio.h>

#define GAS __attribute__((address_space(1)))
#define LAS __attribute__((address_space(3)))
typedef unsigned short bf16;
typedef short bf16x8 __attribute__((ext_vector_type(8)));
typedef short s16x4 __attribute__((ext_vector_type(4)));
typedef float f32x2 __attribute__((ext_vector_type(2)));
typedef float f32x4 __attribute__((ext_vector_type(4)));
typedef float f32x16 __attribute__((ext_vector_type(16)));
typedef unsigned u32x2 __attribute__((ext_vector_type(2)));
typedef unsigned u32x4 __attribute__((ext_vector_type(4)));
typedef int i32x8 __attribute__((ext_vector_type(8)));
typedef int i32x4 __attribute__((ext_vector_type(4)));
typedef GAS unsigned gu32;
#define RLX_AGENT __ATOMIC_RELAXED, __HIP_MEMORY_SCOPE_AGENT
#define LDS_WAIT() asm volatile("s_waitcnt lgkmcnt(0)" ::: "memory")
#define VM_WAIT() asm volatile("s_waitcnt vmcnt(0)" ::: "memory")

constexpr int DM = 2048, SEQ = 8192, NIN = 4616, NZ = 4608, DEX = 1024, NEXP = 16, NLAYER = 2;
constexpr float EPSN = 1e-6f;
constexpr float LOG2E = 1.4426950408889634f;
constexpr int NWAVES = 8, NTHR = 512;
constexpr int HIDROWS = 2 * SEQ + NEXP * 256;

constexpr size_t KiB = 1024, MiB = 1u << 20;
constexpr size_t WS_CTL = 0, CTL_ZERO_BYTES = 1 * MiB;
constexpr size_t WS_MOD = 1 * MiB;
constexpr size_t WS_FLOC = WS_MOD + 128 * KiB;
constexpr size_t WS_TOT = WS_FLOC + 256 * KiB;
constexpr size_t WS_FKL = WS_TOT + 8 * KiB;
constexpr size_t WS_TOKE = WS_FKL + 256 * KiB;
constexpr size_t WS_TOKP = WS_TOKE + 64 * KiB;
constexpr size_t WS_TOKW = WS_TOKP + 64 * KiB;
constexpr size_t WS_LIST = WS_TOKW + 64 * KiB;
constexpr size_t WS_WM = 4 * MiB;
constexpr size_t WS_BWT = WS_WM + 256 * KiB;
constexpr size_t WS_MODP = 6 * MiB;
constexpr size_t WS_WIN = 8 * MiB;
constexpr size_t WS_WOUT = WS_WIN + 2 * 18 * MiB;
constexpr size_t WS_WGU = WS_WOUT + 2 * 8 * MiB;
constexpr size_t WS_WD = WS_WGU + 2 * 16 * 8 * MiB;
constexpr size_t WS_H = WS_WD + 2 * 16 * 4 * MiB;
constexpr size_t WS_Z = WS_H + 32 * MiB;
constexpr size_t WS_QN = WS_Z + 72 * MiB;
constexpr size_t WS_KN = WS_QN + 16 * MiB;
constexpr size_t WS_VN = WS_KN + 16 * MiB;
constexpr size_t WS_DP = WS_VN + 8 * MiB;
constexpr size_t WS_YCAT = WS_DP + 8 * MiB;
constexpr size_t WS_X1 = WS_YCAT + 32 * MiB;
constexpr size_t WS_X2 = WS_X1 + 64 * MiB;
constexpr size_t WS_HID = WS_X2 + 64 * MiB;
constexpr size_t WS_YB = WS_HID + 40 * MiB;
constexpr size_t WS_PART = WS_YB + 80 * MiB;
constexpr size_t WS_ML = WS_PART + 128 * MiB;
constexpr size_t WS_HID1 = WS_ML + 4 * MiB;
constexpr size_t WS_END = WS_HID1 + 40 * MiB;
constexpr int CW_TMO = 0, CW_CODE = 1;
constexpr int CW_CNT = 64;
constexpr int CW_Q = 512;
constexpr int CW_BGT = 640;
constexpr int CW_ARR = 1024;
constexpr int CW_MT = 768;
constexpr int CW_BAR = 4096;
constexpr int CW_RDY = 8192;

constexpr int RING_BYTES = 131072;
constexpr int MISC_OFF = RING_BYTES + 320;
constexpr int AUX_OFF = RING_BYTES + 1024;
constexpr int LDS_BYTES = 163840;

template <class T> __device__ __forceinline__ T* opq(T* p) { asm volatile("" : "+s"(p)); return p; }
__device__ __forceinline__ int opq_tid(int wave) { int t = (wave << 6) | (int)__builtin_amdgcn_mbcnt_hi(~0u, __builtin_amdgcn_mbcnt_lo(~0u, 0u)); asm volatile("" : "+v"(t)); return t; }
__device__ __forceinline__ unsigned cvt_pk_bf16(float lo, float hi) { unsigned r; asm volatile("v_cvt_pk_bf16_f32 %0, %1, %2" : "=v"(r) : "v"(lo), "v"(hi)); return r; }
__device__ __forceinline__ unsigned cvt_pk4_fp8(float a, float b, float c, float d) {
    a = fminf(fmaxf(a, -440.f), 440.f); b = fminf(fmaxf(b, -440.f), 440.f); c = fminf(fmaxf(c, -440.f), 440.f); d = fminf(fmaxf(d, -440.f), 440.f);
    unsigned w; asm volatile("v_cvt_pk_fp8_f32 %0, %1, %2" : "=v"(w) : "v"(a), "v"(b)); asm volatile("v_cvt_pk_fp8_f32 %0, %1, %2 op_sel:[0,0,1]" : "+v"(w) : "v"(c), "v"(d)); return w; }
constexpr float H8_SCALE = 4.f, HID8_SCALE = 4.f, W8_SCALE = 64.f;
constexpr int SC_H8 = 0x7b7b7b7b, SC_HID8 = 0x7b7b7b7b, SC_W8 = 0x7b7b7b7b;
__device__ __forceinline__ float bf_lo(unsigned w) { return __uint_as_float(w << 16); }
__device__ __forceinline__ float bf_hi(unsigned w) { return __uint_as_float(w & 0xffff0000u); }
template <int M> __device__ __forceinline__ float xor_f(float v) {
    static_assert(M < 32, "xor_f: masks below 32 only");
    return __uint_as_float((unsigned)__builtin_amdgcn_ds_swizzle((int)__float_as_uint(v), (M << 10) | 0x1f));
}
__device__ __forceinline__ float wave_sum(float v) {
    v += xor_f<1>(v); v += xor_f<2>(v); v += xor_f<4>(v); v += xor_f<8>(v); v += xor_f<16>(v);
    { auto rr = __builtin_amdgcn_permlane32_swap(__float_as_uint(v), __float_as_uint(v), false, false); v = __uint_as_float(rr[0]) + __uint_as_float(rr[1]); }
    return v;
}
__device__ __forceinline__ float wave_max(float v) {
    v = fmaxf(v, xor_f<1>(v)); v = fmaxf(v, xor_f<2>(v)); v = fmaxf(v, xor_f<4>(v)); v = fmaxf(v, xor_f<8>(v)); v = fmaxf(v, xor_f<16>(v));
    { auto rr = __builtin_amdgcn_permlane32_swap(__float_as_uint(v), __float_as_uint(v), false, false); v = fmaxf(__uint_as_float(rr[0]), __uint_as_float(rr[1])); }
    return v;
}
__device__ __forceinline__ float gelu_t(float x) {
    const float u2 = x * (1.5957691216057308f + 0.0713548162726f * x * x);
    return x * __builtin_amdgcn_rcpf(1.f + __builtin_amdgcn_exp2f(-LOG2E * u2));
}
__device__ __forceinline__ float silu_f(float x) { return x * __builtin_amdgcn_rcpf(1.f + __builtin_amdgcn_exp2f(-LOG2E * x)); }

#define XB_TMO      128
#define XB_XCNT(j)  (256  + 64 * (j))
#define XB_XSUB(j)  (1280 + 64 * (j))
#define XB_XGEN(j)  (2304 + 64 * (j))
#define XB_TOP      3328
#define XB_TOPGEN   3392
#define XCD_BAR_WORDS 3456
#define XB_SPIN_CAP (1u << 18)
__device__ __forceinline__ unsigned xb_ld(unsigned* p)              { return __hip_atomic_load(p, __ATOMIC_RELAXED, __HIP_MEMORY_SCOPE_AGENT); }
__device__ __forceinline__ unsigned xb_add(unsigned* p, unsigned v) { return __hip_atomic_fetch_add(p, v, __ATOMIC_RELAXED, __HIP_MEMORY_SCOPE_AGENT); }
__device__ __forceinline__ unsigned xb_xcc_id() { return (unsigned)__builtin_amdgcn_s_getreg((3 << 11) | 20) & 0xFu; }
#define XB_SPIN(cond, bar) do { unsigned _sp = 0; while (cond) { __builtin_amdgcn_s_sleep(1); \
    if ((++_sp & 255u) == 0u) { if (xb_ld(&(bar)[XB_TMO])) break; if (_sp > XB_SPIN_CAP) { atomicAdd(&(bar)[XB_TMO], 1u); break; } } } } while (0)
struct XcdBarrier { unsigned* bar; unsigned x; volatile LAS unsigned* st; };
__device__ __forceinline__ XcdBarrier xcd_barrier_post(unsigned* bar, volatile LAS unsigned* st) {
    XcdBarrier b; b.bar = bar; b.x = xb_xcc_id(); b.st = st;
    if (threadIdx.x == 0) (void)xb_add(&bar[XB_XCNT(b.x)], 1u);
    return b;
}
__device__ __forceinline__ void xcd_barrier_complete(unsigned* bar, unsigned x, unsigned& nloc, unsigned& nx) {
    const unsigned G = gridDim.x * gridDim.y * gridDim.z;
    unsigned sum, cnt, mine, sp = 0u;
    for (;;) {
        sum = 0u; cnt = 0u; mine = 0u;
#pragma unroll
        for (unsigned j = 0; j < 16; ++j) { const unsigned c = xb_ld(&bar[XB_XCNT(j)]); sum += c; cnt += (c > 0u) ? 1u : 0u; mine = (j == x) ? c : mine; }
        if (sum == G) break;
        __builtin_amdgcn_s_sleep(1);
        if ((++sp & 255u) == 0u) { if (xb_ld(&bar[XB_TMO])) break; if (sp > XB_SPIN_CAP) { atomicAdd(&bar[XB_TMO], 1u); break; } }
    }
    nloc = mine > 0u ? mine : 1u; nx = cnt > 0u ? cnt : 1u;
}
__device__ __forceinline__ void xcd_barrier(const XcdBarrier& b) {
    asm volatile("s_waitcnt vmcnt(0)" ::: "memory");
    __syncthreads();
    if (threadIdx.x == 0) {
        unsigned* bar = b.bar; asm volatile("" : "+s"(bar));
        __builtin_amdgcn_s_waitcnt(0);
        unsigned nloc = b.st[0], nx = b.st[1];
        if (nloc == 0u) { xcd_barrier_complete(bar, b.x, nloc, nx); b.st[0] = nloc; b.st[1] = nx; }
        const unsigned old = xb_add(&bar[XB_XSUB(b.x)], 1u);
        const unsigned gen = old / nloc;
        if (old + 1u == (gen + 1u) * nloc) {
            __builtin_amdgcn_fence(__ATOMIC_RELEASE, "agent");
            asm volatile("s_waitcnt vmcnt(0)" ::: "memory");
            const unsigned og = xb_add(&bar[XB_TOP], 1u);
            const unsigned tg = og / nx;
            if (og + 1u == (tg + 1u) * nx) xb_add(&bar[XB_TOPGEN], 1u);
            else XB_SPIN(xb_ld(&bar[XB_TOPGEN]) == tg, bar);
            __builtin_amdgcn_fence(__ATOMIC_ACQUIRE, "agent");
            xb_add(&bar[XB_XGEN(b.x)], 1u);
            asm volatile("s_waitcnt vmcnt(0)" ::: "memory");
        } else {
            XB_SPIN(xb_ld(&bar[XB_XGEN(b.x)]) == gen, bar);
            __builtin_amdgcn_fence(__ATOMIC_ACQUIRE, "agent");
            asm volatile("s_waitcnt vmcnt(0)" ::: "memory");
        }
    }
    __syncthreads();
}

namespace gm {
constexpr int BM = 256, BK = 64, HALF = 128, HTB = HALF * BK * 2, STAGE_BYTES = 8 * HTB, NXCD = 8, WGM = 8;
__host__ __device__ __forceinline__ int lds_byte(int r, int c) { const int st = (r >> 4) * 2 + (c >> 5), rr = r & 15, cc = c & 31, ob = rr * 64 + cc * 2; return st * 1024 + (ob ^ (((ob >> 9) & 1) << 5)); }
__host__ __device__ __forceinline__ void stage_rc(int b, int& R, int& C) { const int st = b / 1024, sb = b % 1024, swz = sb ^ (((sb >> 9) & 1) << 5); R = (st >> 1) * 16 + swz / 64; C = (st & 1) * 32 + (swz % 64) / 2; }
__host__ __device__ __forceinline__ int perm32(int rho) { const int n = rho >> 4, i = rho & 15; return 8 * (i >> 2) + 4 * n + (i & 3); }

struct Unit { int arow, orow, ocol, e, rt; const char* Bp; };

template <class Epi, class Sched, bool GATHER, bool ALIGN_EPI, bool FP8 = false, int SCA = 0x7f7f7f7f, int SCB = 0x7f7f7f7f>
__device__ __forceinline__ void gemm_phase(LAS unsigned char* lds, const char* Abase, const int Kel, const Sched& S, const Epi& E, const int wv) {
    const int K = FP8 ? (Kel >> 1) : Kel;
    const int tid = opq_tid(wv), wid = wv, lane = tid & 63, wr = wid >> 2, wc = wid & 3, fr = lane & 15, fq = lane >> 4;
    const int nt = K / BK;
    unsigned voffA[2], voffB[2];
#pragma unroll
    for (int i = 0; i < 2; ++i) { int R, C; stage_rc(tid * 16 + i * 8192, R, C); const int Rb = Epi::PERM ? ((R & ~31) + perm32(R & 31)) : R;
        voffA[i] = (unsigned)(R * K + C) * 2u; voffB[i] = (unsigned)(Rb * K + C) * 2u; }
    const size_t kstep = (size_t)(BK * 2);
    const size_t hstep = (size_t)HALF * K * 2;
    const unsigned ldsw = (unsigned)wid * 1024u;
    const int aoff = FP8 ? lds_byte(wr * 64 + fr, fq * 16) : lds_byte(wr * 64 + fr, fq * 8), boff = FP8 ? lds_byte(wc * 32 + fr, fq * 16) : lds_byte(wc * 32 + fr, fq * 8);
#define PG8_SA(b, h) (((b) * 2 + (h)) * HTB)
#define PG8_SB(b, h) ((4 + (b) * 2 + (h)) * HTB)
#define PG8_STAGE(bufoff, gbase, voff) do { _Pragma("unroll") for (int _i = 0; _i < 2; ++_i) { unsigned vo_ = (voff)[_i]; asm volatile("" : "+v"(vo_));     \
        __builtin_amdgcn_global_load_lds((const unsigned*)((const char*)(gbase) + vo_), (LAS unsigned*)(lds + (bufoff) + ldsw + _i * 8192), 16, 0, 0); } } while (0)
#define PG8_STAGE_A(bufoff, ubase, h, kb, vg) do { if constexpr (GATHER) { PG8_STAGE(bufoff, Abase + (kb), (vg)[h]); } else { PG8_STAGE(bufoff, (ubase) + (h) * hstep + (kb), voffA); } } while (0)
#define PG8_STAGE_A2(bufoff, ubase, h, kb) PG8_STAGE_A(bufoff, ubase, h, kb, vgc)
#define PG8_LDA(dst, b, h) do { _Pragma("unroll") for (int m = 0; m < 4; ++m) { if constexpr (FP8) { dst##8[m].lo = *(const LAS i32x4*)(lds + PG8_SA(b, h) + aoff + m * 2048); dst##8[m].hi = *(const LAS i32x4*)(lds + PG8_SA(b, h) + aoff + 16 + m * 2048); } \
        else { dst[m][0] = *(const LAS bf16x8*)(lds + PG8_SA(b, h) + aoff + m * 2048); dst[m][1] = *(const LAS bf16x8*)(lds + PG8_SA(b, h) + aoff + 1024 + m * 2048); } } } while (0)
#define PG8_LDB(dst, b, h) do { _Pragma("unroll") for (int n = 0; n < 2; ++n) { if constexpr (FP8) { dst##8[n].lo = *(const LAS i32x4*)(lds + PG8_SB(b, h) + boff + n * 2048); dst##8[n].hi = *(const LAS i32x4*)(lds + PG8_SB(b, h) + boff + 16 + n * 2048); } \
        else { dst[n][0] = *(const LAS bf16x8*)(lds + PG8_SB(b, h) + boff + n * 2048); dst[n][1] = *(const LAS bf16x8*)(lds + PG8_SB(b, h) + boff + 1024 + n * 2048); } } } while (0)
#define PG8_F8(x) __builtin_shufflevector(__builtin_bit_cast(i32x4, (x)[0]), __builtin_bit_cast(i32x4, (x)[1]), 0, 1, 2, 3, 4, 5, 6, 7)
#define PG8_MMA(ai, bj, At, Bt) do { __builtin_amdgcn_s_setprio(1); _Pragma("unroll") for (int m = 0; m < 4; ++m) _Pragma("unroll") for (int n = 0; n < 2; ++n) { \
        if constexpr (FP8) { acc[ai][bj][m][n] = __builtin_amdgcn_mfma_scale_f32_16x16x128_f8f6f4(Bt##8[n], At##8[m], acc[ai][bj][m][n], 0, 0, 0, SCB, 0, SCA); } \
        else { _Pragma("unroll") for (int k = 0; k < 2; ++k) acc[ai][bj][m][n] = __builtin_amdgcn_mfma_f32_16x16x32_bf16(Bt[n][k], At[m][k], acc[ai][bj][m][n], 0, 0, 0); } } \
        __builtin_amdgcn_s_setprio(0); } while (0)
#define PG8_WAIT_V(n) asm volatile("s_waitcnt vmcnt(" #n ")" ::: "memory")
#define PG8_WAIT_L(n) asm volatile("s_waitcnt lgkmcnt(" #n ")" ::: "memory")
#define PG8_BAR __builtin_amdgcn_s_barrier()
#define PG8_SCHED __builtin_amdgcn_sched_barrier(0)
    Unit cur, nxt; int ui = 0;
    if (!S.next(0, cur)) return;
    f32x4 acc[2][2][4][2];
#pragma unroll
    for (int a = 0; a < 2; ++a)
#pragma unroll
        for (int b = 0; b < 2; ++b)
#pragma unroll
            for (int m = 0; m < 4; ++m)
#pragma unroll
                for (int n = 0; n < 2; ++n) acc[a][b][m][n] = (f32x4){0.f, 0.f, 0.f, 0.f};
    bf16x8 At[4][2], B0[2][2], B1[2][2];
    i32x8 At8[4], B08[2], B18[2];
    unsigned vgc[2][2];
    if constexpr (GATHER) {
#pragma unroll
        for (int h = 0; h < 2; ++h)
#pragma unroll
            for (int i = 0; i < 2; ++i) { int R_, C_; stage_rc(opq_tid(wv) * 16 + i * 8192, R_, C_); vgc[h][i] = ((unsigned)S.row_of(cur, h * HALF + R_) * (unsigned)K + (unsigned)C_) * 2u; }
    }
    const char* cA = GATHER ? Abase : Abase + (size_t)cur.arow * K * 2; const char* cB = cur.Bp;
    PG8_STAGE(PG8_SB(0, 0), cB, voffB); PG8_STAGE(PG8_SB(0, 1), cB + hstep, voffB); PG8_STAGE_A(PG8_SA(0, 0), cA, 0, 0, vgc); PG8_STAGE_A(PG8_SA(0, 1), cA, 1, 0, vgc);
    if (wr == 1) PG8_BAR;
    PG8_WAIT_V(2); PG8_BAR;
    PG8_STAGE(PG8_SB(1, 0), cB + kstep, voffB); PG8_STAGE_A(PG8_SA(1, 0), cA, 0, kstep, vgc); PG8_STAGE(PG8_SB(1, 1), cB + hstep + kstep, voffB);
    PG8_WAIT_V(6); PG8_BAR;
    for (;;) {
        bool has_next = false;
        const char* nA = cA; const char* nB = cB;
        for (int t = 0; t < nt; t += 2) {
            const bool last = (t == nt - 2);
            if (last) { has_next = S.next(ui + 1, nxt); if (has_next) { nA = GATHER ? Abase : Abase + (size_t)nxt.arow * K * 2; nB = nxt.Bp; } }
            const size_t k1 = (size_t)(t + 1) * kstep;
            const char* a2 = last ? nA : cA; const char* b2 = last ? nB : cB + (size_t)(t + 2) * kstep;
            const size_t k2 = last ? 0 : (size_t)(t + 2) * kstep, k3 = k2 + kstep;
            const char* b3 = b2 + kstep;
            PG8_LDB(B0, 0, 0); PG8_LDB(B1, 0, 1); PG8_SCHED; PG8_LDA(At, 0, 0); PG8_STAGE_A(PG8_SA(1, 1), cA, 1, k1, vgc);
            if constexpr (GATHER) { if (last && has_next) {
#pragma unroll
                for (int h = 0; h < 2; ++h)
#pragma unroll
                    for (int i = 0; i < 2; ++i) { int R_, C_; stage_rc(opq_tid(wv) * 16 + i * 8192, R_, C_); vgc[h][i] = ((unsigned)S.row_of(nxt, h * HALF + R_) * (unsigned)K + (unsigned)C_) * 2u; } } }
            PG8_WAIT_V(8); PG8_WAIT_L(0); PG8_BAR; PG8_MMA(0, 0, At, B0); PG8_MMA(0, 1, At, B1); PG8_BAR; PG8_SCHED;
            PG8_LDA(At, 0, 1); PG8_STAGE(PG8_SB(0, 0), b2, voffB); PG8_STAGE(PG8_SB(0, 1), b2 + hstep, voffB); PG8_STAGE_A2(PG8_SA(0, 0), a2, 0, k2);
            PG8_WAIT_V(8); PG8_WAIT_L(0); PG8_BAR; PG8_MMA(1, 0, At, B0); PG8_MMA(1, 1, At, B1); PG8_BAR; PG8_SCHED;
            PG8_LDB(B0, 1, 0); PG8_LDB(B1, 1, 1); PG8_SCHED; PG8_LDA(At, 1, 0); PG8_STAGE_A2(PG8_SA(0, 1), a2, 1, k2);
            PG8_WAIT_V(8); PG8_WAIT_L(0); PG8_BAR; PG8_MMA(0, 0, At, B0); PG8_MMA(0, 1, At, B1); PG8_BAR; PG8_SCHED;
            PG8_LDA(At, 1, 1); PG8_STAGE(PG8_SB(1, 0), b3, voffB); PG8_STAGE(PG8_SB(1, 1), b3 + hstep, voffB); PG8_STAGE_A2(PG8_SA(1, 0), a2, 0, k3);
            PG8_WAIT_V(8); PG8_WAIT_L(0); PG8_BAR; PG8_MMA(1, 0, At, B0); PG8_MMA(1, 1, At, B1); PG8_BAR; PG8_SCHED;
        }
        if constexpr (ALIGN_EPI) { if (wr == 0) PG8_BAR; }
        E(acc, cur, wr, wc, fr, fq);
        if (!has_next) break;
#pragma unroll
        for (int a = 0; a < 2; ++a)
#pragma unroll
            for (int b = 0; b < 2; ++b)
#pragma unroll
                for (int m = 0; m < 4; ++m)
#pragma unroll
                    for (int n = 0; n < 2; ++n) acc[a][b][m][n] = (f32x4){0.f, 0.f, 0.f, 0.f};
        cur = nxt; cA = nA; cB = nB; ++ui;
        if constexpr (ALIGN_EPI) { if (wr == 1) PG8_BAR; }
    }
    PG8_WAIT_V(0);
    if constexpr (!ALIGN_EPI) { if (wr == 0) PG8_BAR; }
    PG8_BAR;
#undef PG8_SA
#undef PG8_SB
#undef PG8_STAGE
#undef PG8_STAGE_A
#undef PG8_STAGE_A2
#undef PG8_LDA
#undef PG8_LDB
#undef PG8_MMA
#undef PG8_F8
#undef PG8_WAIT_V
#undef PG8_WAIT_L
#undef PG8_BAR
#undef PG8_SCHED
}

struct RegOrder {
    int nM, nN, nwg, G, c, K; const char* Bt;
    __device__ __forceinline__ void init(int M, int N, int K_, const void* Bt_, int G_, int c_) { nM = M / BM; nN = N / BM; nwg = nM * nN; G = G_; c = c_; K = K_; Bt = (const char*)Bt_; }
    __device__ __forceinline__ bool next(int i, Unit& u) const {
        const long L = (long)i * G + c; if (L >= nwg) return false;
        int wgid = (int)L; { const int q = nwg / NXCD, r = nwg % NXCD, xcd = wgid % NXCD, off = wgid / NXCD; wgid = (xcd < r ? xcd * (q + 1) : r * (q + 1) + (xcd - r) * q) + off; }
        const int nig = WGM * nN, gid = wgid / nig, fm = gid * WGM, gsz = (nM - fm) < WGM ? (nM - fm) : WGM;
        const int pm = fm + ((wgid % nig) % gsz), pn = (wgid % nig) / gsz;
        u.arow = pm * BM; u.orow = pm * BM; u.ocol = pn * BM; u.e = 0; u.rt = 0; u.Bp = Bt + (size_t)pn * BM * K * 2; return true;
    }
    __device__ __forceinline__ int row_of(const Unit&, int) const { return 0; }
};
}
namespace at {
constexpr int NW = 8, QBLK = 32, KVBLK = 64, QB = NW * QBLK, D = 128;
constexpr int SHM_V = KVBLK * D * 2, SHM_K = KVBLK * D * 2;
constexpr int OFF_WS = 2 * SHM_V + 2 * SHM_K, OFF_NF = OFF_WS + NW * 64 * 4, ATT_LDS = OFF_NF + 2 * 64 * 4;
constexpr float SCALE = 0.08838834764831845f, C2 = 1.4426950408889634f * SCALE, THR = 8.f;
constexpr float ISCALE = 11.313708498984761f;
constexpr int QS = 128, KS = 128, VS = NZ, OS = DM;

#define KSWZ(row, colB) ((row) * 256 + ((colB) ^ (((row) & 7) << 4)))
#define SBAR() __builtin_amdgcn_sched_barrier(0)
__device__ __forceinline__ int v_st(int k, int c) { const int kk = (k & ~0xC) | ((k & 4) << 1) | ((k & 8) >> 1); return ((kk >> 3) * 4 + (c >> 5)) * 512 + ((kk & 7) * 32 + (c & 31)) * 2; }
__device__ __forceinline__ int v_rd_base(int lane) { return ((lane & 3) << 3) | (((lane >> 2) & 3) << 6) | (((lane >> 4) & 1) << 5) | (((lane >> 5) & 1) << 8); }
constexpr int v_rd_off(int d0, int ks, int half) { return d0 * 512 + ks * 4096 + half * 2048; }
__device__ __forceinline__ int crow(int r, int hi) { return (r & 3) + 8 * (r >> 2) + 4 * hi; }
__device__ __forceinline__ unsigned cvtpk(float lo, float hi) { unsigned r; asm volatile("v_cvt_pk_bf16_f32 %0, %1, %2" : "=v"(r) : "v"(lo), "v"(hi)); return r; }
__device__ __forceinline__ bf16x8 load8(const bf16* p) { return *(const GAS bf16x8*)p; }

__device__ __forceinline__ void mask_tile(f32x16& p0, f32x16& p1, int dq) {
    const float NEG = -__builtin_inff();
#pragma unroll
    for (int r = 0; r < 16; ++r) {
        const int c = (r & 3) + 8 * (r >> 2);
        if (dq - c < 0) p0[r] = NEG;
        if (dq - c - 32 < 0) p1[r] = NEG;
    }
}
__device__ __forceinline__ void partialSM(f32x16& p0, f32x16& p1, float& m_reg, float& mn, float& alpha) {
    float pmax = p0[0]; for (int r = 1; r < 16; ++r) pmax = fmaxf(pmax, p0[r]); for (int r = 0; r < 16; ++r) pmax = fmaxf(pmax, p1[r]);
    { auto rr = __builtin_amdgcn_permlane32_swap(__float_as_uint(pmax), __float_as_uint(pmax), false, false);
      pmax = fmaxf(__uint_as_float(rr[0]), __uint_as_float(rr[1])); }
    if (__builtin_expect(__all((pmax - m_reg) * SCALE <= THR), 1)) { mn = m_reg; alpha = 1.f; }
    else { mn = fmaxf(m_reg, pmax); alpha = __builtin_amdgcn_exp2f((m_reg - mn) * C2); m_reg = mn; }
    const float mnL = -mn * C2;
    for (int r = 0; r < 16; ++r) p0[r] = fmaf(p0[r], C2, mnL); for (int r = 0; r < 16; ++r) p1[r] = fmaf(p1[r], C2, mnL);
    for (int r = 0; r < 16; ++r) p0[r] = __builtin_amdgcn_exp2f(p0[r]);
}
__device__ __forceinline__ void finishSM(f32x16& p0, f32x16& p1, float alpha, float& l_reg, bf16x8& pa0, bf16x8& pa1, bf16x8& pa2, bf16x8& pa3) {
    for (int r = 0; r < 16; ++r) p1[r] = __builtin_amdgcn_exp2f(p1[r]);
    float ps = 0; for (int r = 0; r < 16; ++r) ps += p0[r]; for (int r = 0; r < 16; ++r) ps += p1[r];
    { auto rr = __builtin_amdgcn_permlane32_swap(__float_as_uint(ps), __float_as_uint(ps), false, false);
      ps = __uint_as_float(rr[0]) + __uint_as_float(rr[1]); }
    l_reg = l_reg * alpha + ps;
#define PK4(P, B_, OUT) do { unsigned a0 = cvtpk(P[B_+0], P[B_+1]), a1 = cvtpk(P[B_+2], P[B_+3]);                          \
        unsigned b0 = cvtpk(P[B_+4], P[B_+5]), b1 = cvtpk(P[B_+6], P[B_+7]);                                             \
        auto r0 = __builtin_amdgcn_permlane32_swap(a0, b0, false, false); auto r1 = __builtin_amdgcn_permlane32_swap(a1, b1, false, false); \
        u32x4 w = {r0[0], r1[0], r0[1], r1[1]}; OUT = *reinterpret_cast<bf16x8*>(&w); } while (0)
    PK4(p0, 0, pa0); PK4(p0, 8, pa1); PK4(p1, 0, pa2); PK4(p1, 8, pa3);
#undef PK4
}
template <int KB>
__device__ __forceinline__ void qkt(f32x16& p0, f32x16& p1, const char* K_lds, int r32, int hi, const bf16x8* qr) {
    { const float* nf = (const float*)(K_lds + 2 * SHM_K + NW * 64 * 4) + KB * 64 + 4 * hi;
#pragma unroll
      for (int g = 0; g < 4; ++g) { const f32x4 a = *(const f32x4*)(nf + 8 * g), b = *(const f32x4*)(nf + 32 + 8 * g);
#pragma unroll
          for (int j = 0; j < 4; ++j) { p0[4 * g + j] = a[j]; p1[4 * g + j] = b[j]; } } }
    const char* kb[4];
#pragma unroll
    for (int dd = 0; dd < 4; ++dd) kb[dd] = K_lds + KB * SHM_K + KSWZ(r32, (dd * 16 + hi * 8) * 2);
#pragma unroll
    for (int d0 = 0; d0 < 8; ++d0) { const char* a = kb[d0 & 3] + (d0 >> 2) * 128;
        bf16x8 b0 = *reinterpret_cast<const bf16x8*>(a);
        bf16x8 b1 = *reinterpret_cast<const bf16x8*>(a + 32 * 256);
        p0 = __builtin_amdgcn_mfma_f32_32x32x16_bf16(b0, qr[d0], p0, 0, 0, 0);
        p1 = __builtin_amdgcn_mfma_f32_32x32x16_bf16(b1, qr[d0], p1, 0, 0, 0); }
}
template <int VB>
__device__ __forceinline__ void pv_tile(f32x16* o, int vb0, bf16x8 pa0, bf16x8 pa1, bf16x8 pa2, bf16x8 pa3) {
#define TRRD(dst, off) asm volatile("ds_read_b64_tr_b16 %0, %1 offset:%2" : "=&v"(dst) : "v"(vb0), "i"(off) : "memory")
#define PV_D0(d0) do { s16x4 l0, l1, l2, l3, h0, h1, h2, h3; constexpr int b_ = VB * SHM_V + v_rd_off(d0, 0, 0); \
        TRRD(l0, b_); TRRD(h0, b_ + 2048); TRRD(l1, b_ + 4096); TRRD(h1, b_ + 6144); TRRD(l2, b_ + 8192); TRRD(h2, b_ + 10240); TRRD(l3, b_ + 12288); TRRD(h3, b_ + 14336); \
        asm volatile("s_waitcnt lgkmcnt(0)" ::: "memory"); SBAR();   \
        o[d0] = __builtin_amdgcn_mfma_f32_32x32x16_bf16(pa0, (bf16x8){l0[0], l0[1], l0[2], l0[3], h0[0], h0[1], h0[2], h0[3]}, o[d0], 0, 0, 0);   \
        o[d0] = __builtin_amdgcn_mfma_f32_32x32x16_bf16(pa1, (bf16x8){l1[0], l1[1], l1[2], l1[3], h1[0], h1[1], h1[2], h1[3]}, o[d0], 0, 0, 0);   \
        o[d0] = __builtin_amdgcn_mfma_f32_32x32x16_bf16(pa2, (bf16x8){l2[0], l2[1], l2[2], l2[3], h2[0], h2[1], h2[2], h2[3]}, o[d0], 0, 0, 0);   \
        o[d0] = __builtin_amdgcn_mfma_f32_32x32x16_bf16(pa3, (bf16x8){l3[0], l3[1], l3[2], l3[3], h3[0], h3[1], h3[2], h3[3]}, o[d0], 0, 0, 0); } while (0)
    PV_D0(0); PV_D0(1); PV_D0(2); PV_D0(3);
#undef PV_D0
#undef TRRD
}

struct BlockRef { const bf16* Q; const bf16* K; const bf16* V; bf16* O; const float* FK; int P0; };
#define ROWV(p, k0, rr) ((p) + (size_t)((k0) + (rr)) * VS + sc)
#define VMW() asm volatile("s_waitcnt vmcnt(0)" ::: "memory")
__device__ __forceinline__ void attn_block(const BlockRef& cur, int ja, int nt, bool fin, bf16* Opart, float* ML, char* lds, LAS unsigned char* ldsL, const int wv) {
    const int tid = opq_tid(wv), wid = wv, lane = tid & 63, r32 = lane & 31, hi = lane >> 5;
    const int NT = nt;
    const int qlo = cur.P0 + wid * QBLK, qm = qlo + r32 - 4 * hi;
    char* V_lds = lds; char* K_lds = lds + 2 * SHM_V;
    float* ws = (float*)(lds + OFF_WS) + wid * 64; float* li_l = ws, * al_l = ws + 32;
    float m_reg = -1e30f, l_reg = 0; f32x16 o[4] = {};
    const int vb0 = (int)(uintptr_t)V_lds + v_rd_base(lane);
    const bf16* Kh = cur.K; const bf16* Vh = cur.V; const float* Fh = cur.FK;
    bf16x8 st_v0, st_v1; bf16x8 qr[8];
#define KDMA(bf, k0) do { int t_ = tid; asm volatile("" : "+v"(t_)); _Pragma("unroll") for (int i_ = 0; i_ < 2; ++i_) { const int p_ = i_ * 512 + t_, r_ = p_ >> 4, c_ = (p_ & 15) ^ (r_ & 7); \
        __builtin_amdgcn_global_load_lds((const unsigned*)((const char*)Kh + (size_t)(k0) * KS * 2 + (unsigned)(r_ * KS * 2 + c_ * 16)), (LAS unsigned*)(ldsL + 2 * SHM_V + (bf) * SHM_K + i_ * 8192 + wid * 1024), 16, 0, 0); } \
        if (wid == 0) __builtin_amdgcn_global_load_lds((const unsigned*)(Fh + (k0) + lane), (LAS unsigned*)(ldsL + OFF_NF + (bf) * 256), 4, 0, 0); } while (0)
#define SLOADV(k0) do { int t_ = tid; asm volatile("" : "+v"(t_)); const int sr = t_ >> 4, sc = (t_ & 15) * 8; st_v0 = load8(ROWV(Vh, k0, sr)); st_v1 = load8(ROWV(Vh, k0, 32 + sr)); } while (0)
#define SWRITE_HV(bf) do { int t_ = tid; asm volatile("" : "+v"(t_)); const int sr = t_ >> 4, sc = (t_ & 15) * 8; *(bf16x8*)(V_lds + (bf) * SHM_V + v_st(sr, sc)) = st_v0; *(bf16x8*)(V_lds + (bf) * SHM_V + v_st(32 + sr, sc)) = st_v1; } while (0)
#define RESC(a) do { if (__any((a) < 1.f)) { if (hi == 0) al_l[r32] = (a); asm volatile("s_waitcnt lgkmcnt(0)" ::: "memory");              \
                     for (int d_ = 0; d_ < 4; ++d_) for (int r = 0; r < 16; ++r) o[d_][r] *= al_l[crow(r, hi)]; } } while (0)
#define KBASE(t) ((ja + (t)) * KVBLK)
#define MASKT(P0_, P1_, t) do { const int kb_ = KBASE(t); if (kb_ + KVBLK - 1 > qlo) mask_tile(P0_, P1_, qm - kb_); } while (0)
    f32x16 pA0, pA1, pB0, pB1; float mnA, mnB, alA, alB; bf16x8 pa0, pa1, pa2, pa3;
    KDMA(0, KBASE(0)); SLOADV(KBASE(0));
#pragma unroll
    for (int d0 = 0; d0 < 8; ++d0) qr[d0] = load8(cur.Q + (size_t)(wid * QBLK + r32) * QS + d0 * 16 + hi * 8);
    VMW(); SWRITE_HV(0);
    __syncthreads();
    if (NT > 1) { KDMA(1, KBASE(1)); SLOADV(KBASE(1)); }
    SBAR(); qkt<0>(pA0, pA1, K_lds, r32, hi, qr);
    MASKT(pA0, pA1, 0); partialSM(pA0, pA1, m_reg, mnA, alA);
    if (NT > 1) { VMW(); SWRITE_HV(1); }
    __syncthreads();
#define HALF_STEP(PX0, PX1, mnX, alX, PY0, PY1, alY, t, KB, VB, SB) do {                                                      \
        SBAR(); qkt<KB>(PX0, PX1, K_lds, r32, hi, qr);                                                                        \
        finishSM(PY0, PY1, alY, l_reg, pa0, pa1, pa2, pa3); SBAR();                                                           \
        if ((t) + 1 < NT) { KDMA(SB, KBASE((t) + 1)); SLOADV(KBASE((t) + 1)); SBAR(); }                                       \
        pv_tile<VB>(o, vb0, pa0, pa1, pa2, pa3); MASKT(PX0, PX1, (t)); partialSM(PX0, PX1, m_reg, mnX, alX);                  \
        VMW(); __syncthreads();                                                                                               \
        if ((t) + 1 < NT) { SWRITE_HV(SB); }                                                                                  \
        RESC(alX); __syncthreads(); } while (0)
    for (int t = 1; t + 1 < NT; t += 2) {
        HALF_STEP(pB0, pB1, mnB, alB, pA0, pA1, alA, t, 1, 0, 0);
        HALF_STEP(pA0, pA1, mnA, alA, pB0, pB1, alB, t + 1, 0, 1, 1);
    }
    const bool even = (NT & 1) == 0;
    if (even) { SBAR(); qkt<1>(pB0, pB1, K_lds, r32, hi, qr); SBAR(); }
    finishSM(pA0, pA1, alA, l_reg, pa0, pa1, pa2, pa3); SBAR();
    pv_tile<0>(o, vb0, pa0, pa1, pa2, pa3);
    if (even) { MASKT(pB0, pB1, NT - 1); partialSM(pB0, pB1, m_reg, mnB, alB); __syncthreads(); RESC(alB);
        finishSM(pB0, pB1, alB, l_reg, pa0, pa1, pa2, pa3); SBAR(); pv_tile<1>(o, vb0, pa0, pa1, pa2, pa3); }
    SBAR();
    if (hi == 0) li_l[r32] = l_reg; asm volatile("s_waitcnt lgkmcnt(0)" ::: "memory");
    float rli[16];
#pragma unroll
    for (int r = 0; r < 16; ++r) rli[r] = __builtin_amdgcn_rcpf(li_l[crow(r, hi)]);
    const int ostr = fin ? OS : D;
    bf16* Ow = (fin ? cur.O : Opart) + (size_t)(wid * QBLK) * ostr;
#pragma unroll
    for (int r = 0; r < 16; ++r) { const int orow = crow(r, hi);
#pragma unroll
        for (int d0 = 0; d0 < 4; ++d0) { const float v = o[d0][r] * rli[r];
            const float vn = xor_f<1>(v);
            if ((r32 & 1) == 0) *(GAS unsigned*)(Ow + (size_t)orow * ostr + d0 * 32 + r32) = cvtpk(v, vn); } }
    if (!fin && hi == 0) { f32x2 mlv; mlv.x = m_reg; mlv.y = l_reg; *(GAS f32x2*)(ML + (size_t)(wid * QBLK + r32) * 2) = mlv; }
    __syncthreads();
#undef KDMA
#undef SLOADV
#undef SWRITE_HV
#undef RESC
#undef KBASE
#undef MASKT
#undef HALF_STEP
}
#undef ROWV
#undef VMW
}
struct Frame {
    LAS unsigned char* lds; volatile LAS unsigned* MISC; gu32* ctl;
    int tid, lane, wave, vcu, G;
    unsigned char* ws;
};
#define CAS __attribute__((address_space(4)))
__device__ __forceinline__ const float* karg(int k) { const CAS char* p = (const CAS char*)__builtin_amdgcn_kernarg_segment_ptr(); asm volatile("" : "+s"(p)); return *(const float* const CAS*)(p + 8 * k); }

__device__ __forceinline__ void tr_item(const float* W, size_t ldw, bf16* WT, size_t ldk, LAS float* scr, int lane) {
    const int kr = lane >> 3, c4 = (lane & 7) * 4;
    f32x4 v[8];
#pragma unroll
    for (int i = 0; i < 8; ++i) v[i] = __builtin_nontemporal_load((const GAS f32x4*)(W + (size_t)(8 * i + kr) * ldw + c4));
#pragma unroll
    for (int i = 0; i < 8; ++i) { LAS float* s = scr + (8 * i + kr) * 33 + c4; s[0] = v[i].x; s[1] = v[i].y; s[2] = v[i].z; s[3] = v[i].w; }
    LDS_WAIT();
    const int c = lane & 7;
#pragma unroll
    for (int j = 0; j < 4; ++j) { const int n = (lane >> 3) + 8 * j; const LAS float* s = scr + (8 * c) * 33 + n;
        u32x4 o; o.x = cvt_pk_bf16(s[0 * 33], s[1 * 33]); o.y = cvt_pk_bf16(s[2 * 33], s[3 * 33]); o.z = cvt_pk_bf16(s[4 * 33], s[5 * 33]); o.w = cvt_pk_bf16(s[6 * 33], s[7 * 33]);
        *(GAS u32x4*)(WT + (size_t)n * ldk + 8 * c) = o; }
    LDS_WAIT();
}
__device__ __forceinline__ void tr_item8(const float* W, size_t ldw, unsigned char* WT, size_t ldk, LAS float* scr, int lane) {
    const int kr = lane >> 3, c4 = (lane & 7) * 4;
    f32x4 v[8];
#pragma unroll
    for (int i = 0; i < 8; ++i) v[i] = __builtin_nontemporal_load((const GAS f32x4*)(W + (size_t)(8 * i + kr) * ldw + c4));
#pragma unroll
    for (int i = 0; i < 8; ++i) { LAS float* s = scr + (8 * i + kr) * 33 + c4; s[0] = v[i].x; s[1] = v[i].y; s[2] = v[i].z; s[3] = v[i].w; }
    LDS_WAIT();
    const int c = lane & 3;
#pragma unroll
    for (int j = 0; j < 2; ++j) { const int n = (lane >> 2) + 16 * j; const LAS float* s = scr + (16 * c) * 33 + n;
        u32x4 o;
        o.x = cvt_pk4_fp8(s[0 * 33] * W8_SCALE, s[1 * 33] * W8_SCALE, s[2 * 33] * W8_SCALE, s[3 * 33] * W8_SCALE); o.y = cvt_pk4_fp8(s[4 * 33] * W8_SCALE, s[5 * 33] * W8_SCALE, s[6 * 33] * W8_SCALE, s[7 * 33] * W8_SCALE);
        o.z = cvt_pk4_fp8(s[8 * 33] * W8_SCALE, s[9 * 33] * W8_SCALE, s[10 * 33] * W8_SCALE, s[11 * 33] * W8_SCALE); o.w = cvt_pk4_fp8(s[12 * 33] * W8_SCALE, s[13 * 33] * W8_SCALE, s[14 * 33] * W8_SCALE, s[15 * 33] * W8_SCALE);
        *(GAS u32x4*)(WT + (size_t)n * ldk + 16 * c) = o; }
    LDS_WAIT();
}
constexpr int I_IN = (DM / 64) * (NZ / 32), I_OUT = (DM / 64) * (DM / 32), I_GU = (DM / 64) * (DEX / 32), I_D = (DEX / 64) * (DM / 32);
constexpr int GV_FIRST = 43;
constexpr int BGI_SMALL = (NLAYER * 4 * 8) / 8, BGI_IN = I_IN / 8, BGI_GV0 = (128 - GV_FIRST) * 4, BGI_GV1 = 128 * 4, BGI_OUT = I_OUT / 8, BGI_GU = NEXP * 2 * I_GU / 8, BGI_D = NEXP * I_D / 8;
constexpr int BG_C0 = BGI_SMALL + BGI_IN;
constexpr int BG_C1 = BG_C0 + BGI_GV0 + BGI_OUT;
constexpr int BG_C2 = BG_C1 + BGI_GU;
constexpr int BG_C3 = BG_C2 + BGI_D;
constexpr int BG_C3B = BG_C3 + BGI_GV1;
constexpr int BG_C4 = BG_C3B + BGI_IN;
constexpr int BG_C5 = BG_C4 + BGI_OUT;
constexpr int BG_C6 = BG_C5 + BGI_GU;
constexpr int BG_C7 = BG_C6 + BGI_D;
__device__ __forceinline__ float mod_at(const unsigned char* ws, const float* b_ada, int l, int j) {
    const float* p = (const float*)(ws + WS_MODP) + (size_t)l * 6 * DM + j;
    return *(const GAS float*)(b_ada + (size_t)l * 6 * DM + j) + ((*(const GAS float*)p + *(const GAS float*)(p + 2 * 6 * DM)) + (*(const GAS float*)(p + 4 * 6 * DM) + *(const GAS float*)(p + 6 * 6 * DM)));
}
__device__ __forceinline__ void gemv_item(const Frame& F, unsigned char* ws, int w) {
    LAS float* sc = (LAS float*)F.lds; LAS f32x4* red = (LAS f32x4*)(F.lds + 8192);
    const int kq = w & 3, l = w >> 9, cb = (w >> 2) & 127, c4 = F.tid % 24, kg = F.tid / 24;
    if (F.tid < 512) sc[F.tid] = silu_f(*(const GAS float*)(karg(1) + kq * 512 + F.tid));
    __syncthreads();
    f32x4 acc = (f32x4){0.f, 0.f, 0.f, 0.f};
    if (kg < 21) {
        const float* wp = karg(2) + (size_t)l * DM * 6 * DM + (size_t)(kq * 512) * 6 * DM + cb * 96 + c4 * 4;
#pragma unroll 8
        for (int k = kg; k < 512; k += 21) { const f32x4 wv = __builtin_nontemporal_load((const GAS f32x4*)(wp + (size_t)k * 6 * DM)); acc += wv * sc[k]; }
        red[kg * 24 + c4] = acc;
    }
    __syncthreads();
    if (F.tid < 24) { f32x4 s = red[F.tid];
        for (int g = 1; g < 21; ++g) s += red[g * 24 + F.tid];
        *(GAS f32x4*)((float*)(ws + WS_MODP) + (size_t)kq * 2 * 6 * DM + (size_t)l * 6 * DM + cb * 96 + F.tid * 4) = s; }
    __syncthreads();
}
__device__ __forceinline__ void conv_wave_item(const Frame& F, unsigned char* ws, int r, int l, LAS float* scr) {
    if (r < I_IN) { const int kb = r / (NZ / 32), nb = r % (NZ / 32);
        tr_item8(karg(6) + (size_t)l * DM * NIN + (size_t)(64 * kb) * NIN + 32 * nb, NIN, ws + WS_WIN + (size_t)l * NZ * DM + (size_t)(32 * nb) * DM + 64 * kb, DM, scr, F.lane); return; }
    r -= I_IN;
    if (r < I_OUT) { const int kb = r / (DM / 32), nb = r % (DM / 32);
        tr_item(karg(15) + (size_t)l * DM * DM + (size_t)(64 * kb) * DM + 32 * nb, DM, (bf16*)(ws + WS_WOUT) + (size_t)l * DM * DM + (size_t)(32 * nb) * DM + 64 * kb, DM, scr, F.lane); return; }
    r -= I_OUT;
    if (r < NEXP * 2 * I_GU) { const int e = r / (2 * I_GU); r -= e * 2 * I_GU; const int up = r >= I_GU; if (up) r -= I_GU; const int kb = r / (DEX / 32), nb = r % (DEX / 32), n0 = 32 * nb;
        const float* src = (up ? karg(19) : karg(18)) + ((size_t)l * NEXP + e) * DM * DEX + (size_t)(64 * kb) * DEX + n0;
        const int drow = (n0 >> 7) * 256 + (up ? 128 : 0) + (n0 & 127);
        tr_item8(src, DEX, ws + WS_WGU + ((size_t)l * NEXP + e) * DM * DM + (size_t)drow * DM + 64 * kb, DM, scr, F.lane); return; }
    r -= NEXP * 2 * I_GU;
    { const int e = r / I_D; r -= e * I_D; const int kb = r / (DM / 32), nb = r % (DM / 32);
      tr_item8(karg(20) + ((size_t)l * NEXP + e) * DEX * DM + (size_t)(64 * kb) * DM + 32 * nb, DM, ws + WS_WD + ((size_t)l * NEXP + e) * DM * DEX + (size_t)(32 * nb) * DEX + 64 * kb, DEX, scr, F.lane); }
}
__device__ __forceinline__ void bg_item(const Frame& F, unsigned char* ws, int t) {
    LAS float* scr = (LAS float*)(F.lds + 16384 + F.wave * 9216);
    if (t < BGI_SMALL) { const int r = t * 8 + F.wave, mat = r >> 3, q = r & 7, kb = q >> 2, nb = q & 3;
        tr_item(karg(10) + (size_t)mat * 128 * 128 + (size_t)(64 * kb) * 128 + 32 * nb, 128, (bf16*)(ws + WS_BWT) + (size_t)mat * 128 * 128 + (size_t)(32 * nb) * 128 + 64 * kb, 128, scr, F.lane); return; }
    t -= BGI_SMALL;
    if (t < BGI_IN) { conv_wave_item(F, ws, t * 8 + F.wave, 0, scr); return; }
    t -= BGI_IN;
    if (t < BGI_GV0) { gemv_item(F, ws, GV_FIRST * 4 + t); return; }
    t -= BGI_GV0;
    if (t < BGI_OUT + BGI_GU + BGI_D) { conv_wave_item(F, ws, I_IN + t * 8 + F.wave, 0, scr); return; }
    t -= BGI_OUT + BGI_GU + BGI_D;
    if (t < BGI_GV1) { gemv_item(F, ws, 512 + t); return; }
    t -= BGI_GV1;
    conv_wave_item(F, ws, t * 8 + F.wave, 1, scr);
}
__device__ __forceinline__ void bg_fill(const Frame& F0, int seam, int need) {
    unsigned char* const ws = opq(F0.ws); Frame F = F0; F.tid = opq_tid(F0.wave); F.lane = F.tid & 63; F.lds = opq(F0.lds);
    LAS unsigned* slot = (LAS unsigned*)(F.lds + AUX_OFF + 24576);
    gu32* const ctl_ = opq(F0.ctl); gu32* ticket = ctl_ + CW_BGT; gu32* arr = ctl_ + CW_ARR + 64 * seam;
    unsigned tn = 0xffffffffu; bool pre = false;
    if (F.tid == 0 && slot[1] == 0u) { (void)__hip_atomic_fetch_add(arr, 1u, RLX_AGENT); const unsigned cur = __hip_atomic_load(ticket, RLX_AGENT);
        if (cur >= (unsigned)BG_C7) slot[1] = 1u;
        else if (cur < (unsigned)need || __hip_atomic_load(arr, RLX_AGENT) < (unsigned)F.G) tn = __hip_atomic_fetch_add(ticket, 1u, RLX_AGENT); }
    for (;;) {
        if (F.tid == 0) slot[0] = tn;
        __syncthreads();
        const unsigned t = __builtin_amdgcn_readfirstlane(slot[0]);
        __syncthreads();
        if (t >= (unsigned)BG_C7) { if (F.tid == 0 && t != 0xffffffffu) slot[1] = 1u; break; }
        if (F.tid == 0) { tn = 0xffffffffu; pre = (t + 2u < (unsigned)need);
            if (pre) tn = __hip_atomic_fetch_add(ticket, 1u, RLX_AGENT); }
        bg_item(F, ws, (int)t);
        if (F.tid == 0 && !pre) { if (t + 1u < (unsigned)need || __hip_atomic_load(arr, RLX_AGENT) < (unsigned)F.G) tn = __hip_atomic_fetch_add(ticket, 1u, RLX_AGENT); }
    }
}
__device__ __forceinline__ void p0_prologue(const Frame& F0) {
    unsigned char* const ws = opq(F0.ws); Frame F = F0; F.tid = opq_tid(F0.wave); F.lane = F.tid & 63; F.lds = opq(F0.lds);
    for (int w = F.vcu; w < GV_FIRST * 4; w += F.G) gemv_item(F, ws, w);
    const float* const a_ws_ = karg(7);
    for (int i = (F.vcu * NTHR + F.tid) * 2; i < NLAYER * 4 * 128 * 128; i += F.G * NTHR * 2) {
        const int t = (i >> 7) & 127, s = i & 127;
        const f32x2 w = *(const GAS f32x2*)(a_ws_ + i);
        const bool keep = (s >> 6) <= (t >> 6);
        *(GAS unsigned*)((bf16*)(ws + WS_WM) + i) = keep ? cvt_pk_bf16(w.x, w.y) : 0u;
    }
}

template <int MODE>
__device__ __forceinline__ void phase_norm1(const Frame& F0, int l, const float* xin, float* xout, int lprev) {
    unsigned char* const ws = opq(F0.ws); Frame F = F0; F.tid = opq_tid(F0.wave); F.lane = F.tid & 63; F.lds = opq(F0.lds);
    LAS float* wfT = (LAS float*)F.lds;
    LAS float* gaL = (LAS float*)(F.lds + 65536);
    LAS float* gbL = (LAS float*)(F.lds + 73728);
    LAS float* g2L = (LAS float*)(F.lds + 81920);
    LAS float* lf = (LAS float*)(F.lds + 90112);
    LAS int* hb = (LAS int*)(F.lds + 91136);
    const float* const b_ada_ = karg(3); const float* const c_bf_ = karg(14);
    if (MODE != 2) {
        const float* const w_in_ = karg(6); const float* const g_mix_ = karg(4);
        for (int i = F.tid; i < DM * 2; i += NTHR) { const int d = i >> 1, half = i & 1;
            const f32x4 w = *(const GAS f32x4*)(w_in_ + (size_t)l * DM * NIN + (size_t)d * NIN + NZ + half * 4);
            wfT[(half * 4 + 0) * DM + d] = w.x; wfT[(half * 4 + 1) * DM + d] = w.y; wfT[(half * 4 + 2) * DM + d] = w.z; wfT[(half * 4 + 3) * DM + d] = w.w; }
        for (int d = F.tid; d < DM; d += NTHR) { gaL[d] = *(const GAS float*)(g_mix_ + (size_t)l * DM + d) * (1.f + mod_at(ws, b_ada_, l, DM + d)); gbL[d] = mod_at(ws, b_ada_, l, d); }
    }
    if (MODE != 0) {
        for (int d = F.tid; d < DM; d += NTHR) g2L[d] = mod_at(ws, b_ada_, lprev, 5 * DM + d);
        if (F.tid == 0) { int a = 0; for (int e = 0; e < NEXP; ++e) { hb[e] = a; a += ((int)__hip_atomic_load(F.ctl + CW_CNT + 64 * lprev + e, RLX_AGENT) + 255) & ~255; } }
    }
    __syncthreads();
    const bf16* YB = (const bf16*)(ws + WS_YB);
    f32x4 vA[8], vB[8]; u32x2 yA0[8], yA1[8], yB0[8], yB1[8];
#define N1_LOAD(V, Y0, Y1, rr) do { const int t_ = c * 32 + F.wave * 4 + (rr);                                                                 \
        _Pragma("unroll") for (int j = 0; j < 8; ++j) V[j] = *(const GAS f32x4*)(xin + (size_t)t_ * DM + 256 * j + 4 * F.lane);                   \
        if (MODE != 0) { const int r0_ = __builtin_amdgcn_readlane(rowA, (rr)), r1_ = __builtin_amdgcn_readlane(rowB, (rr));                      \
            _Pragma("unroll") for (int j = 0; j < 8; ++j) { const int d = 256 * j + 4 * F.lane;                                                    \
                Y0[j] = *(const GAS u32x2*)(YB + (size_t)r0_ * DM + d); Y1[j] = *(const GAS u32x2*)(YB + (size_t)r1_ * DM + d); } } } while (0)
#define N1_PROC(V, Y0, Y1, rr) do { const int rl = F.wave * 4 + (rr), t = c * 32 + rl;                                                          \
        if (MODE != 0) { const float w0 = __builtin_bit_cast(float, __builtin_amdgcn_readlane(__builtin_bit_cast(int, gwA), (rr))), w1 = __builtin_bit_cast(float, __builtin_amdgcn_readlane(__builtin_bit_cast(int, gwB), (rr))); \
            _Pragma("unroll") for (int j = 0; j < 8; ++j) { const int d = 256 * j + 4 * F.lane;                                                    \
                const f32x4 g2 = *(const LAS f32x4*)(g2L + d); const u32x2 y0 = Y0[j], y1 = Y1[j];                                                 \
                f32x4 y; y.x = w0 * bf_lo(y0.x) + w1 * bf_lo(y1.x); y.y = w0 * bf_hi(y0.x) + w1 * bf_hi(y1.x); y.z = w0 * bf_lo(y0.y) + w1 * bf_lo(y1.y); y.w = w0 * bf_hi(y0.y) + w1 * bf_hi(y1.y); \
                V[j] = V[j] + g2 * y;                                                                                                               \
                *(GAS f32x4*)(xout + (size_t)t * DM + d) = V[j]; } }                                                                               \
        if (MODE != 2) {                                                                                                                           \
            float ss = 0.f;                                                                                                                        \
            _Pragma("unroll") for (int j = 0; j < 8; ++j) ss += (V[j].x * V[j].x + V[j].y * V[j].y) + (V[j].z * V[j].z + V[j].w * V[j].w);         \
            const float rs = rsqrtf(wave_sum(ss) * (1.f / DM) + EPSN);                                                                             \
            float fz[8] = {0.f, 0.f, 0.f, 0.f, 0.f, 0.f, 0.f, 0.f};                                                                                \
            unsigned char* hrow = ws + WS_H + (size_t)t * DM;                                   \
            _Pragma("unroll") for (int j = 0; j < 8; ++j) { const int d = 256 * j + 4 * F.lane;                                                    \
                const f32x4 h = V[j] * rs * *(const LAS f32x4*)(gaL + d) + *(const LAS f32x4*)(gbL + d);                                           \
                *(GAS unsigned*)(hrow + d) = cvt_pk4_fp8(h.x * H8_SCALE, h.y * H8_SCALE, h.z * H8_SCALE, h.w * H8_SCALE);                          \
                _Pragma("unroll") for (int q = 0; q < 8; ++q) { const f32x4 w = *(const LAS f32x4*)(wfT + q * DM + d); fz[q] += (h.x * w.x + h.y * w.y) + (h.z * w.z + h.w * w.w); } } \
            _Pragma("unroll") for (int q = 0; q < 8; ++q) fz[q] = wave_sum(fz[q]);                                                                 \
            if (F.lane < 8) { float z = fz[0];                                                                                                     \
                _Pragma("unroll") for (int q = 1; q < 8; ++q) z = (F.lane == q) ? fz[q] : z;                                                       \
                z += *(const GAS float*)(c_bf_ + l * 8 + F.lane);                                                                                  \
                lf[rl * 8 + F.lane] = fminf(z, 0.f) - 0.6931471805599453f * __builtin_amdgcn_logf(1.f + __builtin_amdgcn_exp2f(-LOG2E * fabsf(z))); } } } while (0)
    for (int c = F.vcu; c < SEQ / 32; c += F.G) {
        int rowA = 0, rowB = 0; float gwA = 0.f, gwB = 0.f;
        if (MODE != 0) { const int t_ = c * 32 + F.wave * 4 + (F.lane & 3);
            const int* te = (const int*)(ws + WS_TOKE) + 2 * t_; const int* tp = (const int*)(ws + WS_TOKP) + 2 * t_; const float* tw = (const float*)(ws + WS_TOKW) + 2 * t_;
            rowA = hb[*(const GAS int*)te] + *(const GAS int*)tp; rowB = hb[*(const GAS int*)(te + 1)] + *(const GAS int*)(tp + 1); gwA = *(const GAS float*)tw; gwB = *(const GAS float*)(tw + 1); }
        N1_LOAD(vA, yA0, yA1, 0); N1_LOAD(vB, yB0, yB1, 1);
        N1_PROC(vA, yA0, yA1, 0); N1_LOAD(vA, yA0, yA1, 2);
        N1_PROC(vB, yB0, yB1, 1); N1_LOAD(vB, yB0, yB1, 3);
        N1_PROC(vA, yA0, yA1, 2); N1_PROC(vB, yB0, yB1, 3);
        if (MODE != 2) {
            __syncthreads();
            if (F.tid < 8) { float a = 0.f; float* floc = (float*)(ws + WS_FLOC);
                for (int r = 0; r < 32; ++r) { a += lf[r * 8 + F.tid]; *(GAS float*)(floc + (size_t)(c * 32 + r) * 8 + F.tid) = a; }
                *(GAS float*)((float*)(ws + WS_TOT) + c * 8 + F.tid) = a; }
            __syncthreads();
        }
    }
#undef N1_LOAD
#undef N1_PROC
}

__device__ __forceinline__ void phase_prep(const Frame& F0, int l) {
    unsigned char* const ws = opq(F0.ws); Frame F = F0; F.tid = opq_tid(F0.wave); F.lane = F.tid & 63; F.lds = opq(F0.lds);
    LAS float* pre = (LAS float*)F.lds;
    {
        const float* tot = (const float*)(ws + WS_TOT);
        const int h = F.wave; double v0 = *(const GAS float*)(tot + (4 * F.lane + 0) * 8 + h), v1 = *(const GAS float*)(tot + (4 * F.lane + 1) * 8 + h), v2 = *(const GAS float*)(tot + (4 * F.lane + 2) * 8 + h), v3 = *(const GAS float*)(tot + (4 * F.lane + 3) * 8 + h);
        const double s = v0 + v1 + v2 + v3;
        LAS float* part = (LAS float*)(F.lds + 16384) + h * 64;
        part[F.lane] = (float)s;
        LDS_WAIT();
        double ex = 0.0;
        for (int i = 0; i < 64; ++i) { const float pv = part[i]; ex += (i < F.lane) ? (double)pv : 0.0; }
        pre[h * 256 + 4 * F.lane + 0] = (float)ex; pre[h * 256 + 4 * F.lane + 1] = (float)(ex + v0); pre[h * 256 + 4 * F.lane + 2] = (float)(ex + v0 + v1); pre[h * 256 + 4 * F.lane + 3] = (float)(ex + v0 + v1 + v2);
    }
    __syncthreads();
    const bf16* Z = (const bf16*)(ws + WS_Z);
    float qg[16], kg[16], vg[8]; const float* const c_qg_ = karg(12); const float* const c_kg_ = karg(13); const float* const a_vg_ = karg(9);
#pragma unroll
    for (int i = 0; i < 16; ++i) { qg[i] = *(const GAS float*)(c_qg_ + l * 128 + (F.lane & 7) * 16 + i); kg[i] = *(const GAS float*)(c_kg_ + l * 128 + (F.lane & 7) * 16 + i); }
#pragma unroll
    for (int i = 0; i < 8; ++i) vg[i] = *(const GAS float*)(a_vg_ + l * 512 + F.lane * 8 + i);
    const int gw = F.vcu * NWAVES + F.wave, NGW = F.G * NWAVES;
    for (int t = gw; t < SEQ; t += NGW) {
        const bf16* zr = Z + (size_t)t * NZ;
#pragma unroll
        for (int which = 0; which < 2; ++which) {
            const u32x4 a = *(const GAS u32x4*)(zr + 1536 + which * 1024 + 16 * F.lane), b = *(const GAS u32x4*)(zr + 1536 + which * 1024 + 16 * F.lane + 8);
            float f[16]; f[0] = bf_lo(a.x); f[1] = bf_hi(a.x); f[2] = bf_lo(a.y); f[3] = bf_hi(a.y); f[4] = bf_lo(a.z); f[5] = bf_hi(a.z); f[6] = bf_lo(a.w); f[7] = bf_hi(a.w);
            f[8] = bf_lo(b.x); f[9] = bf_hi(b.x); f[10] = bf_lo(b.y); f[11] = bf_hi(b.y); f[12] = bf_lo(b.z); f[13] = bf_hi(b.z); f[14] = bf_lo(b.w); f[15] = bf_hi(b.w);
            float ss = 0.f;
#pragma unroll
            for (int i = 0; i < 16; ++i) ss += f[i] * f[i];
            ss += xor_f<1>(ss); ss += xor_f<2>(ss); ss += xor_f<4>(ss);
            const float rs = rsqrtf(ss * (1.f / 128.f) + EPSN);
            u32x4 o0, o1;
#define QK_G(i) ((which ? kg[i] : qg[i]) * rs * f[i])
            o0.x = cvt_pk_bf16(QK_G(0), QK_G(1)); o0.y = cvt_pk_bf16(QK_G(2), QK_G(3)); o0.z = cvt_pk_bf16(QK_G(4), QK_G(5)); o0.w = cvt_pk_bf16(QK_G(6), QK_G(7));
            o1.x = cvt_pk_bf16(QK_G(8), QK_G(9)); o1.y = cvt_pk_bf16(QK_G(10), QK_G(11)); o1.z = cvt_pk_bf16(QK_G(12), QK_G(13)); o1.w = cvt_pk_bf16(QK_G(14), QK_G(15));
#undef QK_G
            bf16* dst = (bf16*)(ws + (which ? WS_KN : WS_QN)) + ((size_t)(F.lane >> 3) * SEQ + t) * 128 + (F.lane & 7) * 16;
            *(GAS u32x4*)dst = o0; *(GAS u32x4*)(dst + 8) = o1;
        }
        {
            const u32x4 a = *(const GAS u32x4*)(zr + 512 + 8 * F.lane);
            float f[8]; f[0] = bf_lo(a.x); f[1] = bf_hi(a.x); f[2] = bf_lo(a.y); f[3] = bf_hi(a.y); f[4] = bf_lo(a.z); f[5] = bf_hi(a.z); f[6] = bf_lo(a.w); f[7] = bf_hi(a.w);
            float ss = 0.f;
#pragma unroll
            for (int i = 0; i < 8; ++i) ss += f[i] * f[i];
            ss += xor_f<1>(ss); ss += xor_f<2>(ss); ss += xor_f<4>(ss); ss += xor_f<8>(ss);
            const float rs = rsqrtf(ss * (1.f / 128.f) + EPSN);
            u32x4 o; o.x = cvt_pk_bf16(f[0] * rs * vg[0], f[1] * rs * vg[1]); o.y = cvt_pk_bf16(f[2] * rs * vg[2], f[3] * rs * vg[3]); o.z = cvt_pk_bf16(f[4] * rs * vg[4], f[5] * rs * vg[5]); o.w = cvt_pk_bf16(f[6] * rs * vg[6], f[7] * rs * vg[7]);
            *(GAS u32x4*)((bf16*)(ws + WS_VN) + (size_t)t * 512 + 8 * F.lane) = o;
        }
        {
            const int w = 2 << (F.lane >> 4);
            const u32x4 a = *(const GAS u32x4*)(zr + 1024 + 8 * F.lane);
            float p[8]; p[0] = bf_lo(a.x); p[1] = bf_hi(a.x); p[2] = bf_lo(a.y); p[3] = bf_hi(a.y); p[4] = bf_lo(a.z); p[5] = bf_hi(a.z); p[6] = bf_lo(a.w); p[7] = bf_hi(a.w);
            float s[8];
#pragma unroll
            for (int i = 0; i < 8; ++i) s[i] = p[i];
            for (int j = 1; j < 16; ++j) { if (j < w && t - j >= 0) { const u32x4 b = *(const GAS u32x4*)(zr - (size_t)j * NZ + 1024 + 8 * F.lane);
                s[0] += bf_lo(b.x); s[1] += bf_hi(b.x); s[2] += bf_lo(b.y); s[3] += bf_hi(b.y); s[4] += bf_lo(b.z); s[5] += bf_hi(b.z); s[6] += bf_lo(b.w); s[7] += bf_hi(b.w); } }
            const float ic = 1.f / (float)((t + 1 < w) ? (t + 1) : w);
            u32x4 o; o.x = cvt_pk_bf16(s[0] * ic - p[0], s[1] * ic - p[1]); o.y = cvt_pk_bf16(s[2] * ic - p[2], s[3] * ic - p[3]); o.z = cvt_pk_bf16(s[4] * ic - p[4], s[5] * ic - p[5]); o.w = cvt_pk_bf16(s[6] * ic - p[6], s[7] * ic - p[7]);
            *(GAS u32x4*)((bf16*)(ws + WS_DP) + (size_t)t * 512 + 8 * F.lane) = o;
        }
        if (F.lane < 8) *(GAS float*)((float*)(ws + WS_FKL) + (size_t)F.lane * SEQ + t) = (pre[F.lane * 256 + (t >> 5)] + *(const GAS float*)((const float*)(ws + WS_FLOC) + (size_t)t * 8 + F.lane)) * -11.313708498984761f;
    }
}

__device__ __forceinline__ void phase_small_item(const Frame& F0, int l, int item) {
    unsigned char* const ws = opq(F0.ws); Frame F = F0; F.tid = opq_tid(F0.wave); F.lane = F.tid & 63; F.lds = opq(F0.lds);
    const int fr = F.lane & 15, fq = F.lane >> 4, w = F.wave;
    const bf16* Z = (const bf16*)(ws + WS_Z); bf16* YC = (bf16*)(ws + WS_YCAT);
    f32x4 acc[8];
#pragma unroll
    for (int m = 0; m < 8; ++m) acc[m] = (f32x4){0.f, 0.f, 0.f, 0.f};
    const float* a_bs_ = opq(karg(8)); const float* b_scale_ = opq(karg(11));
    if (item < 256) {
        const int blk = item >> 2, h = item & 3;
        const bf16* VN = (const bf16*)(ws + WS_VN) + (size_t)(blk * 128) * 512 + h * 128 + 16 * w + fr;
        const bf16* WM = (const bf16*)(ws + WS_WM) + ((size_t)(l * 4 + h) * 128) * 128;
        bf16x8 yb[4];
#pragma unroll
        for (int ks = 0; ks < 4; ++ks)
#pragma unroll
            for (int j = 0; j < 8; ++j) yb[ks][j] = (short)*(const GAS bf16*)(VN + (size_t)(ks * 32 + 8 * fq + j) * 512);
#pragma unroll
        for (int m = 0; m < 8; ++m)
#pragma unroll
            for (int ks = 0; ks < 4; ++ks) { const bf16x8 xa = *(const GAS bf16x8*)(WM + (size_t)(16 * m + fr) * 128 + ks * 32 + 8 * fq);
                acc[m] = __builtin_amdgcn_mfma_f32_16x16x32_bf16(yb[ks], xa, acc[m], 0, 0, 0); }
#pragma unroll
        for (int m = 0; m < 8; ++m) { const int tl = 16 * m + fr, t = blk * 128 + tl, col = h * 128 + 16 * w + 4 * fq;
            const float bsv = *(const GAS float*)(a_bs_ + l * 512 + h * 128 + tl);
            const u32x2 u = *(const GAS u32x2*)(Z + (size_t)t * NZ + col);
            u32x2 o; o.x = cvt_pk_bf16(bf_lo(u.x) * (acc[m][0] + bsv), bf_hi(u.x) * (acc[m][1] + bsv)); o.y = cvt_pk_bf16(bf_lo(u.y) * (acc[m][2] + bsv), bf_hi(u.y) * (acc[m][3] + bsv));
            *(GAS u32x2*)(YC + (size_t)t * DM + col) = o; }
    } else {
        const int rb = (item - 256) >> 2, g = (item - 256) & 3;
        const bf16* DP = (const bf16*)(ws + WS_DP) + (size_t)(rb * 128) * 512 + g * 128;
        const bf16* BWT = (const bf16*)(ws + WS_BWT) + ((size_t)(l * 4 + g) * 128) * 128;
        bf16x8 yb[4];
#pragma unroll
        for (int ks = 0; ks < 4; ++ks) yb[ks] = *(const GAS bf16x8*)(BWT + (size_t)(16 * w + fr) * 128 + ks * 32 + 8 * fq);
#pragma unroll
        for (int m = 0; m < 8; ++m)
#pragma unroll
            for (int ks = 0; ks < 4; ++ks) { const bf16x8 xa = *(const GAS bf16x8*)(DP + (size_t)(16 * m + fr) * 512 + ks * 32 + 8 * fq);
                acc[m] = __builtin_amdgcn_mfma_f32_16x16x32_bf16(yb[ks], xa, acc[m], 0, 0, 0); }
        const f32x4 bsc = *(const GAS f32x4*)(b_scale_ + l * 512 + g * 128 + 16 * w + 4 * fq);
#pragma unroll
        for (int m = 0; m < 8; ++m) { const int t = rb * 128 + 16 * m + fr, col = 512 + g * 128 + 16 * w + 4 * fq;
            u32x2 o; o.x = cvt_pk_bf16(acc[m][0] * bsc.x, acc[m][1] * bsc.y); o.y = cvt_pk_bf16(acc[m][2] * bsc.z, acc[m][3] * bsc.w);
            *(GAS u32x2*)(YC + (size_t)t * DM + col) = o; }
    }
}

__device__ __forceinline__ void phase_norm2_route(const Frame& F0, int l) {
    unsigned char* const ws = opq(F0.ws); Frame F = F0; F.tid = opq_tid(F0.wave); F.lane = F.tid & 63; F.lds = opq(F0.lds);
    LAS float* wrT = (LAS float*)F.lds;
    LAS float* gaL = (LAS float*)(F.lds + AUX_OFF);
    LAS float* gbL = (LAS float*)(F.lds + AUX_OFF + 8192);
    LAS int* lcnt = (LAS int*)(F.lds + AUX_OFF + 16384);
    const float* const w_router_ = karg(16); const float* const g_ffn_ = karg(5); const float* const b_ada_ = karg(3); const float* const b_router_ = karg(17);
    for (int i = F.tid; i < DM * 4; i += NTHR) { const int d = i >> 2, q = i & 3;
        const f32x4 w = *(const GAS f32x4*)(w_router_ + (size_t)d * 16 + q * 4);
        wrT[(q * 4 + 0) * DM + d] = w.x; wrT[(q * 4 + 1) * DM + d] = w.y; wrT[(q * 4 + 2) * DM + d] = w.z; wrT[(q * 4 + 3) * DM + d] = w.w; }
    for (int d = F.tid; d < DM; d += NTHR) { gaL[d] = *(const GAS float*)(g_ffn_ + (size_t)l * DM + d) * (1.f + mod_at(ws, b_ada_, l, 4 * DM + d)); gbL[d] = mod_at(ws, b_ada_, l, 3 * DM + d); }
    const float* X1 = (const float*)(ws + WS_X1);
    float brt[16];
#pragma unroll
    for (int e = 0; e < 16; ++e) brt[e] = *(const GAS float*)(b_router_ + e);
    for (int c = F.vcu; c < SEQ / 32; c += F.G) {
        if (F.tid < 32) lcnt[F.tid] = 0;
        __syncthreads();
        int my_e0 = 0, my_e1 = 0, my_r0 = 0, my_r1 = 0; float my_w0 = 0.f, my_w1 = 0.f;
        f32x4 vA[8], vB[8];
#define N2_LOAD(V, rr) do { const int t_ = c * 32 + F.wave * 4 + (rr); _Pragma("unroll") for (int j = 0; j < 8; ++j) V[j] = *(const GAS f32x4*)(X1 + (size_t)t_ * DM + 256 * j + 4 * F.lane); } while (0)
#define N2_PROC(V, rr) do { const int t = c * 32 + F.wave * 4 + (rr);                                                                           \
            float ss = 0.f;                                                                                                                        \
            _Pragma("unroll") for (int j = 0; j < 8; ++j) ss += (V[j].x * V[j].x + V[j].y * V[j].y) + (V[j].z * V[j].z + V[j].w * V[j].w);         \
            const float rs = rsqrtf(wave_sum(ss) * (1.f / DM) + EPSN);                                                                             \
            float lg[16];                                                                                                                          \
            _Pragma("unroll") for (int e = 0; e < 16; ++e) lg[e] = 0.f;                                                                            \
            unsigned char* hrow = ws + WS_H + (size_t)t * DM;                          \
            _Pragma("unroll") for (int j = 0; j < 8; ++j) { const int d = 256 * j + 4 * F.lane;                                                    \
                const f32x4 h = V[j] * rs * *(const LAS f32x4*)(gaL + d) + *(const LAS f32x4*)(gbL + d);                                           \
                *(GAS unsigned*)(hrow + d) = cvt_pk4_fp8(h.x * H8_SCALE, h.y * H8_SCALE, h.z * H8_SCALE, h.w * H8_SCALE);                          \
                _Pragma("unroll") for (int e = 0; e < 16; ++e) { const f32x4 w = *(const LAS f32x4*)(wrT + e * DM + d); lg[e] += (h.x * w.x + h.y * w.y) + (h.z * w.z + h.w * w.w); } } \
            _Pragma("unroll") for (int e = 0; e < 16; ++e) lg[e] = wave_sum(lg[e]);                                                                \
            float sc[16], sel[16];                                                                                                                 \
            _Pragma("unroll") for (int e = 0; e < 16; ++e) { sc[e] = __builtin_amdgcn_rcpf(1.f + __builtin_amdgcn_exp2f(-LOG2E * lg[e])); sel[e] = sc[e] + brt[e]; }                      \
            int bg = 0; float bgs = -INFINITY;                                                                                                     \
            _Pragma("unroll") for (int g = 0; g < 4; ++g) { float a = -INFINITY, b = -INFINITY;                                                    \
                _Pragma("unroll") for (int i = 0; i < 4; ++i) { const float x = sel[g * 4 + i]; if (x > a) { b = a; a = x; } else if (x > b) b = x; } \
                if (a + b > bgs) { bgs = a + b; bg = g; } }                                                                                        \
            int e0 = 0, e1 = 0; float a = -INFINITY, b = -INFINITY, s0 = 0.f, s1 = 0.f;                                                            \
            _Pragma("unroll") for (int g = 0; g < 4; ++g)                                                                                          \
                _Pragma("unroll") for (int i = 0; i < 4; ++i) { const int e = g * 4 + i; const float x = sel[e];                                   \
                    if (g == bg) { if (x > a) { b = a; e1 = e0; s1 = s0; a = x; e0 = e; s0 = sc[e]; } else if (x > b) { b = x; e1 = e; s1 = sc[e]; } } } \
            const float inv = 1.f / (s0 + s1);                                                                                                     \
            if (F.lane == (rr)) { my_e0 = e0; my_e1 = e1; my_w0 = s0 * inv; my_w1 = s1 * inv; } } while (0)
        N2_LOAD(vA, 0);
#pragma unroll 1
        for (int rp = 0; rp < 2; ++rp) {
            N2_LOAD(vB, 2 * rp + 1);
            N2_PROC(vA, 2 * rp);
            if (rp == 0) N2_LOAD(vA, 2);
            N2_PROC(vB, 2 * rp + 1);
        }
        if (F.lane < 4) { my_r0 = __hip_atomic_fetch_add(&lcnt[my_e0], 1, __ATOMIC_RELAXED, __HIP_MEMORY_SCOPE_WORKGROUP); my_r1 = __hip_atomic_fetch_add(&lcnt[my_e1], 1, __ATOMIC_RELAXED, __HIP_MEMORY_SCOPE_WORKGROUP); }
        __syncthreads();
        if (F.tid < 16) lcnt[16 + F.tid] = (int)__hip_atomic_fetch_add(F.ctl + CW_CNT + 64 * l + F.tid, (unsigned)lcnt[F.tid], RLX_AGENT);
        __syncthreads();
        if (F.lane < 4) { const int t = c * 32 + F.wave * 4 + F.lane;
            const int p0 = lcnt[16 + my_e0] + my_r0, p1 = lcnt[16 + my_e1] + my_r1;
            int* list = (int*)(ws + WS_LIST);
            *(GAS int*)(list + my_e0 * SEQ + p0) = t; *(GAS int*)(list + my_e1 * SEQ + p1) = t;
            *(GAS int*)((int*)(ws + WS_TOKE) + 2 * t) = my_e0; *(GAS int*)((int*)(ws + WS_TOKE) + 2 * t + 1) = my_e1;
            *(GAS int*)((int*)(ws + WS_TOKP) + 2 * t) = p0; *(GAS int*)((int*)(ws + WS_TOKP) + 2 * t + 1) = p1;
            *(GAS float*)((float*)(ws + WS_TOKW) + 2 * t) = my_w0; *(GAS float*)((float*)(ws + WS_TOKW) + 2 * t + 1) = my_w1; }
        __syncthreads();
    }
#undef N2_LOAD
#undef N2_PROC
}

struct MoeOrder {
    int G, c, total, K, nct; const char* Bt; size_t estride; const int* list; LAS int* tab;
    __device__ __forceinline__ bool next(int i, gm::Unit& u) const {
        const int L = i * G + c; if (L >= total) return false;
        const int q = L / nct, ct = L - q * nct;
        int e = 0;
#pragma unroll
        for (int k = 1; k < NEXP; ++k) e += (q >= tab[k]) ? 1 : 0;
        e = __builtin_amdgcn_readfirstlane(e);
        const int rt = q - __builtin_amdgcn_readfirstlane(tab[e]);
        u.e = e; u.rt = rt; u.arow = (__builtin_amdgcn_readfirstlane(tab[e]) + rt) * 256; u.orow = u.arow; u.ocol = ct * 256;
        u.Bp = Bt + (size_t)e * estride + (size_t)ct * 256 * K * 2; return true;
    }
    __device__ __forceinline__ int row_of(const gm::Unit& u, int r) const {
        const int p = u.rt * 256 + r, n = tab[32 + u.e], pc = p < n ? p : n - 1;
        const int v = *(const GAS int*)(list + u.e * SEQ + pc);
        return (p < n) ? v : 0;
    }
};
__device__ __forceinline__ void moe_table(const Frame& F, int l, LAS int* tab) {
    __syncthreads();
    if (F.tid == 0) { int a = 0;
        for (int e = 0; e < NEXP; ++e) { const int n = (int)__hip_atomic_load(F.ctl + CW_CNT + 64 * l + e, RLX_AGENT); tab[e] = a; tab[32 + e] = n; a += (n + 255) >> 8; }
        tab[16] = a; }
    __syncthreads();
}

constexpr int ATT_CH = 16;
struct MixTab { LAS int* jlo; LAS int* items; LAS int* nitems; LAS float* fend; LAS int* scan; };
__device__ __forceinline__ MixTab mix_tab_ptrs(LAS unsigned char* lds) {
    MixTab T; T.jlo = (LAS int*)(lds + 69632); T.items = (LAS int*)(lds + 69632 + 1024); T.nitems = (LAS int*)(lds + 69632 + 1024 + 8192); T.fend = (LAS float*)(lds + 69632 + 1024 + 8192 + 64);
    T.scan = (LAS int*)(lds + 69632 + 1024 + 8192 + 64 + 4096); return T;
}
__device__ __forceinline__ void mix_build_table(const Frame& F0, int l, const MixTab& T) {
    unsigned char* const ws = opq(F0.ws); const int tid = opq_tid(F0.wave);
    const float* FKL = (const float*)(ws + WS_FKL);
    for (int i = tid; i < 1024; i += NTHR) T.fend[i] = *(const GAS float*)(FKL + (size_t)(i >> 7) * SEQ + (i & 127) * 64 + 63);
    float gq = 0.f, gk = 0.f; const float* const c_qg_ = karg(12); const float* const c_kg_ = karg(13);
    { const int ln = tid & 63; gq = fmaxf(fabsf(*(const GAS float*)(c_qg_ + l * 128 + ln)), fabsf(*(const GAS float*)(c_qg_ + l * 128 + 64 + ln))); gk = fmaxf(fabsf(*(const GAS float*)(c_kg_ + l * 128 + ln)), fabsf(*(const GAS float*)(c_kg_ + l * 128 + 64 + ln)));
      gq = wave_max(gq); gk = wave_max(gk); }
    const float thr = (2.f * 1.01f * 11.313708498984761f * gq * gk + 30.f) * 11.313708498984761f;
    __syncthreads();
    int nfull = 0, nrem = 0, jl = 0, nt = 0;
    if (tid < 256) { const int h = tid >> 5, qb = tid & 31; const float f0 = *(const GAS float*)(FKL + (size_t)h * SEQ + qb * 256);
        for (int j = 0; j < 4 * qb; ++j) jl += (T.fend[h * 128 + j] - f0 <= -thr) ? 1 : 0;
        nt = 4 * (qb + 1) - jl; nfull = nt / ATT_CH; nrem = (nt % ATT_CH) ? 1 : 0; T.jlo[tid] = jl | ((nfull + nrem) << 8); }
    if (tid < 256) { T.scan[tid] = nfull; T.scan[256 + tid] = nrem; }
    __syncthreads();
    for (int o = 1; o < 256; o <<= 1) { int a = 0, b = 0; if (tid < 256 && tid >= o) { a = T.scan[tid - o]; b = T.scan[256 + tid - o]; } __syncthreads();
        if (tid < 256) { T.scan[tid] += a; T.scan[256 + tid] += b; } __syncthreads(); }
    if (tid < 256) { const int totf = T.scan[255], pf = T.scan[tid] - nfull, pr = totf + T.scan[256 + tid] - nrem, jb = 4 * ((tid & 31) + 1);
        for (int c = 0; c < nfull; ++c) T.items[pf + c] = tid | (c << 8) | ((jb - (c + 1) * ATT_CH) << 12) | (ATT_CH << 20);
        if (nrem) T.items[pr] = tid | (nfull << 8) | (jl << 12) | ((nt - nfull * ATT_CH) << 20);
        if (tid == 255) T.nitems[0] = totf + T.scan[511]; }
    __syncthreads();
}
__device__ __forceinline__ void phase_attn_combine(const Frame& F0, int l, const MixTab& T) {
    unsigned char* const ws = opq(F0.ws); const int tid = opq_tid(F0.wave);
    const bf16* PART = (const bf16*)(ws + WS_PART); const float* MLb = (const float*)(ws + WS_ML); bf16* YC = (bf16*)(ws + WS_YCAT);
    for (int b = F0.vcu; b < 256; b += F0.G) {
        const int nch = __builtin_amdgcn_readfirstlane(T.jlo[b]) >> 8; if (nch <= 1) continue;
        const int h = b >> 5, qb = b & 31, row = tid >> 1, half = tid & 1;
        float m[8], w[8], mx = -3.0e38f, ws_ = 0.f;
#pragma unroll
        for (int c = 0; c < 8; ++c) { if (c < nch) { const f32x2 v = *(const GAS f32x2*)(MLb + ((size_t)(b * 8 + c) * 256 + row) * 2); m[c] = v.x; w[c] = v.y; mx = fmaxf(mx, v.x); } else { m[c] = -3.0e38f; w[c] = 0.f; } }
#pragma unroll
        for (int c = 0; c < 8; ++c) { w[c] = (c < nch) ? w[c] * __builtin_amdgcn_exp2f((m[c] - mx) * at::C2) : 0.f; ws_ += w[c]; }
        const float inv = 1.f / ws_;
        float acc[64];
#pragma unroll
        for (int i = 0; i < 64; ++i) acc[i] = 0.f;
#pragma unroll
        for (int c = 0; c < 8; ++c) { if (c < nch) { const bf16* p = PART + ((size_t)(b * 8 + c) * 256 + row) * 128 + half * 64; const float wc = w[c] * inv;
#pragma unroll
            for (int q = 0; q < 8; ++q) { const u32x4 v = *(const GAS u32x4*)(p + q * 8);
                acc[q * 8 + 0] += wc * bf_lo(v.x); acc[q * 8 + 1] += wc * bf_hi(v.x); acc[q * 8 + 2] += wc * bf_lo(v.y); acc[q * 8 + 3] += wc * bf_hi(v.y);
                acc[q * 8 + 4] += wc * bf_lo(v.z); acc[q * 8 + 5] += wc * bf_hi(v.z); acc[q * 8 + 6] += wc * bf_lo(v.w); acc[q * 8 + 7] += wc * bf_hi(v.w); } } }
        bf16* o = YC + (size_t)(qb * 256 + row) * DM + 1024 + h * 128 + half * 64;
#pragma unroll
        for (int q = 0; q < 8; ++q) { u32x4 v; v.x = cvt_pk_bf16(acc[q * 8 + 0], acc[q * 8 + 1]); v.y = cvt_pk_bf16(acc[q * 8 + 2], acc[q * 8 + 3]); v.z = cvt_pk_bf16(acc[q * 8 + 4], acc[q * 8 + 5]); v.w = cvt_pk_bf16(acc[q * 8 + 6], acc[q * 8 + 7]);
            *(GAS u32x4*)(o + q * 8) = v; }
    }
}

struct MoeDynOrder {
    int total, K; const char* Bt; size_t estride; LAS int* tab; gu32* ticket; gu32* ready; gu32* tmo; LAS unsigned* slot;
    __device__ __forceinline__ bool next(int, gm::Unit& u) const {
        if (__builtin_amdgcn_readfirstlane(threadIdx.x >> 6) == 0) {
            unsigned T = 0u;
            if ((threadIdx.x & 63) == 0) T = __hip_atomic_fetch_add(ticket, 1u, RLX_AGENT);
            T = __builtin_amdgcn_readfirstlane(T);
            if (T < (unsigned)total) {
                gu32* w = ready + 16 * (T >> 3); unsigned sp = 0u;
                while ((unsigned)__builtin_amdgcn_readfirstlane(__hip_atomic_load(w, RLX_AGENT)) < 64u) {
                    __builtin_amdgcn_s_sleep(2);
                    if ((++sp & 255u) == 0u) { if (__hip_atomic_load(tmo, RLX_AGENT) != 0u) break; if (sp > (1u << 20)) { __hip_atomic_store(tmo, 1u, RLX_AGENT); break; } } }
                __builtin_amdgcn_fence(__ATOMIC_ACQUIRE, "agent");
                asm volatile("s_waitcnt vmcnt(0)" ::: "memory");
            }
            if ((threadIdx.x & 63) == 0) slot[0] = T;
        }
        asm volatile("s_waitcnt lgkmcnt(0)" ::: "memory"); __builtin_amdgcn_s_barrier(); asm volatile("" ::: "memory");
        const unsigned T = (unsigned)__builtin_amdgcn_readfirstlane((int)slot[0]);
        if (T >= (unsigned)total) return false;
        const int q = (int)(T >> 3), ct = (int)(T & 7);
        int e = 0;
#pragma unroll
        for (int k = 1; k < NEXP; ++k) e += (q >= tab[k]) ? 1 : 0;
        e = __builtin_amdgcn_readfirstlane(e);
        u.e = e; u.rt = q - __builtin_amdgcn_readfirstlane(tab[e]); u.arow = q * 256; u.orow = u.arow; u.ocol = ct * 256;
        u.Bp = Bt + (size_t)e * estride + (size_t)ct * 256 * K * 2; return true;
    }
    __device__ __forceinline__ int row_of(const gm::Unit&, int) const { return 0; }
};
struct EpiZ {
    static constexpr bool PERM = true;
    bf16* O;
    __device__ __forceinline__ void operator()(const f32x4 (&acc)[2][2][4][2], const gm::Unit& u, int wr, int wc, int fr, int fq) const {
        const int row0 = u.orow + wr * 64 + fr, col0 = u.ocol + wc * 32 + 8 * fq; const bool act = u.ocol < 1024;
#pragma unroll
        for (int ai = 0; ai < 2; ++ai)
#pragma unroll
            for (int m = 0; m < 4; ++m) { bf16* rowp = O + (size_t)(row0 + ai * 128 + m * 16) * NZ + col0;
#pragma unroll
                for (int bj = 0; bj < 2; ++bj) { f32x4 v0 = acc[ai][bj][m][0], v1 = acc[ai][bj][m][1];
                    if (act) {
#pragma unroll
                        for (int j = 0; j < 4; ++j) { v0[j] = gelu_t(v0[j]); v1[j] = gelu_t(v1[j]); } }
                    u32x4 w; w.x = cvt_pk_bf16(v0[0], v0[1]); w.y = cvt_pk_bf16(v0[2], v0[3]); w.z = cvt_pk_bf16(v1[0], v1[1]); w.w = cvt_pk_bf16(v1[2], v1[3]);
                    *(GAS u32x4*)(rowp + bj * 128) = w; } }
    }
};
struct EpiRes {
    static constexpr bool PERM = false;
    const float* xin; const LAS float* gate; float* out;
    __device__ __forceinline__ void operator()(const f32x4 (&acc)[2][2][4][2], const gm::Unit& u, int wr, int wc, int fr, int fq) const {
        const int row0 = u.orow + wr * 64 + fr, col0 = u.ocol + wc * 32 + 4 * fq;
        f32x4 gv[2][2];
#pragma unroll
        for (int bj = 0; bj < 2; ++bj)
#pragma unroll
            for (int n = 0; n < 2; ++n) gv[bj][n] = *(const LAS f32x4*)(gate + col0 + bj * 128 + n * 16);
#pragma unroll
        for (int ai = 0; ai < 2; ++ai)
#pragma unroll
            for (int m = 0; m < 4; ++m) { const size_t off = (size_t)(row0 + ai * 128 + m * 16) * DM + col0;
#pragma unroll
                for (int bj = 0; bj < 2; ++bj)
#pragma unroll
                    for (int n = 0; n < 2; ++n) { const f32x4 xv = *(const GAS f32x4*)(xin + off + bj * 128 + n * 16);
                        *(GAS f32x4*)(out + off + bj * 128 + n * 16) = xv + gv[bj][n] * acc[ai][bj][m][n]; } }
    }
};
struct EpiHid {
    static constexpr bool PERM = true;
    bf16* O;
    __device__ __forceinline__ void operator()(const f32x4 (&acc)[2][2][4][2], const gm::Unit& u, int wr, int wc, int fr, int fq) const {
        const int row0 = u.orow + wr * 64 + fr, col0 = (u.ocol >> 1) + wc * 32 + 8 * fq;
#pragma unroll
        for (int ai = 0; ai < 2; ++ai)
#pragma unroll
            for (int m = 0; m < 4; ++m) { bf16* rowp = O + (size_t)(row0 + ai * 128 + m * 16) * DEX + col0;
                f32x4 h0, h1;
#pragma unroll
                for (int j = 0; j < 4; ++j) { h0[j] = silu_f(acc[ai][0][m][0][j]) * acc[ai][1][m][0][j]; h1[j] = silu_f(acc[ai][0][m][1][j]) * acc[ai][1][m][1][j]; }
                u32x4 w; w.x = cvt_pk_bf16(h0[0], h0[1]); w.y = cvt_pk_bf16(h0[2], h0[3]); w.z = cvt_pk_bf16(h1[0], h1[1]); w.w = cvt_pk_bf16(h1[2], h1[3]);
                *(GAS u32x4*)rowp = w; }
    }
};
struct EpiHidPub {
    static constexpr bool PERM = true;
    unsigned char* O; gu32* ready;
    __device__ __forceinline__ void operator()(const f32x4 (&acc)[2][2][4][2], const gm::Unit& u, int wr, int wc, int fr, int fq) const {
        const __amdgpu_buffer_rsrc_t rs = __builtin_amdgcn_make_buffer_rsrc(O, (short)0, (int)(HIDROWS * DEX), 0x00020000);
        const int row0 = u.orow + wr * 64 + fr, col0 = (u.ocol >> 1) + wc * 32 + 8 * fq;
#pragma unroll
        for (int ai = 0; ai < 2; ++ai)
#pragma unroll
            for (int m = 0; m < 4; ++m) { const int off = (row0 + ai * 128 + m * 16) * DEX + col0;
                f32x4 h0, h1;
#pragma unroll
                for (int j = 0; j < 4; ++j) { h0[j] = HID8_SCALE * silu_f(acc[ai][0][m][0][j]) * acc[ai][1][m][0][j]; h1[j] = HID8_SCALE * silu_f(acc[ai][0][m][1][j]) * acc[ai][1][m][1][j]; }
                u32x2 w; w.x = cvt_pk4_fp8(h0[0], h0[1], h0[2], h0[3]); w.y = cvt_pk4_fp8(h1[0], h1[1], h1[2], h1[3]);
                __builtin_amdgcn_raw_buffer_store_b64(w, rs, off, 0, 16); }
        asm volatile("s_waitcnt vmcnt(0)" ::: "memory");
        if (fr == 0 && fq == 0) (void)__hip_atomic_fetch_add(ready + 16 * (u.orow >> 8), 1u, RLX_AGENT);
    }
};
struct EpiYB {
    static constexpr bool PERM = true;
    bf16* O;
    __device__ __forceinline__ void operator()(const f32x4 (&acc)[2][2][4][2], const gm::Unit& u, int wr, int wc, int fr, int fq) const {
        const int row0 = u.orow + wr * 64 + fr, col0 = u.ocol + wc * 32 + 8 * fq;
#pragma unroll
        for (int ai = 0; ai < 2; ++ai)
#pragma unroll
            for (int m = 0; m < 4; ++m) { bf16* rowp = O + (size_t)(row0 + ai * 128 + m * 16) * DM + col0;
#pragma unroll
                for (int bj = 0; bj < 2; ++bj) { const f32x4 v0 = acc[ai][bj][m][0], v1 = acc[ai][bj][m][1];
                    u32x4 w; w.x = cvt_pk_bf16(v0[0], v0[1]); w.y = cvt_pk_bf16(v0[2], v0[3]); w.z = cvt_pk_bf16(v1[0], v1[1]); w.w = cvt_pk_bf16(v1[2], v1[3]);
                    *(GAS u32x4*)(rowp + bj * 128) = w; } }
    }
};

#ifdef MK_SELFTEST
#include "selftest.h"
#endif
__device__ __forceinline__ int bg_need(int p) {
    if (p <= 1) return 0;
    if (p <= 5) return BG_C0;
    if (p <= 7) return BG_C1;
    if (p == 8) return BG_C3;
    if (p <= 10) return BG_C3B;
    if (p <= 14) return BG_C4;
    if (p <= 16) return BG_C5;
    return BG_C7;
}
__device__ __forceinline__ bool bg_seam(int k) { if (k == 0) return true; const int j = (k - 1) % 9; return j != 2 && j != 5 && j != 8; }
struct Args { const float* in[21]; float* out; unsigned char* ws; int ph_lo, ph_hi; };
constexpr int N_PHASES = 1 + 9 * NLAYER + 1;

#ifdef MK_ONLY
#define IN(k) (((k) == 0 ? 0 : (((k) - 1) % 9) + 1) == MK_ONLY && lo <= (k) && (k) < hi)
#else
#define IN(k) (lo <= (k) && (k) < hi)
#endif
#ifndef MK_REPEAT
#define MK_REPEAT -1
#endif
#define REPS(kind) ((MK_REPEAT == (kind)) ? 2 : 1)
#define SEAM(k) do { if (IN(k)) { if (bg_seam(k)) bg_fill(F, (k), bg_need((k) + 1)); if (IN((k) + 1)) xcd_barrier(bar); } } while (0)


template <int l> __device__ __forceinline__ void layer_body(const Frame& F, const XcdBarrier& bar, const int lo, const int hi) {
    constexpr int pb = 1 + 9 * l;

        for (int rep_ = 0; rep_ < REPS(1); ++rep_) if (IN(pb)) { if (rep_) xcd_barrier(bar); unsigned char* const wsl = opq(F.ws); LAS unsigned char* const ldl = opq(F.lds); if (l == 0) phase_norm1<0>(F, l, karg(0), nullptr, 0); else phase_norm1<1>(F, l, (const float*)(wsl + WS_X1), (float*)(wsl + WS_X2), l - 1); }
        SEAM(pb);
        for (int rep_ = 0; rep_ < REPS(2); ++rep_) if (IN(pb + 1)) { if (rep_) xcd_barrier(bar); unsigned char* const wsl = opq(F.ws); LAS unsigned char* const ldl = opq(F.lds); gm::RegOrder S; S.init(SEQ, NZ, DM / 2, wsl + WS_WIN + (size_t)l * NZ * DM, F.G, (int)blockIdx.x);
            EpiZ E{(bf16*)(wsl + WS_Z)};
            gm::gemm_phase<EpiZ, gm::RegOrder, false, true, true, SC_H8, SC_W8>(ldl, (const char*)(wsl + WS_H), DM, S, E, F.wave); }
        SEAM(pb + 1);
        for (int rep_ = 0; rep_ < REPS(3); ++rep_) if (IN(pb + 2)) { if (rep_) xcd_barrier(bar); unsigned char* const wsl = opq(F.ws); LAS unsigned char* const ldl = opq(F.lds); phase_prep(F, l); }
        SEAM(pb + 2);
        for (int rep_ = 0; rep_ < REPS(4); ++rep_) if (IN(pb + 3)) { if (rep_) xcd_barrier(bar); unsigned char* const wsl = opq(F.ws); LAS unsigned char* const ldl = opq(F.lds);
            const MixTab T = mix_tab_ptrs(ldl);
            mix_build_table(F, l, T);
            const int natt = __builtin_amdgcn_readfirstlane(T.nitems[0]), ntot = natt + 512;
            LAS int* qslot = T.nitems + 1;
            int it = F.vcu;
            while (it < ntot) {
                if (it >= natt) { phase_small_item(F, l, it - natt); }
                else {
                    const int rec = __builtin_amdgcn_readfirstlane(T.items[it]), b = rec & 255, c = (rec >> 8) & 15, ja = (rec >> 12) & 255, n = (rec >> 20) & 31, h = b >> 5, qb = b & 31;
                    const bool fin = (__builtin_amdgcn_readfirstlane(T.jlo[b]) >> 8) <= 1; unsigned char* const ws = opq(wsl);
                    at::BlockRef cur;
                    cur.Q = (const bf16*)(ws + WS_QN) + ((size_t)h * SEQ + qb * 256) * 128; cur.K = (const bf16*)(ws + WS_KN) + (size_t)h * SEQ * 128;
                    cur.V = (const bf16*)(ws + WS_Z) + 3584 + h * 128; cur.O = (bf16*)(ws + WS_YCAT) + (size_t)(qb * 256) * DM + 1024 + h * 128;
                    cur.FK = (const float*)(ws + WS_FKL) + (size_t)h * SEQ; cur.P0 = qb * 256;
                    at::attn_block(cur, ja, n, fin, (bf16*)(ws + WS_PART) + (size_t)(b * 8 + c) * 256 * 128, (float*)(ws + WS_ML) + (size_t)(b * 8 + c) * 256 * 2, (char*)ldl, ldl, F.wave);
                }
                if (opq_tid(F.wave) == 0) qslot[0] = F.G + (int)__hip_atomic_fetch_add(F.ctl + CW_Q + 64 * l + 32 * rep_, 1u, RLX_AGENT);
                __syncthreads();
                it = __builtin_amdgcn_readfirstlane(qslot[0]);
                __syncthreads();
            }
        }
        SEAM(pb + 3);
        for (int rep_ = 0; rep_ < REPS(5); ++rep_) if (IN(pb + 4)) { if (rep_) xcd_barrier(bar); unsigned char* const wsl = opq(F.ws); LAS unsigned char* const ldl = opq(F.lds); const MixTab T = mix_tab_ptrs(ldl); mix_build_table(F, l, T); phase_attn_combine(F, l, T); }
        SEAM(pb + 4);
        for (int rep_ = 0; rep_ < REPS(6); ++rep_) if (IN(pb + 5)) { if (rep_) xcd_barrier(bar); unsigned char* const wsl = opq(F.ws); LAS unsigned char* const ldl = opq(F.lds); gm::RegOrder S; S.init(SEQ, DM, DM, wsl + WS_WOUT + (size_t)l * DM * DM * 2, F.G, (int)blockIdx.x);
            LAS float* g1L = (LAS float*)(ldl + AUX_OFF);
            { const float* const b_ada_ = karg(3); for (int d = opq_tid(F.wave); d < DM; d += NTHR) g1L[d] = mod_at(wsl, b_ada_, l, 2 * DM + d); }
            __syncthreads();
            EpiRes E{(l == 0) ? karg(0) : (const float*)(wsl + WS_X2), g1L, (float*)(wsl + WS_X1)};
            gm::gemm_phase<EpiRes, gm::RegOrder, false, true>(ldl, (const char*)(wsl + WS_YCAT), DM, S, E, F.wave); }
        SEAM(pb + 5);
        for (int rep_ = 0; rep_ < REPS(7); ++rep_) if (IN(pb + 6)) { if (rep_) xcd_barrier(bar); unsigned char* const wsl = opq(F.ws); LAS unsigned char* const ldl = opq(F.lds); phase_norm2_route(F, l); }
        SEAM(pb + 6);
        for (int rep_ = 0; rep_ < REPS(8); ++rep_) if (IN(pb + 7)) { if (rep_) xcd_barrier(bar); unsigned char* const wsl = opq(F.ws); LAS unsigned char* const ldl = opq(F.lds); LAS int* tab = (LAS int*)(ldl + AUX_OFF + 20480); moe_table(F, l, tab);
            gu32* const rdy = F.ctl + CW_RDY + 4096 * l + 2048 * rep_;
            { MoeOrder S; S.G = F.G; S.c = F.vcu; S.total = 8 * tab[16]; S.K = DM / 2; S.nct = 8; S.Bt = (const char*)(wsl + WS_WGU) + (size_t)l * NEXP * DM * DM; S.estride = (size_t)DM * DM;
              S.list = (const int*)(wsl + WS_LIST); S.tab = tab;
              EpiHidPub E{wsl + (l ? WS_HID1 : WS_HID), rdy};
              gm::gemm_phase<EpiHidPub, MoeOrder, true, true, true, SC_H8, SC_W8>(ldl, (const char*)(wsl + WS_H), DM, S, E, F.wave); }
            { MoeDynOrder S; S.total = 8 * tab[16]; S.K = DEX / 2; S.Bt = (const char*)(wsl + WS_WD) + (size_t)l * NEXP * DM * DEX; S.estride = (size_t)DM * DEX; S.tab = tab;
              S.ticket = F.ctl + CW_MT + 64 * l + 32 * rep_; S.ready = rdy; S.tmo = F.ctl + CW_TMO; S.slot = (LAS unsigned*)(ldl + AUX_OFF + 24576 + 64);
              EpiYB E{(bf16*)(wsl + WS_YB)};
              gm::gemm_phase<EpiYB, MoeDynOrder, false, true, true, SC_HID8, SC_W8>(ldl, (const char*)(wsl + (l ? WS_HID1 : WS_HID)), DEX, S, E, F.wave); }
        }
        SEAM(pb + 7);
    }

__global__ void __launch_bounds__(NTHR, 2) mk_fwd(Args args) {
    extern __shared__ __attribute__((aligned(16))) unsigned char lds[];
    Frame F;
    F.lds = (LAS unsigned char*)lds; F.MISC = (volatile LAS unsigned*)(F.lds + MISC_OFF);
    F.tid = 0; F.lane = 0; F.wave = __builtin_amdgcn_readfirstlane((int)threadIdx.x >> 6);
    F.G = gridDim.x; { const int bx = blockIdx.x; F.vcu = (F.G % 8 == 0) ? (bx % 8) * (F.G / 8) + bx / 8 : bx; }
    F.ws = args.ws; F.ctl = (gu32*)(args.ws + WS_CTL);
    for (int u = threadIdx.x; u < (LDS_BYTES - RING_BYTES) / 4; u += NTHR) ((LAS unsigned*)(F.lds + RING_BYTES))[u] = 0u;
    __syncthreads();
    const int lo = args.ph_lo, hi = args.ph_hi;
    const bool multi = (hi - lo) > 1;
    XcdBarrier bar; bar.bar = (unsigned*)(F.ctl + CW_BAR); bar.x = 0; bar.st = nullptr;
    if (multi) bar = xcd_barrier_post((unsigned*)(F.ctl + CW_BAR), F.MISC + 8);
    for (int rep_ = 0; rep_ < REPS(0); ++rep_) if (IN(0)) { if (rep_) xcd_barrier(bar); p0_prologue(F); } SEAM(0);

    layer_body<0>(F, bar, lo, hi);
    layer_body<1>(F, bar, lo, hi);
    for (int rep_ = 0; rep_ < REPS(10); ++rep_) if (IN(N_PHASES - 1)) { if (rep_) xcd_barrier(bar); phase_norm1<2>(F, NLAYER - 1, (const float*)(F.ws + WS_X1), (float*)karg(21), NLAYER - 1); }
#ifdef MK_SELFTEST
    {
        const bool h0 = st_run(0, 1.f, 0x7f7f7f7f), h0s = st_run(0, 64.f, 0x79797979), h1 = st_run(1, 1.f, 0x7f7f7f7f);
        xcd_barrier(bar);
        float* o = (float*)karg(21);
        if (!(h0 && h0s)) { const float val = h0 ? 0.f : (h1 ? 1000.f : __builtin_nanf(""));
            for (size_t i = (size_t)blockIdx.x * NTHR + threadIdx.x; i < (size_t)SEQ * DM; i += (size_t)gridDim.x * NTHR) o[i] = val; }
    }
#endif
#undef IN
#undef SEAM
}

#ifndef MK_LAUNCHES
#define MK_LAUNCHES 1
#endif
extern "C" void kernel_launch(void* const* d_in, const int* in_sizes, int n_in, void* d_out, int out_size, void* d_ws, size_t ws_size, hipStream_t stream) {
    static int grid = 0;
    if (grid == 0) {
        int dev = 0, cus = 0, per_cu = 0;
        if (n_in != 21 || ws_size < WS_END) { fprintf(stderr, "kernel_launch: unexpected inputs (n_in %d, ws %zu)\n", n_in, ws_size); grid = -1; return; }
        if (hipGetDevice(&dev) != hipSuccess || hipDeviceGetAttribute(&cus, hipDeviceAttributeMultiprocessorCount, dev) != hipSuccess) { grid = -1; return; }
        if (hipFuncSetAttribute((const void*)mk_fwd, hipFuncAttributeMaxDynamicSharedMemorySize, LDS_BYTES) != hipSuccess) { fprintf(stderr, "kernel_launch: hipFuncSetAttribute failed\n"); grid = -1; return; }
        if (hipOccupancyMaxActiveBlocksPerMultiprocessor(&per_cu, (const void*)mk_fwd, NTHR, LDS_BYTES) != hipSuccess || per_cu < 1) fprintf(stderr, "kernel_launch: occupancy query says %d\n", per_cu);
        (void)hipGetLastError();
        grid = cus;
    }
    if (grid < 0) return;
    (void)hipMemsetAsync((char*)d_ws + WS_CTL, 0, CTL_ZERO_BYTES, stream);
    Args a{};
    for (int i = 0; i < 21; ++i) a.in[i] = (const float*)d_in[i];
    a.out = (float*)d_out; a.ws = (unsigned char*)d_ws;
#if MK_LAUNCHES == 1
    a.ph_lo = 0; a.ph_hi = N_PHASES;
    hipLaunchKernelGGL(mk_fwd, dim3(grid), dim3(NTHR), LDS_BYTES, stream, a);
#else
    for (int p = 0; p < N_PHASES; ++p) { a.ph_lo = p; a.ph_hi = p + 1; hipLaunchKernelGGL(mk_fwd, dim3(grid), dim3(NTHR), LDS_BYTES, stream, a); }
#endif
}
```

```cpp
#include <hip/hip_runtime.h>
#include <stdint.h>
#include <stdio.h>

#define GAS __attribute__((address_space(1)))
#define LAS __attribute__((address_space(3)))
typedef unsigned short bf16;
typedef short bf16x8 __attribute__((ext_vector_type(8)));
typedef short s16x4 __attribute__((ext_vector_type(4)));
typedef float f32x2 __attribute__((ext_vector_type(2)));
typedef float f32x4 __attribute__((ext_vector_type(4)));
typedef float f32x16 __attribute__((ext_vector_type(16)));
typedef unsigned u32x2 __attribute__((ext_vector_type(2)));
typedef unsigned u32x4 __attribute__((ext_vector_type(4)));
typedef int i32x8 __attribute__((ext_vector_type(8)));
typedef int i32x4 __attribute__((ext_vector_type(4)));
typedef GAS unsigned gu32;
#define RLX_AGENT __ATOMIC_RELAXED, __HIP_MEMORY_SCOPE_AGENT
#define LDS_WAIT() asm volatile("s_waitcnt lgkmcnt(0)" ::: "memory")
#define VM_WAIT() asm volatile("s_waitcnt vmcnt(0)" ::: "memory")

constexpr int DM = 2048, SEQ = 8192, NIN = 4616, NZ = 4608, DEX = 1024, NEXP = 16, NLAYER = 2;
constexpr float EPSN = 1e-6f;
constexpr float LOG2E = 1.4426950408889634f;
constexpr int NWAVES = 8, NTHR = 512;
constexpr int HIDROWS = 2 * SEQ + NEXP * 256;

constexpr size_t KiB = 1024, MiB = 1u << 20;
constexpr size_t WS_CTL = 0, CTL_ZERO_BYTES = 1 * MiB;
constexpr size_t WS_MOD = 1 * MiB;
constexpr size_t WS_FLOC = WS_MOD + 128 * KiB;
constexpr size_t WS_TOT = WS_FLOC + 256 * KiB;
constexpr size_t WS_FKL = WS_TOT + 8 * KiB;
constexpr size_t WS_TOKE = WS_FKL + 256 * KiB;
constexpr size_t WS_TOKP = WS_TOKE + 64 * KiB;
constexpr size_t WS_TOKW = WS_TOKP + 64 * KiB;
constexpr size_t WS_LIST = WS_TOKW + 64 * KiB;
constexpr size_t WS_WM = 4 * MiB;
constexpr size_t WS_BWT = WS_WM + 256 * KiB;
constexpr size_t WS_MODP = 6 * MiB;
constexpr size_t WS_WIN = 8 * MiB;
constexpr size_t WS_WOUT = WS_WIN + 2 * 18 * MiB;
constexpr size_t WS_WGU = WS_WOUT + 2 * 8 * MiB;
constexpr size_t WS_WD = WS_WGU + 2 * 16 * 8 * MiB;
constexpr size_t WS_H = WS_WD + 2 * 16 * 4 * MiB;
constexpr size_t WS_Z = WS_H + 32 * MiB;
constexpr size_t WS_QN = WS_Z + 72 * MiB;
constexpr size_t WS_KN = WS_QN + 16 * MiB;
constexpr size_t WS_VN = WS_KN + 16 * MiB;
constexpr size_t WS_DP = WS_VN + 8 * MiB;
constexpr size_t WS_YCAT = WS_DP + 8 * MiB;
constexpr size_t WS_X1 = WS_YCAT + 32 * MiB;
constexpr size_t WS_X2 = WS_X1 + 64 * MiB;
constexpr size_t WS_HID = WS_X2 + 64 * MiB;
constexpr size_t WS_YB = WS_HID + 40 * MiB;
constexpr size_t WS_PART = WS_YB + 80 * MiB;
constexpr size_t WS_ML = WS_PART + 128 * MiB;
constexpr size_t WS_HID1 = WS_ML + 4 * MiB;
constexpr size_t WS_END = WS_HID1 + 40 * MiB;
constexpr int CW_TMO = 0, CW_CODE = 1;
constexpr int CW_CNT = 64;
constexpr int CW_Q = 512;
constexpr int CW_BGT = 640;
constexpr int CW_ARR = 1024;
constexpr int CW_MT = 768;
constexpr int CW_BAR = 4096;
constexpr int CW_RDY = 8192;

constexpr int RING_BYTES = 131072;
constexpr int MISC_OFF = RING_BYTES + 320;
constexpr int AUX_OFF = RING_BYTES + 1024;
constexpr int LDS_BYTES = 163840;

template <class T> __device__ __forceinline__ T* opq(T* p) { asm volatile("" : "+s"(p)); return p; }
__device__ __forceinline__ int opq_tid(int wave) { int t = (wave << 6) | (int)__builtin_amdgcn_mbcnt_hi(~0u, __builtin_amdgcn_mbcnt_lo(~0u, 0u)); asm volatile("" : "+v"(t)); return t; }
__device__ __forceinline__ unsigned cvt_pk_bf16(float lo, float hi) { unsigned r; asm volatile("v_cvt_pk_bf16_f32 %0, %1, %2" : "=v"(r) : "v"(lo), "v"(hi)); return r; }
__device__ __forceinline__ unsigned cvt_pk4_fp8(float a, float b, float c, float d) {
    a = fminf(fmaxf(a, -440.f), 440.f); b = fminf(fmaxf(b, -440.f), 440.f); c = fminf(fmaxf(c, -440.f), 440.f); d = fminf(fmaxf(d, -440.f), 440.f);
    unsigned w; asm volatile("v_cvt_pk_fp8_f32 %0, %1, %2" : "=v"(w) : "v"(a), "v"(b)); asm volatile("v_cvt_pk_fp8_f32 %0, %1, %2 op_sel:[0,0,1]" : "+v"(w) : "v"(c), "v"(d)); return w; }
constexpr float H8_SCALE = 4.f, HID8_SCALE = 4.f, W8_SCALE = 64.f;
constexpr int SC_H8 = 0x7b7b7b7b, SC_HID8 = 0x7b7b7b7b, SC_W8 = 0x7b7b7b7b;
__device__ __forceinline__ float bf_lo(unsigned w) { return __uint_as_float(w << 16); }
__device__ __forceinline__ float bf_hi(unsigned w) { return __uint_as_float(w & 0xffff0000u); }
template <int M> __device__ __forceinline__ float xor_f(float v) {
    static_assert(M < 32, "xor_f: masks below 32 only");
    return __uint_as_float((unsigned)__builtin_amdgcn_ds_swizzle((int)__float_as_uint(v), (M << 10) | 0x1f));
}
__device__ __forceinline__ float wave_sum(float v) {
    v += xor_f<1>(v); v += xor_f<2>(v); v += xor_f<4>(v); v += xor_f<8>(v); v += xor_f<16>(v);
    { auto rr = __builtin_amdgcn_permlane32_swap(__float_as_uint(v), __float_as_uint(v), false, false); v = __uint_as_float(rr[0]) + __uint_as_float(rr[1]); }
    return v;
}
__device__ __forceinline__ float wave_max(float v) {
    v = fmaxf(v, xor_f<1>(v)); v = fmaxf(v, xor_f<2>(v)); v = fmaxf(v, xor_f<4>(v)); v = fmaxf(v, xor_f<8>(v)); v = fmaxf(v, xor_f<16>(v));
    { auto rr = __builtin_amdgcn_permlane32_swap(__float_as_uint(v), __float_as_uint(v), false, false); v = fmaxf(__uint_as_float(rr[0]), __uint_as_float(rr[1])); }
    return v;
}
__device__ __forceinline__ float gelu_t(float x) {
    const float u2 = x * (1.5957691216057308f + 0.0713548162726f * x * x);
    return x * __builtin_amdgcn_rcpf(1.f + __builtin_amdgcn_exp2f(-LOG2E * u2));
}
__device__ __forceinline__ float silu_f(float x) { return x * __builtin_amdgcn_rcpf(1.f + __builtin_amdgcn_exp2f(-LOG2E * x)); }

#define XB_TMO      128
#define XB_XCNT(j)  (256  + 64 * (j))
#define XB_XSUB(j)  (1280 + 64 * (j))
#define XB_XGEN(j)  (2304 + 64 * (j))
#define XB_TOP      3328
#define XB_TOPGEN   3392
#define XCD_BAR_WORDS 3456
#define XB_SPIN_CAP (1u << 18)
__device__ __forceinline__ unsigned xb_ld(unsigned* p)              { return __hip_atomic_load(p, __ATOMIC_RELAXED, __HIP_MEMORY_SCOPE_AGENT); }
__device__ __forceinline__ unsigned xb_add(unsigned* p, unsigned v) { return __hip_atomic_fetch_add(p, v, __ATOMIC_RELAXED, __HIP_MEMORY_SCOPE_AGENT); }
__device__ __forceinline__ unsigned xb_xcc_id() { return (unsigned)__builtin_amdgcn_s_getreg((3 << 11) | 20) & 0xFu; }
#define XB_SPIN(cond, bar) do { unsigned _sp = 0; while (cond) { __builtin_amdgcn_s_sleep(1); \
    if ((++_sp & 255u) == 0u) { if (xb_ld(&(bar)[XB_TMO])) break; if (_sp > XB_SPIN_CAP) { atomicAdd(&(bar)[XB_TMO], 1u); break; } } } } while (0)
struct XcdBarrier { unsigned* bar; unsigned x; volatile LAS unsigned* st; };
__device__ __forceinline__ XcdBarrier xcd_barrier_post(unsigned* bar, volatile LAS unsigned* st) {
    XcdBarrier b; b.bar = bar; b.x = xb_xcc_id(); b.st = st;
    if (threadIdx.x == 0) (void)xb_add(&bar[XB_XCNT(b.x)], 1u);
    return b;
}
__device__ __forceinline__ void xcd_barrier_complete(unsigned* bar, unsigned x, unsigned& nloc, unsigned& nx) {
    const unsigned G = gridDim.x * gridDim.y * gridDim.z;
    unsigned sum, cnt, mine, sp = 0u;
    for (;;) {
        sum = 0u; cnt = 0u; mine = 0u;
#pragma unroll
        for (unsigned j = 0; j < 16; ++j) { const unsigned c = xb_ld(&bar[XB_XCNT(j)]); sum += c; cnt += (c > 0u) ? 1u : 0u; mine = (j == x) ? c : mine; }
        if (sum == G) break;
        __builtin_amdgcn_s_sleep(1);
        if ((++sp & 255u) == 0u) { if (xb_ld(&bar[XB_TMO])) break; if (sp > XB_SPIN_CAP) { atomicAdd(&bar[XB_TMO], 1u); break; } }
    }
    nloc = mine > 0u ? mine : 1u; nx = cnt > 0u ? cnt : 1u;
}
__device__ __forceinline__ void xcd_barrier(const XcdBarrier& b) {
    asm volatile("s_waitcnt vmcnt(0)" ::: "memory");
    __syncthreads();
    if (threadIdx.x == 0) {
        unsigned* bar = b.bar; asm volatile("" : "+s"(bar));
        __builtin_amdgcn_s_waitcnt(0);
        unsigned nloc = b.st[0], nx = b.st[1];
        if (nloc == 0u) { xcd_barrier_complete(bar, b.x, nloc, nx); b.st[0] = nloc; b.st[1] = nx; }
        const unsigned old = xb_add(&bar[XB_XSUB(b.x)], 1u);
        const unsigned gen = old / nloc;
        if (old + 1u == (gen + 1u) * nloc) {
            __builtin_amdgcn_fence(__ATOMIC_RELEASE, "agent");
            asm volatile("s_waitcnt vmcnt(0)" ::: "memory");
            const unsigned og = xb_add(&bar[XB_TOP], 1u);
            const unsigned tg = og / nx;
            if (og + 1u == (tg + 1u) * nx) xb_add(&bar[XB_TOPGEN], 1u);
            else XB_SPIN(xb_ld(&bar[XB_TOPGEN]) == tg, bar);
            __builtin_amdgcn_fence(__ATOMIC_ACQUIRE, "agent");
            xb_add(&bar[XB_XGEN(b.x)], 1u);
            asm volatile("s_waitcnt vmcnt(0)" ::: "memory");
        } else {
            XB_SPIN(xb_ld(&bar[XB_XGEN(b.x)]) == gen, bar);
            __builtin_amdgcn_fence(__ATOMIC_ACQUIRE, "agent");
            asm volatile("s_waitcnt vmcnt(0)" ::: "memory");
        }
    }
    __syncthreads();
}

namespace gm {
constexpr int BM = 256, BK = 64, HALF = 128, HTB = HALF * BK * 2, STAGE_BYTES = 8 * HTB, NXCD = 8, WGM = 8;
__host__ __device__ __forceinline__ int lds_byte(int r, int c) { const int st = (r >> 4) * 2 + (c >> 5), rr = r & 15, cc = c & 31, ob = rr * 64 + cc * 2; return st * 1024 + (ob ^ (((ob >> 9) & 1) << 5)); }
__host__ __device__ __forceinline__ void stage_rc(int b, int& R, int& C) { const int st = b / 1024, sb = b % 1024, swz = sb ^ (((sb >> 9) & 1) << 5); R = (st >> 1) * 16 + swz / 64; C = (st & 1) * 32 + (swz % 64) / 2; }
__host__ __device__ __forceinline__ int perm32(int rho) { const int n = rho >> 4, i = rho & 15; return 8 * (i >> 2) + 4 * n + (i & 3); }

struct Unit { int arow, orow, ocol, e, rt; const char* Bp; };

template <class Epi, class Sched, bool GATHER, bool ALIGN_EPI, bool FP8 = false, int SCA = 0x7f7f7f7f, int SCB = 0x7f7f7f7f>
__device__ __forceinline__ void gemm_phase(LAS unsigned char* lds, const char* Abase, const int Kel, const Sched& S, const Epi& E, const int wv) {
    const int K = FP8 ? (Kel >> 1) : Kel;
    const int tid = opq_tid(wv), wid = wv, lane = tid & 63, wr = wid >> 2, wc = wid & 3, fr = lane & 15, fq = lane >> 4;
    const int nt = K / BK;
    unsigned voffA[2], voffB[2];
#pragma unroll
    for (int i = 0; i < 2; ++i) { int R, C; stage_rc(tid * 16 + i * 8192, R, C); const int Rb = Epi::PERM ? ((R & ~31) + perm32(R & 31)) : R;
        voffA[i] = (unsigned)(R * K + C) * 2u; voffB[i] = (unsigned)(Rb * K + C) * 2u; }
    const size_t kstep = (size_t)(BK * 2);
    const size_t hstep = (size_t)HALF * K * 2;
    const unsigned ldsw = (unsigned)wid * 1024u;
    const int aoff = FP8 ? lds_byte(wr * 64 + fr, fq * 16) : lds_byte(wr * 64 + fr, fq * 8), boff = FP8 ? lds_byte(wc * 32 + fr, fq * 16) : lds_byte(wc * 32 + fr, fq * 8);
#define PG8_SA(b, h) (((b) * 2 + (h)) * HTB)
#define PG8_SB(b, h) ((4 + (b) * 2 + (h)) * HTB)
#define PG8_STAGE(bufoff, gbase, voff) do { _Pragma("unroll") for (int _i = 0; _i < 2; ++_i) { unsigned vo_ = (voff)[_i]; asm volatile("" : "+v"(vo_));     \
        __builtin_amdgcn_global_load_lds((const unsigned*)((const char*)(gbase) + vo_), (LAS unsigned*)(lds + (bufoff) + ldsw + _i * 8192), 16, 0, 0); } } while (0)
#define PG8_STAGE_A(bufoff, ubase, h, kb, vg) do { if constexpr (GATHER) { PG8_STAGE(bufoff, Abase + (kb), (vg)[h]); } else { PG8_STAGE(bufoff, (ubase) + (h) * hstep + (kb), voffA); } } while (0)
#define PG8_STAGE_A2(bufoff, ubase, h, kb) PG8_STAGE_A(bufoff, ubase, h, kb, vgc)
#define PG8_LDA(dst, b, h) do { _Pragma("unroll") for (int m = 0; m < 4; ++m) { if constexpr (FP8) { dst##8[m].lo = *(const LAS i32x4*)(lds + PG8_SA(b, h) + aoff + m * 2048); dst##8[m].hi = *(const LAS i32x4*)(lds + PG8_SA(b, h) + aoff + 16 + m * 2048); } \
        else { dst[m][0] = *(const LAS bf16x8*)(lds + PG8_SA(b, h) + aoff + m * 2048); dst[m][1] = *(const LAS bf16x8*)(lds + PG8_SA(b, h) + aoff + 1024 + m * 2048); } } } while (0)
#define PG8_LDB(dst, b, h) do { _Pragma("unroll") for (int n = 0; n < 2; ++n) { if constexpr (FP8) { dst##8[n].lo = *(const LAS i32x4*)(lds + PG8_SB(b, h) + boff + n * 2048); dst##8[n].hi = *(const LAS i32x4*)(lds + PG8_SB(b, h) + boff + 16 + n * 2048); } \
        else { dst[n][0] = *(const LAS bf16x8*)(lds + PG8_SB(b, h) + boff + n * 2048); dst[n][1] = *(const LAS bf16x8*)(lds + PG8_SB(b, h) + boff + 1024 + n * 2048); } } } while (0)
#define PG8_F8(x) __builtin_shufflevector(__builtin_bit_cast(i32x4, (x)[0]), __builtin_bit_cast(i32x4, (x)[1]), 0, 1, 2, 3, 4, 5, 6, 7)
#define PG8_MMA(ai, bj, At, Bt) do { __builtin_amdgcn_s_setprio(1); _Pragma("unroll") for (int m = 0; m < 4; ++m) _Pragma("unroll") for (int n = 0; n < 2; ++n) { \
        if constexpr (FP8) { acc[ai][bj][m][n] = __builtin_amdgcn_mfma_scale_f32_16x16x128_f8f6f4(Bt##8[n], At##8[m], acc[ai][bj][m][n], 0, 0, 0, SCB, 0, SCA); } \
        else { _Pragma("unroll") for (int k = 0; k < 2; ++k) acc[ai][bj][m][n] = __builtin_amdgcn_mfma_f32_16x16x32_bf16(Bt[n][k], At[m][k], acc[ai][bj][m][n], 0, 0, 0); } } \
        __builtin_amdgcn_s_setprio(0); } while (0)
#define PG8_WAIT_V(n) asm volatile("s_waitcnt vmcnt(" #n ")" ::: "memory")
#define PG8_WAIT_L(n) asm volatile("s_waitcnt lgkmcnt(" #n ")" ::: "memory")
#define PG8_BAR __builtin_amdgcn_s_barrier()
#define PG8_SCHED __builtin_amdgcn_sched_barrier(0)
    Unit cur, nxt; int ui = 0;
    if (!S.next(0, cur)) return;
    f32x4 acc[2][2][4][2];
#pragma unroll
    for (int a = 0; a < 2; ++a)
#pragma unroll
        for (int b = 0; b < 2; ++b)
#pragma unroll
            for (int m = 0; m < 4; ++m)
#pragma unroll
                for (int n = 0; n < 2; ++n) acc[a][b][m][n] = (f32x4){0.f, 0.f, 0.f, 0.f};
    bf16x8 At[4][2], B0[2][2], B1[2][2];
    i32x8 At8[4], B08[2], B18[2];
    unsigned vgc[2][2];
    if constexpr (GATHER) {
#pragma unroll
        for (int h = 0; h < 2; ++h)
#pragma unroll
            for (int i = 0; i < 2; ++i) { int R_, C_; stage_rc(opq_tid(wv) * 16 + i * 8192, R_, C_); vgc[h][i] = ((unsigned)S.row_of(cur, h * HALF + R_) * (unsigned)K + (unsigned)C_) * 2u; }
    }
    const char* cA = GATHER ? Abase : Abase + (size_t)cur.arow * K * 2; const char* cB = cur.Bp;
    PG8_STAGE(PG8_SB(0, 0), cB, voffB); PG8_STAGE(PG8_SB(0, 1), cB + hstep, voffB); PG8_STAGE_A(PG8_SA(0, 0), cA, 0, 0, vgc); PG8_STAGE_A(PG8_SA(0, 1), cA, 1, 0, vgc);
    if (wr == 1) PG8_BAR;
    PG8_WAIT_V(2); PG8_BAR;
    PG8_STAGE(PG8_SB(1, 0), cB + kstep, voffB); PG8_STAGE_A(PG8_SA(1, 0), cA, 0, kstep, vgc); PG8_STAGE(PG8_SB(1, 1), cB + hstep + kstep, voffB);
    PG8_WAIT_V(6); PG8_BAR;
    for (;;) {
        bool has_next = false;
        const char* nA = cA; const char* nB = cB;
        for (int t = 0; t < nt; t += 2) {
            const bool last = (t == nt - 2);
            if (last) { has_next = S.next(ui + 1, nxt); if (has_next) { nA = GATHER ? Abase : Abase + (size_t)nxt.arow * K * 2; nB = nxt.Bp; } }
            const size_t k1 = (size_t)(t + 1) * kstep;
            const char* a2 = last ? nA : cA; const char* b2 = last ? nB : cB + (size_t)(t + 2) * kstep;
            const size_t k2 = last ? 0 : (size_t)(t + 2) * kstep, k3 = k2 + kstep;
            const char* b3 = b2 + kstep;
            PG8_LDB(B0, 0, 0); PG8_LDB(B1, 0, 1); PG8_SCHED; PG8_LDA(At, 0, 0); PG8_STAGE_A(PG8_SA(1, 1), cA, 1, k1, vgc);
            if constexpr (GATHER) { if (last && has_next) {
#pragma unroll
                for (int h = 0; h < 2; ++h)
#pragma unroll
                    for (int i = 0; i < 2; ++i) { int R_, C_; stage_rc(opq_tid(wv) * 16 + i * 8192, R_, C_); vgc[h][i] = ((unsigned)S.row_of(nxt, h * HALF + R_) * (unsigned)K + (unsigned)C_) * 2u; } } }
            PG8_WAIT_V(8); PG8_WAIT_L(0); PG8_BAR; PG8_MMA(0, 0, At, B0); PG8_MMA(0, 1, At, B1); PG8_BAR; PG8_SCHED;
            PG8_LDA(At, 0, 1); PG8_STAGE(PG8_SB(0, 0), b2, voffB); PG8_STAGE(PG8_SB(0, 1), b2 + hstep, voffB); PG8_STAGE_A2(PG8_SA(0, 0), a2, 0, k2);
            PG8_WAIT_V(8); PG8_WAIT_L(0); PG8_BAR; PG8_MMA(1, 0, At, B0); PG8_MMA(1, 1, At, B1); PG8_BAR; PG8_SCHED;
            PG8_LDB(B0, 1, 0); PG8_LDB(B1, 1, 1); PG8_SCHED; PG8_LDA(At, 1, 0); PG8_STAGE_A2(PG8_SA(0, 1), a2, 1, k2);
            PG8_WAIT_V(8); PG8_WAIT_L(0); PG8_BAR; PG8_MMA(0, 0, At, B0); PG8_MMA(0, 1, At, B1); PG8_BAR; PG8_SCHED;
            PG8_LDA(At, 1, 1); PG8_STAGE(PG8_SB(1, 0), b3, voffB); PG8_STAGE(PG8_SB(1, 1), b3 + hstep, voffB); PG8_STAGE_A2(PG8_SA(1, 0), a2, 0, k3);
            PG8_WAIT_V(8); PG8_WAIT_L(0); PG8_BAR; PG8_MMA(1, 0, At, B0); PG8_MMA(1, 1, At, B1); PG8_BAR; PG8_SCHED;
        }
        if constexpr (ALIGN_EPI) { if (wr == 0) PG8_BAR; }
        E(acc, cur, wr, wc, fr, fq);
        if (!has_next) break;
#pragma unroll
        for (int a = 0; a < 2; ++a)
#pragma unroll
            for (int b = 0; b < 2; ++b)
#pragma unroll
                for (int m = 0; m < 4; ++m)
#pragma unroll
                    for (int n = 0; n < 2; ++n) acc[a][b][m][n] = (f32x4){0.f, 0.f, 0.f, 0.f};
        cur = nxt; cA = nA; cB = nB; ++ui;
        if constexpr (ALIGN_EPI) { if (wr == 1) PG8_BAR; }
    }
    PG8_WAIT_V(0);
    if constexpr (!ALIGN_EPI) { if (wr == 0) PG8_BAR; }
    PG8_BAR;
#undef PG8_SA
#undef PG8_SB
#undef PG8_STAGE
#undef PG8_STAGE_A
#undef PG8_STAGE_A2
#undef PG8_LDA
#undef PG8_LDB
#undef PG8_MMA
#undef PG8_F8
#undef PG8_WAIT_V
#undef PG8_WAIT_L
#undef PG8_BAR
#undef PG8_SCHED
}

struct RegOrder {
    int nM, nN, nwg, G, c, K; const char* Bt;
    __device__ __forceinline__ void init(int M, int N, int K_, const void* Bt_, int G_, int c_) { nM = M / BM; nN = N / BM; nwg = nM * nN; G = G_; c = c_; K = K_; Bt = (const char*)Bt_; }
    __device__ __forceinline__ bool next(int i, Unit& u) const {
        const long L = (long)i * G + c; if (L >= nwg) return false;
        int wgid = (int)L; { const int q = nwg / NXCD, r = nwg % NXCD, xcd = wgid % NXCD, off = wgid / NXCD; wgid = (xcd < r ? xcd * (q + 1) : r * (q + 1) + (xcd - r) * q) + off; }
        const int nig = WGM * nN, gid = wgid / nig, fm = gid * WGM, gsz = (nM - fm) < WGM ? (nM - fm) : WGM;
        const int pm = fm + ((wgid % nig) % gsz), pn = (wgid % nig) / gsz;
        u.arow = pm * BM; u.orow = pm * BM; u.ocol = pn * BM; u.e = 0; u.rt = 0; u.Bp = Bt + (size_t)pn * BM * K * 2; return true;
    }
    __device__ __forceinline__ int row_of(const Unit&, int) const { return 0; }
};
}
namespace at {
constexpr int NW = 8, QBLK = 32, KVBLK = 64, QB = NW * QBLK, D = 128;
constexpr int SHM_V = KVBLK * D * 2, SHM_K = KVBLK * D * 2;
constexpr int OFF_WS = 2 * SHM_V + 2 * SHM_K, OFF_NF = OFF_WS + NW * 64 * 4, ATT_LDS = OFF_NF + 2 * 64 * 4;
constexpr float SCALE = 0.08838834764831845f, C2 = 1.4426950408889634f * SCALE, THR = 8.f;
constexpr float ISCALE = 11.313708498984761f;
constexpr int QS = 128, KS = 128, VS = NZ, OS = DM;

#define KSWZ(row, colB) ((row) * 256 + ((colB) ^ (((row) & 7) << 4)))
#define SBAR() __builtin_amdgcn_sched_barrier(0)
__device__ __forceinline__ int v_st(int k, int c) { const int kk = (k & ~0xC) | ((k & 4) << 1) | ((k & 8) >> 1); return ((kk >> 3) * 4 + (c >> 5)) * 512 + ((kk & 7) * 32 + (c & 31)) * 2; }
__device__ __forceinline__ int v_rd_base(int lane) { return ((lane & 3) << 3) | (((lane >> 2) & 3) << 6) | (((lane >> 4) & 1) << 5) | (((lane >> 5) & 1) << 8); }
constexpr int v_rd_off(int d0, int ks, int half) { return d0 * 512 + ks * 4096 + half * 2048; }
__device__ __forceinline__ int crow(int r, int hi) { return (r & 3) + 8 * (r >> 2) + 4 * hi; }
__device__ __forceinline__ unsigned cvtpk(float lo, float hi) { unsigned r; asm volatile("v_cvt_pk_bf16_f32 %0, %1, %2" : "=v"(r) : "v"(lo), "v"(hi)); return r; }
__device__ __forceinline__ bf16x8 load8(const bf16* p) { return *(const GAS bf16x8*)p; }

__device__ __forceinline__ void mask_tile(f32x16& p0, f32x16& p1, int dq) {
    const float NEG = -__builtin_inff();
#pragma unroll
    for (int r = 0; r < 16; ++r) {
        const int c = (r & 3) + 8 * (r >> 2);
        if (dq - c < 0) p0[r] = NEG;
        if (dq - c - 32 < 0) p1[r] = NEG;
    }
}
__device__ __forceinline__ void partialSM(f32x16& p0, f32x16& p1, float& m_reg, float& mn, float& alpha) {
    float pmax = p0[0]; for (int r = 1; r < 16; ++r) pmax = fmaxf(pmax, p0[r]); for (int r = 0; r < 16; ++r) pmax = fmaxf(pmax, p1[r]);
    { auto rr = __builtin_amdgcn_permlane32_swap(__float_as_uint(pmax), __float_as_uint(pmax), false, false);
      pmax = fmaxf(__uint_as_float(rr[0]), __uint_as_float(rr[1])); }
    if (__builtin_expect(__all((pmax - m_reg) * SCALE <= THR), 1)) { mn = m_reg; alpha = 1.f; }
    else { mn = fmaxf(m_reg, pmax); alpha = __builtin_amdgcn_exp2f((m_reg - mn) * C2); m_reg = mn; }
    const float mnL = -mn * C2;
    for (int r = 0; r < 16; ++r) p0[r] = fmaf(p0[r], C2, mnL); for (int r = 0; r < 16; ++r) p1[r] = fmaf(p1[r], C2, mnL);
    for (int r = 0; r < 16; ++r) p0[r] = __builtin_amdgcn_exp2f(p0[r]);
}
__device__ __forceinline__ void finishSM(f32x16& p0, f32x16& p1, float alpha, float& l_reg, bf16x8& pa0, bf16x8& pa1, bf16x8& pa2, bf16x8& pa3) {
    for (int r = 0; r < 16; ++r) p1[r] = __builtin_amdgcn_exp2f(p1[r]);
    float ps = 0; for (int r = 0; r < 16; ++r) ps += p0[r]; for (int r = 0; r < 16; ++r) ps += p1[r];
    { auto rr = __builtin_amdgcn_permlane32_swap(__float_as_uint(ps), __float_as_uint(ps), false, false);
      ps = __uint_as_float(rr[0]) + __uint_as_float(rr[1]); }
    l_reg = l_reg * alpha + ps;
#define PK4(P, B_, OUT) do { unsigned a0 = cvtpk(P[B_+0], P[B_+1]), a1 = cvtpk(P[B_+2], P[B_+3]);                          \
        unsigned b0 = cvtpk(P[B_+4], P[B_+5]), b1 = cvtpk(P[B_+6], P[B_+7]);                                             \
        auto r0 = __builtin_amdgcn_permlane32_swap(a0, b0, false, false); auto r1 = __builtin_amdgcn_permlane32_swap(a1, b1, false, false); \
        u32x4 w = {r0[0], r1[0], r0[1], r1[1]}; OUT = *reinterpret_cast<bf16x8*>(&w); } while (0)
    PK4(p0, 0, pa0); PK4(p0, 8, pa1); PK4(p1, 0, pa2); PK4(p1, 8, pa3);
#undef PK4
}
template <int KB>
__device__ __forceinline__ void qkt(f32x16& p0, f32x16& p1, const char* K_lds, int r32, int hi, const bf16x8* qr) {
    { const float* nf = (const float*)(K_lds + 2 * SHM_K + NW * 64 * 4) + KB * 64 + 4 * hi;
#pragma unroll
      for (int g = 0; g < 4; ++g) { const f32x4 a = *(const f32x4*)(nf + 8 * g), b = *(const f32x4*)(nf + 32 + 8 * g);
#pragma unroll
          for (int j = 0; j < 4; ++j) { p0[4 * g + j] = a[j]; p1[4 * g + j] = b[j]; } } }
    const char* kb[4];
#pragma unroll
    for (int dd = 0; dd < 4; ++dd) kb[dd] = K_lds + KB * SHM_K + KSWZ(r32, (dd * 16 + hi * 8) * 2);
#pragma unroll
    for (int d0 = 0; d0 < 8; ++d0) { const char* a = kb[d0 & 3] + (d0 >> 2) * 128;
        bf16x8 b0 = *reinterpret_cast<const bf16x8*>(a);
        bf16x8 b1 = *reinterpret_cast<const bf16x8*>(a + 32 * 256);
        p0 = __builtin_amdgcn_mfma_f32_32x32x16_bf16(b0, qr[d0], p0, 0, 0, 0);
        p1 = __builtin_amdgcn_mfma_f32_32x32x16_bf16(b1, qr[d0], p1, 0, 0, 0); }
}
template <int VB>
__device__ __forceinline__ void pv_tile(f32x16* o, int vb0, bf16x8 pa0, bf16x8 pa1, bf16x8 pa2, bf16x8 pa3) {
#define TRRD(dst, off) asm volatile("ds_read_b64_tr_b16 %0, %1 offset:%2" : "=&v"(dst) : "v"(vb0), "i"(off) : "memory")
#define PV_D0(d0) do { s16x4 l0, l1, l2, l3, h0, h1, h2, h3; constexpr int b_ = VB * SHM_V + v_rd_off(d0, 0, 0); \
        TRRD(l0, b_); TRRD(h0, b_ + 2048); TRRD(l1, b_ + 4096); TRRD(h1, b_ + 6144); TRRD(l2, b_ + 8192); TRRD(h2, b_ + 10240); TRRD(l3, b_ + 12288); TRRD(h3, b_ + 14336); \
        asm volatile("s_waitcnt lgkmcnt(0)" ::: "memory"); SBAR();   \
        o[d0] = __builtin_amdgcn_mfma_f32_32x32x16_bf16(pa0, (bf16x8){l0[0], l0[1], l0[2], l0[3], h0[0], h0[1], h0[2], h0[3]}, o[d0], 0, 0, 0);   \
        o[d0] = __builtin_amdgcn_mfma_f32_32x32x16_bf16(pa1, (bf16x8){l1[0], l1[1], l1[2], l1[3], h1[0], h1[1], h1[2], h1[3]}, o[d0], 0, 0, 0);   \
        o[d0] = __builtin_amdgcn_mfma_f32_32x32x16_bf16(pa2, (bf16x8){l2[0], l2[1], l2[2], l2[3], h2[0], h2[1], h2[2], h2[3]}, o[d0], 0, 0, 0);   \
        o[d0] = __builtin_amdgcn_mfma_f32_32x32x16_bf16(pa3, (bf16x8){l3[0], l3[1], l3[2], l3[3], h3[0], h3[1], h3[2], h3[3]}, o[d0], 0, 0, 0); } while (0)
    PV_D0(0); PV_D0(1); PV_D0(2); PV_D0(3);
#undef PV_D0
#undef TRRD
}

struct BlockRef { const bf16* Q; const bf16* K; const bf16* V; bf16* O; const float* FK; int P0; };
#define ROWV(p, k0, rr) ((p) + (size_t)((k0) + (rr)) * VS + sc)
#define VMW() asm volatile("s_waitcnt vmcnt(0)" ::: "memory")
__device__ __forceinline__ void attn_block(const BlockRef& cur, int ja, int nt, bool fin, bf16* Opart, float* ML, char* lds, LAS unsigned char* ldsL, const int wv) {
    const int tid = opq_tid(wv), wid = wv, lane = tid & 63, r32 = lane & 31, hi = lane >> 5;
    const int NT = nt;
    const int qlo = cur.P0 + wid * QBLK, qm = qlo + r32 - 4 * hi;
    char* V_lds = lds; char* K_lds = lds + 2 * SHM_V;
    float* ws = (float*)(lds + OFF_WS) + wid * 64; float* li_l = ws, * al_l = ws + 32;
    float m_reg = -1e30f, l_reg = 0; f32x16 o[4] = {};
    const int vb0 = (int)(uintptr_t)V_lds + v_rd_base(lane);
    const bf16* Kh = cur.K; const bf16* Vh = cur.V; const float* Fh = cur.FK;
    bf16x8 st_v0, st_v1; bf16x8 qr[8];
#define KDMA(bf, k0) do { int t_ = tid; asm volatile("" : "+v"(t_)); _Pragma("unroll") for (int i_ = 0; i_ < 2; ++i_) { const int p_ = i_ * 512 + t_, r_ = p_ >> 4, c_ = (p_ & 15) ^ (r_ & 7); \
        __builtin_amdgcn_global_load_lds((const unsigned*)((const char*)Kh + (size_t)(k0) * KS * 2 + (unsigned)(r_ * KS * 2 + c_ * 16)), (LAS unsigned*)(ldsL + 2 * SHM_V + (bf) * SHM_K + i_ * 8192 + wid * 1024), 16, 0, 0); } \
        if (wid == 0) __builtin_amdgcn_global_load_lds((const unsigned*)(Fh + (k0) + lane), (LAS unsigned*)(ldsL + OFF_NF + (bf) * 256), 4, 0, 0); } while (0)
#define SLOADV(k0) do { int t_ = tid; asm volatile("" : "+v"(t_)); const int sr = t_ >> 4, sc = (t_ & 15) * 8; st_v0 = load8(ROWV(Vh, k0, sr)); st_v1 = load8(ROWV(Vh, k0, 32 + sr)); } while (0)
#define SWRITE_HV(bf) do { int t_ = tid; asm volatile("" : "+v"(t_)); const int sr = t_ >> 4, sc = (t_ & 15) * 8; *(bf16x8*)(V_lds + (bf) * SHM_V + v_st(sr, sc)) = st_v0; *(bf16x8*)(V_lds + (bf) * SHM_V + v_st(32 + sr, sc)) = st_v1; } while (0)
#define RESC(a) do { if (__any((a) < 1.f)) { if (hi == 0) al_l[r32] = (a); asm volatile("s_waitcnt lgkmcnt(0)" ::: "memory");              \
                     for (int d_ = 0; d_ < 4; ++d_) for (int r = 0; r < 16; ++r) o[d_][r] *= al_l[crow(r, hi)]; } } while (0)
#define KBASE(t) ((ja + (t)) * KVBLK)
#define MASKT(P0_, P1_, t) do { const int kb_ = KBASE(t); if (kb_ + KVBLK - 1 > qlo) mask_tile(P0_, P1_, qm - kb_); } while (0)
    f32x16 pA0, pA1, pB0, pB1; float mnA, mnB, alA, alB; bf16x8 pa0, pa1, pa2, pa3;
    KDMA(0, KBASE(0)); SLOADV(KBASE(0));
#pragma unroll
    for (int d0 = 0; d0 < 8; ++d0) qr[d0] = load8(cur.Q + (size_t)(wid * QBLK + r32) * QS + d0 * 16 + hi * 8);
    VMW(); SWRITE_HV(0);
    __syncthreads();
    if (NT > 1) { KDMA(1, KBASE(1)); SLOADV(KBASE(1)); }
    SBAR(); qkt<0>(pA0, pA1, K_lds, r32, hi, qr);
    MASKT(pA0, pA1, 0); partialSM(pA0, pA1, m_reg, mnA, alA);
    if (NT > 1) { VMW(); SWRITE_HV(1); }
    __syncthreads();
#define HALF_STEP(PX0, PX1, mnX, alX, PY0, PY1, alY, t, KB, VB, SB) do {                                                      \
        SBAR(); qkt<KB>(PX0, PX1, K_lds, r32, hi, qr);                                                                        \
        finishSM(PY0, PY1, alY, l_reg, pa0, pa1, pa2, pa3); SBAR();                                                           \
        if ((t) + 1 < NT) { KDMA(SB, KBASE((t) + 1)); SLOADV(KBASE((t) + 1)); SBAR(); }                                       \
        pv_tile<VB>(o, vb0, pa0, pa1, pa2, pa3); MASKT(PX0, PX1, (t)); partialSM(PX0, PX1, m_reg, mnX, alX);                  \
        VMW(); __syncthreads();                                                                                               \
        if ((t) + 1 < NT) { SWRITE_HV(SB); }                                                                                  \
        RESC(alX); __syncthreads(); } while (0)
    for (int t = 1; t + 1 < NT; t += 2) {
        HALF_STEP(pB0, pB1, mnB, alB, pA0, pA1, alA, t, 1, 0, 0);
        HALF_STEP(pA0, pA1, mnA, alA, pB0, pB1, alB, t + 1, 0, 1, 1);
    }
    const bool even = (NT & 1) == 0;
    if (even) { SBAR(); qkt<1>(pB0, pB1, K_lds, r32, hi, qr); SBAR(); }
    finishSM(pA0, pA1, alA, l_reg, pa0, pa1, pa2, pa3); SBAR();
    pv_tile<0>(o, vb0, pa0, pa1, pa2, pa3);
    if (even) { MASKT(pB0, pB1, NT - 1); partialSM(pB0, pB1, m_reg, mnB, alB); __syncthreads(); RESC(alB);
        finishSM(pB0, pB1, alB, l_reg, pa0, pa1, pa2, pa3); SBAR(); pv_tile<1>(o, vb0, pa0, pa1, pa2, pa3); }
    SBAR();
    if (hi == 0) li_l[r32] = l_reg; asm volatile("s_waitcnt lgkmcnt(0)" ::: "memory");
    float rli[16];
#pragma unroll
    for (int r = 0; r < 16; ++r) rli[r] = __builtin_amdgcn_rcpf(li_l[crow(r, hi)]);
    const int ostr = fin ? OS : D;
    bf16* Ow = (fin ? cur.O : Opart) + (size_t)(wid * QBLK) * ostr;
#pragma unroll
    for (int r = 0; r < 16; ++r) { const int orow = crow(r, hi);
#pragma unroll
        for (int d0 = 0; d0 < 4; ++d0) { const float v = o[d0][r] * rli[r];
            const float vn = xor_f<1>(v);
            if ((r32 & 1) == 0) *(GAS unsigned*)(Ow + (size_t)orow * ostr + d0 * 32 + r32) = cvtpk(v, vn); } }
    if (!fin && hi == 0) { f32x2 mlv; mlv.x = m_reg; mlv.y = l_reg; *(GAS f32x2*)(ML + (size_t)(wid * QBLK + r32) * 2) = mlv; }
    __syncthreads();
#undef KDMA
#undef SLOADV
#undef SWRITE_HV
#undef RESC
#undef KBASE
#undef MASKT
#undef HALF_STEP
}
#undef ROWV
#undef VMW
}
struct Frame {
    LAS unsigned char* lds; volatile LAS unsigned* MISC; gu32* ctl;
    int tid, lane, wave, vcu, G;
    unsigned char* ws;
};
#define CAS __attribute__((address_space(4)))
__device__ __forceinline__ const float* karg(int k) { const CAS char* p = (const CAS char*)__builtin_amdgcn_kernarg_segment_ptr(); asm volatile("" : "+s"(p)); return *(const float* const CAS*)(p + 8 * k); }

__device__ __forceinline__ void tr_item(const float* W, size_t ldw, bf16* WT, size_t ldk, LAS float* scr, int lane) {
    const int kr = lane >> 3, c4 = (lane & 7) * 4;
    f32x4 v[8];
#pragma unroll
    for (int i = 0; i < 8; ++i) v[i] = __builtin_nontemporal_load((const GAS f32x4*)(W + (size_t)(8 * i + kr) * ldw + c4));
#pragma unroll
    for (int i = 0; i < 8; ++i) { LAS float* s = scr + (8 * i + kr) * 33 + c4; s[0] = v[i].x; s[1] = v[i].y; s[2] = v[i].z; s[3] = v[i].w; }
    LDS_WAIT();
    const int c = lane & 7;
#pragma unroll
    for (int j = 0; j < 4; ++j) { const int n = (lane >> 3) + 8 * j; const LAS float* s = scr + (8 * c) * 33 + n;
        u32x4 o; o.x = cvt_pk_bf16(s[0 * 33], s[1 * 33]); o.y = cvt_pk_bf16(s[2 * 33], s[3 * 33]); o.z = cvt_pk_bf16(s[4 * 33], s[5 * 33]); o.w = cvt_pk_bf16(s[6 * 33], s[7 * 33]);
        *(GAS u32x4*)(WT + (size_t)n * ldk + 8 * c) = o; }
    LDS_WAIT();
}
__device__ __forceinline__ void tr_item8(const float* W, size_t ldw, unsigned char* WT, size_t ldk, LAS float* scr, int lane) {
    const int kr = lane >> 3, c4 = (lane & 7) * 4;
    f32x4 v[8];
#pragma unroll
    for (int i = 0; i < 8; ++i) v[i] = __builtin_nontemporal_load((const GAS f32x4*)(W + (size_t)(8 * i + kr) * ldw + c4));
#pragma unroll
    for (int i = 0; i < 8; ++i) { LAS float* s = scr + (8 * i + kr) * 33 + c4; s[0] = v[i].x; s[1] = v[i].y; s[2] = v[i].z; s[3] = v[i].w; }
    LDS_WAIT();
    const int c = lane & 3;
#pragma unroll
    for (int j = 0; j < 2; ++j) { const int n = (lane >> 2) + 16 * j; const LAS float* s = scr + (16 * c) * 33 + n;
        u32x4 o;
        o.x = cvt_pk4_fp8(s[0 * 33] * W8_SCALE, s[1 * 33] * W8_SCALE, s[2 * 33] * W8_SCALE, s[3 * 33] * W8_SCALE); o.y = cvt_pk4_fp8(s[4 * 33] * W8_SCALE, s[5 * 33] * W8_SCALE, s[6 * 33] * W8_SCALE, s[7 * 33] * W8_SCALE);
        o.z = cvt_pk4_fp8(s[8 * 33] * W8_SCALE, s[9 * 33] * W8_SCALE, s[10 * 33] * W8_SCALE, s[11 * 33] * W8_SCALE); o.w = cvt_pk4_fp8(s[12 * 33] * W8_SCALE, s[13 * 33] * W8_SCALE, s[14 * 33] * W8_SCALE, s[15 * 33] * W8_SCALE);
        *(GAS u32x4*)(WT + (size_t)n * ldk + 16 * c) = o; }
    LDS_WAIT();
}
constexpr int I_IN = (DM / 64) * (NZ / 32), I_OUT = (DM / 64) * (DM / 32), I_GU = (DM / 64) * (DEX / 32), I_D = (DEX / 64) * (DM / 32);
constexpr int GV_FIRST = 43;
constexpr int BGI_SMALL = (NLAYER * 4 * 8) / 8, BGI_IN = I_IN / 8, BGI_GV0 = (128 - GV_FIRST) * 4, BGI_GV1 = 128 * 4, BGI_OUT = I_OUT / 8, BGI_GU = NEXP * 2 * I_GU / 8, BGI_D = NEXP * I_D / 8;
constexpr int BG_C0 = BGI_SMALL + BGI_IN;
constexpr int BG_C1 = BG_C0 + BGI_GV0 + BGI_OUT;
constexpr int BG_C2 = BG_C1 + BGI_GU;
constexpr int BG_C3 = BG_C2 + BGI_D;
constexpr int BG_C3B = BG_C3 + BGI_GV1;
constexpr int BG_C4 = BG_C3B + BGI_IN;
constexpr int BG_C5 = BG_C4 + BGI_OUT;
constexpr int BG_C6 = BG_C5 + BGI_GU;
constexpr int BG_C7 = BG_C6 + BGI_D;
__device__ __forceinline__ float mod_at(const unsigned char* ws, const float* b_ada, int l, int j) {
    const float* p = (const float*)(ws + WS_MODP) + (size_t)l * 6 * DM + j;
    return *(const GAS float*)(b_ada + (size_t)l * 6 * DM + j) + ((*(const GAS float*)p + *(const GAS float*)(p + 2 * 6 * DM)) + (*(const GAS float*)(p + 4 * 6 * DM) + *(const GAS float*)(p + 6 * 6 * DM)));
}
__device__ __forceinline__ void gemv_item(const Frame& F, unsigned char* ws, int w) {
    LAS float* sc = (LAS float*)F.lds; LAS f32x4* red = (LAS f32x4*)(F.lds + 8192);
    const int kq = w & 3, l = w >> 9, cb = (w >> 2) & 127, c4 = F.tid % 24, kg = F.tid / 24;
    if (F.tid < 512) sc[F.tid] = silu_f(*(const GAS float*)(karg(1) + kq * 512 + F.tid));
    __syncthreads();
    f32x4 acc = (f32x4){0.f, 0.f, 0.f, 0.f};
    if (kg < 21) {
        const float* wp = karg(2) + (size_t)l * DM * 6 * DM + (size_t)(kq * 512) * 6 * DM + cb * 96 + c4 * 4;
#pragma unroll 8
        for (int k = kg; k < 512; k += 21) { const f32x4 wv = __builtin_nontemporal_load((const GAS f32x4*)(wp + (size_t)k * 6 * DM)); acc += wv * sc[k]; }
        red[kg * 24 + c4] = acc;
    }
    __syncthreads();
    if (F.tid < 24) { f32x4 s = red[F.tid];
        for (int g = 1; g < 21; ++g) s += red[g * 24 + F.tid];
        *(GAS f32x4*)((float*)(ws + WS_MODP) + (size_t)kq * 2 * 6 * DM + (size_t)l * 6 * DM + cb * 96 + F.tid * 4) = s; }
    __syncthreads();
}
__device__ __forceinline__ void conv_wave_item(const Frame& F, unsigned char* ws, int r, int l, LAS float* scr) {
    if (r < I_IN) { const int kb = r / (NZ / 32), nb = r % (NZ / 32);
        tr_item8(karg(6) + (size_t)l * DM * NIN + (size_t)(64 * kb) * NIN + 32 * nb, NIN, ws + WS_WIN + (size_t)l * NZ * DM + (size_t)(32 * nb) * DM + 64 * kb, DM, scr, F.lane); return; }
    r -= I_IN;
    if (r < I_OUT) { const int kb = r / (DM / 32), nb = r % (DM / 32);
        tr_item(karg(15) + (size_t)l * DM * DM + (size_t)(64 * kb) * DM + 32 * nb, DM, (bf16*)(ws + WS_WOUT) + (size_t)l * DM * DM + (size_t)(32 * nb) * DM + 64 * kb, DM, scr, F.lane); return; }
    r -= I_OUT;
    if (r < NEXP * 2 * I_GU) { const int e = r / (2 * I_GU); r -= e * 2 * I_GU; const int up = r >= I_GU; if (up) r -= I_GU; const int kb = r / (DEX / 32), nb = r % (DEX / 32), n0 = 32 * nb;
        const float* src = (up ? karg(19) : karg(18)) + ((size_t)l * NEXP + e) * DM * DEX + (size_t)(64 * kb) * DEX + n0;
        const int drow = (n0 >> 7) * 256 + (up ? 128 : 0) + (n0 & 127);
        tr_item8(src, DEX, ws + WS_WGU + ((size_t)l * NEXP + e) * DM * DM + (size_t)drow * DM + 64 * kb, DM, scr, F.lane); return; }
    r -= NEXP * 2 * I_GU;
    { const int e = r / I_D; r -= e * I_D; const int kb = r / (DM / 32), nb = r % (DM / 32);
      tr_item8(karg(20) + ((size_t)l * NEXP + e) * DEX * DM + (size_t)(64 * kb) * DM + 32 * nb, DM, ws + WS_WD + ((size_t)l * NEXP + e) * DM * DEX + (size_t)(32 * nb) * DEX + 64 * kb, DEX, scr, F.lane); }
}
__device__ __forceinline__ void bg_item(const Frame& F, unsigned char* ws, int t) {
    LAS float* scr = (LAS float*)(F.lds + 16384 + F.wave * 9216);
    if (t < BGI_SMALL) { const int r = t * 8 + F.wave, mat = r >> 3, q = r & 7, kb = q >> 2, nb = q & 3;
        tr_item(karg(10) + (size_t)mat * 128 * 128 + (size_t)(64 * kb) * 128 + 32 * nb, 128, (bf16*)(ws + WS_BWT) + (size_t)mat * 128 * 128 + (size_t)(32 * nb) * 128 + 64 * kb, 128, scr, F.lane); return; }
    t -= BGI_SMALL;
    if (t < BGI_IN) { conv_wave_item(F, ws, t * 8 + F.wave, 0, scr); return; }
    t -= BGI_IN;
    if (t < BGI_GV0) { gemv_item(F, ws, GV_FIRST * 4 + t); return; }
    t -= BGI_GV0;
    if (t < BGI_OUT + BGI_GU + BGI_D) { conv_wave_item(F, ws, I_IN + t * 8 + F.wave, 0, scr); return; }
    t -= BGI_OUT + BGI_GU + BGI_D;
    if (t < BGI_GV1) { gemv_item(F, ws, 512 + t); return; }
    t -= BGI_GV1;
    conv_wave_item(F, ws, t * 8 + F.wave, 1, scr);
}
__device__ __forceinline__ void bg_fill(const Frame& F0, int seam, int need) {
    unsigned char* const ws = opq(F0.ws); Frame F = F0; F.tid = opq_tid(F0.wave); F.lane = F.tid & 63; F.lds = opq(F0.lds);
    LAS unsigned* slot = (LAS unsigned*)(F.lds + AUX_OFF + 24576);
    gu32* const ctl_ = opq(F0.ctl); gu32* ticket = ctl_ + CW_BGT; gu32* arr = ctl_ + CW_ARR + 64 * seam;
    unsigned tn = 0xffffffffu; bool pre = false;
    if (F.tid == 0 && slot[1] == 0u) { (void)__hip_atomic_fetch_add(arr, 1u, RLX_AGENT); const unsigned cur = __hip_atomic_load(ticket, RLX_AGENT);
        if (cur >= (unsigned)BG_C7) slot[1] = 1u;
        else if (cur < (unsigned)need || __hip_atomic_load(arr, RLX_AGENT) < (unsigned)F.G) tn = __hip_atomic_fetch_add(ticket, 1u, RLX_AGENT); }
    for (;;) {
        if (F.tid == 0) slot[0] = tn;
        __syncthreads();
        const unsigned t = __builtin_amdgcn_readfirstlane(slot[0]);
        __syncthreads();
        if (t >= (unsigned)BG_C7) { if (F.tid == 0 && t != 0xffffffffu) slot[1] = 1u; break; }
        if (F.tid == 0) { tn = 0xffffffffu; pre = (t + 2u < (unsigned)need);
            if (pre) tn = __hip_atomic_fetch_add(ticket, 1u, RLX_AGENT); }
        bg_item(F, ws, (int)t);
        if (F.tid == 0 && !pre) { if (t + 1u < (unsigned)need || __hip_atomic_load(arr, RLX_AGENT) < (unsigned)F.G) tn = __hip_atomic_fetch_add(ticket, 1u, RLX_AGENT); }
    }
}
__device__ __forceinline__ void p0_prologue(const Frame& F0) {
    unsigned char* const ws = opq(F0.ws); Frame F = F0; F.tid = opq_tid(F0.wave); F.lane = F.tid & 63; F.lds = opq(F0.lds);
    for (int w = F.vcu; w < GV_FIRST * 4; w += F.G) gemv_item(F, ws, w);
    const float* const a_ws_ = karg(7);
    for (int i = (F.vcu * NTHR + F.tid) * 2; i < NLAYER * 4 * 128 * 128; i += F.G * NTHR * 2) {
        const int t = (i >> 7) & 127, s = i & 127;
        const f32x2 w = *(const GAS f32x2*)(a_ws_ + i);
        const bool keep = (s >> 6) <= (t >> 6);
        *(GAS unsigned*)((bf16*)(ws + WS_WM) + i) = keep ? cvt_pk_bf16(w.x, w.y) : 0u;
    }
}

template <int MODE>
__device__ __forceinline__ void phase_norm1(const Frame& F0, int l, const float* xin, float* xout, int lprev) {
    unsigned char* const ws = opq(F0.ws); Frame F = F0; F.tid = opq_tid(F0.wave); F.lane = F.tid & 63; F.lds = opq(F0.lds);
    LAS float* wfT = (LAS float*)F.lds;
    LAS float* gaL = (LAS float*)(F.lds + 65536);
    LAS float* gbL = (LAS float*)(F.lds + 73728);
    LAS float* g2L = (LAS float*)(F.lds + 81920);
    LAS float* lf = (LAS float*)(F.lds + 90112);
    LAS int* hb = (LAS int*)(F.lds + 91136);
    const float* const b_ada_ = karg(3); const float* const c_bf_ = karg(14);
    if (MODE != 2) {
        const float* const w_in_ = karg(6); const float* const g_mix_ = karg(4);
        for (int i = F.tid; i < DM * 2; i += NTHR) { const int d = i >> 1, half = i & 1;
            const f32x4 w = *(const GAS f32x4*)(w_in_ + (size_t)l * DM * NIN + (size_t)d * NIN + NZ + half * 4);
            wfT[(half * 4 + 0) * DM + d] = w.x; wfT[(half * 4 + 1) * DM + d] = w.y; wfT[(half * 4 + 2) * DM + d] = w.z; wfT[(half * 4 + 3) * DM + d] = w.w; }
        for (int d = F.tid; d < DM; d += NTHR) { gaL[d] = *(const GAS float*)(g_mix_ + (size_t)l * DM + d) * (1.f + mod_at(ws, b_ada_, l, DM + d)); gbL[d] = mod_at(ws, b_ada_, l, d); }
    }
    if (MODE != 0) {
        for (int d = F.tid; d < DM; d += NTHR) g2L[d] = mod_at(ws, b_ada_, lprev, 5 * DM + d);
        if (F.tid == 0) { int a = 0; for (int e = 0; e < NEXP; ++e) { hb[e] = a; a += ((int)__hip_atomic_load(F.ctl + CW_CNT + 64 * lprev + e, RLX_AGENT) + 255) & ~255; } }
    }
    __syncthreads();
    const bf16* YB = (const bf16*)(ws + WS_YB);
    f32x4 vA[8], vB[8]; u32x2 yA0[8], yA1[8], yB0[8], yB1[8];
#define N1_LOAD(V, Y0, Y1, rr) do { const int t_ = c * 32 + F.wave * 4 + (rr);                                                                 \
        _Pragma("unroll") for (int j = 0; j < 8; ++j) V[j] = *(const GAS f32x4*)(xin + (size_t)t_ * DM + 256 * j + 4 * F.lane);                   \
        if (MODE != 0) { const int r0_ = __builtin_amdgcn_readlane(rowA, (rr)), r1_ = __builtin_amdgcn_readlane(rowB, (rr));                      \
            _Pragma("unroll") for (int j = 0; j < 8; ++j) { const int d = 256 * j + 4 * F.lane;                                                    \
                Y0[j] = *(const GAS u32x2*)(YB + (size_t)r0_ * DM + d); Y1[j] = *(const GAS u32x2*)(YB + (size_t)r1_ * DM + d); } } } while (0)
#define N1_PROC(V, Y0, Y1, rr) do { const int rl = F.wave * 4 + (rr), t = c * 32 + rl;                                                          \
        if (MODE != 0) { const float w0 = __builtin_bit_cast(float, __builtin_amdgcn_readlane(__builtin_bit_cast(int, gwA), (rr))), w1 = __builtin_bit_cast(float, __builtin_amdgcn_readlane(__builtin_bit_cast(int, gwB), (rr))); \
            _Pragma("unroll") for (int j = 0; j < 8; ++j) { const int d = 256 * j + 4 * F.lane;                                                    \
                const f32x4 g2 = *(const LAS f32x4*)(g2L + d); const u32x2 y0 = Y0[j], y1 = Y1[j];                                                 \
                f32x4 y; y.x = w0 * bf_lo(y0.x) + w1 * bf_lo(y1.x); y.y = w0 * bf_hi(y0.x) + w1 * bf_hi(y1.x); y.z = w0 * bf_lo(y0.y) + w1 * bf_lo(y1.y); y.w = w0 * bf_hi(y0.y) + w1 * bf_hi(y1.y); \
                V[j] = V[j] + g2 * y;                                                                                                               \
                *(GAS f32x4*)(xout + (size_t)t * DM + d) = V[j]; } }                                                                               \
        if (MODE != 2) {                                                                                                                           \
            float ss = 0.f;                                                                                                                        \
            _Pragma("unroll") for (int j = 0; j < 8; ++j) ss += (V[j].x * V[j].x + V[j].y * V[j].y) + (V[j].z * V[j].z + V[j].w * V[j].w);         \
            const float rs = rsqrtf(wave_sum(ss) * (1.f / DM) + EPSN);                                                                             \
            float fz[8] = {0.f, 0.f, 0.f, 0.f, 0.f, 0.f, 0.f, 0.f};                                                                                \
            unsigned char* hrow = ws + WS_H + (size_t)t * DM;                                   \
            _Pragma("unroll") for (int j = 0; j < 8; ++j) { const int d = 256 * j + 4 * F.lane;                                                    \
                const f32x4 h = V[j] * rs * *(const LAS f32x4*)(gaL + d) + *(const LAS f32x4*)(gbL + d);                                           \
                *(GAS unsigned*)(hrow + d) = cvt_pk4_fp8(h.x * H8_SCALE, h.y * H8_SCALE, h.z * H8_SCALE, h.w * H8_SCALE);                          \
                _Pragma("unroll") for (int q = 0; q < 8; ++q) { const f32x4 w = *(const LAS f32x4*)(wfT + q * DM + d); fz[q] += (h.x * w.x + h.y * w.y) + (h.z * w.z + h.w * w.w); } } \
            _Pragma("unroll") for (int q = 0; q < 8; ++q) fz[q] = wave_sum(fz[q]);                                                                 \
            if (F.lane < 8) { float z = fz[0];                                                                                                     \
                _Pragma("unroll") for (int q = 1; q < 8; ++q) z = (F.lane == q) ? fz[q] : z;                                                       \
                z += *(const GAS float*)(c_bf_ + l * 8 + F.lane);                                                                                  \
                lf[rl * 8 + F.lane] = fminf(z, 0.f) - 0.6931471805599453f * __builtin_amdgcn_logf(1.f + __builtin_amdgcn_exp2f(-LOG2E * fabsf(z))); } } } while (0)
    for (int c = F.vcu; c < SEQ / 32; c += F.G) {
        int rowA = 0, rowB = 0; float gwA = 0.f, gwB = 0.f;
        if (MODE != 0) { const int t_ = c * 32 + F.wave * 4 + (F.lane & 3);
            const int* te = (const int*)(ws + WS_TOKE) + 2 * t_; const int* tp = (const int*)(ws + WS_TOKP) + 2 * t_; const float* tw = (const float*)(ws + WS_TOKW) + 2 * t_;
            rowA = hb[*(const GAS int*)te] + *(const GAS int*)tp; rowB = hb[*(const GAS int*)(te + 1)] + *(const GAS int*)(tp + 1); gwA = *(const GAS float*)tw; gwB = *(const GAS float*)(tw + 1); }
        N1_LOAD(vA, yA0, yA1, 0); N1_LOAD(vB, yB0, yB1, 1);
        N1_PROC(vA, yA0, yA1, 0); N1_LOAD(vA, yA0, yA1, 2);
        N1_PROC(vB, yB0, yB1, 1); N1_LOAD(vB, yB0, yB1, 3);
        N1_PROC(vA, yA0, yA1, 2); N1_PROC(vB, yB0, yB1, 3);
        if (MODE != 2) {
            __syncthreads();
            if (F.tid < 8) { float a = 0.f; float* floc = (float*)(ws + WS_FLOC);
                for (int r = 0; r < 32; ++r) { a += lf[r * 8 + F.tid]; *(GAS float*)(floc + (size_t)(c * 32 + r) * 8 + F.tid) = a; }
                *(GAS float*)((float*)(ws + WS_TOT) + c * 8 + F.tid) = a; }
            __syncthreads();
        }
    }
#undef N1_LOAD
#undef N1_PROC
}

__device__ __forceinline__ void fkl_fixup(const Frame& F0) {
    unsigned char* const ws = opq(F0.ws); Frame F = F0; F.tid = opq_tid(F0.wave); F.lane = F.tid & 63; F.lds = opq(F0.lds);
    LAS float* preL = (LAS float*)(F.lds + AUX_OFF + 8192);
    const float* tot = (const float*)(ws + WS_TOT);
    for (int c = F.vcu; c < SEQ / 32; c += F.G) {
        { const int h = F.wave; double s = 0.0;
#pragma unroll
            for (int q = 0; q < 4; ++q) { const int cc = 4 * F.lane + q; if (cc < c) s += (double)*(const GAS float*)(tot + cc * 8 + h); }
            float hi_ = (float)s, lo_ = (float)(s - (double)hi_);
            hi_ = wave_sum(hi_); lo_ = wave_sum(lo_);
            if (F.lane == 0) preL[h] = hi_ + lo_; }
        __syncthreads();
        if (F.tid < 256) { const int r = F.tid >> 3, h = F.tid & 7, t = c * 32 + r;
            *(GAS float*)((float*)(ws + WS_FKL) + (size_t)h * SEQ + t) = (preL[h] + *(const GAS float*)((const float*)(ws + WS_FLOC) + (size_t)t * 8 + h)) * -11.313708498984761f; }
        __syncthreads();
    }
}

__device__ __forceinline__ void phase_small_item(const Frame& F0, int l, int item) {
    unsigned char* const ws = opq(F0.ws); Frame F = F0; F.tid = opq_tid(F0.wave); F.lane = F.tid & 63; F.lds = opq(F0.lds);
    const int fr = F.lane & 15, fq = F.lane >> 4, w = F.wave;
    const bf16* Z = (const bf16*)(ws + WS_Z); bf16* YC = (bf16*)(ws + WS_YCAT);
    f32x4 acc[8];
#pragma unroll
    for (int m = 0; m < 8; ++m) acc[m] = (f32x4){0.f, 0.f, 0.f, 0.f};
    const float* a_bs_ = opq(karg(8)); const float* b_scale_ = opq(karg(11));
    if (item < 256) {
        const int blk = item >> 2, h = item & 3;
        const bf16* VN = (const bf16*)(ws + WS_VN) + (size_t)(blk * 128) * 512 + h * 128 + 16 * w + fr;
        const bf16* WM = (const bf16*)(ws + WS_WM) + ((size_t)(l * 4 + h) * 128) * 128;
        bf16x8 yb[4];
#pragma unroll
        for (int ks = 0; ks < 4; ++ks)
#pragma unroll
            for (int j = 0; j < 8; ++j) yb[ks][j] = (short)*(const GAS bf16*)(VN + (size_t)(ks * 32 + 8 * fq + j) * 512);
#pragma unroll
        for (int m = 0; m < 8; ++m)
#pragma unroll
            for (int ks = 0; ks < 4; ++ks) { const bf16x8 xa = *(const GAS bf16x8*)(WM + (size_t)(16 * m + fr) * 128 + ks * 32 + 8 * fq);
                acc[m] = __builtin_amdgcn_mfma_f32_16x16x32_bf16(yb[ks], xa, acc[m], 0, 0, 0); }
#pragma unroll
        for (int m = 0; m < 8; ++m) { const int tl = 16 * m + fr, t = blk * 128 + tl, col = h * 128 + 16 * w + 4 * fq;
            const float bsv = *(const GAS float*)(a_bs_ + l * 512 + h * 128 + tl);
            const u32x2 u = *(const GAS u32x2*)(Z + (size_t)t * NZ + col);
            u32x2 o; o.x = cvt_pk_bf16(bf_lo(u.x) * (acc[m][0] + bsv), bf_hi(u.x) * (acc[m][1] + bsv)); o.y = cvt_pk_bf16(bf_lo(u.y) * (acc[m][2] + bsv), bf_hi(u.y) * (acc[m][3] + bsv));
            *(GAS u32x2*)(YC + (size_t)t * DM + col) = o; }
    } else {
        const int rb = (item - 256) >> 2, g = (item - 256) & 3;
        const int wnd = 2 << g, r0 = rb * 128;
        LAS bf16* pt = (LAS bf16*)(F.lds + 86016);
        LAS bf16* dt = (LAS bf16*)F.lds;
        __syncthreads();
        for (int i = F.tid; i < 144 * 16; i += NTHR) { const int rr = i >> 4, cc = (i & 15) * 8, tg = r0 - 16 + rr;
            u32x4 v = (u32x4){0u, 0u, 0u, 0u}; if (tg >= 0) v = *(const GAS u32x4*)(Z + (size_t)tg * NZ + 1024 + g * 128 + cc);
            *(LAS u32x4*)(pt + rr * 128 + cc) = v; }
        __syncthreads();
        { const int c = F.tid & 127, rg = F.tid >> 7;
            float sum = 0.f;
            for (int j = 1; j < wnd; ++j) sum += bf_lo((unsigned)pt[(16 + 32 * rg - j) * 128 + c]);
            for (int i = 0; i < 32; ++i) { const int tl = 32 * rg + i, tg = r0 + tl; const float pv = bf_lo((unsigned)pt[(16 + tl) * 128 + c]);
                sum += pv;
                const float cnt = (float)((tg + 1 < wnd) ? (tg + 1) : wnd);
                const float dv = sum / cnt - pv;
                dt[tl * 136 + c] = (bf16)(cvt_pk_bf16(dv, 0.f) & 0xffffu);
                sum -= bf_lo((unsigned)pt[(16 + tl - (wnd - 1)) * 128 + c]); } }
        __syncthreads();
        const bf16* BWT = (const bf16*)(ws + WS_BWT) + ((size_t)(l * 4 + g) * 128) * 128;
        bf16x8 yb[4];
#pragma unroll
        for (int ks = 0; ks < 4; ++ks) yb[ks] = *(const GAS bf16x8*)(BWT + (size_t)(16 * w + fr) * 128 + ks * 32 + 8 * fq);
#pragma unroll
        for (int m = 0; m < 8; ++m)
#pragma unroll
            for (int ks = 0; ks < 4; ++ks) { const bf16x8 xa = *(const LAS bf16x8*)(dt + (16 * m + fr) * 136 + ks * 32 + 8 * fq);
                acc[m] = __builtin_amdgcn_mfma_f32_16x16x32_bf16(yb[ks], xa, acc[m], 0, 0, 0); }
        __syncthreads();
        const f32x4 bsc = *(const GAS f32x4*)(b_scale_ + l * 512 + g * 128 + 16 * w + 4 * fq);
#pragma unroll
        for (int m = 0; m < 8; ++m) { const int t = rb * 128 + 16 * m + fr, col = 512 + g * 128 + 16 * w + 4 * fq;
            u32x2 o; o.x = cvt_pk_bf16(acc[m][0] * bsc.x, acc[m][1] * bsc.y); o.y = cvt_pk_bf16(acc[m][2] * bsc.z, acc[m][3] * bsc.w);
            *(GAS u32x2*)(YC + (size_t)t * DM + col) = o; }
    }
}

__device__ __forceinline__ void phase_norm2_route(const Frame& F0, int l) {
    unsigned char* const ws = opq(F0.ws); Frame F = F0; F.tid = opq_tid(F0.wave); F.lane = F.tid & 63; F.lds = opq(F0.lds);
    LAS float* wrT = (LAS float*)F.lds;
    LAS float* gaL = (LAS float*)(F.lds + AUX_OFF);
    LAS float* gbL = (LAS float*)(F.lds + AUX_OFF + 8192);
    LAS int* lcnt = (LAS int*)(F.lds + AUX_OFF + 16384);
    const float* const w_router_ = karg(16); const float* const g_ffn_ = karg(5); const float* const b_ada_ = karg(3); const float* const b_router_ = karg(17);
    for (int i = F.tid; i < DM * 4; i += NTHR) { const int d = i >> 2, q = i & 3;
        const f32x4 w = *(const GAS f32x4*)(w_router_ + (size_t)d * 16 + q * 4);
        wrT[(q * 4 + 0) * DM + d] = w.x; wrT[(q * 4 + 1) * DM + d] = w.y; wrT[(q * 4 + 2) * DM + d] = w.z; wrT[(q * 4 + 3) * DM + d] = w.w; }
    for (int d = F.tid; d < DM; d += NTHR) { gaL[d] = *(const GAS float*)(g_ffn_ + (size_t)l * DM + d) * (1.f + mod_at(ws, b_ada_, l, 4 * DM + d)); gbL[d] = mod_at(ws, b_ada_, l, 3 * DM + d); }
    const float* X1 = (const float*)(ws + WS_X1);
    float brt[16];
#pragma unroll
    for (int e = 0; e < 16; ++e) brt[e] = *(const GAS float*)(b_router_ + e);
    for (int c = F.vcu; c < SEQ / 32; c += F.G) {
        if (F.tid < 32) lcnt[F.tid] = 0;
        __syncthreads();
        int my_e0 = 0, my_e1 = 0, my_r0 = 0, my_r1 = 0; float my_w0 = 0.f, my_w1 = 0.f;
        f32x4 vA[8], vB[8];
#define N2_LOAD(V, rr) do { const int t_ = c * 32 + F.wave * 4 + (rr); _Pragma("unroll") for (int j = 0; j < 8; ++j) V[j] = *(const GAS f32x4*)(X1 + (size_t)t_ * DM + 256 * j + 4 * F.lane); } while (0)
#define N2_PROC(V, rr) do { const int t = c * 32 + F.wave * 4 + (rr);                                                                           \
            float ss = 0.f;                                                                                                                        \
            _Pragma("unroll") for (int j = 0; j < 8; ++j) ss += (V[j].x * V[j].x + V[j].y * V[j].y) + (V[j].z * V[j].z + V[j].w * V[j].w);         \
            const float rs = rsqrtf(wave_sum(ss) * (1.f / DM) + EPSN);                                                                             \
            float lg[16];                                                                                                                          \
            _Pragma("unroll") for (int e = 0; e < 16; ++e) lg[e] = 0.f;                                                                            \
            unsigned char* hrow = ws + WS_H + (size_t)t * DM;                          \
            _Pragma("unroll") for (int j = 0; j < 8; ++j) { const int d = 256 * j + 4 * F.lane;                                                    \
                const f32x4 h = V[j] * rs * *(const LAS f32x4*)(gaL + d) + *(const LAS f32x4*)(gbL + d);                                           \
                *(GAS unsigned*)(hrow + d) = cvt_pk4_fp8(h.x * H8_SCALE, h.y * H8_SCALE, h.z * H8_SCALE, h.w * H8_SCALE);                          \
                _Pragma("unroll") for (int e = 0; e < 16; ++e) { const f32x4 w = *(const LAS f32x4*)(wrT + e * DM + d); lg[e] += (h.x * w.x + h.y * w.y) + (h.z * w.z + h.w * w.w); } } \
            _Pragma("unroll") for (int e = 0; e < 16; ++e) lg[e] = wave_sum(lg[e]);                                                                \
            float sc[16], sel[16];                                                                                                                 \
            _Pragma("unroll") for (int e = 0; e < 16; ++e) { sc[e] = __builtin_amdgcn_rcpf(1.f + __builtin_amdgcn_exp2f(-LOG2E * lg[e])); sel[e] = sc[e] + brt[e]; }                      \
            int bg = 0; float bgs = -INFINITY;                                                                                                     \
            _Pragma("unroll") for (int g = 0; g < 4; ++g) { float a = -INFINITY, b = -INFINITY;                                                    \
                _Pragma("unroll") for (int i = 0; i < 4; ++i) { const float x = sel[g * 4 + i]; if (x > a) { b = a; a = x; } else if (x > b) b = x; } \
                if (a + b > bgs) { bgs = a + b; bg = g; } }                                                                                        \
            int e0 = 0, e1 = 0; float a = -INFINITY, b = -INFINITY, s0 = 0.f, s1 = 0.f;                                                            \
            _Pragma("unroll") for (int g = 0; g < 4; ++g)                                                                                          \
                _Pragma("unroll") for (int i = 0; i < 4; ++i) { const int e = g * 4 + i; const float x = sel[e];                                   \
                    if (g == bg) { if (x > a) { b = a; e1 = e0; s1 = s0; a = x; e0 = e; s0 = sc[e]; } else if (x > b) { b = x; e1 = e; s1 = sc[e]; } } } \
            const float inv = 1.f / (s0 + s1);                                                                                                     \
            if (F.lane == (rr)) { my_e0 = e0; my_e1 = e1; my_w0 = s0 * inv; my_w1 = s1 * inv; } } while (0)
        N2_LOAD(vA, 0);
#pragma unroll 1
        for (int rp = 0; rp < 2; ++rp) {
            N2_LOAD(vB, 2 * rp + 1);
            N2_PROC(vA, 2 * rp);
            if (rp == 0) N2_LOAD(vA, 2);
            N2_PROC(vB, 2 * rp + 1);
        }
        if (F.lane < 4) { my_r0 = __hip_atomic_fetch_add(&lcnt[my_e0], 1, __ATOMIC_RELAXED, __HIP_MEMORY_SCOPE_WORKGROUP); my_r1 = __hip_atomic_fetch_add(&lcnt[my_e1], 1, __ATOMIC_RELAXED, __HIP_MEMORY_SCOPE_WORKGROUP); }
        __syncthreads();
        if (F.tid < 16) lcnt[16 + F.tid] = (int)__hip_atomic_fetch_add(F.ctl + CW_CNT + 64 * l + F.tid, (unsigned)lcnt[F.tid], RLX_AGENT);
        __syncthreads();
        if (F.lane < 4) { const int t = c * 32 + F.wave * 4 + F.lane;
            const int p0 = lcnt[16 + my_e0] + my_r0, p1 = lcnt[16 + my_e1] + my_r1;
            int* list = (int*)(ws + WS_LIST);
            *(GAS int*)(list + my_e0 * SEQ + p0) = t; *(GAS int*)(list + my_e1 * SEQ + p1) = t;
            *(GAS int*)((int*)(ws + WS_TOKE) + 2 * t) = my_e0; *(GAS int*)((int*)(ws + WS_TOKE) + 2 * t + 1) = my_e1;
            *(GAS int*)((int*)(ws + WS_TOKP) + 2 * t) = p0; *(GAS int*)((int*)(ws + WS_TOKP) + 2 * t + 1) = p1;
            *(GAS float*)((float*)(ws + WS_TOKW) + 2 * t) = my_w0; *(GAS float*)((float*)(ws + WS_TOKW) + 2 * t + 1) = my_w1; }
        __syncthreads();
    }
#undef N2_LOAD
#undef N2_PROC
}

struct MoeOrder {
    int G, c, total, K, nct; const char* Bt; size_t estride; const int* list; LAS int* tab;
    __device__ __forceinline__ bool next(int i, gm::Unit& u) const {
        const int L = i * G + c; if (L >= total) return false;
        const int q = L / nct, ct = L - q * nct;
        int e = 0;
#pragma unroll
        for (int k = 1; k < NEXP; ++k) e += (q >= tab[k]) ? 1 : 0;
        e = __builtin_amdgcn_readfirstlane(e);
        const int rt = q - __builtin_amdgcn_readfirstlane(tab[e]);
        u.e = e; u.rt = rt; u.arow = (__builtin_amdgcn_readfirstlane(tab[e]) + rt) * 256; u.orow = u.arow; u.ocol = ct * 256;
        u.Bp = Bt + (size_t)e * estride + (size_t)ct * 256 * K * 2; return true;
    }
    __device__ __forceinline__ int row_of(const gm::Unit& u, int r) const {
        const int p = u.rt * 256 + r, n = tab[32 + u.e], pc = p < n ? p : n - 1;
        const int v = *(const GAS int*)(list + u.e * SEQ + pc);
        return (p < n) ? v : 0;
    }
};
__device__ __forceinline__ void moe_table(const Frame& F, int l, LAS int* tab) {
    __syncthreads();
    if (F.tid == 0) { int a = 0;
        for (int e = 0; e < NEXP; ++e) { const int n = (int)__hip_atomic_load(F.ctl + CW_CNT + 64 * l + e, RLX_AGENT); tab[e] = a; tab[32 + e] = n; a += (n + 255) >> 8; }
        tab[16] = a; }
    __syncthreads();
}

constexpr int ATT_CH = 16;
struct MixTab { LAS int* jlo; LAS int* items; LAS int* nitems; LAS float* fend; LAS int* scan; };
__device__ __forceinline__ MixTab mix_tab_ptrs(LAS unsigned char* lds) {
    MixTab T; T.jlo = (LAS int*)(lds + 69632); T.items = (LAS int*)(lds + 69632 + 1024); T.nitems = (LAS int*)(lds + 69632 + 1024 + 8192); T.fend = (LAS float*)(lds + 69632 + 1024 + 8192 + 64);
    T.scan = (LAS int*)(lds + 69632 + 1024 + 8192 + 64 + 4096); return T;
}
__device__ __forceinline__ void mix_build_table(const Frame& F0, int l, const MixTab& T) {
    unsigned char* const ws = opq(F0.ws); const int tid = opq_tid(F0.wave);
    const float* FKL = (const float*)(ws + WS_FKL);
    for (int i = tid; i < 1024; i += NTHR) T.fend[i] = *(const GAS float*)(FKL + (size_t)(i >> 7) * SEQ + (i & 127) * 64 + 63);
    float gq = 0.f, gk = 0.f; const float* const c_qg_ = karg(12); const float* const c_kg_ = karg(13);
    { const int ln = tid & 63; gq = fmaxf(fabsf(*(const GAS float*)(c_qg_ + l * 128 + ln)), fabsf(*(const GAS float*)(c_qg_ + l * 128 + 64 + ln))); gk = fmaxf(fabsf(*(const GAS float*)(c_kg_ + l * 128 + ln)), fabsf(*(const GAS float*)(c_kg_ + l * 128 + 64 + ln)));
      gq = wave_max(gq); gk = wave_max(gk); }
    const float thr = (2.f * 1.01f * 11.313708498984761f * gq * gk + 30.f) * 11.313708498984761f;
    __syncthreads();
    int nfull = 0, nrem = 0, jl = 0, nt = 0;
    if (tid < 256) { const int h = tid >> 5, qb = tid & 31; const float f0 = *(const GAS float*)(FKL + (size_t)h * SEQ + qb * 256);
        for (int j = 0; j < 4 * qb; ++j) jl += (T.fend[h * 128 + j] - f0 <= -thr) ? 1 : 0;
        nt = 4 * (qb + 1) - jl; nfull = nt / ATT_CH; nrem = (nt % ATT_CH) ? 1 : 0; T.jlo[tid] = jl | ((nfull + nrem) << 8); }
    if (tid < 256) { T.scan[tid] = nfull; T.scan[256 + tid] = nrem; }
    __syncthreads();
    for (int o = 1; o < 256; o <<= 1) { int a = 0, b = 0; if (tid < 256 && tid >= o) { a = T.scan[tid - o]; b = T.scan[256 + tid - o]; } __syncthreads();
        if (tid < 256) { T.scan[tid] += a; T.scan[256 + tid] += b; } __syncthreads(); }
    if (tid < 256) { const int totf = T.scan[255], pf = T.scan[tid] - nfull, pr = totf + T.scan[256 + tid] - nrem, jb = 4 * ((tid & 31) + 1);
        for (int c = 0; c < nfull; ++c) T.items[pf + c] = tid | (c << 8) | ((jb - (c + 1) * ATT_CH) << 12) | (ATT_CH << 20);
        if (nrem) T.items[pr] = tid | (nfull << 8) | (jl << 12) | ((nt - nfull * ATT_CH) << 20);
        if (tid == 255) T.nitems[0] = totf + T.scan[511]; }
    __syncthreads();
}
__device__ __forceinline__ void phase_attn_combine(const Frame& F0, int l, const MixTab& T) {
    unsigned char* const ws = opq(F0.ws); const int tid = opq_tid(F0.wave);
    const bf16* PART = (const bf16*)(ws + WS_PART); const float* MLb = (const float*)(ws + WS_ML); bf16* YC = (bf16*)(ws + WS_YCAT);
    for (int b = F0.vcu; b < 256; b += F0.G) {
        const int nch = __builtin_amdgcn_readfirstlane(T.jlo[b]) >> 8; if (nch <= 1) continue;
        const int h = b >> 5, qb = b & 31, row = tid >> 1, half = tid & 1;
        float m[8], w[8], mx = -3.0e38f, ws_ = 0.f;
#pragma unroll
        for (int c = 0; c < 8; ++c) { if (c < nch) { const f32x2 v = *(const GAS f32x2*)(MLb + ((size_t)(b * 8 + c) * 256 + row) * 2); m[c] = v.x; w[c] = v.y; mx = fmaxf(mx, v.x); } else { m[c] = -3.0e38f; w[c] = 0.f; } }
#pragma unroll
        for (int c = 0; c < 8; ++c) { w[c] = (c < nch) ? w[c] * __builtin_amdgcn_exp2f((m[c] - mx) * at::C2) : 0.f; ws_ += w[c]; }
        const float inv = 1.f / ws_;
        float acc[64];
#pragma unroll
        for (int i = 0; i < 64; ++i) acc[i] = 0.f;
#pragma unroll
        for (int c = 0; c < 8; ++c) { if (c < nch) { const bf16* p = PART + ((size_t)(b * 8 + c) * 256 + row) * 128 + half * 64; const float wc = w[c] * inv;
#pragma unroll
            for (int q = 0; q < 8; ++q) { const u32x4 v = *(const GAS u32x4*)(p + q * 8);
                acc[q * 8 + 0] += wc * bf_lo(v.x); acc[q * 8 + 1] += wc * bf_hi(v.x); acc[q * 8 + 2] += wc * bf_lo(v.y); acc[q * 8 + 3] += wc * bf_hi(v.y);
                acc[q * 8 + 4] += wc * bf_lo(v.z); acc[q * 8 + 5] += wc * bf_hi(v.z); acc[q * 8 + 6] += wc * bf_lo(v.w); acc[q * 8 + 7] += wc * bf_hi(v.w); } } }
        bf16* o = YC + (size_t)(qb * 256 + row) * DM + 1024 + h * 128 + half * 64;
#pragma unroll
        for (int q = 0; q < 8; ++q) { u32x4 v; v.x = cvt_pk_bf16(acc[q * 8 + 0], acc[q * 8 + 1]); v.y = cvt_pk_bf16(acc[q * 8 + 2], acc[q * 8 + 3]); v.z = cvt_pk_bf16(acc[q * 8 + 4], acc[q * 8 + 5]); v.w = cvt_pk_bf16(acc[q * 8 + 6], acc[q * 8 + 7]);
            *(GAS u32x4*)(o + q * 8) = v; }
    }
}

struct MoeDynOrder {
    int total, K; const char* Bt; size_t estride; LAS int* tab; gu32* ticket; gu32* ready; gu32* tmo; LAS unsigned* slot;
    __device__ __forceinline__ bool next(int, gm::Unit& u) const {
        if (__builtin_amdgcn_readfirstlane(threadIdx.x >> 6) == 0) {
            unsigned T = 0u;
            if ((threadIdx.x & 63) == 0) T = __hip_atomic_fetch_add(ticket, 1u, RLX_AGENT);
            T = __builtin_amdgcn_readfirstlane(T);
            if (T < (unsigned)total) {
                gu32* w = ready + 16 * (T >> 3); unsigned sp = 0u;
                while ((unsigned)__builtin_amdgcn_readfirstlane(__hip_atomic_load(w, RLX_AGENT)) < 64u) {
                    __builtin_amdgcn_s_sleep(2);
                    if ((++sp & 255u) == 0u) { if (__hip_atomic_load(tmo, RLX_AGENT) != 0u) break; if (sp > (1u << 20)) { __hip_atomic_store(tmo, 1u, RLX_AGENT); break; } } }
                __builtin_amdgcn_fence(__ATOMIC_ACQUIRE, "agent");
                asm volatile("s_waitcnt vmcnt(0)" ::: "memory");
            }
            if ((threadIdx.x & 63) == 0) slot[0] = T;
        }
        asm volatile("s_waitcnt lgkmcnt(0)" ::: "memory"); __builtin_amdgcn_s_barrier(); asm volatile("" ::: "memory");
        const unsigned T = (unsigned)__builtin_amdgcn_readfirstlane((int)slot[0]);
        if (T >= (unsigned)total) return false;
        const int q = (int)(T >> 3), ct = (int)(T & 7);
        int e = 0;
#pragma unroll
        for (int k = 1; k < NEXP; ++k) e += (q >= tab[k]) ? 1 : 0;
        e = __builtin_amdgcn_readfirstlane(e);
        u.e = e; u.rt = q - __builtin_amdgcn_readfirstlane(tab[e]); u.arow = q * 256; u.orow = u.arow; u.ocol = ct * 256;
        u.Bp = Bt + (size_t)e * estride + (size_t)ct * 256 * K * 2; return true;
    }
    __device__ __forceinline__ int row_of(const gm::Unit&, int) const { return 0; }
};
struct EpiZ {
    static constexpr bool PERM = true;
    unsigned char* wsb; int l; LAS float* Pt0;
    __device__ __forceinline__ void operator()(f32x4 (&acc)[2][2][4][2], const gm::Unit& u, int wr, int wc, int fr0, int fq0) const {
        int fr = fr0, fq = fq0; asm volatile("" : "+v"(fr), "+v"(fq));
        unsigned char* const ws = opq(wsb); LAS float* const Pt = opq(Pt0);
        bf16* const O = (bf16*)(ws + WS_Z); bf16* const QN = (bf16*)(ws + WS_QN); bf16* const KN = (bf16*)(ws + WS_KN); bf16* const VN = (bf16*)(ws + WS_VN);
        const int row0 = u.orow + wr * 64 + fr, col0 = u.ocol + wc * 32 + 8 * fq;
        const bool isv = (u.ocol >= 512 && u.ocol < 1024), isq = (u.ocol >= 1536 && u.ocol < 2560), isk = (u.ocol >= 2560 && u.ocol < 3584);
        if (u.ocol < 1024) {
#pragma unroll
            for (int ai = 0; ai < 2; ++ai)
#pragma unroll
                for (int bj = 0; bj < 2; ++bj)
#pragma unroll
                    for (int m = 0; m < 4; ++m)
#pragma unroll
                        for (int n = 0; n < 2; ++n)
#pragma unroll
                            for (int j = 0; j < 4; ++j) acc[ai][bj][m][n][j] = gelu_t(acc[ai][bj][m][n][j]);
        }
        if (isv || isq || isk) {
#pragma unroll
            for (int ai = 0; ai < 2; ++ai)
#pragma unroll
                for (int m = 0; m < 4; ++m)
#pragma unroll
                    for (int bj = 0; bj < 2; ++bj) { const f32x4 a = acc[ai][bj][m][0], b = acc[ai][bj][m][1];
                        float ss = (a[0] * a[0] + a[1] * a[1]) + (a[2] * a[2] + a[3] * a[3]) + (b[0] * b[0] + b[1] * b[1]) + (b[2] * b[2] + b[3] * b[3]);
                        ss += xor_f<16>(ss);
                        { auto rr = __builtin_amdgcn_permlane32_swap(__float_as_uint(ss), __float_as_uint(ss), false, false); ss = __uint_as_float(rr[0]) + __uint_as_float(rr[1]); }
                        if (fq == 0) Pt[((ai * 128 + wr * 64 + m * 16 + fr) * 2 + bj) * 4 + wc] = ss; }
            asm volatile("s_waitcnt lgkmcnt(0)" ::: "memory"); __builtin_amdgcn_s_barrier(); asm volatile("" ::: "memory");
            const float* gp = isv ? karg(9) + l * 512 + (u.ocol - 512) + wc * 32 + 8 * fq : karg(isq ? 12 : 13) + l * 128 + wc * 32 + 8 * fq;
#pragma unroll
            for (int bj = 0; bj < 2; ++bj) {
                const f32x4 g0 = *(const GAS f32x4*)(gp + (isv ? bj * 128 : 0)), g1 = *(const GAS f32x4*)(gp + (isv ? bj * 128 : 0) + 4);
#pragma unroll
                for (int ai = 0; ai < 2; ++ai)
#pragma unroll
                    for (int m = 0; m < 4; ++m) { const int rl = ai * 128 + wr * 64 + m * 16 + fr, row = u.orow + rl;
                        const f32x4 p4 = *(const LAS f32x4*)(Pt + (rl * 2 + bj) * 4);
                        const float rs = rsqrtf(((p4[0] + p4[1]) + (p4[2] + p4[3])) * (1.f / 128.f) + EPSN);
                        const f32x4 v0 = acc[ai][bj][m][0] * rs * g0, v1 = acc[ai][bj][m][1] * rs * g1;
                        u32x4 w; w.x = cvt_pk_bf16(v0[0], v0[1]); w.y = cvt_pk_bf16(v0[2], v0[3]); w.z = cvt_pk_bf16(v1[0], v1[1]); w.w = cvt_pk_bf16(v1[2], v1[3]);
                        bf16* dst;
                        if (isv) dst = VN + (size_t)row * 512 + (u.ocol - 512) + bj * 128 + wc * 32 + 8 * fq;
                        else { const int h = ((u.ocol - (isq ? 1536 : 2560)) >> 7) + bj; dst = (isq ? QN : KN) + ((size_t)h * SEQ + row) * 128 + wc * 32 + 8 * fq; }
                        *(GAS u32x4*)dst = w; } }
            return;
        }
#pragma unroll
        for (int ai = 0; ai < 2; ++ai)
#pragma unroll
            for (int m = 0; m < 4; ++m) { bf16* rowp = O + (size_t)(row0 + ai * 128 + m * 16) * NZ + col0;
#pragma unroll
                for (int bj = 0; bj < 2; ++bj) { const f32x4 v0 = acc[ai][bj][m][0], v1 = acc[ai][bj][m][1];
                    u32x4 w; w.x = cvt_pk_bf16(v0[0], v0[1]); w.y = cvt_pk_bf16(v0[2], v0[3]); w.z = cvt_pk_bf16(v1[0], v1[1]); w.w = cvt_pk_bf16(v1[2], v1[3]);
                    *(GAS u32x4*)(rowp + bj * 128) = w; } }
    }
};
struct EpiRes {
    static constexpr bool PERM = false;
    const float* xin; const LAS float* gate; float* out;
    __device__ __forceinline__ void operator()(const f32x4 (&acc)[2][2][4][2], const gm::Unit& u, int wr, int wc, int fr, int fq) const {
        const int row0 = u.orow + wr * 64 + fr, col0 = u.ocol + wc * 32 + 4 * fq;
        f32x4 gv[2][2];
#pragma unroll
        for (int bj = 0; bj < 2; ++bj)
#pragma unroll
            for (int n = 0; n < 2; ++n) gv[bj][n] = *(const LAS f32x4*)(gate + col0 + bj * 128 + n * 16);
#pragma unroll
        for (int ai = 0; ai < 2; ++ai)
#pragma unroll
            for (int m = 0; m < 4; ++m) { const size_t off = (size_t)(row0 + ai * 128 + m * 16) * DM + col0;
#pragma unroll
                for (int bj = 0; bj < 2; ++bj)
#pragma unroll
                    for (int n = 0; n < 2; ++n) { const f32x4 xv = *(const GAS f32x4*)(xin + off + bj * 128 + n * 16);
                        *(GAS f32x4*)(out + off + bj * 128 + n * 16) = xv + gv[bj][n] * acc[ai][bj][m][n]; } }
    }
};
struct EpiHid {
    static constexpr bool PERM = true;
    bf16* O;
    __device__ __forceinline__ void operator()(const f32x4 (&acc)[2][2][4][2], const gm::Unit& u, int wr, int wc, int fr, int fq) const {
        const int row0 = u.orow + wr * 64 + fr, col0 = (u.ocol >> 1) + wc * 32 + 8 * fq;
#pragma unroll
        for (int ai = 0; ai < 2; ++ai)
#pragma unroll
            for (int m = 0; m < 4; ++m) { bf16* rowp = O + (size_t)(row0 + ai * 128 + m * 16) * DEX + col0;
                f32x4 h0, h1;
#pragma unroll
                for (int j = 0; j < 4; ++j) { h0[j] = silu_f(acc[ai][0][m][0][j]) * acc[ai][1][m][0][j]; h1[j] = silu_f(acc[ai][0][m][1][j]) * acc[ai][1][m][1][j]; }
                u32x4 w; w.x = cvt_pk_bf16(h0[0], h0[1]); w.y = cvt_pk_bf16(h0[2], h0[3]); w.z = cvt_pk_bf16(h1[0], h1[1]); w.w = cvt_pk_bf16(h1[2], h1[3]);
                *(GAS u32x4*)rowp = w; }
    }
};
struct EpiHidPub {
    static constexpr bool PERM = true;
    unsigned char* O; gu32* ready;
    __device__ __forceinline__ void operator()(const f32x4 (&acc)[2][2][4][2], const gm::Unit& u, int wr, int wc, int fr, int fq) const {
        const __amdgpu_buffer_rsrc_t rs = __builtin_amdgcn_make_buffer_rsrc(O, (short)0, (int)(HIDROWS * DEX), 0x00020000);
        const int row0 = u.orow + wr * 64 + fr, col0 = (u.ocol >> 1) + wc * 32 + 8 * fq;
#pragma unroll
        for (int ai = 0; ai < 2; ++ai)
#pragma unroll
            for (int m = 0; m < 4; ++m) { const int off = (row0 + ai * 128 + m * 16) * DEX + col0;
                f32x4 h0, h1;
#pragma unroll
                for (int j = 0; j < 4; ++j) { h0[j] = HID8_SCALE * silu_f(acc[ai][0][m][0][j]) * acc[ai][1][m][0][j]; h1[j] = HID8_SCALE * silu_f(acc[ai][0][m][1][j]) * acc[ai][1][m][1][j]; }
                u32x2 w; w.x = cvt_pk4_fp8(h0[0], h0[1], h0[2], h0[3]); w.y = cvt_pk4_fp8(h1[0], h1[1], h1[2], h1[3]);
                __builtin_amdgcn_raw_buffer_store_b64(w, rs, off, 0, 16); }
        asm volatile("s_waitcnt vmcnt(0)" ::: "memory");
        if (fr == 0 && fq == 0) (void)__hip_atomic_fetch_add(ready + 16 * (u.orow >> 8), 1u, RLX_AGENT);
    }
};
struct EpiYB {
    static constexpr bool PERM = true;
    bf16* O;
    __device__ __forceinline__ void operator()(const f32x4 (&acc)[2][2][4][2], const gm::Unit& u, int wr, int wc, int fr, int fq) const {
        const int row0 = u.orow + wr * 64 + fr, col0 = u.ocol + wc * 32 + 8 * fq;
#pragma unroll
        for (int ai = 0; ai < 2; ++ai)
#pragma unroll
            for (int m = 0; m < 4; ++m) { bf16* rowp = O + (size_t)(row0 + ai * 128 + m * 16) * DM + col0;
#pragma unroll
                for (int bj = 0; bj < 2; ++bj) { const f32x4 v0 = acc[ai][bj][m][0], v1 = acc[ai][bj][m][1];
                    u32x4 w; w.x = cvt_pk_bf16(v0[0], v0[1]); w.y = cvt_pk_bf16(v0[2], v0[3]); w.z = cvt_pk_bf16(v1[0], v1[1]); w.w = cvt_pk_bf16(v1[2], v1[3]);
                    *(GAS u32x4*)(rowp + bj * 128) = w; } }
    }
};

#ifdef MK_SELFTEST
#include "selftest.h"
#endif
__device__ __forceinline__ int bg_need(int p) {
    if (p <= 1) return 0;
    if (p <= 5) return BG_C0;
    if (p <= 7) return BG_C1;
    if (p == 8) return BG_C3;
    if (p <= 10) return BG_C3B;
    if (p <= 14) return BG_C4;
    if (p <= 16) return BG_C5;
    return BG_C7;
}
__device__ __forceinline__ bool bg_seam(int k) { if (k == 0) return true; const int j = (k - 1) % 9; return j != 2 && j != 5 && j != 8; }
struct Args { const float* in[21]; float* out; unsigned char* ws; int ph_lo, ph_hi; };
constexpr int N_PHASES = 1 + 9 * NLAYER + 1;

#ifdef MK_ONLY
#define IN(k) (((k) == 0 ? 0 : (((k) - 1) % 9) + 1) == MK_ONLY && lo <= (k) && (k) < hi)
#else
#define IN(k) (lo <= (k) && (k) < hi)
#endif
#ifndef MK_REPEAT
#define MK_REPEAT -1
#endif
#define REPS(kind) ((MK_REPEAT == (kind)) ? 2 : 1)
#define SEAM(k) do { if (IN(k)) { if (bg_seam(k)) bg_fill(F, (k), bg_need((k) + 1)); if (IN((k) + 1)) xcd_barrier(bar); } } while (0)


template <int l> __device__ __forceinline__ void layer_body(const Frame& F, const XcdBarrier& bar, const int lo, const int hi) {
    constexpr int pb = 1 + 9 * l;

        for (int rep_ = 0; rep_ < REPS(1); ++rep_) if (IN(pb)) { if (rep_) xcd_barrier(bar); unsigned char* const wsl = opq(F.ws); LAS unsigned char* const ldl = opq(F.lds); if (l == 0) phase_norm1<0>(F, l, karg(0), nullptr, 0); else phase_norm1<1>(F, l, (const float*)(wsl + WS_X1), (float*)(wsl + WS_X2), l - 1); }
        SEAM(pb);
        for (int rep_ = 0; rep_ < REPS(2); ++rep_) if (IN(pb + 1)) { if (rep_) xcd_barrier(bar); unsigned char* const wsl = opq(F.ws); LAS unsigned char* const ldl = opq(F.lds); gm::RegOrder S; S.init(SEQ, NZ, DM / 2, wsl + WS_WIN + (size_t)l * NZ * DM, F.G, (int)blockIdx.x);
            fkl_fixup(F);
            EpiZ E{wsl, l, (LAS float*)(ldl + AUX_OFF)};
            gm::gemm_phase<EpiZ, gm::RegOrder, false, true, true, SC_H8, SC_W8>(ldl, (const char*)(wsl + WS_H), DM, S, E, F.wave); }
        SEAM(pb + 1);
        for (int rep_ = 0; rep_ < REPS(4); ++rep_) if (IN(pb + 3)) { if (rep_) xcd_barrier(bar); unsigned char* const wsl = opq(F.ws); LAS unsigned char* const ldl = opq(F.lds);
            const MixTab T = mix_tab_ptrs(ldl);
            mix_build_table(F, l, T);
            const int natt = __builtin_amdgcn_readfirstlane(T.nitems[0]), ntot = natt + 512;
            LAS int* qslot = T.nitems + 1;
            int it = F.vcu;
            while (it < ntot) {
                if (it >= natt) { phase_small_item(F, l, it - natt); }
                else {
                    const int rec = __builtin_amdgcn_readfirstlane(T.items[it]), b = rec & 255, c = (rec >> 8) & 15, ja = (rec >> 12) & 255, n = (rec >> 20) & 31, h = b >> 5, qb = b & 31;
                    const bool fin = (__builtin_amdgcn_readfirstlane(T.jlo[b]) >> 8) <= 1; unsigned char* const ws = opq(wsl);
                    at::BlockRef cur;
                    cur.Q = (const bf16*)(ws + WS_QN) + ((size_t)h * SEQ + qb * 256) * 128; cur.K = (const bf16*)(ws + WS_KN) + (size_t)h * SEQ * 128;
                    cur.V = (const bf16*)(ws + WS_Z) + 3584 + h * 128; cur.O = (bf16*)(ws + WS_YCAT) + (size_t)(qb * 256) * DM + 1024 + h * 128;
                    cur.FK = (const float*)(ws + WS_FKL) + (size_t)h * SEQ; cur.P0 = qb * 256;
                    at::attn_block(cur, ja, n, fin, (bf16*)(ws + WS_PART) + (size_t)(b * 8 + c) * 256 * 128, (float*)(ws + WS_ML) + (size_t)(b * 8 + c) * 256 * 2, (char*)ldl, ldl, F.wave);
                }
                if (opq_tid(F.wave) == 0) qslot[0] = F.G + (int)__hip_atomic_fetch_add(F.ctl + CW_Q + 64 * l + 32 * rep_, 1u, RLX_AGENT);
                __syncthreads();
                it = __builtin_amdgcn_readfirstlane(qslot[0]);
                __syncthreads();
            }
        }
        SEAM(pb + 3);
        for (int rep_ = 0; rep_ < REPS(5); ++rep_) if (IN(pb + 4)) { if (rep_) xcd_barrier(bar); unsigned char* const wsl = opq(F.ws); LAS unsigned char* const ldl = opq(F.lds); const MixTab T = mix_tab_ptrs(ldl); mix_build_table(F, l, T); phase_attn_combine(F, l, T); }
        SEAM(pb + 4);
        for (int rep_ = 0; rep_ < REPS(6); ++rep_) if (IN(pb + 5)) { if (rep_) xcd_barrier(bar); unsigned char* const wsl = opq(F.ws); LAS unsigned char* const ldl = opq(F.lds); gm::RegOrder S; S.init(SEQ, DM, DM, wsl + WS_WOUT + (size_t)l * DM * DM * 2, F.G, (int)blockIdx.x);
            LAS float* g1L = (LAS float*)(ldl + AUX_OFF);
            { const float* const b_ada_ = karg(3); for (int d = opq_tid(F.wave); d < DM; d += NTHR) g1L[d] = mod_at(wsl, b_ada_, l, 2 * DM + d); }
            __syncthreads();
            EpiRes E{(l == 0) ? karg(0) : (const float*)(wsl + WS_X2), g1L, (float*)(wsl + WS_X1)};
            gm::gemm_phase<EpiRes, gm::RegOrder, false, true>(ldl, (const char*)(wsl + WS_YCAT), DM, S, E, F.wave); }
        SEAM(pb + 5);
        for (int rep_ = 0; rep_ < REPS(7); ++rep_) if (IN(pb + 6)) { if (rep_) xcd_barrier(bar); unsigned char* const wsl = opq(F.ws); LAS unsigned char* const ldl = opq(F.lds); phase_norm2_route(F, l); }
        SEAM(pb + 6);
        for (int rep_ = 0; rep_ < REPS(8); ++rep_) if (IN(pb + 7)) { if (rep_) xcd_barrier(bar); unsigned char* const wsl = opq(F.ws); LAS unsigned char* const ldl = opq(F.lds); LAS int* tab = (LAS int*)(ldl + AUX_OFF + 20480); moe_table(F, l, tab);
            gu32* const rdy = F.ctl + CW_RDY + 4096 * l + 2048 * rep_;
            { MoeOrder S; S.G = F.G; S.c = F.vcu; S.total = 8 * tab[16]; S.K = DM / 2; S.nct = 8; S.Bt = (const char*)(wsl + WS_WGU) + (size_t)l * NEXP * DM * DM; S.estride = (size_t)DM * DM;
              S.list = (const int*)(wsl + WS_LIST); S.tab = tab;
              EpiHidPub E{wsl + (l ? WS_HID1 : WS_HID), rdy};
              gm::gemm_phase<EpiHidPub, MoeOrder, true, true, true, SC_H8, SC_W8>(ldl, (const char*)(wsl + WS_H), DM, S, E, F.wave); }
            { MoeDynOrder S; S.total = 8 * tab[16]; S.K = DEX / 2; S.Bt = (const char*)(wsl + WS_WD) + (size_t)l * NEXP * DM * DEX; S.estride = (size_t)DM * DEX; S.tab = tab;
              S.ticket = F.ctl + CW_MT + 64 * l + 32 * rep_; S.ready = rdy; S.tmo = F.ctl + CW_TMO; S.slot = (LAS unsigned*)(ldl + AUX_OFF + 24576 + 64);
              EpiYB E{(bf16*)(wsl + WS_YB)};
              gm::gemm_phase<EpiYB, MoeDynOrder, false, true, true, SC_HID8, SC_W8>(ldl, (const char*)(wsl + (l ? WS_HID1 : WS_HID)), DEX, S, E, F.wave); }
        }
        SEAM(pb + 7);
    }

__global__ void __launch_bounds__(NTHR, 2) mk_fwd(Args args) {
    extern __shared__ __attribute__((aligned(16))) unsigned char lds[];
    Frame F;
    F.lds = (LAS unsigned char*)lds; F.MISC = (volatile LAS unsigned*)(F.lds + MISC_OFF);
    F.tid = 0; F.lane = 0; F.wave = __builtin_amdgcn_readfirstlane((int)threadIdx.x >> 6);
    F.G = gridDim.x; { const int bx = blockIdx.x; F.vcu = (F.G % 8 == 0) ? (bx % 8) * (F.G / 8) + bx / 8 : bx; }
    F.ws = args.ws; F.ctl = (gu32*)(args.ws + WS_CTL);
    for (int u = threadIdx.x; u < (LDS_BYTES - RING_BYTES) / 4; u += NTHR) ((LAS unsigned*)(F.lds + RING_BYTES))[u] = 0u;
    __syncthreads();
    const int lo = args.ph_lo, hi = args.ph_hi;
    const bool multi = (hi - lo) > 1;
    XcdBarrier bar; bar.bar = (unsigned*)(F.ctl + CW_BAR); bar.x = 0; bar.st = nullptr;
    if (multi) bar = xcd_barrier_post((unsigned*)(F.ctl + CW_BAR), F.MISC + 8);
    for (int rep_ = 0; rep_ < REPS(0); ++rep_) if (IN(0)) { if (rep_) xcd_barrier(bar); p0_prologue(F); } SEAM(0);

    layer_body<0>(F, bar, lo, hi);
    layer_body<1>(F, bar, lo, hi);
    for (int rep_ = 0; rep_ < REPS(10); ++rep_) if (IN(N_PHASES - 1)) { if (rep_) xcd_barrier(bar); phase_norm1<2>(F, NLAYER - 1, (const float*)(F.ws + WS_X1), (float*)karg(21), NLAYER - 1); }
#ifdef MK_SELFTEST
    {
        const bool h0 = st_run(0, 1.f, 0x7f7f7f7f), h0s = st_run(0, 64.f, 0x79797979), h1 = st_run(1, 1.f, 0x7f7f7f7f);
        xcd_barrier(bar);
        float* o = (float*)karg(21);
        if (!(h0 && h0s)) { const float val = h0 ? 0.f : (h1 ? 1000.f : __builtin_nanf(""));
            for (size_t i = (size_t)blockIdx.x * NTHR + threadIdx.x; i < (size_t)SEQ * DM; i += (size_t)gridDim.x * NTHR) o[i] = val; }
    }
#endif
#undef IN
#undef SEAM
}

#ifndef MK_LAUNCHES
#define MK_LAUNCHES 1
#endif
extern "C" void kernel_launch(void* const* d_in, const int* in_sizes, int n_in, void* d_out, int out_size, void* d_ws, size_t ws_size, hipStream_t stream) {
    static int grid = 0;
    if (grid == 0) {
        int dev = 0, cus = 0, per_cu = 0;
        if (n_in != 21 || ws_size < WS_END) { fprintf(stderr, "kernel_launch: unexpected inputs (n_in %d, ws %zu)\n", n_in, ws_size); grid = -1; return; }
        if (hipGetDevice(&dev) != hipSuccess || hipDeviceGetAttribute(&cus, hipDeviceAttributeMultiprocessorCount, dev) != hipSuccess) { grid = -1; return; }
        if (hipFuncSetAttribute((const void*)mk_fwd, hipFuncAttributeMaxDynamicSharedMemorySize, LDS_BYTES) != hipSuccess) { fprintf(stderr, "kernel_launch: hipFuncSetAttribute failed\n"); grid = -1; return; }
        if (hipOccupancyMaxActiveBlocksPerMultiprocessor(&per_cu, (const void*)mk_fwd, NTHR, LDS_BYTES) != hipSuccess || per_cu < 1) fprintf(stderr, "kernel_launch: occupancy query says %d\n", per_cu);
        (void)hipGetLastError();
        grid = cus;
    }
    if (grid < 0) return;
    (void)hipMemsetAsync((char*)d_ws + WS_CTL, 0, CTL_ZERO_BYTES, stream);
    Args a{};
    for (int i = 0; i < 21; ++i) a.in[i] = (const float*)d_in[i];
    a.out = (float*)d_out; a.ws = (unsigned char*)d_ws;
#if MK_LAUNCHES == 1
    a.ph_lo = 0; a.ph_hi = N_PHASES;
    hipLaunchKernelGGL(mk_fwd, dim3(grid), dim3(NTHR), LDS_BYTES, stream, a);
#else
    for (int p = 0; p < N_PHASES; ++p) { a.ph_lo = p; a.ph_hi = p + 1; hipLaunchKernelGGL(mk_fwd, dim3(grid), dim3(NTHR), LDS_BYTES, stream, a); }
#endif
}
```

```cpp
#include <hip/hip_runtime.h>
#include <stdint.h>
#include <stdio.h>

#define GAS __attribute__((address_space(1)))
#define LAS __attribute__((address_space(3)))
typedef unsigned short bf16;
typedef short bf16x8 __attribute__((ext_vector_type(8)));
typedef short s16x4 __attribute__((ext_vector_type(4)));
typedef float f32x2 __attribute__((ext_vector_type(2)));
typedef float f32x4 __attribute__((ext_vector_type(4)));
typedef float f32x16 __attribute__((ext_vector_type(16)));
typedef unsigned u32x2 __attribute__((ext_vector_type(2)));
typedef unsigned u32x4 __attribute__((ext_vector_type(4)));
typedef int i32x8 __attribute__((ext_vector_type(8)));
typedef int i32x4 __attribute__((ext_vector_type(4)));
typedef GAS unsigned gu32;
#define RLX_AGENT __ATOMIC_RELAXED, __HIP_MEMORY_SCOPE_AGENT
#define LDS_WAIT() asm volatile("s_waitcnt lgkmcnt(0)" ::: "memory")
#define VM_WAIT() asm volatile("s_waitcnt vmcnt(0)" ::: "memory")

constexpr int DM = 2048, SEQ = 8192, NIN = 4616, NZ = 4608, DEX = 1024, NEXP = 16, NLAYER = 2;
constexpr float EPSN = 1e-6f;
constexpr float LOG2E = 1.4426950408889634f;
constexpr int NWAVES = 8, NTHR = 512;
constexpr int HIDROWS = 2 * SEQ + NEXP * 256;

constexpr size_t KiB = 1024, MiB = 1u << 20;
constexpr size_t WS_CTL = 0, CTL_ZERO_BYTES = 1 * MiB;
constexpr size_t WS_MOD = 1 * MiB;
constexpr size_t WS_FLOC = WS_MOD + 128 * KiB;
constexpr size_t WS_TOT = WS_FLOC + 256 * KiB;
constexpr size_t WS_FKL = WS_TOT + 8 * KiB;
constexpr size_t WS_TOKE = WS_FKL + 256 * KiB;
constexpr size_t WS_TOKP = WS_TOKE + 64 * KiB;
constexpr size_t WS_TOKW = WS_TOKP + 64 * KiB;
constexpr size_t WS_LIST = WS_TOKW + 64 * KiB;
constexpr size_t WS_WM = 4 * MiB;
constexpr size_t WS_BWT = WS_WM + 256 * KiB;
constexpr size_t WS_MODP = 6 * MiB;
constexpr size_t WS_WIN = 8 * MiB;
constexpr size_t WS_WOUT = WS_WIN + 2 * 18 * MiB;
constexpr size_t WS_WGU = WS_WOUT + 2 * 8 * MiB;
constexpr size_t WS_WD = WS_WGU + 2 * 16 * 8 * MiB;
constexpr size_t WS_H = WS_WD + 2 * 16 * 4 * MiB;
constexpr size_t WS_Z = WS_H + 32 * MiB;
constexpr size_t WS_QN = WS_Z + 72 * MiB;
constexpr size_t WS_KN = WS_QN + 16 * MiB;
constexpr size_t WS_VN = WS_KN + 16 * MiB;
constexpr size_t WS_DP = WS_VN + 8 * MiB;
constexpr size_t WS_YCAT = WS_DP + 8 * MiB;
constexpr size_t WS_X1 = WS_YCAT + 32 * MiB;
constexpr size_t WS_X2 = WS_X1 + 64 * MiB;
constexpr size_t WS_HID = WS_X2 + 64 * MiB;
constexpr size_t WS_YB = WS_HID + 40 * MiB;
constexpr size_t WS_PART = WS_YB + 80 * MiB;
constexpr size_t WS_ML = WS_PART + 128 * MiB;
constexpr size_t WS_HID1 = WS_ML + 4 * MiB;
constexpr size_t WS_END = WS_HID1 + 40 * MiB;
constexpr int CW_TMO = 0, CW_CODE = 1;
constexpr int CW_CNT = 64;
constexpr int CW_Q = 512;
constexpr int CW_BGT = 640;
constexpr int CW_ARR = 1024;
constexpr int CW_MT = 768;
constexpr int CW_BAR = 4096;
constexpr int CW_RDY = 8192;

constexpr int RING_BYTES = 131072;
constexpr int MISC_OFF = RING_BYTES + 320;
constexpr int AUX_OFF = RING_BYTES + 1024;
constexpr int LDS_BYTES = 163840;

template <class T> __device__ __forceinline__ T* opq(T* p) { asm volatile("" : "+s"(p)); return p; }
__device__ __forceinline__ int opq_tid(int wave) { int t = (wave << 6) | (int)__builtin_amdgcn_mbcnt_hi(~0u, __builtin_amdgcn_mbcnt_lo(~0u, 0u)); asm volatile("" : "+v"(t)); return t; }
__device__ __forceinline__ unsigned cvt_pk_bf16(float lo, float hi) { unsigned r; asm volatile("v_cvt_pk_bf16_f32 %0, %1, %2" : "=v"(r) : "v"(lo), "v"(hi)); return r; }
__device__ __forceinline__ unsigned cvt_pk4_fp8(float a, float b, float c, float d) {
    a = fminf(fmaxf(a, -440.f), 440.f); b = fminf(fmaxf(b, -440.f), 440.f); c = fminf(fmaxf(c, -440.f), 440.f); d = fminf(fmaxf(d, -440.f), 440.f);
    unsigned w; asm volatile("v_cvt_pk_fp8_f32 %0, %1, %2" : "=v"(w) : "v"(a), "v"(b)); asm volatile("v_cvt_pk_fp8_f32 %0, %1, %2 op_sel:[0,0,1]" : "+v"(w) : "v"(c), "v"(d)); return w; }
constexpr float H8_SCALE = 4.f, HID8_SCALE = 4.f, W8_SCALE = 64.f;
constexpr int SC_H8 = 0x7b7b7b7b, SC_HID8 = 0x7b7b7b7b, SC_W8 = 0x7b7b7b7b;
__device__ __forceinline__ float bf_lo(unsigned w) { return __uint_as_float(w << 16); }
__device__ __forceinline__ float bf_hi(unsigned w) { return __uint_as_float(w & 0xffff0000u); }
template <int M> __device__ __forceinline__ float xor_f(float v) {
    static_assert(M < 32, "xor_f: masks below 32 only");
    return __uint_as_float((unsigned)__builtin_amdgcn_ds_swizzle((int)__float_as_uint(v), (M << 10) | 0x1f));
}
__device__ __forceinline__ float wave_sum(float v) {
    v += xor_f<1>(v); v += xor_f<2>(v); v += xor_f<4>(v); v += xor_f<8>(v); v += xor_f<16>(v);
    { auto rr = __builtin_amdgcn_permlane32_swap(__float_as_uint(v), __float_as_uint(v), false, false); v = __uint_as_float(rr[0]) + __uint_as_float(rr[1]); }
    return v;
}
__device__ __forceinline__ float wave_max(float v) {
    v = fmaxf(v, xor_f<1>(v)); v = fmaxf(v, xor_f<2>(v)); v = fmaxf(v, xor_f<4>(v)); v = fmaxf(v, xor_f<8>(v)); v = fmaxf(v, xor_f<16>(v));
    { auto rr = __builtin_amdgcn_permlane32_swap(__float_as_uint(v), __float_as_uint(v), false, false); v = fmaxf(__uint_as_float(rr[0]), __uint_as_float(rr[1])); }
    return v;
}
__device__ __forceinline__ float gelu_t(float x) {
    const float u2 = x * (1.5957691216057308f + 0.0713548162726f * x * x);
    return x * __builtin_amdgcn_rcpf(1.f + __builtin_amdgcn_exp2f(-LOG2E * u2));
}
__device__ __forceinline__ float silu_f(float x) { return x * __builtin_amdgcn_rcpf(1.f + __builtin_amdgcn_exp2f(-LOG2E * x)); }

#define XB_TMO      128
#define XB_XCNT(j)  (256  + 64 * (j))
#define XB_XSUB(j)  (1280 + 64 * (j))
#define XB_XGEN(j)  (2304 + 64 * (j))
#define XB_TOP      3328
#define XB_TOPGEN   3392
#define XCD_BAR_WORDS 3456
#define XB_SPIN_CAP (1u << 18)
__device__ __forceinline__ unsigned xb_ld(unsigned* p)              { return __hip_atomic_load(p, __ATOMIC_RELAXED, __HIP_MEMORY_SCOPE_AGENT); }
__device__ __forceinline__ unsigned xb_add(unsigned* p, unsigned v) { return __hip_atomic_fetch_add(p, v, __ATOMIC_RELAXED, __HIP_MEMORY_SCOPE_AGENT); }
__device__ __forceinline__ unsigned xb_xcc_id() { return (unsigned)__builtin_amdgcn_s_getreg((3 << 11) | 20) & 0xFu; }
#define XB_SPIN(cond, bar) do { unsigned _sp = 0; while (cond) { __builtin_amdgcn_s_sleep(1); \
    if ((++_sp & 255u) == 0u) { if (xb_ld(&(bar)[XB_TMO])) break; if (_sp > XB_SPIN_CAP) { atomicAdd(&(bar)[XB_TMO], 1u); break; } } } } while (0)
struct XcdBarrier { unsigned* bar; unsigned x; volatile LAS unsigned* st; };
__device__ __forceinline__ XcdBarrier xcd_barrier_post(unsigned* bar, volatile LAS unsigned* st) {
    XcdBarrier b; b.bar = bar; b.x = xb_xcc_id(); b.st = st;
    if (threadIdx.x == 0) (void)xb_add(&bar[XB_XCNT(b.x)], 1u);
    return b;
}
__device__ __forceinline__ void xcd_barrier_complete(unsigned* bar, unsigned x, unsigned& nloc, unsigned& nx) {
    const unsigned G = gridDim.x * gridDim.y * gridDim.z;
    unsigned sum, cnt, mine, sp = 0u;
    for (;;) {
        sum = 0u; cnt = 0u; mine = 0u;
#pragma unroll
        for (unsigned j = 0; j < 16; ++j) { const unsigned c = xb_ld(&bar[XB_XCNT(j)]); sum += c; cnt += (c > 0u) ? 1u : 0u; mine = (j == x) ? c : mine; }
        if (sum == G) break;
        __builtin_amdgcn_s_sleep(1);
        if ((++sp & 255u) == 0u) { if (xb_ld(&bar[XB_TMO])) break; if (sp > XB_SPIN_CAP) { atomicAdd(&bar[XB_TMO], 1u); break; } }
    }
    nloc = mine > 0u ? mine : 1u; nx = cnt > 0u ? cnt : 1u;
}
__device__ __forceinline__ void xcd_barrier(const XcdBarrier& b) {
    asm volatile("s_waitcnt vmcnt(0)" ::: "memory");
    __syncthreads();
    if (threadIdx.x == 0) {
        unsigned* bar = b.bar; asm volatile("" : "+s"(bar));
        __builtin_amdgcn_s_waitcnt(0);
        unsigned nloc = b.st[0], nx = b.st[1];
        if (nloc == 0u) { xcd_barrier_complete(bar, b.x, nloc, nx); b.st[0] = nloc; b.st[1] = nx; }
        const unsigned old = xb_add(&bar[XB_XSUB(b.x)], 1u);
        const unsigned gen = old / nloc;
        if (old + 1u == (gen + 1u) * nloc) {
            __builtin_amdgcn_fence(__ATOMIC_RELEASE, "agent");
            asm volatile("s_waitcnt vmcnt(0)" ::: "memory");
            const unsigned og = xb_add(&bar[XB_TOP], 1u);
            const unsigned tg = og / nx;
            if (og + 1u == (tg + 1u) * nx) xb_add(&bar[XB_TOPGEN], 1u);
            else XB_SPIN(xb_ld(&bar[XB_TOPGEN]) == tg, bar);
            __builtin_amdgcn_fence(__ATOMIC_ACQUIRE, "agent");
            xb_add(&bar[XB_XGEN(b.x)], 1u);
            asm volatile("s_waitcnt vmcnt(0)" ::: "memory");
        } else {
            XB_SPIN(xb_ld(&bar[XB_XGEN(b.x)]) == gen, bar);
            __builtin_amdgcn_fence(__ATOMIC_ACQUIRE, "agent");
            asm volatile("s_waitcnt vmcnt(0)" ::: "memory");
        }
    }
    __syncthreads();
}

namespace gm {
constexpr int BM = 256, BK = 64, HALF = 128, HTB = HALF * BK * 2, STAGE_BYTES = 8 * HTB, NXCD = 8, WGM = 8;
__host__ __device__ __forceinline__ int lds_byte(int r, int c) { const int st = (r >> 4) * 2 + (c >> 5), rr = r & 15, cc = c & 31, ob = rr * 64 + cc * 2; return st * 1024 + (ob ^ (((ob >> 9) & 1) << 5)); }
__host__ __device__ __forceinline__ void stage_rc(int b, int& R, int& C) { const int st = b / 1024, sb = b % 1024, swz = sb ^ (((sb >> 9) & 1) << 5); R = (st >> 1) * 16 + swz / 64; C = (st & 1) * 32 + (swz % 64) / 2; }
__host__ __device__ __forceinline__ int perm32(int rho) { const int n = rho >> 4, i = rho & 15; return 8 * (i >> 2) + 4 * n + (i & 3); }

struct Unit { int arow, orow, ocol, e, rt; const char* Bp; };

template <class Epi, class Sched, bool GATHER, bool ALIGN_EPI, bool FP8 = false, int SCA = 0x7f7f7f7f, int SCB = 0x7f7f7f7f>
__device__ __forceinline__ void gemm_phase(LAS unsigned char* lds, const char* Abase, const int Kel, const Sched& S, const Epi& E, const int wv) {
    const int K = FP8 ? (Kel >> 1) : Kel;
    const int tid = opq_tid(wv), wid = wv, lane = tid & 63, wr = wid >> 2, wc = wid & 3, fr = lane & 15, fq = lane >> 4;
    const int nt = K / BK;
    unsigned voffA[2], voffB[2];
#pragma unroll
    for (int i = 0; i < 2; ++i) { int R, C; stage_rc(tid * 16 + i * 8192, R, C); const int Rb = Epi::PERM ? ((R & ~31) + perm32(R & 31)) : R;
        voffA[i] = (unsigned)(R * K + C) * 2u; voffB[i] = (unsigned)(Rb * K + C) * 2u; }
    const size_t kstep = (size_t)(BK * 2);
    const size_t hstep = (size_t)HALF * K * 2;
    const unsigned ldsw = (unsigned)wid * 1024u;
    const int aoff = FP8 ? lds_byte(wr * 64 + fr, fq * 16) : lds_byte(wr * 64 + fr, fq * 8), boff = FP8 ? lds_byte(wc * 32 + fr, fq * 16) : lds_byte(wc * 32 + fr, fq * 8);
#define PG8_SA(b, h) (((b) * 2 + (h)) * HTB)
#define PG8_SB(b, h) ((4 + (b) * 2 + (h)) * HTB)
#define PG8_STAGE(bufoff, gbase, voff) do { _Pragma("unroll") for (int _i = 0; _i < 2; ++_i) { unsigned vo_ = (voff)[_i]; asm volatile("" : "+v"(vo_));     \
        __builtin_amdgcn_global_load_lds((const unsigned*)((const char*)(gbase) + vo_), (LAS unsigned*)(lds + (bufoff) + ldsw + _i * 8192), 16, 0, 0); } } while (0)
#define PG8_STAGE_A(bufoff, ubase, h, kb, vg) do { if constexpr (GATHER) { PG8_STAGE(bufoff, Abase + (kb), (vg)[h]); } else { PG8_STAGE(bufoff, (ubase) + (h) * hstep + (kb), voffA); } } while (0)
#define PG8_STAGE_A2(bufoff, ubase, h, kb) PG8_STAGE_A(bufoff, ubase, h, kb, vgc)
#define PG8_LDA(dst, b, h) do { _Pragma("unroll") for (int m = 0; m < 4; ++m) { if constexpr (FP8) { dst##8[m].lo = *(const LAS i32x4*)(lds + PG8_SA(b, h) + aoff + m * 2048); dst##8[m].hi = *(const LAS i32x4*)(lds + PG8_SA(b, h) + aoff + 16 + m * 2048); } \
        else { dst[m][0] = *(const LAS bf16x8*)(lds + PG8_SA(b, h) + aoff + m * 2048); dst[m][1] = *(const LAS bf16x8*)(lds + PG8_SA(b, h) + aoff + 1024 + m * 2048); } } } while (0)
#define PG8_LDB(dst, b, h) do { _Pragma("unroll") for (int n = 0; n < 2; ++n) { if constexpr (FP8) { dst##8[n].lo = *(const LAS i32x4*)(lds + PG8_SB(b, h) + boff + n * 2048); dst##8[n].hi = *(const LAS i32x4*)(lds + PG8_SB(b, h) + boff + 16 + n * 2048); } \
        else { dst[n][0] = *(const LAS bf16x8*)(lds + PG8_SB(b, h) + boff + n * 2048); dst[n][1] = *(const LAS bf16x8*)(lds + PG8_SB(b, h) + boff + 1024 + n * 2048); } } } while (0)
#define PG8_F8(x) __builtin_shufflevector(__builtin_bit_cast(i32x4, (x)[0]), __builtin_bit_cast(i32x4, (x)[1]), 0, 1, 2, 3, 4, 5, 6, 7)
#define PG8_MMA(ai, bj, At, Bt) do { __builtin_amdgcn_s_setprio(1); _Pragma("unroll") for (int m = 0; m < 4; ++m) _Pragma("unroll") for (int n = 0; n < 2; ++n) { \
        if constexpr (FP8) { acc[ai][bj][m][n] = __builtin_amdgcn_mfma_scale_f32_16x16x128_f8f6f4(Bt##8[n], At##8[m], acc[ai][bj][m][n], 0, 0, 0, SCB, 0, SCA); } \
        else { _Pragma("unroll") for (int k = 0; k < 2; ++k) acc[ai][bj][m][n] = __builtin_amdgcn_mfma_f32_16x16x32_bf16(Bt[n][k], At[m][k], acc[ai][bj][m][n], 0, 0, 0); } } \
        __builtin_amdgcn_s_setprio(0); } while (0)
#define PG8_WAIT_V(n) asm volatile("s_waitcnt vmcnt(" #n ")" ::: "memory")
#define PG8_WAIT_L(n) asm volatile("s_waitcnt lgkmcnt(" #n ")" ::: "memory")
#define PG8_BAR __builtin_amdgcn_s_barrier()
#define PG8_SCHED __builtin_amdgcn_sched_barrier(0)
    Unit cur, nxt; int ui = 0;
    if (!S.next(0, cur)) return;
    f32x4 acc[2][2][4][2];
#pragma unroll
    for (int a = 0; a < 2; ++a)
#pragma unroll
        for (int b = 0; b < 2; ++b)
#pragma unroll
            for (int m = 0; m < 4; ++m)
#pragma unroll
                for (int n = 0; n < 2; ++n) acc[a][b][m][n] = (f32x4){0.f, 0.f, 0.f, 0.f};
    bf16x8 At[4][2], B0[2][2], B1[2][2];
    i32x8 At8[4], B08[2], B18[2];
    unsigned vgc[2][2];
    if constexpr (GATHER) {
#pragma unroll
        for (int h = 0; h < 2; ++h)
#pragma unroll
            for (int i = 0; i < 2; ++i) { int R_, C_; stage_rc(opq_tid(wv) * 16 + i * 8192, R_, C_); vgc[h][i] = ((unsigned)S.row_of(cur, h * HALF + R_) * (unsigned)K + (unsigned)C_) * 2u; }
    }
    const char* cA = GATHER ? Abase : Abase + (size_t)cur.arow * K * 2; const char* cB = cur.Bp;
    PG8_STAGE(PG8_SB(0, 0), cB, voffB); PG8_STAGE(PG8_SB(0, 1), cB + hstep, voffB); PG8_STAGE_A(PG8_SA(0, 0), cA, 0, 0, vgc); PG8_STAGE_A(PG8_SA(0, 1), cA, 1, 0, vgc);
    if (wr == 1) PG8_BAR;
    PG8_WAIT_V(2); PG8_BAR;
    PG8_STAGE(PG8_SB(1, 0), cB + kstep, voffB); PG8_STAGE_A(PG8_SA(1, 0), cA, 0, kstep, vgc); PG8_STAGE(PG8_SB(1, 1), cB + hstep + kstep, voffB);
    PG8_WAIT_V(6); PG8_BAR;
    for (;;) {
        bool has_next = false;
        const char* nA = cA; const char* nB = cB;
        for (int t = 0; t < nt; t += 2) {
            const bool last = (t == nt - 2);
            if (last) { has_next = S.next(ui + 1, nxt); if (has_next) { nA = GATHER ? Abase : Abase + (size_t)nxt.arow * K * 2; nB = nxt.Bp; } }
            const size_t k1 = (size_t)(t + 1) * kstep;
            const char* a2 = last ? nA : cA; const char* b2 = last ? nB : cB + (size_t)(t + 2) * kstep;
            const size_t k2 = last ? 0 : (size_t)(t + 2) * kstep, k3 = k2 + kstep;
            const char* b3 = b2 + kstep;
            PG8_LDB(B0, 0, 0); PG8_LDB(B1, 0, 1); PG8_SCHED; PG8_LDA(At, 0, 0); PG8_STAGE_A(PG8_SA(1, 1), cA, 1, k1, vgc);
            if constexpr (GATHER) { if (last && has_next) {
#pragma unroll
                for (int h = 0; h < 2; ++h)
#pragma unroll
                    for (int i = 0; i < 2; ++i) { int R_, C_; stage_rc(opq_tid(wv) * 16 + i * 8192, R_, C_); vgc[h][i] = ((unsigned)S.row_of(nxt, h * HALF + R_) * (unsigned)K + (unsigned)C_) * 2u; } } }
            PG8_WAIT_V(8); PG8_WAIT_L(0); PG8_BAR; PG8_MMA(0, 0, At, B0); PG8_MMA(0, 1, At, B1); PG8_BAR; PG8_SCHED;
            PG8_LDA(At, 0, 1); PG8_STAGE(PG8_SB(0, 0), b2, voffB); PG8_STAGE(PG8_SB(0, 1), b2 + hstep, voffB); PG8_STAGE_A2(PG8_SA(0, 0), a2, 0, k2);
            PG8_WAIT_V(8); PG8_WAIT_L(0); PG8_BAR; PG8_MMA(1, 0, At, B0); PG8_MMA(1, 1, At, B1); PG8_BAR; PG8_SCHED;
            PG8_LDB(B0, 1, 0); PG8_LDB(B1, 1, 1); PG8_SCHED; PG8_LDA(At, 1, 0); PG8_STAGE_A2(PG8_SA(0, 1), a2, 1, k2);
            PG8_WAIT_V(8); PG8_WAIT_L(0); PG8_BAR; PG8_MMA(0, 0, At, B0); PG8_MMA(0, 1, At, B1); PG8_BAR; PG8_SCHED;
            PG8_LDA(At, 1, 1); PG8_STAGE(PG8_SB(1, 0), b3, voffB); PG8_STAGE(PG8_SB(1, 1), b3 + hstep, voffB); PG8_STAGE_A2(PG8_SA(1, 0), a2, 0, k3);
            PG8_WAIT_V(8); PG8_WAIT_L(0); PG8_BAR; PG8_MMA(1, 0, At, B0); PG8_MMA(1, 1, At, B1); PG8_BAR; PG8_SCHED;
        }
        if constexpr (ALIGN_EPI) { if (wr == 0) PG8_BAR; }
        E(acc, cur, wr, wc, fr, fq);
        if (!has_next) break;
#pragma unroll
        for (int a = 0; a < 2; ++a)
#pragma unroll
            for (int b = 0; b < 2; ++b)
#pragma unroll
                for (int m = 0; m < 4; ++m)
#pragma unroll
                    for (int n = 0; n < 2; ++n) acc[a][b][m][n] = (f32x4){0.f, 0.f, 0.f, 0.f};
        cur = nxt; cA = nA; cB = nB; ++ui;
        if constexpr (ALIGN_EPI) { if (wr == 1) PG8_BAR; }
    }
    PG8_WAIT_V(0);
    if constexpr (!ALIGN_EPI) { if (wr == 0) PG8_BAR; }
    PG8_BAR;
#undef PG8_SA
#undef PG8_SB
#undef PG8_STAGE
#undef PG8_STAGE_A
#undef PG8_STAGE_A2
#undef PG8_LDA
#undef PG8_LDB
#undef PG8_MMA
#undef PG8_F8
#undef PG8_WAIT_V
#undef PG8_WAIT_L
#undef PG8_BAR
#undef PG8_SCHED
}

struct RegOrder {
    int nM, nN, nwg, G, c, K; const char* Bt;
    __device__ __forceinline__ void init(int M, int N, int K_, const void* Bt_, int G_, int c_) { nM = M / BM; nN = N / BM; nwg = nM * nN; G = G_; c = c_; K = K_; Bt = (const char*)Bt_; }
    __device__ __forceinline__ bool next(int i, Unit& u) const {
        const long L = (long)i * G + c; if (L >= nwg) return false;
        int wgid = (int)L; { const int q = nwg / NXCD, r = nwg % NXCD, xcd = wgid % NXCD, off = wgid / NXCD; wgid = (xcd < r ? xcd * (q + 1) : r * (q + 1) + (xcd - r) * q) + off; }
        const int nig = WGM * nN, gid = wgid / nig, fm = gid * WGM, gsz = (nM - fm) < WGM ? (nM - fm) : WGM;
        const int pm = fm + ((wgid % nig) % gsz), pn = (wgid % nig) / gsz;
        u.arow = pm * BM; u.orow = pm * BM; u.ocol = pn * BM; u.e = 0; u.rt = 0; u.Bp = Bt + (size_t)pn * BM * K * 2; return true;
    }
    __device__ __forceinline__ int row_of(const Unit&, int) const { return 0; }
};
}
namespace at {
constexpr int NW = 8, QBLK = 32, KVBLK = 64, QB = NW * QBLK, D = 128;
constexpr int SHM_V = KVBLK * D * 2, SHM_K = KVBLK * D * 2;
constexpr int OFF_WS = 2 * SHM_V + 2 * SHM_K, OFF_NF = OFF_WS + NW * 64 * 4, ATT_LDS = OFF_NF + 2 * 64 * 4;
constexpr float SCALE = 0.08838834764831845f, C2 = 1.4426950408889634f * SCALE, THR = 8.f;
constexpr float ISCALE = 11.313708498984761f;
constexpr int QS = 128, KS = 128, VS = NZ, OS = DM;

#define KSWZ(row, colB) ((row) * 256 + ((colB) ^ (((row) & 7) << 4)))
#define SBAR() __builtin_amdgcn_sched_barrier(0)
__device__ __forceinline__ int v_st(int k, int c) { const int kk = (k & ~0xC) | ((k & 4) << 1) | ((k & 8) >> 1); return ((kk >> 3) * 4 + (c >> 5)) * 512 + ((kk & 7) * 32 + (c & 31)) * 2; }
__device__ __forceinline__ int v_rd_base(int lane) { return ((lane & 3) << 3) | (((lane >> 2) & 3) << 6) | (((lane >> 4) & 1) << 5) | (((lane >> 5) & 1) << 8); }
constexpr int v_rd_off(int d0, int ks, int half) { return d0 * 512 + ks * 4096 + half * 2048; }
__device__ __forceinline__ int crow(int r, int hi) { return (r & 3) + 8 * (r >> 2) + 4 * hi; }
__device__ __forceinline__ unsigned cvtpk(float lo, float hi) { unsigned r; asm volatile("v_cvt_pk_bf16_f32 %0, %1, %2" : "=v"(r) : "v"(lo), "v"(hi)); return r; }
__device__ __forceinline__ bf16x8 load8(const bf16* p) { return *(const GAS bf16x8*)p; }

__device__ __forceinline__ void mask_tile(f32x16& p0, f32x16& p1, int dq) {
    const float NEG = -__builtin_inff();
#pragma unroll
    for (int r = 0; r < 16; ++r) {
        const int c = (r & 3) + 8 * (r >> 2);
        if (dq - c < 0) p0[r] = NEG;
        if (dq - c - 32 < 0) p1[r] = NEG;
    }
}
__device__ __forceinline__ void partialSM(f32x16& p0, f32x16& p1, float& m_reg, float& mn, float& alpha) {
    float pmax = p0[0]; for (int r = 1; r < 16; ++r) pmax = fmaxf(pmax, p0[r]); for (int r = 0; r < 16; ++r) pmax = fmaxf(pmax, p1[r]);
    { auto rr = __builtin_amdgcn_permlane32_swap(__float_as_uint(pmax), __float_as_uint(pmax), false, false);
      pmax = fmaxf(__uint_as_float(rr[0]), __uint_as_float(rr[1])); }
    if (__builtin_expect(__all((pmax - m_reg) * SCALE <= THR), 1)) { mn = m_reg; alpha = 1.f; }
    else { mn = fmaxf(m_reg, pmax); alpha = __builtin_amdgcn_exp2f((m_reg - mn) * C2); m_reg = mn; }
    const float mnL = -mn * C2;
    for (int r = 0; r < 16; ++r) p0[r] = fmaf(p0[r], C2, mnL); for (int r = 0; r < 16; ++r) p1[r] = fmaf(p1[r], C2, mnL);
    for (int r = 0; r < 16; ++r) p0[r] = __builtin_amdgcn_exp2f(p0[r]);
}
__device__ __forceinline__ void finishSM(f32x16& p0, f32x16& p1, float alpha, float& l_reg, bf16x8& pa0, bf16x8& pa1, bf16x8& pa2, bf16x8& pa3) {
    for (int r = 0; r < 16; ++r) p1[r] = __builtin_amdgcn_exp2f(p1[r]);
    float ps = 0; for (int r = 0; r < 16; ++r) ps += p0[r]; for (int r = 0; r < 16; ++r) ps += p1[r];
    { auto rr = __builtin_amdgcn_permlane32_swap(__float_as_uint(ps), __float_as_uint(ps), false, false);
      ps = __uint_as_float(rr[0]) + __uint_as_float(rr[1]); }
    l_reg = l_reg * alpha + ps;
#define PK4(P, B_, OUT) do { unsigned a0 = cvtpk(P[B_+0], P[B_+1]), a1 = cvtpk(P[B_+2], P[B_+3]);                          \
        unsigned b0 = cvtpk(P[B_+4], P[B_+5]), b1 = cvtpk(P[B_+6], P[B_+7]);                                             \
        auto r0 = __builtin_amdgcn_permlane32_swap(a0, b0, false, false); auto r1 = __builtin_amdgcn_permlane32_swap(a1, b1, false, false); \
        u32x4 w = {r0[0], r1[0], r0[1], r1[1]}; OUT = *reinterpret_cast<bf16x8*>(&w); } while (0)
    PK4(p0, 0, pa0); PK4(p0, 8, pa1); PK4(p1, 0, pa2); PK4(p1, 8, pa3);
#undef PK4
}
template <int KB>
__device__ __forceinline__ void qkt(f32x16& p0, f32x16& p1, const char* K_lds, int r32, int hi, const bf16x8* qr) {
    { const float* nf = (const float*)(K_lds + 2 * SHM_K + NW * 64 * 4) + KB * 64 + 4 * hi;
#pragma unroll
      for (int g = 0; g < 4; ++g) { const f32x4 a = *(const f32x4*)(nf + 8 * g), b = *(const f32x4*)(nf + 32 + 8 * g);
#pragma unroll
          for (int j = 0; j < 4; ++j) { p0[4 * g + j] = a[j]; p1[4 * g + j] = b[j]; } } }
    const char* kb[4];
#pragma unroll
    for (int dd = 0; dd < 4; ++dd) kb[dd] = K_lds + KB * SHM_K + KSWZ(r32, (dd * 16 + hi * 8) * 2);
#pragma unroll
    for (int d0 = 0; d0 < 8; ++d0) { const char* a = kb[d0 & 3] + (d0 >> 2) * 128;
        bf16x8 b0 = *reinterpret_cast<const bf16x8*>(a);
        bf16x8 b1 = *reinterpret_cast<const bf16x8*>(a + 32 * 256);
        p0 = __builtin_amdgcn_mfma_f32_32x32x16_bf16(b0, qr[d0], p0, 0, 0, 0);
        p1 = __builtin_amdgcn_mfma_f32_32x32x16_bf16(b1, qr[d0], p1, 0, 0, 0); }
}
template <int VB>
__device__ __forceinline__ void pv_tile(f32x16* o, int vb0, bf16x8 pa0, bf16x8 pa1, bf16x8 pa2, bf16x8 pa3) {
#define TRRD(dst, off) asm volatile("ds_read_b64_tr_b16 %0, %1 offset:%2" : "=&v"(dst) : "v"(vb0), "i"(off) : "memory")
#define PV_D0(d0) do { s16x4 l0, l1, l2, l3, h0, h1, h2, h3; constexpr int b_ = VB * SHM_V + v_rd_off(d0, 0, 0); \
        TRRD(l0, b_); TRRD(h0, b_ + 2048); TRRD(l1, b_ + 4096); TRRD(h1, b_ + 6144); TRRD(l2, b_ + 8192); TRRD(h2, b_ + 10240); TRRD(l3, b_ + 12288); TRRD(h3, b_ + 14336); \
        asm volatile("s_waitcnt lgkmcnt(0)" ::: "memory"); SBAR();   \
        o[d0] = __builtin_amdgcn_mfma_f32_32x32x16_bf16(pa0, (bf16x8){l0[0], l0[1], l0[2], l0[3], h0[0], h0[1], h0[2], h0[3]}, o[d0], 0, 0, 0);   \
        o[d0] = __builtin_amdgcn_mfma_f32_32x32x16_bf16(pa1, (bf16x8){l1[0], l1[1], l1[2], l1[3], h1[0], h1[1], h1[2], h1[3]}, o[d0], 0, 0, 0);   \
        o[d0] = __builtin_amdgcn_mfma_f32_32x32x16_bf16(pa2, (bf16x8){l2[0], l2[1], l2[2], l2[3], h2[0], h2[1], h2[2], h2[3]}, o[d0], 0, 0, 0);   \
        o[d0] = __builtin_amdgcn_mfma_f32_32x32x16_bf16(pa3, (bf16x8){l3[0], l3[1], l3[2], l3[3], h3[0], h3[1], h3[2], h3[3]}, o[d0], 0, 0, 0); } while (0)
    PV_D0(0); PV_D0(1); PV_D0(2); PV_D0(3);
#undef PV_D0
#undef TRRD
}

struct BlockRef { const bf16* Q; const bf16* K; const bf16* V; bf16* O; const float* FK; int P0; };
#define ROWV(p, k0, rr) ((p) + (size_t)((k0) + (rr)) * VS + sc)
#define VMW() asm volatile("s_waitcnt vmcnt(0)" ::: "memory")
__device__ __forceinline__ void attn_block(const BlockRef& cur, int ja, int nt, bool fin, bf16* Opart, float* ML, char* lds, LAS unsigned char* ldsL, const int wv) {
    const int tid = opq_tid(wv), wid = wv, lane = tid & 63, r32 = lane & 31, hi = lane >> 5;
    const int NT = nt;
    const int qlo = cur.P0 + wid * QBLK, qm = qlo + r32 - 4 * hi;
    char* V_lds = lds; char* K_lds = lds + 2 * SHM_V;
    float* ws = (float*)(lds + OFF_WS) + wid * 64; float* li_l = ws, * al_l = ws + 32;
    float m_reg = -1e30f, l_reg = 0; f32x16 o[4] = {};
    const int vb0 = (int)(uintptr_t)V_lds + v_rd_base(lane);
    const bf16* Kh = cur.K; const bf16* Vh = cur.V; const float* Fh = cur.FK;
    bf16x8 st_v0, st_v1; bf16x8 qr[8];
#define KDMA(bf, k0) do { int t_ = tid; asm volatile("" : "+v"(t_)); _Pragma("unroll") for (int i_ = 0; i_ < 2; ++i_) { const int p_ = i_ * 512 + t_, r_ = p_ >> 4, c_ = (p_ & 15) ^ (r_ & 7); \
        __builtin_amdgcn_global_load_lds((const unsigned*)((const char*)Kh + (size_t)(k0) * KS * 2 + (unsigned)(r_ * KS * 2 + c_ * 16)), (LAS unsigned*)(ldsL + 2 * SHM_V + (bf) * SHM_K + i_ * 8192 + wid * 1024), 16, 0, 0); } \
        if (wid == 0) __builtin_amdgcn_global_load_lds((const unsigned*)(Fh + (k0) + lane), (LAS unsigned*)(ldsL + OFF_NF + (bf) * 256), 4, 0, 0); } while (0)
#define SLOADV(k0) do { int t_ = tid; asm volatile("" : "+v"(t_)); const int sr = t_ >> 4, sc = (t_ & 15) * 8; st_v0 = load8(ROWV(Vh, k0, sr)); st_v1 = load8(ROWV(Vh, k0, 32 + sr)); } while (0)
#define SWRITE_HV(bf) do { int t_ = tid; asm volatile("" : "+v"(t_)); const int sr = t_ >> 4, sc = (t_ & 15) * 8; *(bf16x8*)(V_lds + (bf) * SHM_V + v_st(sr, sc)) = st_v0; *(bf16x8*)(V_lds + (bf) * SHM_V + v_st(32 + sr, sc)) = st_v1; } while (0)
#define RESC(a) do { if (__any((a) < 1.f)) { if (hi == 0) al_l[r32] = (a); asm volatile("s_waitcnt lgkmcnt(0)" ::: "memory");              \
                     for (int d_ = 0; d_ < 4; ++d_) for (int r = 0; r < 16; ++r) o[d_][r] *= al_l[crow(r, hi)]; } } while (0)
#define KBASE(t) ((ja + (t)) * KVBLK)
#define MASKT(P0_, P1_, t) do { const int kb_ = KBASE(t); if (kb_ + KVBLK - 1 > qlo) mask_tile(P0_, P1_, qm - kb_); } while (0)
    f32x16 pA0, pA1, pB0, pB1; float mnA, mnB, alA, alB; bf16x8 pa0, pa1, pa2, pa3;
    KDMA(0, KBASE(0)); SLOADV(KBASE(0));
#pragma unroll
    for (int d0 = 0; d0 < 8; ++d0) qr[d0] = load8(cur.Q + (size_t)(wid * QBLK + r32) * QS + d0 * 16 + hi * 8);
    VMW(); SWRITE_HV(0);
    __syncthreads();
    if (NT > 1) { KDMA(1, KBASE(1)); SLOADV(KBASE(1)); }
    SBAR(); qkt<0>(pA0, pA1, K_lds, r32, hi, qr);
    MASKT(pA0, pA1, 0); partialSM(pA0, pA1, m_reg, mnA, alA);
    if (NT > 1) { VMW(); SWRITE_HV(1); }
    __syncthreads();
#define HALF_STEP(PX0, PX1, mnX, alX, PY0, PY1, alY, t, KB, VB, SB) do {                                                      \
        SBAR(); qkt<KB>(PX0, PX1, K_lds, r32, hi, qr);                                                                        \
        finishSM(PY0, PY1, alY, l_reg, pa0, pa1, pa2, pa3); SBAR();                                                           \
        if ((t) + 1 < NT) { KDMA(SB, KBASE((t) + 1)); SLOADV(KBASE((t) + 1)); SBAR(); }                                       \
        pv_tile<VB>(o, vb0, pa0, pa1, pa2, pa3); MASKT(PX0, PX1, (t)); partialSM(PX0, PX1, m_reg, mnX, alX);                  \
        VMW(); __syncthreads();                                                                                               \
        if ((t) + 1 < NT) { SWRITE_HV(SB); }                                                                                  \
        RESC(alX); __syncthreads(); } while (0)
    for (int t = 1; t + 1 < NT; t += 2) {
        HALF_STEP(pB0, pB1, mnB, alB, pA0, pA1, alA, t, 1, 0, 0);
        HALF_STEP(pA0, pA1, mnA, alA, pB0, pB1, alB, t + 1, 0, 1, 1);
    }
    const bool even = (NT & 1) == 0;
    if (even) { SBAR(); qkt<1>(pB0, pB1, K_lds, r32, hi, qr); SBAR(); }
    finishSM(pA0, pA1, alA, l_reg, pa0, pa1, pa2, pa3); SBAR();
    pv_tile<0>(o, vb0, pa0, pa1, pa2, pa3);
    if (even) { MASKT(pB0, pB1, NT - 1); partialSM(pB0, pB1, m_reg, mnB, alB); __syncthreads(); RESC(alB);
        finishSM(pB0, pB1, alB, l_reg, pa0, pa1, pa2, pa3); SBAR(); pv_tile<1>(o, vb0, pa0, pa1, pa2, pa3); }
    SBAR();
    if (hi == 0) li_l[r32] = l_reg; asm volatile("s_waitcnt lgkmcnt(0)" ::: "memory");
    float rli[16];
#pragma unroll
    for (int r = 0; r < 16; ++r) rli[r] = __builtin_amdgcn_rcpf(li_l[crow(r, hi)]);
    const int ostr = fin ? OS : D;
    bf16* Ow = (fin ? cur.O : Opart) + (size_t)(wid * QBLK) * ostr;
#pragma unroll
    for (int r = 0; r < 16; ++r) { const int orow = crow(r, hi);
#pragma unroll
        for (int d0 = 0; d0 < 4; ++d0) { const float v = o[d0][r] * rli[r];
            const float vn = xor_f<1>(v);
            if ((r32 & 1) == 0) *(GAS unsigned*)(Ow + (size_t)orow * ostr + d0 * 32 + r32) = cvtpk(v, vn); } }
    if (!fin && hi == 0) { f32x2 mlv; mlv.x = m_reg; mlv.y = l_reg; *(GAS f32x2*)(ML + (size_t)(wid * QBLK + r32) * 2) = mlv; }
    __syncthreads();
#undef KDMA
#undef SLOADV
#undef SWRITE_HV
#undef RESC
#undef KBASE
#undef MASKT
#undef HALF_STEP
}
#undef ROWV
#undef VMW
}
struct Frame {
    LAS unsigned char* lds; volatile LAS unsigned* MISC; gu32* ctl;
    int tid, lane, wave, vcu, G;
    unsigned char* ws;
};
#define CAS __attribute__((address_space(4)))
__device__ __forceinline__ const float* karg(int k) { const CAS char* p = (const CAS char*)__builtin_amdgcn_kernarg_segment_ptr(); asm volatile("" : "+s"(p)); return *(const float* const CAS*)(p + 8 * k); }

__device__ __forceinline__ void tr_item(const float* W, size_t ldw, bf16* WT, size_t ldk, LAS float* scr, int lane) {
    const int kr = lane >> 3, c4 = (lane & 7) * 4;
    f32x4 v[8];
#pragma unroll
    for (int i = 0; i < 8; ++i) v[i] = __builtin_nontemporal_load((const GAS f32x4*)(W + (size_t)(8 * i + kr) * ldw + c4));
#pragma unroll
    for (int i = 0; i < 8; ++i) { LAS float* s = scr + (8 * i + kr) * 33 + c4; s[0] = v[i].x; s[1] = v[i].y; s[2] = v[i].z; s[3] = v[i].w; }
    LDS_WAIT();
    const int c = lane & 7;
#pragma unroll
    for (int j = 0; j < 4; ++j) { const int n = (lane >> 3) + 8 * j; const LAS float* s = scr + (8 * c) * 33 + n;
        u32x4 o; o.x = cvt_pk_bf16(s[0 * 33], s[1 * 33]); o.y = cvt_pk_bf16(s[2 * 33], s[3 * 33]); o.z = cvt_pk_bf16(s[4 * 33], s[5 * 33]); o.w = cvt_pk_bf16(s[6 * 33], s[7 * 33]);
        *(GAS u32x4*)(WT + (size_t)n * ldk + 8 * c) = o; }
    LDS_WAIT();
}
__device__ __forceinline__ void tr_item8(const float* W, size_t ldw, unsigned char* WT, size_t ldk, LAS float* scr, int lane) {
    const int kr = lane >> 3, c4 = (lane & 7) * 4;
    f32x4 v[2][8];
#pragma unroll
    for (int hh = 0; hh < 2; ++hh)
#pragma unroll
        for (int i = 0; i < 8; ++i) v[hh][i] = __builtin_nontemporal_load((const GAS f32x4*)(W + (size_t)(8 * i + kr) * ldw + 32 * hh + c4));
#pragma unroll
    for (int hh = 0; hh < 2; ++hh) {
#pragma unroll
        for (int i = 0; i < 8; ++i) { LAS float* s = scr + (8 * i + kr) * 33 + c4; s[0] = v[hh][i].x; s[1] = v[hh][i].y; s[2] = v[hh][i].z; s[3] = v[hh][i].w; }
        LDS_WAIT();
        const int c = lane & 3;
#pragma unroll
        for (int j = 0; j < 2; ++j) { const int n = (lane >> 2) + 16 * j; const LAS float* s = scr + (16 * c) * 33 + n;
            u32x4 o;
            o.x = cvt_pk4_fp8(s[0 * 33] * W8_SCALE, s[1 * 33] * W8_SCALE, s[2 * 33] * W8_SCALE, s[3 * 33] * W8_SCALE); o.y = cvt_pk4_fp8(s[4 * 33] * W8_SCALE, s[5 * 33] * W8_SCALE, s[6 * 33] * W8_SCALE, s[7 * 33] * W8_SCALE);
            o.z = cvt_pk4_fp8(s[8 * 33] * W8_SCALE, s[9 * 33] * W8_SCALE, s[10 * 33] * W8_SCALE, s[11 * 33] * W8_SCALE); o.w = cvt_pk4_fp8(s[12 * 33] * W8_SCALE, s[13 * 33] * W8_SCALE, s[14 * 33] * W8_SCALE, s[15 * 33] * W8_SCALE);
            *(GAS u32x4*)(WT + (size_t)(32 * hh + n) * ldk + 16 * c) = o; }
        LDS_WAIT();
    }
}
constexpr int I_IN = (DM / 64) * (NZ / 32), I_OUT = (DM / 64) * (DM / 32), I_GU = (DM / 64) * (DEX / 32), I_D = (DEX / 64) * (DM / 32);
constexpr int GV_FIRST = 43;
constexpr int BGI_SMALL = (NLAYER * 4 * 8) / 8, BGI_IN = I_IN / 16, BGI_GV0 = (128 - GV_FIRST) * 4, BGI_GV1 = 128 * 4, BGI_OUT = I_OUT / 8, BGI_GU = NEXP * 2 * I_GU / 16, BGI_D = NEXP * I_D / 16;
constexpr int BG_C0 = BGI_SMALL + BGI_IN;
constexpr int BG_C1 = BG_C0 + BGI_GV0 + BGI_OUT;
constexpr int BG_C2 = BG_C1 + BGI_GU;
constexpr int BG_C3 = BG_C2 + BGI_D;
constexpr int BG_C3B = BG_C3 + BGI_GV1;
constexpr int BG_C4 = BG_C3B + BGI_IN;
constexpr int BG_C5 = BG_C4 + BGI_OUT;
constexpr int BG_C6 = BG_C5 + BGI_GU;
constexpr int BG_C7 = BG_C6 + BGI_D;
__device__ __forceinline__ float mod_at(const unsigned char* ws, const float* b_ada, int l, int j) {
    const float* p = (const float*)(ws + WS_MODP) + (size_t)l * 6 * DM + j;
    return *(const GAS float*)(b_ada + (size_t)l * 6 * DM + j) + ((*(const GAS float*)p + *(const GAS float*)(p + 2 * 6 * DM)) + (*(const GAS float*)(p + 4 * 6 * DM) + *(const GAS float*)(p + 6 * 6 * DM)));
}
__device__ __forceinline__ void gemv_item(const Frame& F, unsigned char* ws, int w) {
    LAS float* sc = (LAS float*)F.lds; LAS f32x4* red = (LAS f32x4*)(F.lds + 8192);
    const int kq = w & 3, l = w >> 9, cb = (w >> 2) & 127, c4 = F.tid % 24, kg = F.tid / 24;
    if (F.tid < 512) sc[F.tid] = silu_f(*(const GAS float*)(karg(1) + kq * 512 + F.tid));
    __syncthreads();
    f32x4 acc = (f32x4){0.f, 0.f, 0.f, 0.f};
    if (kg < 21) {
        const float* wp = karg(2) + (size_t)l * DM * 6 * DM + (size_t)(kq * 512) * 6 * DM + cb * 96 + c4 * 4;
#pragma unroll 8
        for (int k = kg; k < 512; k += 21) { const f32x4 wv = __builtin_nontemporal_load((const GAS f32x4*)(wp + (size_t)k * 6 * DM)); acc += wv * sc[k]; }
        red[kg * 24 + c4] = acc;
    }
    __syncthreads();
    if (F.tid < 24) { f32x4 s = red[F.tid];
        for (int g = 1; g < 21; ++g) s += red[g * 24 + F.tid];
        *(GAS f32x4*)((float*)(ws + WS_MODP) + (size_t)kq * 2 * 6 * DM + (size_t)l * 6 * DM + cb * 96 + F.tid * 4) = s; }
    __syncthreads();
}
__device__ __forceinline__ void conv_wave_item(const Frame& F, unsigned char* ws, int r, int l, LAS float* scr) {
    if (r < I_IN) { const int kb = r / (NZ / 32), nb = r % (NZ / 32);
        tr_item8(karg(6) + (size_t)l * DM * NIN + (size_t)(64 * kb) * NIN + 32 * nb, NIN, ws + WS_WIN + (size_t)l * NZ * DM + (size_t)(32 * nb) * DM + 64 * kb, DM, scr, F.lane); return; }
    r -= I_IN;
    if (r < I_OUT) { const int kb = r / (DM / 32), nb = r % (DM / 32);
        tr_item(karg(15) + (size_t)l * DM * DM + (size_t)(64 * kb) * DM + 32 * nb, DM, (bf16*)(ws + WS_WOUT) + (size_t)l * DM * DM + (size_t)(32 * nb) * DM + 64 * kb, DM, scr, F.lane); return; }
    r -= I_OUT;
    if (r < NEXP * 2 * I_GU) { const int e = r / (2 * I_GU); r -= e * 2 * I_GU; const int up = r >= I_GU; if (up) r -= I_GU; const int kb = r / (DEX / 32), nb = r % (DEX / 32), n0 = 32 * nb;
        const float* src = (up ? karg(19) : karg(18)) + ((size_t)l * NEXP + e) * DM * DEX + (size_t)(64 * kb) * DEX + n0;
        const int drow = (n0 >> 7) * 256 + (up ? 128 : 0) + (n0 & 127);
        tr_item8(src, DEX, ws + WS_WGU + ((size_t)l * NEXP + e) * DM * DM + (size_t)drow * DM + 64 * kb, DM, scr, F.lane); return; }
    r -= NEXP * 2 * I_GU;
    { const int e = r / I_D; r -= e * I_D; const int kb = r / (DM / 32), nb = r % (DM / 32);
      tr_item8(karg(20) + ((size_t)l * NEXP + e) * DEX * DM + (size_t)(64 * kb) * DM + 32 * nb, DM, ws + WS_WD + ((size_t)l * NEXP + e) * DM * DEX + (size_t)(32 * nb) * DEX + 64 * kb, DEX, scr, F.lane); }
}
__device__ __forceinline__ void bg_item(const Frame& F, unsigned char* ws, int t) {
    LAS float* scr = (LAS float*)(F.lds + 16384 + F.wave * 9216);
    if (t < BGI_SMALL) { const int r = t * 8 + F.wave, mat = r >> 3, q = r & 7, kb = q >> 2, nb = q & 3;
        tr_item(karg(10) + (size_t)mat * 128 * 128 + (size_t)(64 * kb) * 128 + 32 * nb, 128, (bf16*)(ws + WS_BWT) + (size_t)mat * 128 * 128 + (size_t)(32 * nb) * 128 + 64 * kb, 128, scr, F.lane); return; }
    t -= BGI_SMALL;
    if (t < BGI_IN) { conv_wave_item(F, ws, (t * 8 + F.wave) * 2, 0, scr); return; }
    t -= BGI_IN;
    if (t < BGI_GV0) { gemv_item(F, ws, GV_FIRST * 4 + t); return; }
    t -= BGI_GV0;
    if (t < BGI_OUT) { conv_wave_item(F, ws, I_IN + t * 8 + F.wave, 0, scr); return; }
    t -= BGI_OUT;
    if (t < BGI_GU + BGI_D) { conv_wave_item(F, ws, I_IN + I_OUT + (t * 8 + F.wave) * 2, 0, scr); return; }
    t -= BGI_GU + BGI_D;
    if (t < BGI_GV1) { gemv_item(F, ws, 512 + t); return; }
    t -= BGI_GV1;
    if (t < BGI_IN) { conv_wave_item(F, ws, (t * 8 + F.wave) * 2, 1, scr); return; }
    t -= BGI_IN;
    if (t < BGI_OUT) { conv_wave_item(F, ws, I_IN + t * 8 + F.wave, 1, scr); return; }
    t -= BGI_OUT;
    conv_wave_item(F, ws, I_IN + I_OUT + (t * 8 + F.wave) * 2, 1, scr);
}
__device__ __forceinline__ void bg_fill(const Frame& F0, int seam, int need) {
    unsigned char* const ws = opq(F0.ws); Frame F = F0; F.tid = opq_tid(F0.wave); F.lane = F.tid & 63; F.lds = opq(F0.lds);
    LAS unsigned* slot = (LAS unsigned*)(F.lds + AUX_OFF + 24576);
    gu32* const ctl_ = opq(F0.ctl); gu32* ticket = ctl_ + CW_BGT; gu32* arr = ctl_ + CW_ARR + 64 * seam;
    unsigned tn = 0xffffffffu; bool pre = false;
    if (F.tid == 0 && slot[1] == 0u) { (void)__hip_atomic_fetch_add(arr, 1u, RLX_AGENT); const unsigned cur = __hip_atomic_load(ticket, RLX_AGENT);
        if (cur >= (unsigned)BG_C7) slot[1] = 1u;
        else if (cur < (unsigned)need || __hip_atomic_load(arr, RLX_AGENT) < (unsigned)F.G) tn = __hip_atomic_fetch_add(ticket, 1u, RLX_AGENT); }
    for (;;) {
        if (F.tid == 0) slot[0] = tn;
        __syncthreads();
        const unsigned t = __builtin_amdgcn_readfirstlane(slot[0]);
        __syncthreads();
        if (t >= (unsigned)BG_C7) { if (F.tid == 0 && t != 0xffffffffu) slot[1] = 1u; break; }
        if (F.tid == 0) { tn = 0xffffffffu; pre = (t + 2u < (unsigned)need);
            if (pre) tn = __hip_atomic_fetch_add(ticket, 1u, RLX_AGENT); }
        bg_item(F, ws, (int)t);
        if (F.tid == 0 && !pre) { if (t + 1u < (unsigned)need || __hip_atomic_load(arr, RLX_AGENT) < (unsigned)F.G) tn = __hip_atomic_fetch_add(ticket, 1u, RLX_AGENT); }
    }
}
__device__ __forceinline__ void p0_prologue(const Frame& F0) {
    unsigned char* const ws = opq(F0.ws); Frame F = F0; F.tid = opq_tid(F0.wave); F.lane = F.tid & 63; F.lds = opq(F0.lds);
    for (int w = F.vcu; w < GV_FIRST * 4; w += F.G) gemv_item(F, ws, w);
    const float* const a_ws_ = karg(7);
    for (int i = (F.vcu * NTHR + F.tid) * 2; i < NLAYER * 4 * 128 * 128; i += F.G * NTHR * 2) {
        const int t = (i >> 7) & 127, s = i & 127;
        const f32x2 w = *(const GAS f32x2*)(a_ws_ + i);
        const bool keep = (s >> 6) <= (t >> 6);
        *(GAS unsigned*)((bf16*)(ws + WS_WM) + i) = keep ? cvt_pk_bf16(w.x, w.y) : 0u;
    }
}

template <int MODE>
__device__ __forceinline__ void phase_norm1(const Frame& F0, int l, const float* xin, float* xout, int lprev) {
    unsigned char* const ws = opq(F0.ws); Frame F = F0; F.tid = opq_tid(F0.wave); F.lane = F.tid & 63; F.lds = opq(F0.lds);
    LAS float* wfT = (LAS float*)F.lds;
    LAS float* gaL = (LAS float*)(F.lds + 65536);
    LAS float* gbL = (LAS float*)(F.lds + 73728);
    LAS float* g2L = (LAS float*)(F.lds + 81920);
    LAS float* lf = (LAS float*)(F.lds + 90112);
    LAS int* hb = (LAS int*)(F.lds + 91136);
    const float* const b_ada_ = karg(3); const float* const c_bf_ = karg(14);
    if (MODE != 2) {
        const float* const w_in_ = karg(6); const float* const g_mix_ = karg(4);
        for (int i = F.tid; i < DM * 2; i += NTHR) { const int d = i >> 1, half = i & 1;
            const f32x4 w = *(const GAS f32x4*)(w_in_ + (size_t)l * DM * NIN + (size_t)d * NIN + NZ + half * 4);
            wfT[(half * 4 + 0) * DM + d] = w.x; wfT[(half * 4 + 1) * DM + d] = w.y; wfT[(half * 4 + 2) * DM + d] = w.z; wfT[(half * 4 + 3) * DM + d] = w.w; }
        for (int d = F.tid; d < DM; d += NTHR) { gaL[d] = *(const GAS float*)(g_mix_ + (size_t)l * DM + d) * (1.f + mod_at(ws, b_ada_, l, DM + d)); gbL[d] = mod_at(ws, b_ada_, l, d); }
    }
    if (MODE != 0) {
        for (int d = F.tid; d < DM; d += NTHR) g2L[d] = mod_at(ws, b_ada_, lprev, 5 * DM + d);
        if (F.tid == 0) { int a = 0; for (int e = 0; e < NEXP; ++e) { hb[e] = a; a += ((int)__hip_atomic_load(F.ctl + CW_CNT + 64 * lprev + e, RLX_AGENT) + 255) & ~255; } }
    }
    __syncthreads();
    const bf16* YB = (const bf16*)(ws + WS_YB);
    f32x4 vA[8], vB[8]; u32x2 yA0[8], yA1[8], yB0[8], yB1[8];
#define N1_LOAD(V, Y0, Y1, rr) do { const int t_ = c * 32 + F.wave * 4 + (rr);                                                                 \
        _Pragma("unroll") for (int j = 0; j < 8; ++j) V[j] = *(const GAS f32x4*)(xin + (size_t)t_ * DM + 256 * j + 4 * F.lane);                   \
        if (MODE != 0) { const int r0_ = __builtin_amdgcn_readlane(rowA, (rr)), r1_ = __builtin_amdgcn_readlane(rowB, (rr));                      \
            _Pragma("unroll") for (int j = 0; j < 8; ++j) { const int d = 256 * j + 4 * F.lane;                                                    \
                Y0[j] = *(const GAS u32x2*)(YB + (size_t)r0_ * DM + d); Y1[j] = *(const GAS u32x2*)(YB + (size_t)r1_ * DM + d); } } } while (0)
#define N1_PROC(V, Y0, Y1, rr) do { const int rl = F.wave * 4 + (rr), t = c * 32 + rl;                                                          \
        if (MODE != 0) { const float w0 = __builtin_bit_cast(float, __builtin_amdgcn_readlane(__builtin_bit_cast(int, gwA), (rr))), w1 = __builtin_bit_cast(float, __builtin_amdgcn_readlane(__builtin_bit_cast(int, gwB), (rr))); \
            _Pragma("unroll") for (int j = 0; j < 8; ++j) { const int d = 256 * j + 4 * F.lane;                                                    \
                const f32x4 g2 = *(const LAS f32x4*)(g2L + d); const u32x2 y0 = Y0[j], y1 = Y1[j];                                                 \
                f32x4 y; y.x = w0 * bf_lo(y0.x) + w1 * bf_lo(y1.x); y.y = w0 * bf_hi(y0.x) + w1 * bf_hi(y1.x); y.z = w0 * bf_lo(y0.y) + w1 * bf_lo(y1.y); y.w = w0 * bf_hi(y0.y) + w1 * bf_hi(y1.y); \
                V[j] = V[j] + g2 * y;                                                                                                               \
                *(GAS f32x4*)(xout + (size_t)t * DM + d) = V[j]; } }                                                                               \
        if (MODE != 2) {                                                                                                                           \
            float ss = 0.f;                                                                                                                        \
            _Pragma("unroll") for (int j = 0; j < 8; ++j) ss += (V[j].x * V[j].x + V[j].y * V[j].y) + (V[j].z * V[j].z + V[j].w * V[j].w);         \
            const float rs = rsqrtf(wave_sum(ss) * (1.f / DM) + EPSN);                                                                             \
            float fz[8] = {0.f, 0.f, 0.f, 0.f, 0.f, 0.f, 0.f, 0.f};                                                                                \
            unsigned char* hrow = ws + WS_H + (size_t)t * DM;                                   \
            _Pragma("unroll") for (int j = 0; j < 8; ++j) { const int d = 256 * j + 4 * F.lane;                                                    \
                const f32x4 h = V[j] * rs * *(const LAS f32x4*)(gaL + d) + *(const LAS f32x4*)(gbL + d);                                           \
                *(GAS unsigned*)(hrow + d) = cvt_pk4_fp8(h.x * H8_SCALE, h.y * H8_SCALE, h.z * H8_SCALE, h.w * H8_SCALE);                          \
                _Pragma("unroll") for (int q = 0; q < 8; ++q) { const f32x4 w = *(const LAS f32x4*)(wfT + q * DM + d); fz[q] += (h.x * w.x + h.y * w.y) + (h.z * w.z + h.w * w.w); } } \
            _Pragma("unroll") for (int q = 0; q < 8; ++q) fz[q] = wave_sum(fz[q]);                                                                 \
            if (F.lane < 8) { float z = fz[0];                                                                                                     \
                _Pragma("unroll") for (int q = 1; q < 8; ++q) z = (F.lane == q) ? fz[q] : z;                                                       \
                z += *(const GAS float*)(c_bf_ + l * 8 + F.lane);                                                                                  \
                lf[rl * 8 + F.lane] = fminf(z, 0.f) - 0.6931471805599453f * __builtin_amdgcn_logf(1.f + __builtin_amdgcn_exp2f(-LOG2E * fabsf(z))); } } } while (0)
    for (int c = F.vcu; c < SEQ / 32; c += F.G) {
        int rowA = 0, rowB = 0; float gwA = 0.f, gwB = 0.f;
        if (MODE != 0) { const int t_ = c * 32 + F.wave * 4 + (F.lane & 3);
            const int* te = (const int*)(ws + WS_TOKE) + 2 * t_; const int* tp = (const int*)(ws + WS_TOKP) + 2 * t_; const float* tw = (const float*)(ws + WS_TOKW) + 2 * t_;
            rowA = hb[*(const GAS int*)te] + *(const GAS int*)tp; rowB = hb[*(const GAS int*)(te + 1)] + *(const GAS int*)(tp + 1); gwA = *(const GAS float*)tw; gwB = *(const GAS float*)(tw + 1); }
        N1_LOAD(vA, yA0, yA1, 0); N1_LOAD(vB, yB0, yB1, 1);
        N1_PROC(vA, yA0, yA1, 0); N1_LOAD(vA, yA0, yA1, 2);
        N1_PROC(vB, yB0, yB1, 1); N1_LOAD(vB, yB0, yB1, 3);
        N1_PROC(vA, yA0, yA1, 2); N1_PROC(vB, yB0, yB1, 3);
        if (MODE != 2) {
            __syncthreads();
            if (F.tid < 8) { float a = 0.f; float* floc = (float*)(ws + WS_FLOC);
                for (int r = 0; r < 32; ++r) { a += lf[r * 8 + F.tid]; *(GAS float*)(floc + (size_t)(c * 32 + r) * 8 + F.tid) = a; }
                *(GAS float*)((float*)(ws + WS_TOT) + c * 8 + F.tid) = a; }
            __syncthreads();
        }
    }
#undef N1_LOAD
#undef N1_PROC
}

__device__ __forceinline__ void fkl_fixup(const Frame& F0) {
    unsigned char* const ws = opq(F0.ws); Frame F = F0; F.tid = opq_tid(F0.wave); F.lane = F.tid & 63; F.lds = opq(F0.lds);
    LAS float* preL = (LAS float*)(F.lds + AUX_OFF + 8192);
    const float* tot = (const float*)(ws + WS_TOT);
    for (int c = F.vcu; c < SEQ / 32; c += F.G) {
        { const int h = F.wave; double s = 0.0;
#pragma unroll
            for (int q = 0; q < 4; ++q) { const int cc = 4 * F.lane + q; if (cc < c) s += (double)*(const GAS float*)(tot + cc * 8 + h); }
            float hi_ = (float)s, lo_ = (float)(s - (double)hi_);
            hi_ = wave_sum(hi_); lo_ = wave_sum(lo_);
            if (F.lane == 0) preL[h] = hi_ + lo_; }
        __syncthreads();
        if (F.tid < 256) { const int r = F.tid >> 3, h = F.tid & 7, t = c * 32 + r;
            *(GAS float*)((float*)(ws + WS_FKL) + (size_t)h * SEQ + t) = (preL[h] + *(const GAS float*)((const float*)(ws + WS_FLOC) + (size_t)t * 8 + h)) * -11.313708498984761f; }
        __syncthreads();
    }
}

__device__ __forceinline__ void phase_small_item(const Frame& F0, int l, int item) {
    unsigned char* const ws = opq(F0.ws); Frame F = F0; F.tid = opq_tid(F0.wave); F.lane = F.tid & 63; F.lds = opq(F0.lds);
    const int fr = F.lane & 15, fq = F.lane >> 4, w = F.wave;
    const bf16* Z = (const bf16*)(ws + WS_Z); bf16* YC = (bf16*)(ws + WS_YCAT);
    f32x4 acc[8];
#pragma unroll
    for (int m = 0; m < 8; ++m) acc[m] = (f32x4){0.f, 0.f, 0.f, 0.f};
    const float* a_bs_ = opq(karg(8)); const float* b_scale_ = opq(karg(11));
    if (item < 256) {
        const int blk = item >> 2, h = item & 3;
        const bf16* VN = (const bf16*)(ws + WS_VN) + (size_t)(blk * 128) * 512 + h * 128 + 16 * w + fr;
        const bf16* WM = (const bf16*)(ws + WS_WM) + ((size_t)(l * 4 + h) * 128) * 128;
        bf16x8 yb[4];
#pragma unroll
        for (int ks = 0; ks < 4; ++ks)
#pragma unroll
            for (int j = 0; j < 8; ++j) yb[ks][j] = (short)*(const GAS bf16*)(VN + (size_t)(ks * 32 + 8 * fq + j) * 512);
#pragma unroll
        for (int m = 0; m < 8; ++m)
#pragma unroll
            for (int ks = 0; ks < 4; ++ks) { const bf16x8 xa = *(const GAS bf16x8*)(WM + (size_t)(16 * m + fr) * 128 + ks * 32 + 8 * fq);
                acc[m] = __builtin_amdgcn_mfma_f32_16x16x32_bf16(yb[ks], xa, acc[m], 0, 0, 0); }
#pragma unroll
        for (int m = 0; m < 8; ++m) { const int tl = 16 * m + fr, t = blk * 128 + tl, col = h * 128 + 16 * w + 4 * fq;
            const float bsv = *(const GAS float*)(a_bs_ + l * 512 + h * 128 + tl);
            const u32x2 u = *(const GAS u32x2*)(Z + (size_t)t * NZ + col);
            u32x2 o; o.x = cvt_pk_bf16(bf_lo(u.x) * (acc[m][0] + bsv), bf_hi(u.x) * (acc[m][1] + bsv)); o.y = cvt_pk_bf16(bf_lo(u.y) * (acc[m][2] + bsv), bf_hi(u.y) * (acc[m][3] + bsv));
            *(GAS u32x2*)(YC + (size_t)t * DM + col) = o; }
    } else {
        const int rb = (item - 256) >> 2, g = (item - 256) & 3;
        const int wnd = 2 << g, r0 = rb * 128;
        LAS bf16* pt = (LAS bf16*)(F.lds + 86016);
        LAS bf16* dt = (LAS bf16*)F.lds;
        __syncthreads();
        for (int i = F.tid; i < 144 * 16; i += NTHR) { const int rr = i >> 4, cc = (i & 15) * 8, tg = r0 - 16 + rr;
            u32x4 v = (u32x4){0u, 0u, 0u, 0u}; if (tg >= 0) v = *(const GAS u32x4*)(Z + (size_t)tg * NZ + 1024 + g * 128 + cc);
            *(LAS u32x4*)(pt + rr * 128 + cc) = v; }
        __syncthreads();
        { const int c = F.tid & 127, rg = F.tid >> 7;
            float sum = 0.f;
            for (int j = 1; j < wnd; ++j) sum += bf_lo((unsigned)pt[(16 + 32 * rg - j) * 128 + c]);
            for (int i = 0; i < 32; ++i) { const int tl = 32 * rg + i, tg = r0 + tl; const float pv = bf_lo((unsigned)pt[(16 + tl) * 128 + c]);
                sum += pv;
                const float cnt = (float)((tg + 1 < wnd) ? (tg + 1) : wnd);
                const float dv = sum / cnt - pv;
                dt[tl * 136 + c] = (bf16)(cvt_pk_bf16(dv, 0.f) & 0xffffu);
                sum -= bf_lo((unsigned)pt[(16 + tl - (wnd - 1)) * 128 + c]); } }
        __syncthreads();
        const bf16* BWT = (const bf16*)(ws + WS_BWT) + ((size_t)(l * 4 + g) * 128) * 128;
        bf16x8 yb[4];
#pragma unroll
        for (int ks = 0; ks < 4; ++ks) yb[ks] = *(const GAS bf16x8*)(BWT + (size_t)(16 * w + fr) * 128 + ks * 32 + 8 * fq);
#pragma unroll
        for (int m = 0; m < 8; ++m)
#pragma unroll
            for (int ks = 0; ks < 4; ++ks) { const bf16x8 xa = *(const LAS bf16x8*)(dt + (16 * m + fr) * 136 + ks * 32 + 8 * fq);
                acc[m] = __builtin_amdgcn_mfma_f32_16x16x32_bf16(yb[ks], xa, acc[m], 0, 0, 0); }
        __syncthreads();
        const f32x4 bsc = *(const GAS f32x4*)(b_scale_ + l * 512 + g * 128 + 16 * w + 4 * fq);
#pragma unroll
        for (int m = 0; m < 8; ++m) { const int t = rb * 128 + 16 * m + fr, col = 512 + g * 128 + 16 * w + 4 * fq;
            u32x2 o; o.x = cvt_pk_bf16(acc[m][0] * bsc.x, acc[m][1] * bsc.y); o.y = cvt_pk_bf16(acc[m][2] * bsc.z, acc[m][3] * bsc.w);
            *(GAS u32x2*)(YC + (size_t)t * DM + col) = o; }
    }
}

__device__ __forceinline__ void phase_norm2_route(const Frame& F0, int l) {
    unsigned char* const ws = opq(F0.ws); Frame F = F0; F.tid = opq_tid(F0.wave); F.lane = F.tid & 63; F.lds = opq(F0.lds);
    LAS float* wrT = (LAS float*)F.lds;
    LAS float* gaL = (LAS float*)(F.lds + AUX_OFF);
    LAS float* gbL = (LAS float*)(F.lds + AUX_OFF + 8192);
    LAS int* lcnt = (LAS int*)(F.lds + AUX_OFF + 16384);
    const float* const w_router_ = karg(16); const float* const g_ffn_ = karg(5); const float* const b_ada_ = karg(3); const float* const b_router_ = karg(17);
    for (int i = F.tid; i < DM * 4; i += NTHR) { const int d = i >> 2, q = i & 3;
        const f32x4 w = *(const GAS f32x4*)(w_router_ + (size_t)d * 16 + q * 4);
        wrT[(q * 4 + 0) * DM + d] = w.x; wrT[(q * 4 + 1) * DM + d] = w.y; wrT[(q * 4 + 2) * DM + d] = w.z; wrT[(q * 4 + 3) * DM + d] = w.w; }
    for (int d = F.tid; d < DM; d += NTHR) { gaL[d] = *(const GAS float*)(g_ffn_ + (size_t)l * DM + d) * (1.f + mod_at(ws, b_ada_, l, 4 * DM + d)); gbL[d] = mod_at(ws, b_ada_, l, 3 * DM + d); }
    const float* X1 = (const float*)(ws + WS_X1);
    float brt[16];
#pragma unroll
    for (int e = 0; e < 16; ++e) brt[e] = *(const GAS float*)(b_router_ + e);
    for (int c = F.vcu; c < SEQ / 32; c += F.G) {
        if (F.tid < 32) lcnt[F.tid] = 0;
        __syncthreads();
        int my_e0 = 0, my_e1 = 0, my_r0 = 0, my_r1 = 0; float my_w0 = 0.f, my_w1 = 0.f;
        f32x4 vA[8], vB[8];
#define N2_LOAD(V, rr) do { const int t_ = c * 32 + F.wave * 4 + (rr); _Pragma("unroll") for (int j = 0; j < 8; ++j) V[j] = *(const GAS f32x4*)(X1 + (size_t)t_ * DM + 256 * j + 4 * F.lane); } while (0)
#define N2_PROC(V, rr) do { const int t = c * 32 + F.wave * 4 + (rr);                                                                           \
            float ss = 0.f;                                                                                                                        \
            _Pragma("unroll") for (int j = 0; j < 8; ++j) ss += (V[j].x * V[j].x + V[j].y * V[j].y) + (V[j].z * V[j].z + V[j].w * V[j].w);         \
            const float rs = rsqrtf(wave_sum(ss) * (1.f / DM) + EPSN);                                                                             \
            float lg[16];                                                                                                                          \
            _Pragma("unroll") for (int e = 0; e < 16; ++e) lg[e] = 0.f;                                                                            \
            unsigned char* hrow = ws + WS_H + (size_t)t * DM;                          \
            _Pragma("unroll") for (int j = 0; j < 8; ++j) { const int d = 256 * j + 4 * F.lane;                                                    \
                const f32x4 h = V[j] * rs * *(const LAS f32x4*)(gaL + d) + *(const LAS f32x4*)(gbL + d);                                           \
                *(GAS unsigned*)(hrow + d) = cvt_pk4_fp8(h.x * H8_SCALE, h.y * H8_SCALE, h.z * H8_SCALE, h.w * H8_SCALE);                          \
                _Pragma("unroll") for (int e = 0; e < 16; ++e) { const f32x4 w = *(const LAS f32x4*)(wrT + e * DM + d); lg[e] += (h.x * w.x + h.y * w.y) + (h.z * w.z + h.w * w.w); } } \
            _Pragma("unroll") for (int e = 0; e < 16; ++e) lg[e] = wave_sum(lg[e]);                                                                \
            float sc[16], sel[16];                                                                                                                 \
            _Pragma("unroll") for (int e = 0; e < 16; ++e) { sc[e] = __builtin_amdgcn_rcpf(1.f + __builtin_amdgcn_exp2f(-LOG2E * lg[e])); sel[e] = sc[e] + brt[e]; }                      \
            int bg = 0; float bgs = -INFINITY;                                                                                                     \
            _Pragma("unroll") for (int g = 0; g < 4; ++g) { float a = -INFINITY, b = -INFINITY;                                                    \
                _Pragma("unroll") for (int i = 0; i < 4; ++i) { const float x = sel[g * 4 + i]; if (x > a) { b = a; a = x; } else if (x > b) b = x; } \
                if (a + b > bgs) { bgs = a + b; bg = g; } }                                                                                        \
            int e0 = 0, e1 = 0; float a = -INFINITY, b = -INFINITY, s0 = 0.f, s1 = 0.f;                                                            \
            _Pragma("unroll") for (int g = 0; g < 4; ++g)                                                                                          \
                _Pragma("unroll") for (int i = 0; i < 4; ++i) { const int e = g * 4 + i; const float x = sel[e];                                   \
                    if (g == bg) { if (x > a) { b = a; e1 = e0; s1 = s0; a = x; e0 = e; s0 = sc[e]; } else if (x > b) { b = x; e1 = e; s1 = sc[e]; } } } \
            const float inv = 1.f / (s0 + s1);                                                                                                     \
            if (F.lane == (rr)) { my_e0 = e0; my_e1 = e1; my_w0 = s0 * inv; my_w1 = s1 * inv; } } while (0)
        N2_LOAD(vA, 0);
#pragma unroll 1
        for (int rp = 0; rp < 2; ++rp) {
            N2_LOAD(vB, 2 * rp + 1);
            N2_PROC(vA, 2 * rp);
            if (rp == 0) N2_LOAD(vA, 2);
            N2_PROC(vB, 2 * rp + 1);
        }
        if (F.lane < 4) { my_r0 = __hip_atomic_fetch_add(&lcnt[my_e0], 1, __ATOMIC_RELAXED, __HIP_MEMORY_SCOPE_WORKGROUP); my_r1 = __hip_atomic_fetch_add(&lcnt[my_e1], 1, __ATOMIC_RELAXED, __HIP_MEMORY_SCOPE_WORKGROUP); }
        __syncthreads();
        if (F.tid < 16) lcnt[16 + F.tid] = (int)__hip_atomic_fetch_add(F.ctl + CW_CNT + 64 * l + F.tid, (unsigned)lcnt[F.tid], RLX_AGENT);
        __syncthreads();
        if (F.lane < 4) { const int t = c * 32 + F.wave * 4 + F.lane;
            const int p0 = lcnt[16 + my_e0] + my_r0, p1 = lcnt[16 + my_e1] + my_r1;
            int* list = (int*)(ws + WS_LIST);
            *(GAS int*)(list + my_e0 * SEQ + p0) = t; *(GAS int*)(list + my_e1 * SEQ + p1) = t;
            *(GAS int*)((int*)(ws + WS_TOKE) + 2 * t) = my_e0; *(GAS int*)((int*)(ws + WS_TOKE) + 2 * t + 1) = my_e1;
            *(GAS int*)((int*)(ws + WS_TOKP) + 2 * t) = p0; *(GAS int*)((int*)(ws + WS_TOKP) + 2 * t + 1) = p1;
            *(GAS float*)((float*)(ws + WS_TOKW) + 2 * t) = my_w0; *(GAS float*)((float*)(ws + WS_TOKW) + 2 * t + 1) = my_w1; }
        __syncthreads();
    }
#undef N2_LOAD
#undef N2_PROC
}

struct MoeOrder {
    int G, c, total, K, nct; const char* Bt; size_t estride; const int* list; LAS int* tab;
    __device__ __forceinline__ bool next(int i, gm::Unit& u) const {
        const int L = i * G + c; if (L >= total) return false;
        const int q = L / nct, ct = L - q * nct;
        int e = 0;
#pragma unroll
        for (int k = 1; k < NEXP; ++k) e += (q >= tab[k]) ? 1 : 0;
        e = __builtin_amdgcn_readfirstlane(e);
        const int rt = q - __builtin_amdgcn_readfirstlane(tab[e]);
        u.e = e; u.rt = rt; u.arow = (__builtin_amdgcn_readfirstlane(tab[e]) + rt) * 256; u.orow = u.arow; u.ocol = ct * 256;
        u.Bp = Bt + (size_t)e * estride + (size_t)ct * 256 * K * 2; return true;
    }
    __device__ __forceinline__ int row_of(const gm::Unit& u, int r) const {
        const int p = u.rt * 256 + r, n = tab[32 + u.e], pc = p < n ? p : n - 1;
        const int v = *(const GAS int*)(list + u.e * SEQ + pc);
        return (p < n) ? v : 0;
    }
};
__device__ __forceinline__ void moe_table(const Frame& F, int l, LAS int* tab) {
    __syncthreads();
    if (F.tid == 0) { int a = 0;
        for (int e = 0; e < NEXP; ++e) { const int n = (int)__hip_atomic_load(F.ctl + CW_CNT + 64 * l + e, RLX_AGENT); tab[e] = a; tab[32 + e] = n; a += (n + 255) >> 8; }
        tab[16] = a; }
    __syncthreads();
}

constexpr int ATT_CH = 24;
struct MixTab { LAS int* jlo; LAS int* items; LAS int* nitems; LAS float* fend; LAS int* scan; };
__device__ __forceinline__ MixTab mix_tab_ptrs(LAS unsigned char* lds) {
    MixTab T; T.jlo = (LAS int*)(lds + 69632); T.items = (LAS int*)(lds + 69632 + 1024); T.nitems = (LAS int*)(lds + 69632 + 1024 + 8192); T.fend = (LAS float*)(lds + 69632 + 1024 + 8192 + 64);
    T.scan = (LAS int*)(lds + 69632 + 1024 + 8192 + 64 + 4096); return T;
}
__device__ __forceinline__ void mix_build_table(const Frame& F0, int l, const MixTab& T) {
    unsigned char* const ws = opq(F0.ws); const int tid = opq_tid(F0.wave);
    const float* FKL = (const float*)(ws + WS_FKL);
    for (int i = tid; i < 1024; i += NTHR) T.fend[i] = *(const GAS float*)(FKL + (size_t)(i >> 7) * SEQ + (i & 127) * 64 + 63);
    float gq = 0.f, gk = 0.f; const float* const c_qg_ = karg(12); const float* const c_kg_ = karg(13);
    { const int ln = tid & 63; gq = fmaxf(fabsf(*(const GAS float*)(c_qg_ + l * 128 + ln)), fabsf(*(const GAS float*)(c_qg_ + l * 128 + 64 + ln))); gk = fmaxf(fabsf(*(const GAS float*)(c_kg_ + l * 128 + ln)), fabsf(*(const GAS float*)(c_kg_ + l * 128 + 64 + ln)));
      gq = wave_max(gq); gk = wave_max(gk); }
    const float thr = (2.f * 1.01f * 11.313708498984761f * gq * gk + 30.f) * 11.313708498984761f;
    __syncthreads();
    int nfull = 0, nrem = 0, jl = 0, nt = 0;
    if (tid < 256) { const int h = tid >> 5, qb = tid & 31; const float f0 = *(const GAS float*)(FKL + (size_t)h * SEQ + qb * 256);
        for (int j = 0; j < 4 * qb; ++j) jl += (T.fend[h * 128 + j] - f0 <= -thr) ? 1 : 0;
        nt = 4 * (qb + 1) - jl; nfull = nt / ATT_CH; nrem = (nt % ATT_CH) ? 1 : 0; T.jlo[tid] = jl | ((nfull + nrem) << 8); }
    if (tid < 256) { T.scan[tid] = nfull; T.scan[256 + tid] = nrem; }
    __syncthreads();
    for (int o = 1; o < 256; o <<= 1) { int a = 0, b = 0; if (tid < 256 && tid >= o) { a = T.scan[tid - o]; b = T.scan[256 + tid - o]; } __syncthreads();
        if (tid < 256) { T.scan[tid] += a; T.scan[256 + tid] += b; } __syncthreads(); }
    if (tid < 256) { const int totf = T.scan[255], pf = T.scan[tid] - nfull, pr = totf + T.scan[256 + tid] - nrem, jb = 4 * ((tid & 31) + 1);
        for (int c = 0; c < nfull; ++c) T.items[pf + c] = tid | (c << 8) | ((jb - (c + 1) * ATT_CH) << 12) | (ATT_CH << 20);
        if (nrem) T.items[pr] = tid | (nfull << 8) | (jl << 12) | ((nt - nfull * ATT_CH) << 20);
        if (tid == 255) T.nitems[0] = totf + T.scan[511]; }
    __syncthreads();
}
__device__ __forceinline__ void phase_attn_combine(const Frame& F0, int l, const MixTab& T) {
    unsigned char* const ws = opq(F0.ws); const int tid = opq_tid(F0.wave);
    const bf16* PART = (const bf16*)(ws + WS_PART); const float* MLb = (const float*)(ws + WS_ML); bf16* YC = (bf16*)(ws + WS_YCAT);
    for (int b = F0.vcu; b < 256; b += F0.G) {
        const int nch = __builtin_amdgcn_readfirstlane(T.jlo[b]) >> 8; if (nch <= 1) continue;
        const int h = b >> 5, qb = b & 31, row = tid >> 1, half = tid & 1;
        float m[8], w[8], mx = -3.0e38f, ws_ = 0.f;
#pragma unroll
        for (int c = 0; c < 8; ++c) { if (c < nch) { const f32x2 v = *(const GAS f32x2*)(MLb + ((size_t)(b * 8 + c) * 256 + row) * 2); m[c] = v.x; w[c] = v.y; mx = fmaxf(mx, v.x); } else { m[c] = -3.0e38f; w[c] = 0.f; } }
#pragma unroll
        for (int c = 0; c < 8; ++c) { w[c] = (c < nch) ? w[c] * __builtin_amdgcn_exp2f((m[c] - mx) * at::C2) : 0.f; ws_ += w[c]; }
        const float inv = 1.f / ws_;
        float acc[64];
#pragma unroll
        for (int i = 0; i < 64; ++i) acc[i] = 0.f;
#pragma unroll
        for (int c = 0; c < 8; ++c) { if (c < nch) { const bf16* p = PART + ((size_t)(b * 8 + c) * 256 + row) * 128 + half * 64; const float wc = w[c] * inv;
#pragma unroll
            for (int q = 0; q < 8; ++q) { const u32x4 v = *(const GAS u32x4*)(p + q * 8);
                acc[q * 8 + 0] += wc * bf_lo(v.x); acc[q * 8 + 1] += wc * bf_hi(v.x); acc[q * 8 + 2] += wc * bf_lo(v.y); acc[q * 8 + 3] += wc * bf_hi(v.y);
                acc[q * 8 + 4] += wc * bf_lo(v.z); acc[q * 8 + 5] += wc * bf_hi(v.z); acc[q * 8 + 6] += wc * bf_lo(v.w); acc[q * 8 + 7] += wc * bf_hi(v.w); } } }
        bf16* o = YC + (size_t)(qb * 256 + row) * DM + 1024 + h * 128 + half * 64;
#pragma unroll
        for (int q = 0; q < 8; ++q) { u32x4 v; v.x = cvt_pk_bf16(acc[q * 8 + 0], acc[q * 8 + 1]); v.y = cvt_pk_bf16(acc[q * 8 + 2], acc[q * 8 + 3]); v.z = cvt_pk_bf16(acc[q * 8 + 4], acc[q * 8 + 5]); v.w = cvt_pk_bf16(acc[q * 8 + 6], acc[q * 8 + 7]);
            *(GAS u32x4*)(o + q * 8) = v; }
    }
}

struct MoeDynOrder {
    int total, K; const char* Bt; size_t estride; LAS int* tab; gu32* ticket; gu32* ready; gu32* tmo; LAS unsigned* slot;
    __device__ __forceinline__ bool next(int, gm::Unit& u) const {
        if (__builtin_amdgcn_readfirstlane(threadIdx.x >> 6) == 0) {
            unsigned T = 0u;
            if ((threadIdx.x & 63) == 0) T = __hip_atomic_fetch_add(ticket, 1u, RLX_AGENT);
            T = __builtin_amdgcn_readfirstlane(T);
            if (T < (unsigned)total) {
                gu32* w = ready + 16 * (T >> 3); unsigned sp = 0u;
                while ((unsigned)__builtin_amdgcn_readfirstlane(__hip_atomic_load(w, RLX_AGENT)) < 64u) {
                    __builtin_amdgcn_s_sleep(2);
                    if ((++sp & 255u) == 0u) { if (__hip_atomic_load(tmo, RLX_AGENT) != 0u) break; if (sp > (1u << 20)) { __hip_atomic_store(tmo, 1u, RLX_AGENT); break; } } }
                __builtin_amdgcn_fence(__ATOMIC_ACQUIRE, "agent");
                asm volatile("s_waitcnt vmcnt(0)" ::: "memory");
            }
            if ((threadIdx.x & 63) == 0) slot[0] = T;
        }
        asm volatile("s_waitcnt lgkmcnt(0)" ::: "memory"); __builtin_amdgcn_s_barrier(); asm volatile("" ::: "memory");
        const unsigned T = (unsigned)__builtin_amdgcn_readfirstlane((int)slot[0]);
        if (T >= (unsigned)total) return false;
        const int q = (int)(T >> 3), ct = (int)(T & 7);
        int e = 0;
#pragma unroll
        for (int k = 1; k < NEXP; ++k) e += (q >= tab[k]) ? 1 : 0;
        e = __builtin_amdgcn_readfirstlane(e);
        u.e = e; u.rt = q - __builtin_amdgcn_readfirstlane(tab[e]); u.arow = q * 256; u.orow = u.arow; u.ocol = ct * 256;
        u.Bp = Bt + (size_t)e * estride + (size_t)ct * 256 * K * 2; return true;
    }
    __device__ __forceinline__ int row_of(const gm::Unit&, int) const { return 0; }
};
struct EpiZ {
    static constexpr bool PERM = true;
    unsigned char* wsb; int l; LAS float* Pt0;
    __device__ __forceinline__ void operator()(f32x4 (&acc)[2][2][4][2], const gm::Unit& u, int wr, int wc, int fr0, int fq0) const {
        int fr = fr0, fq = fq0; asm volatile("" : "+v"(fr), "+v"(fq));
        unsigned char* const ws = opq(wsb); LAS float* const Pt = opq(Pt0);
        bf16* const O = (bf16*)(ws + WS_Z); bf16* const QN = (bf16*)(ws + WS_QN); bf16* const KN = (bf16*)(ws + WS_KN); bf16* const VN = (bf16*)(ws + WS_VN);
        const int row0 = u.orow + wr * 64 + fr, col0 = u.ocol + wc * 32 + 8 * fq;
        const bool isv = (u.ocol >= 512 && u.ocol < 1024), isq = (u.ocol >= 1536 && u.ocol < 2560), isk = (u.ocol >= 2560 && u.ocol < 3584);
        if (u.ocol < 1024) {
#pragma unroll
            for (int ai = 0; ai < 2; ++ai)
#pragma unroll
                for (int bj = 0; bj < 2; ++bj)
#pragma unroll
                    for (int m = 0; m < 4; ++m)
#pragma unroll
                        for (int n = 0; n < 2; ++n)
#pragma unroll
                            for (int j = 0; j < 4; ++j) acc[ai][bj][m][n][j] = gelu_t(acc[ai][bj][m][n][j]);
        }
        if (isv || isq || isk) {
#pragma unroll
            for (int ai = 0; ai < 2; ++ai)
#pragma unroll
                for (int m = 0; m < 4; ++m)
#pragma unroll
                    for (int bj = 0; bj < 2; ++bj) { const f32x4 a = acc[ai][bj][m][0], b = acc[ai][bj][m][1];
                        float ss = (a[0] * a[0] + a[1] * a[1]) + (a[2] * a[2] + a[3] * a[3]) + (b[0] * b[0] + b[1] * b[1]) + (b[2] * b[2] + b[3] * b[3]);
                        ss += xor_f<16>(ss);
                        { auto rr = __builtin_amdgcn_permlane32_swap(__float_as_uint(ss), __float_as_uint(ss), false, false); ss = __uint_as_float(rr[0]) + __uint_as_float(rr[1]); }
                        if (fq == 0) Pt[((ai * 128 + wr * 64 + m * 16 + fr) * 2 + bj) * 4 + wc] = ss; }
            asm volatile("s_waitcnt lgkmcnt(0)" ::: "memory"); __builtin_amdgcn_s_barrier(); asm volatile("" ::: "memory");
            const float* gp = isv ? karg(9) + l * 512 + (u.ocol - 512) + wc * 32 + 8 * fq : karg(isq ? 12 : 13) + l * 128 + wc * 32 + 8 * fq;
#pragma unroll
            for (int bj = 0; bj < 2; ++bj) {
                const f32x4 g0 = *(const GAS f32x4*)(gp + (isv ? bj * 128 : 0)), g1 = *(const GAS f32x4*)(gp + (isv ? bj * 128 : 0) + 4);
#pragma unroll
                for (int ai = 0; ai < 2; ++ai)
#pragma unroll
                    for (int m = 0; m < 4; ++m) { const int rl = ai * 128 + wr * 64 + m * 16 + fr, row = u.orow + rl;
                        const f32x4 p4 = *(const LAS f32x4*)(Pt + (rl * 2 + bj) * 4);
                        const float rs = rsqrtf(((p4[0] + p4[1]) + (p4[2] + p4[3])) * (1.f / 128.f) + EPSN);
                        const f32x4 v0 = acc[ai][bj][m][0] * rs * g0, v1 = acc[ai][bj][m][1] * rs * g1;
                        u32x4 w; w.x = cvt_pk_bf16(v0[0], v0[1]); w.y = cvt_pk_bf16(v0[2], v0[3]); w.z = cvt_pk_bf16(v1[0], v1[1]); w.w = cvt_pk_bf16(v1[2], v1[3]);
                        bf16* dst;
                        if (isv) dst = VN + (size_t)row * 512 + (u.ocol - 512) + bj * 128 + wc * 32 + 8 * fq;
                        else { const int h = ((u.ocol - (isq ? 1536 : 2560)) >> 7) + bj; dst = (isq ? QN : KN) + ((size_t)h * SEQ + row) * 128 + wc * 32 + 8 * fq; }
                        *(GAS u32x4*)dst = w; } }
            return;
        }
#pragma unroll
        for (int ai = 0; ai < 2; ++ai)
#pragma unroll
            for (int m = 0; m < 4; ++m) { bf16* rowp = O + (size_t)(row0 + ai * 128 + m * 16) * NZ + col0;
#pragma unroll
                for (int bj = 0; bj < 2; ++bj) { const f32x4 v0 = acc[ai][bj][m][0], v1 = acc[ai][bj][m][1];
                    u32x4 w; w.x = cvt_pk_bf16(v0[0], v0[1]); w.y = cvt_pk_bf16(v0[2], v0[3]); w.z = cvt_pk_bf16(v1[0], v1[1]); w.w = cvt_pk_bf16(v1[2], v1[3]);
                    *(GAS u32x4*)(rowp + bj * 128) = w; } }
    }
};
struct EpiRes {
    static constexpr bool PERM = false;
    const float* xin; const LAS float* gate; float* out;
    __device__ __forceinline__ void operator()(const f32x4 (&acc)[2][2][4][2], const gm::Unit& u, int wr, int wc, int fr, int fq) const {
        const int row0 = u.orow + wr * 64 + fr, col0 = u.ocol + wc * 32 + 4 * fq;
        f32x4 gv[2][2];
#pragma unroll
        for (int bj = 0; bj < 2; ++bj)
#pragma unroll
            for (int n = 0; n < 2; ++n) gv[bj][n] = *(const LAS f32x4*)(gate + col0 + bj * 128 + n * 16);
#pragma unroll
        for (int ai = 0; ai < 2; ++ai)
#pragma unroll
            for (int m = 0; m < 4; ++m) { const size_t off = (size_t)(row0 + ai * 128 + m * 16) * DM + col0;
#pragma unroll
                for (int bj = 0; bj < 2; ++bj)
#pragma unroll
                    for (int n = 0; n < 2; ++n) { const f32x4 xv = *(const GAS f32x4*)(xin + off + bj * 128 + n * 16);
                        *(GAS f32x4*)(out + off + bj * 128 + n * 16) = xv + gv[bj][n] * acc[ai][bj][m][n]; } }
    }
};
struct EpiHid {
    static constexpr bool PERM = true;
    bf16* O;
    __device__ __forceinline__ void operator()(const f32x4 (&acc)[2][2][4][2], const gm::Unit& u, int wr, int wc, int fr, int fq) const {
        const int row0 = u.orow + wr * 64 + fr, col0 = (u.ocol >> 1) + wc * 32 + 8 * fq;
#pragma unroll
        for (int ai = 0; ai < 2; ++ai)
#pragma unroll
            for (int m = 0; m < 4; ++m) { bf16* rowp = O + (size_t)(row0 + ai * 128 + m * 16) * DEX + col0;
                f32x4 h0, h1;
#pragma unroll
                for (int j = 0; j < 4; ++j) { h0[j] = silu_f(acc[ai][0][m][0][j]) * acc[ai][1][m][0][j]; h1[j] = silu_f(acc[ai][0][m][1][j]) * acc[ai][1][m][1][j]; }
                u32x4 w; w.x = cvt_pk_bf16(h0[0], h0[1]); w.y = cvt_pk_bf16(h0[2], h0[3]); w.z = cvt_pk_bf16(h1[0], h1[1]); w.w = cvt_pk_bf16(h1[2], h1[3]);
                *(GAS u32x4*)rowp = w; }
    }
};
struct EpiHidPub {
    static constexpr bool PERM = true;
    unsigned char* O; gu32* ready;
    __device__ __forceinline__ void operator()(const f32x4 (&acc)[2][2][4][2], const gm::Unit& u, int wr, int wc, int fr, int fq) const {
        const __amdgpu_buffer_rsrc_t rs = __builtin_amdgcn_make_buffer_rsrc(O, (short)0, (int)(HIDROWS * DEX), 0x00020000);
        const int row0 = u.orow + wr * 64 + fr, col0 = (u.ocol >> 1) + wc * 32 + 8 * fq;
#pragma unroll
        for (int ai = 0; ai < 2; ++ai)
#pragma unroll
            for (int m = 0; m < 4; ++m) { const int off = (row0 + ai * 128 + m * 16) * DEX + col0;
                f32x4 h0, h1;
#pragma unroll
                for (int j = 0; j < 4; ++j) { h0[j] = HID8_SCALE * silu_f(acc[ai][0][m][0][j]) * acc[ai][1][m][0][j]; h1[j] = HID8_SCALE * silu_f(acc[ai][0][m][1][j]) * acc[ai][1][m][1][j]; }
                u32x2 w; w.x = cvt_pk4_fp8(h0[0], h0[1], h0[2], h0[3]); w.y = cvt_pk4_fp8(h1[0], h1[1], h1[2], h1[3]);
                __builtin_amdgcn_raw_buffer_store_b64(w, rs, off, 0, 16); }
        asm volatile("s_waitcnt vmcnt(0)" ::: "memory");
        if (fr == 0 && fq == 0) (void)__hip_atomic_fetch_add(ready + 16 * (u.orow >> 8), 1u, RLX_AGENT);
    }
};
struct EpiYB {
    static constexpr bool PERM = true;
    bf16* O;
    __device__ __forceinline__ void operator()(const f32x4 (&acc)[2][2][4][2], const gm::Unit& u, int wr, int wc, int fr, int fq) const {
        const int row0 = u.orow + wr * 64 + fr, col0 = u.ocol + wc * 32 + 8 * fq;
#pragma unroll
        for (int ai = 0; ai < 2; ++ai)
#pragma unroll
            for (int m = 0; m < 4; ++m) { bf16* rowp = O + (size_t)(row0 + ai * 128 + m * 16) * DM + col0;
#pragma unroll
                for (int bj = 0; bj < 2; ++bj) { const f32x4 v0 = acc[ai][bj][m][0], v1 = acc[ai][bj][m][1];
                    u32x4 w; w.x = cvt_pk_bf16(v0[0], v0[1]); w.y = cvt_pk_bf16(v0[2], v0[3]); w.z = cvt_pk_bf16(v1[0], v1[1]); w.w = cvt_pk_bf16(v1[2], v1[3]);
                    *(GAS u32x4*)(rowp + bj * 128) = w; } }
    }
};

#ifdef MK_SELFTEST
#include "selftest.h"
#endif
__device__ __forceinline__ int bg_need(int p) {
    if (p <= 1) return 0;
    if (p <= 5) return BG_C0;
    if (p <= 7) return BG_C1;
    if (p == 8) return BG_C3;
    if (p <= 10) return BG_C3B;
    if (p <= 14) return BG_C4;
    if (p <= 16) return BG_C5;
    return BG_C7;
}
__device__ __forceinline__ bool bg_seam(int k) { if (k == 0) return true; const int j = (k - 1) % 9; return j != 2 && j != 5 && j != 8; }
struct Args { const float* in[21]; float* out; unsigned char* ws; int ph_lo, ph_hi; };
constexpr int N_PHASES = 1 + 9 * NLAYER + 1;

#ifdef MK_ONLY
#define IN(k) (((k) == 0 ? 0 : (((k) - 1) % 9) + 1) == MK_ONLY && lo <= (k) && (k) < hi)
#else
#define IN(k) (lo <= (k) && (k) < hi)
#endif
#ifndef MK_REPEAT
#define MK_REPEAT -1
#endif
#define REPS(kind) ((MK_REPEAT == (kind)) ? 2 : 1)
#define SEAM(k) do { if (IN(k)) { if (bg_seam(k)) bg_fill(F, (k), bg_need((k) + 1)); if (IN((k) + 1)) xcd_barrier(bar); } } while (0)


template <int l> __device__ __forceinline__ void layer_body(const Frame& F, const XcdBarrier& bar, const int lo, const int hi) {
    constexpr int pb = 1 + 9 * l;

        for (int rep_ = 0; rep_ < REPS(1); ++rep_) if (IN(pb)) { if (rep_) xcd_barrier(bar); unsigned char* const wsl = opq(F.ws); LAS unsigned char* const ldl = opq(F.lds); if (l == 0) phase_norm1<0>(F, l, karg(0), nullptr, 0); else phase_norm1<1>(F, l, (const float*)(wsl + WS_X1), (float*)(wsl + WS_X2), l - 1); }
        SEAM(pb);
        for (int rep_ = 0; rep_ < REPS(2); ++rep_) if (IN(pb + 1)) { if (rep_) xcd_barrier(bar); unsigned char* const wsl = opq(F.ws); LAS unsigned char* const ldl = opq(F.lds);
            const int Gg = (F.G == 256) ? 192 : F.G;
            gm::RegOrder S; S.init(SEQ, NZ, DM / 2, wsl + WS_WIN + (size_t)l * NZ * DM, Gg, (int)blockIdx.x);
            fkl_fixup(F);
            EpiZ E{wsl, l, (LAS float*)(ldl + AUX_OFF)};
            if ((int)blockIdx.x < Gg) gm::gemm_phase<EpiZ, gm::RegOrder, false, true, true, SC_H8, SC_W8>(ldl, (const char*)(wsl + WS_H), DM, S, E, F.wave); }
        SEAM(pb + 1);
        for (int rep_ = 0; rep_ < REPS(4); ++rep_) if (IN(pb + 3)) { if (rep_) xcd_barrier(bar); unsigned char* const wsl = opq(F.ws); LAS unsigned char* const ldl = opq(F.lds);
            const MixTab T = mix_tab_ptrs(ldl);
            mix_build_table(F, l, T);
            const int natt = __builtin_amdgcn_readfirstlane(T.nitems[0]), ntot = natt + 512;
            LAS int* qslot = T.nitems + 1;
            int it = F.vcu;
            while (it < ntot) {
                if (it >= natt) { phase_small_item(F, l, it - natt); }
                else {
                    const int rec = __builtin_amdgcn_readfirstlane(T.items[it]), b = rec & 255, c = (rec >> 8) & 15, ja = (rec >> 12) & 255, n = (rec >> 20) & 31, h = b >> 5, qb = b & 31;
                    const bool fin = (__builtin_amdgcn_readfirstlane(T.jlo[b]) >> 8) <= 1; unsigned char* const ws = opq(wsl);
                    at::BlockRef cur;
                    cur.Q = (const bf16*)(ws + WS_QN) + ((size_t)h * SEQ + qb * 256) * 128; cur.K = (const bf16*)(ws + WS_KN) + (size_t)h * SEQ * 128;
                    cur.V = (const bf16*)(ws + WS_Z) + 3584 + h * 128; cur.O = (bf16*)(ws + WS_YCAT) + (size_t)(qb * 256) * DM + 1024 + h * 128;
                    cur.FK = (const float*)(ws + WS_FKL) + (size_t)h * SEQ; cur.P0 = qb * 256;
                    at::attn_block(cur, ja, n, fin, (bf16*)(ws + WS_PART) + (size_t)(b * 8 + c) * 256 * 128, (float*)(ws + WS_ML) + (size_t)(b * 8 + c) * 256 * 2, (char*)ldl, ldl, F.wave);
                }
                if (opq_tid(F.wave) == 0) qslot[0] = F.G + (int)__hip_atomic_fetch_add(F.ctl + CW_Q + 64 * l + 32 * rep_, 1u, RLX_AGENT);
                __syncthreads();
                it = __builtin_amdgcn_readfirstlane(qslot[0]);
                __syncthreads();
            }
        }
        SEAM(pb + 3);
        for (int rep_ = 0; rep_ < REPS(5); ++rep_) if (IN(pb + 4)) { if (rep_) xcd_barrier(bar); unsigned char* const wsl = opq(F.ws); LAS unsigned char* const ldl = opq(F.lds); const MixTab T = mix_tab_ptrs(ldl); mix_build_table(F, l, T); phase_attn_combine(F, l, T); }
        SEAM(pb + 4);
        for (int rep_ = 0; rep_ < REPS(6); ++rep_) if (IN(pb + 5)) { if (rep_) xcd_barrier(bar); unsigned char* const wsl = opq(F.ws); LAS unsigned char* const ldl = opq(F.lds); gm::RegOrder S; S.init(SEQ, DM, DM, wsl + WS_WOUT + (size_t)l * DM * DM * 2, F.G, (int)blockIdx.x);
            LAS float* g1L = (LAS float*)(ldl + AUX_OFF);
            { const float* const b_ada_ = karg(3); for (int d = opq_tid(F.wave); d < DM; d += NTHR) g1L[d] = mod_at(wsl, b_ada_, l, 2 * DM + d); }
            __syncthreads();
            EpiRes E{(l == 0) ? karg(0) : (const float*)(wsl + WS_X2), g1L, (float*)(wsl + WS_X1)};
            gm::gemm_phase<EpiRes, gm::RegOrder, false, true>(ldl, (const char*)(wsl + WS_YCAT), DM, S, E, F.wave); }
        SEAM(pb + 5);
        for (int rep_ = 0; rep_ < REPS(7); ++rep_) if (IN(pb + 6)) { if (rep_) xcd_barrier(bar); unsigned char* const wsl = opq(F.ws); LAS unsigned char* const ldl = opq(F.lds); phase_norm2_route(F, l); }
        SEAM(pb + 6);
        for (int rep_ = 0; rep_ < REPS(8); ++rep_) if (IN(pb + 7)) { if (rep_) xcd_barrier(bar); unsigned char* const wsl = opq(F.ws); LAS unsigned char* const ldl = opq(F.lds); LAS int* tab = (LAS int*)(ldl + AUX_OFF + 20480); moe_table(F, l, tab);
            gu32* const rdy = F.ctl + CW_RDY + 4096 * l + 2048 * rep_;
            { MoeOrder S; S.G = F.G; S.c = F.vcu; S.total = 8 * tab[16]; S.K = DM / 2; S.nct = 8; S.Bt = (const char*)(wsl + WS_WGU) + (size_t)l * NEXP * DM * DM; S.estride = (size_t)DM * DM;
              S.list = (const int*)(wsl + WS_LIST); S.tab = tab;
              EpiHidPub E{wsl + (l ? WS_HID1 : WS_HID), rdy};
              gm::gemm_phase<EpiHidPub, MoeOrder, true, true, true, SC_H8, SC_W8>(ldl, (const char*)(wsl + WS_H), DM, S, E, F.wave); }
            { MoeDynOrder S; S.total = 8 * tab[16]; S.K = DEX / 2; S.Bt = (const char*)(wsl + WS_WD) + (size_t)l * NEXP * DM * DEX; S.estride = (size_t)DM * DEX; S.tab = tab;
              S.ticket = F.ctl + CW_MT + 64 * l + 32 * rep_; S.ready = rdy; S.tmo = F.ctl + CW_TMO; S.slot = (LAS unsigned*)(ldl + AUX_OFF + 24576 + 64);
              EpiYB E{(bf16*)(wsl + WS_YB)};
              gm::gemm_phase<EpiYB, MoeDynOrder, false, true, true, SC_HID8, SC_W8>(ldl, (const char*)(wsl + (l ? WS_HID1 : WS_HID)), DEX, S, E, F.wave); }
        }
        SEAM(pb + 7);
    }

__global__ void __launch_bounds__(NTHR, 2) mk_fwd(Args args) {
    extern __shared__ __attribute__((aligned(16))) unsigned char lds[];
    Frame F;
    F.lds = (LAS unsigned char*)lds; F.MISC = (volatile LAS unsigned*)(F.lds + MISC_OFF);
    F.tid = 0; F.lane = 0; F.wave = __builtin_amdgcn_readfirstlane((int)threadIdx.x >> 6);
    F.G = gridDim.x; { const int bx = blockIdx.x; F.vcu = (F.G % 8 == 0) ? (bx % 8) * (F.G / 8) + bx / 8 : bx; }
    F.ws = args.ws; F.ctl = (gu32*)(args.ws + WS_CTL);
    for (int u = threadIdx.x; u < (LDS_BYTES - RING_BYTES) / 4; u += NTHR) ((LAS unsigned*)(F.lds + RING_BYTES))[u] = 0u;
    __syncthreads();
    const int lo = args.ph_lo, hi = args.ph_hi;
    const bool multi = (hi - lo) > 1;
    XcdBarrier bar; bar.bar = (unsigned*)(F.ctl + CW_BAR); bar.x = 0; bar.st = nullptr;
    if (multi) bar = xcd_barrier_post((unsigned*)(F.ctl + CW_BAR), F.MISC + 8);
    for (int rep_ = 0; rep_ < REPS(0); ++rep_) if (IN(0)) { if (rep_) xcd_barrier(bar); p0_prologue(F); } SEAM(0);

    layer_body<0>(F, bar, lo, hi);
    layer_body<1>(F, bar, lo, hi);
    for (int rep_ = 0; rep_ < REPS(10); ++rep_) if (IN(N_PHASES - 1)) { if (rep_) xcd_barrier(bar); phase_norm1<2>(F, NLAYER - 1, (const float*)(F.ws + WS_X1), (float*)karg(21), NLAYER - 1); }
#ifdef MK_SELFTEST
    {
        const bool h0 = st_run(0, 1.f, 0x7f7f7f7f), h0s = st_run(0, 64.f, 0x79797979), h1 = st_run(1, 1.f, 0x7f7f7f7f);
        xcd_barrier(bar);
        float* o = (float*)karg(21);
        if (!(h0 && h0s)) { const float val = h0 ? 0.f : (h1 ? 1000.f : __builtin_nanf(""));
            for (size_t i = (size_t)blockIdx.x * NTHR + threadIdx.x; i < (size_t)SEQ * DM; i += (size_t)gridDim.x * NTHR) o[i] = val; }
    }
#endif
#undef IN
#undef SEAM
}

#ifndef MK_LAUNCHES
#define MK_LAUNCHES 1
#endif
extern "C" void kernel_launch(void* const* d_in, const int* in_sizes, int n_in, void* d_out, int out_size, void* d_ws, size_t ws_size, hipStream_t stream) {
    static int grid = 0;
    if (grid == 0) {
        int dev = 0, cus = 0, per_cu = 0;
        if (n_in != 21 || ws_size < WS_END) { fprintf(stderr, "kernel_launch: unexpected inputs (n_in %d, ws %zu)\n", n_in, ws_size); grid = -1; return; }
        if (hipGetDevice(&dev) != hipSuccess || hipDeviceGetAttribute(&cus, hipDeviceAttributeMultiprocessorCount, dev) != hipSuccess) { grid = -1; return; }
        if (hipFuncSetAttribute((const void*)mk_fwd, hipFuncAttributeMaxDynamicSharedMemorySize, LDS_BYTES) != hipSuccess) { fprintf(stderr, "kernel_launch: hipFuncSetAttribute failed\n"); grid = -1; return; }
        if (hipOccupancyMaxActiveBlocksPerMultiprocessor(&per_cu, (const void*)mk_fwd, NTHR, LDS_BYTES) != hipSuccess || per_cu < 1) fprintf(stderr, "kernel_launch: occupancy query says %d\n", per_cu);
        (void)hipGetLastError();
        grid = cus;
    }
    if (grid < 0) return;
    (void)hipMemsetAsync((char*)d_ws + WS_CTL, 0, CTL_ZERO_BYTES, stream);
    Args a{};
    for (int i = 0; i < 21; ++i) a.in[i] = (const float*)d_in[i];
    a.out = (float*)d_out; a.ws = (unsigned char*)d_ws;
#if MK_LAUNCHES == 1
    a.ph_lo = 0; a.ph_hi = N_PHASES;
    hipLaunchKernelGGL(mk_fwd, dim3(grid), dim3(NTHR), LDS_BYTES, stream, a);
#else
    for (int p = 0; p < N_PHASES; ++p) { a.ph_lo = p; a.ph_hi = p + 1; hipLaunchKernelGGL(mk_fwd, dim3(grid), dim3(NTHR), LDS_BYTES, stream, a); }
#endif
}
```

```cpp
#include <hip/hip_runtime.h>
#include <stdint.h>
#include <stdio.h>

#define GAS __attribute__((address_space(1)))
#define LAS __attribute__((address_space(3)))
typedef unsigned short bf16;
typedef short bf16x8 __attribute__((ext_vector_type(8)));
typedef short s16x4 __attribute__((ext_vector_type(4)));
typedef float f32x2 __attribute__((ext_vector_type(2)));
typedef float f32x4 __attribute__((ext_vector_type(4)));
typedef float f32x16 __attribute__((ext_vector_type(16)));
typedef unsigned u32x2 __attribute__((ext_vector_type(2)));
typedef unsigned u32x4 __attribute__((ext_vector_type(4)));
typedef int i32x8 __attribute__((ext_vector_type(8)));
typedef int i32x4 __attribute__((ext_vector_type(4)));
typedef GAS unsigned gu32;
#define RLX_AGENT __ATOMIC_RELAXED, __HIP_MEMORY_SCOPE_AGENT
#define LDS_WAIT() asm volatile("s_waitcnt lgkmcnt(0)" ::: "memory")
#define VM_WAIT() asm volatile("s_waitcnt vmcnt(0)" ::: "memory")

constexpr int DM = 2048, SEQ = 8192, NIN = 4616, NZ = 4608, DEX = 1024, NEXP = 16, NLAYER = 2;
constexpr float EPSN = 1e-6f;
constexpr float LOG2E = 1.4426950408889634f;
constexpr int NWAVES = 8, NTHR = 512;
constexpr int HIDROWS = 2 * SEQ + NEXP * 256;

constexpr size_t KiB = 1024, MiB = 1u << 20;
constexpr size_t WS_CTL = 0, CTL_ZERO_BYTES = 1 * MiB;
constexpr size_t WS_MOD = 1 * MiB;
constexpr size_t WS_FLOC = WS_MOD + 128 * KiB;
constexpr size_t WS_TOT = WS_FLOC + 256 * KiB;
constexpr size_t WS_FKL = WS_TOT + 8 * KiB;
constexpr size_t WS_TOKE = WS_FKL + 256 * KiB;
constexpr size_t WS_TOKP = WS_TOKE + 64 * KiB;
constexpr size_t WS_TOKW = WS_TOKP + 64 * KiB;
constexpr size_t WS_NCH = 7 * MiB;
constexpr size_t WS_LIST = WS_TOKW + 64 * KiB;
constexpr size_t WS_WM = 4 * MiB;
constexpr size_t WS_BWT = WS_WM + 256 * KiB;
constexpr size_t WS_MODP = 6 * MiB;
constexpr size_t WS_WIN = 8 * MiB;
constexpr size_t WS_WOUT = WS_WIN + 2 * 18 * MiB;
constexpr size_t WS_WGU = WS_WOUT + 2 * 8 * MiB;
constexpr size_t WS_WD = WS_WGU + 2 * 16 * 8 * MiB;
constexpr size_t WS_H = WS_WD + 2 * 16 * 4 * MiB;
constexpr size_t WS_Z = WS_H + 32 * MiB;
constexpr size_t WS_QN = WS_Z + 72 * MiB;
constexpr size_t WS_KN = WS_QN + 16 * MiB;
constexpr size_t WS_VN = WS_KN + 16 * MiB;
constexpr size_t WS_DP = WS_VN + 8 * MiB;
constexpr size_t WS_YCAT = WS_DP + 8 * MiB;
constexpr size_t WS_X1 = WS_YCAT + 32 * MiB;
constexpr size_t WS_X2 = WS_X1 + 64 * MiB;
constexpr size_t WS_HID = WS_X2 + 64 * MiB;
constexpr size_t WS_YB = WS_HID + 40 * MiB;
constexpr size_t WS_PART = WS_YB + 80 * MiB;
constexpr size_t WS_ML = WS_PART + 128 * MiB;
constexpr size_t WS_HID1 = WS_ML + 4 * MiB;
constexpr size_t WS_END = WS_HID1 + 40 * MiB;
constexpr int CW_TMO = 0, CW_CODE = 1;
constexpr int CW_CNT = 64;
constexpr int CW_Q = 512;
constexpr int CW_BGT = 640;
constexpr int CW_ARR = 1024;
constexpr int CW_MT = 768;
constexpr int CW_BAR = 4096;
constexpr int CW_RDY = 8192;

constexpr int RING_BYTES = 131072;
constexpr int MISC_OFF = RING_BYTES + 320;
constexpr int AUX_OFF = RING_BYTES + 1024;
constexpr int LDS_BYTES = 163840;

template <class T> __device__ __forceinline__ T* opq(T* p) { asm volatile("" : "+s"(p)); return p; }
__device__ __forceinline__ int opq_tid(int wave) { int t = (wave << 6) | (int)__builtin_amdgcn_mbcnt_hi(~0u, __builtin_amdgcn_mbcnt_lo(~0u, 0u)); asm volatile("" : "+v"(t)); return t; }
__device__ __forceinline__ unsigned cvt_pk_bf16(float lo, float hi) { unsigned r; asm volatile("v_cvt_pk_bf16_f32 %0, %1, %2" : "=v"(r) : "v"(lo), "v"(hi)); return r; }
__device__ __forceinline__ unsigned cvt_pk4_fp8(float a, float b, float c, float d) {
    a = fminf(fmaxf(a, -440.f), 440.f); b = fminf(fmaxf(b, -440.f), 440.f); c = fminf(fmaxf(c, -440.f), 440.f); d = fminf(fmaxf(d, -440.f), 440.f);
    unsigned w; asm volatile("v_cvt_pk_fp8_f32 %0, %1, %2" : "=v"(w) : "v"(a), "v"(b)); asm volatile("v_cvt_pk_fp8_f32 %0, %1, %2 op_sel:[0,0,1]" : "+v"(w) : "v"(c), "v"(d)); return w; }
constexpr float H8_SCALE = 4.f, HID8_SCALE = 4.f, W8_SCALE = 64.f;
constexpr int SC_H8 = 0x7b7b7b7b, SC_HID8 = 0x7b7b7b7b, SC_W8 = 0x7b7b7b7b;
__device__ __forceinline__ float bf_lo(unsigned w) { return __uint_as_float(w << 16); }
__device__ __forceinline__ float bf_hi(unsigned w) { return __uint_as_float(w & 0xffff0000u); }
template <int M> __device__ __forceinline__ float xor_f(float v) {
    static_assert(M < 32, "xor_f: masks below 32 only");
    return __uint_as_float((unsigned)__builtin_amdgcn_ds_swizzle((int)__float_as_uint(v), (M << 10) | 0x1f));
}
__device__ __forceinline__ float wave_sum(float v) {
    v += __uint_as_float((unsigned)__builtin_amdgcn_update_dpp(0, (int)__float_as_uint(v), 0xb1, 0xf, 0xf, true));
    v += __uint_as_float((unsigned)__builtin_amdgcn_update_dpp(0, (int)__float_as_uint(v), 0x4e, 0xf, 0xf, true));
    v += __uint_as_float((unsigned)__builtin_amdgcn_update_dpp(0, (int)__float_as_uint(v), 0x141, 0xf, 0xf, true));
    v += __uint_as_float((unsigned)__builtin_amdgcn_update_dpp(0, (int)__float_as_uint(v), 0x140, 0xf, 0xf, true));
    v += xor_f<16>(v);
    { auto rr = __builtin_amdgcn_permlane32_swap(__float_as_uint(v), __float_as_uint(v), false, false); v = __uint_as_float(rr[0]) + __uint_as_float(rr[1]); }
    return v;
}
__device__ __forceinline__ float wave_max(float v) {
    v = fmaxf(v, xor_f<1>(v)); v = fmaxf(v, xor_f<2>(v)); v = fmaxf(v, xor_f<4>(v)); v = fmaxf(v, xor_f<8>(v)); v = fmaxf(v, xor_f<16>(v));
    { auto rr = __builtin_amdgcn_permlane32_swap(__float_as_uint(v), __float_as_uint(v), false, false); v = fmaxf(__uint_as_float(rr[0]), __uint_as_float(rr[1])); }
    return v;
}
__device__ __forceinline__ float gelu_t(float x) {
    const float u2 = x * (1.5957691216057308f + 0.0713548162726f * x * x);
    return x * __builtin_amdgcn_rcpf(1.f + __builtin_amdgcn_exp2f(-LOG2E * u2));
}
__device__ __forceinline__ float silu_f(float x) { return x * __builtin_amdgcn_rcpf(1.f + __builtin_amdgcn_exp2f(-LOG2E * x)); }

#define XB_TMO      128
#define XB_XCNT(j)  (256  + 64 * (j))
#define XB_XSUB(j)  (1280 + 64 * (j))
#define XB_XGEN(j)  (2304 + 64 * (j))
#define XB_TOP      3328
#define XB_TOPGEN   3392
#define XCD_BAR_WORDS 3456
#define XB_SPIN_CAP (1u << 18)
__device__ __forceinline__ unsigned xb_ld(unsigned* p)              { return __hip_atomic_load(p, __ATOMIC_RELAXED, __HIP_MEMORY_SCOPE_AGENT); }
__device__ __forceinline__ unsigned xb_add(unsigned* p, unsigned v) { return __hip_atomic_fetch_add(p, v, __ATOMIC_RELAXED, __HIP_MEMORY_SCOPE_AGENT); }
__device__ __forceinline__ unsigned xb_xcc_id() { return (unsigned)__builtin_amdgcn_s_getreg((3 << 11) | 20) & 0xFu; }
#define XB_SPIN(cond, bar) do { unsigned _sp = 0; while (cond) { __builtin_amdgcn_s_sleep(1); \
    if ((++_sp & 255u) == 0u) { if (xb_ld(&(bar)[XB_TMO])) break; if (_sp > XB_SPIN_CAP) { atomicAdd(&(bar)[XB_TMO], 1u); break; } } } } while (0)
struct XcdBarrier { unsigned* bar; unsigned x; volatile LAS unsigned* st; };
__device__ __forceinline__ XcdBarrier xcd_barrier_post(unsigned* bar, volatile LAS unsigned* st) {
    XcdBarrier b; b.bar = bar; b.x = xb_xcc_id(); b.st = st;
    if (threadIdx.x == 0) (void)xb_add(&bar[XB_XCNT(b.x)], 1u);
    return b;
}
__device__ __forceinline__ void xcd_barrier_complete(unsigned* bar, unsigned x, unsigned& nloc, unsigned& nx) {
    const unsigned G = gridDim.x * gridDim.y * gridDim.z;
    unsigned sum, cnt, mine, sp = 0u;
    for (;;) {
        sum = 0u; cnt = 0u; mine = 0u;
#pragma unroll
        for (unsigned j = 0; j < 16; ++j) { const unsigned c = xb_ld(&bar[XB_XCNT(j)]); sum += c; cnt += (c > 0u) ? 1u : 0u; mine = (j == x) ? c : mine; }
        if (sum == G) break;
        __builtin_amdgcn_s_sleep(1);
        if ((++sp & 255u) == 0u) { if (xb_ld(&bar[XB_TMO])) break; if (sp > XB_SPIN_CAP) { atomicAdd(&bar[XB_TMO], 1u); break; } }
    }
    nloc = mine > 0u ? mine : 1u; nx = cnt > 0u ? cnt : 1u;
}
__device__ __forceinline__ void xcd_barrier(const XcdBarrier& b) {
    asm volatile("s_waitcnt vmcnt(0)" ::: "memory");
    __syncthreads();
    if (threadIdx.x == 0) {
        unsigned* bar = b.bar; asm volatile("" : "+s"(bar));
        __builtin_amdgcn_s_waitcnt(0);
        unsigned nloc = b.st[0], nx = b.st[1];
        if (nloc == 0u) { xcd_barrier_complete(bar, b.x, nloc, nx); b.st[0] = nloc; b.st[1] = nx; }
        const unsigned old = xb_add(&bar[XB_XSUB(b.x)], 1u);
        const unsigned gen = old / nloc;
        if (old + 1u == (gen + 1u) * nloc) {
            __builtin_amdgcn_fence(__ATOMIC_RELEASE, "agent");
            asm volatile("s_waitcnt vmcnt(0)" ::: "memory");
            const unsigned og = xb_add(&bar[XB_TOP], 1u);
            const unsigned tg = og / nx;
            if (og + 1u == (tg + 1u) * nx) xb_add(&bar[XB_TOPGEN], 1u);
            else XB_SPIN(xb_ld(&bar[XB_TOPGEN]) == tg, bar);
            __builtin_amdgcn_fence(__ATOMIC_ACQUIRE, "agent");
            xb_add(&bar[XB_XGEN(b.x)], 1u);
            asm volatile("s_waitcnt vmcnt(0)" ::: "memory");
        } else {
            XB_SPIN(xb_ld(&bar[XB_XGEN(b.x)]) == gen, bar);
            __builtin_amdgcn_fence(__ATOMIC_ACQUIRE, "agent");
            asm volatile("s_waitcnt vmcnt(0)" ::: "memory");
        }
    }
    __syncthreads();
}

namespace gm {
constexpr int BM = 256, BK = 64, HALF = 128, HTB = HALF * BK * 2, STAGE_BYTES = 8 * HTB, NXCD = 8, WGM = 8;
__host__ __device__ __forceinline__ int lds_byte(int r, int c) { const int st = (r >> 4) * 2 + (c >> 5), rr = r & 15, cc = c & 31, ob = rr * 64 + cc * 2; return st * 1024 + (ob ^ (((ob >> 9) & 1) << 5)); }
__host__ __device__ __forceinline__ void stage_rc(int b, int& R, int& C) { const int st = b / 1024, sb = b % 1024, swz = sb ^ (((sb >> 9) & 1) << 5); R = (st >> 1) * 16 + swz / 64; C = (st & 1) * 32 + (swz % 64) / 2; }
__host__ __device__ __forceinline__ int perm32(int rho) { const int n = rho >> 4, i = rho & 15; return 8 * (i >> 2) + 4 * n + (i & 3); }

struct Unit { int arow, orow, ocol, e, rt; const char* Bp; };

template <class Epi, class Sched, bool GATHER, bool ALIGN_EPI, bool FP8 = false, int SCA = 0x7f7f7f7f, int SCB = 0x7f7f7f7f>
__device__ __forceinline__ void gemm_phase(LAS unsigned char* lds, const char* Abase, const int Kel, const Sched& S, const Epi& E, const int wv) {
    const int K = FP8 ? (Kel >> 1) : Kel;
    const int tid = opq_tid(wv), wid = wv, lane = tid & 63, wr = wid >> 2, wc = wid & 3, fr = lane & 15, fq = lane >> 4;
    const int nt = K / BK;
    unsigned voffA[2], voffB[2];
#pragma unroll
    for (int i = 0; i < 2; ++i) { int R, C; stage_rc(tid * 16 + i * 8192, R, C); const int Rb = Epi::PERM ? ((R & ~31) + perm32(R & 31)) : R;
        voffA[i] = (unsigned)(R * K + C) * 2u; voffB[i] = (unsigned)(Rb * K + C) * 2u; }
    const size_t kstep = (size_t)(BK * 2);
    const size_t hstep = (size_t)HALF * K * 2;
    const unsigned ldsw = (unsigned)wid * 1024u;
    const int aoff = FP8 ? lds_byte(wr * 64 + fr, fq * 16) : lds_byte(wr * 64 + fr, fq * 8), boff = FP8 ? lds_byte(wc * 32 + fr, fq * 16) : lds_byte(wc * 32 + fr, fq * 8);
#define PG8_SA(b, h) (((b) * 2 + (h)) * HTB)
#define PG8_SB(b, h) ((4 + (b) * 2 + (h)) * HTB)
#define PG8_STAGE(bufoff, gbase, voff) do { _Pragma("unroll") for (int _i = 0; _i < 2; ++_i) { unsigned vo_ = (voff)[_i]; asm volatile("" : "+v"(vo_));     \
        __builtin_amdgcn_global_load_lds((const unsigned*)((const char*)(gbase) + vo_), (LAS unsigned*)(lds + (bufoff) + ldsw + _i * 8192), 16, 0, 0); } } while (0)
#define PG8_STAGE_A(bufoff, ubase, h, kb, vg) do { if constexpr (GATHER) { PG8_STAGE(bufoff, Abase + (kb), (vg)[h]); } else { PG8_STAGE(bufoff, (ubase) + (h) * hstep + (kb), voffA); } } while (0)
#define PG8_STAGE_A2(bufoff, ubase, h, kb) PG8_STAGE_A(bufoff, ubase, h, kb, vgc)
#define PG8_LDA(dst, b, h) do { _Pragma("unroll") for (int m = 0; m < 4; ++m) { if constexpr (FP8) { dst##8[m].lo = *(const LAS i32x4*)(lds + PG8_SA(b, h) + aoff + m * 2048); dst##8[m].hi = *(const LAS i32x4*)(lds + PG8_SA(b, h) + aoff + 16 + m * 2048); } \
        else { dst[m][0] = *(const LAS bf16x8*)(lds + PG8_SA(b, h) + aoff + m * 2048); dst[m][1] = *(const LAS bf16x8*)(lds + PG8_SA(b, h) + aoff + 1024 + m * 2048); } } } while (0)
#define PG8_LDB(dst, b, h) do { _Pragma("unroll") for (int n = 0; n < 2; ++n) { if constexpr (FP8) { dst##8[n].lo = *(const LAS i32x4*)(lds + PG8_SB(b, h) + boff + n * 2048); dst##8[n].hi = *(const LAS i32x4*)(lds + PG8_SB(b, h) + boff + 16 + n * 2048); } \
        else { dst[n][0] = *(const LAS bf16x8*)(lds + PG8_SB(b, h) + boff + n * 2048); dst[n][1] = *(const LAS bf16x8*)(lds + PG8_SB(b, h) + boff + 1024 + n * 2048); } } } while (0)
#define PG8_F8(x) __builtin_shufflevector(__builtin_bit_cast(i32x4, (x)[0]), __builtin_bit_cast(i32x4, (x)[1]), 0, 1, 2, 3, 4, 5, 6, 7)
#define PG8_MMA(ai, bj, At, Bt) do { __builtin_amdgcn_s_setprio(1); _Pragma("unroll") for (int m = 0; m < 4; ++m) _Pragma("unroll") for (int n = 0; n < 2; ++n) { \
        if constexpr (FP8) { acc[ai][bj][m][n] = __builtin_amdgcn_mfma_scale_f32_16x16x128_f8f6f4(Bt##8[n], At##8[m], acc[ai][bj][m][n], 0, 0, 0, SCB, 0, SCA); } \
        else { _Pragma("unroll") for (int k = 0; k < 2; ++k) acc[ai][bj][m][n] = __builtin_amdgcn_mfma_f32_16x16x32_bf16(Bt[n][k], At[m][k], acc[ai][bj][m][n], 0, 0, 0); } } \
        __builtin_amdgcn_s_setprio(0); } while (0)
#define PG8_WAIT_V(n) asm volatile("s_waitcnt vmcnt(" #n ")" ::: "memory")
#define PG8_WAIT_L(n) asm volatile("s_waitcnt lgkmcnt(" #n ")" ::: "memory")
#define PG8_BAR __builtin_amdgcn_s_barrier()
#define PG8_SCHED __builtin_amdgcn_sched_barrier(0)
    Unit cur, nxt; int ui = 0;
    if (!S.next(0, cur)) return;
    f32x4 acc[2][2][4][2];
#pragma unroll
    for (int a = 0; a < 2; ++a)
#pragma unroll
        for (int b = 0; b < 2; ++b)
#pragma unroll
            for (int m = 0; m < 4; ++m)
#pragma unroll
                for (int n = 0; n < 2; ++n) acc[a][b][m][n] = (f32x4){0.f, 0.f, 0.f, 0.f};
    bf16x8 At[4][2], B0[2][2], B1[2][2];
    i32x8 At8[4], B08[2], B18[2];
    unsigned vgc[2][2];
    if constexpr (GATHER) {
#pragma unroll
        for (int h = 0; h < 2; ++h)
#pragma unroll
            for (int i = 0; i < 2; ++i) { int R_, C_; stage_rc(opq_tid(wv) * 16 + i * 8192, R_, C_); vgc[h][i] = ((unsigned)S.row_of(cur, h * HALF + R_) * (unsigned)K + (unsigned)C_) * 2u; }
    }
    const char* cA = GATHER ? Abase : Abase + (size_t)cur.arow * K * 2; const char* cB = cur.Bp;
    PG8_STAGE(PG8_SB(0, 0), cB, voffB); PG8_STAGE(PG8_SB(0, 1), cB + hstep, voffB); PG8_STAGE_A(PG8_SA(0, 0), cA, 0, 0, vgc); PG8_STAGE_A(PG8_SA(0, 1), cA, 1, 0, vgc);
    if (wr == 1) PG8_BAR;
    PG8_WAIT_V(2); PG8_BAR;
    PG8_STAGE(PG8_SB(1, 0), cB + kstep, voffB); PG8_STAGE_A(PG8_SA(1, 0), cA, 0, kstep, vgc); PG8_STAGE(PG8_SB(1, 1), cB + hstep + kstep, voffB);
    PG8_WAIT_V(6); PG8_BAR;
    for (;;) {
        bool has_next = false;
        const char* nA = cA; const char* nB = cB;
        for (int t = 0; t < nt; t += 2) {
            const bool last = (t == nt - 2);
            if (last) { has_next = S.next(ui + 1, nxt); if (has_next) { nA = GATHER ? Abase : Abase + (size_t)nxt.arow * K * 2; nB = nxt.Bp; } }
            const size_t k1 = (size_t)(t + 1) * kstep;
            const char* a2 = last ? nA : cA; const char* b2 = last ? nB : cB + (size_t)(t + 2) * kstep;
            const size_t k2 = last ? 0 : (size_t)(t + 2) * kstep, k3 = k2 + kstep;
            const char* b3 = b2 + kstep;
            PG8_LDB(B0, 0, 0); PG8_LDB(B1, 0, 1); PG8_SCHED; PG8_LDA(At, 0, 0); PG8_STAGE_A(PG8_SA(1, 1), cA, 1, k1, vgc);
            if constexpr (GATHER) { if (last && has_next) {
#pragma unroll
                for (int h = 0; h < 2; ++h)
#pragma unroll
                    for (int i = 0; i < 2; ++i) { int R_, C_; stage_rc(opq_tid(wv) * 16 + i * 8192, R_, C_); vgc[h][i] = ((unsigned)S.row_of(nxt, h * HALF + R_) * (unsigned)K + (unsigned)C_) * 2u; } } }
            PG8_WAIT_V(8); PG8_WAIT_L(0); PG8_BAR; PG8_MMA(0, 0, At, B0); PG8_MMA(0, 1, At, B1); PG8_BAR; PG8_SCHED;
            PG8_LDA(At, 0, 1); PG8_STAGE(PG8_SB(0, 0), b2, voffB); PG8_STAGE(PG8_SB(0, 1), b2 + hstep, voffB); PG8_STAGE_A2(PG8_SA(0, 0), a2, 0, k2);
            PG8_WAIT_V(8); PG8_WAIT_L(0); PG8_BAR; PG8_MMA(1, 0, At, B0); PG8_MMA(1, 1, At, B1); PG8_BAR; PG8_SCHED;
            PG8_LDB(B0, 1, 0); PG8_LDB(B1, 1, 1); PG8_SCHED; PG8_LDA(At, 1, 0); PG8_STAGE_A2(PG8_SA(0, 1), a2, 1, k2);
            PG8_WAIT_V(8); PG8_WAIT_L(0); PG8_BAR; PG8_MMA(0, 0, At, B0); PG8_MMA(0, 1, At, B1); PG8_BAR; PG8_SCHED;
            PG8_LDA(At, 1, 1); PG8_STAGE(PG8_SB(1, 0), b3, voffB); PG8_STAGE(PG8_SB(1, 1), b3 + hstep, voffB); PG8_STAGE_A2(PG8_SA(1, 0), a2, 0, k3);
            PG8_WAIT_V(8); PG8_WAIT_L(0); PG8_BAR; PG8_MMA(1, 0, At, B0); PG8_MMA(1, 1, At, B1); PG8_BAR; PG8_SCHED;
        }
        if constexpr (ALIGN_EPI) { if (wr == 0) PG8_BAR; }
        E(acc, cur, wr, wc, fr, fq);
        if (!has_next) break;
#pragma unroll
        for (int a = 0; a < 2; ++a)
#pragma unroll
            for (int b = 0; b < 2; ++b)
#pragma unroll
                for (int m = 0; m < 4; ++m)
#pragma unroll
                    for (int n = 0; n < 2; ++n) acc[a][b][m][n] = (f32x4){0.f, 0.f, 0.f, 0.f};
        cur = nxt; cA = nA; cB = nB; ++ui;
        if constexpr (ALIGN_EPI) { if (wr == 1) PG8_BAR; }
    }
    PG8_WAIT_V(0);
    if constexpr (!ALIGN_EPI) { if (wr == 0) PG8_BAR; }
    PG8_BAR;
#undef PG8_SA
#undef PG8_SB
#undef PG8_STAGE
#undef PG8_STAGE_A
#undef PG8_STAGE_A2
#undef PG8_LDA
#undef PG8_LDB
#undef PG8_MMA
#undef PG8_F8
#undef PG8_WAIT_V
#undef PG8_WAIT_L
#undef PG8_BAR
#undef PG8_SCHED
}

struct RegOrder {
    int nM, nN, nwg, G, c, K; const char* Bt;
    __device__ __forceinline__ void init(int M, int N, int K_, const void* Bt_, int G_, int c_) { nM = M / BM; nN = N / BM; nwg = nM * nN; G = G_; c = c_; K = K_; Bt = (const char*)Bt_; }
    __device__ __forceinline__ bool next(int i, Unit& u) const {
        const long L = (long)i * G + c; if (L >= nwg) return false;
        int wgid = (int)L; { const int q = nwg / NXCD, r = nwg % NXCD, xcd = wgid % NXCD, off = wgid / NXCD; wgid = (xcd < r ? xcd * (q + 1) : r * (q + 1) + (xcd - r) * q) + off; }
        const int nig = WGM * nN, gid = wgid / nig, fm = gid * WGM, gsz = (nM - fm) < WGM ? (nM - fm) : WGM;
        const int pm = fm + ((wgid % nig) % gsz), pn = (wgid % nig) / gsz;
        u.arow = pm * BM; u.orow = pm * BM; u.ocol = pn * BM; u.e = 0; u.rt = 0; u.Bp = Bt + (size_t)pn * BM * K * 2; return true;
    }
    __device__ __forceinline__ int row_of(const Unit&, int) const { return 0; }
};
}
namespace at {
constexpr int NW = 8, QBLK = 32, KVBLK = 64, QB = NW * QBLK, D = 128;
constexpr int SHM_V = KVBLK * D * 2, SHM_K = KVBLK * D * 2;
constexpr int OFF_WS = 2 * SHM_V + 2 * SHM_K, OFF_NF = OFF_WS + NW * 64 * 4, ATT_LDS = OFF_NF + 2 * 64 * 4;
constexpr float SCALE = 0.08838834764831845f, C2 = 1.4426950408889634f * SCALE, THR = 8.f;
constexpr float ISCALE = 11.313708498984761f;
constexpr int QS = 128, KS = 128, VS = NZ, OS = DM;

#define KSWZ(row, colB) ((row) * 256 + ((colB) ^ (((row) & 7) << 4)))
#define SBAR() __builtin_amdgcn_sched_barrier(0)
__device__ __forceinline__ int v_st(int k, int c) { const int kk = (k & ~0xC) | ((k & 4) << 1) | ((k & 8) >> 1); return ((kk >> 3) * 4 + (c >> 5)) * 512 + ((kk & 7) * 32 + (c & 31)) * 2; }
__device__ __forceinline__ int v_rd_base(int lane) { return ((lane & 3) << 3) | (((lane >> 2) & 3) << 6) | (((lane >> 4) & 1) << 5) | (((lane >> 5) & 1) << 8); }
constexpr int v_rd_off(int d0, int ks, int half) { return d0 * 512 + ks * 4096 + half * 2048; }
__device__ __forceinline__ int crow(int r, int hi) { return (r & 3) + 8 * (r >> 2) + 4 * hi; }
__device__ __forceinline__ unsigned cvtpk(float lo, float hi) { unsigned r; asm volatile("v_cvt_pk_bf16_f32 %0, %1, %2" : "=v"(r) : "v"(lo), "v"(hi)); return r; }
__device__ __forceinline__ bf16x8 load8(const bf16* p) { return *(const GAS bf16x8*)p; }

__device__ __forceinline__ void mask_tile(f32x16& p0, f32x16& p1, int dq) {
    const float NEG = -__builtin_inff();
#pragma unroll
    for (int r = 0; r < 16; ++r) {
        const int c = (r & 3) + 8 * (r >> 2);
        if (dq - c < 0) p0[r] = NEG;
        if (dq - c - 32 < 0) p1[r] = NEG;
    }
}
__device__ __forceinline__ void partialSM(f32x16& p0, f32x16& p1, float& m_reg, float& mn, float& alpha) {
    float pmax = p0[0]; for (int r = 1; r < 16; ++r) pmax = fmaxf(pmax, p0[r]); for (int r = 0; r < 16; ++r) pmax = fmaxf(pmax, p1[r]);
    { auto rr = __builtin_amdgcn_permlane32_swap(__float_as_uint(pmax), __float_as_uint(pmax), false, false);
      pmax = fmaxf(__uint_as_float(rr[0]), __uint_as_float(rr[1])); }
    if (__builtin_expect(__all((pmax - m_reg) * SCALE <= THR), 1)) { mn = m_reg; alpha = 1.f; }
    else { mn = fmaxf(m_reg, pmax); alpha = __builtin_amdgcn_exp2f((m_reg - mn) * C2); m_reg = mn; }
    const float mnL = -mn * C2;
    for (int r = 0; r < 16; ++r) p0[r] = fmaf(p0[r], C2, mnL); for (int r = 0; r < 16; ++r) p1[r] = fmaf(p1[r], C2, mnL);
    for (int r = 0; r < 16; ++r) p0[r] = __builtin_amdgcn_exp2f(p0[r]);
}
__device__ __forceinline__ void finishSM(f32x16& p0, f32x16& p1, float alpha, float& l_reg, bf16x8& pa0, bf16x8& pa1, bf16x8& pa2, bf16x8& pa3) {
    for (int r = 0; r < 16; ++r) p1[r] = __builtin_amdgcn_exp2f(p1[r]);
    float ps = 0; for (int r = 0; r < 16; ++r) ps += p0[r]; for (int r = 0; r < 16; ++r) ps += p1[r];
    { auto rr = __builtin_amdgcn_permlane32_swap(__float_as_uint(ps), __float_as_uint(ps), false, false);
      ps = __uint_as_float(rr[0]) + __uint_as_float(rr[1]); }
    l_reg = l_reg * alpha + ps;
#define PK4(P, B_, OUT) do { unsigned a0 = cvtpk(P[B_+0], P[B_+1]), a1 = cvtpk(P[B_+2], P[B_+3]);                          \
        unsigned b0 = cvtpk(P[B_+4], P[B_+5]), b1 = cvtpk(P[B_+6], P[B_+7]);                                             \
        auto r0 = __builtin_amdgcn_permlane32_swap(a0, b0, false, false); auto r1 = __builtin_amdgcn_permlane32_swap(a1, b1, false, false); \
        u32x4 w = {r0[0], r1[0], r0[1], r1[1]}; OUT = *reinterpret_cast<bf16x8*>(&w); } while (0)
    PK4(p0, 0, pa0); PK4(p0, 8, pa1); PK4(p1, 0, pa2); PK4(p1, 8, pa3);
#undef PK4
}
template <int KB>
__device__ __forceinline__ void qkt(f32x16& p0, f32x16& p1, const char* K_lds, int r32, int hi, const bf16x8* qr) {
    { const float* nf = (const float*)(K_lds + 2 * SHM_K + NW * 64 * 4) + KB * 64 + 4 * hi;
#pragma unroll
      for (int g = 0; g < 4; ++g) { const f32x4 a = *(const f32x4*)(nf + 8 * g), b = *(const f32x4*)(nf + 32 + 8 * g);
#pragma unroll
          for (int j = 0; j < 4; ++j) { p0[4 * g + j] = a[j]; p1[4 * g + j] = b[j]; } } }
    const char* kb[4];
#pragma unroll
    for (int dd = 0; dd < 4; ++dd) kb[dd] = K_lds + KB * SHM_K + KSWZ(r32, (dd * 16 + hi * 8) * 2);
#pragma unroll
    for (int d0 = 0; d0 < 8; ++d0) { const char* a = kb[d0 & 3] + (d0 >> 2) * 128;
        bf16x8 b0 = *reinterpret_cast<const bf16x8*>(a);
        bf16x8 b1 = *reinterpret_cast<const bf16x8*>(a + 32 * 256);
        p0 = __builtin_amdgcn_mfma_f32_32x32x16_bf16(b0, qr[d0], p0, 0, 0, 0);
        p1 = __builtin_amdgcn_mfma_f32_32x32x16_bf16(b1, qr[d0], p1, 0, 0, 0); }
}
template <int VB>
__device__ __forceinline__ void pv_tile(f32x16* o, int vb0, bf16x8 pa0, bf16x8 pa1, bf16x8 pa2, bf16x8 pa3) {
#define TRRD(dst, off) asm volatile("ds_read_b64_tr_b16 %0, %1 offset:%2" : "=&v"(dst) : "v"(vb0), "i"(off) : "memory")
#define PV_D0(d0) do { s16x4 l0, l1, l2, l3, h0, h1, h2, h3; constexpr int b_ = VB * SHM_V + v_rd_off(d0, 0, 0); \
        TRRD(l0, b_); TRRD(h0, b_ + 2048); TRRD(l1, b_ + 4096); TRRD(h1, b_ + 6144); TRRD(l2, b_ + 8192); TRRD(h2, b_ + 10240); TRRD(l3, b_ + 12288); TRRD(h3, b_ + 14336); \
        asm volatile("s_waitcnt lgkmcnt(0)" ::: "memory"); SBAR();   \
        o[d0] = __builtin_amdgcn_mfma_f32_32x32x16_bf16(pa0, (bf16x8){l0[0], l0[1], l0[2], l0[3], h0[0], h0[1], h0[2], h0[3]}, o[d0], 0, 0, 0);   \
        o[d0] = __builtin_amdgcn_mfma_f32_32x32x16_bf16(pa1, (bf16x8){l1[0], l1[1], l1[2], l1[3], h1[0], h1[1], h1[2], h1[3]}, o[d0], 0, 0, 0);   \
        o[d0] = __builtin_amdgcn_mfma_f32_32x32x16_bf16(pa2, (bf16x8){l2[0], l2[1], l2[2], l2[3], h2[0], h2[1], h2[2], h2[3]}, o[d0], 0, 0, 0);   \
        o[d0] = __builtin_amdgcn_mfma_f32_32x32x16_bf16(pa3, (bf16x8){l3[0], l3[1], l3[2], l3[3], h3[0], h3[1], h3[2], h3[3]}, o[d0], 0, 0, 0); } while (0)
    PV_D0(0); PV_D0(1); PV_D0(2); PV_D0(3);
#undef PV_D0
#undef TRRD
}

struct BlockRef { const bf16* Q; const bf16* K; const bf16* V; bf16* O; const float* FK; int P0; };
#define ROWV(p, k0, rr) ((p) + (size_t)((k0) + (rr)) * VS + sc)
#define VMW() asm volatile("s_waitcnt vmcnt(0)" ::: "memory")
__device__ __forceinline__ void attn_block(const BlockRef& cur, int ja, int nt, bool fin, bf16* Opart, float* ML, char* lds, LAS unsigned char* ldsL, const int wv) {
    const int tid = opq_tid(wv), wid = wv, lane = tid & 63, r32 = lane & 31, hi = lane >> 5;
    const int NT = nt;
    const int qlo = cur.P0 + wid * QBLK, qm = qlo + r32 - 4 * hi;
    char* V_lds = lds; char* K_lds = lds + 2 * SHM_V;
    float* ws = (float*)(lds + OFF_WS) + wid * 64; float* li_l = ws, * al_l = ws + 32;
    float m_reg = -1e30f, l_reg = 0; f32x16 o[4] = {};
    const int vb0 = (int)(uintptr_t)V_lds + v_rd_base(lane);
    const bf16* Kh = cur.K; const bf16* Vh = cur.V; const float* Fh = cur.FK;
    bf16x8 st_v0, st_v1; bf16x8 qr[8];
#define KDMA(bf, k0) do { int t_ = tid; asm volatile("" : "+v"(t_)); _Pragma("unroll") for (int i_ = 0; i_ < 2; ++i_) { const int p_ = i_ * 512 + t_, r_ = p_ >> 4, c_ = (p_ & 15) ^ (r_ & 7); \
        __builtin_amdgcn_global_load_lds((const unsigned*)((const char*)Kh + (size_t)(k0) * KS * 2 + (unsigned)(r_ * KS * 2 + c_ * 16)), (LAS unsigned*)(ldsL + 2 * SHM_V + (bf) * SHM_K + i_ * 8192 + wid * 1024), 16, 0, 0); } \
        if (wid == 0) __builtin_amdgcn_global_load_lds((const unsigned*)(Fh + (k0) + lane), (LAS unsigned*)(ldsL + OFF_NF + (bf) * 256), 4, 0, 0); } while (0)
#define SLOADV(k0) do { int t_ = tid; asm volatile("" : "+v"(t_)); const int sr = t_ >> 4, sc = (t_ & 15) * 8; st_v0 = load8(ROWV(Vh, k0, sr)); st_v1 = load8(ROWV(Vh, k0, 32 + sr)); } while (0)
#define SWRITE_HV(bf) do { int t_ = tid; asm volatile("" : "+v"(t_)); const int sr = t_ >> 4, sc = (t_ & 15) * 8; *(bf16x8*)(V_lds + (bf) * SHM_V + v_st(sr, sc)) = st_v0; *(bf16x8*)(V_lds + (bf) * SHM_V + v_st(32 + sr, sc)) = st_v1; } while (0)
#define RESC(a) do { if (__any((a) < 1.f)) { if (hi == 0) al_l[r32] = (a); asm volatile("s_waitcnt lgkmcnt(0)" ::: "memory");              \
                     for (int d_ = 0; d_ < 4; ++d_) for (int r = 0; r < 16; ++r) o[d_][r] *= al_l[crow(r, hi)]; } } while (0)
#define KBASE(t) ((ja + (t)) * KVBLK)
#define MASKT(P0_, P1_, t) do { const int kb_ = KBASE(t); if (kb_ + KVBLK - 1 > qlo) mask_tile(P0_, P1_, qm - kb_); } while (0)
    f32x16 pA0, pA1, pB0, pB1; float mnA, mnB, alA, alB; bf16x8 pa0, pa1, pa2, pa3;
    KDMA(0, KBASE(0)); SLOADV(KBASE(0));
#pragma unroll
    for (int d0 = 0; d0 < 8; ++d0) qr[d0] = load8(cur.Q + (size_t)(wid * QBLK + r32) * QS + d0 * 16 + hi * 8);
    VMW(); SWRITE_HV(0);
    __syncthreads();
    if (NT > 1) { KDMA(1, KBASE(1)); SLOADV(KBASE(1)); }
    SBAR(); qkt<0>(pA0, pA1, K_lds, r32, hi, qr);
    MASKT(pA0, pA1, 0); partialSM(pA0, pA1, m_reg, mnA, alA);
    if (NT > 1) { VMW(); SWRITE_HV(1); }
    __syncthreads();
#define HALF_STEP(PX0, PX1, mnX, alX, PY0, PY1, alY, t, KB, VB, SB) do {                                                      \
        SBAR(); qkt<KB>(PX0, PX1, K_lds, r32, hi, qr);                                                                        \
        finishSM(PY0, PY1, alY, l_reg, pa0, pa1, pa2, pa3); SBAR();                                                           \
        if ((t) + 1 < NT) { KDMA(SB, KBASE((t) + 1)); SLOADV(KBASE((t) + 1)); SBAR(); }                                       \
        pv_tile<VB>(o, vb0, pa0, pa1, pa2, pa3); MASKT(PX0, PX1, (t)); partialSM(PX0, PX1, m_reg, mnX, alX);                  \
        VMW(); __syncthreads();                                                                                               \
        if ((t) + 1 < NT) { SWRITE_HV(SB); }                                                                                  \
        RESC(alX); __syncthreads(); } while (0)
    for (int t = 1; t + 1 < NT; t += 2) {
        HALF_STEP(pB0, pB1, mnB, alB, pA0, pA1, alA, t, 1, 0, 0);
        HALF_STEP(pA0, pA1, mnA, alA, pB0, pB1, alB, t + 1, 0, 1, 1);
    }
    const bool even = (NT & 1) == 0;
    if (even) { SBAR(); qkt<1>(pB0, pB1, K_lds, r32, hi, qr); SBAR(); }
    finishSM(pA0, pA1, alA, l_reg, pa0, pa1, pa2, pa3); SBAR();
    pv_tile<0>(o, vb0, pa0, pa1, pa2, pa3);
    if (even) { MASKT(pB0, pB1, NT - 1); partialSM(pB0, pB1, m_reg, mnB, alB); __syncthreads(); RESC(alB);
        finishSM(pB0, pB1, alB, l_reg, pa0, pa1, pa2, pa3); SBAR(); pv_tile<1>(o, vb0, pa0, pa1, pa2, pa3); }
    SBAR();
    if (hi == 0) li_l[r32] = l_reg; asm volatile("s_waitcnt lgkmcnt(0)" ::: "memory");
    float rli[16];
#pragma unroll
    for (int r = 0; r < 16; ++r) rli[r] = __builtin_amdgcn_rcpf(li_l[crow(r, hi)]);
    const int ostr = fin ? OS : D;
    bf16* Ow = (fin ? cur.O : Opart) + (size_t)(wid * QBLK) * ostr;
#pragma unroll
    for (int r = 0; r < 16; ++r) { const int orow = crow(r, hi);
#pragma unroll
        for (int d0 = 0; d0 < 4; ++d0) { const float v = o[d0][r] * rli[r];
            const float vn = xor_f<1>(v);
            if ((r32 & 1) == 0) *(GAS unsigned*)(Ow + (size_t)orow * ostr + d0 * 32 + r32) = cvtpk(v, vn); } }
    if (!fin && hi == 0) { f32x2 mlv; mlv.x = m_reg; mlv.y = l_reg; *(GAS f32x2*)(ML + (size_t)(wid * QBLK + r32) * 2) = mlv; }
    __syncthreads();
#undef KDMA
#undef SLOADV
#undef SWRITE_HV
#undef RESC
#undef KBASE
#undef MASKT
#undef HALF_STEP
}
#undef ROWV
#undef VMW
}
struct Frame {
    LAS unsigned char* lds; volatile LAS unsigned* MISC; gu32* ctl;
    int tid, lane, wave, vcu, G;
    unsigned char* ws;
};
#define CAS __attribute__((address_space(4)))
__device__ __forceinline__ const float* karg(int k) { const CAS char* p = (const CAS char*)__builtin_amdgcn_kernarg_segment_ptr(); asm volatile("" : "+s"(p)); return *(const float* const CAS*)(p + 8 * k); }

__device__ __forceinline__ void tr_item(const float* W, size_t ldw, bf16* WT, size_t ldk, LAS float* scr, int lane) {
    const int kr = lane >> 3, c4 = (lane & 7) * 4;
    f32x4 v[8];
#pragma unroll
    for (int i = 0; i < 8; ++i) v[i] = __builtin_nontemporal_load((const GAS f32x4*)(W + (size_t)(8 * i + kr) * ldw + c4));
#pragma unroll
    for (int i = 0; i < 8; ++i) { LAS float* s = scr + (8 * i + kr) * 33 + c4; s[0] = v[i].x; s[1] = v[i].y; s[2] = v[i].z; s[3] = v[i].w; }
    LDS_WAIT();
    const int c = lane & 7;
#pragma unroll
    for (int j = 0; j < 4; ++j) { const int n = (lane >> 3) + 8 * j; const LAS float* s = scr + (8 * c) * 33 + n;
        u32x4 o; o.x = cvt_pk_bf16(s[0 * 33], s[1 * 33]); o.y = cvt_pk_bf16(s[2 * 33], s[3 * 33]); o.z = cvt_pk_bf16(s[4 * 33], s[5 * 33]); o.w = cvt_pk_bf16(s[6 * 33], s[7 * 33]);
        *(GAS u32x4*)(WT + (size_t)n * ldk + 8 * c) = o; }
    LDS_WAIT();
}
__device__ __forceinline__ void tr_item8(const float* W, size_t ldw, unsigned char* WT, size_t ldk, LAS float* scr, int lane) {
    const int kr = lane >> 3, c4 = (lane & 7) * 4;
    f32x4 v[2][8];
#pragma unroll
    for (int hh = 0; hh < 2; ++hh)
#pragma unroll
        for (int i = 0; i < 8; ++i) v[hh][i] = __builtin_nontemporal_load((const GAS f32x4*)(W + (size_t)(8 * i + kr) * ldw + 32 * hh + c4));
#pragma unroll
    for (int hh = 0; hh < 2; ++hh) {
#pragma unroll
        for (int i = 0; i < 8; ++i) { LAS float* s = scr + (8 * i + kr) * 33 + c4; s[0] = v[hh][i].x; s[1] = v[hh][i].y; s[2] = v[hh][i].z; s[3] = v[hh][i].w; }
        LDS_WAIT();
        const int c = lane & 3;
#pragma unroll
        for (int j = 0; j < 2; ++j) { const int n = (lane >> 2) + 16 * j; const LAS float* s = scr + (16 * c) * 33 + n;
            u32x4 o;
            o.x = cvt_pk4_fp8(s[0 * 33] * W8_SCALE, s[1 * 33] * W8_SCALE, s[2 * 33] * W8_SCALE, s[3 * 33] * W8_SCALE); o.y = cvt_pk4_fp8(s[4 * 33] * W8_SCALE, s[5 * 33] * W8_SCALE, s[6 * 33] * W8_SCALE, s[7 * 33] * W8_SCALE);
            o.z = cvt_pk4_fp8(s[8 * 33] * W8_SCALE, s[9 * 33] * W8_SCALE, s[10 * 33] * W8_SCALE, s[11 * 33] * W8_SCALE); o.w = cvt_pk4_fp8(s[12 * 33] * W8_SCALE, s[13 * 33] * W8_SCALE, s[14 * 33] * W8_SCALE, s[15 * 33] * W8_SCALE);
            *(GAS u32x4*)(WT + (size_t)(32 * hh + n) * ldk + 16 * c) = o; }
        LDS_WAIT();
    }
}
constexpr int I_IN = (DM / 64) * (NZ / 32), I_OUT = (DM / 64) * (DM / 32), I_GU = (DM / 64) * (DEX / 32), I_D = (DEX / 64) * (DM / 32);
constexpr int GV_FIRST = 43;
constexpr int BGI_SMALL = (NLAYER * 4 * 8) / 8, BGI_IN = I_IN / 16, BGI_GV0 = (128 - GV_FIRST) * 4, BGI_GV1 = 128 * 4, BGI_OUT = I_OUT / 8, BGI_GU = NEXP * 2 * I_GU / 16, BGI_D = NEXP * I_D / 16;
constexpr int BG_C0 = BGI_SMALL + BGI_IN;
constexpr int BG_C1 = BG_C0 + BGI_GV0 + BGI_OUT;
constexpr int BG_C2 = BG_C1 + BGI_GU;
constexpr int BG_C3 = BG_C2 + BGI_D;
constexpr int BG_C3B = BG_C3 + BGI_GV1;
constexpr int BG_C4 = BG_C3B + BGI_IN;
constexpr int BG_C5 = BG_C4 + BGI_OUT;
constexpr int BG_C6 = BG_C5 + BGI_GU;
constexpr int BG_C7 = BG_C6 + BGI_D;
__device__ __forceinline__ float mod_at(const unsigned char* ws, const float* b_ada, int l, int j) {
    const float* p = (const float*)(ws + WS_MODP) + (size_t)l * 6 * DM + j;
    return *(const GAS float*)(b_ada + (size_t)l * 6 * DM + j) + ((*(const GAS float*)p + *(const GAS float*)(p + 2 * 6 * DM)) + (*(const GAS float*)(p + 4 * 6 * DM) + *(const GAS float*)(p + 6 * 6 * DM)));
}
__device__ __forceinline__ void gemv_item(const Frame& F, unsigned char* ws, int w) {
    LAS float* sc = (LAS float*)F.lds; LAS f32x4* red = (LAS f32x4*)(F.lds + 8192);
    const int kq = w & 3, l = w >> 9, cb = (w >> 2) & 127, c4 = F.tid % 24, kg = F.tid / 24;
    if (F.tid < 512) sc[F.tid] = silu_f(*(const GAS float*)(karg(1) + kq * 512 + F.tid));
    __syncthreads();
    f32x4 acc = (f32x4){0.f, 0.f, 0.f, 0.f};
    if (kg < 21) {
        const float* wp = karg(2) + (size_t)l * DM * 6 * DM + (size_t)(kq * 512) * 6 * DM + cb * 96 + c4 * 4;
#pragma unroll 8
        for (int k = kg; k < 512; k += 21) { const f32x4 wv = __builtin_nontemporal_load((const GAS f32x4*)(wp + (size_t)k * 6 * DM)); acc += wv * sc[k]; }
        red[kg * 24 + c4] = acc;
    }
    __syncthreads();
    if (F.tid < 24) { f32x4 s = red[F.tid];
        for (int g = 1; g < 21; ++g) s += red[g * 24 + F.tid];
        *(GAS f32x4*)((float*)(ws + WS_MODP) + (size_t)kq * 2 * 6 * DM + (size_t)l * 6 * DM + cb * 96 + F.tid * 4) = s; }
    __syncthreads();
}
__device__ __forceinline__ void conv_wave_item(const Frame& F, unsigned char* ws, int r, int l, LAS float* scr) {
    if (r < I_IN) { const int kb = r / (NZ / 32), nb = r % (NZ / 32);
        tr_item8(karg(6) + (size_t)l * DM * NIN + (size_t)(64 * kb) * NIN + 32 * nb, NIN, ws + WS_WIN + (size_t)l * NZ * DM + (size_t)(32 * nb) * DM + 64 * kb, DM, scr, F.lane); return; }
    r -= I_IN;
    if (r < I_OUT) { const int kb = r / (DM / 32), nb = r % (DM / 32);
        tr_item(karg(15) + (size_t)l * DM * DM + (size_t)(64 * kb) * DM + 32 * nb, DM, (bf16*)(ws + WS_WOUT) + (size_t)l * DM * DM + (size_t)(32 * nb) * DM + 64 * kb, DM, scr, F.lane); return; }
    r -= I_OUT;
    if (r < NEXP * 2 * I_GU) { const int e = r / (2 * I_GU); r -= e * 2 * I_GU; const int up = r >= I_GU; if (up) r -= I_GU; const int kb = r / (DEX / 32), nb = r % (DEX / 32), n0 = 32 * nb;
        const float* src = (up ? karg(19) : karg(18)) + ((size_t)l * NEXP + e) * DM * DEX + (size_t)(64 * kb) * DEX + n0;
        const int drow = (n0 >> 7) * 256 + (up ? 128 : 0) + (n0 & 127);
        tr_item8(src, DEX, ws + WS_WGU + ((size_t)l * NEXP + e) * DM * DM + (size_t)drow * DM + 64 * kb, DM, scr, F.lane); return; }
    r -= NEXP * 2 * I_GU;
    { const int e = r / I_D; r -= e * I_D; const int kb = r / (DM / 32), nb = r % (DM / 32);
      tr_item8(karg(20) + ((size_t)l * NEXP + e) * DEX * DM + (size_t)(64 * kb) * DM + 32 * nb, DM, ws + WS_WD + ((size_t)l * NEXP + e) * DM * DEX + (size_t)(32 * nb) * DEX + 64 * kb, DEX, scr, F.lane); }
}
__device__ __forceinline__ void bg_item(const Frame& F, unsigned char* ws, int t) {
    LAS float* scr = (LAS float*)(F.lds + 16384 + F.wave * 9216);
    if (t < BGI_SMALL) { const int r = t * 8 + F.wave, mat = r >> 3, q = r & 7, kb = q >> 2, nb = q & 3;
        tr_item(karg(10) + (size_t)mat * 128 * 128 + (size_t)(64 * kb) * 128 + 32 * nb, 128, (bf16*)(ws + WS_BWT) + (size_t)mat * 128 * 128 + (size_t)(32 * nb) * 128 + 64 * kb, 128, scr, F.lane); return; }
    t -= BGI_SMALL;
    if (t < BGI_IN) { conv_wave_item(F, ws, (t * 8 + F.wave) * 2, 0, scr); return; }
    t -= BGI_IN;
    if (t < BGI_GV0) { gemv_item(F, ws, GV_FIRST * 4 + t); return; }
    t -= BGI_GV0;
    if (t < BGI_OUT) { conv_wave_item(F, ws, I_IN + t * 8 + F.wave, 0, scr); return; }
    t -= BGI_OUT;
    if (t < BGI_GU + BGI_D) { conv_wave_item(F, ws, I_IN + I_OUT + (t * 8 + F.wave) * 2, 0, scr); return; }
    t -= BGI_GU + BGI_D;
    if (t < BGI_GV1) { gemv_item(F, ws, 512 + t); return; }
    t -= BGI_GV1;
    if (t < BGI_IN) { conv_wave_item(F, ws, (t * 8 + F.wave) * 2, 1, scr); return; }
    t -= BGI_IN;
    if (t < BGI_OUT) { conv_wave_item(F, ws, I_IN + t * 8 + F.wave, 1, scr); return; }
    t -= BGI_OUT;
    conv_wave_item(F, ws, I_IN + I_OUT + (t * 8 + F.wave) * 2, 1, scr);
}
__device__ __forceinline__ void bg_fill(const Frame& F0, int seam, int need) {
    unsigned char* const ws = opq(F0.ws); Frame F = F0; F.tid = opq_tid(F0.wave); F.lane = F.tid & 63; F.lds = opq(F0.lds);
    LAS unsigned* slot = (LAS unsigned*)(F.lds + AUX_OFF + 24576);
    gu32* const ctl_ = opq(F0.ctl); gu32* ticket = ctl_ + CW_BGT; gu32* arr = ctl_ + CW_ARR + 64 * seam;
    unsigned tn = 0xffffffffu; bool pre = false;
    if (F.tid == 0 && slot[1] == 0u) { (void)__hip_atomic_fetch_add(arr, 1u, RLX_AGENT); const unsigned cur = __hip_atomic_load(ticket, RLX_AGENT);
        if (cur >= (unsigned)BG_C7) slot[1] = 1u;
        else if (cur < (unsigned)need || __hip_atomic_load(arr, RLX_AGENT) < (unsigned)F.G) tn = __hip_atomic_fetch_add(ticket, 1u, RLX_AGENT); }
    for (;;) {
        if (F.tid == 0) slot[0] = tn;
        __syncthreads();
        const unsigned t = __builtin_amdgcn_readfirstlane(slot[0]);
        __syncthreads();
        if (t >= (unsigned)BG_C7) { if (F.tid == 0 && t != 0xffffffffu) slot[1] = 1u; break; }
        if (F.tid == 0) { tn = 0xffffffffu; pre = (t + 2u < (unsigned)need);
            if (pre) tn = __hip_atomic_fetch_add(ticket, 1u, RLX_AGENT); }
        bg_item(F, ws, (int)t);
        if (F.tid == 0 && !pre) { if (t + 1u < (unsigned)need || __hip_atomic_load(arr, RLX_AGENT) < (unsigned)F.G) tn = __hip_atomic_fetch_add(ticket, 1u, RLX_AGENT); }
    }
}
__device__ __forceinline__ void p0_prologue(const Frame& F0) {
    unsigned char* const ws = opq(F0.ws); Frame F = F0; F.tid = opq_tid(F0.wave); F.lane = F.tid & 63; F.lds = opq(F0.lds);
    for (int w = F.vcu; w < GV_FIRST * 4; w += F.G) gemv_item(F, ws, w);
    const float* const a_ws_ = karg(7);
    for (int i = (F.vcu * NTHR + F.tid) * 2; i < NLAYER * 4 * 128 * 128; i += F.G * NTHR * 2) {
        const int t = (i >> 7) & 127, s = i & 127;
        const f32x2 w = *(const GAS f32x2*)(a_ws_ + i);
        const bool keep = (s >> 6) <= (t >> 6);
        *(GAS unsigned*)((bf16*)(ws + WS_WM) + i) = keep ? cvt_pk_bf16(w.x, w.y) : 0u;
    }
}

template <int MODE>
__device__ __forceinline__ void phase_norm1(const Frame& F0, int l, const float* xin, float* xout, int lprev) {
    unsigned char* const ws = opq(F0.ws); Frame F = F0; F.tid = opq_tid(F0.wave); F.lane = F.tid & 63; F.lds = opq(F0.lds);
    LAS float* wfT = (LAS float*)F.lds;
    LAS float* gaL = (LAS float*)(F.lds + 65536);
    LAS float* gbL = (LAS float*)(F.lds + 73728);
    LAS float* g2L = (LAS float*)(F.lds + 81920);
    LAS float* lf = (LAS float*)(F.lds + 90112);
    LAS int* hb = (LAS int*)(F.lds + 91136);
    const float* const b_ada_ = karg(3); const float* const c_bf_ = karg(14);
    if (MODE != 2) {
        const float* const w_in_ = karg(6); const float* const g_mix_ = karg(4);
        for (int i = F.tid; i < DM * 2; i += NTHR) { const int d = i >> 1, half = i & 1;
            const f32x4 w = *(const GAS f32x4*)(w_in_ + (size_t)l * DM * NIN + (size_t)d * NIN + NZ + half * 4);
            wfT[(half * 4 + 0) * DM + d] = w.x; wfT[(half * 4 + 1) * DM + d] = w.y; wfT[(half * 4 + 2) * DM + d] = w.z; wfT[(half * 4 + 3) * DM + d] = w.w; }
        for (int d = F.tid; d < DM; d += NTHR) { gaL[d] = *(const GAS float*)(g_mix_ + (size_t)l * DM + d) * (1.f + mod_at(ws, b_ada_, l, DM + d)); gbL[d] = mod_at(ws, b_ada_, l, d); }
    }
    if (MODE != 0) {
        for (int d = F.tid; d < DM; d += NTHR) g2L[d] = mod_at(ws, b_ada_, lprev, 5 * DM + d);
        if (F.tid == 0) { int a = 0; for (int e = 0; e < NEXP; ++e) { hb[e] = a; a += ((int)__hip_atomic_load(F.ctl + CW_CNT + 64 * lprev + e, RLX_AGENT) + 255) & ~255; } }
    }
    __syncthreads();
    const bf16* YB = (const bf16*)(ws + WS_YB);
    f32x4 vA[8], vB[8]; u32x2 yA0[8], yA1[8], yB0[8], yB1[8];
#define N1_LOAD(V, Y0, Y1, rr) do { const int t_ = c * 32 + F.wave * 4 + (rr);                                                                 \
        _Pragma("unroll") for (int j = 0; j < 8; ++j) V[j] = *(const GAS f32x4*)(xin + (size_t)t_ * DM + 256 * j + 4 * F.lane);                   \
        if (MODE != 0) { const int r0_ = __builtin_amdgcn_readlane(rowA, (rr)), r1_ = __builtin_amdgcn_readlane(rowB, (rr));                      \
            _Pragma("unroll") for (int j = 0; j < 8; ++j) { const int d = 256 * j + 4 * F.lane;                                                    \
                Y0[j] = *(const GAS u32x2*)(YB + (size_t)r0_ * DM + d); Y1[j] = *(const GAS u32x2*)(YB + (size_t)r1_ * DM + d); } } } while (0)
#define N1_PROC(V, Y0, Y1, rr) do { const int rl = F.wave * 4 + (rr), t = c * 32 + rl;                                                          \
        if (MODE != 0) { const float w0 = __builtin_bit_cast(float, __builtin_amdgcn_readlane(__builtin_bit_cast(int, gwA), (rr))), w1 = __builtin_bit_cast(float, __builtin_amdgcn_readlane(__builtin_bit_cast(int, gwB), (rr))); \
            _Pragma("unroll") for (int j = 0; j < 8; ++j) { const int d = 256 * j + 4 * F.lane;                                                    \
                const f32x4 g2 = *(const LAS f32x4*)(g2L + d); const u32x2 y0 = Y0[j], y1 = Y1[j];                                                 \
                f32x4 y; y.x = w0 * bf_lo(y0.x) + w1 * bf_lo(y1.x); y.y = w0 * bf_hi(y0.x) + w1 * bf_hi(y1.x); y.z = w0 * bf_lo(y0.y) + w1 * bf_lo(y1.y); y.w = w0 * bf_hi(y0.y) + w1 * bf_hi(y1.y); \
                V[j] = V[j] + g2 * y;                                                                                                               \
                *(GAS f32x4*)(xout + (size_t)t * DM + d) = V[j]; } }                                                                               \
        if (MODE != 2) {                                                                                                                           \
            float ss = 0.f;                                                                                                                        \
            _Pragma("unroll") for (int j = 0; j < 8; ++j) ss += (V[j].x * V[j].x + V[j].y * V[j].y) + (V[j].z * V[j].z + V[j].w * V[j].w);         \
            const float rs = rsqrtf(wave_sum(ss) * (1.f / DM) + EPSN);                                                                             \
            float fz[8] = {0.f, 0.f, 0.f, 0.f, 0.f, 0.f, 0.f, 0.f};                                                                                \
            unsigned char* hrow = ws + WS_H + (size_t)t * DM;                                   \
            _Pragma("unroll") for (int j = 0; j < 8; ++j) { const int d = 256 * j + 4 * F.lane;                                                    \
                const f32x4 h = V[j] * rs * *(const LAS f32x4*)(gaL + d) + *(const LAS f32x4*)(gbL + d);                                           \
                *(GAS unsigned*)(hrow + d) = cvt_pk4_fp8(h.x * H8_SCALE, h.y * H8_SCALE, h.z * H8_SCALE, h.w * H8_SCALE);                          \
                _Pragma("unroll") for (int q = 0; q < 8; ++q) { const f32x4 w = *(const LAS f32x4*)(wfT + q * DM + d); fz[q] += (h.x * w.x + h.y * w.y) + (h.z * w.z + h.w * w.w); } } \
            _Pragma("unroll") for (int q = 0; q < 8; ++q) fz[q] = wave_sum(fz[q]);                                                                 \
            if (F.lane < 8) { float z = fz[0];                                                                                                     \
                _Pragma("unroll") for (int q = 1; q < 8; ++q) z = (F.lane == q) ? fz[q] : z;                                                       \
                z += *(const GAS float*)(c_bf_ + l * 8 + F.lane);                                                                                  \
                lf[rl * 8 + F.lane] = fminf(z, 0.f) - 0.6931471805599453f * __builtin_amdgcn_logf(1.f + __builtin_amdgcn_exp2f(-LOG2E * fabsf(z))); } } } while (0)
    for (int c = F.vcu; c < SEQ / 32; c += F.G) {
        int rowA = 0, rowB = 0; float gwA = 0.f, gwB = 0.f;
        if (MODE != 0) { const int t_ = c * 32 + F.wave * 4 + (F.lane & 3);
            const int* te = (const int*)(ws + WS_TOKE) + 2 * t_; const int* tp = (const int*)(ws + WS_TOKP) + 2 * t_; const float* tw = (const float*)(ws + WS_TOKW) + 2 * t_;
            rowA = hb[*(const GAS int*)te] + *(const GAS int*)tp; rowB = hb[*(const GAS int*)(te + 1)] + *(const GAS int*)(tp + 1); gwA = *(const GAS float*)tw; gwB = *(const GAS float*)(tw + 1); }
        N1_LOAD(vA, yA0, yA1, 0); N1_LOAD(vB, yB0, yB1, 1);
        N1_PROC(vA, yA0, yA1, 0); N1_LOAD(vA, yA0, yA1, 2);
        N1_PROC(vB, yB0, yB1, 1); N1_LOAD(vB, yB0, yB1, 3);
        N1_PROC(vA, yA0, yA1, 2); N1_PROC(vB, yB0, yB1, 3);
        if (MODE != 2) {
            __syncthreads();
            if (F.tid < 8) { float a = 0.f; float* floc = (float*)(ws + WS_FLOC);
                for (int r = 0; r < 32; ++r) { a += lf[r * 8 + F.tid]; *(GAS float*)(floc + (size_t)(c * 32 + r) * 8 + F.tid) = a; }
                *(GAS float*)((float*)(ws + WS_TOT) + c * 8 + F.tid) = a; }
            __syncthreads();
        }
    }
#undef N1_LOAD
#undef N1_PROC
}

__device__ __forceinline__ void fkl_fixup(const Frame& F0) {
    unsigned char* const ws = opq(F0.ws); Frame F = F0; F.tid = opq_tid(F0.wave); F.lane = F.tid & 63; F.lds = opq(F0.lds);
    LAS float* preL = (LAS float*)(F.lds + AUX_OFF + 8192);
    const float* tot = (const float*)(ws + WS_TOT);
    for (int c = F.vcu; c < SEQ / 32; c += F.G) {
        { const int h = F.wave; double s = 0.0;
#pragma unroll
            for (int q = 0; q < 4; ++q) { const int cc = 4 * F.lane + q; if (cc < c) s += (double)*(const GAS float*)(tot + cc * 8 + h); }
            float hi_ = (float)s, lo_ = (float)(s - (double)hi_);
            hi_ = wave_sum(hi_); lo_ = wave_sum(lo_);
            if (F.lane == 0) preL[h] = hi_ + lo_; }
        __syncthreads();
        if (F.tid < 256) { const int r = F.tid >> 3, h = F.tid & 7, t = c * 32 + r;
            *(GAS float*)((float*)(ws + WS_FKL) + (size_t)h * SEQ + t) = (preL[h] + *(const GAS float*)((const float*)(ws + WS_FLOC) + (size_t)t * 8 + h)) * -11.313708498984761f; }
        __syncthreads();
    }
}

__device__ __forceinline__ void phase_small_item(const Frame& F0, int l, int item) {
    unsigned char* const ws = opq(F0.ws); Frame F = F0; F.tid = opq_tid(F0.wave); F.lane = F.tid & 63; F.lds = opq(F0.lds);
    const int fr = F.lane & 15, fq = F.lane >> 4, w = F.wave;
    const bf16* Z = (const bf16*)(ws + WS_Z); bf16* YC = (bf16*)(ws + WS_YCAT);
    f32x4 acc[8];
#pragma unroll
    for (int m = 0; m < 8; ++m) acc[m] = (f32x4){0.f, 0.f, 0.f, 0.f};
    const float* a_bs_ = opq(karg(8)); const float* b_scale_ = opq(karg(11));
    if (item < 256) {
        const int blk = item >> 2, h = item & 3;
        const bf16* VN = (const bf16*)(ws + WS_VN) + (size_t)(blk * 128) * 512 + h * 128 + 16 * w + fr;
        const bf16* WM = (const bf16*)(ws + WS_WM) + ((size_t)(l * 4 + h) * 128) * 128;
        bf16x8 yb[4];
#pragma unroll
        for (int ks = 0; ks < 4; ++ks)
#pragma unroll
            for (int j = 0; j < 8; ++j) yb[ks][j] = (short)*(const GAS bf16*)(VN + (size_t)(ks * 32 + 8 * fq + j) * 512);
#pragma unroll
        for (int m = 0; m < 8; ++m)
#pragma unroll
            for (int ks = 0; ks < 4; ++ks) { const bf16x8 xa = *(const GAS bf16x8*)(WM + (size_t)(16 * m + fr) * 128 + ks * 32 + 8 * fq);
                acc[m] = __builtin_amdgcn_mfma_f32_16x16x32_bf16(yb[ks], xa, acc[m], 0, 0, 0); }
#pragma unroll
        for (int m = 0; m < 8; ++m) { const int tl = 16 * m + fr, t = blk * 128 + tl, col = h * 128 + 16 * w + 4 * fq;
            const float bsv = *(const GAS float*)(a_bs_ + l * 512 + h * 128 + tl);
            const u32x2 u = *(const GAS u32x2*)(Z + (size_t)t * NZ + col);
            u32x2 o; o.x = cvt_pk_bf16(bf_lo(u.x) * (acc[m][0] + bsv), bf_hi(u.x) * (acc[m][1] + bsv)); o.y = cvt_pk_bf16(bf_lo(u.y) * (acc[m][2] + bsv), bf_hi(u.y) * (acc[m][3] + bsv));
            *(GAS u32x2*)(YC + (size_t)t * DM + col) = o; }
    } else {
        const int rb = (item - 256) >> 2, g = (item - 256) & 3;
        const int wnd = 2 << g, r0 = rb * 128;
        LAS bf16* pt = (LAS bf16*)(F.lds + 86016);
        LAS bf16* dt = (LAS bf16*)F.lds;
        __syncthreads();
        for (int i = F.tid; i < 144 * 16; i += NTHR) { const int rr = i >> 4, cc = (i & 15) * 8, tg = r0 - 16 + rr;
            u32x4 v = (u32x4){0u, 0u, 0u, 0u}; if (tg >= 0) v = *(const GAS u32x4*)(Z + (size_t)tg * NZ + 1024 + g * 128 + cc);
            *(LAS u32x4*)(pt + rr * 128 + cc) = v; }
        __syncthreads();
        { const int c = F.tid & 127, rg = F.tid >> 7;
            float sum = 0.f;
            for (int j = 1; j < wnd; ++j) sum += bf_lo((unsigned)pt[(16 + 32 * rg - j) * 128 + c]);
            for (int i = 0; i < 32; ++i) { const int tl = 32 * rg + i, tg = r0 + tl; const float pv = bf_lo((unsigned)pt[(16 + tl) * 128 + c]);
                sum += pv;
                const float cnt = (float)((tg + 1 < wnd) ? (tg + 1) : wnd);
                const float dv = sum / cnt - pv;
                dt[tl * 136 + c] = (bf16)(cvt_pk_bf16(dv, 0.f) & 0xffffu);
                sum -= bf_lo((unsigned)pt[(16 + tl - (wnd - 1)) * 128 + c]); } }
        __syncthreads();
        const bf16* BWT = (const bf16*)(ws + WS_BWT) + ((size_t)(l * 4 + g) * 128) * 128;
        bf16x8 yb[4];
#pragma unroll
        for (int ks = 0; ks < 4; ++ks) yb[ks] = *(const GAS bf16x8*)(BWT + (size_t)(16 * w + fr) * 128 + ks * 32 + 8 * fq);
#pragma unroll
        for (int m = 0; m < 8; ++m)
#pragma unroll
            for (int ks = 0; ks < 4; ++ks) { const bf16x8 xa = *(const LAS bf16x8*)(dt + (16 * m + fr) * 136 + ks * 32 + 8 * fq);
                acc[m] = __builtin_amdgcn_mfma_f32_16x16x32_bf16(yb[ks], xa, acc[m], 0, 0, 0); }
        __syncthreads();
        const f32x4 bsc = *(const GAS f32x4*)(b_scale_ + l * 512 + g * 128 + 16 * w + 4 * fq);
#pragma unroll
        for (int m = 0; m < 8; ++m) { const int t = rb * 128 + 16 * m + fr, col = 512 + g * 128 + 16 * w + 4 * fq;
            u32x2 o; o.x = cvt_pk_bf16(acc[m][0] * bsc.x, acc[m][1] * bsc.y); o.y = cvt_pk_bf16(acc[m][2] * bsc.z, acc[m][3] * bsc.w);
            *(GAS u32x2*)(YC + (size_t)t * DM + col) = o; }
    }
}

__device__ __forceinline__ void phase_norm2_route(const Frame& F0, int l) {
    unsigned char* const ws = opq(F0.ws); Frame F = F0; F.tid = opq_tid(F0.wave); F.lane = F.tid & 63; F.lds = opq(F0.lds);
    LAS float* wrT = (LAS float*)F.lds;
    LAS float* gaL = (LAS float*)(F.lds + AUX_OFF);
    LAS float* gbL = (LAS float*)(F.lds + AUX_OFF + 8192);
    LAS int* lcnt = (LAS int*)(F.lds + AUX_OFF + 16384);
    const float* const w_router_ = karg(16); const float* const g_ffn_ = karg(5); const float* const b_ada_ = karg(3); const float* const b_router_ = karg(17);
    for (int i = F.tid; i < DM * 4; i += NTHR) { const int d = i >> 2, q = i & 3;
        const f32x4 w = *(const GAS f32x4*)(w_router_ + (size_t)d * 16 + q * 4);
        wrT[(q * 4 + 0) * DM + d] = w.x; wrT[(q * 4 + 1) * DM + d] = w.y; wrT[(q * 4 + 2) * DM + d] = w.z; wrT[(q * 4 + 3) * DM + d] = w.w; }
    for (int d = F.tid; d < DM; d += NTHR) { gaL[d] = *(const GAS float*)(g_ffn_ + (size_t)l * DM + d) * (1.f + mod_at(ws, b_ada_, l, 4 * DM + d)); gbL[d] = mod_at(ws, b_ada_, l, 3 * DM + d); }
    const float* X1 = (const float*)(ws + WS_X1);
    float brt[16];
#pragma unroll
    for (int e = 0; e < 16; ++e) brt[e] = *(const GAS float*)(b_router_ + e);
    for (int c = F.vcu; c < SEQ / 32; c += F.G) {
        if (F.tid < 32) lcnt[F.tid] = 0;
        __syncthreads();
        int my_e0 = 0, my_e1 = 0, my_r0 = 0, my_r1 = 0; float my_w0 = 0.f, my_w1 = 0.f;
        f32x4 vA[8], vB[8];
#define N2_LOAD(V, rr) do { const int t_ = c * 32 + F.wave * 4 + (rr); _Pragma("unroll") for (int j = 0; j < 8; ++j) V[j] = *(const GAS f32x4*)(X1 + (size_t)t_ * DM + 256 * j + 4 * F.lane); } while (0)
#define N2_PROC(V, rr) do { const int t = c * 32 + F.wave * 4 + (rr);                                                                           \
            float ss = 0.f;                                                                                                                        \
            _Pragma("unroll") for (int j = 0; j < 8; ++j) ss += (V[j].x * V[j].x + V[j].y * V[j].y) + (V[j].z * V[j].z + V[j].w * V[j].w);         \
            const float rs = rsqrtf(wave_sum(ss) * (1.f / DM) + EPSN);                                                                             \
            float lg[16];                                                                                                                          \
            _Pragma("unroll") for (int e = 0; e < 16; ++e) lg[e] = 0.f;                                                                            \
            unsigned char* hrow = ws + WS_H + (size_t)t * DM;                          \
            _Pragma("unroll") for (int j = 0; j < 8; ++j) { const int d = 256 * j + 4 * F.lane;                                                    \
                const f32x4 h = V[j] * rs * *(const LAS f32x4*)(gaL + d) + *(const LAS f32x4*)(gbL + d);                                           \
                *(GAS unsigned*)(hrow + d) = cvt_pk4_fp8(h.x * H8_SCALE, h.y * H8_SCALE, h.z * H8_SCALE, h.w * H8_SCALE);                          \
                _Pragma("unroll") for (int e = 0; e < 16; ++e) { const f32x4 w = *(const LAS f32x4*)(wrT + e * DM + d); lg[e] += (h.x * w.x + h.y * w.y) + (h.z * w.z + h.w * w.w); } } \
            _Pragma("unroll") for (int e = 0; e < 16; ++e) lg[e] = wave_sum(lg[e]);                                                                \
            float sc[16], sel[16];                                                                                                                 \
            _Pragma("unroll") for (int e = 0; e < 16; ++e) { sc[e] = __builtin_amdgcn_rcpf(1.f + __builtin_amdgcn_exp2f(-LOG2E * lg[e])); sel[e] = sc[e] + brt[e]; }                      \
            int bg = 0; float bgs = -INFINITY;                                                                                                     \
            _Pragma("unroll") for (int g = 0; g < 4; ++g) { float a = -INFINITY, b = -INFINITY;                                                    \
                _Pragma("unroll") for (int i = 0; i < 4; ++i) { const float x = sel[g * 4 + i]; if (x > a) { b = a; a = x; } else if (x > b) b = x; } \
                if (a + b > bgs) { bgs = a + b; bg = g; } }                                                                                        \
            int e0 = 0, e1 = 0; float a = -INFINITY, b = -INFINITY, s0 = 0.f, s1 = 0.f;                                                            \
            _Pragma("unroll") for (int g = 0; g < 4; ++g)                                                                                          \
                _Pragma("unroll") for (int i = 0; i < 4; ++i) { const int e = g * 4 + i; const float x = sel[e];                                   \
                    if (g == bg) { if (x > a) { b = a; e1 = e0; s1 = s0; a = x; e0 = e; s0 = sc[e]; } else if (x > b) { b = x; e1 = e; s1 = sc[e]; } } } \
            const float inv = 1.f / (s0 + s1);                                                                                                     \
            if (F.lane == (rr)) { my_e0 = e0; my_e1 = e1; my_w0 = s0 * inv; my_w1 = s1 * inv; } } while (0)
        N2_LOAD(vA, 0);
#pragma unroll 1
        for (int rp = 0; rp < 2; ++rp) {
            N2_LOAD(vB, 2 * rp + 1);
            N2_PROC(vA, 2 * rp);
            if (rp == 0) N2_LOAD(vA, 2);
            N2_PROC(vB, 2 * rp + 1);
        }
        if (F.lane < 4) { my_r0 = __hip_atomic_fetch_add(&lcnt[my_e0], 1, __ATOMIC_RELAXED, __HIP_MEMORY_SCOPE_WORKGROUP); my_r1 = __hip_atomic_fetch_add(&lcnt[my_e1], 1, __ATOMIC_RELAXED, __HIP_MEMORY_SCOPE_WORKGROUP); }
        __syncthreads();
        if (F.tid < 16) lcnt[16 + F.tid] = (int)__hip_atomic_fetch_add(F.ctl + CW_CNT + 64 * l + F.tid, (unsigned)lcnt[F.tid], RLX_AGENT);
        __syncthreads();
        if (F.lane < 4) { const int t = c * 32 + F.wave * 4 + F.lane;
            const int p0 = lcnt[16 + my_e0] + my_r0, p1 = lcnt[16 + my_e1] + my_r1;
            int* list = (int*)(ws + WS_LIST);
            *(GAS int*)(list + my_e0 * SEQ + p0) = t; *(GAS int*)(list + my_e1 * SEQ + p1) = t;
            *(GAS int*)((int*)(ws + WS_TOKE) + 2 * t) = my_e0; *(GAS int*)((int*)(ws + WS_TOKE) + 2 * t + 1) = my_e1;
            *(GAS int*)((int*)(ws + WS_TOKP) + 2 * t) = p0; *(GAS int*)((int*)(ws + WS_TOKP) + 2 * t + 1) = p1;
            *(GAS float*)((float*)(ws + WS_TOKW) + 2 * t) = my_w0; *(GAS float*)((float*)(ws + WS_TOKW) + 2 * t + 1) = my_w1; }
        __syncthreads();
    }
#undef N2_LOAD
#undef N2_PROC
}

struct MoeOrder {
    int G, c, total, K, nct; const char* Bt; size_t estride; const int* list; LAS int* tab;
    __device__ __forceinline__ bool next(int i, gm::Unit& u) const {
        const int L = i * G + c; if (L >= total) return false;
        const int q = L / nct, ct = L - q * nct;
        int e = 0;
#pragma unroll
        for (int k = 1; k < NEXP; ++k) e += (q >= tab[k]) ? 1 : 0;
        e = __builtin_amdgcn_readfirstlane(e);
        const int rt = q - __builtin_amdgcn_readfirstlane(tab[e]);
        u.e = e; u.rt = rt; u.arow = (__builtin_amdgcn_readfirstlane(tab[e]) + rt) * 256; u.orow = u.arow; u.ocol = ct * 256;
        u.Bp = Bt + (size_t)e * estride + (size_t)ct * 256 * K * 2; return true;
    }
    __device__ __forceinline__ int row_of(const gm::Unit& u, int r) const {
        const int p = u.rt * 256 + r, n = tab[32 + u.e], pc = p < n ? p : n - 1;
        const int v = *(const GAS int*)(list + u.e * SEQ + pc);
        return (p < n) ? v : 0;
    }
};
__device__ __forceinline__ void moe_table(const Frame& F, int l, LAS int* tab) {
    __syncthreads();
    if (F.tid == 0) { int a = 0;
        for (int e = 0; e < NEXP; ++e) { const int n = (int)__hip_atomic_load(F.ctl + CW_CNT + 64 * l + e, RLX_AGENT); tab[e] = a; tab[32 + e] = n; a += (n + 255) >> 8; }
        tab[16] = a; }
    __syncthreads();
}

constexpr int ATT_CH = 24;
struct MixTab { LAS int* jlo; LAS int* items; LAS int* nitems; LAS float* fend; LAS int* scan; };
__device__ __forceinline__ MixTab mix_tab_ptrs(LAS unsigned char* lds) {
    MixTab T; T.jlo = (LAS int*)(lds + 69632); T.items = (LAS int*)(lds + 69632 + 1024); T.nitems = (LAS int*)(lds + 69632 + 1024 + 8192); T.fend = (LAS float*)(lds + 69632 + 1024 + 8192 + 64);
    T.scan = (LAS int*)(lds + 69632 + 1024 + 8192 + 64 + 4096); return T;
}
__device__ __forceinline__ void mix_build_table(const Frame& F0, int l, const MixTab& T) {
    unsigned char* const ws = opq(F0.ws); const int tid = opq_tid(F0.wave);
    const float* FKL = (const float*)(ws + WS_FKL);
    for (int i = tid; i < 1024; i += NTHR) T.fend[i] = *(const GAS float*)(FKL + (size_t)(i >> 7) * SEQ + (i & 127) * 64 + 63);
    float gq = 0.f, gk = 0.f; const float* const c_qg_ = karg(12); const float* const c_kg_ = karg(13);
    { const int ln = tid & 63; gq = fmaxf(fabsf(*(const GAS float*)(c_qg_ + l * 128 + ln)), fabsf(*(const GAS float*)(c_qg_ + l * 128 + 64 + ln))); gk = fmaxf(fabsf(*(const GAS float*)(c_kg_ + l * 128 + ln)), fabsf(*(const GAS float*)(c_kg_ + l * 128 + 64 + ln)));
      gq = wave_max(gq); gk = wave_max(gk); }
    const float thr = (2.f * 1.01f * 11.313708498984761f * gq * gk + 30.f) * 11.313708498984761f;
    __syncthreads();
    int nfull = 0, nrem = 0, jl = 0, nt = 0;
    if (tid < 256) { const int h = tid >> 5, qb = tid & 31; const float f0 = *(const GAS float*)(FKL + (size_t)h * SEQ + qb * 256);
        for (int j = 0; j < 4 * qb; ++j) jl += (T.fend[h * 128 + j] - f0 <= -thr) ? 1 : 0;
        nt = 4 * (qb + 1) - jl; nfull = nt / ATT_CH; nrem = (nt % ATT_CH) ? 1 : 0; T.jlo[tid] = jl | ((nfull + nrem) << 8); }
    if (tid < 256) { T.scan[tid] = nfull; T.scan[256 + tid] = nrem; }
    __syncthreads();
    for (int o = 1; o < 256; o <<= 1) { int a = 0, b = 0; if (tid < 256 && tid >= o) { a = T.scan[tid - o]; b = T.scan[256 + tid - o]; } __syncthreads();
        if (tid < 256) { T.scan[tid] += a; T.scan[256 + tid] += b; } __syncthreads(); }
    if (tid < 256) { const int totf = T.scan[255], pf = T.scan[tid] - nfull, pr = totf + T.scan[256 + tid] - nrem, jb = 4 * ((tid & 31) + 1);
        for (int c = 0; c < nfull; ++c) T.items[pf + c] = tid | (c << 8) | ((jb - (c + 1) * ATT_CH) << 12) | (ATT_CH << 20);
        if (nrem) T.items[pr] = tid | (nfull << 8) | (jl << 12) | ((nt - nfull * ATT_CH) << 20);
        if (tid == 255) T.nitems[0] = totf + T.scan[511]; }
    __syncthreads();
}
__device__ __forceinline__ void phase_attn_combine(const Frame& F0, int l, const MixTab& T) {
    unsigned char* const ws = opq(F0.ws); const int tid = opq_tid(F0.wave);
    const bf16* PART = (const bf16*)(ws + WS_PART); const float* MLb = (const float*)(ws + WS_ML); bf16* YC = (bf16*)(ws + WS_YCAT);
    for (int b = F0.vcu; b < 256; b += F0.G) {
        const int nch = __builtin_amdgcn_readfirstlane(*(const GAS int*)((const int*)(ws + WS_NCH) + l * 256 + b)); if (nch <= 1) continue;
        const int h = b >> 5, qb = b & 31, row = tid >> 1, half = tid & 1;
        float m[8], w[8], mx = -3.0e38f, ws_ = 0.f;
#pragma unroll
        for (int c = 0; c < 8; ++c) { if (c < nch) { const f32x2 v = *(const GAS f32x2*)(MLb + ((size_t)(b * 8 + c) * 256 + row) * 2); m[c] = v.x; w[c] = v.y; mx = fmaxf(mx, v.x); } else { m[c] = -3.0e38f; w[c] = 0.f; } }
#pragma unroll
        for (int c = 0; c < 8; ++c) { w[c] = (c < nch) ? w[c] * __builtin_amdgcn_exp2f((m[c] - mx) * at::C2) : 0.f; ws_ += w[c]; }
        const float inv = 1.f / ws_;
        float acc[64];
#pragma unroll
        for (int i = 0; i < 64; ++i) acc[i] = 0.f;
#pragma unroll
        for (int c = 0; c < 8; ++c) { if (c < nch) { const bf16* p = PART + ((size_t)(b * 8 + c) * 256 + row) * 128 + half * 64; const float wc = w[c] * inv;
#pragma unroll
            for (int q = 0; q < 8; ++q) { const u32x4 v = *(const GAS u32x4*)(p + q * 8);
                acc[q * 8 + 0] += wc * bf_lo(v.x); acc[q * 8 + 1] += wc * bf_hi(v.x); acc[q * 8 + 2] += wc * bf_lo(v.y); acc[q * 8 + 3] += wc * bf_hi(v.y);
                acc[q * 8 + 4] += wc * bf_lo(v.z); acc[q * 8 + 5] += wc * bf_hi(v.z); acc[q * 8 + 6] += wc * bf_lo(v.w); acc[q * 8 + 7] += wc * bf_hi(v.w); } } }
        bf16* o = YC + (size_t)(qb * 256 + row) * DM + 1024 + h * 128 + half * 64;
#pragma unroll
        for (int q = 0; q < 8; ++q) { u32x4 v; v.x = cvt_pk_bf16(acc[q * 8 + 0], acc[q * 8 + 1]); v.y = cvt_pk_bf16(acc[q * 8 + 2], acc[q * 8 + 3]); v.z = cvt_pk_bf16(acc[q * 8 + 4], acc[q * 8 + 5]); v.w = cvt_pk_bf16(acc[q * 8 + 6], acc[q * 8 + 7]);
            *(GAS u32x4*)(o + q * 8) = v; }
    }
}

struct MoeDynOrder {
    int total, K; const char* Bt; size_t estride; LAS int* tab; gu32* ticket; gu32* ready; gu32* tmo; LAS unsigned* slot;
    __device__ __forceinline__ bool next(int, gm::Unit& u) const {
        if (__builtin_amdgcn_readfirstlane(threadIdx.x >> 6) == 0) {
            unsigned T = 0u;
            if ((threadIdx.x & 63) == 0) T = __hip_atomic_fetch_add(ticket, 1u, RLX_AGENT);
            T = __builtin_amdgcn_readfirstlane(T);
            if (T < (unsigned)total) {
                gu32* w = ready + 16 * (T >> 3); unsigned sp = 0u;
                while ((unsigned)__builtin_amdgcn_readfirstlane(__hip_atomic_load(w, RLX_AGENT)) < 64u) {
                    __builtin_amdgcn_s_sleep(2);
                    if ((++sp & 255u) == 0u) { if (__hip_atomic_load(tmo, RLX_AGENT) != 0u) break; if (sp > (1u << 20)) { __hip_atomic_store(tmo, 1u, RLX_AGENT); break; } } }
                __builtin_amdgcn_fence(__ATOMIC_ACQUIRE, "agent");
                asm volatile("s_waitcnt vmcnt(0)" ::: "memory");
            }
            if ((threadIdx.x & 63) == 0) slot[0] = T;
        }
        asm volatile("s_waitcnt lgkmcnt(0)" ::: "memory"); __builtin_amdgcn_s_barrier(); asm volatile("" ::: "memory");
        const unsigned T = (unsigned)__builtin_amdgcn_readfirstlane((int)slot[0]);
        if (T >= (unsigned)total) return false;
        const int q = (int)(T >> 3), ct = (int)(T & 7);
        int e = 0;
#pragma unroll
        for (int k = 1; k < NEXP; ++k) e += (q >= tab[k]) ? 1 : 0;
        e = __builtin_amdgcn_readfirstlane(e);
        u.e = e; u.rt = q - __builtin_amdgcn_readfirstlane(tab[e]); u.arow = q * 256; u.orow = u.arow; u.ocol = ct * 256;
        u.Bp = Bt + (size_t)e * estride + (size_t)ct * 256 * K * 2; return true;
    }
    __device__ __forceinline__ int row_of(const gm::Unit&, int) const { return 0; }
};
struct EpiZ {
    static constexpr bool PERM = true;
    unsigned char* wsb; int l; LAS float* Pt0;
    __device__ __forceinline__ void operator()(f32x4 (&acc)[2][2][4][2], const gm::Unit& u, int wr, int wc, int fr0, int fq0) const {
        int fr = fr0, fq = fq0; asm volatile("" : "+v"(fr), "+v"(fq));
        unsigned char* const ws = opq(wsb); LAS float* const Pt = opq(Pt0);
        bf16* const O = (bf16*)(ws + WS_Z); bf16* const QN = (bf16*)(ws + WS_QN); bf16* const KN = (bf16*)(ws + WS_KN); bf16* const VN = (bf16*)(ws + WS_VN);
        const int row0 = u.orow + wr * 64 + fr, col0 = u.ocol + wc * 32 + 8 * fq;
        const bool isv = (u.ocol >= 512 && u.ocol < 1024), isq = (u.ocol >= 1536 && u.ocol < 2560), isk = (u.ocol >= 2560 && u.ocol < 3584);
        if (u.ocol < 1024) {
#pragma unroll
            for (int ai = 0; ai < 2; ++ai)
#pragma unroll
                for (int bj = 0; bj < 2; ++bj)
#pragma unroll
                    for (int m = 0; m < 4; ++m)
#pragma unroll
                        for (int n = 0; n < 2; ++n)
#pragma unroll
                            for (int j = 0; j < 4; ++j) acc[ai][bj][m][n][j] = gelu_t(acc[ai][bj][m][n][j]);
        }
        if (isv || isq || isk) {
#pragma unroll
            for (int ai = 0; ai < 2; ++ai)
#pragma unroll
                for (int m = 0; m < 4; ++m)
#pragma unroll
                    for (int bj = 0; bj < 2; ++bj) { const f32x4 a = acc[ai][bj][m][0], b = acc[ai][bj][m][1];
                        float ss = (a[0] * a[0] + a[1] * a[1]) + (a[2] * a[2] + a[3] * a[3]) + (b[0] * b[0] + b[1] * b[1]) + (b[2] * b[2] + b[3] * b[3]);
                        ss += xor_f<16>(ss);
                        { auto rr = __builtin_amdgcn_permlane32_swap(__float_as_uint(ss), __float_as_uint(ss), false, false); ss = __uint_as_float(rr[0]) + __uint_as_float(rr[1]); }
                        if (fq == 0) Pt[((ai * 128 + wr * 64 + m * 16 + fr) * 2 + bj) * 4 + wc] = ss; }
            asm volatile("s_waitcnt lgkmcnt(0)" ::: "memory"); __builtin_amdgcn_s_barrier(); asm volatile("" ::: "memory");
            const float* gp = isv ? karg(9) + l * 512 + (u.ocol - 512) + wc * 32 + 8 * fq : karg(isq ? 12 : 13) + l * 128 + wc * 32 + 8 * fq;
#pragma unroll
            for (int bj = 0; bj < 2; ++bj) {
                const f32x4 g0 = *(const GAS f32x4*)(gp + (isv ? bj * 128 : 0)), g1 = *(const GAS f32x4*)(gp + (isv ? bj * 128 : 0) + 4);
#pragma unroll
                for (int ai = 0; ai < 2; ++ai)
#pragma unroll
                    for (int m = 0; m < 4; ++m) { const int rl = ai * 128 + wr * 64 + m * 16 + fr, row = u.orow + rl;
                        const f32x4 p4 = *(const LAS f32x4*)(Pt + (rl * 2 + bj) * 4);
                        const float rs = rsqrtf(((p4[0] + p4[1]) + (p4[2] + p4[3])) * (1.f / 128.f) + EPSN);
                        const f32x4 v0 = acc[ai][bj][m][0] * rs * g0, v1 = acc[ai][bj][m][1] * rs * g1;
                        u32x4 w; w.x = cvt_pk_bf16(v0[0], v0[1]); w.y = cvt_pk_bf16(v0[2], v0[3]); w.z = cvt_pk_bf16(v1[0], v1[1]); w.w = cvt_pk_bf16(v1[2], v1[3]);
                        bf16* dst;
                        if (isv) dst = VN + (size_t)row * 512 + (u.ocol - 512) + bj * 128 + wc * 32 + 8 * fq;
                        else { const int h = ((u.ocol - (isq ? 1536 : 2560)) >> 7) + bj; dst = (isq ? QN : KN) + ((size_t)h * SEQ + row) * 128 + wc * 32 + 8 * fq; }
                        *(GAS u32x4*)dst = w; } }
            return;
        }
#pragma unroll
        for (int ai = 0; ai < 2; ++ai)
#pragma unroll
            for (int m = 0; m < 4; ++m) { bf16* rowp = O + (size_t)(row0 + ai * 128 + m * 16) * NZ + col0;
#pragma unroll
                for (int bj = 0; bj < 2; ++bj) { const f32x4 v0 = acc[ai][bj][m][0], v1 = acc[ai][bj][m][1];
                    u32x4 w; w.x = cvt_pk_bf16(v0[0], v0[1]); w.y = cvt_pk_bf16(v0[2], v0[3]); w.z = cvt_pk_bf16(v1[0], v1[1]); w.w = cvt_pk_bf16(v1[2], v1[3]);
                    *(GAS u32x4*)(rowp + bj * 128) = w; } }
    }
};
struct EpiRes {
    static constexpr bool PERM = false;
    const float* xin; const LAS float* gate; float* out;
    __device__ __forceinline__ void operator()(const f32x4 (&acc)[2][2][4][2], const gm::Unit& u, int wr, int wc, int fr, int fq) const {
        const int row0 = u.orow + wr * 64 + fr, col0 = u.ocol + wc * 32 + 4 * fq;
        f32x4 gv[2][2];
#pragma unroll
        for (int bj = 0; bj < 2; ++bj)
#pragma unroll
            for (int n = 0; n < 2; ++n) gv[bj][n] = *(const LAS f32x4*)(gate + col0 + bj * 128 + n * 16);
#pragma unroll
        for (int ai = 0; ai < 2; ++ai)
#pragma unroll
            for (int m = 0; m < 4; ++m) { const size_t off = (size_t)(row0 + ai * 128 + m * 16) * DM + col0;
#pragma unroll
                for (int bj = 0; bj < 2; ++bj)
#pragma unroll
                    for (int n = 0; n < 2; ++n) { const f32x4 xv = *(const GAS f32x4*)(xin + off + bj * 128 + n * 16);
                        *(GAS f32x4*)(out + off + bj * 128 + n * 16) = xv + gv[bj][n] * acc[ai][bj][m][n]; } }
    }
};
struct EpiHid {
    static constexpr bool PERM = true;
    bf16* O;
    __device__ __forceinline__ void operator()(const f32x4 (&acc)[2][2][4][2], const gm::Unit& u, int wr, int wc, int fr, int fq) const {
        const int row0 = u.orow + wr * 64 + fr, col0 = (u.ocol >> 1) + wc * 32 + 8 * fq;
#pragma unroll
        for (int ai = 0; ai < 2; ++ai)
#pragma unroll
            for (int m = 0; m < 4; ++m) { bf16* rowp = O + (size_t)(row0 + ai * 128 + m * 16) * DEX + col0;
                f32x4 h0, h1;
#pragma unroll
                for (int j = 0; j < 4; ++j) { h0[j] = silu_f(acc[ai][0][m][0][j]) * acc[ai][1][m][0][j]; h1[j] = silu_f(acc[ai][0][m][1][j]) * acc[ai][1][m][1][j]; }
                u32x4 w; w.x = cvt_pk_bf16(h0[0], h0[1]); w.y = cvt_pk_bf16(h0[2], h0[3]); w.z = cvt_pk_bf16(h1[0], h1[1]); w.w = cvt_pk_bf16(h1[2], h1[3]);
                *(GAS u32x4*)rowp = w; }
    }
};
struct EpiHidPub {
    static constexpr bool PERM = true;
    unsigned char* O; gu32* ready;
    __device__ __forceinline__ void operator()(const f32x4 (&acc)[2][2][4][2], const gm::Unit& u, int wr, int wc, int fr, int fq) const {
        const __amdgpu_buffer_rsrc_t rs = __builtin_amdgcn_make_buffer_rsrc(O, (short)0, (int)(HIDROWS * DEX), 0x00020000);
        const int row0 = u.orow + wr * 64 + fr, col0 = (u.ocol >> 1) + wc * 32 + 8 * fq;
#pragma unroll
        for (int ai = 0; ai < 2; ++ai)
#pragma unroll
            for (int m = 0; m < 4; ++m) { const int off = (row0 + ai * 128 + m * 16) * DEX + col0;
                f32x4 h0, h1;
#pragma unroll
                for (int j = 0; j < 4; ++j) { h0[j] = HID8_SCALE * silu_f(acc[ai][0][m][0][j]) * acc[ai][1][m][0][j]; h1[j] = HID8_SCALE * silu_f(acc[ai][0][m][1][j]) * acc[ai][1][m][1][j]; }
                u32x2 w; w.x = cvt_pk4_fp8(h0[0], h0[1], h0[2], h0[3]); w.y = cvt_pk4_fp8(h1[0], h1[1], h1[2], h1[3]);
                __builtin_amdgcn_raw_buffer_store_b64(w, rs, off, 0, 16); }
        asm volatile("s_waitcnt vmcnt(0)" ::: "memory");
        if (fr == 0 && fq == 0) (void)__hip_atomic_fetch_add(ready + 16 * (u.orow >> 8), 1u, RLX_AGENT);
    }
};
struct EpiYB {
    static constexpr bool PERM = true;
    bf16* O;
    __device__ __forceinline__ void operator()(const f32x4 (&acc)[2][2][4][2], const gm::Unit& u, int wr, int wc, int fr, int fq) const {
        const int row0 = u.orow + wr * 64 + fr, col0 = u.ocol + wc * 32 + 8 * fq;
#pragma unroll
        for (int ai = 0; ai < 2; ++ai)
#pragma unroll
            for (int m = 0; m < 4; ++m) { bf16* rowp = O + (size_t)(row0 + ai * 128 + m * 16) * DM + col0;
#pragma unroll
                for (int bj = 0; bj < 2; ++bj) { const f32x4 v0 = acc[ai][bj][m][0], v1 = acc[ai][bj][m][1];
                    u32x4 w; w.x = cvt_pk_bf16(v0[0], v0[1]); w.y = cvt_pk_bf16(v0[2], v0[3]); w.z = cvt_pk_bf16(v1[0], v1[1]); w.w = cvt_pk_bf16(v1[2], v1[3]);
                    *(GAS u32x4*)(rowp + bj * 128) = w; } }
    }
};

#ifdef MK_SELFTEST
#include "selftest.h"
#endif
__device__ __forceinline__ int bg_need(int p) {
    if (p <= 1) return 0;
    if (p <= 5) return BG_C0;
    if (p <= 7) return BG_C1;
    if (p == 8) return BG_C3;
    if (p <= 10) return BG_C3B;
    if (p <= 14) return BG_C4;
    if (p <= 16) return BG_C5;
    return BG_C7;
}
__device__ __forceinline__ bool bg_seam(int k) { if (k == 0) return true; const int j = (k - 1) % 9; return j != 2 && j != 5 && j != 8; }
struct Args { const float* in[21]; float* out; unsigned char* ws; int ph_lo, ph_hi; };
constexpr int N_PHASES = 1 + 9 * NLAYER + 1;

#ifdef MK_ONLY
#define IN(k) (((k) == 0 ? 0 : (((k) - 1) % 9) + 1) == MK_ONLY && lo <= (k) && (k) < hi)
#else
#define IN(k) (lo <= (k) && (k) < hi)
#endif
#ifndef MK_REPEAT
#define MK_REPEAT -1
#endif
#define REPS(kind) ((MK_REPEAT == (kind)) ? 2 : 1)
#define SEAM(k) do { if (IN(k)) { if (bg_seam(k)) bg_fill(F, (k), bg_need((k) + 1)); if (IN((k) + 1)) xcd_barrier(bar); } } while (0)


template <int l> __device__ __forceinline__ void layer_body(const Frame& F, const XcdBarrier& bar, const int lo, const int hi) {
    constexpr int pb = 1 + 9 * l;

        for (int rep_ = 0; rep_ < REPS(1); ++rep_) if (IN(pb)) { if (rep_) xcd_barrier(bar); unsigned char* const wsl = opq(F.ws); LAS unsigned char* const ldl = opq(F.lds); if (l == 0) phase_norm1<0>(F, l, karg(0), nullptr, 0); else phase_norm1<1>(F, l, (const float*)(wsl + WS_X1), (float*)(wsl + WS_X2), l - 1); }
        SEAM(pb);
        for (int rep_ = 0; rep_ < REPS(2); ++rep_) if (IN(pb + 1)) { if (rep_) xcd_barrier(bar); unsigned char* const wsl = opq(F.ws); LAS unsigned char* const ldl = opq(F.lds);
            const int Gg = (F.G == 256) ? 192 : F.G;
            gm::RegOrder S; S.init(SEQ, NZ, DM / 2, wsl + WS_WIN + (size_t)l * NZ * DM, Gg, (int)blockIdx.x);
            fkl_fixup(F);
            EpiZ E{wsl, l, (LAS float*)(ldl + AUX_OFF)};
            if ((int)blockIdx.x < Gg) gm::gemm_phase<EpiZ, gm::RegOrder, false, true, true, SC_H8, SC_W8>(ldl, (const char*)(wsl + WS_H), DM, S, E, F.wave); }
        SEAM(pb + 1);
        for (int rep_ = 0; rep_ < REPS(4); ++rep_) if (IN(pb + 3)) { if (rep_) xcd_barrier(bar); unsigned char* const wsl = opq(F.ws); LAS unsigned char* const ldl = opq(F.lds);
            const MixTab T = mix_tab_ptrs(ldl);
            mix_build_table(F, l, T);
            if (F.vcu == 0) { const int t_ = opq_tid(F.wave); if (t_ < 256) *(GAS int*)((int*)(wsl + WS_NCH) + l * 256 + t_) = T.jlo[t_] >> 8; }
            const int natt = __builtin_amdgcn_readfirstlane(T.nitems[0]), ntot = natt + 512;
            LAS int* qslot = T.nitems + 1;
            int it = F.vcu;
            while (it < ntot) {
                if (it >= natt) { phase_small_item(F, l, it - natt); }
                else {
                    const int rec = __builtin_amdgcn_readfirstlane(T.items[it]), b = rec & 255, c = (rec >> 8) & 15, ja = (rec >> 12) & 255, n = (rec >> 20) & 31, h = b >> 5, qb = b & 31;
                    const bool fin = (__builtin_amdgcn_readfirstlane(T.jlo[b]) >> 8) <= 1; unsigned char* const ws = opq(wsl);
                    at::BlockRef cur;
                    cur.Q = (const bf16*)(ws + WS_QN) + ((size_t)h * SEQ + qb * 256) * 128; cur.K = (const bf16*)(ws + WS_KN) + (size_t)h * SEQ * 128;
                    cur.V = (const bf16*)(ws + WS_Z) + 3584 + h * 128; cur.O = (bf16*)(ws + WS_YCAT) + (size_t)(qb * 256) * DM + 1024 + h * 128;
                    cur.FK = (const float*)(ws + WS_FKL) + (size_t)h * SEQ; cur.P0 = qb * 256;
                    at::attn_block(cur, ja, n, fin, (bf16*)(ws + WS_PART) + (size_t)(b * 8 + c) * 256 * 128, (float*)(ws + WS_ML) + (size_t)(b * 8 + c) * 256 * 2, (char*)ldl, ldl, F.wave);
                }
                if (opq_tid(F.wave) == 0) qslot[0] = F.G + (int)__hip_atomic_fetch_add(F.ctl + CW_Q + 64 * l + 32 * rep_, 1u, RLX_AGENT);
                __syncthreads();
                it = __builtin_amdgcn_readfirstlane(qslot[0]);
                __syncthreads();
            }
        }
        SEAM(pb + 3);
        for (int rep_ = 0; rep_ < REPS(5); ++rep_) if (IN(pb + 4)) { if (rep_) xcd_barrier(bar); unsigned char* const wsl = opq(F.ws); LAS unsigned char* const ldl = opq(F.lds); const MixTab T = mix_tab_ptrs(ldl); phase_attn_combine(F, l, T); }
        SEAM(pb + 4);
        for (int rep_ = 0; rep_ < REPS(6); ++rep_) if (IN(pb + 5)) { if (rep_) xcd_barrier(bar); unsigned char* const wsl = opq(F.ws); LAS unsigned char* const ldl = opq(F.lds); gm::RegOrder S; S.init(SEQ, DM, DM, wsl + WS_WOUT + (size_t)l * DM * DM * 2, F.G, (int)blockIdx.x);
            LAS float* g1L = (LAS float*)(ldl + AUX_OFF);
            { const float* const b_ada_ = karg(3); for (int d = opq_tid(F.wave); d < DM; d += NTHR) g1L[d] = mod_at(wsl, b_ada_, l, 2 * DM + d); }
            __syncthreads();
            EpiRes E{(l == 0) ? karg(0) : (const float*)(wsl + WS_X2), g1L, (float*)(wsl + WS_X1)};
            gm::gemm_phase<EpiRes, gm::RegOrder, false, true>(ldl, (const char*)(wsl + WS_YCAT), DM, S, E, F.wave); }
        SEAM(pb + 5);
        for (int rep_ = 0; rep_ < REPS(7); ++rep_) if (IN(pb + 6)) { if (rep_) xcd_barrier(bar); unsigned char* const wsl = opq(F.ws); LAS unsigned char* const ldl = opq(F.lds); phase_norm2_route(F, l); }
        SEAM(pb + 6);
        for (int rep_ = 0; rep_ < REPS(8); ++rep_) if (IN(pb + 7)) { if (rep_) xcd_barrier(bar); unsigned char* const wsl = opq(F.ws); LAS unsigned char* const ldl = opq(F.lds); LAS int* tab = (LAS int*)(ldl + AUX_OFF + 20480); moe_table(F, l, tab);
            gu32* const rdy = F.ctl + CW_RDY + 4096 * l + 2048 * rep_;
            { MoeOrder S; S.G = F.G; S.c = F.vcu; S.total = 8 * tab[16]; S.K = DM / 2; S.nct = 8; S.Bt = (const char*)(wsl + WS_WGU) + (size_t)l * NEXP * DM * DM; S.estride = (size_t)DM * DM;
              S.list = (const int*)(wsl + WS_LIST); S.tab = tab;
              EpiHidPub E{wsl + (l ? WS_HID1 : WS_HID), rdy};
              gm::gemm_phase<EpiHidPub, MoeOrder, true, true, true, SC_H8, SC_W8>(ldl, (const char*)(wsl + WS_H), DM, S, E, F.wave); }
            { MoeDynOrder S; S.total = 8 * tab[16]; S.K = DEX / 2; S.Bt = (const char*)(wsl + WS_WD) + (size_t)l * NEXP * DM * DEX; S.estride = (size_t)DM * DEX; S.tab = tab;
              S.ticket = F.ctl + CW_MT + 64 * l + 32 * rep_; S.ready = rdy; S.tmo = F.ctl + CW_TMO; S.slot = (LAS unsigned*)(ldl + AUX_OFF + 24576 + 64);
              EpiYB E{(bf16*)(wsl + WS_YB)};
              gm::gemm_phase<EpiYB, MoeDynOrder, false, true, true, SC_HID8, SC_W8>(ldl, (const char*)(wsl + (l ? WS_HID1 : WS_HID)), DEX, S, E, F.wave); }
        }
        SEAM(pb + 7);
    }

__global__ void __launch_bounds__(NTHR, 2) mk_fwd(Args args) {
    extern __shared__ __attribute__((aligned(16))) unsigned char lds[];
    Frame F;
    F.lds = (LAS unsigned char*)lds; F.MISC = (volatile LAS unsigned*)(F.lds + MISC_OFF);
    F.tid = 0; F.lane = 0; F.wave = __builtin_amdgcn_readfirstlane((int)threadIdx.x >> 6);
    F.G = gridDim.x; { const int bx = blockIdx.x; F.vcu = (F.G % 8 == 0) ? (bx % 8) * (F.G / 8) + bx / 8 : bx; }
    F.ws = args.ws; F.ctl = (gu32*)(args.ws + WS_CTL);
    for (int u = threadIdx.x; u < (LDS_BYTES - RING_BYTES) / 4; u += NTHR) ((LAS unsigned*)(F.lds + RING_BYTES))[u] = 0u;
    __syncthreads();
    const int lo = args.ph_lo, hi = args.ph_hi;
    const bool multi = (hi - lo) > 1;
    XcdBarrier bar; bar.bar = (unsigned*)(F.ctl + CW_BAR); bar.x = 0; bar.st = nullptr;
    if (multi) bar = xcd_barrier_post((unsigned*)(F.ctl + CW_BAR), F.MISC + 8);
    for (int rep_ = 0; rep_ < REPS(0); ++rep_) if (IN(0)) { if (rep_) xcd_barrier(bar); p0_prologue(F); } SEAM(0);

    layer_body<0>(F, bar, lo, hi);
    layer_body<1>(F, bar, lo, hi);
    for (int rep_ = 0; rep_ < REPS(10); ++rep_) if (IN(N_PHASES - 1)) { if (rep_) xcd_barrier(bar); phase_norm1<2>(F, NLAYER - 1, (const float*)(F.ws + WS_X1), (float*)karg(21), NLAYER - 1); }
#ifdef MK_SELFTEST
    {
        const bool h0 = st_run(0, 1.f, 0x7f7f7f7f), h0s = st_run(0, 64.f, 0x79797979), h1 = st_run(1, 1.f, 0x7f7f7f7f);
        xcd_barrier(bar);
        float* o = (float*)karg(21);
        if (!(h0 && h0s)) { const float val = h0 ? 0.f : (h1 ? 1000.f : __builtin_nanf(""));
            for (size_t i = (size_t)blockIdx.x * NTHR + threadIdx.x; i < (size_t)SEQ * DM; i += (size_t)gridDim.x * NTHR) o[i] = val; }
    }
#endif
#undef IN
#undef SEAM
}

#ifndef MK_LAUNCHES
#define MK_LAUNCHES 1
#endif
extern "C" void kernel_launch(void* const* d_in, const int* in_sizes, int n_in, void* d_out, int out_size, void* d_ws, size_t ws_size, hipStream_t stream) {
    static int grid = 0;
    if (grid == 0) {
        int dev = 0, cus = 0, per_cu = 0;
        if (n_in != 21 || ws_size < WS_END) { fprintf(stderr, "kernel_launch: unexpected inputs (n_in %d, ws %zu)\n", n_in, ws_size); grid = -1; return; }
        if (hipGetDevice(&dev) != hipSuccess || hipDeviceGetAttribute(&cus, hipDeviceAttributeMultiprocessorCount, dev) != hipSuccess) { grid = -1; return; }
        if (hipFuncSetAttribute((const void*)mk_fwd, hipFuncAttributeMaxDynamicSharedMemorySize, LDS_BYTES) != hipSuccess) { fprintf(stderr, "kernel_launch: hipFuncSetAttribute failed\n"); grid = -1; return; }
        if (hipOccupancyMaxActiveBlocksPerMultiprocessor(&per_cu, (const void*)mk_fwd, NTHR, LDS_BYTES) != hipSuccess || per_cu < 1) fprintf(stderr, "kernel_launch: occupancy query says %d\n", per_cu);
        (void)hipGetLastError();
        grid = cus;
    }
    if (grid < 0) return;
    (void)hipMemsetAsync((char*)d_ws + WS_CTL, 0, CTL_ZERO_BYTES, stream);
    Args a{};
    for (int i = 0; i < 21; ++i) a.in[i] = (const float*)d_in[i];
    a.out = (float*)d_out; a.ws = (unsigned char*)d_ws;
#if MK_LAUNCHES == 1
    a.ph_lo = 0; a.ph_hi = N_PHASES;
    hipLaunchKernelGGL(mk_fwd, dim3(grid), dim3(NTHR), LDS_BYTES, stream, a);
#else
    for (int p = 0; p < N_PHASES; ++p) { a.ph_lo = p; a.ph_hi = p + 1; hipLaunchKernelGGL(mk_fwd, dim3(grid), dim3(NTHR), LDS_BYTES, stream, a); }
#endif
}
```

```cpp
#include <hip/hip_runtime.h>
#include <stdint.h>
#include <stdio.h>

#define GAS __attribute__((address_space(1)))
#define LAS __attribute__((address_space(3)))
typedef unsigned short bf16;
typedef short bf16x8 __attribute__((ext_vector_type(8)));
typedef short s16x4 __attribute__((ext_vector_type(4)));
typedef float f32x2 __attribute__((ext_vector_type(2)));
typedef float f32x4 __attribute__((ext_vector_type(4)));
typedef float f32x16 __attribute__((ext_vector_type(16)));
typedef unsigned u32x2 __attribute__((ext_vector_type(2)));
typedef unsigned u32x4 __attribute__((ext_vector_type(4)));
typedef int i32x8 __attribute__((ext_vector_type(8)));
typedef int i32x4 __attribute__((ext_vector_type(4)));
typedef GAS unsigned gu32;
#define RLX_AGENT __ATOMIC_RELAXED, __HIP_MEMORY_SCOPE_AGENT
#define LDS_WAIT() asm volatile("s_waitcnt lgkmcnt(0)" ::: "memory")
#define VM_WAIT() asm volatile("s_waitcnt vmcnt(0)" ::: "memory")

constexpr int DM = 2048, SEQ = 8192, NIN = 4616, NZ = 4608, DEX = 1024, NEXP = 16, NLAYER = 2;
constexpr float EPSN = 1e-6f;
constexpr float LOG2E = 1.4426950408889634f;
constexpr int NWAVES = 8, NTHR = 512;
constexpr int HIDROWS = 2 * SEQ + NEXP * 256;

constexpr size_t KiB = 1024, MiB = 1u << 20;
constexpr size_t WS_CTL = 0, CTL_ZERO_BYTES = 1 * MiB;
constexpr size_t WS_MOD = 1 * MiB;
constexpr size_t WS_FLOC = WS_MOD + 128 * KiB;
constexpr size_t WS_TOT = WS_FLOC + 256 * KiB;
constexpr size_t WS_FKL = WS_TOT + 8 * KiB;
constexpr size_t WS_TOKE = WS_FKL + 256 * KiB;
constexpr size_t WS_TOKP = WS_TOKE + 64 * KiB;
constexpr size_t WS_TOKW = WS_TOKP + 64 * KiB;
constexpr size_t WS_NCH = 7 * MiB;
constexpr size_t WS_LIST = WS_TOKW + 64 * KiB;
constexpr size_t WS_WM = 4 * MiB;
constexpr size_t WS_BWT = WS_WM + 256 * KiB;
constexpr size_t WS_MODP = 6 * MiB;
constexpr size_t WS_WIN = 8 * MiB;
constexpr size_t WS_WOUT = WS_WIN + 2 * 18 * MiB;
constexpr size_t WS_WGU = WS_WOUT + 2 * 8 * MiB;
constexpr size_t WS_WD = WS_WGU + 2 * 16 * 8 * MiB;
constexpr size_t WS_H = WS_WD + 2 * 16 * 4 * MiB;
constexpr size_t WS_Z = WS_H + 32 * MiB;
constexpr size_t WS_QN = WS_Z + 72 * MiB;
constexpr size_t WS_KN = WS_QN + 16 * MiB;
constexpr size_t WS_VN = WS_KN + 16 * MiB;
constexpr size_t WS_DP = WS_VN + 8 * MiB;
constexpr size_t WS_YCAT = WS_DP + 8 * MiB;
constexpr size_t WS_X1 = WS_YCAT + 32 * MiB;
constexpr size_t WS_X2 = WS_X1 + 64 * MiB;
constexpr size_t WS_HID = WS_X2 + 64 * MiB;
constexpr size_t WS_YB = WS_HID + 40 * MiB;
constexpr size_t WS_PART = WS_YB + 80 * MiB;
constexpr size_t WS_ML = WS_PART + 128 * MiB;
constexpr size_t WS_HID1 = WS_ML + 4 * MiB;
constexpr size_t WS_END = WS_HID1 + 40 * MiB;
constexpr int CW_TMO = 0, CW_CODE = 1;
constexpr int CW_CNT = 64;
constexpr int CW_Q = 512;
constexpr int CW_BGT = 640;
constexpr int CW_ARR = 1024;
constexpr int CW_MT = 768;
constexpr int CW_BAR = 4096;
constexpr int CW_RDY = 8192;

constexpr int RING_BYTES = 131072;
constexpr int MISC_OFF = RING_BYTES + 320;
constexpr int AUX_OFF = RING_BYTES + 1024;
constexpr int LDS_BYTES = 163840;

template <class T> __device__ __forceinline__ T* opq(T* p) { asm volatile("" : "+s"(p)); return p; }
__device__ __forceinline__ int opq_tid(int wave) { int t = (wave << 6) | (int)__builtin_amdgcn_mbcnt_hi(~0u, __builtin_amdgcn_mbcnt_lo(~0u, 0u)); asm volatile("" : "+v"(t)); return t; }
__device__ __forceinline__ unsigned cvt_pk_bf16(float lo, float hi) { unsigned r; asm volatile("v_cvt_pk_bf16_f32 %0, %1, %2" : "=v"(r) : "v"(lo), "v"(hi)); return r; }
__device__ __forceinline__ unsigned cvt_pk4_fp8(float a, float b, float c, float d) {
    a = fminf(fmaxf(a, -440.f), 440.f); b = fminf(fmaxf(b, -440.f), 440.f); c = fminf(fmaxf(c, -440.f), 440.f); d = fminf(fmaxf(d, -440.f), 440.f);
    unsigned w; asm volatile("v_cvt_pk_fp8_f32 %0, %1, %2" : "=v"(w) : "v"(a), "v"(b)); asm volatile("v_cvt_pk_fp8_f32 %0, %1, %2 op_sel:[0,0,1]" : "+v"(w) : "v"(c), "v"(d)); return w; }
constexpr float H8_SCALE = 4.f, HID8_SCALE = 4.f, W8_SCALE = 64.f;
constexpr int SC_H8 = 0x7b7b7b7b, SC_HID8 = 0x7b7b7b7b, SC_W8 = 0x7b7b7b7b;
__device__ __forceinline__ float bf_lo(unsigned w) { return __uint_as_float(w << 16); }
__device__ __forceinline__ float bf_hi(unsigned w) { return __uint_as_float(w & 0xffff0000u); }
template <int M> __device__ __forceinline__ float xor_f(float v) {
    static_assert(M < 32, "xor_f: masks below 32 only");
    return __uint_as_float((unsigned)__builtin_amdgcn_ds_swizzle((int)__float_as_uint(v), (M << 10) | 0x1f));
}
__device__ __forceinline__ float wave_sum(float v) {
    v += __uint_as_float((unsigned)__builtin_amdgcn_update_dpp(0, (int)__float_as_uint(v), 0xb1, 0xf, 0xf, true));
    v += __uint_as_float((unsigned)__builtin_amdgcn_update_dpp(0, (int)__float_as_uint(v), 0x4e, 0xf, 0xf, true));
    v += __uint_as_float((unsigned)__builtin_amdgcn_update_dpp(0, (int)__float_as_uint(v), 0x141, 0xf, 0xf, true));
    v += __uint_as_float((unsigned)__builtin_amdgcn_update_dpp(0, (int)__float_as_uint(v), 0x140, 0xf, 0xf, true));
    v += xor_f<16>(v);
    { auto rr = __builtin_amdgcn_permlane32_swap(__float_as_uint(v), __float_as_uint(v), false, false); v = __uint_as_float(rr[0]) + __uint_as_float(rr[1]); }
    return v;
}
__device__ __forceinline__ float wave_max(float v) {
    v = fmaxf(v, xor_f<1>(v)); v = fmaxf(v, xor_f<2>(v)); v = fmaxf(v, xor_f<4>(v)); v = fmaxf(v, xor_f<8>(v)); v = fmaxf(v, xor_f<16>(v));
    { auto rr = __builtin_amdgcn_permlane32_swap(__float_as_uint(v), __float_as_uint(v), false, false); v = fmaxf(__uint_as_float(rr[0]), __uint_as_float(rr[1])); }
    return v;
}
__device__ __forceinline__ float gelu_t(float x) {
    const float u2 = x * (1.5957691216057308f + 0.0713548162726f * x * x);
    return x * __builtin_amdgcn_rcpf(1.f + __builtin_amdgcn_exp2f(-LOG2E * u2));
}
__device__ __forceinline__ float silu_f(float x) { return x * __builtin_amdgcn_rcpf(1.f + __builtin_amdgcn_exp2f(-LOG2E * x)); }

#define XB_TMO      128
#define XB_XCNT(j)  (256  + 64 * (j))
#define XB_XSUB(j)  (1280 + 64 * (j))
#define XB_XGEN(j)  (2304 + 64 * (j))
#define XB_TOP      3328
#define XB_TOPGEN   3392
#define XCD_BAR_WORDS 3456
#define XB_SPIN_CAP (1u << 18)
__device__ __forceinline__ unsigned xb_ld(unsigned* p)              { return __hip_atomic_load(p, __ATOMIC_RELAXED, __HIP_MEMORY_SCOPE_AGENT); }
__device__ __forceinline__ unsigned xb_add(unsigned* p, unsigned v) { return __hip_atomic_fetch_add(p, v, __ATOMIC_RELAXED, __HIP_MEMORY_SCOPE_AGENT); }
__device__ __forceinline__ unsigned xb_xcc_id() { return (unsigned)__builtin_amdgcn_s_getreg((3 << 11) | 20) & 0xFu; }
#define XB_SPIN(cond, bar) do { unsigned _sp = 0; while (cond) { __builtin_amdgcn_s_sleep(1); \
    if ((++_sp & 255u) == 0u) { if (xb_ld(&(bar)[XB_TMO])) break; if (_sp > XB_SPIN_CAP) { atomicAdd(&(bar)[XB_TMO], 1u); break; } } } } while (0)
struct XcdBarrier { unsigned* bar; unsigned x; volatile LAS unsigned* st; };
__device__ __forceinline__ XcdBarrier xcd_barrier_post(unsigned* bar, volatile LAS unsigned* st) {
    XcdBarrier b; b.bar = bar; b.x = xb_xcc_id(); b.st = st;
    if (threadIdx.x == 0) (void)xb_add(&bar[XB_XCNT(b.x)], 1u);
    return b;
}
__device__ __forceinline__ void xcd_barrier_complete(unsigned* bar, unsigned x, unsigned& nloc, unsigned& nx) {
    const unsigned G = gridDim.x * gridDim.y * gridDim.z;
    unsigned sum, cnt, mine, sp = 0u;
    for (;;) {
        sum = 0u; cnt = 0u; mine = 0u;
#pragma unroll
        for (unsigned j = 0; j < 16; ++j) { const unsigned c = xb_ld(&bar[XB_XCNT(j)]); sum += c; cnt += (c > 0u) ? 1u : 0u; mine = (j == x) ? c : mine; }
        if (sum == G) break;
        __builtin_amdgcn_s_sleep(1);
        if ((++sp & 255u) == 0u) { if (xb_ld(&bar[XB_TMO])) break; if (sp > XB_SPIN_CAP) { atomicAdd(&bar[XB_TMO], 1u); break; } }
    }
    nloc = mine > 0u ? mine : 1u; nx = cnt > 0u ? cnt : 1u;
}
__device__ __forceinline__ void xcd_barrier(const XcdBarrier& b) {
    asm volatile("s_waitcnt vmcnt(0)" ::: "memory");
    __syncthreads();
    if (threadIdx.x == 0) {
        unsigned* bar = b.bar; asm volatile("" : "+s"(bar));
        __builtin_amdgcn_s_waitcnt(0);
        unsigned nloc = b.st[0], nx = b.st[1];
        if (nloc == 0u) { xcd_barrier_complete(bar, b.x, nloc, nx); b.st[0] = nloc; b.st[1] = nx; }
        const unsigned old = xb_add(&bar[XB_XSUB(b.x)], 1u);
        const unsigned gen = old / nloc;
        if (old + 1u == (gen + 1u) * nloc) {
            __builtin_amdgcn_fence(__ATOMIC_RELEASE, "agent");
            asm volatile("s_waitcnt vmcnt(0)" ::: "memory");
            const unsigned og = xb_add(&bar[XB_TOP], 1u);
            const unsigned tg = og / nx;
            if (og + 1u == (tg + 1u) * nx) xb_add(&bar[XB_TOPGEN], 1u);
            else XB_SPIN(xb_ld(&bar[XB_TOPGEN]) == tg, bar);
            __builtin_amdgcn_fence(__ATOMIC_ACQUIRE, "agent");
            xb_add(&bar[XB_XGEN(b.x)], 1u);
            asm volatile("s_waitcnt vmcnt(0)" ::: "memory");
        } else {
            XB_SPIN(xb_ld(&bar[XB_XGEN(b.x)]) == gen, bar);
            __builtin_amdgcn_fence(__ATOMIC_ACQUIRE, "agent");
            asm volatile("s_waitcnt vmcnt(0)" ::: "memory");
        }
    }
    __syncthreads();
}

namespace gm {
constexpr int BM = 256, BK = 64, HALF = 128, HTB = HALF * BK * 2, STAGE_BYTES = 8 * HTB, NXCD = 8, WGM = 8;
__host__ __device__ __forceinline__ int lds_byte(int r, int c) { const int st = (r >> 4) * 2 + (c >> 5), rr = r & 15, cc = c & 31, ob = rr * 64 + cc * 2; return st * 1024 + (ob ^ (((ob >> 9) & 1) << 5)); }
__host__ __device__ __forceinline__ void stage_rc(int b, int& R, int& C) { const int st = b / 1024, sb = b % 1024, swz = sb ^ (((sb >> 9) & 1) << 5); R = (st >> 1) * 16 + swz / 64; C = (st & 1) * 32 + (swz % 64) / 2; }
__host__ __device__ __forceinline__ int perm32(int rho) { const int n = rho >> 4, i = rho & 15; return 8 * (i >> 2) + 4 * n + (i & 3); }

struct Unit { int arow, orow, ocol, e, rt; const char* Bp; };

template <class Epi, class Sched, bool GATHER, bool ALIGN_EPI, bool FP8 = false, int SCA = 0x7f7f7f7f, int SCB = 0x7f7f7f7f>
__device__ __forceinline__ void gemm_phase(LAS unsigned char* lds, const char* Abase, const int Kel, const Sched& S, const Epi& E, const int wv) {
    const int K = FP8 ? (Kel >> 1) : Kel;
    const int tid = opq_tid(wv), wid = wv, lane = tid & 63, wr = wid >> 2, wc = wid & 3, fr = lane & 15, fq = lane >> 4;
    const int nt = K / BK;
    unsigned voffA[2], voffB[2];
#pragma unroll
    for (int i = 0; i < 2; ++i) { int R, C; stage_rc(tid * 16 + i * 8192, R, C); const int Rb = Epi::PERM ? ((R & ~31) + perm32(R & 31)) : R;
        voffA[i] = (unsigned)(R * K + C) * 2u; voffB[i] = (unsigned)(Rb * K + C) * 2u; }
    const size_t kstep = (size_t)(BK * 2);
    const size_t hstep = (size_t)HALF * K * 2;
    const unsigned ldsw = (unsigned)wid * 1024u;
    const int aoff = FP8 ? lds_byte(wr * 64 + fr, fq * 16) : lds_byte(wr * 64 + fr, fq * 8), boff = FP8 ? lds_byte(wc * 32 + fr, fq * 16) : lds_byte(wc * 32 + fr, fq * 8);
#define PG8_SA(b, h) (((b) * 2 + (h)) * HTB)
#define PG8_SB(b, h) ((4 + (b) * 2 + (h)) * HTB)
#define PG8_STAGE(bufoff, gbase, voff) do { _Pragma("unroll") for (int _i = 0; _i < 2; ++_i) { unsigned vo_ = (voff)[_i]; asm volatile("" : "+v"(vo_));     \
        __builtin_amdgcn_global_load_lds((const unsigned*)((const char*)(gbase) + vo_), (LAS unsigned*)(lds + (bufoff) + ldsw + _i * 8192), 16, 0, 0); } } while (0)
#define PG8_STAGE_A(bufoff, ubase, h, kb, vg) do { if constexpr (GATHER) { PG8_STAGE(bufoff, Abase + (kb), (vg)[h]); } else { PG8_STAGE(bufoff, (ubase) + (h) * hstep + (kb), voffA); } } while (0)
#define PG8_STAGE_A2(bufoff, ubase, h, kb) PG8_STAGE_A(bufoff, ubase, h, kb, vgc)
#define PG8_LDA(dst, b, h) do { _Pragma("unroll") for (int m = 0; m < 4; ++m) { if constexpr (FP8) { dst##8[m].lo = *(const LAS i32x4*)(lds + PG8_SA(b, h) + aoff + m * 2048); dst##8[m].hi = *(const LAS i32x4*)(lds + PG8_SA(b, h) + aoff + 16 + m * 2048); } \
        else { dst[m][0] = *(const LAS bf16x8*)(lds + PG8_SA(b, h) + aoff + m * 2048); dst[m][1] = *(const LAS bf16x8*)(lds + PG8_SA(b, h) + aoff + 1024 + m * 2048); } } } while (0)
#define PG8_LDB(dst, b, h) do { _Pragma("unroll") for (int n = 0; n < 2; ++n) { if constexpr (FP8) { dst##8[n].lo = *(const LAS i32x4*)(lds + PG8_SB(b, h) + boff + n * 2048); dst##8[n].hi = *(const LAS i32x4*)(lds + PG8_SB(b, h) + boff + 16 + n * 2048); } \
        else { dst[n][0] = *(const LAS bf16x8*)(lds + PG8_SB(b, h) + boff + n * 2048); dst[n][1] = *(const LAS bf16x8*)(lds + PG8_SB(b, h) + boff + 1024 + n * 2048); } } } while (0)
#define PG8_F8(x) __builtin_shufflevector(__builtin_bit_cast(i32x4, (x)[0]), __builtin_bit_cast(i32x4, (x)[1]), 0, 1, 2, 3, 4, 5, 6, 7)
#define PG8_MMA(ai, bj, At, Bt) do { __builtin_amdgcn_s_setprio(1); _Pragma("unroll") for (int m = 0; m < 4; ++m) _Pragma("unroll") for (int n = 0; n < 2; ++n) { \
        if constexpr (FP8) { acc[ai][bj][m][n] = __builtin_amdgcn_mfma_scale_f32_16x16x128_f8f6f4(Bt##8[n], At##8[m], acc[ai][bj][m][n], 0, 0, 0, SCB, 0, SCA); } \
        else { _Pragma("unroll") for (int k = 0; k < 2; ++k) acc[ai][bj][m][n] = __builtin_amdgcn_mfma_f32_16x16x32_bf16(Bt[n][k], At[m][k], acc[ai][bj][m][n], 0, 0, 0); } } \
        __builtin_amdgcn_s_setprio(0); } while (0)
#define PG8_WAIT_V(n) asm volatile("s_waitcnt vmcnt(" #n ")" ::: "memory")
#define PG8_WAIT_L(n) asm volatile("s_waitcnt lgkmcnt(" #n ")" ::: "memory")
#define PG8_BAR __builtin_amdgcn_s_barrier()
#define PG8_SCHED __builtin_amdgcn_sched_barrier(0)
    Unit cur, nxt; int ui = 0;
    if (!S.next(0, cur)) return;
    f32x4 acc[2][2][4][2];
#pragma unroll
    for (int a = 0; a < 2; ++a)
#pragma unroll
        for (int b = 0; b < 2; ++b)
#pragma unroll
            for (int m = 0; m < 4; ++m)
#pragma unroll
                for (int n = 0; n < 2; ++n) acc[a][b][m][n] = (f32x4){0.f, 0.f, 0.f, 0.f};
    bf16x8 At[4][2], B0[2][2], B1[2][2];
    i32x8 At8[4], B08[2], B18[2];
    unsigned vgc[2][2];
    if constexpr (GATHER) {
#pragma unroll
        for (int h = 0; h < 2; ++h)
#pragma unroll
            for (int i = 0; i < 2; ++i) { int R_, C_; stage_rc(opq_tid(wv) * 16 + i * 8192, R_, C_); vgc[h][i] = ((unsigned)S.row_of(cur, h * HALF + R_) * (unsigned)K + (unsigned)C_) * 2u; }
    }
    const char* cA = GATHER ? Abase : Abase + (size_t)cur.arow * K * 2; const char* cB = cur.Bp;
    PG8_STAGE(PG8_SB(0, 0), cB, voffB); PG8_STAGE(PG8_SB(0, 1), cB + hstep, voffB); PG8_STAGE_A(PG8_SA(0, 0), cA, 0, 0, vgc); PG8_STAGE_A(PG8_SA(0, 1), cA, 1, 0, vgc);
    if (wr == 1) PG8_BAR;
    PG8_WAIT_V(2); PG8_BAR;
    PG8_STAGE(PG8_SB(1, 0), cB + kstep, voffB); PG8_STAGE_A(PG8_SA(1, 0), cA, 0, kstep, vgc); PG8_STAGE(PG8_SB(1, 1), cB + hstep + kstep, voffB);
    PG8_WAIT_V(6); PG8_BAR;
    for (;;) {
        bool has_next = false;
        const char* nA = cA; const char* nB = cB;
        for (int t = 0; t < nt; t += 2) {
            const bool last = (t == nt - 2);
            if (last) { has_next = S.next(ui + 1, nxt); if (has_next) { nA = GATHER ? Abase : Abase + (size_t)nxt.arow * K * 2; nB = nxt.Bp; } }
            const size_t k1 = (size_t)(t + 1) * kstep;
            const char* a2 = last ? nA : cA; const char* b2 = last ? nB : cB + (size_t)(t + 2) * kstep;
            const size_t k2 = last ? 0 : (size_t)(t + 2) * kstep, k3 = k2 + kstep;
            const char* b3 = b2 + kstep;
            PG8_LDB(B0, 0, 0); PG8_LDB(B1, 0, 1); PG8_SCHED; PG8_LDA(At, 0, 0); PG8_STAGE_A(PG8_SA(1, 1), cA, 1, k1, vgc);
            if constexpr (GATHER) { if (last && has_next) {
#pragma unroll
                for (int h = 0; h < 2; ++h)
#pragma unroll
                    for (int i = 0; i < 2; ++i) { int R_, C_; stage_rc(opq_tid(wv) * 16 + i * 8192, R_, C_); vgc[h][i] = ((unsigned)S.row_of(nxt, h * HALF + R_) * (unsigned)K + (unsigned)C_) * 2u; } } }
            PG8_WAIT_V(8); PG8_WAIT_L(0); PG8_BAR; PG8_MMA(0, 0, At, B0); PG8_MMA(0, 1, At, B1); PG8_BAR; PG8_SCHED;
            PG8_LDA(At, 0, 1); PG8_STAGE(PG8_SB(0, 0), b2, voffB); PG8_STAGE(PG8_SB(0, 1), b2 + hstep, voffB); PG8_STAGE_A2(PG8_SA(0, 0), a2, 0, k2);
            PG8_WAIT_V(8); PG8_WAIT_L(0); PG8_BAR; PG8_MMA(1, 0, At, B0); PG8_MMA(1, 1, At, B1); PG8_BAR; PG8_SCHED;
            PG8_LDB(B0, 1, 0); PG8_LDB(B1, 1, 1); PG8_SCHED; PG8_LDA(At, 1, 0); PG8_STAGE_A2(PG8_SA(0, 1), a2, 1, k2);
            PG8_WAIT_V(8); PG8_WAIT_L(0); PG8_BAR; PG8_MMA(0, 0, At, B0); PG8_MMA(0, 1, At, B1); PG8_BAR; PG8_SCHED;
            PG8_LDA(At, 1, 1); PG8_STAGE(PG8_SB(1, 0), b3, voffB); PG8_STAGE(PG8_SB(1, 1), b3 + hstep, voffB); PG8_STAGE_A2(PG8_SA(1, 0), a2, 0, k3);
            PG8_WAIT_V(8); PG8_WAIT_L(0); PG8_BAR; PG8_MMA(1, 0, At, B0); PG8_MMA(1, 1, At, B1); PG8_BAR; PG8_SCHED;
        }
        if constexpr (ALIGN_EPI) { if (wr == 0) PG8_BAR; }
        E(acc, cur, wr, wc, fr, fq);
        if (!has_next) break;
#pragma unroll
        for (int a = 0; a < 2; ++a)
#pragma unroll
            for (int b = 0; b < 2; ++b)
#pragma unroll
                for (int m = 0; m < 4; ++m)
#pragma unroll
                    for (int n = 0; n < 2; ++n) acc[a][b][m][n] = (f32x4){0.f, 0.f, 0.f, 0.f};
        cur = nxt; cA = nA; cB = nB; ++ui;
        if constexpr (ALIGN_EPI) { if (wr == 1) PG8_BAR; }
    }
    PG8_WAIT_V(0);
    if constexpr (!ALIGN_EPI) { if (wr == 0) PG8_BAR; }
    PG8_BAR;
#undef PG8_SA
#undef PG8_SB
#undef PG8_STAGE
#undef PG8_STAGE_A
#undef PG8_STAGE_A2
#undef PG8_LDA
#undef PG8_LDB
#undef PG8_MMA
#undef PG8_F8
#undef PG8_WAIT_V
#undef PG8_WAIT_L
#undef PG8_BAR
#undef PG8_SCHED
}

struct RegOrder {
    int nM, nN, nwg, G, c, K; const char* Bt;
    __device__ __forceinline__ void init(int M, int N, int K_, const void* Bt_, int G_, int c_) { nM = M / BM; nN = N / BM; nwg = nM * nN; G = G_; c = c_; K = K_; Bt = (const char*)Bt_; }
    __device__ __forceinline__ bool next(int i, Unit& u) const {
        const long L = (long)i * G + c; if (L >= nwg) return false;
        int wgid = (int)L; { const int q = nwg / NXCD, r = nwg % NXCD, xcd = wgid % NXCD, off = wgid / NXCD; wgid = (xcd < r ? xcd * (q + 1) : r * (q + 1) + (xcd - r) * q) + off; }
        const int nig = WGM * nN, gid = wgid / nig, fm = gid * WGM, gsz = (nM - fm) < WGM ? (nM - fm) : WGM;
        const int pm = fm + ((wgid % nig) % gsz), pn = (wgid % nig) / gsz;
        u.arow = pm * BM; u.orow = pm * BM; u.ocol = pn * BM; u.e = 0; u.rt = 0; u.Bp = Bt + (size_t)pn * BM * K * 2; return true;
    }
    __device__ __forceinline__ int row_of(const Unit&, int) const { return 0; }
};
}
namespace at {
constexpr int NW = 8, QBLK = 32, KVBLK = 64, QB = NW * QBLK, D = 128;
constexpr int SHM_V = KVBLK * D * 2, SHM_K = KVBLK * D * 2;
constexpr int OFF_WS = 2 * SHM_V + 2 * SHM_K, OFF_NF = OFF_WS + NW * 64 * 4, ATT_LDS = OFF_NF + 2 * 64 * 4;
constexpr float SCALE = 0.08838834764831845f, C2 = 1.4426950408889634f * SCALE, THR = 8.f;
constexpr float ISCALE = 11.313708498984761f;
constexpr int QS = 128, KS = 128, VS = NZ, OS = DM;

#define KSWZ(row, colB) ((row) * 256 + ((colB) ^ (((row) & 7) << 4)))
#define SBAR() __builtin_amdgcn_sched_barrier(0)
__device__ __forceinline__ int v_st(int k, int c) { const int kk = (k & ~0xC) | ((k & 4) << 1) | ((k & 8) >> 1); return ((kk >> 3) * 4 + (c >> 5)) * 512 + ((kk & 7) * 32 + (c & 31)) * 2; }
__device__ __forceinline__ int v_rd_base(int lane) { return ((lane & 3) << 3) | (((lane >> 2) & 3) << 6) | (((lane >> 4) & 1) << 5) | (((lane >> 5) & 1) << 8); }
constexpr int v_rd_off(int d0, int ks, int half) { return d0 * 512 + ks * 4096 + half * 2048; }
__device__ __forceinline__ int crow(int r, int hi) { return (r & 3) + 8 * (r >> 2) + 4 * hi; }
__device__ __forceinline__ unsigned cvtpk(float lo, float hi) { unsigned r; asm volatile("v_cvt_pk_bf16_f32 %0, %1, %2" : "=v"(r) : "v"(lo), "v"(hi)); return r; }
__device__ __forceinline__ bf16x8 load8(const bf16* p) { return *(const GAS bf16x8*)p; }

__device__ __forceinline__ void mask_tile(f32x16& p0, f32x16& p1, int dq) {
    const float NEG = -__builtin_inff();
#pragma unroll
    for (int r = 0; r < 16; ++r) {
        const int c = (r & 3) + 8 * (r >> 2);
        if (dq - c < 0) p0[r] = NEG;
        if (dq - c - 32 < 0) p1[r] = NEG;
    }
}
__device__ __forceinline__ void partialSM(f32x16& p0, f32x16& p1, float& m_reg, float& mn, float& alpha) {
    float pmax = p0[0]; for (int r = 1; r < 16; ++r) pmax = fmaxf(pmax, p0[r]); for (int r = 0; r < 16; ++r) pmax = fmaxf(pmax, p1[r]);
    { auto rr = __builtin_amdgcn_permlane32_swap(__float_as_uint(pmax), __float_as_uint(pmax), false, false);
      pmax = fmaxf(__uint_as_float(rr[0]), __uint_as_float(rr[1])); }
    if (__builtin_expect(__all((pmax - m_reg) * SCALE <= THR), 1)) { mn = m_reg; alpha = 1.f; }
    else { mn = fmaxf(m_reg, pmax); alpha = __builtin_amdgcn_exp2f((m_reg - mn) * C2); m_reg = mn; }
    const float mnL = -mn * C2;
    for (int r = 0; r < 16; ++r) p0[r] = fmaf(p0[r], C2, mnL); for (int r = 0; r < 16; ++r) p1[r] = fmaf(p1[r], C2, mnL);
    for (int r = 0; r < 16; ++r) p0[r] = __builtin_amdgcn_exp2f(p0[r]);
}
__device__ __forceinline__ void finishSM(f32x16& p0, f32x16& p1, float alpha, float& l_reg, bf16x8& pa0, bf16x8& pa1, bf16x8& pa2, bf16x8& pa3) {
    for (int r = 0; r < 16; ++r) p1[r] = __builtin_amdgcn_exp2f(p1[r]);
    float ps = 0; for (int r = 0; r < 16; ++r) ps += p0[r]; for (int r = 0; r < 16; ++r) ps += p1[r];
    { auto rr = __builtin_amdgcn_permlane32_swap(__float_as_uint(ps), __float_as_uint(ps), false, false);
      ps = __uint_as_float(rr[0]) + __uint_as_float(rr[1]); }
    l_reg = l_reg * alpha + ps;
#define PK4(P, B_, OUT) do { unsigned a0 = cvtpk(P[B_+0], P[B_+1]), a1 = cvtpk(P[B_+2], P[B_+3]);                          \
        unsigned b0 = cvtpk(P[B_+4], P[B_+5]), b1 = cvtpk(P[B_+6], P[B_+7]);                                             \
        auto r0 = __builtin_amdgcn_permlane32_swap(a0, b0, false, false); auto r1 = __builtin_amdgcn_permlane32_swap(a1, b1, false, false); \
        u32x4 w = {r0[0], r1[0], r0[1], r1[1]}; OUT = *reinterpret_cast<bf16x8*>(&w); } while (0)
    PK4(p0, 0, pa0); PK4(p0, 8, pa1); PK4(p1, 0, pa2); PK4(p1, 8, pa3);
#undef PK4
}
template <int KB>
__device__ __forceinline__ void qkt(f32x16& p0, f32x16& p1, const char* K_lds, int r32, int hi, const bf16x8* qr) {
    { const float* nf = (const float*)(K_lds + 2 * SHM_K + NW * 64 * 4) + KB * 64 + 4 * hi;
#pragma unroll
      for (int g = 0; g < 4; ++g) { const f32x4 a = *(const f32x4*)(nf + 8 * g), b = *(const f32x4*)(nf + 32 + 8 * g);
#pragma unroll
          for (int j = 0; j < 4; ++j) { p0[4 * g + j] = a[j]; p1[4 * g + j] = b[j]; } } }
    const char* kb[4];
#pragma unroll
    for (int dd = 0; dd < 4; ++dd) kb[dd] = K_lds + KB * SHM_K + KSWZ(r32, (dd * 16 + hi * 8) * 2);
#pragma unroll
    for (int d0 = 0; d0 < 8; ++d0) { const char* a = kb[d0 & 3] + (d0 >> 2) * 128;
        bf16x8 b0 = *reinterpret_cast<const bf16x8*>(a);
        bf16x8 b1 = *reinterpret_cast<const bf16x8*>(a + 32 * 256);
        p0 = __builtin_amdgcn_mfma_f32_32x32x16_bf16(b0, qr[d0], p0, 0, 0, 0);
        p1 = __builtin_amdgcn_mfma_f32_32x32x16_bf16(b1, qr[d0], p1, 0, 0, 0); }
}
template <int VB>
__device__ __forceinline__ void pv_tile(f32x16* o, int vb0, bf16x8 pa0, bf16x8 pa1, bf16x8 pa2, bf16x8 pa3) {
#define TRRD(dst, off) asm volatile("ds_read_b64_tr_b16 %0, %1 offset:%2" : "=&v"(dst) : "v"(vb0), "i"(off) : "memory")
#define PV_D0(d0) do { s16x4 l0, l1, l2, l3, h0, h1, h2, h3; constexpr int b_ = VB * SHM_V + v_rd_off(d0, 0, 0); \
        TRRD(l0, b_); TRRD(h0, b_ + 2048); TRRD(l1, b_ + 4096); TRRD(h1, b_ + 6144); TRRD(l2, b_ + 8192); TRRD(h2, b_ + 10240); TRRD(l3, b_ + 12288); TRRD(h3, b_ + 14336); \
        asm volatile("s_waitcnt lgkmcnt(0)" ::: "memory"); SBAR();   \
        o[d0] = __builtin_amdgcn_mfma_f32_32x32x16_bf16(pa0, (bf16x8){l0[0], l0[1], l0[2], l0[3], h0[0], h0[1], h0[2], h0[3]}, o[d0], 0, 0, 0);   \
        o[d0] = __builtin_amdgcn_mfma_f32_32x32x16_bf16(pa1, (bf16x8){l1[0], l1[1], l1[2], l1[3], h1[0], h1[1], h1[2], h1[3]}, o[d0], 0, 0, 0);   \
        o[d0] = __builtin_amdgcn_mfma_f32_32x32x16_bf16(pa2, (bf16x8){l2[0], l2[1], l2[2], l2[3], h2[0], h2[1], h2[2], h2[3]}, o[d0], 0, 0, 0);   \
        o[d0] = __builtin_amdgcn_mfma_f32_32x32x16_bf16(pa3, (bf16x8){l3[0], l3[1], l3[2], l3[3], h3[0], h3[1], h3[2], h3[3]}, o[d0], 0, 0, 0); } while (0)
    PV_D0(0); PV_D0(1); PV_D0(2); PV_D0(3);
#undef PV_D0
#undef TRRD
}

struct BlockRef { const bf16* Q; const bf16* K; const bf16* V; bf16* O; const float* FK; int P0; };
#define ROWV(p, k0, rr) ((p) + (size_t)((k0) + (rr)) * VS + sc)
#define VMW() asm volatile("s_waitcnt vmcnt(0)" ::: "memory")
__device__ __forceinline__ void attn_block(const BlockRef& cur, int ja, int nt, bool fin, bf16* Opart, float* ML, char* lds, LAS unsigned char* ldsL, const int wv) {
    const int tid = opq_tid(wv), wid = wv, lane = tid & 63, r32 = lane & 31, hi = lane >> 5;
    const int NT = nt;
    const int qlo = cur.P0 + wid * QBLK, qm = qlo + r32 - 4 * hi;
    char* V_lds = lds; char* K_lds = lds + 2 * SHM_V;
    float* ws = (float*)(lds + OFF_WS) + wid * 64; float* li_l = ws, * al_l = ws + 32;
    float m_reg = -1e30f, l_reg = 0; f32x16 o[4] = {};
    const int vb0 = (int)(uintptr_t)V_lds + v_rd_base(lane);
    const bf16* Kh = cur.K; const bf16* Vh = cur.V; const float* Fh = cur.FK;
    bf16x8 st_v0, st_v1; bf16x8 qr[8];
#define KDMA(bf, k0) do { int t_ = tid; asm volatile("" : "+v"(t_)); _Pragma("unroll") for (int i_ = 0; i_ < 2; ++i_) { const int p_ = i_ * 512 + t_, r_ = p_ >> 4, c_ = (p_ & 15) ^ (r_ & 7); \
        __builtin_amdgcn_global_load_lds((const unsigned*)((const char*)Kh + (size_t)(k0) * KS * 2 + (unsigned)(r_ * KS * 2 + c_ * 16)), (LAS unsigned*)(ldsL + 2 * SHM_V + (bf) * SHM_K + i_ * 8192 + wid * 1024), 16, 0, 0); } \
        if (wid == 0) __builtin_amdgcn_global_load_lds((const unsigned*)(Fh + (k0) + lane), (LAS unsigned*)(ldsL + OFF_NF + (bf) * 256), 4, 0, 0); } while (0)
#define SLOADV(k0) do { int t_ = tid; asm volatile("" : "+v"(t_)); const int sr = t_ >> 4, sc = (t_ & 15) * 8; st_v0 = load8(ROWV(Vh, k0, sr)); st_v1 = load8(ROWV(Vh, k0, 32 + sr)); } while (0)
#define SWRITE_HV(bf) do { int t_ = tid; asm volatile("" : "+v"(t_)); const int sr = t_ >> 4, sc = (t_ & 15) * 8; *(bf16x8*)(V_lds + (bf) * SHM_V + v_st(sr, sc)) = st_v0; *(bf16x8*)(V_lds + (bf) * SHM_V + v_st(32 + sr, sc)) = st_v1; } while (0)
#define RESC(a) do { if (__any((a) < 1.f)) { if (hi == 0) al_l[r32] = (a); asm volatile("s_waitcnt lgkmcnt(0)" ::: "memory");              \
                     for (int d_ = 0; d_ < 4; ++d_) for (int r = 0; r < 16; ++r) o[d_][r] *= al_l[crow(r, hi)]; } } while (0)
#define KBASE(t) ((ja + (t)) * KVBLK)
#define MASKT(P0_, P1_, t) do { const int kb_ = KBASE(t); if (kb_ + KVBLK - 1 > qlo) mask_tile(P0_, P1_, qm - kb_); } while (0)
    f32x16 pA0, pA1, pB0, pB1; float mnA, mnB, alA, alB; bf16x8 pa0, pa1, pa2, pa3;
    KDMA(0, KBASE(0)); SLOADV(KBASE(0));
#pragma unroll
    for (int d0 = 0; d0 < 8; ++d0) qr[d0] = load8(cur.Q + (size_t)(wid * QBLK + r32) * QS + d0 * 16 + hi * 8);
    VMW(); SWRITE_HV(0);
    __syncthreads();
    if (NT > 1) { KDMA(1, KBASE(1)); SLOADV(KBASE(1)); }
    SBAR(); qkt<0>(pA0, pA1, K_lds, r32, hi, qr);
    MASKT(pA0, pA1, 0); partialSM(pA0, pA1, m_reg, mnA, alA);
    if (NT > 1) { VMW(); SWRITE_HV(1); }
    __syncthreads();
#define HALF_STEP(PX0, PX1, mnX, alX, PY0, PY1, alY, t, KB, VB, SB) do {                                                      \
        SBAR(); qkt<KB>(PX0, PX1, K_lds, r32, hi, qr);                                                                        \
        finishSM(PY0, PY1, alY, l_reg, pa0, pa1, pa2, pa3); SBAR();                                                           \
        if ((t) + 1 < NT) { KDMA(SB, KBASE((t) + 1)); SLOADV(KBASE((t) + 1)); SBAR(); }                                       \
        pv_tile<VB>(o, vb0, pa0, pa1, pa2, pa3); MASKT(PX0, PX1, (t)); partialSM(PX0, PX1, m_reg, mnX, alX);                  \
        VMW(); __syncthreads();                                                                                               \
        if ((t) + 1 < NT) { SWRITE_HV(SB); }                                                                                  \
        RESC(alX); __syncthreads(); } while (0)
    for (int t = 1; t + 1 < NT; t += 2) {
        HALF_STEP(pB0, pB1, mnB, alB, pA0, pA1, alA, t, 1, 0, 0);
        HALF_STEP(pA0, pA1, mnA, alA, pB0, pB1, alB, t + 1, 0, 1, 1);
    }
    const bool even = (NT & 1) == 0;
    if (even) { SBAR(); qkt<1>(pB0, pB1, K_lds, r32, hi, qr); SBAR(); }
    finishSM(pA0, pA1, alA, l_reg, pa0, pa1, pa2, pa3); SBAR();
    pv_tile<0>(o, vb0, pa0, pa1, pa2, pa3);
    if (even) { MASKT(pB0, pB1, NT - 1); partialSM(pB0, pB1, m_reg, mnB, alB); __syncthreads(); RESC(alB);
        finishSM(pB0, pB1, alB, l_reg, pa0, pa1, pa2, pa3); SBAR(); pv_tile<1>(o, vb0, pa0, pa1, pa2, pa3); }
    SBAR();
    if (hi == 0) li_l[r32] = l_reg; asm volatile("s_waitcnt lgkmcnt(0)" ::: "memory");
    float rli[16];
#pragma unroll
    for (int r = 0; r < 16; ++r) rli[r] = __builtin_amdgcn_rcpf(li_l[crow(r, hi)]);
    const int ostr = fin ? OS : D;
    bf16* Ow = (fin ? cur.O : Opart) + (size_t)(wid * QBLK) * ostr;
#pragma unroll
    for (int r = 0; r < 16; ++r) { const int orow = crow(r, hi);
#pragma unroll
        for (int d0 = 0; d0 < 4; ++d0) { const float v = o[d0][r] * rli[r];
            const float vn = xor_f<1>(v);
            if ((r32 & 1) == 0) *(GAS unsigned*)(Ow + (size_t)orow * ostr + d0 * 32 + r32) = cvtpk(v, vn); } }
    if (!fin && hi == 0) { f32x2 mlv; mlv.x = m_reg; mlv.y = l_reg; *(GAS f32x2*)(ML + (size_t)(wid * QBLK + r32) * 2) = mlv; }
    __syncthreads();
#undef KDMA
#undef SLOADV
#undef SWRITE_HV
#undef RESC
#undef KBASE
#undef MASKT
#undef HALF_STEP
}
#undef ROWV
#undef VMW
}
struct Frame {
    LAS unsigned char* lds; volatile LAS unsigned* MISC; gu32* ctl;
    int tid, lane, wave, vcu, G;
    unsigned char* ws;
};
#define CAS __attribute__((address_space(4)))
__device__ __forceinline__ const float* karg(int k) { const CAS char* p = (const CAS char*)__builtin_amdgcn_kernarg_segment_ptr(); asm volatile("" : "+s"(p)); return *(const float* const CAS*)(p + 8 * k); }

__device__ __forceinline__ void tr_item(const float* W, size_t ldw, bf16* WT, size_t ldk, LAS float* scr, int lane) {
    const int kr = lane >> 3, c4 = (lane & 7) * 4;
    f32x4 v[8];
#pragma unroll
    for (int i = 0; i < 8; ++i) v[i] = __builtin_nontemporal_load((const GAS f32x4*)(W + (size_t)(8 * i + kr) * ldw + c4));
#pragma unroll
    for (int i = 0; i < 8; ++i) { LAS float* s = scr + (8 * i + kr) * 33 + c4; s[0] = v[i].x; s[1] = v[i].y; s[2] = v[i].z; s[3] = v[i].w; }
    LDS_WAIT();
    const int c = lane & 7;
#pragma unroll
    for (int j = 0; j < 4; ++j) { const int n = (lane >> 3) + 8 * j; const LAS float* s = scr + (8 * c) * 33 + n;
        u32x4 o; o.x = cvt_pk_bf16(s[0 * 33], s[1 * 33]); o.y = cvt_pk_bf16(s[2 * 33], s[3 * 33]); o.z = cvt_pk_bf16(s[4 * 33], s[5 * 33]); o.w = cvt_pk_bf16(s[6 * 33], s[7 * 33]);
        *(GAS u32x4*)(WT + (size_t)n * ldk + 8 * c) = o; }
    LDS_WAIT();
}
__device__ __forceinline__ void tr_item8(const float* W, size_t ldw, unsigned char* WT, size_t ldk, LAS float* scr, int lane) {
    const int kr = lane >> 3, c4 = (lane & 7) * 4;
    f32x4 v[2][8];
#pragma unroll
    for (int hh = 0; hh < 2; ++hh)
#pragma unroll
        for (int i = 0; i < 8; ++i) v[hh][i] = __builtin_nontemporal_load((const GAS f32x4*)(W + (size_t)(8 * i + kr) * ldw + 32 * hh + c4));
#pragma unroll
    for (int hh = 0; hh < 2; ++hh) {
#pragma unroll
        for (int i = 0; i < 8; ++i) { LAS float* s = scr + (8 * i + kr) * 33 + c4; s[0] = v[hh][i].x; s[1] = v[hh][i].y; s[2] = v[hh][i].z; s[3] = v[hh][i].w; }
        LDS_WAIT();
        const int c = lane & 3;
#pragma unroll
        for (int j = 0; j < 2; ++j) { const int n = (lane >> 2) + 16 * j; const LAS float* s = scr + (16 * c) * 33 + n;
            u32x4 o;
            o.x = cvt_pk4_fp8(s[0 * 33] * W8_SCALE, s[1 * 33] * W8_SCALE, s[2 * 33] * W8_SCALE, s[3 * 33] * W8_SCALE); o.y = cvt_pk4_fp8(s[4 * 33] * W8_SCALE, s[5 * 33] * W8_SCALE, s[6 * 33] * W8_SCALE, s[7 * 33] * W8_SCALE);
            o.z = cvt_pk4_fp8(s[8 * 33] * W8_SCALE, s[9 * 33] * W8_SCALE, s[10 * 33] * W8_SCALE, s[11 * 33] * W8_SCALE); o.w = cvt_pk4_fp8(s[12 * 33] * W8_SCALE, s[13 * 33] * W8_SCALE, s[14 * 33] * W8_SCALE, s[15 * 33] * W8_SCALE);
            *(GAS u32x4*)(WT + (size_t)(32 * hh + n) * ldk + 16 * c) = o; }
        LDS_WAIT();
    }
}
constexpr int I_IN = (DM / 64) * (NZ / 32), I_OUT = (DM / 64) * (DM / 32), I_GU = (DM / 64) * (DEX / 32), I_D = (DEX / 64) * (DM / 32);
constexpr int GV_FIRST = 43;
constexpr int BGI_SMALL = (NLAYER * 4 * 8) / 8, BGI_IN = I_IN / 16, BGI_GV0 = (128 - GV_FIRST) * 4, BGI_GV1 = 128 * 4, BGI_OUT = I_OUT / 8, BGI_GU = NEXP * 2 * I_GU / 16, BGI_D = NEXP * I_D / 16;
constexpr int BG_C0 = BGI_SMALL + BGI_IN;
constexpr int BG_C1 = BG_C0 + BGI_GV0 + BGI_OUT;
constexpr int BG_C2 = BG_C1 + BGI_GU;
constexpr int BG_C3 = BG_C2 + BGI_D;
constexpr int BG_C3B = BG_C3 + BGI_GV1;
constexpr int BG_C4 = BG_C3B + BGI_IN;
constexpr int BG_C5 = BG_C4 + BGI_OUT;
constexpr int BG_C6 = BG_C5 + BGI_GU;
constexpr int BG_C7 = BG_C6 + BGI_D;
__device__ __forceinline__ float mod_at(const unsigned char* ws, const float* b_ada, int l, int j) {
    const float* p = (const float*)(ws + WS_MODP) + (size_t)l * 6 * DM + j;
    return *(const GAS float*)(b_ada + (size_t)l * 6 * DM + j) + ((*(const GAS float*)p + *(const GAS float*)(p + 2 * 6 * DM)) + (*(const GAS float*)(p + 4 * 6 * DM) + *(const GAS float*)(p + 6 * 6 * DM)));
}
__device__ __forceinline__ void gemv_item(const Frame& F, unsigned char* ws, int w) {
    LAS float* sc = (LAS float*)F.lds; LAS f32x4* red = (LAS f32x4*)(F.lds + 8192);
    const int kq = w & 3, l = w >> 9, cb = (w >> 2) & 127, c4 = F.tid % 24, kg = F.tid / 24;
    if (F.tid < 512) sc[F.tid] = silu_f(*(const GAS float*)(karg(1) + kq * 512 + F.tid));
    __syncthreads();
    f32x4 acc = (f32x4){0.f, 0.f, 0.f, 0.f};
    if (kg < 21) {
        const float* wp = karg(2) + (size_t)l * DM * 6 * DM + (size_t)(kq * 512) * 6 * DM + cb * 96 + c4 * 4;
#pragma unroll 8
        for (int k = kg; k < 512; k += 21) { const f32x4 wv = __builtin_nontemporal_load((const GAS f32x4*)(wp + (size_t)k * 6 * DM)); acc += wv * sc[k]; }
        red[kg * 24 + c4] = acc;
    }
    __syncthreads();
    if (F.tid < 24) { f32x4 s = red[F.tid];
        for (int g = 1; g < 21; ++g) s += red[g * 24 + F.tid];
        *(GAS f32x4*)((float*)(ws + WS_MODP) + (size_t)kq * 2 * 6 * DM + (size_t)l * 6 * DM + cb * 96 + F.tid * 4) = s; }
    __syncthreads();
}
__device__ __forceinline__ void conv_wave_item(const Frame& F, unsigned char* ws, int r, int l, LAS float* scr) {
    if (r < I_IN) { const int kb = r / (NZ / 32), nb = r % (NZ / 32);
        tr_item8(karg(6) + (size_t)l * DM * NIN + (size_t)(64 * kb) * NIN + 32 * nb, NIN, ws + WS_WIN + (size_t)l * NZ * DM + (size_t)(32 * nb) * DM + 64 * kb, DM, scr, F.lane); return; }
    r -= I_IN;
    if (r < I_OUT) { const int kb = r / (DM / 32), nb = r % (DM / 32);
        tr_item(karg(15) + (size_t)l * DM * DM + (size_t)(64 * kb) * DM + 32 * nb, DM, (bf16*)(ws + WS_WOUT) + (size_t)l * DM * DM + (size_t)(32 * nb) * DM + 64 * kb, DM, scr, F.lane); return; }
    r -= I_OUT;
    if (r < NEXP * 2 * I_GU) { const int e = r / (2 * I_GU); r -= e * 2 * I_GU; const int up = r >= I_GU; if (up) r -= I_GU; const int kb = r / (DEX / 32), nb = r % (DEX / 32), n0 = 32 * nb;
        const float* src = (up ? karg(19) : karg(18)) + ((size_t)l * NEXP + e) * DM * DEX + (size_t)(64 * kb) * DEX + n0;
        const int drow = (n0 >> 7) * 256 + (up ? 128 : 0) + (n0 & 127);
        tr_item8(src, DEX, ws + WS_WGU + ((size_t)l * NEXP + e) * DM * DM + (size_t)drow * DM + 64 * kb, DM, scr, F.lane); return; }
    r -= NEXP * 2 * I_GU;
    { const int e = r / I_D; r -= e * I_D; const int kb = r / (DM / 32), nb = r % (DM / 32);
      tr_item8(karg(20) + ((size_t)l * NEXP + e) * DEX * DM + (size_t)(64 * kb) * DM + 32 * nb, DM, ws + WS_WD + ((size_t)l * NEXP + e) * DM * DEX + (size_t)(32 * nb) * DEX + 64 * kb, DEX, scr, F.lane); }
}
__device__ __forceinline__ void bg_item(const Frame& F, unsigned char* ws, int t) {
    LAS float* scr = (LAS float*)(F.lds + 16384 + F.wave * 9216);
    if (t < BGI_SMALL) { const int r = t * 8 + F.wave, mat = r >> 3, q = r & 7, kb = q >> 2, nb = q & 3;
        tr_item(karg(10) + (size_t)mat * 128 * 128 + (size_t)(64 * kb) * 128 + 32 * nb, 128, (bf16*)(ws + WS_BWT) + (size_t)mat * 128 * 128 + (size_t)(32 * nb) * 128 + 64 * kb, 128, scr, F.lane); return; }
    t -= BGI_SMALL;
    if (t < BGI_IN) { conv_wave_item(F, ws, (t * 8 + F.wave) * 2, 0, scr); return; }
    t -= BGI_IN;
    if (t < BGI_GV0) { gemv_item(F, ws, GV_FIRST * 4 + t); return; }
    t -= BGI_GV0;
    if (t < BGI_OUT) { conv_wave_item(F, ws, I_IN + t * 8 + F.wave, 0, scr); return; }
    t -= BGI_OUT;
    if (t < BGI_GU + BGI_D) { conv_wave_item(F, ws, I_IN + I_OUT + (t * 8 + F.wave) * 2, 0, scr); return; }
    t -= BGI_GU + BGI_D;
    if (t < BGI_GV1) { gemv_item(F, ws, 512 + t); return; }
    t -= BGI_GV1;
    if (t < BGI_IN) { conv_wave_item(F, ws, (t * 8 + F.wave) * 2, 1, scr); return; }
    t -= BGI_IN;
    if (t < BGI_OUT) { conv_wave_item(F, ws, I_IN + t * 8 + F.wave, 1, scr); return; }
    t -= BGI_OUT;
    conv_wave_item(F, ws, I_IN + I_OUT + (t * 8 + F.wave) * 2, 1, scr);
}
__device__ __forceinline__ void bg_fill(const Frame& F0, int seam, int need, int expect, bool self) {
    unsigned char* const ws = opq(F0.ws); Frame F = F0; F.tid = opq_tid(F0.wave); F.lane = F.tid & 63; F.lds = opq(F0.lds);
    LAS unsigned* slot = (LAS unsigned*)(F.lds + AUX_OFF + 24576);
    gu32* const ctl_ = opq(F0.ctl); gu32* ticket = ctl_ + CW_BGT; gu32* arr = ctl_ + CW_ARR + 64 * seam;
    unsigned tn = 0xffffffffu; bool pre = false;
    if (F.tid == 0 && slot[1] == 0u) { if (self) (void)__hip_atomic_fetch_add(arr, 1u, RLX_AGENT); const unsigned cur = __hip_atomic_load(ticket, RLX_AGENT);
        if (cur >= (unsigned)BG_C7) slot[1] = 1u;
        else if (cur < (unsigned)need || __hip_atomic_load(arr, RLX_AGENT) < (unsigned)expect) tn = __hip_atomic_fetch_add(ticket, 1u, RLX_AGENT); }
    for (;;) {
        if (F.tid == 0) slot[0] = tn;
        __syncthreads();
        const unsigned t = __builtin_amdgcn_readfirstlane(slot[0]);
        __syncthreads();
        if (t >= (unsigned)BG_C7) { if (F.tid == 0 && t != 0xffffffffu) slot[1] = 1u; break; }
        if (F.tid == 0) { tn = 0xffffffffu; pre = (t + 2u < (unsigned)need);
            if (pre) tn = __hip_atomic_fetch_add(ticket, 1u, RLX_AGENT); }
        bg_item(F, ws, (int)t);
        if (F.tid == 0 && !pre) { if (t + 1u < (unsigned)need || __hip_atomic_load(arr, RLX_AGENT) < (unsigned)expect) tn = __hip_atomic_fetch_add(ticket, 1u, RLX_AGENT); }
    }
}
__device__ __forceinline__ void p0_prologue(const Frame& F0) {
    unsigned char* const ws = opq(F0.ws); Frame F = F0; F.tid = opq_tid(F0.wave); F.lane = F.tid & 63; F.lds = opq(F0.lds);
    for (int w = F.vcu; w < GV_FIRST * 4; w += F.G) gemv_item(F, ws, w);
    const float* const a_ws_ = karg(7);
    for (int i = (F.vcu * NTHR + F.tid) * 2; i < NLAYER * 4 * 128 * 128; i += F.G * NTHR * 2) {
        const int t = (i >> 7) & 127, s = i & 127;
        const f32x2 w = *(const GAS f32x2*)(a_ws_ + i);
        const bool keep = (s >> 6) <= (t >> 6);
        *(GAS unsigned*)((bf16*)(ws + WS_WM) + i) = keep ? cvt_pk_bf16(w.x, w.y) : 0u;
    }
}

template <int MODE>
__device__ __forceinline__ void phase_norm1(const Frame& F0, int l, const float* xin, float* xout, int lprev) {
    unsigned char* const ws = opq(F0.ws); Frame F = F0; F.tid = opq_tid(F0.wave); F.lane = F.tid & 63; F.lds = opq(F0.lds);
    LAS float* wfT = (LAS float*)F.lds;
    LAS float* gaL = (LAS float*)(F.lds + 65536);
    LAS float* gbL = (LAS float*)(F.lds + 73728);
    LAS float* g2L = (LAS float*)(F.lds + 81920);
    LAS float* lf = (LAS float*)(F.lds + 90112);
    LAS int* hb = (LAS int*)(F.lds + 91136);
    const float* const b_ada_ = karg(3); const float* const c_bf_ = karg(14);
    if (MODE != 2) {
        const float* const w_in_ = karg(6); const float* const g_mix_ = karg(4);
        for (int i = F.tid; i < DM * 2; i += NTHR) { const int d = i >> 1, half = i & 1;
            const f32x4 w = *(const GAS f32x4*)(w_in_ + (size_t)l * DM * NIN + (size_t)d * NIN + NZ + half * 4);
            wfT[(half * 4 + 0) * DM + d] = w.x; wfT[(half * 4 + 1) * DM + d] = w.y; wfT[(half * 4 + 2) * DM + d] = w.z; wfT[(half * 4 + 3) * DM + d] = w.w; }
        for (int d = F.tid; d < DM; d += NTHR) { gaL[d] = *(const GAS float*)(g_mix_ + (size_t)l * DM + d) * (1.f + mod_at(ws, b_ada_, l, DM + d)); gbL[d] = mod_at(ws, b_ada_, l, d); }
    }
    if (MODE != 0) {
        for (int d = F.tid; d < DM; d += NTHR) g2L[d] = mod_at(ws, b_ada_, lprev, 5 * DM + d);
        if (F.tid == 0) { int a = 0; for (int e = 0; e < NEXP; ++e) { hb[e] = a; a += ((int)__hip_atomic_load(F.ctl + CW_CNT + 64 * lprev + e, RLX_AGENT) + 255) & ~255; } }
    }
    __syncthreads();
    const bf16* YB = (const bf16*)(ws + WS_YB);
    f32x4 vA[8], vB[8]; u32x2 yA0[8], yA1[8], yB0[8], yB1[8];
#define N1_LOAD(V, Y0, Y1, rr) do { const int t_ = c * 32 + F.wave * 4 + (rr);                                                                 \
        _Pragma("unroll") for (int j = 0; j < 8; ++j) V[j] = *(const GAS f32x4*)(xin + (size_t)t_ * DM + 256 * j + 4 * F.lane);                   \
        if (MODE != 0) { const int r0_ = __builtin_amdgcn_readlane(rowA, (rr)), r1_ = __builtin_amdgcn_readlane(rowB, (rr));                      \
            _Pragma("unroll") for (int j = 0; j < 8; ++j) { const int d = 256 * j + 4 * F.lane;                                                    \
                Y0[j] = *(const GAS u32x2*)(YB + (size_t)r0_ * DM + d); Y1[j] = *(const GAS u32x2*)(YB + (size_t)r1_ * DM + d); } } } while (0)
#define N1_PROC(V, Y0, Y1, rr) do { const int rl = F.wave * 4 + (rr), t = c * 32 + rl;                                                          \
        if (MODE != 0) { const float w0 = __builtin_bit_cast(float, __builtin_amdgcn_readlane(__builtin_bit_cast(int, gwA), (rr))), w1 = __builtin_bit_cast(float, __builtin_amdgcn_readlane(__builtin_bit_cast(int, gwB), (rr))); \
            _Pragma("unroll") for (int j = 0; j < 8; ++j) { const int d = 256 * j + 4 * F.lane;                                                    \
                const f32x4 g2 = *(const LAS f32x4*)(g2L + d); const u32x2 y0 = Y0[j], y1 = Y1[j];                                                 \
                f32x4 y; y.x = w0 * bf_lo(y0.x) + w1 * bf_lo(y1.x); y.y = w0 * bf_hi(y0.x) + w1 * bf_hi(y1.x); y.z = w0 * bf_lo(y0.y) + w1 * bf_lo(y1.y); y.w = w0 * bf_hi(y0.y) + w1 * bf_hi(y1.y); \
                V[j] = V[j] + g2 * y;                                                                                                               \
                *(GAS f32x4*)(xout + (size_t)t * DM + d) = V[j]; } }                                                                               \
        if (MODE != 2) {                                                                                                                           \
            float ss = 0.f;                                                                                                                        \
            _Pragma("unroll") for (int j = 0; j < 8; ++j) ss += (V[j].x * V[j].x + V[j].y * V[j].y) + (V[j].z * V[j].z + V[j].w * V[j].w);         \
            const float rs = rsqrtf(wave_sum(ss) * (1.f / DM) + EPSN);                                                                             \
            float fz[8] = {0.f, 0.f, 0.f, 0.f, 0.f, 0.f, 0.f, 0.f};                                                                                \
            unsigned char* hrow = ws + WS_H + (size_t)t * DM;                                   \
            _Pragma("unroll") for (int j = 0; j < 8; ++j) { const int d = 256 * j + 4 * F.lane;                                                    \
                const f32x4 h = V[j] * rs * *(const LAS f32x4*)(gaL + d) + *(const LAS f32x4*)(gbL + d);                                           \
                *(GAS unsigned*)(hrow + d) = cvt_pk4_fp8(h.x * H8_SCALE, h.y * H8_SCALE, h.z * H8_SCALE, h.w * H8_SCALE);                          \
                _Pragma("unroll") for (int q = 0; q < 8; ++q) { const f32x4 w = *(const LAS f32x4*)(wfT + q * DM + d); fz[q] += (h.x * w.x + h.y * w.y) + (h.z * w.z + h.w * w.w); } } \
            _Pragma("unroll") for (int q = 0; q < 8; ++q) fz[q] = wave_sum(fz[q]);                                                                 \
            if (F.lane < 8) { float z = fz[0];                                                                                                     \
                _Pragma("unroll") for (int q = 1; q < 8; ++q) z = (F.lane == q) ? fz[q] : z;                                                       \
                z += *(const GAS float*)(c_bf_ + l * 8 + F.lane);                                                                                  \
                lf[rl * 8 + F.lane] = fminf(z, 0.f) - 0.6931471805599453f * __builtin_amdgcn_logf(1.f + __builtin_amdgcn_exp2f(-LOG2E * fabsf(z))); } } } while (0)
    for (int c = F.vcu; c < SEQ / 32; c += F.G) {
        int rowA = 0, rowB = 0; float gwA = 0.f, gwB = 0.f;
        if (MODE != 0) { const int t_ = c * 32 + F.wave * 4 + (F.lane & 3);
            const int* te = (const int*)(ws + WS_TOKE) + 2 * t_; const int* tp = (const int*)(ws + WS_TOKP) + 2 * t_; const float* tw = (const float*)(ws + WS_TOKW) + 2 * t_;
            rowA = hb[*(const GAS int*)te] + *(const GAS int*)tp; rowB = hb[*(const GAS int*)(te + 1)] + *(const GAS int*)(tp + 1); gwA = *(const GAS float*)tw; gwB = *(const GAS float*)(tw + 1); }
        N1_LOAD(vA, yA0, yA1, 0); N1_LOAD(vB, yB0, yB1, 1);
        N1_PROC(vA, yA0, yA1, 0); N1_LOAD(vA, yA0, yA1, 2);
        N1_PROC(vB, yB0, yB1, 1); N1_LOAD(vB, yB0, yB1, 3);
        N1_PROC(vA, yA0, yA1, 2); N1_PROC(vB, yB0, yB1, 3);
        if (MODE != 2) {
            __syncthreads();
            if (F.tid < 8) { float a = 0.f; float* floc = (float*)(ws + WS_FLOC);
                for (int r = 0; r < 32; ++r) { a += lf[r * 8 + F.tid]; *(GAS float*)(floc + (size_t)(c * 32 + r) * 8 + F.tid) = a; }
                *(GAS float*)((float*)(ws + WS_TOT) + c * 8 + F.tid) = a; }
            __syncthreads();
        }
    }
#undef N1_LOAD
#undef N1_PROC
}

__device__ __forceinline__ void fkl_fixup(const Frame& F0) {
    unsigned char* const ws = opq(F0.ws); Frame F = F0; F.tid = opq_tid(F0.wave); F.lane = F.tid & 63; F.lds = opq(F0.lds);
    LAS float* preL = (LAS float*)(F.lds + AUX_OFF + 8192);
    const float* tot = (const float*)(ws + WS_TOT);
    for (int c = F.vcu; c < SEQ / 32; c += F.G) {
        { const int h = F.wave; double s = 0.0;
#pragma unroll
            for (int q = 0; q < 4; ++q) { const int cc = 4 * F.lane + q; if (cc < c) s += (double)*(const GAS float*)(tot + cc * 8 + h); }
            float hi_ = (float)s, lo_ = (float)(s - (double)hi_);
            hi_ = wave_sum(hi_); lo_ = wave_sum(lo_);
            if (F.lane == 0) preL[h] = hi_ + lo_; }
        __syncthreads();
        if (F.tid < 256) { const int r = F.tid >> 3, h = F.tid & 7, t = c * 32 + r;
            *(GAS float*)((float*)(ws + WS_FKL) + (size_t)h * SEQ + t) = (preL[h] + *(const GAS float*)((const float*)(ws + WS_FLOC) + (size_t)t * 8 + h)) * -11.313708498984761f; }
        __syncthreads();
    }
}

__device__ __forceinline__ void phase_small_item(const Frame& F0, int l, int item) {
    unsigned char* const ws = opq(F0.ws); Frame F = F0; F.tid = opq_tid(F0.wave); F.lane = F.tid & 63; F.lds = opq(F0.lds);
    const int fr = F.lane & 15, fq = F.lane >> 4, w = F.wave;
    const bf16* Z = (const bf16*)(ws + WS_Z); bf16* YC = (bf16*)(ws + WS_YCAT);
    f32x4 acc[8];
#pragma unroll
    for (int m = 0; m < 8; ++m) acc[m] = (f32x4){0.f, 0.f, 0.f, 0.f};
    const float* a_bs_ = opq(karg(8)); const float* b_scale_ = opq(karg(11));
    if (item < 256) {
        const int blk = item >> 2, h = item & 3;
        const bf16* VN = (const bf16*)(ws + WS_VN) + (size_t)(blk * 128) * 512 + h * 128 + 16 * w + fr;
        const bf16* WM = (const bf16*)(ws + WS_WM) + ((size_t)(l * 4 + h) * 128) * 128;
        bf16x8 yb[4];
#pragma unroll
        for (int ks = 0; ks < 4; ++ks)
#pragma unroll
            for (int j = 0; j < 8; ++j) yb[ks][j] = (short)*(const GAS bf16*)(VN + (size_t)(ks * 32 + 8 * fq + j) * 512);
#pragma unroll
        for (int m = 0; m < 8; ++m)
#pragma unroll
            for (int ks = 0; ks < 4; ++ks) { const bf16x8 xa = *(const GAS bf16x8*)(WM + (size_t)(16 * m + fr) * 128 + ks * 32 + 8 * fq);
                acc[m] = __builtin_amdgcn_mfma_f32_16x16x32_bf16(yb[ks], xa, acc[m], 0, 0, 0); }
#pragma unroll
        for (int m = 0; m < 8; ++m) { const int tl = 16 * m + fr, t = blk * 128 + tl, col = h * 128 + 16 * w + 4 * fq;
            const float bsv = *(const GAS float*)(a_bs_ + l * 512 + h * 128 + tl);
            const u32x2 u = *(const GAS u32x2*)(Z + (size_t)t * NZ + col);
            u32x2 o; o.x = cvt_pk_bf16(bf_lo(u.x) * (acc[m][0] + bsv), bf_hi(u.x) * (acc[m][1] + bsv)); o.y = cvt_pk_bf16(bf_lo(u.y) * (acc[m][2] + bsv), bf_hi(u.y) * (acc[m][3] + bsv));
            *(GAS u32x2*)(YC + (size_t)t * DM + col) = o; }
    } else {
        const int rb = (item - 256) >> 2, g = (item - 256) & 3;
        const int wnd = 2 << g, r0 = rb * 128;
        LAS bf16* pt = (LAS bf16*)(F.lds + 86016);
        LAS bf16* dt = (LAS bf16*)F.lds;
        __syncthreads();
        for (int i = F.tid; i < 144 * 16; i += NTHR) { const int rr = i >> 4, cc = (i & 15) * 8, tg = r0 - 16 + rr;
            u32x4 v = (u32x4){0u, 0u, 0u, 0u}; if (tg >= 0) v = *(const GAS u32x4*)(Z + (size_t)tg * NZ + 1024 + g * 128 + cc);
            *(LAS u32x4*)(pt + rr * 128 + cc) = v; }
        __syncthreads();
        { const int c = F.tid & 127, rg = F.tid >> 7;
            float sum = 0.f;
            for (int j = 1; j < wnd; ++j) sum += bf_lo((unsigned)pt[(16 + 32 * rg - j) * 128 + c]);
            for (int i = 0; i < 32; ++i) { const int tl = 32 * rg + i, tg = r0 + tl; const float pv = bf_lo((unsigned)pt[(16 + tl) * 128 + c]);
                sum += pv;
                const float cnt = (float)((tg + 1 < wnd) ? (tg + 1) : wnd);
                const float dv = sum / cnt - pv;
                dt[tl * 136 + c] = (bf16)(cvt_pk_bf16(dv, 0.f) & 0xffffu);
                sum -= bf_lo((unsigned)pt[(16 + tl - (wnd - 1)) * 128 + c]); } }
        __syncthreads();
        const bf16* BWT = (const bf16*)(ws + WS_BWT) + ((size_t)(l * 4 + g) * 128) * 128;
        bf16x8 yb[4];
#pragma unroll
        for (int ks = 0; ks < 4; ++ks) yb[ks] = *(const GAS bf16x8*)(BWT + (size_t)(16 * w + fr) * 128 + ks * 32 + 8 * fq);
#pragma unroll
        for (int m = 0; m < 8; ++m)
#pragma unroll
            for (int ks = 0; ks < 4; ++ks) { const bf16x8 xa = *(const LAS bf16x8*)(dt + (16 * m + fr) * 136 + ks * 32 + 8 * fq);
                acc[m] = __builtin_amdgcn_mfma_f32_16x16x32_bf16(yb[ks], xa, acc[m], 0, 0, 0); }
        __syncthreads();
        const f32x4 bsc = *(const GAS f32x4*)(b_scale_ + l * 512 + g * 128 + 16 * w + 4 * fq);
#pragma unroll
        for (int m = 0; m < 8; ++m) { const int t = rb * 128 + 16 * m + fr, col = 512 + g * 128 + 16 * w + 4 * fq;
            u32x2 o; o.x = cvt_pk_bf16(acc[m][0] * bsc.x, acc[m][1] * bsc.y); o.y = cvt_pk_bf16(acc[m][2] * bsc.z, acc[m][3] * bsc.w);
            *(GAS u32x2*)(YC + (size_t)t * DM + col) = o; }
    }
}

__device__ __forceinline__ void phase_norm2_route(const Frame& F0, int l) {
    unsigned char* const ws = opq(F0.ws); Frame F = F0; F.tid = opq_tid(F0.wave); F.lane = F.tid & 63; F.lds = opq(F0.lds);
    LAS float* wrT = (LAS float*)F.lds;
    LAS float* gaL = (LAS float*)(F.lds + AUX_OFF);
    LAS float* gbL = (LAS float*)(F.lds + AUX_OFF + 8192);
    LAS int* lcnt = (LAS int*)(F.lds + AUX_OFF + 16384);
    const float* const w_router_ = karg(16); const float* const g_ffn_ = karg(5); const float* const b_ada_ = karg(3); const float* const b_router_ = karg(17);
    for (int i = F.tid; i < DM * 4; i += NTHR) { const int d = i >> 2, q = i & 3;
        const f32x4 w = *(const GAS f32x4*)(w_router_ + (size_t)d * 16 + q * 4);
        wrT[(q * 4 + 0) * DM + d] = w.x; wrT[(q * 4 + 1) * DM + d] = w.y; wrT[(q * 4 + 2) * DM + d] = w.z; wrT[(q * 4 + 3) * DM + d] = w.w; }
    for (int d = F.tid; d < DM; d += NTHR) { gaL[d] = *(const GAS float*)(g_ffn_ + (size_t)l * DM + d) * (1.f + mod_at(ws, b_ada_, l, 4 * DM + d)); gbL[d] = mod_at(ws, b_ada_, l, 3 * DM + d); }
    const float* X1 = (const float*)(ws + WS_X1);
    float brt[16];
#pragma unroll
    for (int e = 0; e < 16; ++e) brt[e] = *(const GAS float*)(b_router_ + e);
    for (int c = F.vcu; c < SEQ / 32; c += F.G) {
        if (F.tid < 32) lcnt[F.tid] = 0;
        __syncthreads();
        int my_e0 = 0, my_e1 = 0, my_r0 = 0, my_r1 = 0; float my_w0 = 0.f, my_w1 = 0.f;
        f32x4 vA[8], vB[8];
#define N2_LOAD(V, rr) do { const int t_ = c * 32 + F.wave * 4 + (rr); _Pragma("unroll") for (int j = 0; j < 8; ++j) V[j] = *(const GAS f32x4*)(X1 + (size_t)t_ * DM + 256 * j + 4 * F.lane); } while (0)
#define N2_PROC(V, rr) do { const int t = c * 32 + F.wave * 4 + (rr);                                                                           \
            float ss = 0.f;                                                                                                                        \
            _Pragma("unroll") for (int j = 0; j < 8; ++j) ss += (V[j].x * V[j].x + V[j].y * V[j].y) + (V[j].z * V[j].z + V[j].w * V[j].w);         \
            const float rs = rsqrtf(wave_sum(ss) * (1.f / DM) + EPSN);                                                                             \
            float lg[16];                                                                                                                          \
            _Pragma("unroll") for (int e = 0; e < 16; ++e) lg[e] = 0.f;                                                                            \
            unsigned char* hrow = ws + WS_H + (size_t)t * DM;                          \
            _Pragma("unroll") for (int j = 0; j < 8; ++j) { const int d = 256 * j + 4 * F.lane;                                                    \
                const f32x4 h = V[j] * rs * *(const LAS f32x4*)(gaL + d) + *(const LAS f32x4*)(gbL + d);                                           \
                *(GAS unsigned*)(hrow + d) = cvt_pk4_fp8(h.x * H8_SCALE, h.y * H8_SCALE, h.z * H8_SCALE, h.w * H8_SCALE);                          \
                _Pragma("unroll") for (int e = 0; e < 16; ++e) { const f32x4 w = *(const LAS f32x4*)(wrT + e * DM + d); lg[e] += (h.x * w.x + h.y * w.y) + (h.z * w.z + h.w * w.w); } } \
            _Pragma("unroll") for (int e = 0; e < 16; ++e) lg[e] = wave_sum(lg[e]);                                                                \
            float sc[16], sel[16];                                                                                                                 \
            _Pragma("unroll") for (int e = 0; e < 16; ++e) { sc[e] = __builtin_amdgcn_rcpf(1.f + __builtin_amdgcn_exp2f(-LOG2E * lg[e])); sel[e] = sc[e] + brt[e]; }                      \
            int bg = 0; float bgs = -INFINITY;                                                                                                     \
            _Pragma("unroll") for (int g = 0; g < 4; ++g) { float a = -INFINITY, b = -INFINITY;                                                    \
                _Pragma("unroll") for (int i = 0; i < 4; ++i) { const float x = sel[g * 4 + i]; if (x > a) { b = a; a = x; } else if (x > b) b = x; } \
                if (a + b > bgs) { bgs = a + b; bg = g; } }                                                                                        \
            int e0 = 0, e1 = 0; float a = -INFINITY, b = -INFINITY, s0 = 0.f, s1 = 0.f;                                                            \
            _Pragma("unroll") for (int g = 0; g < 4; ++g)                                                                                          \
                _Pragma("unroll") for (int i = 0; i < 4; ++i) { const int e = g * 4 + i; const float x = sel[e];                                   \
                    if (g == bg) { if (x > a) { b = a; e1 = e0; s1 = s0; a = x; e0 = e; s0 = sc[e]; } else if (x > b) { b = x; e1 = e; s1 = sc[e]; } } } \
            const float inv = 1.f / (s0 + s1);                                                                                                     \
            if (F.lane == (rr)) { my_e0 = e0; my_e1 = e1; my_w0 = s0 * inv; my_w1 = s1 * inv; } } while (0)
        N2_LOAD(vA, 0);
#pragma unroll 1
        for (int rp = 0; rp < 2; ++rp) {
            N2_LOAD(vB, 2 * rp + 1);
            N2_PROC(vA, 2 * rp);
            if (rp == 0) N2_LOAD(vA, 2);
            N2_PROC(vB, 2 * rp + 1);
        }
        if (F.lane < 4) { my_r0 = __hip_atomic_fetch_add(&lcnt[my_e0], 1, __ATOMIC_RELAXED, __HIP_MEMORY_SCOPE_WORKGROUP); my_r1 = __hip_atomic_fetch_add(&lcnt[my_e1], 1, __ATOMIC_RELAXED, __HIP_MEMORY_SCOPE_WORKGROUP); }
        __syncthreads();
        if (F.tid < 16) lcnt[16 + F.tid] = (int)__hip_atomic_fetch_add(F.ctl + CW_CNT + 64 * l + F.tid, (unsigned)lcnt[F.tid], RLX_AGENT);
        __syncthreads();
        if (F.lane < 4) { const int t = c * 32 + F.wave * 4 + F.lane;
            const int p0 = lcnt[16 + my_e0] + my_r0, p1 = lcnt[16 + my_e1] + my_r1;
            int* list = (int*)(ws + WS_LIST);
            *(GAS int*)(list + my_e0 * SEQ + p0) = t; *(GAS int*)(list + my_e1 * SEQ + p1) = t;
            *(GAS int*)((int*)(ws + WS_TOKE) + 2 * t) = my_e0; *(GAS int*)((int*)(ws + WS_TOKE) + 2 * t + 1) = my_e1;
            *(GAS int*)((int*)(ws + WS_TOKP) + 2 * t) = p0; *(GAS int*)((int*)(ws + WS_TOKP) + 2 * t + 1) = p1;
            *(GAS float*)((float*)(ws + WS_TOKW) + 2 * t) = my_w0; *(GAS float*)((float*)(ws + WS_TOKW) + 2 * t + 1) = my_w1; }
        __syncthreads();
    }
#undef N2_LOAD
#undef N2_PROC
}

struct MoeOrder {
    int G, c, total, K, nct; const char* Bt; size_t estride; const int* list; LAS int* tab;
    __device__ __forceinline__ bool next(int i, gm::Unit& u) const {
        const int L = i * G + c; if (L >= total) return false;
        const int q = L / nct, ct = L - q * nct;
        int e = 0;
#pragma unroll
        for (int k = 1; k < NEXP; ++k) e += (q >= tab[k]) ? 1 : 0;
        e = __builtin_amdgcn_readfirstlane(e);
        const int rt = q - __builtin_amdgcn_readfirstlane(tab[e]);
        u.e = e; u.rt = rt; u.arow = (__builtin_amdgcn_readfirstlane(tab[e]) + rt) * 256; u.orow = u.arow; u.ocol = ct * 256;
        u.Bp = Bt + (size_t)e * estride + (size_t)ct * 256 * K * 2; return true;
    }
    __device__ __forceinline__ int row_of(const gm::Unit& u, int r) const {
        const int p = u.rt * 256 + r, n = tab[32 + u.e], pc = p < n ? p : n - 1;
        const int v = *(const GAS int*)(list + u.e * SEQ + pc);
        return (p < n) ? v : 0;
    }
};
__device__ __forceinline__ void moe_table(const Frame& F, int l, LAS int* tab) {
    __syncthreads();
    if (F.tid == 0) { int a = 0;
        for (int e = 0; e < NEXP; ++e) { const int n = (int)__hip_atomic_load(F.ctl + CW_CNT + 64 * l + e, RLX_AGENT); tab[e] = a; tab[32 + e] = n; a += (n + 255) >> 8; }
        tab[16] = a; }
    __syncthreads();
}

constexpr int ATT_CH = 24;
struct MixTab { LAS int* jlo; LAS int* items; LAS int* nitems; LAS float* fend; LAS int* scan; };
__device__ __forceinline__ MixTab mix_tab_ptrs(LAS unsigned char* lds) {
    MixTab T; T.jlo = (LAS int*)(lds + 69632); T.items = (LAS int*)(lds + 69632 + 1024); T.nitems = (LAS int*)(lds + 69632 + 1024 + 8192); T.fend = (LAS float*)(lds + 69632 + 1024 + 8192 + 64);
    T.scan = (LAS int*)(lds + 69632 + 1024 + 8192 + 64 + 4096); return T;
}
__device__ __forceinline__ void mix_build_table(const Frame& F0, int l, const MixTab& T) {
    unsigned char* const ws = opq(F0.ws); const int tid = opq_tid(F0.wave);
    const float* FKL = (const float*)(ws + WS_FKL);
    for (int i = tid; i < 1024; i += NTHR) T.fend[i] = *(const GAS float*)(FKL + (size_t)(i >> 7) * SEQ + (i & 127) * 64 + 63);
    float gq = 0.f, gk = 0.f; const float* const c_qg_ = karg(12); const float* const c_kg_ = karg(13);
    { const int ln = tid & 63; gq = fmaxf(fabsf(*(const GAS float*)(c_qg_ + l * 128 + ln)), fabsf(*(const GAS float*)(c_qg_ + l * 128 + 64 + ln))); gk = fmaxf(fabsf(*(const GAS float*)(c_kg_ + l * 128 + ln)), fabsf(*(const GAS float*)(c_kg_ + l * 128 + 64 + ln)));
      gq = wave_max(gq); gk = wave_max(gk); }
    const float thr = (2.f * 1.01f * 11.313708498984761f * gq * gk + 30.f) * 11.313708498984761f;
    __syncthreads();
    int nfull = 0, nrem = 0, jl = 0, nt = 0;
    if (tid < 256) { const int h = tid >> 5, qb = tid & 31; const float f0 = *(const GAS float*)(FKL + (size_t)h * SEQ + qb * 256);
        for (int j = 0; j < 4 * qb; ++j) jl += (T.fend[h * 128 + j] - f0 <= -thr) ? 1 : 0;
        nt = 4 * (qb + 1) - jl; nfull = nt / ATT_CH; nrem = (nt % ATT_CH) ? 1 : 0; T.jlo[tid] = jl | ((nfull + nrem) << 8); }
    if (tid < 256) { T.scan[tid] = nfull; T.scan[256 + tid] = nrem; }
    __syncthreads();
    for (int o = 1; o < 256; o <<= 1) { int a = 0, b = 0; if (tid < 256 && tid >= o) { a = T.scan[tid - o]; b = T.scan[256 + tid - o]; } __syncthreads();
        if (tid < 256) { T.scan[tid] += a; T.scan[256 + tid] += b; } __syncthreads(); }
    if (tid < 256) { const int totf = T.scan[255], pf = T.scan[tid] - nfull, pr = totf + T.scan[256 + tid] - nrem, jb = 4 * ((tid & 31) + 1);
        for (int c = 0; c < nfull; ++c) T.items[pf + c] = tid | (c << 8) | ((jb - (c + 1) * ATT_CH) << 12) | (ATT_CH << 20);
        if (nrem) T.items[pr] = tid | (nfull << 8) | (jl << 12) | ((nt - nfull * ATT_CH) << 20);
        if (tid == 255) T.nitems[0] = totf + T.scan[511]; }
    __syncthreads();
}
__device__ __forceinline__ void phase_attn_combine(const Frame& F0, int l, const MixTab& T) {
    unsigned char* const ws = opq(F0.ws); const int tid = opq_tid(F0.wave);
    const bf16* PART = (const bf16*)(ws + WS_PART); const float* MLb = (const float*)(ws + WS_ML); bf16* YC = (bf16*)(ws + WS_YCAT);
    for (int b = F0.vcu; b < 256; b += F0.G) {
        const int nch = __builtin_amdgcn_readfirstlane(*(const GAS int*)((const int*)(ws + WS_NCH) + l * 256 + b)); if (nch <= 1) continue;
        const int h = b >> 5, qb = b & 31, row = tid >> 1, half = tid & 1;
        float m[8], w[8], mx = -3.0e38f, ws_ = 0.f;
#pragma unroll
        for (int c = 0; c < 8; ++c) { if (c < nch) { const f32x2 v = *(const GAS f32x2*)(MLb + ((size_t)(b * 8 + c) * 256 + row) * 2); m[c] = v.x; w[c] = v.y; mx = fmaxf(mx, v.x); } else { m[c] = -3.0e38f; w[c] = 0.f; } }
#pragma unroll
        for (int c = 0; c < 8; ++c) { w[c] = (c < nch) ? w[c] * __builtin_amdgcn_exp2f((m[c] - mx) * at::C2) : 0.f; ws_ += w[c]; }
        const float inv = 1.f / ws_;
        float acc[64];
#pragma unroll
        for (int i = 0; i < 64; ++i) acc[i] = 0.f;
#pragma unroll
        for (int c = 0; c < 8; ++c) { if (c < nch) { const bf16* p = PART + ((size_t)(b * 8 + c) * 256 + row) * 128 + half * 64; const float wc = w[c] * inv;
#pragma unroll
            for (int q = 0; q < 8; ++q) { const u32x4 v = *(const GAS u32x4*)(p + q * 8);
                acc[q * 8 + 0] += wc * bf_lo(v.x); acc[q * 8 + 1] += wc * bf_hi(v.x); acc[q * 8 + 2] += wc * bf_lo(v.y); acc[q * 8 + 3] += wc * bf_hi(v.y);
                acc[q * 8 + 4] += wc * bf_lo(v.z); acc[q * 8 + 5] += wc * bf_hi(v.z); acc[q * 8 + 6] += wc * bf_lo(v.w); acc[q * 8 + 7] += wc * bf_hi(v.w); } } }
        bf16* o = YC + (size_t)(qb * 256 + row) * DM + 1024 + h * 128 + half * 64;
#pragma unroll
        for (int q = 0; q < 8; ++q) { u32x4 v; v.x = cvt_pk_bf16(acc[q * 8 + 0], acc[q * 8 + 1]); v.y = cvt_pk_bf16(acc[q * 8 + 2], acc[q * 8 + 3]); v.z = cvt_pk_bf16(acc[q * 8 + 4], acc[q * 8 + 5]); v.w = cvt_pk_bf16(acc[q * 8 + 6], acc[q * 8 + 7]);
            *(GAS u32x4*)(o + q * 8) = v; }
    }
}

struct MoeDynOrder {
    int total, K; const char* Bt; size_t estride; LAS int* tab; gu32* ticket; gu32* ready; gu32* tmo; LAS unsigned* slot;
    __device__ __forceinline__ bool next(int, gm::Unit& u) const {
        if (__builtin_amdgcn_readfirstlane(threadIdx.x >> 6) == 0) {
            unsigned T = 0u;
            if ((threadIdx.x & 63) == 0) T = __hip_atomic_fetch_add(ticket, 1u, RLX_AGENT);
            T = __builtin_amdgcn_readfirstlane(T);
            if (T < (unsigned)total) {
                gu32* w = ready + 16 * (T >> 3); unsigned sp = 0u;
                while ((unsigned)__builtin_amdgcn_readfirstlane(__hip_atomic_load(w, RLX_AGENT)) < 64u) {
                    __builtin_amdgcn_s_sleep(2);
                    if ((++sp & 255u) == 0u) { if (__hip_atomic_load(tmo, RLX_AGENT) != 0u) break; if (sp > (1u << 20)) { __hip_atomic_store(tmo, 1u, RLX_AGENT); break; } } }
                __builtin_amdgcn_fence(__ATOMIC_ACQUIRE, "agent");
                asm volatile("s_waitcnt vmcnt(0)" ::: "memory");
            }
            if ((threadIdx.x & 63) == 0) slot[0] = T;
        }
        asm volatile("s_waitcnt lgkmcnt(0)" ::: "memory"); __builtin_amdgcn_s_barrier(); asm volatile("" ::: "memory");
        const unsigned T = (unsigned)__builtin_amdgcn_readfirstlane((int)slot[0]);
        if (T >= (unsigned)total) return false;
        const int q = (int)(T >> 3), ct = (int)(T & 7);
        int e = 0;
#pragma unroll
        for (int k = 1; k < NEXP; ++k) e += (q >= tab[k]) ? 1 : 0;
        e = __builtin_amdgcn_readfirstlane(e);
        u.e = e; u.rt = q - __builtin_amdgcn_readfirstlane(tab[e]); u.arow = q * 256; u.orow = u.arow; u.ocol = ct * 256;
        u.Bp = Bt + (size_t)e * estride + (size_t)ct * 256 * K * 2; return true;
    }
    __device__ __forceinline__ int row_of(const gm::Unit&, int) const { return 0; }
};
struct EpiZ {
    static constexpr bool PERM = true;
    unsigned char* wsb; int l; LAS float* Pt0;
    __device__ __forceinline__ void operator()(f32x4 (&acc)[2][2][4][2], const gm::Unit& u, int wr, int wc, int fr0, int fq0) const {
        int fr = fr0, fq = fq0; asm volatile("" : "+v"(fr), "+v"(fq));
        unsigned char* const ws = opq(wsb); LAS float* const Pt = opq(Pt0);
        bf16* const O = (bf16*)(ws + WS_Z); bf16* const QN = (bf16*)(ws + WS_QN); bf16* const KN = (bf16*)(ws + WS_KN); bf16* const VN = (bf16*)(ws + WS_VN);
        const int row0 = u.orow + wr * 64 + fr, col0 = u.ocol + wc * 32 + 8 * fq;
        const bool isv = (u.ocol >= 512 && u.ocol < 1024), isq = (u.ocol >= 1536 && u.ocol < 2560), isk = (u.ocol >= 2560 && u.ocol < 3584);
        if (u.ocol < 1024) {
#pragma unroll
            for (int ai = 0; ai < 2; ++ai)
#pragma unroll
                for (int bj = 0; bj < 2; ++bj)
#pragma unroll
                    for (int m = 0; m < 4; ++m)
#pragma unroll
                        for (int n = 0; n < 2; ++n)
#pragma unroll
                            for (int j = 0; j < 4; ++j) acc[ai][bj][m][n][j] = gelu_t(acc[ai][bj][m][n][j]);
        }
        if (isv || isq || isk) {
#pragma unroll
            for (int ai = 0; ai < 2; ++ai)
#pragma unroll
                for (int m = 0; m < 4; ++m)
#pragma unroll
                    for (int bj = 0; bj < 2; ++bj) { const f32x4 a = acc[ai][bj][m][0], b = acc[ai][bj][m][1];
                        float ss = (a[0] * a[0] + a[1] * a[1]) + (a[2] * a[2] + a[3] * a[3]) + (b[0] * b[0] + b[1] * b[1]) + (b[2] * b[2] + b[3] * b[3]);
                        ss += xor_f<16>(ss);
                        { auto rr = __builtin_amdgcn_permlane32_swap(__float_as_uint(ss), __float_as_uint(ss), false, false); ss = __uint_as_float(rr[0]) + __uint_as_float(rr[1]); }
                        if (fq == 0) Pt[((ai * 128 + wr * 64 + m * 16 + fr) * 2 + bj) * 4 + wc] = ss; }
            asm volatile("s_waitcnt lgkmcnt(0)" ::: "memory"); __builtin_amdgcn_s_barrier(); asm volatile("" ::: "memory");
            const float* gp = isv ? karg(9) + l * 512 + (u.ocol - 512) + wc * 32 + 8 * fq : karg(isq ? 12 : 13) + l * 128 + wc * 32 + 8 * fq;
#pragma unroll
            for (int bj = 0; bj < 2; ++bj) {
                const f32x4 g0 = *(const GAS f32x4*)(gp + (isv ? bj * 128 : 0)), g1 = *(const GAS f32x4*)(gp + (isv ? bj * 128 : 0) + 4);
#pragma unroll
                for (int ai = 0; ai < 2; ++ai)
#pragma unroll
                    for (int m = 0; m < 4; ++m) { const int rl = ai * 128 + wr * 64 + m * 16 + fr, row = u.orow + rl;
                        const f32x4 p4 = *(const LAS f32x4*)(Pt + (rl * 2 + bj) * 4);
                        const float rs = rsqrtf(((p4[0] + p4[1]) + (p4[2] + p4[3])) * (1.f / 128.f) + EPSN);
                        const f32x4 v0 = acc[ai][bj][m][0] * rs * g0, v1 = acc[ai][bj][m][1] * rs * g1;
                        u32x4 w; w.x = cvt_pk_bf16(v0[0], v0[1]); w.y = cvt_pk_bf16(v0[2], v0[3]); w.z = cvt_pk_bf16(v1[0], v1[1]); w.w = cvt_pk_bf16(v1[2], v1[3]);
                        bf16* dst;
                        if (isv) dst = VN + (size_t)row * 512 + (u.ocol - 512) + bj * 128 + wc * 32 + 8 * fq;
                        else { const int h = ((u.ocol - (isq ? 1536 : 2560)) >> 7) + bj; dst = (isq ? QN : KN) + ((size_t)h * SEQ + row) * 128 + wc * 32 + 8 * fq; }
                        *(GAS u32x4*)dst = w; } }
            return;
        }
#pragma unroll
        for (int ai = 0; ai < 2; ++ai)
#pragma unroll
            for (int m = 0; m < 4; ++m) { bf16* rowp = O + (size_t)(row0 + ai * 128 + m * 16) * NZ + col0;
#pragma unroll
                for (int bj = 0; bj < 2; ++bj) { const f32x4 v0 = acc[ai][bj][m][0], v1 = acc[ai][bj][m][1];
                    u32x4 w; w.x = cvt_pk_bf16(v0[0], v0[1]); w.y = cvt_pk_bf16(v0[2], v0[3]); w.z = cvt_pk_bf16(v1[0], v1[1]); w.w = cvt_pk_bf16(v1[2], v1[3]);
                    *(GAS u32x4*)(rowp + bj * 128) = w; } }
    }
};
struct EpiRes {
    static constexpr bool PERM = false;
    const float* xin; const LAS float* gate; float* out;
    __device__ __forceinline__ void operator()(const f32x4 (&acc)[2][2][4][2], const gm::Unit& u, int wr, int wc, int fr, int fq) const {
        const int row0 = u.orow + wr * 64 + fr, col0 = u.ocol + wc * 32 + 4 * fq;
        f32x4 gv[2][2];
#pragma unroll
        for (int bj = 0; bj < 2; ++bj)
#pragma unroll
            for (int n = 0; n < 2; ++n) gv[bj][n] = *(const LAS f32x4*)(gate + col0 + bj * 128 + n * 16);
#pragma unroll
        for (int ai = 0; ai < 2; ++ai)
#pragma unroll
            for (int m = 0; m < 4; ++m) { const size_t off = (size_t)(row0 + ai * 128 + m * 16) * DM + col0;
#pragma unroll
                for (int bj = 0; bj < 2; ++bj)
#pragma unroll
                    for (int n = 0; n < 2; ++n) { const f32x4 xv = *(const GAS f32x4*)(xin + off + bj * 128 + n * 16);
                        *(GAS f32x4*)(out + off + bj * 128 + n * 16) = xv + gv[bj][n] * acc[ai][bj][m][n]; } }
    }
};
struct EpiHid {
    static constexpr bool PERM = true;
    bf16* O;
    __device__ __forceinline__ void operator()(const f32x4 (&acc)[2][2][4][2], const gm::Unit& u, int wr, int wc, int fr, int fq) const {
        const int row0 = u.orow + wr * 64 + fr, col0 = (u.ocol >> 1) + wc * 32 + 8 * fq;
#pragma unroll
        for (int ai = 0; ai < 2; ++ai)
#pragma unroll
            for (int m = 0; m < 4; ++m) { bf16* rowp = O + (size_t)(row0 + ai * 128 + m * 16) * DEX + col0;
                f32x4 h0, h1;
#pragma unroll
                for (int j = 0; j < 4; ++j) { h0[j] = silu_f(acc[ai][0][m][0][j]) * acc[ai][1][m][0][j]; h1[j] = silu_f(acc[ai][0][m][1][j]) * acc[ai][1][m][1][j]; }
                u32x4 w; w.x = cvt_pk_bf16(h0[0], h0[1]); w.y = cvt_pk_bf16(h0[2], h0[3]); w.z = cvt_pk_bf16(h1[0], h1[1]); w.w = cvt_pk_bf16(h1[2], h1[3]);
                *(GAS u32x4*)rowp = w; }
    }
};
struct EpiHidPub {
    static constexpr bool PERM = true;
    unsigned char* O; gu32* ready;
    __device__ __forceinline__ void operator()(const f32x4 (&acc)[2][2][4][2], const gm::Unit& u, int wr, int wc, int fr, int fq) const {
        const __amdgpu_buffer_rsrc_t rs = __builtin_amdgcn_make_buffer_rsrc(O, (short)0, (int)(HIDROWS * DEX), 0x00020000);
        const int row0 = u.orow + wr * 64 + fr, col0 = (u.ocol >> 1) + wc * 32 + 8 * fq;
#pragma unroll
        for (int ai = 0; ai < 2; ++ai)
#pragma unroll
            for (int m = 0; m < 4; ++m) { const int off = (row0 + ai * 128 + m * 16) * DEX + col0;
                f32x4 h0, h1;
#pragma unroll
                for (int j = 0; j < 4; ++j) { h0[j] = HID8_SCALE * silu_f(acc[ai][0][m][0][j]) * acc[ai][1][m][0][j]; h1[j] = HID8_SCALE * silu_f(acc[ai][0][m][1][j]) * acc[ai][1][m][1][j]; }
                u32x2 w; w.x = cvt_pk4_fp8(h0[0], h0[1], h0[2], h0[3]); w.y = cvt_pk4_fp8(h1[0], h1[1], h1[2], h1[3]);
                __builtin_amdgcn_raw_buffer_store_b64(w, rs, off, 0, 16); }
        asm volatile("s_waitcnt vmcnt(0)" ::: "memory");
        if (fr == 0 && fq == 0) (void)__hip_atomic_fetch_add(ready + 16 * (u.orow >> 8), 1u, RLX_AGENT);
    }
};
struct EpiYB {
    static constexpr bool PERM = true;
    bf16* O;
    __device__ __forceinline__ void operator()(const f32x4 (&acc)[2][2][4][2], const gm::Unit& u, int wr, int wc, int fr, int fq) const {
        const int row0 = u.orow + wr * 64 + fr, col0 = u.ocol + wc * 32 + 8 * fq;
#pragma unroll
        for (int ai = 0; ai < 2; ++ai)
#pragma unroll
            for (int m = 0; m < 4; ++m) { bf16* rowp = O + (size_t)(row0 + ai * 128 + m * 16) * DM + col0;
#pragma unroll
                for (int bj = 0; bj < 2; ++bj) { const f32x4 v0 = acc[ai][bj][m][0], v1 = acc[ai][bj][m][1];
                    u32x4 w; w.x = cvt_pk_bf16(v0[0], v0[1]); w.y = cvt_pk_bf16(v0[2], v0[3]); w.z = cvt_pk_bf16(v1[0], v1[1]); w.w = cvt_pk_bf16(v1[2], v1[3]);
                    *(GAS u32x4*)(rowp + bj * 128) = w; } }
    }
};

#ifdef MK_SELFTEST
#include "selftest.h"
#endif
__device__ __forceinline__ int bg_need(int p) {
    if (p <= 1) return 0;
    if (p <= 5) return BG_C0;
    if (p <= 7) return BG_C1;
    if (p == 8) return BG_C3;
    if (p <= 10) return BG_C3B;
    if (p <= 14) return BG_C4;
    if (p <= 16) return BG_C5;
    return BG_C7;
}
__device__ __forceinline__ bool bg_seam(int k) { if (k == 0) return true; const int j = (k - 1) % 9; return j != 2 && j != 5 && j != 8; }
struct Args { const float* in[21]; float* out; unsigned char* ws; int ph_lo, ph_hi; };
constexpr int N_PHASES = 1 + 9 * NLAYER + 1;

#ifdef MK_ONLY
#define IN(k) (((k) == 0 ? 0 : (((k) - 1) % 9) + 1) == MK_ONLY && lo <= (k) && (k) < hi)
#else
#define IN(k) (lo <= (k) && (k) < hi)
#endif
#ifndef MK_REPEAT
#define MK_REPEAT -1
#endif
#define REPS(kind) ((MK_REPEAT == (kind)) ? 2 : 1)
#define SEAM(k) do { if (IN(k)) { if (bg_seam(k)) bg_fill(F, (k), bg_need((k) + 1), F.G, true); if (IN((k) + 1)) xcd_barrier(bar); } } while (0)


template <int l> __device__ __forceinline__ void layer_body(const Frame& F, const XcdBarrier& bar, const int lo, const int hi) {
    constexpr int pb = 1 + 9 * l;

        for (int rep_ = 0; rep_ < REPS(1); ++rep_) if (IN(pb)) { if (rep_) xcd_barrier(bar); unsigned char* const wsl = opq(F.ws); LAS unsigned char* const ldl = opq(F.lds); if (l == 0) phase_norm1<0>(F, l, karg(0), nullptr, 0); else phase_norm1<1>(F, l, (const float*)(wsl + WS_X1), (float*)(wsl + WS_X2), l - 1); }
        SEAM(pb);
        for (int rep_ = 0; rep_ < REPS(2); ++rep_) if (IN(pb + 1)) { if (rep_) xcd_barrier(bar); unsigned char* const wsl = opq(F.ws); LAS unsigned char* const ldl = opq(F.lds);
            const int Gg = (F.G == 256) ? 144 : F.G;
            gm::RegOrder S; S.init(SEQ, NZ, DM / 2, wsl + WS_WIN + (size_t)l * NZ * DM, Gg, (int)blockIdx.x);
            fkl_fixup(F);
            EpiZ E{wsl, l, (LAS float*)(ldl + AUX_OFF)};
            if ((int)blockIdx.x < Gg) gm::gemm_phase<EpiZ, gm::RegOrder, false, true, true, SC_H8, SC_W8>(ldl, (const char*)(wsl + WS_H), DM, S, E, F.wave); }
        SEAM(pb + 1);
        for (int rep_ = 0; rep_ < REPS(4); ++rep_) if (IN(pb + 3)) { if (rep_) xcd_barrier(bar); unsigned char* const wsl = opq(F.ws); LAS unsigned char* const ldl = opq(F.lds);
            const MixTab T = mix_tab_ptrs(ldl);
            mix_build_table(F, l, T);
            if (F.vcu == 0) { const int t_ = opq_tid(F.wave); if (t_ < 256) *(GAS int*)((int*)(wsl + WS_NCH) + l * 256 + t_) = T.jlo[t_] >> 8; }
            const int natt = __builtin_amdgcn_readfirstlane(T.nitems[0]), ntot = natt + 512;
            LAS int* qslot = T.nitems + 1;
            int it = F.vcu;
            while (it < ntot) {
                if (it >= natt) { phase_small_item(F, l, it - natt); }
                else {
                    const int rec = __builtin_amdgcn_readfirstlane(T.items[it]), b = rec & 255, c = (rec >> 8) & 15, ja = (rec >> 12) & 255, n = (rec >> 20) & 31, h = b >> 5, qb = b & 31;
                    const bool fin = (__builtin_amdgcn_readfirstlane(T.jlo[b]) >> 8) <= 1; unsigned char* const ws = opq(wsl);
                    at::BlockRef cur;
                    cur.Q = (const bf16*)(ws + WS_QN) + ((size_t)h * SEQ + qb * 256) * 128; cur.K = (const bf16*)(ws + WS_KN) + (size_t)h * SEQ * 128;
                    cur.V = (const bf16*)(ws + WS_Z) + 3584 + h * 128; cur.O = (bf16*)(ws + WS_YCAT) + (size_t)(qb * 256) * DM + 1024 + h * 128;
                    cur.FK = (const float*)(ws + WS_FKL) + (size_t)h * SEQ; cur.P0 = qb * 256;
                    at::attn_block(cur, ja, n, fin, (bf16*)(ws + WS_PART) + (size_t)(b * 8 + c) * 256 * 128, (float*)(ws + WS_ML) + (size_t)(b * 8 + c) * 256 * 2, (char*)ldl, ldl, F.wave);
                }
                if (opq_tid(F.wave) == 0) qslot[0] = F.G + (int)__hip_atomic_fetch_add(F.ctl + CW_Q + 64 * l + 32 * rep_, 1u, RLX_AGENT);
                __syncthreads();
                it = __builtin_amdgcn_readfirstlane(qslot[0]);
                __syncthreads();
            }
        }
        SEAM(pb + 3);
        for (int rep_ = 0; rep_ < REPS(5); ++rep_) if (IN(pb + 4)) { if (rep_) xcd_barrier(bar); unsigned char* const wsl = opq(F.ws); LAS unsigned char* const ldl = opq(F.lds); const MixTab T = mix_tab_ptrs(ldl); phase_attn_combine(F, l, T); }
        SEAM(pb + 4);
        for (int rep_ = 0; rep_ < REPS(6); ++rep_) if (IN(pb + 5)) { if (rep_) xcd_barrier(bar); unsigned char* const wsl = opq(F.ws); LAS unsigned char* const ldl = opq(F.lds); gm::RegOrder S; S.init(SEQ, DM, DM, wsl + WS_WOUT + (size_t)l * DM * DM * 2, F.G, (int)blockIdx.x);
            LAS float* g1L = (LAS float*)(ldl + AUX_OFF);
            { const float* const b_ada_ = karg(3); for (int d = opq_tid(F.wave); d < DM; d += NTHR) g1L[d] = mod_at(wsl, b_ada_, l, 2 * DM + d); }
            __syncthreads();
            EpiRes E{(l == 0) ? karg(0) : (const float*)(wsl + WS_X2), g1L, (float*)(wsl + WS_X1)};
            gm::gemm_phase<EpiRes, gm::RegOrder, false, true>(ldl, (const char*)(wsl + WS_YCAT), DM, S, E, F.wave); }
        SEAM(pb + 5);
        for (int rep_ = 0; rep_ < REPS(7); ++rep_) if (IN(pb + 6)) { if (rep_) xcd_barrier(bar); unsigned char* const wsl = opq(F.ws); LAS unsigned char* const ldl = opq(F.lds); phase_norm2_route(F, l); }
        SEAM(pb + 6);
        for (int rep_ = 0; rep_ < REPS(8); ++rep_) if (IN(pb + 7)) { if (rep_) xcd_barrier(bar); unsigned char* const wsl = opq(F.ws); LAS unsigned char* const ldl = opq(F.lds); LAS int* tab = (LAS int*)(ldl + AUX_OFF + 20480); moe_table(F, l, tab);
            gu32* const rdy = F.ctl + CW_RDY + 4096 * l + 2048 * rep_;
            const int tot1 = 8 * tab[16];
            const bool split = (F.G == 256) && (tot1 <= 576);
            const int Gm = split ? 192 : F.G, cm = split ? (F.vcu >> 5) * 24 + (F.vcu & 31) : F.vcu;
            if (split && (F.vcu & 31) >= 24) bg_fill(F, 20 + l, 0, Gm, false);
            else { MoeOrder S; S.G = Gm; S.c = cm; S.total = 8 * tab[16]; S.K = DM / 2; S.nct = 8; S.Bt = (const char*)(wsl + WS_WGU) + (size_t)l * NEXP * DM * DM; S.estride = (size_t)DM * DM;
              S.list = (const int*)(wsl + WS_LIST); S.tab = tab;
              EpiHidPub E{wsl + (l ? WS_HID1 : WS_HID), rdy};
              gm::gemm_phase<EpiHidPub, MoeOrder, true, true, true, SC_H8, SC_W8>(ldl, (const char*)(wsl + WS_H), DM, S, E, F.wave);
              if (split && opq_tid(F.wave) == 0) (void)__hip_atomic_fetch_add(F.ctl + CW_ARR + 64 * (20 + l), 1u, RLX_AGENT); }
            { MoeDynOrder S; S.total = 8 * tab[16]; S.K = DEX / 2; S.Bt = (const char*)(wsl + WS_WD) + (size_t)l * NEXP * DM * DEX; S.estride = (size_t)DM * DEX; S.tab = tab;
              S.ticket = F.ctl + CW_MT + 64 * l + 32 * rep_; S.ready = rdy; S.tmo = F.ctl + CW_TMO; S.slot = (LAS unsigned*)(ldl + AUX_OFF + 24576 + 64);
              EpiYB E{(bf16*)(wsl + WS_YB)};
              gm::gemm_phase<EpiYB, MoeDynOrder, false, true, true, SC_HID8, SC_W8>(ldl, (const char*)(wsl + (l ? WS_HID1 : WS_HID)), DEX, S, E, F.wave); }
        }
        SEAM(pb + 7);
    }

__global__ void __launch_bounds__(NTHR, 2) mk_fwd(Args args) {
    extern __shared__ __attribute__((aligned(16))) unsigned char lds[];
    Frame F;
    F.lds = (LAS unsigned char*)lds; F.MISC = (volatile LAS unsigned*)(F.lds + MISC_OFF);
    F.tid = 0; F.lane = 0; F.wave = __builtin_amdgcn_readfirstlane((int)threadIdx.x >> 6);
    F.G = gridDim.x; { const int bx = blockIdx.x; F.vcu = (F.G % 8 == 0) ? (bx % 8) * (F.G / 8) + bx / 8 : bx; }
    F.ws = args.ws; F.ctl = (gu32*)(args.ws + WS_CTL);
    for (int u = threadIdx.x; u < (LDS_BYTES - RING_BYTES) / 4; u += NTHR) ((LAS unsigned*)(F.lds + RING_BYTES))[u] = 0u;
    __syncthreads();
    const int lo = args.ph_lo, hi = args.ph_hi;
    const bool multi = (hi - lo) > 1;
    XcdBarrier bar; bar.bar = (unsigned*)(F.ctl + CW_BAR); bar.x = 0; bar.st = nullptr;
    if (multi) bar = xcd_barrier_post((unsigned*)(F.ctl + CW_BAR), F.MISC + 8);
    for (int rep_ = 0; rep_ < REPS(0); ++rep_) if (IN(0)) { if (rep_) xcd_barrier(bar); p0_prologue(F); } SEAM(0);

    layer_body<0>(F, bar, lo, hi);
    layer_body<1>(F, bar, lo, hi);
    for (int rep_ = 0; rep_ < REPS(10); ++rep_) if (IN(N_PHASES - 1)) { if (rep_) xcd_barrier(bar); phase_norm1<2>(F, NLAYER - 1, (const float*)(F.ws + WS_X1), (float*)karg(21), NLAYER - 1); }
#ifdef MK_SELFTEST
    {
        const bool h0 = st_run(0, 1.f, 0x7f7f7f7f), h0s = st_run(0, 64.f, 0x79797979), h1 = st_run(1, 1.f, 0x7f7f7f7f);
        xcd_barrier(bar);
        float* o = (float*)karg(21);
        if (!(h0 && h0s)) { const float val = h0 ? 0.f : (h1 ? 1000.f : __builtin_nanf(""));
            for (size_t i = (size_t)blockIdx.x * NTHR + threadIdx.x; i < (size_t)SEQ * DM; i += (size_t)gridDim.x * NTHR) o[i] = val; }
    }
#endif
#undef IN
#undef SEAM
}

#ifndef MK_LAUNCHES
#define MK_LAUNCHES 1
#endif
extern "C" void kernel_launch(void* const* d_in, const int* in_sizes, int n_in, void* d_out, int out_size, void* d_ws, size_t ws_size, hipStream_t stream) {
    static int grid = 0;
    if (grid == 0) {
        int dev = 0, cus = 0, per_cu = 0;
        if (n_in != 21 || ws_size < WS_END) { fprintf(stderr, "kernel_launch: unexpected inputs (n_in %d, ws %zu)\n", n_in, ws_size); grid = -1; return; }
        if (hipGetDevice(&dev) != hipSuccess || hipDeviceGetAttribute(&cus, hipDeviceAttributeMultiprocessorCount, dev) != hipSuccess) { grid = -1; return; }
        if (hipFuncSetAttribute((const void*)mk_fwd, hipFuncAttributeMaxDynamicSharedMemorySize, LDS_BYTES) != hipSuccess) { fprintf(stderr, "kernel_launch: hipFuncSetAttribute failed\n"); grid = -1; return; }
        if (hipOccupancyMaxActiveBlocksPerMultiprocessor(&per_cu, (const void*)mk_fwd, NTHR, LDS_BYTES) != hipSuccess || per_cu < 1) fprintf(stderr, "kernel_launch: occupancy query says %d\n", per_cu);
        (void)hipGetLastError();
        grid = cus;
    }
    if (grid < 0) return;
    (void)hipMemsetAsync((char*)d_ws + WS_CTL, 0, CTL_ZERO_BYTES, stream);
    Args a{};
    for (int i = 0; i < 21; ++i) a.in[i] = (const float*)d_in[i];
    a.out = (float*)d_out; a.ws = (unsigned char*)d_ws;
#if MK_LAUNCHES == 1
    a.ph_lo = 0; a.ph_hi = N_PHASES;
    hipLaunchKernelGGL(mk_fwd, dim3(grid), dim3(NTHR), LDS_BYTES, stream, a);
#else
    for (int p = 0; p < N_PHASES; ++p) { a.ph_lo = p; a.ph_hi = p + 1; hipLaunchKernelGGL(mk_fwd, dim3(grid), dim3(NTHR), LDS_BYTES, stream, a); }
#endif
}
```

```cpp
#include <hip/hip_runtime.h>
#include <stdint.h>
#include <stdio.h>

#define GAS __attribute__((address_space(1)))
#define LAS __attribute__((address_space(3)))
typedef unsigned short bf16;
typedef short bf16x8 __attribute__((ext_vector_type(8)));
typedef short s16x4 __attribute__((ext_vector_type(4)));
typedef float f32x2 __attribute__((ext_vector_type(2)));
typedef float f32x4 __attribute__((ext_vector_type(4)));
typedef float f32x16 __attribute__((ext_vector_type(16)));
typedef unsigned u32x2 __attribute__((ext_vector_type(2)));
typedef unsigned u32x4 __attribute__((ext_vector_type(4)));
typedef int i32x8 __attribute__((ext_vector_type(8)));
typedef int i32x4 __attribute__((ext_vector_type(4)));
typedef GAS unsigned gu32;
#define RLX_AGENT __ATOMIC_RELAXED, __HIP_MEMORY_SCOPE_AGENT
#define LDS_WAIT() asm volatile("s_waitcnt lgkmcnt(0)" ::: "memory")
#define VM_WAIT() asm volatile("s_waitcnt vmcnt(0)" ::: "memory")

constexpr int DM = 2048, SEQ = 8192, NIN = 4616, NZ = 4608, DEX = 1024, NEXP = 16, NLAYER = 2;
constexpr float EPSN = 1e-6f;
constexpr float LOG2E = 1.4426950408889634f;
constexpr int NWAVES = 8, NTHR = 512;
constexpr int HIDROWS = 2 * SEQ + NEXP * 256;

constexpr size_t KiB = 1024, MiB = 1u << 20;
constexpr size_t WS_CTL = 0, CTL_ZERO_BYTES = 1 * MiB;
constexpr size_t WS_MOD = 1 * MiB;
constexpr size_t WS_FLOC = WS_MOD + 128 * KiB;
constexpr size_t WS_TOT = WS_FLOC + 256 * KiB;
constexpr size_t WS_FKL = WS_TOT + 8 * KiB;
constexpr size_t WS_TOKE = WS_FKL + 256 * KiB;
constexpr size_t WS_TOKP = WS_TOKE + 64 * KiB;
constexpr size_t WS_TOKW = WS_TOKP + 64 * KiB;
constexpr size_t WS_NCH = 7 * MiB;
constexpr size_t WS_LIST = WS_TOKW + 64 * KiB;
constexpr size_t WS_WM = 4 * MiB;
constexpr size_t WS_BWT = WS_WM + 256 * KiB;
constexpr size_t WS_MODP = 6 * MiB;
constexpr size_t WS_WIN = 8 * MiB;
constexpr size_t WS_WOUT = WS_WIN + 2 * 18 * MiB;
constexpr size_t WS_WGU = WS_WOUT + 2 * 8 * MiB;
constexpr size_t WS_WD = WS_WGU + 2 * 16 * 8 * MiB;
constexpr size_t WS_H = WS_WD + 2 * 16 * 4 * MiB;
constexpr size_t WS_Z = WS_H + 32 * MiB;
constexpr size_t WS_QN = WS_Z + 72 * MiB;
constexpr size_t WS_KN = WS_QN + 16 * MiB;
constexpr size_t WS_VN = WS_KN + 16 * MiB;
constexpr size_t WS_DP = WS_VN + 8 * MiB;
constexpr size_t WS_YCAT = WS_DP + 8 * MiB;
constexpr size_t WS_X1 = WS_YCAT + 32 * MiB;
constexpr size_t WS_X2 = WS_X1 + 64 * MiB;
constexpr size_t WS_HID = WS_X2 + 64 * MiB;
constexpr size_t WS_YB = WS_HID + 40 * MiB;
constexpr size_t WS_PART = WS_YB + 80 * MiB;
constexpr size_t WS_ML = WS_PART + 128 * MiB;
constexpr size_t WS_HID1 = WS_ML + 4 * MiB;
constexpr size_t WS_END = WS_HID1 + 40 * MiB;
constexpr int CW_TMO = 0, CW_CODE = 1;
constexpr int CW_CNT = 64;
constexpr int CW_Q = 512;
constexpr int CW_BGT = 640;
constexpr int CW_ARR = 1024;
constexpr int CW_MT = 768;
constexpr int CW_BAR = 4096;
constexpr int CW_PC = 32768;
constexpr int CW_RDY = 8192;

constexpr int RING_BYTES = 131072;
constexpr int MISC_OFF = RING_BYTES + 320;
constexpr int AUX_OFF = RING_BYTES + 1024;
constexpr int LDS_BYTES = 163840;

template <class T> __device__ __forceinline__ T* opq(T* p) { asm volatile("" : "+s"(p)); return p; }
__device__ __forceinline__ int opq_tid(int wave) { int t = (wave << 6) | (int)__builtin_amdgcn_mbcnt_hi(~0u, __builtin_amdgcn_mbcnt_lo(~0u, 0u)); asm volatile("" : "+v"(t)); return t; }
__device__ __forceinline__ unsigned cvt_pk_bf16(float lo, float hi) { unsigned r; asm volatile("v_cvt_pk_bf16_f32 %0, %1, %2" : "=v"(r) : "v"(lo), "v"(hi)); return r; }
__device__ __forceinline__ unsigned cvt_pk4_fp8(float a, float b, float c, float d) {
    a = fminf(fmaxf(a, -440.f), 440.f); b = fminf(fmaxf(b, -440.f), 440.f); c = fminf(fmaxf(c, -440.f), 440.f); d = fminf(fmaxf(d, -440.f), 440.f);
    unsigned w; asm volatile("v_cvt_pk_fp8_f32 %0, %1, %2" : "=v"(w) : "v"(a), "v"(b)); asm volatile("v_cvt_pk_fp8_f32 %0, %1, %2 op_sel:[0,0,1]" : "+v"(w) : "v"(c), "v"(d)); return w; }
constexpr float H8_SCALE = 4.f, HID8_SCALE = 4.f, W8_SCALE = 64.f;
constexpr int SC_H8 = 0x7b7b7b7b, SC_HID8 = 0x7b7b7b7b, SC_W8 = 0x7b7b7b7b;
__device__ __forceinline__ float bf_lo(unsigned w) { return __uint_as_float(w << 16); }
__device__ __forceinline__ float bf_hi(unsigned w) { return __uint_as_float(w & 0xffff0000u); }
template <int M> __device__ __forceinline__ float xor_f(float v) {
    static_assert(M < 32, "xor_f: masks below 32 only");
    return __uint_as_float((unsigned)__builtin_amdgcn_ds_swizzle((int)__float_as_uint(v), (M << 10) | 0x1f));
}
__device__ __forceinline__ float wave_sum(float v) {
    v += __uint_as_float((unsigned)__builtin_amdgcn_update_dpp(0, (int)__float_as_uint(v), 0xb1, 0xf, 0xf, true));
    v += __uint_as_float((unsigned)__builtin_amdgcn_update_dpp(0, (int)__float_as_uint(v), 0x4e, 0xf, 0xf, true));
    v += __uint_as_float((unsigned)__builtin_amdgcn_update_dpp(0, (int)__float_as_uint(v), 0x141, 0xf, 0xf, true));
    v += __uint_as_float((unsigned)__builtin_amdgcn_update_dpp(0, (int)__float_as_uint(v), 0x140, 0xf, 0xf, true));
    v += xor_f<16>(v);
    { auto rr = __builtin_amdgcn_permlane32_swap(__float_as_uint(v), __float_as_uint(v), false, false); v = __uint_as_float(rr[0]) + __uint_as_float(rr[1]); }
    return v;
}
__device__ __forceinline__ float wave_max(float v) {
    v = fmaxf(v, xor_f<1>(v)); v = fmaxf(v, xor_f<2>(v)); v = fmaxf(v, xor_f<4>(v)); v = fmaxf(v, xor_f<8>(v)); v = fmaxf(v, xor_f<16>(v));
    { auto rr = __builtin_amdgcn_permlane32_swap(__float_as_uint(v), __float_as_uint(v), false, false); v = fmaxf(__uint_as_float(rr[0]), __uint_as_float(rr[1])); }
    return v;
}
__device__ __forceinline__ float gelu_t(float x) {
    const float u2 = x * (1.5957691216057308f + 0.0713548162726f * x * x);
    return x * __builtin_amdgcn_rcpf(1.f + __builtin_amdgcn_exp2f(-LOG2E * u2));
}
__device__ __forceinline__ float silu_f(float x) { return x * __builtin_amdgcn_rcpf(1.f + __builtin_amdgcn_exp2f(-LOG2E * x)); }

#define XB_TMO      128
#define XB_XCNT(j)  (256  + 64 * (j))
#define XB_XSUB(j)  (1280 + 64 * (j))
#define XB_XGEN(j)  (2304 + 64 * (j))
#define XB_TOP      3328
#define XB_TOPGEN   3392
#define XCD_BAR_WORDS 3456
#define XB_SPIN_CAP (1u << 18)
__device__ __forceinline__ unsigned xb_ld(unsigned* p)              { return __hip_atomic_load(p, __ATOMIC_RELAXED, __HIP_MEMORY_SCOPE_AGENT); }
__device__ __forceinline__ unsigned xb_add(unsigned* p, unsigned v) { return __hip_atomic_fetch_add(p, v, __ATOMIC_RELAXED, __HIP_MEMORY_SCOPE_AGENT); }
__device__ __forceinline__ unsigned xb_xcc_id() { return (unsigned)__builtin_amdgcn_s_getreg((3 << 11) | 20) & 0xFu; }
#define XB_SPIN(cond, bar) do { unsigned _sp = 0; while (cond) { __builtin_amdgcn_s_sleep(1); \
    if ((++_sp & 255u) == 0u) { if (xb_ld(&(bar)[XB_TMO])) break; if (_sp > XB_SPIN_CAP) { atomicAdd(&(bar)[XB_TMO], 1u); break; } } } } while (0)
struct XcdBarrier { unsigned* bar; unsigned x; volatile LAS unsigned* st; };
__device__ __forceinline__ XcdBarrier xcd_barrier_post(unsigned* bar, volatile LAS unsigned* st) {
    XcdBarrier b; b.bar = bar; b.x = xb_xcc_id(); b.st = st;
    if (threadIdx.x == 0) (void)xb_add(&bar[XB_XCNT(b.x)], 1u);
    return b;
}
__device__ __forceinline__ void xcd_barrier_complete(unsigned* bar, unsigned x, unsigned& nloc, unsigned& nx) {
    const unsigned G = gridDim.x * gridDim.y * gridDim.z;
    unsigned sum, cnt, mine, sp = 0u;
    for (;;) {
        sum = 0u; cnt = 0u; mine = 0u;
#pragma unroll
        for (unsigned j = 0; j < 16; ++j) { const unsigned c = xb_ld(&bar[XB_XCNT(j)]); sum += c; cnt += (c > 0u) ? 1u : 0u; mine = (j == x) ? c : mine; }
        if (sum == G) break;
        __builtin_amdgcn_s_sleep(1);
        if ((++sp & 255u) == 0u) { if (xb_ld(&bar[XB_TMO])) break; if (sp > XB_SPIN_CAP) { atomicAdd(&bar[XB_TMO], 1u); break; } }
    }
    nloc = mine > 0u ? mine : 1u; nx = cnt > 0u ? cnt : 1u;
}
__device__ __forceinline__ void xcd_barrier(const XcdBarrier& b) {
    asm volatile("s_waitcnt vmcnt(0)" ::: "memory");
    __syncthreads();
    if (threadIdx.x == 0) {
        unsigned* bar = b.bar; asm volatile("" : "+s"(bar));
        __builtin_amdgcn_s_waitcnt(0);
        unsigned nloc = b.st[0], nx = b.st[1];
        if (nloc == 0u) { xcd_barrier_complete(bar, b.x, nloc, nx); b.st[0] = nloc; b.st[1] = nx; }
        const unsigned old = xb_add(&bar[XB_XSUB(b.x)], 1u);
        const unsigned gen = old / nloc;
        if (old + 1u == (gen + 1u) * nloc) {
            __builtin_amdgcn_fence(__ATOMIC_RELEASE, "agent");
            asm volatile("s_waitcnt vmcnt(0)" ::: "memory");
            const unsigned og = xb_add(&bar[XB_TOP], 1u);
            const unsigned tg = og / nx;
            if (og + 1u == (tg + 1u) * nx) xb_add(&bar[XB_TOPGEN], 1u);
            else XB_SPIN(xb_ld(&bar[XB_TOPGEN]) == tg, bar);
            __builtin_amdgcn_fence(__ATOMIC_ACQUIRE, "agent");
            xb_add(&bar[XB_XGEN(b.x)], 1u);
            asm volatile("s_waitcnt vmcnt(0)" ::: "memory");
        } else {
            XB_SPIN(xb_ld(&bar[XB_XGEN(b.x)]) == gen, bar);
            __builtin_amdgcn_fence(__ATOMIC_ACQUIRE, "agent");
            asm volatile("s_waitcnt vmcnt(0)" ::: "memory");
        }
    }
    __syncthreads();
}

namespace gm {
constexpr int BM = 256, BK = 64, HALF = 128, HTB = HALF * BK * 2, STAGE_BYTES = 8 * HTB, NXCD = 8, WGM = 8;
__host__ __device__ __forceinline__ int lds_byte(int r, int c) { const int st = (r >> 4) * 2 + (c >> 5), rr = r & 15, cc = c & 31, ob = rr * 64 + cc * 2; return st * 1024 + (ob ^ (((ob >> 9) & 1) << 5)); }
__host__ __device__ __forceinline__ void stage_rc(int b, int& R, int& C) { const int st = b / 1024, sb = b % 1024, swz = sb ^ (((sb >> 9) & 1) << 5); R = (st >> 1) * 16 + swz / 64; C = (st & 1) * 32 + (swz % 64) / 2; }
__host__ __device__ __forceinline__ int perm32(int rho) { const int n = rho >> 4, i = rho & 15; return 8 * (i >> 2) + 4 * n + (i & 3); }

struct Unit { int arow, orow, ocol, e, rt; const char* Bp; };

template <class Epi, class Sched, bool GATHER, bool ALIGN_EPI, bool FP8 = false, int SCA = 0x7f7f7f7f, int SCB = 0x7f7f7f7f>
__device__ __forceinline__ void gemm_phase(LAS unsigned char* lds, const char* Abase, const int Kel, const Sched& S, const Epi& E, const int wv) {
    const int K = FP8 ? (Kel >> 1) : Kel;
    const int tid = opq_tid(wv), wid = wv, lane = tid & 63, wr = wid >> 2, wc = wid & 3, fr = lane & 15, fq = lane >> 4;
    const int nt = K / BK;
    unsigned voffA[2], voffB[2];
#pragma unroll
    for (int i = 0; i < 2; ++i) { int R, C; stage_rc(tid * 16 + i * 8192, R, C); const int Rb = Epi::PERM ? ((R & ~31) + perm32(R & 31)) : R;
        voffA[i] = (unsigned)(R * K + C) * 2u; voffB[i] = (unsigned)(Rb * K + C) * 2u; }
    const size_t kstep = (size_t)(BK * 2);
    const size_t hstep = (size_t)HALF * K * 2;
    const unsigned ldsw = (unsigned)wid * 1024u;
    const int aoff = FP8 ? lds_byte(wr * 64 + fr, fq * 16) : lds_byte(wr * 64 + fr, fq * 8), boff = FP8 ? lds_byte(wc * 32 + fr, fq * 16) : lds_byte(wc * 32 + fr, fq * 8);
#define PG8_SA(b, h) (((b) * 2 + (h)) * HTB)
#define PG8_SB(b, h) ((4 + (b) * 2 + (h)) * HTB)
#define PG8_STAGE(bufoff, gbase, voff) do { _Pragma("unroll") for (int _i = 0; _i < 2; ++_i) { unsigned vo_ = (voff)[_i]; asm volatile("" : "+v"(vo_));     \
        __builtin_amdgcn_global_load_lds((const unsigned*)((const char*)(gbase) + vo_), (LAS unsigned*)(lds + (bufoff) + ldsw + _i * 8192), 16, 0, 0); } } while (0)
#define PG8_STAGE_A(bufoff, ubase, h, kb, vg) do { if constexpr (GATHER) { PG8_STAGE(bufoff, Abase + (kb), (vg)[h]); } else { PG8_STAGE(bufoff, (ubase) + (h) * hstep + (kb), voffA); } } while (0)
#define PG8_STAGE_A2(bufoff, ubase, h, kb) PG8_STAGE_A(bufoff, ubase, h, kb, vgc)
#define PG8_LDA(dst, b, h) do { _Pragma("unroll") for (int m = 0; m < 4; ++m) { if constexpr (FP8) { dst##8[m].lo = *(const LAS i32x4*)(lds + PG8_SA(b, h) + aoff + m * 2048); dst##8[m].hi = *(const LAS i32x4*)(lds + PG8_SA(b, h) + aoff + 16 + m * 2048); } \
        else { dst[m][0] = *(const LAS bf16x8*)(lds + PG8_SA(b, h) + aoff + m * 2048); dst[m][1] = *(const LAS bf16x8*)(lds + PG8_SA(b, h) + aoff + 1024 + m * 2048); } } } while (0)
#define PG8_LDB(dst, b, h) do { _Pragma("unroll") for (int n = 0; n < 2; ++n) { if constexpr (FP8) { dst##8[n].lo = *(const LAS i32x4*)(lds + PG8_SB(b, h) + boff + n * 2048); dst##8[n].hi = *(const LAS i32x4*)(lds + PG8_SB(b, h) + boff + 16 + n * 2048); } \
        else { dst[n][0] = *(const LAS bf16x8*)(lds + PG8_SB(b, h) + boff + n * 2048); dst[n][1] = *(const LAS bf16x8*)(lds + PG8_SB(b, h) + boff + 1024 + n * 2048); } } } while (0)
#define PG8_F8(x) __builtin_shufflevector(__builtin_bit_cast(i32x4, (x)[0]), __builtin_bit_cast(i32x4, (x)[1]), 0, 1, 2, 3, 4, 5, 6, 7)
#define PG8_MMA(ai, bj, At, Bt) do { __builtin_amdgcn_s_setprio(1); _Pragma("unroll") for (int m = 0; m < 4; ++m) _Pragma("unroll") for (int n = 0; n < 2; ++n) { \
        if constexpr (FP8) { acc[ai][bj][m][n] = __builtin_amdgcn_mfma_scale_f32_16x16x128_f8f6f4(Bt##8[n], At##8[m], acc[ai][bj][m][n], 0, 0, 0, SCB, 0, SCA); } \
        else { _Pragma("unroll") for (int k = 0; k < 2; ++k) acc[ai][bj][m][n] = __builtin_amdgcn_mfma_f32_16x16x32_bf16(Bt[n][k], At[m][k], acc[ai][bj][m][n], 0, 0, 0); } } \
        __builtin_amdgcn_s_setprio(0); } while (0)
#define PG8_WAIT_V(n) asm volatile("s_waitcnt vmcnt(" #n ")" ::: "memory")
#define PG8_WAIT_L(n) asm volatile("s_waitcnt lgkmcnt(" #n ")" ::: "memory")
#define PG8_BAR __builtin_amdgcn_s_barrier()
#define PG8_SCHED __builtin_amdgcn_sched_barrier(0)
    Unit cur, nxt; int ui = 0;
    if (!S.next(0, cur)) return;
    f32x4 acc[2][2][4][2];
#pragma unroll
    for (int a = 0; a < 2; ++a)
#pragma unroll
        for (int b = 0; b < 2; ++b)
#pragma unroll
            for (int m = 0; m < 4; ++m)
#pragma unroll
                for (int n = 0; n < 2; ++n) acc[a][b][m][n] = (f32x4){0.f, 0.f, 0.f, 0.f};
    bf16x8 At[4][2], B0[2][2], B1[2][2];
    i32x8 At8[4], B08[2], B18[2];
    unsigned vgc[2][2];
    if constexpr (GATHER) {
#pragma unroll
        for (int h = 0; h < 2; ++h)
#pragma unroll
            for (int i = 0; i < 2; ++i) { int R_, C_; stage_rc(opq_tid(wv) * 16 + i * 8192, R_, C_); vgc[h][i] = ((unsigned)S.row_of(cur, h * HALF + R_) * (unsigned)K + (unsigned)C_) * 2u; }
    }
    const char* cA = GATHER ? Abase : Abase + (size_t)cur.arow * K * 2; const char* cB = cur.Bp;
    PG8_STAGE(PG8_SB(0, 0), cB, voffB); PG8_STAGE(PG8_SB(0, 1), cB + hstep, voffB); PG8_STAGE_A(PG8_SA(0, 0), cA, 0, 0, vgc); PG8_STAGE_A(PG8_SA(0, 1), cA, 1, 0, vgc);
    if (wr == 1) PG8_BAR;
    PG8_WAIT_V(2); PG8_BAR;
    PG8_STAGE(PG8_SB(1, 0), cB + kstep, voffB); PG8_STAGE_A(PG8_SA(1, 0), cA, 0, kstep, vgc); PG8_STAGE(PG8_SB(1, 1), cB + hstep + kstep, voffB);
    PG8_WAIT_V(6); PG8_BAR;
    for (;;) {
        bool has_next = false;
        const char* nA = cA; const char* nB = cB;
        for (int t = 0; t < nt; t += 2) {
            const bool last = (t == nt - 2);
            if (last) { has_next = S.next(ui + 1, nxt); if (has_next) { nA = GATHER ? Abase : Abase + (size_t)nxt.arow * K * 2; nB = nxt.Bp; } }
            const size_t k1 = (size_t)(t + 1) * kstep;
            const char* a2 = last ? nA : cA; const char* b2 = last ? nB : cB + (size_t)(t + 2) * kstep;
            const size_t k2 = last ? 0 : (size_t)(t + 2) * kstep, k3 = k2 + kstep;
            const char* b3 = b2 + kstep;
            PG8_LDB(B0, 0, 0); PG8_LDB(B1, 0, 1); PG8_SCHED; PG8_LDA(At, 0, 0); PG8_STAGE_A(PG8_SA(1, 1), cA, 1, k1, vgc);
            if constexpr (GATHER) { if (last && has_next) {
#pragma unroll
                for (int h = 0; h < 2; ++h)
#pragma unroll
                    for (int i = 0; i < 2; ++i) { int R_, C_; stage_rc(opq_tid(wv) * 16 + i * 8192, R_, C_); vgc[h][i] = ((unsigned)S.row_of(nxt, h * HALF + R_) * (unsigned)K + (unsigned)C_) * 2u; } } }
            PG8_WAIT_V(8); PG8_WAIT_L(0); PG8_BAR; PG8_MMA(0, 0, At, B0); PG8_MMA(0, 1, At, B1); PG8_BAR; PG8_SCHED;
            PG8_LDA(At, 0, 1); PG8_STAGE(PG8_SB(0, 0), b2, voffB); PG8_STAGE(PG8_SB(0, 1), b2 + hstep, voffB); PG8_STAGE_A2(PG8_SA(0, 0), a2, 0, k2);
            PG8_WAIT_V(8); PG8_WAIT_L(0); PG8_BAR; PG8_MMA(1, 0, At, B0); PG8_MMA(1, 1, At, B1); PG8_BAR; PG8_SCHED;
            PG8_LDB(B0, 1, 0); PG8_LDB(B1, 1, 1); PG8_SCHED; PG8_LDA(At, 1, 0); PG8_STAGE_A2(PG8_SA(0, 1), a2, 1, k2);
            PG8_WAIT_V(8); PG8_WAIT_L(0); PG8_BAR; PG8_MMA(0, 0, At, B0); PG8_MMA(0, 1, At, B1); PG8_BAR; PG8_SCHED;
            PG8_LDA(At, 1, 1); PG8_STAGE(PG8_SB(1, 0), b3, voffB); PG8_STAGE(PG8_SB(1, 1), b3 + hstep, voffB); PG8_STAGE_A2(PG8_SA(1, 0), a2, 0, k3);
            PG8_WAIT_V(8); PG8_WAIT_L(0); PG8_BAR; PG8_MMA(1, 0, At, B0); PG8_MMA(1, 1, At, B1); PG8_BAR; PG8_SCHED;
        }
        if constexpr (ALIGN_EPI) { if (wr == 0) PG8_BAR; }
        E(acc, cur, wr, wc, fr, fq);
        if (!has_next) break;
#pragma unroll
        for (int a = 0; a < 2; ++a)
#pragma unroll
            for (int b = 0; b < 2; ++b)
#pragma unroll
                for (int m = 0; m < 4; ++m)
#pragma unroll
                    for (int n = 0; n < 2; ++n) acc[a][b][m][n] = (f32x4){0.f, 0.f, 0.f, 0.f};
        cur = nxt; cA = nA; cB = nB; ++ui;
        if constexpr (ALIGN_EPI) { if (wr == 1) PG8_BAR; }
    }
    PG8_WAIT_V(0);
    if constexpr (!ALIGN_EPI) { if (wr == 0) PG8_BAR; }
    PG8_BAR;
#undef PG8_SA
#undef PG8_SB
#undef PG8_STAGE
#undef PG8_STAGE_A
#undef PG8_STAGE_A2
#undef PG8_LDA
#undef PG8_LDB
#undef PG8_MMA
#undef PG8_F8
#undef PG8_WAIT_V
#undef PG8_WAIT_L
#undef PG8_BAR
#undef PG8_SCHED
}

struct RegOrder {
    int nM, nN, nwg, G, c, K; const char* Bt;
    __device__ __forceinline__ void init(int M, int N, int K_, const void* Bt_, int G_, int c_) { nM = M / BM; nN = N / BM; nwg = nM * nN; G = G_; c = c_; K = K_; Bt = (const char*)Bt_; }
    __device__ __forceinline__ bool next(int i, Unit& u) const {
        const long L = (long)i * G + c; if (L >= nwg) return false;
        int wgid = (int)L; { const int q = nwg / NXCD, r = nwg % NXCD, xcd = wgid % NXCD, off = wgid / NXCD; wgid = (xcd < r ? xcd * (q + 1) : r * (q + 1) + (xcd - r) * q) + off; }
        const int nig = WGM * nN, gid = wgid / nig, fm = gid * WGM, gsz = (nM - fm) < WGM ? (nM - fm) : WGM;
        const int pm = fm + ((wgid % nig) % gsz), pn = (wgid % nig) / gsz;
        u.arow = pm * BM; u.orow = pm * BM; u.ocol = pn * BM; u.e = 0; u.rt = 0; u.Bp = Bt + (size_t)pn * BM * K * 2; return true;
    }
    __device__ __forceinline__ int row_of(const Unit&, int) const { return 0; }
};
}
namespace at {
constexpr int NW = 8, QBLK = 32, KVBLK = 64, QB = NW * QBLK, D = 128;
constexpr int SHM_V = KVBLK * D * 2, SHM_K = KVBLK * D * 2;
constexpr int OFF_WS = 2 * SHM_V + 2 * SHM_K, OFF_NF = OFF_WS + NW * 64 * 4, ATT_LDS = OFF_NF + 2 * 64 * 4;
constexpr float SCALE = 0.08838834764831845f, C2 = 1.4426950408889634f * SCALE, THR = 8.f;
constexpr float ISCALE = 11.313708498984761f;
constexpr int QS = 128, KS = 128, VS = NZ, OS = DM;

#define KSWZ(row, colB) ((row) * 256 + ((colB) ^ (((row) & 7) << 4)))
#define SBAR() __builtin_amdgcn_sched_barrier(0)
__device__ __forceinline__ int v_st(int k, int c) { const int kk = (k & ~0xC) | ((k & 4) << 1) | ((k & 8) >> 1); return ((kk >> 3) * 4 + (c >> 5)) * 512 + ((kk & 7) * 32 + (c & 31)) * 2; }
__device__ __forceinline__ int v_rd_base(int lane) { return ((lane & 3) << 3) | (((lane >> 2) & 3) << 6) | (((lane >> 4) & 1) << 5) | (((lane >> 5) & 1) << 8); }
constexpr int v_rd_off(int d0, int ks, int half) { return d0 * 512 + ks * 4096 + half * 2048; }
__device__ __forceinline__ int crow(int r, int hi) { return (r & 3) + 8 * (r >> 2) + 4 * hi; }
__device__ __forceinline__ unsigned cvtpk(float lo, float hi) { unsigned r; asm volatile("v_cvt_pk_bf16_f32 %0, %1, %2" : "=v"(r) : "v"(lo), "v"(hi)); return r; }
__device__ __forceinline__ bf16x8 load8(const bf16* p) { return *(const GAS bf16x8*)p; }

__device__ __forceinline__ void mask_tile(f32x16& p0, f32x16& p1, int dq) {
    const float NEG = -__builtin_inff();
#pragma unroll
    for (int r = 0; r < 16; ++r) {
        const int c = (r & 3) + 8 * (r >> 2);
        if (dq - c < 0) p0[r] = NEG;
        if (dq - c - 32 < 0) p1[r] = NEG;
    }
}
__device__ __forceinline__ void partialSM(f32x16& p0, f32x16& p1, float& m_reg, float& mn, float& alpha) {
    float pmax = p0[0]; for (int r = 1; r < 16; ++r) pmax = fmaxf(pmax, p0[r]); for (int r = 0; r < 16; ++r) pmax = fmaxf(pmax, p1[r]);
    { auto rr = __builtin_amdgcn_permlane32_swap(__float_as_uint(pmax), __float_as_uint(pmax), false, false);
      pmax = fmaxf(__uint_as_float(rr[0]), __uint_as_float(rr[1])); }
    if (__builtin_expect(__all((pmax - m_reg) * SCALE <= THR), 1)) { mn = m_reg; alpha = 1.f; }
    else { mn = fmaxf(m_reg, pmax); alpha = __builtin_amdgcn_exp2f((m_reg - mn) * C2); m_reg = mn; }
    const float mnL = -mn * C2;
    for (int r = 0; r < 16; ++r) p0[r] = fmaf(p0[r], C2, mnL); for (int r = 0; r < 16; ++r) p1[r] = fmaf(p1[r], C2, mnL);
    for (int r = 0; r < 16; ++r) p0[r] = __builtin_amdgcn_exp2f(p0[r]);
}
__device__ __forceinline__ void finishSM(f32x16& p0, f32x16& p1, float alpha, float& l_reg, bf16x8& pa0, bf16x8& pa1, bf16x8& pa2, bf16x8& pa3) {
    for (int r = 0; r < 16; ++r) p1[r] = __builtin_amdgcn_exp2f(p1[r]);
    float ps = 0; for (int r = 0; r < 16; ++r) ps += p0[r]; for (int r = 0; r < 16; ++r) ps += p1[r];
    { auto rr = __builtin_amdgcn_permlane32_swap(__float_as_uint(ps), __float_as_uint(ps), false, false);
      ps = __uint_as_float(rr[0]) + __uint_as_float(rr[1]); }
    l_reg = l_reg * alpha + ps;
#define PK4(P, B_, OUT) do { unsigned a0 = cvtpk(P[B_+0], P[B_+1]), a1 = cvtpk(P[B_+2], P[B_+3]);                          \
        unsigned b0 = cvtpk(P[B_+4], P[B_+5]), b1 = cvtpk(P[B_+6], P[B_+7]);                                             \
        auto r0 = __builtin_amdgcn_permlane32_swap(a0, b0, false, false); auto r1 = __builtin_amdgcn_permlane32_swap(a1, b1, false, false); \
        u32x4 w = {r0[0], r1[0], r0[1], r1[1]}; OUT = *reinterpret_cast<bf16x8*>(&w); } while (0)
    PK4(p0, 0, pa0); PK4(p0, 8, pa1); PK4(p1, 0, pa2); PK4(p1, 8, pa3);
#undef PK4
}
template <int KB>
__device__ __forceinline__ void qkt(f32x16& p0, f32x16& p1, const char* K_lds, int r32, int hi, const bf16x8* qr) {
    { const float* nf = (const float*)(K_lds + 2 * SHM_K + NW * 64 * 4) + KB * 64 + 4 * hi;
#pragma unroll
      for (int g = 0; g < 4; ++g) { const f32x4 a = *(const f32x4*)(nf + 8 * g), b = *(const f32x4*)(nf + 32 + 8 * g);
#pragma unroll
          for (int j = 0; j < 4; ++j) { p0[4 * g + j] = a[j]; p1[4 * g + j] = b[j]; } } }
    const char* kb[4];
#pragma unroll
    for (int dd = 0; dd < 4; ++dd) kb[dd] = K_lds + KB * SHM_K + KSWZ(r32, (dd * 16 + hi * 8) * 2);
#pragma unroll
    for (int d0 = 0; d0 < 8; ++d0) { const char* a = kb[d0 & 3] + (d0 >> 2) * 128;
        bf16x8 b0 = *reinterpret_cast<const bf16x8*>(a);
        bf16x8 b1 = *reinterpret_cast<const bf16x8*>(a + 32 * 256);
        p0 = __builtin_amdgcn_mfma_f32_32x32x16_bf16(b0, qr[d0], p0, 0, 0, 0);
        p1 = __builtin_amdgcn_mfma_f32_32x32x16_bf16(b1, qr[d0], p1, 0, 0, 0); }
}
template <int VB>
__device__ __forceinline__ void pv_tile(f32x16* o, int vb0, bf16x8 pa0, bf16x8 pa1, bf16x8 pa2, bf16x8 pa3) {
#define TRRD(dst, off) asm volatile("ds_read_b64_tr_b16 %0, %1 offset:%2" : "=&v"(dst) : "v"(vb0), "i"(off) : "memory")
#define PV_D0(d0) do { s16x4 l0, l1, l2, l3, h0, h1, h2, h3; constexpr int b_ = VB * SHM_V + v_rd_off(d0, 0, 0); \
        TRRD(l0, b_); TRRD(h0, b_ + 2048); TRRD(l1, b_ + 4096); TRRD(h1, b_ + 6144); TRRD(l2, b_ + 8192); TRRD(h2, b_ + 10240); TRRD(l3, b_ + 12288); TRRD(h3, b_ + 14336); \
        asm volatile("s_waitcnt lgkmcnt(0)" ::: "memory"); SBAR();   \
        o[d0] = __builtin_amdgcn_mfma_f32_32x32x16_bf16(pa0, (bf16x8){l0[0], l0[1], l0[2], l0[3], h0[0], h0[1], h0[2], h0[3]}, o[d0], 0, 0, 0);   \
        o[d0] = __builtin_amdgcn_mfma_f32_32x32x16_bf16(pa1, (bf16x8){l1[0], l1[1], l1[2], l1[3], h1[0], h1[1], h1[2], h1[3]}, o[d0], 0, 0, 0);   \
        o[d0] = __builtin_amdgcn_mfma_f32_32x32x16_bf16(pa2, (bf16x8){l2[0], l2[1], l2[2], l2[3], h2[0], h2[1], h2[2], h2[3]}, o[d0], 0, 0, 0);   \
        o[d0] = __builtin_amdgcn_mfma_f32_32x32x16_bf16(pa3, (bf16x8){l3[0], l3[1], l3[2], l3[3], h3[0], h3[1], h3[2], h3[3]}, o[d0], 0, 0, 0); } while (0)
    PV_D0(0); PV_D0(1); PV_D0(2); PV_D0(3);
#undef PV_D0
#undef TRRD
}

struct BlockRef { const bf16* Q; const bf16* K; const bf16* V; unsigned char* O; const float* FK; int P0; };
#define ROWV(p, k0, rr) ((p) + (size_t)((k0) + (rr)) * VS + sc)
#define VMW() asm volatile("s_waitcnt vmcnt(0)" ::: "memory")
__device__ __forceinline__ void attn_block(const BlockRef& cur, int ja, int nt, bool fin, bf16* Opart, float* ML, char* lds, LAS unsigned char* ldsL, const int wv) {
    const int tid = opq_tid(wv), wid = wv, lane = tid & 63, r32 = lane & 31, hi = lane >> 5;
    const int NT = nt;
    const int qlo = cur.P0 + wid * QBLK, qm = qlo + r32 - 4 * hi;
    char* V_lds = lds; char* K_lds = lds + 2 * SHM_V;
    float* ws = (float*)(lds + OFF_WS) + wid * 64; float* li_l = ws, * al_l = ws + 32;
    float m_reg = -1e30f, l_reg = 0; f32x16 o[4] = {};
    const int vb0 = (int)(uintptr_t)V_lds + v_rd_base(lane);
    const bf16* Kh = cur.K; const bf16* Vh = cur.V; const float* Fh = cur.FK;
    bf16x8 st_v0, st_v1; bf16x8 qr[8];
#define KDMA(bf, k0) do { int t_ = tid; asm volatile("" : "+v"(t_)); _Pragma("unroll") for (int i_ = 0; i_ < 2; ++i_) { const int p_ = i_ * 512 + t_, r_ = p_ >> 4, c_ = (p_ & 15) ^ (r_ & 7); \
        __builtin_amdgcn_global_load_lds((const unsigned*)((const char*)Kh + (size_t)(k0) * KS * 2 + (unsigned)(r_ * KS * 2 + c_ * 16)), (LAS unsigned*)(ldsL + 2 * SHM_V + (bf) * SHM_K + i_ * 8192 + wid * 1024), 16, 0, 0); } \
        if (wid == 0) __builtin_amdgcn_global_load_lds((const unsigned*)(Fh + (k0) + lane), (LAS unsigned*)(ldsL + OFF_NF + (bf) * 256), 4, 0, 0); } while (0)
#define SLOADV(k0) do { int t_ = tid; asm volatile("" : "+v"(t_)); const int sr = t_ >> 4, sc = (t_ & 15) * 8; st_v0 = load8(ROWV(Vh, k0, sr)); st_v1 = load8(ROWV(Vh, k0, 32 + sr)); } while (0)
#define SWRITE_HV(bf) do { int t_ = tid; asm volatile("" : "+v"(t_)); const int sr = t_ >> 4, sc = (t_ & 15) * 8; *(bf16x8*)(V_lds + (bf) * SHM_V + v_st(sr, sc)) = st_v0; *(bf16x8*)(V_lds + (bf) * SHM_V + v_st(32 + sr, sc)) = st_v1; } while (0)
#define RESC(a) do { if (__any((a) < 1.f)) { if (hi == 0) al_l[r32] = (a); asm volatile("s_waitcnt lgkmcnt(0)" ::: "memory");              \
                     for (int d_ = 0; d_ < 4; ++d_) for (int r = 0; r < 16; ++r) o[d_][r] *= al_l[crow(r, hi)]; } } while (0)
#define KBASE(t) ((ja + (t)) * KVBLK)
#define MASKT(P0_, P1_, t) do { const int kb_ = KBASE(t); if (kb_ + KVBLK - 1 > qlo) mask_tile(P0_, P1_, qm - kb_); } while (0)
    f32x16 pA0, pA1, pB0, pB1; float mnA, mnB, alA, alB; bf16x8 pa0, pa1, pa2, pa3;
    KDMA(0, KBASE(0)); SLOADV(KBASE(0));
#pragma unroll
    for (int d0 = 0; d0 < 8; ++d0) qr[d0] = load8(cur.Q + (size_t)(wid * QBLK + r32) * QS + d0 * 16 + hi * 8);
    VMW(); SWRITE_HV(0);
    __syncthreads();
    if (NT > 1) { KDMA(1, KBASE(1)); SLOADV(KBASE(1)); }
    SBAR(); qkt<0>(pA0, pA1, K_lds, r32, hi, qr);
    MASKT(pA0, pA1, 0); partialSM(pA0, pA1, m_reg, mnA, alA);
    if (NT > 1) { VMW(); SWRITE_HV(1); }
    __syncthreads();
#define HALF_STEP(PX0, PX1, mnX, alX, PY0, PY1, alY, t, KB, VB, SB) do {                                                      \
        SBAR(); qkt<KB>(PX0, PX1, K_lds, r32, hi, qr);                                                                        \
        finishSM(PY0, PY1, alY, l_reg, pa0, pa1, pa2, pa3); SBAR();                                                           \
        if ((t) + 1 < NT) { KDMA(SB, KBASE((t) + 1)); SLOADV(KBASE((t) + 1)); SBAR(); }                                       \
        pv_tile<VB>(o, vb0, pa0, pa1, pa2, pa3); MASKT(PX0, PX1, (t)); partialSM(PX0, PX1, m_reg, mnX, alX);                  \
        VMW(); __syncthreads();                                                                                               \
        if ((t) + 1 < NT) { SWRITE_HV(SB); }                                                                                  \
        RESC(alX); __syncthreads(); } while (0)
    for (int t = 1; t + 1 < NT; t += 2) {
        HALF_STEP(pB0, pB1, mnB, alB, pA0, pA1, alA, t, 1, 0, 0);
        HALF_STEP(pA0, pA1, mnA, alA, pB0, pB1, alB, t + 1, 0, 1, 1);
    }
    const bool even = (NT & 1) == 0;
    if (even) { SBAR(); qkt<1>(pB0, pB1, K_lds, r32, hi, qr); SBAR(); }
    finishSM(pA0, pA1, alA, l_reg, pa0, pa1, pa2, pa3); SBAR();
    pv_tile<0>(o, vb0, pa0, pa1, pa2, pa3);
    if (even) { MASKT(pB0, pB1, NT - 1); partialSM(pB0, pB1, m_reg, mnB, alB); __syncthreads(); RESC(alB);
        finishSM(pB0, pB1, alB, l_reg, pa0, pa1, pa2, pa3); SBAR(); pv_tile<1>(o, vb0, pa0, pa1, pa2, pa3); }
    SBAR();
    if (hi == 0) li_l[r32] = l_reg; asm volatile("s_waitcnt lgkmcnt(0)" ::: "memory");
    float rli[16];
#pragma unroll
    for (int r = 0; r < 16; ++r) rli[r] = __builtin_amdgcn_rcpf(li_l[crow(r, hi)]);
    if (fin) {
        unsigned char* Ow = cur.O + (size_t)(wid * QBLK) * OS;
#pragma unroll
        for (int r = 0; r < 16; ++r) { const int orow = crow(r, hi);
#pragma unroll
            for (int d0 = 0; d0 < 4; ++d0) { const float v = o[d0][r] * rli[r] * H8_SCALE; const int vi = (int)__float_as_uint(v);
                const float v1 = __uint_as_float((unsigned)__builtin_amdgcn_mov_dpp(vi, 0x55, 0xf, 0xf, true)), v2 = __uint_as_float((unsigned)__builtin_amdgcn_mov_dpp(vi, 0xaa, 0xf, 0xf, true)), v3 = __uint_as_float((unsigned)__builtin_amdgcn_mov_dpp(vi, 0xff, 0xf, 0xf, true));
                const unsigned w = cvt_pk4_fp8(v, v1, v2, v3);
                if ((r32 & 3) == 0) *(GAS unsigned*)(Ow + (size_t)orow * OS + d0 * 32 + r32) = w; } }
    } else {
        bf16* Ow = Opart + (size_t)(wid * QBLK) * D;
#pragma unroll
        for (int r = 0; r < 16; ++r) { const int orow = crow(r, hi);
#pragma unroll
            for (int d0 = 0; d0 < 4; ++d0) { const float v = o[d0][r] * rli[r];
                const float vn = xor_f<1>(v);
                if ((r32 & 1) == 0) __hip_atomic_store((unsigned*)(Ow + (size_t)orow * D + d0 * 32 + r32), cvtpk(v, vn), RLX_AGENT); } }
    }
    if (!fin) { if (hi == 0) { float* const pm = ML + (size_t)(wid * QBLK + r32) * 2; __hip_atomic_store(pm, m_reg, RLX_AGENT); __hip_atomic_store(pm + 1, l_reg, RLX_AGENT); }
        asm volatile("s_waitcnt vmcnt(0)" ::: "memory"); }
    __syncthreads();
#undef KDMA
#undef SLOADV
#undef SWRITE_HV
#undef RESC
#undef KBASE
#undef MASKT
#undef HALF_STEP
}
#undef ROWV
#undef VMW
}
struct Frame {
    LAS unsigned char* lds; volatile LAS unsigned* MISC; gu32* ctl;
    int tid, lane, wave, vcu, G;
    unsigned char* ws;
};
#define CAS __attribute__((address_space(4)))
__device__ __forceinline__ const float* karg(int k) { const CAS char* p = (const CAS char*)__builtin_amdgcn_kernarg_segment_ptr(); asm volatile("" : "+s"(p)); return *(const float* const CAS*)(p + 8 * k); }

__device__ __forceinline__ void tr_item(const float* W, size_t ldw, bf16* WT, size_t ldk, LAS float* scr, int lane) {
    const int kr = lane >> 3, c4 = (lane & 7) * 4;
    f32x4 v[8];
#pragma unroll
    for (int i = 0; i < 8; ++i) v[i] = __builtin_nontemporal_load((const GAS f32x4*)(W + (size_t)(8 * i + kr) * ldw + c4));
#pragma unroll
    for (int i = 0; i < 8; ++i) { LAS float* s = scr + (8 * i + kr) * 33 + c4; s[0] = v[i].x; s[1] = v[i].y; s[2] = v[i].z; s[3] = v[i].w; }
    LDS_WAIT();
    const int c = lane & 7;
#pragma unroll
    for (int j = 0; j < 4; ++j) { const int n = (lane >> 3) + 8 * j; const LAS float* s = scr + (8 * c) * 33 + n;
        u32x4 o; o.x = cvt_pk_bf16(s[0 * 33], s[1 * 33]); o.y = cvt_pk_bf16(s[2 * 33], s[3 * 33]); o.z = cvt_pk_bf16(s[4 * 33], s[5 * 33]); o.w = cvt_pk_bf16(s[6 * 33], s[7 * 33]);
        *(GAS u32x4*)(WT + (size_t)n * ldk + 8 * c) = o; }
    LDS_WAIT();
}
__device__ __forceinline__ void tr_item8(const float* W, size_t ldw, unsigned char* WT, size_t ldk, LAS float* scr, int lane) {
    const int kr = lane >> 3, c4 = (lane & 7) * 4;
    f32x4 v[2][8];
#pragma unroll
    for (int hh = 0; hh < 2; ++hh)
#pragma unroll
        for (int i = 0; i < 8; ++i) v[hh][i] = __builtin_nontemporal_load((const GAS f32x4*)(W + (size_t)(8 * i + kr) * ldw + 32 * hh + c4));
#pragma unroll
    for (int hh = 0; hh < 2; ++hh) {
#pragma unroll
        for (int i = 0; i < 8; ++i) { LAS float* s = scr + (8 * i + kr) * 33 + c4; s[0] = v[hh][i].x; s[1] = v[hh][i].y; s[2] = v[hh][i].z; s[3] = v[hh][i].w; }
        LDS_WAIT();
        const int c = lane & 3;
#pragma unroll
        for (int j = 0; j < 2; ++j) { const int n = (lane >> 2) + 16 * j; const LAS float* s = scr + (16 * c) * 33 + n;
            u32x4 o;
            o.x = cvt_pk4_fp8(s[0 * 33] * W8_SCALE, s[1 * 33] * W8_SCALE, s[2 * 33] * W8_SCALE, s[3 * 33] * W8_SCALE); o.y = cvt_pk4_fp8(s[4 * 33] * W8_SCALE, s[5 * 33] * W8_SCALE, s[6 * 33] * W8_SCALE, s[7 * 33] * W8_SCALE);
            o.z = cvt_pk4_fp8(s[8 * 33] * W8_SCALE, s[9 * 33] * W8_SCALE, s[10 * 33] * W8_SCALE, s[11 * 33] * W8_SCALE); o.w = cvt_pk4_fp8(s[12 * 33] * W8_SCALE, s[13 * 33] * W8_SCALE, s[14 * 33] * W8_SCALE, s[15 * 33] * W8_SCALE);
            *(GAS u32x4*)(WT + (size_t)(32 * hh + n) * ldk + 16 * c) = o; }
        LDS_WAIT();
    }
}
constexpr int I_IN = (DM / 64) * (NZ / 32), I_OUT = (DM / 64) * (DM / 32), I_GU = (DM / 64) * (DEX / 32), I_D = (DEX / 64) * (DM / 32);
constexpr int GV_FIRST = 43;
constexpr int BGI_SMALL = (NLAYER * 4 * 8) / 8, BGI_IN = I_IN / 16, BGI_GV0 = (128 - GV_FIRST) * 4, BGI_GV1 = 128 * 4, BGI_OUT = I_OUT / 16, BGI_GU = NEXP * 2 * I_GU / 16, BGI_D = NEXP * I_D / 16;
constexpr int BG_C0 = BGI_SMALL + BGI_IN;
constexpr int BG_C1 = BG_C0 + BGI_GV0 + BGI_OUT;
constexpr int BG_C2 = BG_C1 + BGI_GU;
constexpr int BG_C3 = BG_C2 + BGI_D;
constexpr int BG_C3B = BG_C3 + BGI_GV1;
constexpr int BG_C4 = BG_C3B + BGI_IN;
constexpr int BG_C5 = BG_C4 + BGI_OUT;
constexpr int BG_C6 = BG_C5 + BGI_GU;
constexpr int BG_C7 = BG_C6 + BGI_D;
__device__ __forceinline__ float mod_at(const unsigned char* ws, const float* b_ada, int l, int j) {
    const float* p = (const float*)(ws + WS_MODP) + (size_t)l * 6 * DM + j;
    return *(const GAS float*)(b_ada + (size_t)l * 6 * DM + j) + ((*(const GAS float*)p + *(const GAS float*)(p + 2 * 6 * DM)) + (*(const GAS float*)(p + 4 * 6 * DM) + *(const GAS float*)(p + 6 * 6 * DM)));
}
__device__ __forceinline__ void mod_ld(const unsigned char* ws, const float* b_ada, int l, int j, float (&r)[5]) {
    const float* p = (const float*)(ws + WS_MODP) + (size_t)l * 6 * DM + j;
    r[0] = *(const GAS float*)(b_ada + (size_t)l * 6 * DM + j); r[1] = *(const GAS float*)p; r[2] = *(const GAS float*)(p + 2 * 6 * DM); r[3] = *(const GAS float*)(p + 4 * 6 * DM); r[4] = *(const GAS float*)(p + 6 * 6 * DM);
}
__device__ __forceinline__ float mod_sum(const float (&r)[5]) { return r[0] + ((r[1] + r[2]) + (r[3] + r[4])); }
__device__ __forceinline__ void gemv_item(const Frame& F, unsigned char* ws, int w) {
    LAS float* sc = (LAS float*)F.lds; LAS f32x4* red = (LAS f32x4*)(F.lds + 8192);
    const int kq = w & 3, l = w >> 9, cb = (w >> 2) & 127, c4 = F.tid % 24, kg = F.tid / 24;
    if (F.tid < 512) sc[F.tid] = silu_f(*(const GAS float*)(karg(1) + kq * 512 + F.tid));
    __syncthreads();
    f32x4 acc = (f32x4){0.f, 0.f, 0.f, 0.f};
    if (kg < 21) {
        const float* wp = karg(2) + (size_t)l * DM * 6 * DM + (size_t)(kq * 512) * 6 * DM + cb * 96 + c4 * 4;
#pragma unroll
        for (int b0 = 0; b0 < 24; b0 += 8) { f32x4 wq[8];
#pragma unroll
            for (int it = 0; it < 8; ++it) wq[it] = __builtin_nontemporal_load((const GAS f32x4*)(wp + (size_t)(kg + 21 * (b0 + it)) * 6 * DM));
#pragma unroll
            for (int it = 0; it < 8; ++it) acc += wq[it] * sc[kg + 21 * (b0 + it)]; }
        if (kg < 8) { const f32x4 wv = __builtin_nontemporal_load((const GAS f32x4*)(wp + (size_t)(kg + 504) * 6 * DM)); acc += wv * sc[kg + 504]; }
        red[kg * 24 + c4] = acc;
    }
    __syncthreads();
    if (F.tid < 24) { f32x4 s = red[F.tid];
        for (int g = 1; g < 21; ++g) s += red[g * 24 + F.tid];
        *(GAS f32x4*)((float*)(ws + WS_MODP) + (size_t)kq * 2 * 6 * DM + (size_t)l * 6 * DM + cb * 96 + F.tid * 4) = s; }
    __syncthreads();
}
__device__ __forceinline__ void conv_wave_item(const Frame& F, unsigned char* ws, int r, int l, LAS float* scr) {
    if (r < I_IN) { const int kb = r / (NZ / 32), nb = r % (NZ / 32);
        tr_item8(karg(6) + (size_t)l * DM * NIN + (size_t)(64 * kb) * NIN + 32 * nb, NIN, ws + WS_WIN + (size_t)l * NZ * DM + (size_t)(32 * nb) * DM + 64 * kb, DM, scr, F.lane); return; }
    r -= I_IN;
    if (r < I_OUT) { const int kb = r / (DM / 32), nb = r % (DM / 32);
        tr_item8(karg(15) + (size_t)l * DM * DM + (size_t)(64 * kb) * DM + 32 * nb, DM, ws + WS_WOUT + (size_t)l * DM * DM + (size_t)(32 * nb) * DM + 64 * kb, DM, scr, F.lane); return; }
    r -= I_OUT;
    if (r < NEXP * 2 * I_GU) { const int e = r / (2 * I_GU); r -= e * 2 * I_GU; const int up = r >= I_GU; if (up) r -= I_GU; const int kb = r / (DEX / 32), nb = r % (DEX / 32), n0 = 32 * nb;
        const float* src = (up ? karg(19) : karg(18)) + ((size_t)l * NEXP + e) * DM * DEX + (size_t)(64 * kb) * DEX + n0;
        const int drow = (n0 >> 7) * 256 + (up ? 128 : 0) + (n0 & 127);
        tr_item8(src, DEX, ws + WS_WGU + ((size_t)l * NEXP + e) * DM * DM + (size_t)drow * DM + 64 * kb, DM, scr, F.lane); return; }
    r -= NEXP * 2 * I_GU;
    { const int e = r / I_D; r -= e * I_D; const int kb = r / (DM / 32), nb = r % (DM / 32);
      tr_item8(karg(20) + ((size_t)l * NEXP + e) * DEX * DM + (size_t)(64 * kb) * DM + 32 * nb, DM, ws + WS_WD + ((size_t)l * NEXP + e) * DM * DEX + (size_t)(32 * nb) * DEX + 64 * kb, DEX, scr, F.lane); }
}
__device__ __forceinline__ void bg_item(const Frame& F, unsigned char* ws, int t) {
    LAS float* scr = (LAS float*)(F.lds + 16384 + F.wave * 9216);
    if (t < BGI_SMALL) { const int r = t * 8 + F.wave, mat = r >> 3, q = r & 7, kb = q >> 2, nb = q & 3;
        tr_item(karg(10) + (size_t)mat * 128 * 128 + (size_t)(64 * kb) * 128 + 32 * nb, 128, (bf16*)(ws + WS_BWT) + (size_t)mat * 128 * 128 + (size_t)(32 * nb) * 128 + 64 * kb, 128, scr, F.lane); return; }
    t -= BGI_SMALL;
    if (t < BGI_IN) { conv_wave_item(F, ws, (t * 8 + F.wave) * 2, 0, scr); return; }
    t -= BGI_IN;
    if (t < BGI_GV0) { gemv_item(F, ws, GV_FIRST * 4 + t); return; }
    t -= BGI_GV0;
    if (t < BGI_OUT) { conv_wave_item(F, ws, I_IN + (t * 8 + F.wave) * 2, 0, scr); return; }
    t -= BGI_OUT;
    if (t < BGI_GU + BGI_D) { conv_wave_item(F, ws, I_IN + I_OUT + (t * 8 + F.wave) * 2, 0, scr); return; }
    t -= BGI_GU + BGI_D;
    if (t < BGI_GV1) { gemv_item(F, ws, 512 + t); return; }
    t -= BGI_GV1;
    if (t < BGI_IN) { conv_wave_item(F, ws, (t * 8 + F.wave) * 2, 1, scr); return; }
    t -= BGI_IN;
    if (t < BGI_OUT) { conv_wave_item(F, ws, I_IN + (t * 8 + F.wave) * 2, 1, scr); return; }
    t -= BGI_OUT;
    conv_wave_item(F, ws, I_IN + I_OUT + (t * 8 + F.wave) * 2, 1, scr);
}
__device__ __forceinline__ void bg_fill(const Frame& F0, int seam, int need, int expect, bool self) {
    unsigned char* const ws = opq(F0.ws); Frame F = F0; F.tid = opq_tid(F0.wave); F.lane = F.tid & 63; F.lds = opq(F0.lds);
    LAS unsigned* slot = (LAS unsigned*)(F.lds + AUX_OFF + 24576);
    gu32* const ctl_ = opq(F0.ctl); gu32* ticket = ctl_ + CW_BGT; gu32* arr = ctl_ + CW_ARR + 64 * seam;
    unsigned tn = 0xffffffffu; bool pre = false;
    if (F.tid == 0 && slot[1] == 0u) {
        const unsigned a0 = self ? __hip_atomic_fetch_add(arr, 1u, RLX_AGENT) + 1u : __hip_atomic_load(arr, RLX_AGENT); const unsigned cur = __hip_atomic_load(ticket, RLX_AGENT);
        if (cur >= (unsigned)BG_C7) slot[1] = 1u;
        else if (cur < (unsigned)need || a0 < (unsigned)expect) tn = __hip_atomic_fetch_add(ticket, 1u, RLX_AGENT); }
    for (;;) {
        if (F.tid == 0) slot[0] = tn;
        __syncthreads();
        const unsigned t = __builtin_amdgcn_readfirstlane(slot[0]);
        __syncthreads();
        if (t >= (unsigned)BG_C7) { if (F.tid == 0 && t != 0xffffffffu) slot[1] = 1u; break; }
        if (F.tid == 0) { tn = 0xffffffffu; pre = (t + (unsigned)F.G + 2u < (unsigned)need);
            if (pre) tn = __hip_atomic_fetch_add(ticket, 1u, RLX_AGENT); }
        bg_item(F, ws, (int)t);
        if (F.tid == 0 && !pre) { if (t + 1u < (unsigned)need || __hip_atomic_load(arr, RLX_AGENT) < (unsigned)expect) tn = __hip_atomic_fetch_add(ticket, 1u, RLX_AGENT); }
    }
}
__device__ __forceinline__ void p0_prologue(const Frame& F0) {
    unsigned char* const ws = opq(F0.ws); Frame F = F0; F.tid = opq_tid(F0.wave); F.lane = F.tid & 63; F.lds = opq(F0.lds);
    for (int w = F.vcu; w < GV_FIRST * 4; w += F.G) gemv_item(F, ws, w);
    const float* const a_ws_ = karg(7);
    for (int i = (F.vcu * NTHR + F.tid) * 2; i < NLAYER * 4 * 128 * 128; i += F.G * NTHR * 2) {
        const int t = (i >> 7) & 127, s = i & 127;
        const f32x2 w = *(const GAS f32x2*)(a_ws_ + i);
        const bool keep = (s >> 6) <= (t >> 6);
        *(GAS unsigned*)((bf16*)(ws + WS_WM) + i) = keep ? cvt_pk_bf16(w.x, w.y) : 0u;
    }
}

template <int MODE>
__device__ __forceinline__ void phase_norm1(const Frame& F0, int l, const void* xin, void* xout, int lprev) {
    unsigned char* const ws = opq(F0.ws); Frame F = F0; F.tid = opq_tid(F0.wave); F.lane = F.tid & 63; F.lds = opq(F0.lds);
    LAS float* wfT = (LAS float*)F.lds;
    LAS float* gaL = (LAS float*)(F.lds + 65536);
    LAS float* gbL = (LAS float*)(F.lds + 73728);
    LAS float* g2L = (LAS float*)(F.lds + 81920);
    LAS float* lf = (LAS float*)(F.lds + 90112);
    LAS int* hb = (LAS int*)(F.lds + 91136);
    const float* const b_ada_ = karg(3); const float* const c_bf_ = karg(14);
    if (MODE != 2) {
        const float* const w_in_ = karg(6); const float* const g_mix_ = karg(4);
        f32x4 wq[8]; float gm_[4], ms_[4][5], mh_[4][5];
#pragma unroll
        for (int it = 0; it < 8; ++it) { const int i = F.tid + it * NTHR, d = i >> 1, half = i & 1; wq[it] = *(const GAS f32x4*)(w_in_ + (size_t)l * DM * NIN + (size_t)d * NIN + NZ + half * 4); }
#pragma unroll
        for (int it = 0; it < 4; ++it) { const int d = F.tid + it * NTHR; gm_[it] = *(const GAS float*)(g_mix_ + (size_t)l * DM + d); mod_ld(ws, b_ada_, l, DM + d, ms_[it]); mod_ld(ws, b_ada_, l, d, mh_[it]); }
#pragma unroll
        for (int it = 0; it < 8; ++it) { const int i = F.tid + it * NTHR, d = i >> 1, half = i & 1; const f32x4 w = wq[it];
            wfT[(half * 4 + 0) * DM + d] = w.x; wfT[(half * 4 + 1) * DM + d] = w.y; wfT[(half * 4 + 2) * DM + d] = w.z; wfT[(half * 4 + 3) * DM + d] = w.w; }
#pragma unroll
        for (int it = 0; it < 4; ++it) { const int d = F.tid + it * NTHR; gaL[d] = gm_[it] * (1.f + mod_sum(ms_[it])); gbL[d] = mod_sum(mh_[it]); }
    }
    if (MODE != 0) {
        { float m2_[4][5];
#pragma unroll
          for (int it = 0; it < 4; ++it) mod_ld(ws, b_ada_, lprev, 5 * DM + F.tid + it * NTHR, m2_[it]);
#pragma unroll
          for (int it = 0; it < 4; ++it) g2L[F.tid + it * NTHR] = mod_sum(m2_[it]); }
        if (F.tid < NEXP) hb[16 + F.tid] = ((int)__hip_atomic_load(F.ctl + CW_CNT + 64 * lprev + F.tid, RLX_AGENT) + 255) & ~255;
        __syncthreads();
        if (F.tid == 0) { int a = 0; for (int e = 0; e < NEXP; ++e) { hb[e] = a; a += hb[16 + e]; } }
    }
    __syncthreads();
    const bf16* YB = (const bf16*)(ws + WS_YB);
    f32x4 vA[8], vB[8]; u32x2 xA[8], xB[8], yA0[8], yA1[8], yB0[8], yB1[8];
#define N1_LOAD(V, XR, Y0, Y1, rr) do { const int t_ = c * 32 + F.wave * 4 + (rr);                                                             \
        if (MODE == 0) { _Pragma("unroll") for (int j = 0; j < 8; ++j) V[j] = *(const GAS f32x4*)((const float*)xin + (size_t)t_ * DM + 256 * j + 4 * F.lane); }   \
        else { _Pragma("unroll") for (int j = 0; j < 8; ++j) XR[j] = *(const GAS u32x2*)((const bf16*)xin + (size_t)t_ * DM + 256 * j + 4 * F.lane); }              \
        if (MODE != 0) { const int r0_ = __builtin_amdgcn_readlane(rowA, (rr)), r1_ = __builtin_amdgcn_readlane(rowB, (rr));                      \
            _Pragma("unroll") for (int j = 0; j < 8; ++j) { const int d = 256 * j + 4 * F.lane;                                                    \
                Y0[j] = *(const GAS u32x2*)(YB + (size_t)r0_ * DM + d); Y1[j] = *(const GAS u32x2*)(YB + (size_t)r1_ * DM + d); } } } while (0)
#define N1_PROC(V, XR, Y0, Y1, rr) do { const int rl = F.wave * 4 + (rr), t = c * 32 + rl;                                                      \
        if (MODE != 0) { _Pragma("unroll") for (int j = 0; j < 8; ++j) { V[j].x = bf_lo(XR[j].x); V[j].y = bf_hi(XR[j].x); V[j].z = bf_lo(XR[j].y); V[j].w = bf_hi(XR[j].y); } }   \
        if (MODE != 0) { const float w0 = __builtin_bit_cast(float, __builtin_amdgcn_readlane(__builtin_bit_cast(int, gwA), (rr))), w1 = __builtin_bit_cast(float, __builtin_amdgcn_readlane(__builtin_bit_cast(int, gwB), (rr))); \
            _Pragma("unroll") for (int j = 0; j < 8; ++j) { const int d = 256 * j + 4 * F.lane;                                                    \
                const f32x4 g2 = *(const LAS f32x4*)(g2L + d); const u32x2 y0 = Y0[j], y1 = Y1[j];                                                 \
                f32x4 y; y.x = w0 * bf_lo(y0.x) + w1 * bf_lo(y1.x); y.y = w0 * bf_hi(y0.x) + w1 * bf_hi(y1.x); y.z = w0 * bf_lo(y0.y) + w1 * bf_lo(y1.y); y.w = w0 * bf_hi(y0.y) + w1 * bf_hi(y1.y); \
                V[j] = V[j] + g2 * y;                                                                                                               \
                if (MODE == 2) *(GAS f32x4*)((float*)xout + (size_t)t * DM + d) = V[j];                                                            \
                else { u32x2 o_; o_.x = cvt_pk_bf16(V[j].x, V[j].y); o_.y = cvt_pk_bf16(V[j].z, V[j].w); *(GAS u32x2*)((bf16*)xout + (size_t)t * DM + d) = o_; } } }   \
        if (MODE != 2) {                                                                                                                           \
            float ss = 0.f;                                                                                                                        \
            _Pragma("unroll") for (int j = 0; j < 8; ++j) ss += (V[j].x * V[j].x + V[j].y * V[j].y) + (V[j].z * V[j].z + V[j].w * V[j].w);         \
            const float rs = rsqrtf(wave_sum(ss) * (1.f / DM) + EPSN);                                                                             \
            float fz[8] = {0.f, 0.f, 0.f, 0.f, 0.f, 0.f, 0.f, 0.f};                                                                                \
            unsigned char* hrow = ws + WS_H + (size_t)t * DM;                                   \
            _Pragma("unroll") for (int j = 0; j < 8; ++j) { const int d = 256 * j + 4 * F.lane;                                                    \
                const f32x4 h = V[j] * rs * *(const LAS f32x4*)(gaL + d) + *(const LAS f32x4*)(gbL + d);                                           \
                *(GAS unsigned*)(hrow + d) = cvt_pk4_fp8(h.x * H8_SCALE, h.y * H8_SCALE, h.z * H8_SCALE, h.w * H8_SCALE);                          \
                _Pragma("unroll") for (int q = 0; q < 8; ++q) { const f32x4 w = *(const LAS f32x4*)(wfT + q * DM + d); fz[q] += (h.x * w.x + h.y * w.y) + (h.z * w.z + h.w * w.w); } } \
            _Pragma("unroll") for (int q = 0; q < 8; ++q) fz[q] = wave_sum(fz[q]);                                                                 \
            if (F.lane < 8) { float z = fz[0];                                                                                                     \
                _Pragma("unroll") for (int q = 1; q < 8; ++q) z = (F.lane == q) ? fz[q] : z;                                                       \
                z += *(const GAS float*)(c_bf_ + l * 8 + F.lane);                                                                                  \
                lf[rl * 8 + F.lane] = fminf(z, 0.f) - 0.6931471805599453f * __builtin_amdgcn_logf(1.f + __builtin_amdgcn_exp2f(-LOG2E * fabsf(z))); } } } while (0)
    for (int c = F.vcu; c < SEQ / 32; c += F.G) {
        int rowA = 0, rowB = 0; float gwA = 0.f, gwB = 0.f;
        if (MODE != 0) { const int t_ = c * 32 + F.wave * 4 + (F.lane & 3);
            const int* te = (const int*)(ws + WS_TOKE) + 2 * t_; const int* tp = (const int*)(ws + WS_TOKP) + 2 * t_; const float* tw = (const float*)(ws + WS_TOKW) + 2 * t_;
            rowA = hb[*(const GAS int*)te] + *(const GAS int*)tp; rowB = hb[*(const GAS int*)(te + 1)] + *(const GAS int*)(tp + 1); gwA = *(const GAS float*)tw; gwB = *(const GAS float*)(tw + 1); }
        N1_LOAD(vA, xA, yA0, yA1, 0); N1_LOAD(vB, xB, yB0, yB1, 1);
        N1_PROC(vA, xA, yA0, yA1, 0); N1_LOAD(vA, xA, yA0, yA1, 2);
        N1_PROC(vB, xB, yB0, yB1, 1); N1_LOAD(vB, xB, yB0, yB1, 3);
        N1_PROC(vA, xA, yA0, yA1, 2); N1_PROC(vB, xB, yB0, yB1, 3);
        if (MODE != 2) {
            __syncthreads();
            if (F.tid < 8) { float a = 0.f; float* floc = (float*)(ws + WS_FLOC);
                for (int r = 0; r < 32; ++r) { a += lf[r * 8 + F.tid]; *(GAS float*)(floc + (size_t)(c * 32 + r) * 8 + F.tid) = a; }
                *(GAS float*)((float*)(ws + WS_TOT) + c * 8 + F.tid) = a; }
            __syncthreads();
        }
    }
#undef N1_LOAD
#undef N1_PROC
}

__device__ __forceinline__ void fkl_fixup(const Frame& F0) {
    unsigned char* const ws = opq(F0.ws); Frame F = F0; F.tid = opq_tid(F0.wave); F.lane = F.tid & 63; F.lds = opq(F0.lds);
    LAS float* preL = (LAS float*)(F.lds + AUX_OFF + 8192);
    const float* tot = (const float*)(ws + WS_TOT);
    for (int c = F.vcu; c < SEQ / 32; c += F.G) {
        { const int h = F.wave; double s = 0.0;
#pragma unroll
            for (int q = 0; q < 4; ++q) { const int cc = 4 * F.lane + q; if (cc < c) s += (double)*(const GAS float*)(tot + cc * 8 + h); }
            float hi_ = (float)s, lo_ = (float)(s - (double)hi_);
            hi_ = wave_sum(hi_); lo_ = wave_sum(lo_);
            if (F.lane == 0) preL[h] = hi_ + lo_; }
        __syncthreads();
        if (F.tid < 256) { const int r = F.tid >> 3, h = F.tid & 7, t = c * 32 + r;
            *(GAS float*)((float*)(ws + WS_FKL) + (size_t)h * SEQ + t) = (preL[h] + *(const GAS float*)((const float*)(ws + WS_FLOC) + (size_t)t * 8 + h)) * -11.313708498984761f; }
        __syncthreads();
    }
}

__device__ __forceinline__ void phase_small_item(const Frame& F0, int l, int item) {
    unsigned char* const ws = opq(F0.ws); Frame F = F0; F.tid = opq_tid(F0.wave); F.lane = F.tid & 63; F.lds = opq(F0.lds);
    const int fr = F.lane & 15, fq = F.lane >> 4, w = F.wave;
    const bf16* Z = (const bf16*)(ws + WS_Z); unsigned char* YC = ws + WS_YCAT;
    f32x4 acc[8];
#pragma unroll
    for (int m = 0; m < 8; ++m) acc[m] = (f32x4){0.f, 0.f, 0.f, 0.f};
    const float* a_bs_ = opq(karg(8)); const float* b_scale_ = opq(karg(11));
    if (item < 256) {
        const int blk = item >> 2, h = item & 3;
        const bf16* VN = (const bf16*)(ws + WS_VN) + (size_t)(blk * 128) * 512 + h * 128 + 16 * w + fr;
        const bf16* WM = (const bf16*)(ws + WS_WM) + ((size_t)(l * 4 + h) * 128) * 128;
        bf16x8 yb[4]; u32x2 ue[8]; float bse[8];
#pragma unroll
        for (int m = 0; m < 8; ++m) { const int tl = 16 * m + fr; bse[m] = *(const GAS float*)(a_bs_ + l * 512 + h * 128 + tl); ue[m] = *(const GAS u32x2*)(Z + (size_t)(blk * 128 + tl) * NZ + h * 128 + 16 * w + 4 * fq); }
#pragma unroll
        for (int ks = 0; ks < 4; ++ks)
#pragma unroll
            for (int j = 0; j < 8; ++j) yb[ks][j] = (short)*(const GAS bf16*)(VN + (size_t)(ks * 32 + 8 * fq + j) * 512);
#pragma unroll
        for (int m = 0; m < 8; ++m)
#pragma unroll
            for (int ks = 0; ks < 4; ++ks) { const bf16x8 xa = *(const GAS bf16x8*)(WM + (size_t)(16 * m + fr) * 128 + ks * 32 + 8 * fq);
                acc[m] = __builtin_amdgcn_mfma_f32_16x16x32_bf16(yb[ks], xa, acc[m], 0, 0, 0); }
#pragma unroll
        for (int m = 0; m < 8; ++m) { const int tl = 16 * m + fr, t = blk * 128 + tl, col = h * 128 + 16 * w + 4 * fq;
            const float bsv = bse[m]; const u32x2 u = ue[m];
            *(GAS unsigned*)(YC + (size_t)t * DM + col) = cvt_pk4_fp8(H8_SCALE * bf_lo(u.x) * (acc[m][0] + bsv), H8_SCALE * bf_hi(u.x) * (acc[m][1] + bsv), H8_SCALE * bf_lo(u.y) * (acc[m][2] + bsv), H8_SCALE * bf_hi(u.y) * (acc[m][3] + bsv)); }
    } else {
        const int rb = (item - 256) >> 2, g = (item - 256) & 3;
        const int wnd = 2 << g, r0 = rb * 128;
        LAS bf16* pt = (LAS bf16*)(F.lds + 86016);
        LAS bf16* dt = (LAS bf16*)F.lds;
        const bf16* BWT = (const bf16*)(ws + WS_BWT) + ((size_t)(l * 4 + g) * 128) * 128;
        bf16x8 yb[4];
#pragma unroll
        for (int ks = 0; ks < 4; ++ks) yb[ks] = *(const GAS bf16x8*)(BWT + (size_t)(16 * w + fr) * 128 + ks * 32 + 8 * fq);
        const f32x4 bsc = *(const GAS f32x4*)(b_scale_ + l * 512 + g * 128 + 16 * w + 4 * fq);
        u32x4 pv[5];
#pragma unroll
        for (int it = 0; it < 5; ++it) { const int i = F.tid + it * NTHR, rr = i >> 4, cc = (i & 15) * 8, tg = r0 - 16 + rr;
            pv[it] = (u32x4){0u, 0u, 0u, 0u}; if (i < 144 * 16 && tg >= 0) pv[it] = *(const GAS u32x4*)(Z + (size_t)tg * NZ + 1024 + g * 128 + cc); }
        __syncthreads();
#pragma unroll
        for (int it = 0; it < 5; ++it) { const int i = F.tid + it * NTHR, rr = i >> 4, cc = (i & 15) * 8;
            if (i < 144 * 16) *(LAS u32x4*)(pt + rr * 128 + cc) = pv[it]; }
        __syncthreads();
        { const int c = F.tid & 127, rg = F.tid >> 7;
            float sum = 0.f;
            for (int j = 1; j < wnd; ++j) sum += bf_lo((unsigned)pt[(16 + 32 * rg - j) * 128 + c]);
            for (int i = 0; i < 32; ++i) { const int tl = 32 * rg + i, tg = r0 + tl; const float pv = bf_lo((unsigned)pt[(16 + tl) * 128 + c]);
                sum += pv;
                const float cnt = (float)((tg + 1 < wnd) ? (tg + 1) : wnd);
                const float dv = sum / cnt - pv;
                dt[tl * 136 + c] = (bf16)(cvt_pk_bf16(dv, 0.f) & 0xffffu);
                sum -= bf_lo((unsigned)pt[(16 + tl - (wnd - 1)) * 128 + c]); } }
        __syncthreads();
#pragma unroll
        for (int m = 0; m < 8; ++m)
#pragma unroll
            for (int ks = 0; ks < 4; ++ks) { const bf16x8 xa = *(const LAS bf16x8*)(dt + (16 * m + fr) * 136 + ks * 32 + 8 * fq);
                acc[m] = __builtin_amdgcn_mfma_f32_16x16x32_bf16(yb[ks], xa, acc[m], 0, 0, 0); }
        __syncthreads();
#pragma unroll
        for (int m = 0; m < 8; ++m) { const int t = rb * 128 + 16 * m + fr, col = 512 + g * 128 + 16 * w + 4 * fq;
            *(GAS unsigned*)(YC + (size_t)t * DM + col) = cvt_pk4_fp8(H8_SCALE * acc[m][0] * bsc.x, H8_SCALE * acc[m][1] * bsc.y, H8_SCALE * acc[m][2] * bsc.z, H8_SCALE * acc[m][3] * bsc.w); }
    }
}

__device__ __forceinline__ void phase_norm2_route(const Frame& F0, int l) {
    unsigned char* const ws = opq(F0.ws); Frame F = F0; F.tid = opq_tid(F0.wave); F.lane = F.tid & 63; F.lds = opq(F0.lds);
    LAS float* wrT = (LAS float*)F.lds;
    LAS float* gaL = (LAS float*)(F.lds + AUX_OFF);
    LAS float* gbL = (LAS float*)(F.lds + AUX_OFF + 8192);
    LAS int* lcnt = (LAS int*)(F.lds + AUX_OFF + 16384);
    const float* const w_router_ = karg(16); const float* const g_ffn_ = karg(5); const float* const b_ada_ = karg(3); const float* const b_router_ = karg(17);
    {
        f32x4 wq[16]; float gm_[4], ms_[4][5], mh_[4][5];
#pragma unroll
        for (int it = 0; it < 16; ++it) { const int i = F.tid + it * NTHR, d = i >> 2, q = i & 3; wq[it] = *(const GAS f32x4*)(w_router_ + (size_t)d * 16 + q * 4); }
#pragma unroll
        for (int it = 0; it < 4; ++it) { const int d = F.tid + it * NTHR; gm_[it] = *(const GAS float*)(g_ffn_ + (size_t)l * DM + d); mod_ld(ws, b_ada_, l, 4 * DM + d, ms_[it]); mod_ld(ws, b_ada_, l, 3 * DM + d, mh_[it]); }
#pragma unroll
        for (int it = 0; it < 16; ++it) { const int i = F.tid + it * NTHR, d = i >> 2, q = i & 3; const f32x4 w = wq[it];
            wrT[(q * 4 + 0) * DM + d] = w.x; wrT[(q * 4 + 1) * DM + d] = w.y; wrT[(q * 4 + 2) * DM + d] = w.z; wrT[(q * 4 + 3) * DM + d] = w.w; }
#pragma unroll
        for (int it = 0; it < 4; ++it) { const int d = F.tid + it * NTHR; gaL[d] = gm_[it] * (1.f + mod_sum(ms_[it])); gbL[d] = mod_sum(mh_[it]); }
    }
    const bf16* X1 = (const bf16*)(ws + WS_X1);
    float brt[16];
#pragma unroll
    for (int e = 0; e < 16; ++e) brt[e] = *(const GAS float*)(b_router_ + e);
    for (int c = F.vcu; c < SEQ / 32; c += F.G) {
        if (F.tid < 32) lcnt[F.tid] = 0;
        __syncthreads();
        int my_e0 = 0, my_e1 = 0, my_r0 = 0, my_r1 = 0; float my_w0 = 0.f, my_w1 = 0.f;
        f32x4 vA[8], vB[8]; u32x2 xA[8], xB[8];
#define N2_LOAD(V, rr) do { const int t_ = c * 32 + F.wave * 4 + (rr); _Pragma("unroll") for (int j = 0; j < 8; ++j) x##V[j] = *(const GAS u32x2*)(X1 + (size_t)t_ * DM + 256 * j + 4 * F.lane); } while (0)
#define N2_CVT(V) do { _Pragma("unroll") for (int j = 0; j < 8; ++j) { v##V[j].x = bf_lo(x##V[j].x); v##V[j].y = bf_hi(x##V[j].x); v##V[j].z = bf_lo(x##V[j].y); v##V[j].w = bf_hi(x##V[j].y); } } while (0)
#define N2_ROUTE(LG, rr) do {                                                                                                                      \
            float sc[16], sel[16];                                                                                                                 \
            _Pragma("unroll") for (int e = 0; e < 16; ++e) { sc[e] = __builtin_amdgcn_rcpf(1.f + __builtin_amdgcn_exp2f(-LOG2E * LG[e])); sel[e] = sc[e] + brt[e]; }                      \
            int bg = 0; float bgs = -INFINITY;                                                                                                     \
            _Pragma("unroll") for (int g = 0; g < 4; ++g) { float a = -INFINITY, b = -INFINITY;                                                    \
                _Pragma("unroll") for (int i = 0; i < 4; ++i) { const float x = sel[g * 4 + i]; if (x > a) { b = a; a = x; } else if (x > b) b = x; } \
                if (a + b > bgs) { bgs = a + b; bg = g; } }                                                                                        \
            int e0 = 0, e1 = 0; float a = -INFINITY, b = -INFINITY, s0 = 0.f, s1 = 0.f;                                                            \
            _Pragma("unroll") for (int g = 0; g < 4; ++g)                                                                                          \
                _Pragma("unroll") for (int i = 0; i < 4; ++i) { const int e = g * 4 + i; const float x = sel[e];                                   \
                    if (g == bg) { if (x > a) { b = a; e1 = e0; s1 = s0; a = x; e0 = e; s0 = sc[e]; } else if (x > b) { b = x; e1 = e; s1 = sc[e]; } } } \
            const float inv = 1.f / (s0 + s1);                                                                                                     \
            if (F.lane == (rr)) { my_e0 = e0; my_e1 = e1; my_w0 = s0 * inv; my_w1 = s1 * inv; } } while (0)
#define N2_PROC2(V, W, rr, NEXT_LOADS) do { const int t = c * 32 + F.wave * 4 + (rr);                                                                       \
            N2_CVT(A); N2_CVT(B);                                                                                                                  \
            float ss0 = 0.f, ss1 = 0.f;                                                                                                            \
            _Pragma("unroll") for (int j = 0; j < 8; ++j) { ss0 += (V[j].x * V[j].x + V[j].y * V[j].y) + (V[j].z * V[j].z + V[j].w * V[j].w); ss1 += (W[j].x * W[j].x + W[j].y * W[j].y) + (W[j].z * W[j].z + W[j].w * W[j].w); } \
            const float rs0 = rsqrtf(wave_sum(ss0) * (1.f / DM) + EPSN), rs1 = rsqrtf(wave_sum(ss1) * (1.f / DM) + EPSN);                           \
            float lg0[16], lg1[16];                                                                                                                \
            _Pragma("unroll") for (int e = 0; e < 16; ++e) { lg0[e] = 0.f; lg1[e] = 0.f; }                                                         \
            unsigned char* hrow = ws + WS_H + (size_t)t * DM;                          \
            _Pragma("unroll") for (int j = 0; j < 8; ++j) { const int d = 256 * j + 4 * F.lane;                                                    \
                const f32x4 ga_ = *(const LAS f32x4*)(gaL + d), gb_ = *(const LAS f32x4*)(gbL + d);                                                 \
                const f32x4 h0 = V[j] * rs0 * ga_ + gb_, h1 = W[j] * rs1 * ga_ + gb_;                                                              \
                *(GAS unsigned*)(hrow + d) = cvt_pk4_fp8(h0.x * H8_SCALE, h0.y * H8_SCALE, h0.z * H8_SCALE, h0.w * H8_SCALE);                      \
                *(GAS unsigned*)(hrow + DM + d) = cvt_pk4_fp8(h1.x * H8_SCALE, h1.y * H8_SCALE, h1.z * H8_SCALE, h1.w * H8_SCALE);                 \
                _Pragma("unroll") for (int e = 0; e < 16; ++e) { const f32x4 w = *(const LAS f32x4*)(wrT + e * DM + d);                            \
                    lg0[e] += (h0.x * w.x + h0.y * w.y) + (h0.z * w.z + h0.w * w.w); lg1[e] += (h1.x * w.x + h1.y * w.y) + (h1.z * w.z + h1.w * w.w); } } \
            NEXT_LOADS;                                                              \
            _Pragma("unroll") for (int e = 0; e < 16; ++e) { lg0[e] = wave_sum(lg0[e]); lg1[e] = wave_sum(lg1[e]); }                               \
            N2_ROUTE(lg0, (rr)); N2_ROUTE(lg1, (rr) + 1); } while (0)
        N2_LOAD(A, 0); N2_LOAD(B, 1);
        N2_PROC2(vA, vB, 0, N2_LOAD(A, 2); N2_LOAD(B, 3));
        N2_PROC2(vA, vB, 2, (void)0);
        if (F.lane < 4) { my_r0 = __hip_atomic_fetch_add(&lcnt[my_e0], 1, __ATOMIC_RELAXED, __HIP_MEMORY_SCOPE_WORKGROUP); my_r1 = __hip_atomic_fetch_add(&lcnt[my_e1], 1, __ATOMIC_RELAXED, __HIP_MEMORY_SCOPE_WORKGROUP); }
        __syncthreads();
        if (F.tid < 16) lcnt[16 + F.tid] = (int)__hip_atomic_fetch_add(F.ctl + CW_CNT + 64 * l + F.tid, (unsigned)lcnt[F.tid], RLX_AGENT);
        __syncthreads();
        if (F.lane < 4) { const int t = c * 32 + F.wave * 4 + F.lane;
            const int p0 = lcnt[16 + my_e0] + my_r0, p1 = lcnt[16 + my_e1] + my_r1;
            int* list = (int*)(ws + WS_LIST);
            *(GAS int*)(list + my_e0 * SEQ + p0) = t; *(GAS int*)(list + my_e1 * SEQ + p1) = t;
            *(GAS int*)((int*)(ws + WS_TOKE) + 2 * t) = my_e0; *(GAS int*)((int*)(ws + WS_TOKE) + 2 * t + 1) = my_e1;
            *(GAS int*)((int*)(ws + WS_TOKP) + 2 * t) = p0; *(GAS int*)((int*)(ws + WS_TOKP) + 2 * t + 1) = p1;
            *(GAS float*)((float*)(ws + WS_TOKW) + 2 * t) = my_w0; *(GAS float*)((float*)(ws + WS_TOKW) + 2 * t + 1) = my_w1; }
        __syncthreads();
    }
#undef N2_LOAD
#undef N2_CVT
#undef N2_PROC2
#undef N2_ROUTE
}

struct MoeOrder {
    int G, c, total, K, nct; const char* Bt; size_t estride; const int* list; LAS int* tab;
    __device__ __forceinline__ bool next(int i, gm::Unit& u) const {
        const int L = i * G + c; if (L >= total) return false;
        const int q = L / nct, ct = L - q * nct;
        int e = 0;
#pragma unroll
        for (int k = 1; k < NEXP; ++k) e += (q >= tab[k]) ? 1 : 0;
        e = __builtin_amdgcn_readfirstlane(e);
        const int rt = q - __builtin_amdgcn_readfirstlane(tab[e]);
        u.e = e; u.rt = rt; u.arow = (__builtin_amdgcn_readfirstlane(tab[e]) + rt) * 256; u.orow = u.arow; u.ocol = ct * 256;
        u.Bp = Bt + (size_t)e * estride + (size_t)ct * 256 * K * 2; return true;
    }
    __device__ __forceinline__ int row_of(const gm::Unit& u, int r) const {
        const int p = u.rt * 256 + r, n = tab[32 + u.e], pc = p < n ? p : n - 1;
        const int v = *(const GAS int*)(list + u.e * SEQ + pc);
        return (p < n) ? v : 0;
    }
};
__device__ __forceinline__ void moe_table(const Frame& F, int l, LAS int* tab) {
    const int tid = opq_tid(F.wave);
    __syncthreads();
    if (tid < NEXP) tab[32 + tid] = (int)__hip_atomic_load(F.ctl + CW_CNT + 64 * l + tid, RLX_AGENT);
    __syncthreads();
    if (tid == 0) { int a = 0;
        for (int e = 0; e < NEXP; ++e) { tab[e] = a; a += (tab[32 + e] + 255) >> 8; }
        tab[16] = a; }
    __syncthreads();
}

constexpr int ATT_CH = 24;
struct MixTab { LAS int* jlo; LAS int* items; LAS int* nitems; LAS float* fend; LAS int* scan; };
__device__ __forceinline__ MixTab mix_tab_ptrs(LAS unsigned char* lds) {
    MixTab T; T.jlo = (LAS int*)(lds + 69632); T.items = (LAS int*)(lds + 69632 + 1024); T.nitems = (LAS int*)(lds + 69632 + 1024 + 8192); T.fend = (LAS float*)(lds + 69632 + 1024 + 8192 + 64);
    T.scan = (LAS int*)(lds + 69632 + 1024 + 8192 + 64 + 4096); return T;
}
__device__ __forceinline__ void mix_build_table(const Frame& F0, int l, const MixTab& T) {
    unsigned char* const ws = opq(F0.ws); const int tid = opq_tid(F0.wave);
    const float* FKL = (const float*)(ws + WS_FKL);
    for (int i = tid; i < 1024; i += NTHR) T.fend[i] = *(const GAS float*)(FKL + (size_t)(i >> 7) * SEQ + (i & 127) * 64 + 63);
    float gq = 0.f, gk = 0.f; const float* const c_qg_ = karg(12); const float* const c_kg_ = karg(13);
    { const int ln = tid & 63; gq = fmaxf(fabsf(*(const GAS float*)(c_qg_ + l * 128 + ln)), fabsf(*(const GAS float*)(c_qg_ + l * 128 + 64 + ln))); gk = fmaxf(fabsf(*(const GAS float*)(c_kg_ + l * 128 + ln)), fabsf(*(const GAS float*)(c_kg_ + l * 128 + 64 + ln)));
      gq = wave_max(gq); gk = wave_max(gk); }
    const float thr = (2.f * 1.01f * 11.313708498984761f * gq * gk + 22.f) * 11.313708498984761f;
    __syncthreads();
    int nfull = 0, nrem = 0, jl = 0, nt = 0;
    if (tid < 256) { const int h = tid >> 5, qb = tid & 31; const float f0 = *(const GAS float*)(FKL + (size_t)h * SEQ + qb * 256);
        for (int j = 0; j < 4 * qb; ++j) jl += (T.fend[h * 128 + j] - f0 <= -thr) ? 1 : 0;
        nt = 4 * (qb + 1) - jl; nfull = nt / ATT_CH; nrem = (nt % ATT_CH) ? 1 : 0; T.jlo[tid] = jl | ((nfull + nrem) << 8); }
    if (tid < 256) { T.scan[tid] = nfull; T.scan[256 + tid] = nrem; }
    __syncthreads();
    for (int o = 1; o < 256; o <<= 1) { int a = 0, b = 0; if (tid < 256 && tid >= o) { a = T.scan[tid - o]; b = T.scan[256 + tid - o]; } __syncthreads();
        if (tid < 256) { T.scan[tid] += a; T.scan[256 + tid] += b; } __syncthreads(); }
    if (tid < 256) { const int totf = T.scan[255], pf = T.scan[tid] - nfull, pr = totf + T.scan[256 + tid] - nrem, jb = 4 * ((tid & 31) + 1);
        for (int c = 0; c < nfull; ++c) T.items[pf + c] = tid | (c << 8) | ((jb - (c + 1) * ATT_CH) << 12) | (ATT_CH << 20);
        if (nrem) T.items[pr] = tid | (nfull << 8) | (jl << 12) | ((nt - nfull * ATT_CH) << 20);
        if (tid == 255) T.nitems[0] = totf + T.scan[511]; }
    __syncthreads();
}
__device__ __forceinline__ void attn_combine_block(const Frame& F0, const int b, const int nch) {
    unsigned char* const ws = opq(F0.ws); const int tid = opq_tid(F0.wave);
    const bf16* PART = (const bf16*)(ws + WS_PART); const float* MLb = (const float*)(ws + WS_ML); unsigned char* YC = ws + WS_YCAT;
    {
        const int h = b >> 5, qb = b & 31, row = tid >> 1, half = tid & 1;
        float m[8], w[8], mx = -3.0e38f, ws_ = 0.f;
#pragma unroll
        for (int c = 0; c < 8; ++c) { if (c < nch) { const f32x2 v = *(const GAS f32x2*)(MLb + ((size_t)(b * 8 + c) * 256 + row) * 2); m[c] = v.x; w[c] = v.y; mx = fmaxf(mx, v.x); } else { m[c] = -3.0e38f; w[c] = 0.f; } }
#pragma unroll
        for (int c = 0; c < 8; ++c) { w[c] = (c < nch) ? w[c] * __builtin_amdgcn_exp2f((m[c] - mx) * at::C2) : 0.f; ws_ += w[c]; }
        const float inv = 1.f / ws_;
        float acc[64];
#pragma unroll
        for (int i = 0; i < 64; ++i) acc[i] = 0.f;
#pragma unroll
        for (int c = 0; c < 8; ++c) { if (c < nch) { const bf16* p = PART + ((size_t)(b * 8 + c) * 256 + row) * 128 + half * 64; const float wc = w[c] * inv;
#pragma unroll
            for (int q = 0; q < 8; ++q) { const u32x4 v = *(const GAS u32x4*)(p + q * 8);
                acc[q * 8 + 0] += wc * bf_lo(v.x); acc[q * 8 + 1] += wc * bf_hi(v.x); acc[q * 8 + 2] += wc * bf_lo(v.y); acc[q * 8 + 3] += wc * bf_hi(v.y);
                acc[q * 8 + 4] += wc * bf_lo(v.z); acc[q * 8 + 5] += wc * bf_hi(v.z); acc[q * 8 + 6] += wc * bf_lo(v.w); acc[q * 8 + 7] += wc * bf_hi(v.w); } } }
        unsigned char* o = YC + (size_t)(qb * 256 + row) * DM + 1024 + h * 128 + half * 64;
#pragma unroll
        for (int q = 0; q < 4; ++q) { u32x4 v;
            v.x = cvt_pk4_fp8(H8_SCALE * acc[q * 16 + 0], H8_SCALE * acc[q * 16 + 1], H8_SCALE * acc[q * 16 + 2], H8_SCALE * acc[q * 16 + 3]); v.y = cvt_pk4_fp8(H8_SCALE * acc[q * 16 + 4], H8_SCALE * acc[q * 16 + 5], H8_SCALE * acc[q * 16 + 6], H8_SCALE * acc[q * 16 + 7]);
            v.z = cvt_pk4_fp8(H8_SCALE * acc[q * 16 + 8], H8_SCALE * acc[q * 16 + 9], H8_SCALE * acc[q * 16 + 10], H8_SCALE * acc[q * 16 + 11]); v.w = cvt_pk4_fp8(H8_SCALE * acc[q * 16 + 12], H8_SCALE * acc[q * 16 + 13], H8_SCALE * acc[q * 16 + 14], H8_SCALE * acc[q * 16 + 15]);
            *(GAS u32x4*)(o + q * 16) = v; }
    }
}

struct MoeDynOrder {
    int total, K; const char* Bt; size_t estride; LAS int* tab; gu32* ticket; gu32* ready; gu32* tmo; LAS unsigned* slot;
    __device__ __forceinline__ bool next(int, gm::Unit& u) const {
        if (__builtin_amdgcn_readfirstlane(threadIdx.x >> 6) == 0) {
            unsigned T = 0u;
            if ((threadIdx.x & 63) == 0) T = __hip_atomic_fetch_add(ticket, 1u, RLX_AGENT);
            T = __builtin_amdgcn_readfirstlane(T);
            if (T < (unsigned)total) {
                gu32* w = ready + 16 * (T >> 3); unsigned sp = 0u;
                while ((unsigned)__builtin_amdgcn_readfirstlane(__hip_atomic_load(w, RLX_AGENT)) < 64u) {
                    __builtin_amdgcn_s_sleep(2);
                    if ((++sp & 255u) == 0u) { if (__hip_atomic_load(tmo, RLX_AGENT) != 0u) break; if (sp > (1u << 20)) { __hip_atomic_store(tmo, 1u, RLX_AGENT); break; } } }
                __builtin_amdgcn_fence(__ATOMIC_ACQUIRE, "agent");
                asm volatile("s_waitcnt vmcnt(0)" ::: "memory");
            }
            if ((threadIdx.x & 63) == 0) slot[0] = T;
        }
        asm volatile("s_waitcnt lgkmcnt(0)" ::: "memory"); __builtin_amdgcn_s_barrier(); asm volatile("" ::: "memory");
        const unsigned T = (unsigned)__builtin_amdgcn_readfirstlane((int)slot[0]);
        if (T >= (unsigned)total) return false;
        const int q = (int)(T >> 3), ct = (int)(T & 7);
        int e = 0;
#pragma unroll
        for (int k = 1; k < NEXP; ++k) e += (q >= tab[k]) ? 1 : 0;
        e = __builtin_amdgcn_readfirstlane(e);
        u.e = e; u.rt = q - __builtin_amdgcn_readfirstlane(tab[e]); u.arow = q * 256; u.orow = u.arow; u.ocol = ct * 256;
        u.Bp = Bt + (size_t)e * estride + (size_t)ct * 256 * K * 2; return true;
    }
    __device__ __forceinline__ int row_of(const gm::Unit&, int) const { return 0; }
};
struct EpiZ {
    static constexpr bool PERM = true;
    unsigned char* wsb; int l; LAS float* Pt0;
    __device__ __forceinline__ void operator()(f32x4 (&acc)[2][2][4][2], const gm::Unit& u, int wr, int wc, int fr0, int fq0) const {
        int fr = fr0, fq = fq0; asm volatile("" : "+v"(fr), "+v"(fq));
        unsigned char* const ws = opq(wsb); LAS float* const Pt = opq(Pt0);
        bf16* const O = (bf16*)(ws + WS_Z); bf16* const QN = (bf16*)(ws + WS_QN); bf16* const KN = (bf16*)(ws + WS_KN); bf16* const VN = (bf16*)(ws + WS_VN);
        const int row0 = u.orow + wr * 64 + fr, col0 = u.ocol + wc * 32 + 8 * fq;
        const bool isv = (u.ocol >= 512 && u.ocol < 1024), isq = (u.ocol >= 1536 && u.ocol < 2560), isk = (u.ocol >= 2560 && u.ocol < 3584);
        if (u.ocol < 1024) {
#pragma unroll
            for (int ai = 0; ai < 2; ++ai)
#pragma unroll
                for (int bj = 0; bj < 2; ++bj)
#pragma unroll
                    for (int m = 0; m < 4; ++m)
#pragma unroll
                        for (int n = 0; n < 2; ++n)
#pragma unroll
                            for (int j = 0; j < 4; ++j) acc[ai][bj][m][n][j] = gelu_t(acc[ai][bj][m][n][j]);
        }
        if (isv || isq || isk) {
#pragma unroll
            for (int ai = 0; ai < 2; ++ai)
#pragma unroll
                for (int m = 0; m < 4; ++m)
#pragma unroll
                    for (int bj = 0; bj < 2; ++bj) { const f32x4 a = acc[ai][bj][m][0], b = acc[ai][bj][m][1];
                        float ss = (a[0] * a[0] + a[1] * a[1]) + (a[2] * a[2] + a[3] * a[3]) + (b[0] * b[0] + b[1] * b[1]) + (b[2] * b[2] + b[3] * b[3]);
                        ss += xor_f<16>(ss);
                        { auto rr = __builtin_amdgcn_permlane32_swap(__float_as_uint(ss), __float_as_uint(ss), false, false); ss = __uint_as_float(rr[0]) + __uint_as_float(rr[1]); }
                        if (fq == 0) Pt[((ai * 128 + wr * 64 + m * 16 + fr) * 2 + bj) * 4 + wc] = ss; }
            asm volatile("s_waitcnt lgkmcnt(0)" ::: "memory"); __builtin_amdgcn_s_barrier(); asm volatile("" ::: "memory");
            const float* gp = isv ? karg(9) + l * 512 + (u.ocol - 512) + wc * 32 + 8 * fq : karg(isq ? 12 : 13) + l * 128 + wc * 32 + 8 * fq;
#pragma unroll
            for (int bj = 0; bj < 2; ++bj) {
                const f32x4 g0 = *(const GAS f32x4*)(gp + (isv ? bj * 128 : 0)), g1 = *(const GAS f32x4*)(gp + (isv ? bj * 128 : 0) + 4);
#pragma unroll
                for (int ai = 0; ai < 2; ++ai)
#pragma unroll
                    for (int m = 0; m < 4; ++m) { const int rl = ai * 128 + wr * 64 + m * 16 + fr, row = u.orow + rl;
                        const f32x4 p4 = *(const LAS f32x4*)(Pt + (rl * 2 + bj) * 4);
                        const float rs = rsqrtf(((p4[0] + p4[1]) + (p4[2] + p4[3])) * (1.f / 128.f) + EPSN);
                        const f32x4 v0 = acc[ai][bj][m][0] * rs * g0, v1 = acc[ai][bj][m][1] * rs * g1;
                        u32x4 w; w.x = cvt_pk_bf16(v0[0], v0[1]); w.y = cvt_pk_bf16(v0[2], v0[3]); w.z = cvt_pk_bf16(v1[0], v1[1]); w.w = cvt_pk_bf16(v1[2], v1[3]);
                        bf16* dst;
                        if (isv) dst = VN + (size_t)row * 512 + (u.ocol - 512) + bj * 128 + wc * 32 + 8 * fq;
                        else { const int h = ((u.ocol - (isq ? 1536 : 2560)) >> 7) + bj; dst = (isq ? QN : KN) + ((size_t)h * SEQ + row) * 128 + wc * 32 + 8 * fq; }
                        *(GAS u32x4*)dst = w; } }
            return;
        }
#pragma unroll
        for (int ai = 0; ai < 2; ++ai)
#pragma unroll
            for (int m = 0; m < 4; ++m) { bf16* rowp = O + (size_t)(row0 + ai * 128 + m * 16) * NZ + col0;
#pragma unroll
                for (int bj = 0; bj < 2; ++bj) { const f32x4 v0 = acc[ai][bj][m][0], v1 = acc[ai][bj][m][1];
                    u32x4 w; w.x = cvt_pk_bf16(v0[0], v0[1]); w.y = cvt_pk_bf16(v0[2], v0[3]); w.z = cvt_pk_bf16(v1[0], v1[1]); w.w = cvt_pk_bf16(v1[2], v1[3]);
                    *(GAS u32x4*)(rowp + bj * 128) = w; } }
    }
};
template <bool XBF> struct EpiRes {
    static constexpr bool PERM = false;
    const void* xin; const LAS float* gate; bf16* out;
    __device__ __forceinline__ void operator()(const f32x4 (&acc)[2][2][4][2], const gm::Unit& u, int wr, int wc, int fr, int fq) const {
        const int row0 = u.orow + wr * 64 + fr, col0 = u.ocol + wc * 32 + 4 * fq;
        f32x4 gv[2][2];
#pragma unroll
        for (int bj = 0; bj < 2; ++bj)
#pragma unroll
            for (int n = 0; n < 2; ++n) gv[bj][n] = *(const LAS f32x4*)(gate + col0 + bj * 128 + n * 16);
#pragma unroll
        for (int ai = 0; ai < 2; ++ai) {
            f32x4 xf[XBF ? 1 : 4][2][2]; u32x2 xh[XBF ? 4 : 1][2][2];
#pragma unroll
            for (int m = 0; m < 4; ++m) { const size_t off = (size_t)(row0 + ai * 128 + m * 16) * DM + col0;
#pragma unroll
                for (int bj = 0; bj < 2; ++bj)
#pragma unroll
                    for (int n = 0; n < 2; ++n) {
                        if constexpr (XBF) xh[m][bj][n] = *(const GAS u32x2*)((const bf16*)xin + off + bj * 128 + n * 16);
                        else xf[m][bj][n] = *(const GAS f32x4*)((const float*)xin + off + bj * 128 + n * 16); } }
#pragma unroll
            for (int m = 0; m < 4; ++m) { const size_t off = (size_t)(row0 + ai * 128 + m * 16) * DM + col0;
#pragma unroll
                for (int bj = 0; bj < 2; ++bj)
#pragma unroll
                    for (int n = 0; n < 2; ++n) { f32x4 xv;
                        if constexpr (XBF) { const u32x2 xb = xh[m][bj][n]; xv.x = bf_lo(xb.x); xv.y = bf_hi(xb.x); xv.z = bf_lo(xb.y); xv.w = bf_hi(xb.y); }
                        else xv = xf[m][bj][n];
                        const f32x4 r = xv + gv[bj][n] * acc[ai][bj][m][n]; u32x2 o; o.x = cvt_pk_bf16(r.x, r.y); o.y = cvt_pk_bf16(r.z, r.w);
                        *(GAS u32x2*)(out + off + bj * 128 + n * 16) = o; } }
        }
    }
};
struct EpiHid {
    static constexpr bool PERM = true;
    bf16* O;
    __device__ __forceinline__ void operator()(const f32x4 (&acc)[2][2][4][2], const gm::Unit& u, int wr, int wc, int fr, int fq) const {
        const int row0 = u.orow + wr * 64 + fr, col0 = (u.ocol >> 1) + wc * 32 + 8 * fq;
#pragma unroll
        for (int ai = 0; ai < 2; ++ai)
#pragma unroll
            for (int m = 0; m < 4; ++m) { bf16* rowp = O + (size_t)(row0 + ai * 128 + m * 16) * DEX + col0;
                f32x4 h0, h1;
#pragma unroll
                for (int j = 0; j < 4; ++j) { h0[j] = silu_f(acc[ai][0][m][0][j]) * acc[ai][1][m][0][j]; h1[j] = silu_f(acc[ai][0][m][1][j]) * acc[ai][1][m][1][j]; }
                u32x4 w; w.x = cvt_pk_bf16(h0[0], h0[1]); w.y = cvt_pk_bf16(h0[2], h0[3]); w.z = cvt_pk_bf16(h1[0], h1[1]); w.w = cvt_pk_bf16(h1[2], h1[3]);
                *(GAS u32x4*)rowp = w; }
    }
};
struct EpiHidPub {
    static constexpr bool PERM = true;
    unsigned char* O; gu32* ready;
    __device__ __forceinline__ void operator()(const f32x4 (&acc)[2][2][4][2], const gm::Unit& u, int wr, int wc, int fr, int fq) const {
        const __amdgpu_buffer_rsrc_t rs = __builtin_amdgcn_make_buffer_rsrc(O, (short)0, (int)(HIDROWS * DEX), 0x00020000);
        const int row0 = u.orow + wr * 64 + fr, col0 = (u.ocol >> 1) + wc * 32 + 8 * fq;
#pragma unroll
        for (int ai = 0; ai < 2; ++ai)
#pragma unroll
            for (int m = 0; m < 4; ++m) { const int off = (row0 + ai * 128 + m * 16) * DEX + col0;
                f32x4 h0, h1;
#pragma unroll
                for (int j = 0; j < 4; ++j) { h0[j] = HID8_SCALE * silu_f(acc[ai][0][m][0][j]) * acc[ai][1][m][0][j]; h1[j] = HID8_SCALE * silu_f(acc[ai][0][m][1][j]) * acc[ai][1][m][1][j]; }
                u32x2 w; w.x = cvt_pk4_fp8(h0[0], h0[1], h0[2], h0[3]); w.y = cvt_pk4_fp8(h1[0], h1[1], h1[2], h1[3]);
                __builtin_amdgcn_raw_buffer_store_b64(w, rs, off, 0, 16); }
        asm volatile("s_waitcnt vmcnt(0)" ::: "memory");
        if (fr == 0 && fq == 0) (void)__hip_atomic_fetch_add(ready + 16 * (u.orow >> 8), 1u, RLX_AGENT);
    }
};
struct EpiYB {
    static constexpr bool PERM = true;
    bf16* O;
    __device__ __forceinline__ void operator()(const f32x4 (&acc)[2][2][4][2], const gm::Unit& u, int wr, int wc, int fr, int fq) const {
        const int row0 = u.orow + wr * 64 + fr, col0 = u.ocol + wc * 32 + 8 * fq;
#pragma unroll
        for (int ai = 0; ai < 2; ++ai)
#pragma unroll
            for (int m = 0; m < 4; ++m) { bf16* rowp = O + (size_t)(row0 + ai * 128 + m * 16) * DM + col0;
#pragma unroll
                for (int bj = 0; bj < 2; ++bj) { const f32x4 v0 = acc[ai][bj][m][0], v1 = acc[ai][bj][m][1];
                    u32x4 w; w.x = cvt_pk_bf16(v0[0], v0[1]); w.y = cvt_pk_bf16(v0[2], v0[3]); w.z = cvt_pk_bf16(v1[0], v1[1]); w.w = cvt_pk_bf16(v1[2], v1[3]);
                    *(GAS u32x4*)(rowp + bj * 128) = w; } }
    }
};

#ifdef MK_SELFTEST
#include "selftest.h"
#endif
__device__ __forceinline__ int bg_need(int p) {
    if (p <= 1) return 0;
    if (p <= 4) return BG_C0;
    if (p <= 7) return BG_C1;
    if (p == 8) return BG_C3;
    if (p <= 10) return BG_C3B;
    if (p <= 13) return BG_C4;
    if (p <= 16) return BG_C5;
    return BG_C7;
}
__device__ __forceinline__ bool bg_seam(int k) { if (k == 0) return true; const int j = (k - 1) % 9; return j != 2 && j != 5 && j != 8; }
struct Args { const float* in[21]; float* out; unsigned char* ws; int ph_lo, ph_hi; };
constexpr int N_PHASES = 1 + 9 * NLAYER + 1;

#ifdef MK_ONLY
#define IN(k) (((k) == 0 ? 0 : (((k) - 1) % 9) + 1) == MK_ONLY && lo <= (k) && (k) < hi)
#else
#define IN(k) (lo <= (k) && (k) < hi)
#endif
#ifndef MK_REPEAT
#define MK_REPEAT -1
#endif
#define REPS(kind) ((MK_REPEAT == (kind)) ? 2 : 1)
#define SEAM(k) do { if (IN(k)) { if (bg_seam(k)) bg_fill(F, (k), bg_need((k) + 1), F.G, true); if (IN((k) + 1)) xcd_barrier(bar); } } while (0)


#ifdef MK_TPROBE
#define TP_B(kind) do { if (MK_TPROBE == (kind) && blockIdx.x == 0 && threadIdx.x == 0) ((volatile LAS unsigned*)(F.lds + AUX_OFF + 24576 + 128))[0] = (unsigned)__builtin_amdgcn_s_memrealtime(); } while (0)
#define TP_E(kind) do { if (MK_TPROBE == (kind) && blockIdx.x == 0 && threadIdx.x == 0) { volatile LAS unsigned* tp_ = (volatile LAS unsigned*)(F.lds + AUX_OFF + 24576 + 128); tp_[1] += (unsigned)__builtin_amdgcn_s_memrealtime() - tp_[0]; } } while (0)
#else
#define TP_B(kind) do { } while (0)
#define TP_E(kind) do { } while (0)
#endif
template <int l> __device__ __forceinline__ void layer_body(const Frame& F, const XcdBarrier& bar, const int lo, const int hi) {
    constexpr int pb = 1 + 9 * l;

        TP_B(1);
        for (int rep_ = 0; rep_ < REPS(1); ++rep_) if (IN(pb)) { if (rep_) xcd_barrier(bar); unsigned char* const wsl = opq(F.ws); LAS unsigned char* const ldl = opq(F.lds); if (l == 0) phase_norm1<0>(F, l, karg(0), nullptr, 0); else phase_norm1<1>(F, l, (const void*)(wsl + WS_X1), (void*)(wsl + WS_X2), l - 1); }
        SEAM(pb);
        TP_E(1);
        TP_B(2);
        for (int rep_ = 0; rep_ < REPS(2); ++rep_) if (IN(pb + 1)) { if (rep_) xcd_barrier(bar); unsigned char* const wsl = opq(F.ws); LAS unsigned char* const ldl = opq(F.lds);
            const int Gg = (F.G == 256) ? (l == 0 ? 144 : 192) : F.G;
            gm::RegOrder S; S.init(SEQ, NZ, DM / 2, wsl + WS_WIN + (size_t)l * NZ * DM, Gg, (int)blockIdx.x);
            fkl_fixup(F);
            EpiZ E{wsl, l, (LAS float*)(ldl + AUX_OFF)};
            if ((int)blockIdx.x < Gg) gm::gemm_phase<EpiZ, gm::RegOrder, false, true, true, SC_H8, SC_W8>(ldl, (const char*)(wsl + WS_H), DM, S, E, F.wave); }
        SEAM(pb + 1);
        TP_E(2);
        TP_B(4);
        for (int rep_ = 0; rep_ < REPS(4); ++rep_) if (IN(pb + 3)) { if (rep_) xcd_barrier(bar); unsigned char* const wsl = opq(F.ws); LAS unsigned char* const ldl = opq(F.lds);
            const MixTab T = mix_tab_ptrs(ldl);
            TP_B(15); mix_build_table(F, l, T); TP_E(15);
#if defined(MK_TPROBE) && MK_TPROBE == 16
            if (blockIdx.x == 0 && threadIdx.x == 0) { unsigned tot_ = 0; for (int i_ = 0; i_ < 256; ++i_) { const int qb_ = i_ & 31; tot_ += 4 * (qb_ + 1) - (T.jlo[i_] & 255); }
                ((volatile LAS unsigned*)(F.lds + AUX_OFF + 24576 + 128))[1] += tot_; }
#endif
#if defined(MK_TPROBE) && (MK_TPROBE == 17 || MK_TPROBE == 18)
            const unsigned tpd0_ = (unsigned)__builtin_amdgcn_s_memrealtime();
#endif
            const int natt = __builtin_amdgcn_readfirstlane(T.nitems[0]), ntot = natt + 512;
            LAS int* qslot = T.nitems + 1;
            int it = F.vcu;
            while (it < ntot) {
                int pub = -1, pubn = 0;
                if (it >= natt) { TP_B(14); phase_small_item(F, l, it - natt); TP_E(14); }
                else {
                    const int rec = __builtin_amdgcn_readfirstlane(T.items[it]), b = rec & 255, c = (rec >> 8) & 15, ja = (rec >> 12) & 255, n = (rec >> 20) & 31, h = b >> 5, qb = b & 31;
                    const bool fin = (__builtin_amdgcn_readfirstlane(T.jlo[b]) >> 8) <= 1; unsigned char* const ws = opq(wsl);
                    at::BlockRef cur;
                    cur.Q = (const bf16*)(ws + WS_QN) + ((size_t)h * SEQ + qb * 256) * 128; cur.K = (const bf16*)(ws + WS_KN) + (size_t)h * SEQ * 128;
                    cur.V = (const bf16*)(ws + WS_Z) + 3584 + h * 128; cur.O = ws + WS_YCAT + (size_t)(qb * 256) * DM + 1024 + h * 128;
                    cur.FK = (const float*)(ws + WS_FKL) + (size_t)h * SEQ; cur.P0 = qb * 256;
                    TP_B(13); at::attn_block(cur, ja, n, fin, (bf16*)(ws + WS_PART) + (size_t)(b * 8 + c) * 256 * 128, (float*)(ws + WS_ML) + (size_t)(b * 8 + c) * 256 * 2, (char*)ldl, ldl, F.wave); TP_E(13);
                    if (!fin) { pub = b; pubn = __builtin_amdgcn_readfirstlane(T.jlo[b]) >> 8; }
                }
                if (opq_tid(F.wave) == 0) { qslot[0] = F.G + (int)__hip_atomic_fetch_add(F.ctl + CW_Q + 64 * l + 32 * rep_, 1u, RLX_AGENT);
                    qslot[1] = (pub >= 0) ? (int)__hip_atomic_fetch_add(F.ctl + CW_PC + 8192 * l + 4096 * rep_ + 16 * pub, 1u, RLX_AGENT) : -2; }
                __syncthreads();
                it = __builtin_amdgcn_readfirstlane(qslot[0]);
                const int arrived = __builtin_amdgcn_readfirstlane(qslot[1]);
                __syncthreads();
                if (pub >= 0 && arrived == pubn - 1) {
                    __builtin_amdgcn_fence(__ATOMIC_ACQUIRE, "agent");
                    attn_combine_block(F, pub, pubn); }
            }
#if defined(MK_TPROBE) && (MK_TPROBE == 17 || MK_TPROBE == 18)
            if (threadIdx.x == 0) { const unsigned el_ = (unsigned)__builtin_amdgcn_s_memrealtime() - tpd0_;
                if (MK_TPROBE == 17) atomicMax((unsigned*)(F.ctl + 3000 + l), el_); else atomicMax((unsigned*)(F.ctl + 3000 + l), 0x7fffffffu - el_); }
#endif
        }
        SEAM(pb + 3);
        TP_E(4);
        TP_B(6);
        for (int rep_ = 0; rep_ < REPS(6); ++rep_) if (IN(pb + 5)) { if (rep_) xcd_barrier(bar); unsigned char* const wsl = opq(F.ws); LAS unsigned char* const ldl = opq(F.lds); gm::RegOrder S; S.init(SEQ, DM, DM / 2, wsl + WS_WOUT + (size_t)l * DM * DM, F.G, (int)blockIdx.x);
            LAS float* g1L = (LAS float*)(ldl + AUX_OFF);
            { const float* const b_ada_ = karg(3); const int t_ = opq_tid(F.wave); float m1_[4][5];
#pragma unroll
              for (int it = 0; it < 4; ++it) mod_ld(wsl, b_ada_, l, 2 * DM + t_ + it * NTHR, m1_[it]);
#pragma unroll
              for (int it = 0; it < 4; ++it) g1L[t_ + it * NTHR] = mod_sum(m1_[it]); }
            __syncthreads();
            EpiRes<(l != 0)> E{(l == 0) ? (const void*)karg(0) : (const void*)(wsl + WS_X2), g1L, (bf16*)(wsl + WS_X1)};
            gm::gemm_phase<EpiRes<(l != 0)>, gm::RegOrder, false, true, true, SC_H8, SC_W8>(ldl, (const char*)(wsl + WS_YCAT), DM, S, E, F.wave); }
        SEAM(pb + 5);
        TP_E(6);
        TP_B(7);
        for (int rep_ = 0; rep_ < REPS(7); ++rep_) if (IN(pb + 6)) { if (rep_) xcd_barrier(bar); unsigned char* const wsl = opq(F.ws); LAS unsigned char* const ldl = opq(F.lds); phase_norm2_route(F, l); }
        SEAM(pb + 6);
        TP_E(7);
        TP_B(8);
        for (int rep_ = 0; rep_ < REPS(8); ++rep_) if (IN(pb + 7)) { if (rep_) xcd_barrier(bar); unsigned char* const wsl = opq(F.ws); LAS unsigned char* const ldl = opq(F.lds); LAS int* tab = (LAS int*)(ldl + AUX_OFF + 20480); moe_table(F, l, tab);
            gu32* const rdy = F.ctl + CW_RDY + 4096 * l + 2048 * rep_;
            TP_B(11);
            const int tot1 = 8 * tab[16];
            const bool split = (F.G == 256) && (tot1 <= 576) && (l == 0);
            const int Gm = split ? 192 : F.G, cm = split ? (F.vcu >> 5) * 24 + (F.vcu & 31) : F.vcu;
            if (split && (F.vcu & 31) >= 24) bg_fill(F, 20 + l, 0, Gm, false);
            else { MoeOrder S; S.G = Gm; S.c = cm; S.total = 8 * tab[16]; S.K = DM / 2; S.nct = 8; S.Bt = (const char*)(wsl + WS_WGU) + (size_t)l * NEXP * DM * DM; S.estride = (size_t)DM * DM;
              S.list = (const int*)(wsl + WS_LIST); S.tab = tab;
              EpiHidPub E{wsl + (l ? WS_HID1 : WS_HID), rdy};
              gm::gemm_phase<EpiHidPub, MoeOrder, true, true, true, SC_H8, SC_W8>(ldl, (const char*)(wsl + WS_H), DM, S, E, F.wave);
              if (split && opq_tid(F.wave) == 0) (void)__hip_atomic_fetch_add(F.ctl + CW_ARR + 64 * (20 + l), 1u, RLX_AGENT); }
            TP_E(11); TP_B(12);
            { MoeDynOrder S; S.total = 8 * tab[16]; S.K = DEX / 2; S.Bt = (const char*)(wsl + WS_WD) + (size_t)l * NEXP * DM * DEX; S.estride = (size_t)DM * DEX; S.tab = tab;
              S.ticket = F.ctl + CW_MT + 64 * l + 32 * rep_; S.ready = rdy; S.tmo = F.ctl + CW_TMO; S.slot = (LAS unsigned*)(ldl + AUX_OFF + 24576 + 64);
              EpiYB E{(bf16*)(wsl + WS_YB)};
              gm::gemm_phase<EpiYB, MoeDynOrder, false, true, true, SC_HID8, SC_W8>(ldl, (const char*)(wsl + (l ? WS_HID1 : WS_HID)), DEX, S, E, F.wave); }
            TP_E(12);
        }
        SEAM(pb + 7);
        TP_E(8);
    }

__global__ void __launch_bounds__(NTHR, 2) mk_fwd(Args args) {
    extern __shared__ __attribute__((aligned(16))) unsigned char lds[];
    Frame F;
    F.lds = (LAS unsigned char*)lds; F.MISC = (volatile LAS unsigned*)(F.lds + MISC_OFF);
    F.tid = 0; F.lane = 0; F.wave = __builtin_amdgcn_readfirstlane((int)threadIdx.x >> 6);
    F.G = gridDim.x; { const int bx = blockIdx.x; F.vcu = (F.G % 8 == 0) ? (bx % 8) * (F.G / 8) + bx / 8 : bx; }
    F.ws = args.ws; F.ctl = (gu32*)(args.ws + WS_CTL);
    for (int u = threadIdx.x; u < (LDS_BYTES - RING_BYTES) / 4; u += NTHR) ((LAS unsigned*)(F.lds + RING_BYTES))[u] = 0u;
    __syncthreads();
    const int lo = args.ph_lo, hi = args.ph_hi;
    const bool multi = (hi - lo) > 1;
    XcdBarrier bar; bar.bar = (unsigned*)(F.ctl + CW_BAR); bar.x = 0; bar.st = nullptr;
    if (multi) bar = xcd_barrier_post((unsigned*)(F.ctl + CW_BAR), F.MISC + 8);
    TP_B(0); for (int rep_ = 0; rep_ < REPS(0); ++rep_) if (IN(0)) { if (rep_) xcd_barrier(bar); p0_prologue(F); } SEAM(0); TP_E(0);

    layer_body<0>(F, bar, lo, hi);
    layer_body<1>(F, bar, lo, hi);
    TP_B(10);
    for (int rep_ = 0; rep_ < REPS(10); ++rep_) if (IN(N_PHASES - 1)) { if (rep_) xcd_barrier(bar); phase_norm1<2>(F, NLAYER - 1, (const void*)(F.ws + WS_X1), (void*)karg(21), NLAYER - 1); }
    TP_E(10);
#ifdef MK_TPROBE
    if (blockIdx.x == 0 && threadIdx.x == 0) { unsigned d_ = ((volatile LAS unsigned*)(F.lds + AUX_OFF + 24576 + 128))[1];
        if (MK_TPROBE == 17) d_ = __hip_atomic_load(F.ctl + 3000, RLX_AGENT) + __hip_atomic_load(F.ctl + 3001, RLX_AGENT);
        if (MK_TPROBE == 18) d_ = (0x7fffffffu - __hip_atomic_load(F.ctl + 3000, RLX_AGENT)) + (0x7fffffffu - __hip_atomic_load(F.ctl + 3001, RLX_AGENT)); const unsigned t0_ = (unsigned)__builtin_amdgcn_s_memrealtime(); while ((unsigned)__builtin_amdgcn_s_memrealtime() - t0_ < d_) __builtin_amdgcn_s_sleep(8); }
#endif
#ifdef MK_SELFTEST
    {
        const bool h0 = st_run(0, 1.f, 0x7f7f7f7f), h0s = st_run(0, 64.f, 0x79797979), h1 = st_run(1, 1.f, 0x7f7f7f7f);
        xcd_barrier(bar);
        float* o = (float*)karg(21);
        if (!(h0 && h0s)) { const float val = h0 ? 0.f : (h1 ? 1000.f : __builtin_nanf(""));
            for (size_t i = (size_t)blockIdx.x * NTHR + threadIdx.x; i < (size_t)SEQ * DM; i += (size_t)gridDim.x * NTHR) o[i] = val; }
    }
#endif
#undef IN
#undef SEAM
}

#ifndef MK_LAUNCHES
#define MK_LAUNCHES 1
#endif
extern "C" void kernel_launch(void* const* d_in, const int* in_sizes, int n_in, void* d_out, int out_size, void* d_ws, size_t ws_size, hipStream_t stream) {
    static int grid = 0;
    if (grid == 0) {
        int dev = 0, cus = 0, per_cu = 0;
        if (n_in != 21 || ws_size < WS_END) { fprintf(stderr, "kernel_launch: unexpected inputs (n_in %d, ws %zu)\n", n_in, ws_size); grid = -1; return; }
        if (hipGetDevice(&dev) != hipSuccess || hipDeviceGetAttribute(&cus, hipDeviceAttributeMultiprocessorCount, dev) != hipSuccess) { grid = -1; return; }
        if (hipFuncSetAttribute((const void*)mk_fwd, hipFuncAttributeMaxDynamicSharedMemorySize, LDS_BYTES) != hipSuccess) { fprintf(stderr, "kernel_launch: hipFuncSetAttribute failed\n"); grid = -1; return; }
        if (hipOccupancyMaxActiveBlocksPerMultiprocessor(&per_cu, (const void*)mk_fwd, NTHR, LDS_BYTES) != hipSuccess || per_cu < 1) fprintf(stderr, "kernel_launch: occupancy query says %d\n", per_cu);
        (void)hipGetLastError();
        grid = cus;
    }
    if (grid < 0) return;
    (void)hipMemsetAsync((char*)d_ws + WS_CTL, 0, CTL_ZERO_BYTES, stream);
    Args a{};
    for (int i = 0; i < 21; ++i) a.in[i] = (const float*)d_in[i];
    a.out = (float*)d_out; a.ws = (unsigned char*)d_ws;
#if MK_LAUNCHES == 1
    a.ph_lo = 0; a.ph_hi = N_PHASES;
    hipLaunchKernelGGL(mk_fwd, dim3(grid), dim3(NTHR), LDS_BYTES, stream, a);
#else
    for (int p = 0; p < N_PHASES; ++p) { a.ph_lo = p; a.ph_hi = p + 1; hipLaunchKernelGGL(mk_fwd, dim3(grid), dim3(NTHR), LDS_BYTES, stream, a); }
#endif
}
```

```cpp
#include <hip/hip_runtime.h>
#include <stdint.h>
#include <stdio.h>

#define GAS __attribute__((address_space(1)))
#define LAS __attribute__((address_space(3)))
typedef unsigned short bf16;
typedef short bf16x8 __attribute__((ext_vector_type(8)));
typedef short s16x4 __attribute__((ext_vector_type(4)));
typedef float f32x2 __attribute__((ext_vector_type(2)));
typedef float f32x4 __attribute__((ext_vector_type(4)));
typedef float f32x16 __attribute__((ext_vector_type(16)));
typedef unsigned u32x2 __attribute__((ext_vector_type(2)));
typedef unsigned u32x4 __attribute__((ext_vector_type(4)));
typedef int i32x8 __attribute__((ext_vector_type(8)));
typedef int i32x4 __attribute__((ext_vector_type(4)));
typedef GAS unsigned gu32;
#define RLX_AGENT __ATOMIC_RELAXED, __HIP_MEMORY_SCOPE_AGENT
#define LDS_WAIT() asm volatile("s_waitcnt lgkmcnt(0)" ::: "memory")
#define VM_WAIT() asm volatile("s_waitcnt vmcnt(0)" ::: "memory")

constexpr int DM = 2048, SEQ = 8192, NIN = 4616, NZ = 4608, DEX = 1024, NEXP = 16, NLAYER = 2;
constexpr float EPSN = 1e-6f;
constexpr float LOG2E = 1.4426950408889634f;
constexpr int NWAVES = 8, NTHR = 512;
constexpr int HIDROWS = 2 * SEQ + NEXP * 256;

constexpr size_t KiB = 1024, MiB = 1u << 20;
constexpr size_t WS_CTL = 0, CTL_ZERO_BYTES = 1 * MiB;
constexpr size_t WS_MOD = 1 * MiB;
constexpr size_t WS_FLOC = WS_MOD + 128 * KiB;
constexpr size_t WS_TOT = WS_FLOC + 256 * KiB;
constexpr size_t WS_FKL = WS_TOT + 8 * KiB;
constexpr size_t WS_TOKE = WS_FKL + 256 * KiB;
constexpr size_t WS_TOKP = WS_TOKE + 64 * KiB;
constexpr size_t WS_TOKW = WS_TOKP + 64 * KiB;
constexpr size_t WS_NCH = 7 * MiB;
constexpr size_t WS_LIST = WS_TOKW + 64 * KiB;
constexpr size_t WS_WM = 4 * MiB;
constexpr size_t WS_BWT = WS_WM + 256 * KiB;
constexpr size_t WS_MODP = 6 * MiB;
constexpr size_t WS_WIN = 8 * MiB;
constexpr size_t WS_WOUT = WS_WIN + 2 * 18 * MiB;
constexpr size_t WS_WGU = WS_WOUT + 2 * 8 * MiB;
constexpr size_t WS_WD = WS_WGU + 2 * 16 * 8 * MiB;
constexpr size_t WS_H = WS_WD + 2 * 16 * 4 * MiB;
constexpr size_t WS_Z = WS_H + 32 * MiB;
constexpr size_t WS_QN = WS_Z + 72 * MiB;
constexpr size_t WS_KN = WS_QN + 16 * MiB;
constexpr size_t WS_VN = WS_KN + 16 * MiB;
constexpr size_t WS_DP = WS_VN + 8 * MiB;
constexpr size_t WS_YCAT = WS_DP + 8 * MiB;
constexpr size_t WS_X1 = WS_YCAT + 32 * MiB;
constexpr size_t WS_X2 = WS_X1 + 64 * MiB;
constexpr size_t WS_HID = WS_X2 + 64 * MiB;
constexpr size_t WS_YB = WS_HID + 40 * MiB;
constexpr size_t WS_PART = WS_YB + 80 * MiB;
constexpr size_t WS_ML = WS_PART + 128 * MiB;
constexpr size_t WS_HID1 = WS_ML + 4 * MiB;
constexpr size_t WS_END = WS_HID1 + 40 * MiB;
constexpr int CW_TMO = 0, CW_CODE = 1;
constexpr int CW_CNT = 64;
constexpr int CW_Q = 512;
constexpr int CW_BGT = 640;
constexpr int CW_ARR = 1024;
constexpr int CW_MT = 768;
constexpr int CW_BAR = 4096;
constexpr int CW_PC = 32768;
constexpr int CW_RDY = 8192;

constexpr int RING_BYTES = 131072;
constexpr int MISC_OFF = RING_BYTES + 320;
constexpr int AUX_OFF = RING_BYTES + 1024;
constexpr int LDS_BYTES = 163840;

template <class T> __device__ __forceinline__ T* opq(T* p) { asm volatile("" : "+s"(p)); return p; }
__device__ __forceinline__ int opq_tid(int wave) { int t = (wave << 6) | (int)__builtin_amdgcn_mbcnt_hi(~0u, __builtin_amdgcn_mbcnt_lo(~0u, 0u)); asm volatile("" : "+v"(t)); return t; }
__device__ __forceinline__ unsigned cvt_pk_bf16(float lo, float hi) { unsigned r; asm volatile("v_cvt_pk_bf16_f32 %0, %1, %2" : "=v"(r) : "v"(lo), "v"(hi)); return r; }
__device__ __forceinline__ unsigned cvt_pk4_fp8(float a, float b, float c, float d) {
    a = fminf(fmaxf(a, -440.f), 440.f); b = fminf(fmaxf(b, -440.f), 440.f); c = fminf(fmaxf(c, -440.f), 440.f); d = fminf(fmaxf(d, -440.f), 440.f);
    unsigned w; asm volatile("v_cvt_pk_fp8_f32 %0, %1, %2" : "=v"(w) : "v"(a), "v"(b)); asm volatile("v_cvt_pk_fp8_f32 %0, %1, %2 op_sel:[0,0,1]" : "+v"(w) : "v"(c), "v"(d)); return w; }
constexpr float H8_SCALE = 4.f, HID8_SCALE = 4.f, W8_SCALE = 64.f;
constexpr int SC_H8 = 0x7b7b7b7b, SC_HID8 = 0x7b7b7b7b, SC_W8 = 0x7b7b7b7b;
__device__ __forceinline__ float bf_lo(unsigned w) { return __uint_as_float(w << 16); }
__device__ __forceinline__ float bf_hi(unsigned w) { return __uint_as_float(w & 0xffff0000u); }
template <int M> __device__ __forceinline__ float xor_f(float v) {
    static_assert(M < 32, "xor_f: masks below 32 only");
    return __uint_as_float((unsigned)__builtin_amdgcn_ds_swizzle((int)__float_as_uint(v), (M << 10) | 0x1f));
}
__device__ __forceinline__ float wave_sum(float v) {
    v += __uint_as_float((unsigned)__builtin_amdgcn_update_dpp(0, (int)__float_as_uint(v), 0xb1, 0xf, 0xf, true));
    v += __uint_as_float((unsigned)__builtin_amdgcn_update_dpp(0, (int)__float_as_uint(v), 0x4e, 0xf, 0xf, true));
    v += __uint_as_float((unsigned)__builtin_amdgcn_update_dpp(0, (int)__float_as_uint(v), 0x141, 0xf, 0xf, true));
    v += __uint_as_float((unsigned)__builtin_amdgcn_update_dpp(0, (int)__float_as_uint(v), 0x140, 0xf, 0xf, true));
    v += xor_f<16>(v);
    { auto rr = __builtin_amdgcn_permlane32_swap(__float_as_uint(v), __float_as_uint(v), false, false); v = __uint_as_float(rr[0]) + __uint_as_float(rr[1]); }
    return v;
}
__device__ __forceinline__ float wave_max(float v) {
    v = fmaxf(v, xor_f<1>(v)); v = fmaxf(v, xor_f<2>(v)); v = fmaxf(v, xor_f<4>(v)); v = fmaxf(v, xor_f<8>(v)); v = fmaxf(v, xor_f<16>(v));
    { auto rr = __builtin_amdgcn_permlane32_swap(__float_as_uint(v), __float_as_uint(v), false, false); v = fmaxf(__uint_as_float(rr[0]), __uint_as_float(rr[1])); }
    return v;
}
__device__ __forceinline__ float gelu_t(float x) {
    const float u2 = x * (1.5957691216057308f + 0.0713548162726f * x * x);
    return x * __builtin_amdgcn_rcpf(1.f + __builtin_amdgcn_exp2f(-LOG2E * u2));
}
__device__ __forceinline__ float silu_f(float x) { return x * __builtin_amdgcn_rcpf(1.f + __builtin_amdgcn_exp2f(-LOG2E * x)); }

#define XB_TMO      128
#define XB_XCNT(j)  (256  + 64 * (j))
#define XB_XSUB(j)  (1280 + 64 * (j))
#define XB_XGEN(j)  (2304 + 64 * (j))
#define XB_TOP      3328
#define XB_TOPGEN   3392
#define XCD_BAR_WORDS 3456
#define XB_SPIN_CAP (1u << 18)
__device__ __forceinline__ unsigned xb_ld(unsigned* p)              { return __hip_atomic_load(p, __ATOMIC_RELAXED, __HIP_MEMORY_SCOPE_AGENT); }
__device__ __forceinline__ unsigned xb_add(unsigned* p, unsigned v) { return __hip_atomic_fetch_add(p, v, __ATOMIC_RELAXED, __HIP_MEMORY_SCOPE_AGENT); }
__device__ __forceinline__ unsigned xb_xcc_id() { return (unsigned)__builtin_amdgcn_s_getreg((3 << 11) | 20) & 0xFu; }
#define XB_SPIN(cond, bar) do { unsigned _sp = 0; while (cond) { __builtin_amdgcn_s_sleep(1); \
    if ((++_sp & 255u) == 0u) { if (xb_ld(&(bar)[XB_TMO])) break; if (_sp > XB_SPIN_CAP) { atomicAdd(&(bar)[XB_TMO], 1u); break; } } } } while (0)
struct XcdBarrier { unsigned* bar; unsigned x; volatile LAS unsigned* st; };
__device__ __forceinline__ XcdBarrier xcd_barrier_post(unsigned* bar, volatile LAS unsigned* st) {
    XcdBarrier b; b.bar = bar; b.x = xb_xcc_id(); b.st = st;
    if (threadIdx.x == 0) (void)xb_add(&bar[XB_XCNT(b.x)], 1u);
    return b;
}
__device__ __forceinline__ void xcd_barrier_complete(unsigned* bar, unsigned x, unsigned& nloc, unsigned& nx) {
    const unsigned G = gridDim.x * gridDim.y * gridDim.z;
    unsigned sum, cnt, mine, sp = 0u;
    for (;;) {
        sum = 0u; cnt = 0u; mine = 0u;
#pragma unroll
        for (unsigned j = 0; j < 16; ++j) { const unsigned c = xb_ld(&bar[XB_XCNT(j)]); sum += c; cnt += (c > 0u) ? 1u : 0u; mine = (j == x) ? c : mine; }
        if (sum == G) break;
        __builtin_amdgcn_s_sleep(1);
        if ((++sp & 255u) == 0u) { if (xb_ld(&bar[XB_TMO])) break; if (sp > XB_SPIN_CAP) { atomicAdd(&bar[XB_TMO], 1u); break; } }
    }
    nloc = mine > 0u ? mine : 1u; nx = cnt > 0u ? cnt : 1u;
}
__device__ __forceinline__ void xcd_barrier(const XcdBarrier& b) {
    asm volatile("s_waitcnt vmcnt(0)" ::: "memory");
    __syncthreads();
    if (threadIdx.x == 0) {
        unsigned* bar = b.bar; asm volatile("" : "+s"(bar));
        __builtin_amdgcn_s_waitcnt(0);
        unsigned nloc = b.st[0], nx = b.st[1];
        if (nloc == 0u) { xcd_barrier_complete(bar, b.x, nloc, nx); b.st[0] = nloc; b.st[1] = nx; }
        const unsigned old = xb_add(&bar[XB_XSUB(b.x)], 1u);
        const unsigned gen = old / nloc;
        if (old + 1u == (gen + 1u) * nloc) {
            __builtin_amdgcn_fence(__ATOMIC_RELEASE, "agent");
            asm volatile("s_waitcnt vmcnt(0)" ::: "memory");
            const unsigned og = xb_add(&bar[XB_TOP], 1u);
            const unsigned tg = og / nx;
            if (og + 1u == (tg + 1u) * nx) xb_add(&bar[XB_TOPGEN], 1u);
            else XB_SPIN(xb_ld(&bar[XB_TOPGEN]) == tg, bar);
            __builtin_amdgcn_fence(__ATOMIC_ACQUIRE, "agent");
            xb_add(&bar[XB_XGEN(b.x)], 1u);
            asm volatile("s_waitcnt vmcnt(0)" ::: "memory");
        } else {
            XB_SPIN(xb_ld(&bar[XB_XGEN(b.x)]) == gen, bar);
            __builtin_amdgcn_fence(__ATOMIC_ACQUIRE, "agent");
            asm volatile("s_waitcnt vmcnt(0)" ::: "memory");
        }
    }
    __syncthreads();
}

namespace gm {
constexpr int BM = 256, BK = 64, HALF = 128, HTB = HALF * BK * 2, STAGE_BYTES = 8 * HTB, NXCD = 8, WGM = 8;
__host__ __device__ __forceinline__ int lds_byte(int r, int c) { const int st = (r >> 4) * 2 + (c >> 5), rr = r & 15, cc = c & 31, ob = rr * 64 + cc * 2; return st * 1024 + (ob ^ (((ob >> 9) & 1) << 5)); }
__host__ __device__ __forceinline__ void stage_rc(int b, int& R, int& C) { const int st = b / 1024, sb = b % 1024, swz = sb ^ (((sb >> 9) & 1) << 5); R = (st >> 1) * 16 + swz / 64; C = (st & 1) * 32 + (swz % 64) / 2; }
__host__ __device__ __forceinline__ int perm32(int rho) { const int n = rho >> 4, i = rho & 15; return 8 * (i >> 2) + 4 * n + (i & 3); }

struct Unit { int arow, orow, ocol, e, rt; const char* Bp; };

template <class Epi, class Sched, bool GATHER, bool ALIGN_EPI, bool FP8 = false, int SCA = 0x7f7f7f7f, int SCB = 0x7f7f7f7f>
__device__ __forceinline__ void gemm_phase(LAS unsigned char* lds, const char* Abase, const int Kel, const Sched& S, const Epi& E, const int wv) {
    const int K = FP8 ? (Kel >> 1) : Kel;
    const int tid = opq_tid(wv), wid = wv, lane = tid & 63, wr = wid >> 2, wc = wid & 3, fr = lane & 15, fq = lane >> 4;
    const int nt = K / BK;
    unsigned voffA[2], voffB[2];
#pragma unroll
    for (int i = 0; i < 2; ++i) { int R, C; stage_rc(tid * 16 + i * 8192, R, C); const int Rb = Epi::PERM ? ((R & ~31) + perm32(R & 31)) : R;
        voffA[i] = (unsigned)(R * K + C) * 2u; voffB[i] = (unsigned)(Rb * K + C) * 2u; }
    const size_t kstep = (size_t)(BK * 2);
    const size_t hstep = (size_t)HALF * K * 2;
    const unsigned ldsw = (unsigned)wid * 1024u;
    const int aoff = FP8 ? lds_byte(wr * 64 + fr, fq * 16) : lds_byte(wr * 64 + fr, fq * 8), boff = FP8 ? lds_byte(wc * 32 + fr, fq * 16) : lds_byte(wc * 32 + fr, fq * 8);
#define PG8_SA(b, h) (((b) * 2 + (h)) * HTB)
#define PG8_SB(b, h) ((4 + (b) * 2 + (h)) * HTB)
#define PG8_STAGE(bufoff, gbase, voff) do { _Pragma("unroll") for (int _i = 0; _i < 2; ++_i) { unsigned vo_ = (voff)[_i]; asm volatile("" : "+v"(vo_));     \
        __builtin_amdgcn_global_load_lds((const unsigned*)((const char*)(gbase) + vo_), (LAS unsigned*)(lds + (bufoff) + ldsw + _i * 8192), 16, 0, 0); } } while (0)
#define PG8_STAGE_A(bufoff, ubase, h, kb, vg) do { if constexpr (GATHER) { PG8_STAGE(bufoff, Abase + (kb), (vg)[h]); } else { PG8_STAGE(bufoff, (ubase) + (h) * hstep + (kb), voffA); } } while (0)
#define PG8_STAGE_A2(bufoff, ubase, h, kb) PG8_STAGE_A(bufoff, ubase, h, kb, vgc)
#define PG8_LDA(dst, b, h) do { _Pragma("unroll") for (int m = 0; m < 4; ++m) { if constexpr (FP8) { dst##8[m].lo = *(const LAS i32x4*)(lds + PG8_SA(b, h) + aoff + m * 2048); dst##8[m].hi = *(const LAS i32x4*)(lds + PG8_SA(b, h) + aoff + 16 + m * 2048); } \
        else { dst[m][0] = *(const LAS bf16x8*)(lds + PG8_SA(b, h) + aoff + m * 2048); dst[m][1] = *(const LAS bf16x8*)(lds + PG8_SA(b, h) + aoff + 1024 + m * 2048); } } } while (0)
#define PG8_LDB(dst, b, h) do { _Pragma("unroll") for (int n = 0; n < 2; ++n) { if constexpr (FP8) { dst##8[n].lo = *(const LAS i32x4*)(lds + PG8_SB(b, h) + boff + n * 2048); dst##8[n].hi = *(const LAS i32x4*)(lds + PG8_SB(b, h) + boff + 16 + n * 2048); } \
        else { dst[n][0] = *(const LAS bf16x8*)(lds + PG8_SB(b, h) + boff + n * 2048); dst[n][1] = *(const LAS bf16x8*)(lds + PG8_SB(b, h) + boff + 1024 + n * 2048); } } } while (0)
#define PG8_F8(x) __builtin_shufflevector(__builtin_bit_cast(i32x4, (x)[0]), __builtin_bit_cast(i32x4, (x)[1]), 0, 1, 2, 3, 4, 5, 6, 7)
#define PG8_MMA(ai, bj, At, Bt) do { __builtin_amdgcn_s_setprio(1); _Pragma("unroll") for (int m = 0; m < 4; ++m) _Pragma("unroll") for (int n = 0; n < 2; ++n) { \
        if constexpr (FP8) { acc[ai][bj][m][n] = __builtin_amdgcn_mfma_scale_f32_16x16x128_f8f6f4(Bt##8[n], At##8[m], acc[ai][bj][m][n], 0, 0, 0, SCB, 0, SCA); } \
        else { _Pragma("unroll") for (int k = 0; k < 2; ++k) acc[ai][bj][m][n] = __builtin_amdgcn_mfma_f32_16x16x32_bf16(Bt[n][k], At[m][k], acc[ai][bj][m][n], 0, 0, 0); } } \
        __builtin_amdgcn_s_setprio(0); } while (0)
#define PG8_WAIT_V(n) asm volatile("s_waitcnt vmcnt(" #n ")" ::: "memory")
#define PG8_WAIT_L(n) asm volatile("s_waitcnt lgkmcnt(" #n ")" ::: "memory")
#define PG8_BAR __builtin_amdgcn_s_barrier()
#define PG8_SCHED __builtin_amdgcn_sched_barrier(0)
    Unit cur, nxt; int ui = 0;
    if (!S.next(0, cur)) return;
    f32x4 acc[2][2][4][2];
#pragma unroll
    for (int a = 0; a < 2; ++a)
#pragma unroll
        for (int b = 0; b < 2; ++b)
#pragma unroll
            for (int m = 0; m < 4; ++m)
#pragma unroll
                for (int n = 0; n < 2; ++n) acc[a][b][m][n] = (f32x4){0.f, 0.f, 0.f, 0.f};
    bf16x8 At[4][2], B0[2][2], B1[2][2];
    i32x8 At8[4], B08[2], B18[2];
    unsigned vgc[2][2];
    if constexpr (GATHER) {
#pragma unroll
        for (int h = 0; h < 2; ++h)
#pragma unroll
            for (int i = 0; i < 2; ++i) { int R_, C_; stage_rc(opq_tid(wv) * 16 + i * 8192, R_, C_); vgc[h][i] = ((unsigned)S.row_of(cur, h * HALF + R_) * (unsigned)K + (unsigned)C_) * 2u; }
    }
    const char* cA = GATHER ? Abase : Abase + (size_t)cur.arow * K * 2; const char* cB = cur.Bp;
    PG8_STAGE(PG8_SB(0, 0), cB, voffB); PG8_STAGE(PG8_SB(0, 1), cB + hstep, voffB); PG8_STAGE_A(PG8_SA(0, 0), cA, 0, 0, vgc); PG8_STAGE_A(PG8_SA(0, 1), cA, 1, 0, vgc);
    if (wr == 1) PG8_BAR;
    PG8_WAIT_V(2); PG8_BAR;
    PG8_STAGE(PG8_SB(1, 0), cB + kstep, voffB); PG8_STAGE_A(PG8_SA(1, 0), cA, 0, kstep, vgc); PG8_STAGE(PG8_SB(1, 1), cB + hstep + kstep, voffB);
    PG8_WAIT_V(6); PG8_BAR;
    for (;;) {
        bool has_next = false;
        const char* nA = cA; const char* nB = cB;
        for (int t = 0; t < nt; t += 2) {
            const bool last = (t == nt - 2);
            if (last) { has_next = S.next(ui + 1, nxt); if (has_next) { nA = GATHER ? Abase : Abase + (size_t)nxt.arow * K * 2; nB = nxt.Bp; } }
            const size_t k1 = (size_t)(t + 1) * kstep;
            const char* a2 = last ? nA : cA; const char* b2 = last ? nB : cB + (size_t)(t + 2) * kstep;
            const size_t k2 = last ? 0 : (size_t)(t + 2) * kstep, k3 = k2 + kstep;
            const char* b3 = b2 + kstep;
            PG8_LDB(B0, 0, 0); PG8_LDB(B1, 0, 1); PG8_SCHED; PG8_LDA(At, 0, 0); PG8_STAGE_A(PG8_SA(1, 1), cA, 1, k1, vgc);
            if constexpr (GATHER) { if (last && has_next) {
#pragma unroll
                for (int h = 0; h < 2; ++h)
#pragma unroll
                    for (int i = 0; i < 2; ++i) { int R_, C_; stage_rc(opq_tid(wv) * 16 + i * 8192, R_, C_); vgc[h][i] = ((unsigned)S.row_of(nxt, h * HALF + R_) * (unsigned)K + (unsigned)C_) * 2u; } } }
            PG8_WAIT_V(8); PG8_WAIT_L(0); PG8_BAR; PG8_MMA(0, 0, At, B0); PG8_MMA(0, 1, At, B1); PG8_BAR; PG8_SCHED;
            PG8_LDA(At, 0, 1); PG8_STAGE(PG8_SB(0, 0), b2, voffB); PG8_STAGE(PG8_SB(0, 1), b2 + hstep, voffB); PG8_STAGE_A2(PG8_SA(0, 0), a2, 0, k2);
            PG8_WAIT_V(8); PG8_WAIT_L(0); PG8_BAR; PG8_MMA(1, 0, At, B0); PG8_MMA(1, 1, At, B1); PG8_BAR; PG8_SCHED;
            PG8_LDB(B0, 1, 0); PG8_LDB(B1, 1, 1); PG8_SCHED; PG8_LDA(At, 1, 0); PG8_STAGE_A2(PG8_SA(0, 1), a2, 1, k2);
            PG8_WAIT_V(8); PG8_WAIT_L(0); PG8_BAR; PG8_MMA(0, 0, At, B0); PG8_MMA(0, 1, At, B1); PG8_BAR; PG8_SCHED;
            PG8_LDA(At, 1, 1); PG8_STAGE(PG8_SB(1, 0), b3, voffB); PG8_STAGE(PG8_SB(1, 1), b3 + hstep, voffB); PG8_STAGE_A2(PG8_SA(1, 0), a2, 0, k3);
            PG8_WAIT_V(8); PG8_WAIT_L(0); PG8_BAR; PG8_MMA(1, 0, At, B0); PG8_MMA(1, 1, At, B1); PG8_BAR; PG8_SCHED;
        }
        if constexpr (ALIGN_EPI) { if (wr == 0) PG8_BAR; }
        E(acc, cur, wr, wc, fr, fq);
        if (!has_next) break;
#pragma unroll
        for (int a = 0; a < 2; ++a)
#pragma unroll
            for (int b = 0; b < 2; ++b)
#pragma unroll
                for (int m = 0; m < 4; ++m)
#pragma unroll
                    for (int n = 0; n < 2; ++n) acc[a][b][m][n] = (f32x4){0.f, 0.f, 0.f, 0.f};
        cur = nxt; cA = nA; cB = nB; ++ui;
        if constexpr (ALIGN_EPI) { if (wr == 1) PG8_BAR; }
    }
    PG8_WAIT_V(0);
    if constexpr (!ALIGN_EPI) { if (wr == 0) PG8_BAR; }
    PG8_BAR;
#undef PG8_SA
#undef PG8_SB
#undef PG8_STAGE
#undef PG8_STAGE_A
#undef PG8_STAGE_A2
#undef PG8_LDA
#undef PG8_LDB
#undef PG8_MMA
#undef PG8_F8
#undef PG8_WAIT_V
#undef PG8_WAIT_L
#undef PG8_BAR
#undef PG8_SCHED
}

struct RegOrder {
    int nM, nN, nwg, G, c, K; const char* Bt;
    __device__ __forceinline__ void init(int M, int N, int K_, const void* Bt_, int G_, int c_) { nM = M / BM; nN = N / BM; nwg = nM * nN; G = G_; c = c_; K = K_; Bt = (const char*)Bt_; }
    __device__ __forceinline__ bool next(int i, Unit& u) const {
        const long L = (long)i * G + c; if (L >= nwg) return false;
        int wgid = (int)L; { const int q = nwg / NXCD, r = nwg % NXCD, xcd = wgid % NXCD, off = wgid / NXCD; wgid = (xcd < r ? xcd * (q + 1) : r * (q + 1) + (xcd - r) * q) + off; }
        const int nig = WGM * nN, gid = wgid / nig, fm = gid * WGM, gsz = (nM - fm) < WGM ? (nM - fm) : WGM;
        const int pm = fm + ((wgid % nig) % gsz), pn = (wgid % nig) / gsz;
        u.arow = pm * BM; u.orow = pm * BM; u.ocol = pn * BM; u.e = 0; u.rt = 0; u.Bp = Bt + (size_t)pn * BM * K * 2; return true;
    }
    __device__ __forceinline__ int row_of(const Unit&, int) const { return 0; }
};
}
namespace at {
constexpr int NW = 8, QBLK = 32, KVBLK = 64, QB = NW * QBLK, D = 128;
constexpr int SHM_V = KVBLK * D * 2, SHM_K = KVBLK * D * 2;
constexpr int OFF_WS = 2 * SHM_V + 2 * SHM_K, OFF_NF = OFF_WS + NW * 64 * 4, ATT_LDS = OFF_NF + 2 * 64 * 4;
constexpr float SCALE = 0.08838834764831845f, C2 = 1.4426950408889634f * SCALE, THR = 8.f;
constexpr float ISCALE = 11.313708498984761f;
constexpr int QS = 128, KS = 128, VS = NZ, OS = DM;

#define KSWZ(row, colB) ((row) * 256 + ((colB) ^ (((row) & 7) << 4)))
#define SBAR() __builtin_amdgcn_sched_barrier(0)
__device__ __forceinline__ int v_st(int k, int c) { const int kk = (k & ~0xC) | ((k & 4) << 1) | ((k & 8) >> 1); return ((kk >> 3) * 4 + (c >> 5)) * 512 + ((kk & 7) * 32 + (c & 31)) * 2; }
__device__ __forceinline__ int v_rd_base(int lane) { return ((lane & 3) << 3) | (((lane >> 2) & 3) << 6) | (((lane >> 4) & 1) << 5) | (((lane >> 5) & 1) << 8); }
constexpr int v_rd_off(int d0, int ks, int half) { return d0 * 512 + ks * 4096 + half * 2048; }
__device__ __forceinline__ int crow(int r, int hi) { return (r & 3) + 8 * (r >> 2) + 4 * hi; }
__device__ __forceinline__ unsigned cvtpk(float lo, float hi) { unsigned r; asm volatile("v_cvt_pk_bf16_f32 %0, %1, %2" : "=v"(r) : "v"(lo), "v"(hi)); return r; }
__device__ __forceinline__ bf16x8 load8(const bf16* p) { return *(const GAS bf16x8*)p; }

__device__ __forceinline__ void mask_tile(f32x16& p0, f32x16& p1, int dq) {
    const float NEG = -__builtin_inff();
#pragma unroll
    for (int r = 0; r < 16; ++r) {
        const int c = (r & 3) + 8 * (r >> 2);
        if (dq - c < 0) p0[r] = NEG;
        if (dq - c - 32 < 0) p1[r] = NEG;
    }
}
__device__ __forceinline__ void partialSM(f32x16& p0, f32x16& p1, float& m_reg, float& mn, float& alpha) {
    float pmax = p0[0]; for (int r = 1; r < 16; ++r) pmax = fmaxf(pmax, p0[r]); for (int r = 0; r < 16; ++r) pmax = fmaxf(pmax, p1[r]);
    { auto rr = __builtin_amdgcn_permlane32_swap(__float_as_uint(pmax), __float_as_uint(pmax), false, false);
      pmax = fmaxf(__uint_as_float(rr[0]), __uint_as_float(rr[1])); }
    if (__builtin_expect(__all((pmax - m_reg) * SCALE <= THR), 1)) { mn = m_reg; alpha = 1.f; }
    else { mn = fmaxf(m_reg, pmax); alpha = __builtin_amdgcn_exp2f((m_reg - mn) * C2); m_reg = mn; }
    const float mnL = -mn * C2;
    for (int r = 0; r < 16; ++r) p0[r] = fmaf(p0[r], C2, mnL); for (int r = 0; r < 16; ++r) p1[r] = fmaf(p1[r], C2, mnL);
    for (int r = 0; r < 16; ++r) p0[r] = __builtin_amdgcn_exp2f(p0[r]);
}
__device__ __forceinline__ void finishSM(f32x16& p0, f32x16& p1, float alpha, float& l_reg, bf16x8& pa0, bf16x8& pa1, bf16x8& pa2, bf16x8& pa3) {
    for (int r = 0; r < 16; ++r) p1[r] = __builtin_amdgcn_exp2f(p1[r]);
    float ps = 0; for (int r = 0; r < 16; ++r) ps += p0[r]; for (int r = 0; r < 16; ++r) ps += p1[r];
    { auto rr = __builtin_amdgcn_permlane32_swap(__float_as_uint(ps), __float_as_uint(ps), false, false);
      ps = __uint_as_float(rr[0]) + __uint_as_float(rr[1]); }
    l_reg = l_reg * alpha + ps;
#define PK4(P, B_, OUT) do { unsigned a0 = cvtpk(P[B_+0], P[B_+1]), a1 = cvtpk(P[B_+2], P[B_+3]);                          \
        unsigned b0 = cvtpk(P[B_+4], P[B_+5]), b1 = cvtpk(P[B_+6], P[B_+7]);                                             \
        auto r0 = __builtin_amdgcn_permlane32_swap(a0, b0, false, false); auto r1 = __builtin_amdgcn_permlane32_swap(a1, b1, false, false); \
        u32x4 w = {r0[0], r1[0], r0[1], r1[1]}; OUT = *reinterpret_cast<bf16x8*>(&w); } while (0)
    PK4(p0, 0, pa0); PK4(p0, 8, pa1); PK4(p1, 0, pa2); PK4(p1, 8, pa3);
#undef PK4
}
template <int KB>
__device__ __forceinline__ void qkt(f32x16& p0, f32x16& p1, const char* K_lds, int r32, int hi, const bf16x8* qr) {
    { const float* nf = (const float*)(K_lds + 2 * SHM_K + NW * 64 * 4) + KB * 64 + 4 * hi;
#pragma unroll
      for (int g = 0; g < 4; ++g) { const f32x4 a = *(const f32x4*)(nf + 8 * g), b = *(const f32x4*)(nf + 32 + 8 * g);
#pragma unroll
          for (int j = 0; j < 4; ++j) { p0[4 * g + j] = a[j]; p1[4 * g + j] = b[j]; } } }
    const char* kb[4];
#pragma unroll
    for (int dd = 0; dd < 4; ++dd) kb[dd] = K_lds + KB * SHM_K + KSWZ(r32, (dd * 16 + hi * 8) * 2);
#pragma unroll
    for (int d0 = 0; d0 < 8; ++d0) { const char* a = kb[d0 & 3] + (d0 >> 2) * 128;
        bf16x8 b0 = *reinterpret_cast<const bf16x8*>(a);
        bf16x8 b1 = *reinterpret_cast<const bf16x8*>(a + 32 * 256);
        p0 = __builtin_amdgcn_mfma_f32_32x32x16_bf16(b0, qr[d0], p0, 0, 0, 0);
        p1 = __builtin_amdgcn_mfma_f32_32x32x16_bf16(b1, qr[d0], p1, 0, 0, 0); }
}
template <int VB>
__device__ __forceinline__ void pv_tile(f32x16* o, int vb0, bf16x8 pa0, bf16x8 pa1, bf16x8 pa2, bf16x8 pa3) {
#define TRRD(dst, off) asm volatile("ds_read_b64_tr_b16 %0, %1 offset:%2" : "=&v"(dst) : "v"(vb0), "i"(off) : "memory")
#define PV_D0(d0) do { s16x4 l0, l1, l2, l3, h0, h1, h2, h3; constexpr int b_ = VB * SHM_V + v_rd_off(d0, 0, 0); \
        TRRD(l0, b_); TRRD(h0, b_ + 2048); TRRD(l1, b_ + 4096); TRRD(h1, b_ + 6144); TRRD(l2, b_ + 8192); TRRD(h2, b_ + 10240); TRRD(l3, b_ + 12288); TRRD(h3, b_ + 14336); \
        asm volatile("s_waitcnt lgkmcnt(0)" ::: "memory"); SBAR();   \
        o[d0] = __builtin_amdgcn_mfma_f32_32x32x16_bf16(pa0, (bf16x8){l0[0], l0[1], l0[2], l0[3], h0[0], h0[1], h0[2], h0[3]}, o[d0], 0, 0, 0);   \
        o[d0] = __builtin_amdgcn_mfma_f32_32x32x16_bf16(pa1, (bf16x8){l1[0], l1[1], l1[2], l1[3], h1[0], h1[1], h1[2], h1[3]}, o[d0], 0, 0, 0);   \
        o[d0] = __builtin_amdgcn_mfma_f32_32x32x16_bf16(pa2, (bf16x8){l2[0], l2[1], l2[2], l2[3], h2[0], h2[1], h2[2], h2[3]}, o[d0], 0, 0, 0);   \
        o[d0] = __builtin_amdgcn_mfma_f32_32x32x16_bf16(pa3, (bf16x8){l3[0], l3[1], l3[2], l3[3], h3[0], h3[1], h3[2], h3[3]}, o[d0], 0, 0, 0); } while (0)
    PV_D0(0); PV_D0(1); PV_D0(2); PV_D0(3);
#undef PV_D0
#undef TRRD
}

struct BlockRef { const bf16* Q; const bf16* K; const bf16* V; unsigned char* O; const float* FK; int P0; };
#define ROWV(p, k0, rr) ((p) + (size_t)((k0) + (rr)) * VS + sc)
#define VMW() asm volatile("s_waitcnt vmcnt(0)" ::: "memory")
__device__ __forceinline__ void attn_block(const BlockRef& cur, int ja, int nt, bool fin, bf16* Opart, float* ML, char* lds, LAS unsigned char* ldsL, const int wv) {
    const int tid = opq_tid(wv), wid = wv, lane = tid & 63, r32 = lane & 31, hi = lane >> 5;
    const int NT = nt;
    const int qlo = cur.P0 + wid * QBLK, qm = qlo + r32 - 4 * hi;
    char* V_lds = lds; char* K_lds = lds + 2 * SHM_V;
    float* ws = (float*)(lds + OFF_WS) + wid * 64; float* li_l = ws, * al_l = ws + 32;
    float m_reg = -1e30f, l_reg = 0; f32x16 o[4] = {};
    const int vb0 = (int)(uintptr_t)V_lds + v_rd_base(lane);
    const bf16* Kh = cur.K; const bf16* Vh = cur.V; const float* Fh = cur.FK;
    bf16x8 st_v0, st_v1; bf16x8 qr[8];
#define KDMA(bf, k0) do { int t_ = tid; asm volatile("" : "+v"(t_)); _Pragma("unroll") for (int i_ = 0; i_ < 2; ++i_) { const int p_ = i_ * 512 + t_, r_ = p_ >> 4, c_ = (p_ & 15) ^ (r_ & 7); \
        __builtin_amdgcn_global_load_lds((const unsigned*)((const char*)Kh + (size_t)(k0) * KS * 2 + (unsigned)(r_ * KS * 2 + c_ * 16)), (LAS unsigned*)(ldsL + 2 * SHM_V + (bf) * SHM_K + i_ * 8192 + wid * 1024), 16, 0, 0); } \
        if (wid == 0) __builtin_amdgcn_global_load_lds((const unsigned*)(Fh + (k0) + lane), (LAS unsigned*)(ldsL + OFF_NF + (bf) * 256), 4, 0, 0); } while (0)
#define SLOADV(k0) do { int t_ = tid; asm volatile("" : "+v"(t_)); const int sr = t_ >> 4, sc = (t_ & 15) * 8; st_v0 = load8(ROWV(Vh, k0, sr)); st_v1 = load8(ROWV(Vh, k0, 32 + sr)); } while (0)
#define SWRITE_HV(bf) do { int t_ = tid; asm volatile("" : "+v"(t_)); const int sr = t_ >> 4, sc = (t_ & 15) * 8; *(bf16x8*)(V_lds + (bf) * SHM_V + v_st(sr, sc)) = st_v0; *(bf16x8*)(V_lds + (bf) * SHM_V + v_st(32 + sr, sc)) = st_v1; } while (0)
#define RESC(a) do { if (__any((a) < 1.f)) { if (hi == 0) al_l[r32] = (a); asm volatile("s_waitcnt lgkmcnt(0)" ::: "memory");              \
                     for (int d_ = 0; d_ < 4; ++d_) for (int r = 0; r < 16; ++r) o[d_][r] *= al_l[crow(r, hi)]; } } while (0)
#define KBASE(t) ((ja + (t)) * KVBLK)
#define MASKT(P0_, P1_, t) do { const int kb_ = KBASE(t); if (kb_ + KVBLK - 1 > qlo) mask_tile(P0_, P1_, qm - kb_); } while (0)
    f32x16 pA0, pA1, pB0, pB1; float mnA, mnB, alA, alB; bf16x8 pa0, pa1, pa2, pa3;
    KDMA(0, KBASE(0)); SLOADV(KBASE(0));
#pragma unroll
    for (int d0 = 0; d0 < 8; ++d0) qr[d0] = load8(cur.Q + (size_t)(wid * QBLK + r32) * QS + d0 * 16 + hi * 8);
    VMW(); SWRITE_HV(0);
    __syncthreads();
    if (NT > 1) { KDMA(1, KBASE(1)); SLOADV(KBASE(1)); }
    SBAR(); qkt<0>(pA0, pA1, K_lds, r32, hi, qr);
    MASKT(pA0, pA1, 0); partialSM(pA0, pA1, m_reg, mnA, alA);
    if (NT > 1) { VMW(); SWRITE_HV(1); }
    __syncthreads();
#define HALF_STEP(PX0, PX1, mnX, alX, PY0, PY1, alY, t, KB, VB, SB) do {                                                      \
        SBAR(); qkt<KB>(PX0, PX1, K_lds, r32, hi, qr);                                                                        \
        finishSM(PY0, PY1, alY, l_reg, pa0, pa1, pa2, pa3); SBAR();                                                           \
        if ((t) + 1 < NT) { KDMA(SB, KBASE((t) + 1)); SLOADV(KBASE((t) + 1)); SBAR(); }                                       \
        pv_tile<VB>(o, vb0, pa0, pa1, pa2, pa3); MASKT(PX0, PX1, (t)); partialSM(PX0, PX1, m_reg, mnX, alX);                  \
        VMW(); __syncthreads();                                                                                               \
        if ((t) + 1 < NT) { SWRITE_HV(SB); }                                                                                  \
        RESC(alX); __syncthreads(); } while (0)
    for (int t = 1; t + 1 < NT; t += 2) {
        HALF_STEP(pB0, pB1, mnB, alB, pA0, pA1, alA, t, 1, 0, 0);
        HALF_STEP(pA0, pA1, mnA, alA, pB0, pB1, alB, t + 1, 0, 1, 1);
    }
    const bool even = (NT & 1) == 0;
    if (even) { SBAR(); qkt<1>(pB0, pB1, K_lds, r32, hi, qr); SBAR(); }
    finishSM(pA0, pA1, alA, l_reg, pa0, pa1, pa2, pa3); SBAR();
    pv_tile<0>(o, vb0, pa0, pa1, pa2, pa3);
    if (even) { MASKT(pB0, pB1, NT - 1); partialSM(pB0, pB1, m_reg, mnB, alB); __syncthreads(); RESC(alB);
        finishSM(pB0, pB1, alB, l_reg, pa0, pa1, pa2, pa3); SBAR(); pv_tile<1>(o, vb0, pa0, pa1, pa2, pa3); }
    SBAR();
    if (hi == 0) li_l[r32] = l_reg; asm volatile("s_waitcnt lgkmcnt(0)" ::: "memory");
    float rli[16];
#pragma unroll
    for (int r = 0; r < 16; ++r) rli[r] = __builtin_amdgcn_rcpf(li_l[crow(r, hi)]);
    if (fin) {
        unsigned char* Ow = cur.O + (size_t)(wid * QBLK) * OS;
#pragma unroll
        for (int r = 0; r < 16; ++r) { const int orow = crow(r, hi);
#pragma unroll
            for (int d0 = 0; d0 < 4; ++d0) { const float v = o[d0][r] * rli[r] * H8_SCALE; const int vi = (int)__float_as_uint(v);
                const float v1 = __uint_as_float((unsigned)__builtin_amdgcn_mov_dpp(vi, 0x55, 0xf, 0xf, true)), v2 = __uint_as_float((unsigned)__builtin_amdgcn_mov_dpp(vi, 0xaa, 0xf, 0xf, true)), v3 = __uint_as_float((unsigned)__builtin_amdgcn_mov_dpp(vi, 0xff, 0xf, 0xf, true));
                const unsigned w = cvt_pk4_fp8(v, v1, v2, v3);
                if ((r32 & 3) == 0) *(GAS unsigned*)(Ow + (size_t)orow * OS + d0 * 32 + r32) = w; } }
    } else {
        bf16* Ow = Opart + (size_t)(wid * QBLK) * D;
#pragma unroll
        for (int r = 0; r < 16; ++r) { const int orow = crow(r, hi);
#pragma unroll
            for (int d0 = 0; d0 < 4; ++d0) { const float v = o[d0][r] * rli[r];
                const float vn = xor_f<1>(v);
                if ((r32 & 1) == 0) __hip_atomic_store((unsigned*)(Ow + (size_t)orow * D + d0 * 32 + r32), cvtpk(v, vn), RLX_AGENT); } }
    }
    if (!fin) { if (hi == 0) { float* const pm = ML + (size_t)(wid * QBLK + r32) * 2; __hip_atomic_store(pm, m_reg, RLX_AGENT); __hip_atomic_store(pm + 1, l_reg, RLX_AGENT); }
        asm volatile("s_waitcnt vmcnt(0)" ::: "memory"); }
    __syncthreads();
#undef KDMA
#undef SLOADV
#undef SWRITE_HV
#undef RESC
#undef KBASE
#undef MASKT
#undef HALF_STEP
}
#undef ROWV
#undef VMW
}
struct Frame {
    LAS unsigned char* lds; volatile LAS unsigned* MISC; gu32* ctl;
    int tid, lane, wave, vcu, G;
    unsigned char* ws;
};
#define CAS __attribute__((address_space(4)))
__device__ __forceinline__ const float* karg(int k) { const CAS char* p = (const CAS char*)__builtin_amdgcn_kernarg_segment_ptr(); asm volatile("" : "+s"(p)); return *(const float* const CAS*)(p + 8 * k); }

__device__ __forceinline__ void tr_item(const float* W, size_t ldw, bf16* WT, size_t ldk, LAS float* scr, int lane) {
    const int kr = lane >> 3, c4 = (lane & 7) * 4;
    f32x4 v[8];
#pragma unroll
    for (int i = 0; i < 8; ++i) v[i] = __builtin_nontemporal_load((const GAS f32x4*)(W + (size_t)(8 * i + kr) * ldw + c4));
#pragma unroll
    for (int i = 0; i < 8; ++i) { LAS float* s = scr + (8 * i + kr) * 33 + c4; s[0] = v[i].x; s[1] = v[i].y; s[2] = v[i].z; s[3] = v[i].w; }
    LDS_WAIT();
    const int c = lane & 7;
#pragma unroll
    for (int j = 0; j < 4; ++j) { const int n = (lane >> 3) + 8 * j; const LAS float* s = scr + (8 * c) * 33 + n;
        u32x4 o; o.x = cvt_pk_bf16(s[0 * 33], s[1 * 33]); o.y = cvt_pk_bf16(s[2 * 33], s[3 * 33]); o.z = cvt_pk_bf16(s[4 * 33], s[5 * 33]); o.w = cvt_pk_bf16(s[6 * 33], s[7 * 33]);
        *(GAS u32x4*)(WT + (size_t)n * ldk + 8 * c) = o; }
    LDS_WAIT();
}
__device__ __forceinline__ void tr_item8(const float* W, size_t ldw, unsigned char* WT, size_t ldk, LAS float* scr, int lane) {
    const int kr = lane >> 3, c4 = (lane & 7) * 4;
    f32x4 v[2][8];
#pragma unroll
    for (int hh = 0; hh < 2; ++hh)
#pragma unroll
        for (int i = 0; i < 8; ++i) v[hh][i] = __builtin_nontemporal_load((const GAS f32x4*)(W + (size_t)(8 * i + kr) * ldw + 32 * hh + c4));
#pragma unroll
    for (int hh = 0; hh < 2; ++hh) {
#pragma unroll
        for (int i = 0; i < 8; ++i) { LAS float* s = scr + (8 * i + kr) * 33 + c4; s[0] = v[hh][i].x; s[1] = v[hh][i].y; s[2] = v[hh][i].z; s[3] = v[hh][i].w; }
        LDS_WAIT();
        const int c = lane & 3;
#pragma unroll
        for (int j = 0; j < 2; ++j) { const int n = (lane >> 2) + 16 * j; const LAS float* s = scr + (16 * c) * 33 + n;
            u32x4 o;
            o.x = cvt_pk4_fp8(s[0 * 33] * W8_SCALE, s[1 * 33] * W8_SCALE, s[2 * 33] * W8_SCALE, s[3 * 33] * W8_SCALE); o.y = cvt_pk4_fp8(s[4 * 33] * W8_SCALE, s[5 * 33] * W8_SCALE, s[6 * 33] * W8_SCALE, s[7 * 33] * W8_SCALE);
            o.z = cvt_pk4_fp8(s[8 * 33] * W8_SCALE, s[9 * 33] * W8_SCALE, s[10 * 33] * W8_SCALE, s[11 * 33] * W8_SCALE); o.w = cvt_pk4_fp8(s[12 * 33] * W8_SCALE, s[13 * 33] * W8_SCALE, s[14 * 33] * W8_SCALE, s[15 * 33] * W8_SCALE);
            *(GAS u32x4*)(WT + (size_t)(32 * hh + n) * ldk + 16 * c) = o; }
        LDS_WAIT();
    }
}
constexpr int I_IN = (DM / 64) * (NZ / 32), I_OUT = (DM / 64) * (DM / 32), I_GU = (DM / 64) * (DEX / 32), I_D = (DEX / 64) * (DM / 32);
constexpr int GV_FIRST = 43;
constexpr int BGI_SMALL = (NLAYER * 4 * 8) / 8, BGI_IN = I_IN / 16, BGI_GV0 = (128 - GV_FIRST) * 4, BGI_GV1 = 128 * 4, BGI_OUT = I_OUT / 16, BGI_GU = NEXP * 2 * I_GU / 16, BGI_D = NEXP * I_D / 16;
constexpr int BG_C0 = BGI_SMALL + BGI_IN;
constexpr int BG_C1 = BG_C0 + BGI_GV0 + BGI_OUT;
constexpr int BG_C2 = BG_C1 + BGI_GU;
constexpr int BG_C3 = BG_C2 + BGI_D;
constexpr int BG_C3B = BG_C3 + BGI_GV1;
constexpr int BG_C4 = BG_C3B + BGI_IN;
constexpr int BG_C5 = BG_C4 + BGI_OUT;
constexpr int BG_C6 = BG_C5 + BGI_GU;
constexpr int BG_C7 = BG_C6 + BGI_D;
__device__ __forceinline__ float mod_at(const unsigned char* ws, const float* b_ada, int l, int j) {
    const float* p = (const float*)(ws + WS_MODP) + (size_t)l * 6 * DM + j;
    return *(const GAS float*)(b_ada + (size_t)l * 6 * DM + j) + ((*(const GAS float*)p + *(const GAS float*)(p + 2 * 6 * DM)) + (*(const GAS float*)(p + 4 * 6 * DM) + *(const GAS float*)(p + 6 * 6 * DM)));
}
__device__ __forceinline__ void mod_ld(const unsigned char* ws, const float* b_ada, int l, int j, float (&r)[5]) {
    const float* p = (const float*)(ws + WS_MODP) + (size_t)l * 6 * DM + j;
    r[0] = *(const GAS float*)(b_ada + (size_t)l * 6 * DM + j); r[1] = *(const GAS float*)p; r[2] = *(const GAS float*)(p + 2 * 6 * DM); r[3] = *(const GAS float*)(p + 4 * 6 * DM); r[4] = *(const GAS float*)(p + 6 * 6 * DM);
}
__device__ __forceinline__ float mod_sum(const float (&r)[5]) { return r[0] + ((r[1] + r[2]) + (r[3] + r[4])); }
__device__ __forceinline__ void gemv_item(const Frame& F, unsigned char* ws, int w) {
    LAS float* sc = (LAS float*)F.lds; LAS f32x4* red = (LAS f32x4*)(F.lds + 8192);
    const int kq = w & 3, l = w >> 9, cb = (w >> 2) & 127, c4 = F.tid % 24, kg = F.tid / 24;
    if (F.tid < 512) sc[F.tid] = silu_f(*(const GAS float*)(karg(1) + kq * 512 + F.tid));
    __syncthreads();
    f32x4 acc = (f32x4){0.f, 0.f, 0.f, 0.f};
    if (kg < 21) {
        const float* wp = karg(2) + (size_t)l * DM * 6 * DM + (size_t)(kq * 512) * 6 * DM + cb * 96 + c4 * 4;
#pragma unroll
        for (int b0 = 0; b0 < 24; b0 += 8) { f32x4 wq[8];
#pragma unroll
            for (int it = 0; it < 8; ++it) wq[it] = __builtin_nontemporal_load((const GAS f32x4*)(wp + (size_t)(kg + 21 * (b0 + it)) * 6 * DM));
#pragma unroll
            for (int it = 0; it < 8; ++it) acc += wq[it] * sc[kg + 21 * (b0 + it)]; }
        if (kg < 8) { const f32x4 wv = __builtin_nontemporal_load((const GAS f32x4*)(wp + (size_t)(kg + 504) * 6 * DM)); acc += wv * sc[kg + 504]; }
        red[kg * 24 + c4] = acc;
    }
    __syncthreads();
    if (F.tid < 24) { f32x4 s = red[F.tid];
        for (int g = 1; g < 21; ++g) s += red[g * 24 + F.tid];
        *(GAS f32x4*)((float*)(ws + WS_MODP) + (size_t)kq * 2 * 6 * DM + (size_t)l * 6 * DM + cb * 96 + F.tid * 4) = s; }
    __syncthreads();
}
__device__ __forceinline__ void conv_wave_item(const Frame& F, unsigned char* ws, int r, int l, LAS float* scr) {
    if (r < I_IN) { const int kb = r / (NZ / 32), nb = r % (NZ / 32);
        tr_item8(karg(6) + (size_t)l * DM * NIN + (size_t)(64 * kb) * NIN + 32 * nb, NIN, ws + WS_WIN + (size_t)l * NZ * DM + (size_t)(32 * nb) * DM + 64 * kb, DM, scr, F.lane); return; }
    r -= I_IN;
    if (r < I_OUT) { const int kb = r / (DM / 32), nb = r % (DM / 32);
        tr_item8(karg(15) + (size_t)l * DM * DM + (size_t)(64 * kb) * DM + 32 * nb, DM, ws + WS_WOUT + (size_t)l * DM * DM + (size_t)(32 * nb) * DM + 64 * kb, DM, scr, F.lane); return; }
    r -= I_OUT;
    if (r < NEXP * 2 * I_GU) { const int e = r / (2 * I_GU); r -= e * 2 * I_GU; const int up = r >= I_GU; if (up) r -= I_GU; const int kb = r / (DEX / 32), nb = r % (DEX / 32), n0 = 32 * nb;
        const float* src = (up ? karg(19) : karg(18)) + ((size_t)l * NEXP + e) * DM * DEX + (size_t)(64 * kb) * DEX + n0;
        const int drow = (n0 >> 7) * 256 + (up ? 128 : 0) + (n0 & 127);
        tr_item8(src, DEX, ws + WS_WGU + ((size_t)l * NEXP + e) * DM * DM + (size_t)drow * DM + 64 * kb, DM, scr, F.lane); return; }
    r -= NEXP * 2 * I_GU;
    { const int e = r / I_D; r -= e * I_D; const int kb = r / (DM / 32), nb = r % (DM / 32);
      tr_item8(karg(20) + ((size_t)l * NEXP + e) * DEX * DM + (size_t)(64 * kb) * DM + 32 * nb, DM, ws + WS_WD + ((size_t)l * NEXP + e) * DM * DEX + (size_t)(32 * nb) * DEX + 64 * kb, DEX, scr, F.lane); }
}
__device__ __forceinline__ void bg_item(const Frame& F, unsigned char* ws, int t) {
    LAS float* scr = (LAS float*)(F.lds + 16384 + F.wave * 9216);
    if (t < BGI_SMALL) { const int r = t * 8 + F.wave, mat = r >> 3, q = r & 7, kb = q >> 2, nb = q & 3;
        tr_item(karg(10) + (size_t)mat * 128 * 128 + (size_t)(64 * kb) * 128 + 32 * nb, 128, (bf16*)(ws + WS_BWT) + (size_t)mat * 128 * 128 + (size_t)(32 * nb) * 128 + 64 * kb, 128, scr, F.lane); return; }
    t -= BGI_SMALL;
    if (t < BGI_IN) { conv_wave_item(F, ws, (t * 8 + F.wave) * 2, 0, scr); return; }
    t -= BGI_IN;
    if (t < BGI_GV0) { gemv_item(F, ws, GV_FIRST * 4 + t); return; }
    t -= BGI_GV0;
    if (t < BGI_OUT) { conv_wave_item(F, ws, I_IN + (t * 8 + F.wave) * 2, 0, scr); return; }
    t -= BGI_OUT;
    if (t < BGI_GU + BGI_D) { conv_wave_item(F, ws, I_IN + I_OUT + (t * 8 + F.wave) * 2, 0, scr); return; }
    t -= BGI_GU + BGI_D;
    if (t < BGI_GV1) { gemv_item(F, ws, 512 + t); return; }
    t -= BGI_GV1;
    if (t < BGI_IN) { conv_wave_item(F, ws, (t * 8 + F.wave) * 2, 1, scr); return; }
    t -= BGI_IN;
    if (t < BGI_OUT) { conv_wave_item(F, ws, I_IN + (t * 8 + F.wave) * 2, 1, scr); return; }
    t -= BGI_OUT;
    conv_wave_item(F, ws, I_IN + I_OUT + (t * 8 + F.wave) * 2, 1, scr);
}
__device__ __forceinline__ void bg_fill(const Frame& F0, int seam, int need, int expect, bool self) {
    unsigned char* const ws = opq(F0.ws); Frame F = F0; F.tid = opq_tid(F0.wave); F.lane = F.tid & 63; F.lds = opq(F0.lds);
    LAS unsigned* slot = (LAS unsigned*)(F.lds + AUX_OFF + 24576);
    gu32* const ctl_ = opq(F0.ctl); gu32* ticket = ctl_ + CW_BGT; gu32* arr = ctl_ + CW_ARR + 64 * seam;
    unsigned tn = 0xffffffffu; bool pre = false;
    if (F.tid == 0 && slot[1] == 0u) {
        const unsigned a0 = self ? __hip_atomic_fetch_add(arr, 1u, RLX_AGENT) + 1u : __hip_atomic_load(arr, RLX_AGENT); const unsigned cur = __hip_atomic_load(ticket, RLX_AGENT);
        if (cur >= (unsigned)BG_C7) slot[1] = 1u;
        else if (cur < (unsigned)need || a0 < (unsigned)expect) tn = __hip_atomic_fetch_add(ticket, 1u, RLX_AGENT); }
    for (;;) {
        if (F.tid == 0) slot[0] = tn;
        __syncthreads();
        const unsigned t = __builtin_amdgcn_readfirstlane(slot[0]);
        __syncthreads();
        if (t >= (unsigned)BG_C7) { if (F.tid == 0 && t != 0xffffffffu) slot[1] = 1u; break; }
        if (F.tid == 0) { tn = 0xffffffffu; pre = (t + 2u < (unsigned)need);
            if (pre) tn = __hip_atomic_fetch_add(ticket, 1u, RLX_AGENT); }
        bg_item(F, ws, (int)t);
        if (F.tid == 0 && !pre) { if (t + 1u < (unsigned)need || __hip_atomic_load(arr, RLX_AGENT) < (unsigned)expect) tn = __hip_atomic_fetch_add(ticket, 1u, RLX_AGENT); }
    }
}
__device__ __forceinline__ void p0_prologue(const Frame& F0) {
    unsigned char* const ws = opq(F0.ws); Frame F = F0; F.tid = opq_tid(F0.wave); F.lane = F.tid & 63; F.lds = opq(F0.lds);
    for (int w = F.vcu; w < GV_FIRST * 4; w += F.G) gemv_item(F, ws, w);
    const float* const a_ws_ = karg(7);
    for (int i = (F.vcu * NTHR + F.tid) * 2; i < NLAYER * 4 * 128 * 128; i += F.G * NTHR * 2) {
        const int t = (i >> 7) & 127, s = i & 127;
        const f32x2 w = *(const GAS f32x2*)(a_ws_ + i);
        const bool keep = (s >> 6) <= (t >> 6);
        *(GAS unsigned*)((bf16*)(ws + WS_WM) + i) = keep ? cvt_pk_bf16(w.x, w.y) : 0u;
    }
}

template <int MODE>
__device__ __forceinline__ void phase_norm1(const Frame& F0, int l, const void* xin, void* xout, int lprev) {
    unsigned char* const ws = opq(F0.ws); Frame F = F0; F.tid = opq_tid(F0.wave); F.lane = F.tid & 63; F.lds = opq(F0.lds);
    LAS float* wfT = (LAS float*)F.lds;
    LAS float* gaL = (LAS float*)(F.lds + 65536);
    LAS float* gbL = (LAS float*)(F.lds + 73728);
    LAS float* g2L = (LAS float*)(F.lds + 81920);
    LAS float* lf = (LAS float*)(F.lds + 90112);
    LAS int* hb = (LAS int*)(F.lds + 91136);
    const float* const b_ada_ = karg(3); const float* const c_bf_ = karg(14);
    if (MODE != 2) {
        const float* const w_in_ = karg(6); const float* const g_mix_ = karg(4);
        f32x4 wq[8]; float gm_[4], ms_[4][5], mh_[4][5];
#pragma unroll
        for (int it = 0; it < 8; ++it) { const int i = F.tid + it * NTHR, d = i >> 1, half = i & 1; wq[it] = *(const GAS f32x4*)(w_in_ + (size_t)l * DM * NIN + (size_t)d * NIN + NZ + half * 4); }
#pragma unroll
        for (int it = 0; it < 4; ++it) { const int d = F.tid + it * NTHR; gm_[it] = *(const GAS float*)(g_mix_ + (size_t)l * DM + d); mod_ld(ws, b_ada_, l, DM + d, ms_[it]); mod_ld(ws, b_ada_, l, d, mh_[it]); }
#pragma unroll
        for (int it = 0; it < 8; ++it) { const int i = F.tid + it * NTHR, d = i >> 1, half = i & 1; const f32x4 w = wq[it];
            wfT[(half * 4 + 0) * DM + d] = w.x; wfT[(half * 4 + 1) * DM + d] = w.y; wfT[(half * 4 + 2) * DM + d] = w.z; wfT[(half * 4 + 3) * DM + d] = w.w; }
#pragma unroll
        for (int it = 0; it < 4; ++it) { const int d = F.tid + it * NTHR; gaL[d] = gm_[it] * (1.f + mod_sum(ms_[it])); gbL[d] = mod_sum(mh_[it]); }
    }
    if (MODE != 0) {
        { float m2_[4][5];
#pragma unroll
          for (int it = 0; it < 4; ++it) mod_ld(ws, b_ada_, lprev, 5 * DM + F.tid + it * NTHR, m2_[it]);
#pragma unroll
          for (int it = 0; it < 4; ++it) g2L[F.tid + it * NTHR] = mod_sum(m2_[it]); }
        if (F.tid < NEXP) hb[16 + F.tid] = ((int)__hip_atomic_load(F.ctl + CW_CNT + 64 * lprev + F.tid, RLX_AGENT) + 255) & ~255;
        __syncthreads();
        if (F.tid == 0) { int a = 0; for (int e = 0; e < NEXP; ++e) { hb[e] = a; a += hb[16 + e]; } }
    }
    __syncthreads();
    const bf16* YB = (const bf16*)(ws + WS_YB);
    f32x4 vA[8], vB[8]; u32x2 xA[8], xB[8], yA0[8], yA1[8], yB0[8], yB1[8];
#define N1_LOAD(V, XR, Y0, Y1, rr) do { const int t_ = c * 32 + F.wave * 4 + (rr);                                                             \
        if (MODE == 0) { _Pragma("unroll") for (int j = 0; j < 8; ++j) V[j] = *(const GAS f32x4*)((const float*)xin + (size_t)t_ * DM + 256 * j + 4 * F.lane); }   \
        else { _Pragma("unroll") for (int j = 0; j < 8; ++j) XR[j] = *(const GAS u32x2*)((const bf16*)xin + (size_t)t_ * DM + 256 * j + 4 * F.lane); }              \
        if (MODE != 0) { const int r0_ = __builtin_amdgcn_readlane(rowA, (rr)), r1_ = __builtin_amdgcn_readlane(rowB, (rr));                      \
            _Pragma("unroll") for (int j = 0; j < 8; ++j) { const int d = 256 * j + 4 * F.lane;                                                    \
                Y0[j] = *(const GAS u32x2*)(YB + (size_t)r0_ * DM + d); Y1[j] = *(const GAS u32x2*)(YB + (size_t)r1_ * DM + d); } } } while (0)
#define N1_PROC(V, XR, Y0, Y1, rr) do { const int rl = F.wave * 4 + (rr), t = c * 32 + rl;                                                      \
        if (MODE != 0) { _Pragma("unroll") for (int j = 0; j < 8; ++j) { V[j].x = bf_lo(XR[j].x); V[j].y = bf_hi(XR[j].x); V[j].z = bf_lo(XR[j].y); V[j].w = bf_hi(XR[j].y); } }   \
        if (MODE != 0) { const float w0 = __builtin_bit_cast(float, __builtin_amdgcn_readlane(__builtin_bit_cast(int, gwA), (rr))), w1 = __builtin_bit_cast(float, __builtin_amdgcn_readlane(__builtin_bit_cast(int, gwB), (rr))); \
            _Pragma("unroll") for (int j = 0; j < 8; ++j) { const int d = 256 * j + 4 * F.lane;                                                    \
                const f32x4 g2 = *(const LAS f32x4*)(g2L + d); const u32x2 y0 = Y0[j], y1 = Y1[j];                                                 \
                f32x4 y; y.x = w0 * bf_lo(y0.x) + w1 * bf_lo(y1.x); y.y = w0 * bf_hi(y0.x) + w1 * bf_hi(y1.x); y.z = w0 * bf_lo(y0.y) + w1 * bf_lo(y1.y); y.w = w0 * bf_hi(y0.y) + w1 * bf_hi(y1.y); \
                V[j] = V[j] + g2 * y;                                                                                                               \
                if (MODE == 2) *(GAS f32x4*)((float*)xout + (size_t)t * DM + d) = V[j];                                                            \
                else { u32x2 o_; o_.x = cvt_pk_bf16(V[j].x, V[j].y); o_.y = cvt_pk_bf16(V[j].z, V[j].w); *(GAS u32x2*)((bf16*)xout + (size_t)t * DM + d) = o_; } } }   \
        if (MODE != 2) {                                                                                                                           \
            float ss = 0.f;                                                                                                                        \
            _Pragma("unroll") for (int j = 0; j < 8; ++j) ss += (V[j].x * V[j].x + V[j].y * V[j].y) + (V[j].z * V[j].z + V[j].w * V[j].w);         \
            const float rs = rsqrtf(wave_sum(ss) * (1.f / DM) + EPSN);                                                                             \
            float fz[8] = {0.f, 0.f, 0.f, 0.f, 0.f, 0.f, 0.f, 0.f};                                                                                \
            unsigned char* hrow = ws + WS_H + (size_t)t * DM;                                   \
            _Pragma("unroll") for (int j = 0; j < 8; ++j) { const int d = 256 * j + 4 * F.lane;                                                    \
                const f32x4 h = V[j] * rs * *(const LAS f32x4*)(gaL + d) + *(const LAS f32x4*)(gbL + d);                                           \
                *(GAS unsigned*)(hrow + d) = cvt_pk4_fp8(h.x * H8_SCALE, h.y * H8_SCALE, h.z * H8_SCALE, h.w * H8_SCALE);                          \
                _Pragma("unroll") for (int q = 0; q < 8; ++q) { const f32x4 w = *(const LAS f32x4*)(wfT + q * DM + d); fz[q] += (h.x * w.x + h.y * w.y) + (h.z * w.z + h.w * w.w); } } \
            _Pragma("unroll") for (int q = 0; q < 8; ++q) fz[q] = wave_sum(fz[q]);                                                                 \
            if (F.lane < 8) { float z = fz[0];                                                                                                     \
                _Pragma("unroll") for (int q = 1; q < 8; ++q) z = (F.lane == q) ? fz[q] : z;                                                       \
                z += *(const GAS float*)(c_bf_ + l * 8 + F.lane);                                                                                  \
                lf[rl * 8 + F.lane] = fminf(z, 0.f) - 0.6931471805599453f * __builtin_amdgcn_logf(1.f + __builtin_amdgcn_exp2f(-LOG2E * fabsf(z))); } } } while (0)
    for (int c = F.vcu; c < SEQ / 32; c += F.G) {
        int rowA = 0, rowB = 0; float gwA = 0.f, gwB = 0.f;
        if (MODE != 0) { const int t_ = c * 32 + F.wave * 4 + (F.lane & 3);
            const int* te = (const int*)(ws + WS_TOKE) + 2 * t_; const int* tp = (const int*)(ws + WS_TOKP) + 2 * t_; const float* tw = (const float*)(ws + WS_TOKW) + 2 * t_;
            rowA = hb[*(const GAS int*)te] + *(const GAS int*)tp; rowB = hb[*(const GAS int*)(te + 1)] + *(const GAS int*)(tp + 1); gwA = *(const GAS float*)tw; gwB = *(const GAS float*)(tw + 1); }
        N1_LOAD(vA, xA, yA0, yA1, 0); N1_LOAD(vB, xB, yB0, yB1, 1);
        N1_PROC(vA, xA, yA0, yA1, 0); N1_LOAD(vA, xA, yA0, yA1, 2);
        N1_PROC(vB, xB, yB0, yB1, 1); N1_LOAD(vB, xB, yB0, yB1, 3);
        N1_PROC(vA, xA, yA0, yA1, 2); N1_PROC(vB, xB, yB0, yB1, 3);
        if (MODE != 2) {
            __syncthreads();
            if (F.tid < 8) { float a = 0.f; float* floc = (float*)(ws + WS_FLOC);
                for (int r = 0; r < 32; ++r) { a += lf[r * 8 + F.tid]; *(GAS float*)(floc + (size_t)(c * 32 + r) * 8 + F.tid) = a; }
                *(GAS float*)((float*)(ws + WS_TOT) + c * 8 + F.tid) = a; }
            __syncthreads();
        }
    }
#undef N1_LOAD
#undef N1_PROC
}

__device__ __forceinline__ void fkl_fixup(const Frame& F0) {
    unsigned char* const ws = opq(F0.ws); Frame F = F0; F.tid = opq_tid(F0.wave); F.lane = F.tid & 63; F.lds = opq(F0.lds);
    LAS float* preL = (LAS float*)(F.lds + AUX_OFF + 8192);
    const float* tot = (const float*)(ws + WS_TOT);
    for (int c = F.vcu; c < SEQ / 32; c += F.G) {
        { const int h = F.wave; double s = 0.0;
#pragma unroll
            for (int q = 0; q < 4; ++q) { const int cc = 4 * F.lane + q; if (cc < c) s += (double)*(const GAS float*)(tot + cc * 8 + h); }
            float hi_ = (float)s, lo_ = (float)(s - (double)hi_);
            hi_ = wave_sum(hi_); lo_ = wave_sum(lo_);
            if (F.lane == 0) preL[h] = hi_ + lo_; }
        __syncthreads();
        if (F.tid < 256) { const int r = F.tid >> 3, h = F.tid & 7, t = c * 32 + r;
            *(GAS float*)((float*)(ws + WS_FKL) + (size_t)h * SEQ + t) = (preL[h] + *(const GAS float*)((const float*)(ws + WS_FLOC) + (size_t)t * 8 + h)) * -11.313708498984761f; }
        __syncthreads();
    }
}

__device__ __forceinline__ void phase_small_item(const Frame& F0, int l, int item) {
    unsigned char* const ws = opq(F0.ws); Frame F = F0; F.tid = opq_tid(F0.wave); F.lane = F.tid & 63; F.lds = opq(F0.lds);
    const int fr = F.lane & 15, fq = F.lane >> 4, w = F.wave;
    const bf16* Z = (const bf16*)(ws + WS_Z); unsigned char* YC = ws + WS_YCAT;
    f32x4 acc[8];
#pragma unroll
    for (int m = 0; m < 8; ++m) acc[m] = (f32x4){0.f, 0.f, 0.f, 0.f};
    const float* a_bs_ = opq(karg(8)); const float* b_scale_ = opq(karg(11));
    if (item < 256) {
        const int blk = item >> 2, h = item & 3;
        const bf16* VN = (const bf16*)(ws + WS_VN) + (size_t)(blk * 128) * 512 + h * 128 + 16 * w + fr;
        const bf16* WM = (const bf16*)(ws + WS_WM) + ((size_t)(l * 4 + h) * 128) * 128;
        bf16x8 yb[4]; u32x2 ue[8]; float bse[8];
#pragma unroll
        for (int m = 0; m < 8; ++m) { const int tl = 16 * m + fr; bse[m] = *(const GAS float*)(a_bs_ + l * 512 + h * 128 + tl); ue[m] = *(const GAS u32x2*)(Z + (size_t)(blk * 128 + tl) * NZ + h * 128 + 16 * w + 4 * fq); }
#pragma unroll
        for (int ks = 0; ks < 4; ++ks)
#pragma unroll
            for (int j = 0; j < 8; ++j) yb[ks][j] = (short)*(const GAS bf16*)(VN + (size_t)(ks * 32 + 8 * fq + j) * 512);
#pragma unroll
        for (int m = 0; m < 8; ++m)
#pragma unroll
            for (int ks = 0; ks < 4; ++ks) { const bf16x8 xa = *(const GAS bf16x8*)(WM + (size_t)(16 * m + fr) * 128 + ks * 32 + 8 * fq);
                acc[m] = __builtin_amdgcn_mfma_f32_16x16x32_bf16(yb[ks], xa, acc[m], 0, 0, 0); }
#pragma unroll
        for (int m = 0; m < 8; ++m) { const int tl = 16 * m + fr, t = blk * 128 + tl, col = h * 128 + 16 * w + 4 * fq;
            const float bsv = bse[m]; const u32x2 u = ue[m];
            *(GAS unsigned*)(YC + (size_t)t * DM + col) = cvt_pk4_fp8(H8_SCALE * bf_lo(u.x) * (acc[m][0] + bsv), H8_SCALE * bf_hi(u.x) * (acc[m][1] + bsv), H8_SCALE * bf_lo(u.y) * (acc[m][2] + bsv), H8_SCALE * bf_hi(u.y) * (acc[m][3] + bsv)); }
    } else {
        const int rb = (item - 256) >> 2, g = (item - 256) & 3;
        const int wnd = 2 << g, r0 = rb * 128;
        LAS bf16* pt = (LAS bf16*)(F.lds + 86016);
        LAS bf16* dt = (LAS bf16*)F.lds;
        const bf16* BWT = (const bf16*)(ws + WS_BWT) + ((size_t)(l * 4 + g) * 128) * 128;
        bf16x8 yb[4];
#pragma unroll
        for (int ks = 0; ks < 4; ++ks) yb[ks] = *(const GAS bf16x8*)(BWT + (size_t)(16 * w + fr) * 128 + ks * 32 + 8 * fq);
        const f32x4 bsc = *(const GAS f32x4*)(b_scale_ + l * 512 + g * 128 + 16 * w + 4 * fq);
        u32x4 pv[5];
#pragma unroll
        for (int it = 0; it < 5; ++it) { const int i = F.tid + it * NTHR, rr = i >> 4, cc = (i & 15) * 8, tg = r0 - 16 + rr;
            pv[it] = (u32x4){0u, 0u, 0u, 0u}; if (i < 144 * 16 && tg >= 0) pv[it] = *(const GAS u32x4*)(Z + (size_t)tg * NZ + 1024 + g * 128 + cc); }
        __syncthreads();
#pragma unroll
        for (int it = 0; it < 5; ++it) { const int i = F.tid + it * NTHR, rr = i >> 4, cc = (i & 15) * 8;
            if (i < 144 * 16) *(LAS u32x4*)(pt + rr * 128 + cc) = pv[it]; }
        __syncthreads();
        { const int c = F.tid & 127, rg = F.tid >> 7;
            float sum = 0.f;
            for (int j = 1; j < wnd; ++j) sum += bf_lo((unsigned)pt[(16 + 32 * rg - j) * 128 + c]);
            for (int i = 0; i < 32; ++i) { const int tl = 32 * rg + i, tg = r0 + tl; const float pv = bf_lo((unsigned)pt[(16 + tl) * 128 + c]);
                sum += pv;
                const float cnt = (float)((tg + 1 < wnd) ? (tg + 1) : wnd);
                const float dv = sum / cnt - pv;
                dt[tl * 136 + c] = (bf16)(cvt_pk_bf16(dv, 0.f) & 0xffffu);
                sum -= bf_lo((unsigned)pt[(16 + tl - (wnd - 1)) * 128 + c]); } }
        __syncthreads();
#pragma unroll
        for (int m = 0; m < 8; ++m)
#pragma unroll
            for (int ks = 0; ks < 4; ++ks) { const bf16x8 xa = *(const LAS bf16x8*)(dt + (16 * m + fr) * 136 + ks * 32 + 8 * fq);
                acc[m] = __builtin_amdgcn_mfma_f32_16x16x32_bf16(yb[ks], xa, acc[m], 0, 0, 0); }
        __syncthreads();
#pragma unroll
        for (int m = 0; m < 8; ++m) { const int t = rb * 128 + 16 * m + fr, col = 512 + g * 128 + 16 * w + 4 * fq;
            *(GAS unsigned*)(YC + (size_t)t * DM + col) = cvt_pk4_fp8(H8_SCALE * acc[m][0] * bsc.x, H8_SCALE * acc[m][1] * bsc.y, H8_SCALE * acc[m][2] * bsc.z, H8_SCALE * acc[m][3] * bsc.w); }
    }
}

__device__ __forceinline__ void phase_norm2_route(const Frame& F0, int l) {
    unsigned char* const ws = opq(F0.ws); Frame F = F0; F.tid = opq_tid(F0.wave); F.lane = F.tid & 63; F.lds = opq(F0.lds);
    LAS float* wrT = (LAS float*)F.lds;
    LAS float* gaL = (LAS float*)(F.lds + AUX_OFF);
    LAS float* gbL = (LAS float*)(F.lds + AUX_OFF + 8192);
    LAS int* lcnt = (LAS int*)(F.lds + AUX_OFF + 16384);
    const float* const w_router_ = karg(16); const float* const g_ffn_ = karg(5); const float* const b_ada_ = karg(3); const float* const b_router_ = karg(17);
    {
        f32x4 wq[16]; float gm_[4], ms_[4][5], mh_[4][5];
#pragma unroll
        for (int it = 0; it < 16; ++it) { const int i = F.tid + it * NTHR, d = i >> 2, q = i & 3; wq[it] = *(const GAS f32x4*)(w_router_ + (size_t)d * 16 + q * 4); }
#pragma unroll
        for (int it = 0; it < 4; ++it) { const int d = F.tid + it * NTHR; gm_[it] = *(const GAS float*)(g_ffn_ + (size_t)l * DM + d); mod_ld(ws, b_ada_, l, 4 * DM + d, ms_[it]); mod_ld(ws, b_ada_, l, 3 * DM + d, mh_[it]); }
#pragma unroll
        for (int it = 0; it < 16; ++it) { const int i = F.tid + it * NTHR, d = i >> 2, q = i & 3; const f32x4 w = wq[it];
            wrT[(q * 4 + 0) * DM + d] = w.x; wrT[(q * 4 + 1) * DM + d] = w.y; wrT[(q * 4 + 2) * DM + d] = w.z; wrT[(q * 4 + 3) * DM + d] = w.w; }
#pragma unroll
        for (int it = 0; it < 4; ++it) { const int d = F.tid + it * NTHR; gaL[d] = gm_[it] * (1.f + mod_sum(ms_[it])); gbL[d] = mod_sum(mh_[it]); }
    }
    const bf16* X1 = (const bf16*)(ws + WS_X1);
    float brt[16];
#pragma unroll
    for (int e = 0; e < 16; ++e) brt[e] = *(const GAS float*)(b_router_ + e);
    for (int c = F.vcu; c < SEQ / 32; c += F.G) {
        if (F.tid < 32) lcnt[F.tid] = 0;
        __syncthreads();
        int my_e0 = 0, my_e1 = 0, my_r0 = 0, my_r1 = 0; float my_w0 = 0.f, my_w1 = 0.f;
        f32x4 vA[8], vB[8]; u32x2 xA[8], xB[8];
#define N2_LOAD(V, rr) do { const int t_ = c * 32 + F.wave * 4 + (rr); _Pragma("unroll") for (int j = 0; j < 8; ++j) x##V[j] = *(const GAS u32x2*)(X1 + (size_t)t_ * DM + 256 * j + 4 * F.lane); } while (0)
#define N2_CVT(V) do { _Pragma("unroll") for (int j = 0; j < 8; ++j) { v##V[j].x = bf_lo(x##V[j].x); v##V[j].y = bf_hi(x##V[j].x); v##V[j].z = bf_lo(x##V[j].y); v##V[j].w = bf_hi(x##V[j].y); } } while (0)
#define N2_ROUTE(LG, rr) do {                                                                                                                      \
            float sc[16], sel[16];                                                                                                                 \
            _Pragma("unroll") for (int e = 0; e < 16; ++e) { sc[e] = __builtin_amdgcn_rcpf(1.f + __builtin_amdgcn_exp2f(-LOG2E * LG[e])); sel[e] = sc[e] + brt[e]; }                      \
            int bg = 0; float bgs = -INFINITY;                                                                                                     \
            _Pragma("unroll") for (int g = 0; g < 4; ++g) { float a = -INFINITY, b = -INFINITY;                                                    \
                _Pragma("unroll") for (int i = 0; i < 4; ++i) { const float x = sel[g * 4 + i]; if (x > a) { b = a; a = x; } else if (x > b) b = x; } \
                if (a + b > bgs) { bgs = a + b; bg = g; } }                                                                                        \
            int e0 = 0, e1 = 0; float a = -INFINITY, b = -INFINITY, s0 = 0.f, s1 = 0.f;                                                            \
            _Pragma("unroll") for (int g = 0; g < 4; ++g)                                                                                          \
                _Pragma("unroll") for (int i = 0; i < 4; ++i) { const int e = g * 4 + i; const float x = sel[e];                                   \
                    if (g == bg) { if (x > a) { b = a; e1 = e0; s1 = s0; a = x; e0 = e; s0 = sc[e]; } else if (x > b) { b = x; e1 = e; s1 = sc[e]; } } } \
            const float inv = 1.f / (s0 + s1);                                                                                                     \
            if (F.lane == (rr)) { my_e0 = e0; my_e1 = e1; my_w0 = s0 * inv; my_w1 = s1 * inv; } } while (0)
#define N2_PROC2(V, W, rr, NEXT_LOADS) do { const int t = c * 32 + F.wave * 4 + (rr);                                                                       \
            N2_CVT(A); N2_CVT(B);                                                                                                                  \
            float ss0 = 0.f, ss1 = 0.f;                                                                                                            \
            _Pragma("unroll") for (int j = 0; j < 8; ++j) { ss0 += (V[j].x * V[j].x + V[j].y * V[j].y) + (V[j].z * V[j].z + V[j].w * V[j].w); ss1 += (W[j].x * W[j].x + W[j].y * W[j].y) + (W[j].z * W[j].z + W[j].w * W[j].w); } \
            const float rs0 = rsqrtf(wave_sum(ss0) * (1.f / DM) + EPSN), rs1 = rsqrtf(wave_sum(ss1) * (1.f / DM) + EPSN);                           \
            float lg0[16], lg1[16];                                                                                                                \
            _Pragma("unroll") for (int e = 0; e < 16; ++e) { lg0[e] = 0.f; lg1[e] = 0.f; }                                                         \
            unsigned char* hrow = ws + WS_H + (size_t)t * DM;                          \
            _Pragma("unroll") for (int j = 0; j < 8; ++j) { const int d = 256 * j + 4 * F.lane;                                                    \
                const f32x4 ga_ = *(const LAS f32x4*)(gaL + d), gb_ = *(const LAS f32x4*)(gbL + d);                                                 \
                const f32x4 h0 = V[j] * rs0 * ga_ + gb_, h1 = W[j] * rs1 * ga_ + gb_;                                                              \
                *(GAS unsigned*)(hrow + d) = cvt_pk4_fp8(h0.x * H8_SCALE, h0.y * H8_SCALE, h0.z * H8_SCALE, h0.w * H8_SCALE);                      \
                *(GAS unsigned*)(hrow + DM + d) = cvt_pk4_fp8(h1.x * H8_SCALE, h1.y * H8_SCALE, h1.z * H8_SCALE, h1.w * H8_SCALE);                 \
                _Pragma("unroll") for (int e = 0; e < 16; ++e) { const f32x4 w = *(const LAS f32x4*)(wrT + e * DM + d);                            \
                    lg0[e] += (h0.x * w.x + h0.y * w.y) + (h0.z * w.z + h0.w * w.w); lg1[e] += (h1.x * w.x + h1.y * w.y) + (h1.z * w.z + h1.w * w.w); } } \
            NEXT_LOADS;                                                              \
            _Pragma("unroll") for (int e = 0; e < 16; ++e) { lg0[e] = wave_sum(lg0[e]); lg1[e] = wave_sum(lg1[e]); }                               \
            N2_ROUTE(lg0, (rr)); N2_ROUTE(lg1, (rr) + 1); } while (0)
        N2_LOAD(A, 0); N2_LOAD(B, 1);
        N2_PROC2(vA, vB, 0, N2_LOAD(A, 2); N2_LOAD(B, 3));
        N2_PROC2(vA, vB, 2, (void)0);
        if (F.lane < 4) { my_r0 = __hip_atomic_fetch_add(&lcnt[my_e0], 1, __ATOMIC_RELAXED, __HIP_MEMORY_SCOPE_WORKGROUP); my_r1 = __hip_atomic_fetch_add(&lcnt[my_e1], 1, __ATOMIC_RELAXED, __HIP_MEMORY_SCOPE_WORKGROUP); }
        __syncthreads();
        if (F.tid < 16) lcnt[16 + F.tid] = (int)__hip_atomic_fetch_add(F.ctl + CW_CNT + 64 * l + F.tid, (unsigned)lcnt[F.tid], RLX_AGENT);
        __syncthreads();
        if (F.lane < 4) { const int t = c * 32 + F.wave * 4 + F.lane;
            const int p0 = lcnt[16 + my_e0] + my_r0, p1 = lcnt[16 + my_e1] + my_r1;
            int* list = (int*)(ws + WS_LIST);
            *(GAS int*)(list + my_e0 * SEQ + p0) = t; *(GAS int*)(list + my_e1 * SEQ + p1) = t;
            *(GAS int*)((int*)(ws + WS_TOKE) + 2 * t) = my_e0; *(GAS int*)((int*)(ws + WS_TOKE) + 2 * t + 1) = my_e1;
            *(GAS int*)((int*)(ws + WS_TOKP) + 2 * t) = p0; *(GAS int*)((int*)(ws + WS_TOKP) + 2 * t + 1) = p1;
            *(GAS float*)((float*)(ws + WS_TOKW) + 2 * t) = my_w0; *(GAS float*)((float*)(ws + WS_TOKW) + 2 * t + 1) = my_w1; }
        __syncthreads();
    }
#undef N2_LOAD
#undef N2_CVT
#undef N2_PROC2
#undef N2_ROUTE
}

struct MoeOrder {
    int G, c, total, K, nct; const char* Bt; size_t estride; const int* list; LAS int* tab; LAS int* rows;
    __device__ __forceinline__ bool next(int i, gm::Unit& u) const {
        const int L = i * G + c; if (L >= total) return false;
        const int q = L / nct, ct = L - q * nct;
        int e = 0;
#pragma unroll
        for (int k = 1; k < NEXP; ++k) e += (q >= tab[k]) ? 1 : 0;
        e = __builtin_amdgcn_readfirstlane(e);
        const int rt = q - __builtin_amdgcn_readfirstlane(tab[e]);
        u.e = e; u.rt = i; u.arow = (__builtin_amdgcn_readfirstlane(tab[e]) + rt) * 256; u.orow = u.arow; u.ocol = ct * 256;
        u.Bp = Bt + (size_t)e * estride + (size_t)ct * 256 * K * 2; return true;
    }
    __device__ __forceinline__ int row_of(const gm::Unit& u, int r) const { return rows[u.rt * 256 + r]; }
    __device__ __forceinline__ void stage_rows(int tid) const {
        int v[4] = {0, 0, 0, 0};
#pragma unroll
        for (int i = 0; i < 4; ++i) { const int L = i * G + c;
            if (L < total && tid < 256) { const int q = L / nct; int e = 0;
#pragma unroll
                for (int k = 1; k < NEXP; ++k) e += (q >= tab[k]) ? 1 : 0;
                const int rt = q - tab[e], p = rt * 256 + tid, n = tab[32 + e], pc = p < n ? p : n - 1;
                const int w = *(const GAS int*)(list + e * SEQ + pc); v[i] = (p < n) ? w : 0; } }
        if (tid < 256) {
#pragma unroll
            for (int i = 0; i < 4; ++i) rows[i * 256 + tid] = v[i]; }
        __syncthreads();
    }
};
__device__ __forceinline__ void moe_table(const Frame& F, int l, LAS int* tab) {
    const int tid = opq_tid(F.wave);
    __syncthreads();
    if (tid < NEXP) tab[32 + tid] = (int)__hip_atomic_load(F.ctl + CW_CNT + 64 * l + tid, RLX_AGENT);
    __syncthreads();
    if (tid == 0) { int a = 0;
        for (int e = 0; e < NEXP; ++e) { tab[e] = a; a += (tab[32 + e] + 255) >> 8; }
        tab[16] = a; }
    __syncthreads();
}

constexpr int ATT_CH = 24;
struct MixTab { LAS int* jlo; LAS int* items; LAS int* nitems; LAS float* fend; LAS int* scan; };
__device__ __forceinline__ MixTab mix_tab_ptrs(LAS unsigned char* lds) {
    MixTab T; T.jlo = (LAS int*)(lds + 69632); T.items = (LAS int*)(lds + 69632 + 1024); T.nitems = (LAS int*)(lds + 69632 + 1024 + 8192); T.fend = (LAS float*)(lds + 69632 + 1024 + 8192 + 64);
    T.scan = (LAS int*)(lds + 69632 + 1024 + 8192 + 64 + 4096); return T;
}
__device__ __forceinline__ void mix_build_table(const Frame& F0, int l, const MixTab& T) {
    unsigned char* const ws = opq(F0.ws); const int tid = opq_tid(F0.wave);
    const float* FKL = (const float*)(ws + WS_FKL);
    for (int i = tid; i < 1024; i += NTHR) T.fend[i] = *(const GAS float*)(FKL + (size_t)(i >> 7) * SEQ + (i & 127) * 64 + 63);
    float gq = 0.f, gk = 0.f; const float* const c_qg_ = karg(12); const float* const c_kg_ = karg(13);
    { const int ln = tid & 63; gq = fmaxf(fabsf(*(const GAS float*)(c_qg_ + l * 128 + ln)), fabsf(*(const GAS float*)(c_qg_ + l * 128 + 64 + ln))); gk = fmaxf(fabsf(*(const GAS float*)(c_kg_ + l * 128 + ln)), fabsf(*(const GAS float*)(c_kg_ + l * 128 + 64 + ln)));
      gq = wave_max(gq); gk = wave_max(gk); }
    const float thr = (2.f * 1.01f * 11.313708498984761f * gq * gk + 22.f) * 11.313708498984761f;
    __syncthreads();
    int nfull = 0, nrem = 0, jl = 0, nt = 0;
    if (tid < 256) { const int h = tid >> 5, qb = tid & 31; const float f0 = *(const GAS float*)(FKL + (size_t)h * SEQ + qb * 256);
        for (int j = 0; j < 4 * qb; ++j) jl += (T.fend[h * 128 + j] - f0 <= -thr) ? 1 : 0;
        nt = 4 * (qb + 1) - jl; nfull = nt / ATT_CH; nrem = (nt % ATT_CH) ? 1 : 0; T.jlo[tid] = jl | ((nfull + nrem) << 8); }
    if (tid < 256) { T.scan[tid] = nfull; T.scan[256 + tid] = nrem; }
    __syncthreads();
    for (int o = 1; o < 256; o <<= 1) { int a = 0, b = 0; if (tid < 256 && tid >= o) { a = T.scan[tid - o]; b = T.scan[256 + tid - o]; } __syncthreads();
        if (tid < 256) { T.scan[tid] += a; T.scan[256 + tid] += b; } __syncthreads(); }
    if (tid < 256) { const int totf = T.scan[255], pf = T.scan[tid] - nfull, pr = totf + T.scan[256 + tid] - nrem, jb = 4 * ((tid & 31) + 1);
        for (int c = 0; c < nfull; ++c) T.items[pf + c] = tid | (c << 8) | ((jb - (c + 1) * ATT_CH) << 12) | (ATT_CH << 20);
        if (nrem) T.items[pr] = tid | (nfull << 8) | (jl << 12) | ((nt - nfull * ATT_CH) << 20);
        if (tid == 255) T.nitems[0] = totf + T.scan[511]; }
    __syncthreads();
}
__device__ __forceinline__ void attn_combine_block(const Frame& F0, const int b, const int nch) {
    unsigned char* const ws = opq(F0.ws); const int tid = opq_tid(F0.wave);
    const bf16* PART = (const bf16*)(ws + WS_PART); const float* MLb = (const float*)(ws + WS_ML); unsigned char* YC = ws + WS_YCAT;
    {
        const int h = b >> 5, qb = b & 31, row = tid >> 1, half = tid & 1;
        float m[8], w[8], mx = -3.0e38f, ws_ = 0.f;
#pragma unroll
        for (int c = 0; c < 8; ++c) { if (c < nch) { const f32x2 v = *(const GAS f32x2*)(MLb + ((size_t)(b * 8 + c) * 256 + row) * 2); m[c] = v.x; w[c] = v.y; mx = fmaxf(mx, v.x); } else { m[c] = -3.0e38f; w[c] = 0.f; } }
#pragma unroll
        for (int c = 0; c < 8; ++c) { w[c] = (c < nch) ? w[c] * __builtin_amdgcn_exp2f((m[c] - mx) * at::C2) : 0.f; ws_ += w[c]; }
        const float inv = 1.f / ws_;
        float acc[64];
#pragma unroll
        for (int i = 0; i < 64; ++i) acc[i] = 0.f;
#pragma unroll
        for (int c = 0; c < 8; ++c) { if (c < nch) { const bf16* p = PART + ((size_t)(b * 8 + c) * 256 + row) * 128 + half * 64; const float wc = w[c] * inv;
#pragma unroll
            for (int q = 0; q < 8; ++q) { const u32x4 v = *(const GAS u32x4*)(p + q * 8);
                acc[q * 8 + 0] += wc * bf_lo(v.x); acc[q * 8 + 1] += wc * bf_hi(v.x); acc[q * 8 + 2] += wc * bf_lo(v.y); acc[q * 8 + 3] += wc * bf_hi(v.y);
                acc[q * 8 + 4] += wc * bf_lo(v.z); acc[q * 8 + 5] += wc * bf_hi(v.z); acc[q * 8 + 6] += wc * bf_lo(v.w); acc[q * 8 + 7] += wc * bf_hi(v.w); } } }
        unsigned char* o = YC + (size_t)(qb * 256 + row) * DM + 1024 + h * 128 + half * 64;
#pragma unroll
        for (int q = 0; q < 4; ++q) { u32x4 v;
            v.x = cvt_pk4_fp8(H8_SCALE * acc[q * 16 + 0], H8_SCALE * acc[q * 16 + 1], H8_SCALE * acc[q * 16 + 2], H8_SCALE * acc[q * 16 + 3]); v.y = cvt_pk4_fp8(H8_SCALE * acc[q * 16 + 4], H8_SCALE * acc[q * 16 + 5], H8_SCALE * acc[q * 16 + 6], H8_SCALE * acc[q * 16 + 7]);
            v.z = cvt_pk4_fp8(H8_SCALE * acc[q * 16 + 8], H8_SCALE * acc[q * 16 + 9], H8_SCALE * acc[q * 16 + 10], H8_SCALE * acc[q * 16 + 11]); v.w = cvt_pk4_fp8(H8_SCALE * acc[q * 16 + 12], H8_SCALE * acc[q * 16 + 13], H8_SCALE * acc[q * 16 + 14], H8_SCALE * acc[q * 16 + 15]);
            *(GAS u32x4*)(o + q * 16) = v; }
    }
}

struct MoeDynOrder {
    int total, K; const char* Bt; size_t estride; LAS int* tab; gu32* ticket; gu32* ready; gu32* tmo; LAS unsigned* slot;
    __device__ __forceinline__ bool next(int, gm::Unit& u) const {
        if (__builtin_amdgcn_readfirstlane(threadIdx.x >> 6) == 0) {
            unsigned T = 0u;
            if ((threadIdx.x & 63) == 0) T = __hip_atomic_fetch_add(ticket, 1u, RLX_AGENT);
            T = __builtin_amdgcn_readfirstlane(T);
            if (T < (unsigned)total) {
                gu32* w = ready + 16 * (T >> 3); unsigned sp = 0u;
                while ((unsigned)__builtin_amdgcn_readfirstlane(__hip_atomic_load(w, RLX_AGENT)) < 64u) {
                    __builtin_amdgcn_s_sleep(2);
                    if ((++sp & 255u) == 0u) { if (__hip_atomic_load(tmo, RLX_AGENT) != 0u) break; if (sp > (1u << 20)) { __hip_atomic_store(tmo, 1u, RLX_AGENT); break; } } }
                __builtin_amdgcn_fence(__ATOMIC_ACQUIRE, "agent");
                asm volatile("s_waitcnt vmcnt(0)" ::: "memory");
            }
            if ((threadIdx.x & 63) == 0) slot[0] = T;
        }
        asm volatile("s_waitcnt lgkmcnt(0)" ::: "memory"); __builtin_amdgcn_s_barrier(); asm volatile("" ::: "memory");
        const unsigned T = (unsigned)__builtin_amdgcn_readfirstlane((int)slot[0]);
        if (T >= (unsigned)total) return false;
        const int q = (int)(T >> 3), ct = (int)(T & 7);
        int e = 0;
#pragma unroll
        for (int k = 1; k < NEXP; ++k) e += (q >= tab[k]) ? 1 : 0;
        e = __builtin_amdgcn_readfirstlane(e);
        u.e = e; u.rt = q - __builtin_amdgcn_readfirstlane(tab[e]); u.arow = q * 256; u.orow = u.arow; u.ocol = ct * 256;
        u.Bp = Bt + (size_t)e * estride + (size_t)ct * 256 * K * 2; return true;
    }
    __device__ __forceinline__ int row_of(const gm::Unit&, int) const { return 0; }
};
struct EpiZ {
    static constexpr bool PERM = true;
    unsigned char* wsb; int l; LAS float* Pt0;
    __device__ __forceinline__ void operator()(f32x4 (&acc)[2][2][4][2], const gm::Unit& u, int wr, int wc, int fr0, int fq0) const {
        int fr = fr0, fq = fq0; asm volatile("" : "+v"(fr), "+v"(fq));
        unsigned char* const ws = opq(wsb); LAS float* const Pt = opq(Pt0);
        bf16* const O = (bf16*)(ws + WS_Z); bf16* const QN = (bf16*)(ws + WS_QN); bf16* const KN = (bf16*)(ws + WS_KN); bf16* const VN = (bf16*)(ws + WS_VN);
        const int row0 = u.orow + wr * 64 + fr, col0 = u.ocol + wc * 32 + 8 * fq;
        const bool isv = (u.ocol >= 512 && u.ocol < 1024), isq = (u.ocol >= 1536 && u.ocol < 2560), isk = (u.ocol >= 2560 && u.ocol < 3584);
        if (u.ocol < 1024) {
#pragma unroll
            for (int ai = 0; ai < 2; ++ai)
#pragma unroll
                for (int bj = 0; bj < 2; ++bj)
#pragma unroll
                    for (int m = 0; m < 4; ++m)
#pragma unroll
                        for (int n = 0; n < 2; ++n)
#pragma unroll
                            for (int j = 0; j < 4; ++j) acc[ai][bj][m][n][j] = gelu_t(acc[ai][bj][m][n][j]);
        }
        if (isv || isq || isk) {
#pragma unroll
            for (int ai = 0; ai < 2; ++ai)
#pragma unroll
                for (int m = 0; m < 4; ++m)
#pragma unroll
                    for (int bj = 0; bj < 2; ++bj) { const f32x4 a = acc[ai][bj][m][0], b = acc[ai][bj][m][1];
                        float ss = (a[0] * a[0] + a[1] * a[1]) + (a[2] * a[2] + a[3] * a[3]) + (b[0] * b[0] + b[1] * b[1]) + (b[2] * b[2] + b[3] * b[3]);
                        ss += xor_f<16>(ss);
                        { auto rr = __builtin_amdgcn_permlane32_swap(__float_as_uint(ss), __float_as_uint(ss), false, false); ss = __uint_as_float(rr[0]) + __uint_as_float(rr[1]); }
                        if (fq == 0) Pt[((ai * 128 + wr * 64 + m * 16 + fr) * 2 + bj) * 4 + wc] = ss; }
            asm volatile("s_waitcnt lgkmcnt(0)" ::: "memory"); __builtin_amdgcn_s_barrier(); asm volatile("" ::: "memory");
            const float* gp = isv ? karg(9) + l * 512 + (u.ocol - 512) + wc * 32 + 8 * fq : karg(isq ? 12 : 13) + l * 128 + wc * 32 + 8 * fq;
#pragma unroll
            for (int bj = 0; bj < 2; ++bj) {
                const f32x4 g0 = *(const GAS f32x4*)(gp + (isv ? bj * 128 : 0)), g1 = *(const GAS f32x4*)(gp + (isv ? bj * 128 : 0) + 4);
#pragma unroll
                for (int ai = 0; ai < 2; ++ai)
#pragma unroll
                    for (int m = 0; m < 4; ++m) { const int rl = ai * 128 + wr * 64 + m * 16 + fr, row = u.orow + rl;
                        const f32x4 p4 = *(const LAS f32x4*)(Pt + (rl * 2 + bj) * 4);
                        const float rs = rsqrtf(((p4[0] + p4[1]) + (p4[2] + p4[3])) * (1.f / 128.f) + EPSN);
                        const f32x4 v0 = acc[ai][bj][m][0] * rs * g0, v1 = acc[ai][bj][m][1] * rs * g1;
                        u32x4 w; w.x = cvt_pk_bf16(v0[0], v0[1]); w.y = cvt_pk_bf16(v0[2], v0[3]); w.z = cvt_pk_bf16(v1[0], v1[1]); w.w = cvt_pk_bf16(v1[2], v1[3]);
                        bf16* dst;
                        if (isv) dst = VN + (size_t)row * 512 + (u.ocol - 512) + bj * 128 + wc * 32 + 8 * fq;
                        else { const int h = ((u.ocol - (isq ? 1536 : 2560)) >> 7) + bj; dst = (isq ? QN : KN) + ((size_t)h * SEQ + row) * 128 + wc * 32 + 8 * fq; }
                        *(GAS u32x4*)dst = w; } }
            return;
        }
#pragma unroll
        for (int ai = 0; ai < 2; ++ai)
#pragma unroll
            for (int m = 0; m < 4; ++m) { bf16* rowp = O + (size_t)(row0 + ai * 128 + m * 16) * NZ + col0;
#pragma unroll
                for (int bj = 0; bj < 2; ++bj) { const f32x4 v0 = acc[ai][bj][m][0], v1 = acc[ai][bj][m][1];
                    u32x4 w; w.x = cvt_pk_bf16(v0[0], v0[1]); w.y = cvt_pk_bf16(v0[2], v0[3]); w.z = cvt_pk_bf16(v1[0], v1[1]); w.w = cvt_pk_bf16(v1[2], v1[3]);
                    *(GAS u32x4*)(rowp + bj * 128) = w; } }
    }
};
template <bool XBF> struct EpiRes {
    static constexpr bool PERM = false;
    const void* xin; const LAS float* gate; bf16* out;
    __device__ __forceinline__ void operator()(const f32x4 (&acc)[2][2][4][2], const gm::Unit& u, int wr, int wc, int fr, int fq) const {
        const int row0 = u.orow + wr * 64 + fr, col0 = u.ocol + wc * 32 + 4 * fq;
        f32x4 gv[2][2];
#pragma unroll
        for (int bj = 0; bj < 2; ++bj)
#pragma unroll
            for (int n = 0; n < 2; ++n) gv[bj][n] = *(const LAS f32x4*)(gate + col0 + bj * 128 + n * 16);
#pragma unroll
        for (int ai = 0; ai < 2; ++ai) {
            f32x4 xf[XBF ? 1 : 4][2][2]; u32x2 xh[XBF ? 4 : 1][2][2];
#pragma unroll
            for (int m = 0; m < 4; ++m) { const size_t off = (size_t)(row0 + ai * 128 + m * 16) * DM + col0;
#pragma unroll
                for (int bj = 0; bj < 2; ++bj)
#pragma unroll
                    for (int n = 0; n < 2; ++n) {
                        if constexpr (XBF) xh[m][bj][n] = *(const GAS u32x2*)((const bf16*)xin + off + bj * 128 + n * 16);
                        else xf[m][bj][n] = *(const GAS f32x4*)((const float*)xin + off + bj * 128 + n * 16); } }
#pragma unroll
            for (int m = 0; m < 4; ++m) { const size_t off = (size_t)(row0 + ai * 128 + m * 16) * DM + col0;
#pragma unroll
                for (int bj = 0; bj < 2; ++bj)
#pragma unroll
                    for (int n = 0; n < 2; ++n) { f32x4 xv;
                        if constexpr (XBF) { const u32x2 xb = xh[m][bj][n]; xv.x = bf_lo(xb.x); xv.y = bf_hi(xb.x); xv.z = bf_lo(xb.y); xv.w = bf_hi(xb.y); }
                        else xv = xf[m][bj][n];
                        const f32x4 r = xv + gv[bj][n] * acc[ai][bj][m][n]; u32x2 o; o.x = cvt_pk_bf16(r.x, r.y); o.y = cvt_pk_bf16(r.z, r.w);
                        *(GAS u32x2*)(out + off + bj * 128 + n * 16) = o; } }
        }
    }
};
struct EpiHid {
    static constexpr bool PERM = true;
    bf16* O;
    __device__ __forceinline__ void operator()(const f32x4 (&acc)[2][2][4][2], const gm::Unit& u, int wr, int wc, int fr, int fq) const {
        const int row0 = u.orow + wr * 64 + fr, col0 = (u.ocol >> 1) + wc * 32 + 8 * fq;
#pragma unroll
        for (int ai = 0; ai < 2; ++ai)
#pragma unroll
            for (int m = 0; m < 4; ++m) { bf16* rowp = O + (size_t)(row0 + ai * 128 + m * 16) * DEX + col0;
                f32x4 h0, h1;
#pragma unroll
                for (int j = 0; j < 4; ++j) { h0[j] = silu_f(acc[ai][0][m][0][j]) * acc[ai][1][m][0][j]; h1[j] = silu_f(acc[ai][0][m][1][j]) * acc[ai][1][m][1][j]; }
                u32x4 w; w.x = cvt_pk_bf16(h0[0], h0[1]); w.y = cvt_pk_bf16(h0[2], h0[3]); w.z = cvt_pk_bf16(h1[0], h1[1]); w.w = cvt_pk_bf16(h1[2], h1[3]);
                *(GAS u32x4*)rowp = w; }
    }
};
struct EpiHidPub {
    static constexpr bool PERM = true;
    unsigned char* O; gu32* ready;
    __device__ __forceinline__ void operator()(const f32x4 (&acc)[2][2][4][2], const gm::Unit& u, int wr, int wc, int fr, int fq) const {
        const __amdgpu_buffer_rsrc_t rs = __builtin_amdgcn_make_buffer_rsrc(O, (short)0, (int)(HIDROWS * DEX), 0x00020000);
        const int row0 = u.orow + wr * 64 + fr, col0 = (u.ocol >> 1) + wc * 32 + 8 * fq;
#pragma unroll
        for (int ai = 0; ai < 2; ++ai)
#pragma unroll
            for (int m = 0; m < 4; ++m) { const int off = (row0 + ai * 128 + m * 16) * DEX + col0;
                f32x4 h0, h1;
#pragma unroll
                for (int j = 0; j < 4; ++j) { h0[j] = HID8_SCALE * silu_f(acc[ai][0][m][0][j]) * acc[ai][1][m][0][j]; h1[j] = HID8_SCALE * silu_f(acc[ai][0][m][1][j]) * acc[ai][1][m][1][j]; }
                u32x2 w; w.x = cvt_pk4_fp8(h0[0], h0[1], h0[2], h0[3]); w.y = cvt_pk4_fp8(h1[0], h1[1], h1[2], h1[3]);
                __builtin_amdgcn_raw_buffer_store_b64(w, rs, off, 0, 16); }
        asm volatile("s_waitcnt vmcnt(0)" ::: "memory");
        if (fr == 0 && fq == 0) (void)__hip_atomic_fetch_add(ready + 16 * (u.orow >> 8), 1u, RLX_AGENT);
    }
};
struct EpiYB {
    static constexpr bool PERM = true;
    bf16* O;
    __device__ __forceinline__ void operator()(const f32x4 (&acc)[2][2][4][2], const gm::Unit& u, int wr, int wc, int fr, int fq) const {
        const int row0 = u.orow + wr * 64 + fr, col0 = u.ocol + wc * 32 + 8 * fq;
#pragma unroll
        for (int ai = 0; ai < 2; ++ai)
#pragma unroll
            for (int m = 0; m < 4; ++m) { bf16* rowp = O + (size_t)(row0 + ai * 128 + m * 16) * DM + col0;
#pragma unroll
                for (int bj = 0; bj < 2; ++bj) { const f32x4 v0 = acc[ai][bj][m][0], v1 = acc[ai][bj][m][1];
                    u32x4 w; w.x = cvt_pk_bf16(v0[0], v0[1]); w.y = cvt_pk_bf16(v0[2], v0[3]); w.z = cvt_pk_bf16(v1[0], v1[1]); w.w = cvt_pk_bf16(v1[2], v1[3]);
                    *(GAS u32x4*)(rowp + bj * 128) = w; } }
    }
};

#ifdef MK_SELFTEST
#include "selftest.h"
#endif
__device__ __forceinline__ int bg_need(int p) {
    if (p <= 1) return 0;
    if (p <= 4) return BG_C0;
    if (p <= 7) return BG_C1;
    if (p == 8) return BG_C3;
    if (p <= 10) return BG_C3B;
    if (p <= 13) return BG_C4;
    if (p <= 16) return BG_C5;
    return BG_C7;
}
__device__ __forceinline__ bool bg_seam(int k) { if (k == 0) return true; const int j = (k - 1) % 9; return j != 2 && j != 5 && j != 8; }
struct Args { const float* in[21]; float* out; unsigned char* ws; int ph_lo, ph_hi; };
constexpr int N_PHASES = 1 + 9 * NLAYER + 1;

#ifdef MK_ONLY
#define IN(k) (((k) == 0 ? 0 : (((k) - 1) % 9) + 1) == MK_ONLY && lo <= (k) && (k) < hi)
#else
#define IN(k) (lo <= (k) && (k) < hi)
#endif
#ifndef MK_REPEAT
#define MK_REPEAT -1
#endif
#define REPS(kind) ((MK_REPEAT == (kind)) ? 2 : 1)
#define SEAM(k) do { if (IN(k)) { if (bg_seam(k)) bg_fill(F, (k), bg_need((k) + 1), F.G, true); if (IN((k) + 1)) xcd_barrier(bar); } } while (0)


#ifdef MK_TPROBE
#define TP_B(kind) do { if (MK_TPROBE == (kind) && blockIdx.x == 0 && threadIdx.x == 0) ((volatile LAS unsigned*)(F.lds + AUX_OFF + 24576 + 128))[0] = (unsigned)__builtin_amdgcn_s_memrealtime(); } while (0)
#define TP_E(kind) do { if (MK_TPROBE == (kind) && blockIdx.x == 0 && threadIdx.x == 0) { volatile LAS unsigned* tp_ = (volatile LAS unsigned*)(F.lds + AUX_OFF + 24576 + 128); tp_[1] += (unsigned)__builtin_amdgcn_s_memrealtime() - tp_[0]; } } while (0)
#else
#define TP_B(kind) do { } while (0)
#define TP_E(kind) do { } while (0)
#endif
template <int l> __device__ __forceinline__ void layer_body(const Frame& F, const XcdBarrier& bar, const int lo, const int hi) {
    constexpr int pb = 1 + 9 * l;

        TP_B(1);
        for (int rep_ = 0; rep_ < REPS(1); ++rep_) if (IN(pb)) { if (rep_) xcd_barrier(bar); unsigned char* const wsl = opq(F.ws); LAS unsigned char* const ldl = opq(F.lds); if (l == 0) phase_norm1<0>(F, l, karg(0), nullptr, 0); else phase_norm1<1>(F, l, (const void*)(wsl + WS_X1), (void*)(wsl + WS_X2), l - 1); }
        SEAM(pb);
        TP_E(1);
        TP_B(2);
        for (int rep_ = 0; rep_ < REPS(2); ++rep_) if (IN(pb + 1)) { if (rep_) xcd_barrier(bar); unsigned char* const wsl = opq(F.ws); LAS unsigned char* const ldl = opq(F.lds);
            const int Gg = (F.G == 256) ? (l == 0 ? 144 : 192) : F.G;
            gm::RegOrder S; S.init(SEQ, NZ, DM / 2, wsl + WS_WIN + (size_t)l * NZ * DM, Gg, (int)blockIdx.x);
            fkl_fixup(F);
            EpiZ E{wsl, l, (LAS float*)(ldl + AUX_OFF)};
            if ((int)blockIdx.x < Gg) gm::gemm_phase<EpiZ, gm::RegOrder, false, true, true, SC_H8, SC_W8>(ldl, (const char*)(wsl + WS_H), DM, S, E, F.wave); }
        SEAM(pb + 1);
        TP_E(2);
        TP_B(4);
        for (int rep_ = 0; rep_ < REPS(4); ++rep_) if (IN(pb + 3)) { if (rep_) xcd_barrier(bar); unsigned char* const wsl = opq(F.ws); LAS unsigned char* const ldl = opq(F.lds);
            const MixTab T = mix_tab_ptrs(ldl);
            TP_B(15); mix_build_table(F, l, T); TP_E(15);
#if defined(MK_TPROBE) && MK_TPROBE == 16
            if (blockIdx.x == 0 && threadIdx.x == 0) { unsigned tot_ = 0; for (int i_ = 0; i_ < 256; ++i_) { const int qb_ = i_ & 31; tot_ += 4 * (qb_ + 1) - (T.jlo[i_] & 255); }
                ((volatile LAS unsigned*)(F.lds + AUX_OFF + 24576 + 128))[1] += tot_; }
#endif
#if defined(MK_TPROBE) && (MK_TPROBE == 17 || MK_TPROBE == 18)
            const unsigned tpd0_ = (unsigned)__builtin_amdgcn_s_memrealtime();
#endif
            const int natt = __builtin_amdgcn_readfirstlane(T.nitems[0]), ntot = natt + 512;
            LAS int* qslot = T.nitems + 1;
            int it = F.vcu;
            while (it < ntot) {
                int pub = -1, pubn = 0;
                if (it >= natt) { TP_B(14); phase_small_item(F, l, it - natt); TP_E(14); }
                else {
                    const int rec = __builtin_amdgcn_readfirstlane(T.items[it]), b = rec & 255, c = (rec >> 8) & 15, ja = (rec >> 12) & 255, n = (rec >> 20) & 31, h = b >> 5, qb = b & 31;
                    const bool fin = (__builtin_amdgcn_readfirstlane(T.jlo[b]) >> 8) <= 1; unsigned char* const ws = opq(wsl);
                    at::BlockRef cur;
                    cur.Q = (const bf16*)(ws + WS_QN) + ((size_t)h * SEQ + qb * 256) * 128; cur.K = (const bf16*)(ws + WS_KN) + (size_t)h * SEQ * 128;
                    cur.V = (const bf16*)(ws + WS_Z) + 3584 + h * 128; cur.O = ws + WS_YCAT + (size_t)(qb * 256) * DM + 1024 + h * 128;
                    cur.FK = (const float*)(ws + WS_FKL) + (size_t)h * SEQ; cur.P0 = qb * 256;
                    TP_B(13); at::attn_block(cur, ja, n, fin, (bf16*)(ws + WS_PART) + (size_t)(b * 8 + c) * 256 * 128, (float*)(ws + WS_ML) + (size_t)(b * 8 + c) * 256 * 2, (char*)ldl, ldl, F.wave); TP_E(13);
                    if (!fin) { pub = b; pubn = __builtin_amdgcn_readfirstlane(T.jlo[b]) >> 8; }
                }
                if (opq_tid(F.wave) == 0) { qslot[0] = F.G + (int)__hip_atomic_fetch_add(F.ctl + CW_Q + 64 * l + 32 * rep_, 1u, RLX_AGENT);
                    qslot[1] = (pub >= 0) ? (int)__hip_atomic_fetch_add(F.ctl + CW_PC + 8192 * l + 4096 * rep_ + 16 * pub, 1u, RLX_AGENT) : -2; }
                __syncthreads();
                it = __builtin_amdgcn_readfirstlane(qslot[0]);
                const int arrived = __builtin_amdgcn_readfirstlane(qslot[1]);
                __syncthreads();
                if (pub >= 0 && arrived == pubn - 1) {
                    __builtin_amdgcn_fence(__ATOMIC_ACQUIRE, "agent");
                    attn_combine_block(F, pub, pubn); }
            }
#if defined(MK_TPROBE) && (MK_TPROBE == 17 || MK_TPROBE == 18)
            if (threadIdx.x == 0) { const unsigned el_ = (unsigned)__builtin_amdgcn_s_memrealtime() - tpd0_;
                if (MK_TPROBE == 17) atomicMax((unsigned*)(F.ctl + 3000 + l), el_); else atomicMax((unsigned*)(F.ctl + 3000 + l), 0x7fffffffu - el_); }
#endif
        }
        SEAM(pb + 3);
        TP_E(4);
        TP_B(6);
        for (int rep_ = 0; rep_ < REPS(6); ++rep_) if (IN(pb + 5)) { if (rep_) xcd_barrier(bar); unsigned char* const wsl = opq(F.ws); LAS unsigned char* const ldl = opq(F.lds); gm::RegOrder S; S.init(SEQ, DM, DM / 2, wsl + WS_WOUT + (size_t)l * DM * DM, F.G, (int)blockIdx.x);
            LAS float* g1L = (LAS float*)(ldl + AUX_OFF);
            { const float* const b_ada_ = karg(3); const int t_ = opq_tid(F.wave); float m1_[4][5];
#pragma unroll
              for (int it = 0; it < 4; ++it) mod_ld(wsl, b_ada_, l, 2 * DM + t_ + it * NTHR, m1_[it]);
#pragma unroll
              for (int it = 0; it < 4; ++it) g1L[t_ + it * NTHR] = mod_sum(m1_[it]); }
            __syncthreads();
            EpiRes<(l != 0)> E{(l == 0) ? (const void*)karg(0) : (const void*)(wsl + WS_X2), g1L, (bf16*)(wsl + WS_X1)};
            gm::gemm_phase<EpiRes<(l != 0)>, gm::RegOrder, false, true, true, SC_H8, SC_W8>(ldl, (const char*)(wsl + WS_YCAT), DM, S, E, F.wave); }
        SEAM(pb + 5);
        TP_E(6);
        TP_B(7);
        for (int rep_ = 0; rep_ < REPS(7); ++rep_) if (IN(pb + 6)) { if (rep_) xcd_barrier(bar); unsigned char* const wsl = opq(F.ws); LAS unsigned char* const ldl = opq(F.lds); phase_norm2_route(F, l); }
        SEAM(pb + 6);
        TP_E(7);
        TP_B(8);
        for (int rep_ = 0; rep_ < REPS(8); ++rep_) if (IN(pb + 7)) { if (rep_) xcd_barrier(bar); unsigned char* const wsl = opq(F.ws); LAS unsigned char* const ldl = opq(F.lds); LAS int* tab = (LAS int*)(ldl + AUX_OFF + 20480); moe_table(F, l, tab);
            gu32* const rdy = F.ctl + CW_RDY + 4096 * l + 2048 * rep_;
            TP_B(11);
            const int tot1 = 8 * tab[16];
            const bool split = (F.G == 256) && (tot1 <= 576) && (l == 0);
            const int Gm = split ? 192 : F.G, cm = split ? (F.vcu >> 5) * 24 + (F.vcu & 31) : F.vcu;
            if (split && (F.vcu & 31) >= 24) bg_fill(F, 20 + l, 0, Gm, false);
            else { MoeOrder S; S.G = Gm; S.c = cm; S.total = 8 * tab[16]; S.K = DM / 2; S.nct = 8; S.Bt = (const char*)(wsl + WS_WGU) + (size_t)l * NEXP * DM * DM; S.estride = (size_t)DM * DM;
              S.list = (const int*)(wsl + WS_LIST); S.tab = tab; S.rows = (LAS int*)(ldl + AUX_OFF + 4096); S.stage_rows(opq_tid(F.wave));
              EpiHidPub E{wsl + (l ? WS_HID1 : WS_HID), rdy};
              gm::gemm_phase<EpiHidPub, MoeOrder, true, true, true, SC_H8, SC_W8>(ldl, (const char*)(wsl + WS_H), DM, S, E, F.wave);
              if (split && opq_tid(F.wave) == 0) (void)__hip_atomic_fetch_add(F.ctl + CW_ARR + 64 * (20 + l), 1u, RLX_AGENT); }
            TP_E(11); TP_B(12);
            { MoeDynOrder S; S.total = 8 * tab[16]; S.K = DEX / 2; S.Bt = (const char*)(wsl + WS_WD) + (size_t)l * NEXP * DM * DEX; S.estride = (size_t)DM * DEX; S.tab = tab;
              S.ticket = F.ctl + CW_MT + 64 * l + 32 * rep_; S.ready = rdy; S.tmo = F.ctl + CW_TMO; S.slot = (LAS unsigned*)(ldl + AUX_OFF + 24576 + 64);
              EpiYB E{(bf16*)(wsl + WS_YB)};
              gm::gemm_phase<EpiYB, MoeDynOrder, false, true, true, SC_HID8, SC_W8>(ldl, (const char*)(wsl + (l ? WS_HID1 : WS_HID)), DEX, S, E, F.wave); }
            TP_E(12);
        }
        SEAM(pb + 7);
        TP_E(8);
    }

__global__ void __launch_bounds__(NTHR, 2) mk_fwd(Args args) {
    extern __shared__ __attribute__((aligned(16))) unsigned char lds[];
    Frame F;
    F.lds = (LAS unsigned char*)lds; F.MISC = (volatile LAS unsigned*)(F.lds + MISC_OFF);
    F.tid = 0; F.lane = 0; F.wave = __builtin_amdgcn_readfirstlane((int)threadIdx.x >> 6);
    F.G = gridDim.x; { const int bx = blockIdx.x; F.vcu = (F.G % 8 == 0) ? (bx % 8) * (F.G / 8) + bx / 8 : bx; }
    F.ws = args.ws; F.ctl = (gu32*)(args.ws + WS_CTL);
    for (int u = threadIdx.x; u < (LDS_BYTES - RING_BYTES) / 4; u += NTHR) ((LAS unsigned*)(F.lds + RING_BYTES))[u] = 0u;
    __syncthreads();
    const int lo = args.ph_lo, hi = args.ph_hi;
    const bool multi = (hi - lo) > 1;
    XcdBarrier bar; bar.bar = (unsigned*)(F.ctl + CW_BAR); bar.x = 0; bar.st = nullptr;
    if (multi) bar = xcd_barrier_post((unsigned*)(F.ctl + CW_BAR), F.MISC + 8);
    TP_B(0); for (int rep_ = 0; rep_ < REPS(0); ++rep_) if (IN(0)) { if (rep_) xcd_barrier(bar); p0_prologue(F); } SEAM(0); TP_E(0);

    layer_body<0>(F, bar, lo, hi);
    layer_body<1>(F, bar, lo, hi);
    TP_B(10);
    for (int rep_ = 0; rep_ < REPS(10); ++rep_) if (IN(N_PHASES - 1)) { if (rep_) xcd_barrier(bar); phase_norm1<2>(F, NLAYER - 1, (const void*)(F.ws + WS_X1), (void*)karg(21), NLAYER - 1); }
    TP_E(10);
#ifdef MK_TPROBE
    if (blockIdx.x == 0 && threadIdx.x == 0) { unsigned d_ = ((volatile LAS unsigned*)(F.lds + AUX_OFF + 24576 + 128))[1];
        if (MK_TPROBE == 17) d_ = __hip_atomic_load(F.ctl + 3000, RLX_AGENT) + __hip_atomic_load(F.ctl + 3001, RLX_AGENT);
        if (MK_TPROBE == 18) d_ = (0x7fffffffu - __hip_atomic_load(F.ctl + 3000, RLX_AGENT)) + (0x7fffffffu - __hip_atomic_load(F.ctl + 3001, RLX_AGENT)); const unsigned t0_ = (unsigned)__builtin_amdgcn_s_memrealtime(); while ((unsigned)__builtin_amdgcn_s_memrealtime() - t0_ < d_) __builtin_amdgcn_s_sleep(8); }
#endif
#ifdef MK_SELFTEST
    {
        const bool h0 = st_run(0, 1.f, 0x7f7f7f7f), h0s = st_run(0, 64.f, 0x79797979), h1 = st_run(1, 1.f, 0x7f7f7f7f);
        xcd_barrier(bar);
        float* o = (float*)karg(21);
        if (!(h0 && h0s)) { const float val = h0 ? 0.f : (h1 ? 1000.f : __builtin_nanf(""));
            for (size_t i = (size_t)blockIdx.x * NTHR + threadIdx.x; i < (size_t)SEQ * DM; i += (size_t)gridDim.x * NTHR) o[i] = val; }
    }
#endif
#undef IN
#undef SEAM
}

#ifndef MK_LAUNCHES
#define MK_LAUNCHES 1
#endif
extern "C" void kernel_launch(void* const* d_in, const int* in_sizes, int n_in, void* d_out, int out_size, void* d_ws, size_t ws_size, hipStream_t stream) {
    static int grid = 0;
    if (grid == 0) {
        int dev = 0, cus = 0, per_cu = 0;
        if (n_in != 21 || ws_size < WS_END) { fprintf(stderr, "kernel_launch: unexpected inputs (n_in %d, ws %zu)\n", n_in, ws_size); grid = -1; return; }
        if (hipGetDevice(&dev) != hipSuccess || hipDeviceGetAttribute(&cus, hipDeviceAttributeMultiprocessorCount, dev) != hipSuccess) { grid = -1; return; }
        if (hipFuncSetAttribute((const void*)mk_fwd, hipFuncAttributeMaxDynamicSharedMemorySize, LDS_BYTES) != hipSuccess) { fprintf(stderr, "kernel_launch: hipFuncSetAttribute failed\n"); grid = -1; return; }
        if (hipOccupancyMaxActiveBlocksPerMultiprocessor(&per_cu, (const void*)mk_fwd, NTHR, LDS_BYTES) != hipSuccess || per_cu < 1) fprintf(stderr, "kernel_launch: occupancy query says %d\n", per_cu);
        (void)hipGetLastError();
        grid = cus;
    }
    if (grid < 0) return;
    (void)hipMemsetAsync((char*)d_ws + WS_CTL, 0, CTL_ZERO_BYTES, stream);
    Args a{};
    for (int i = 0; i < 21; ++i) a.in[i] = (const float*)d_in[i];
    a.out = (float*)d_out; a.ws = (unsigned char*)d_ws;
#if MK_LAUNCHES == 1
    a.ph_lo = 0; a.ph_hi = N_PHASES;
    hipLaunchKernelGGL(mk_fwd, dim3(grid), dim3(NTHR), LDS_BYTES, stream, a);
#else
    for (int p = 0; p < N_PHASES; ++p) { a.ph_lo = p; a.ph_hi = p + 1; hipLaunchKernelGGL(mk_fwd, dim3(grid), dim3(NTHR), LDS_BYTES, stream, a); }
#endif
}
```

```cpp
#include <hip/hip_runtime.h>
#include <stdint.h>
#include <stdio.h>

#define GAS __attribute__((address_space(1)))
#define LAS __attribute__((address_space(3)))
typedef unsigned short bf16;
typedef short bf16x8 __attribute__((ext_vector_type(8)));
typedef short s16x4 __attribute__((ext_vector_type(4)));
typedef float f32x2 __attribute__((ext_vector_type(2)));
typedef float f32x4 __attribute__((ext_vector_type(4)));
typedef float f32x16 __attribute__((ext_vector_type(16)));
typedef unsigned u32x2 __attribute__((ext_vector_type(2)));
typedef unsigned u32x4 __attribute__((ext_vector_type(4)));
typedef int i32x8 __attribute__((ext_vector_type(8)));
typedef int i32x4 __attribute__((ext_vector_type(4)));
typedef GAS unsigned gu32;
#define RLX_AGENT __ATOMIC_RELAXED, __HIP_MEMORY_SCOPE_AGENT
#define LDS_WAIT() asm volatile("s_waitcnt lgkmcnt(0)" ::: "memory")
#define VM_WAIT() asm volatile("s_waitcnt vmcnt(0)" ::: "memory")

constexpr int DM = 2048, SEQ = 8192, NIN = 4616, NZ = 4608, DEX = 1024, NEXP = 16, NLAYER = 2;
constexpr float EPSN = 1e-6f;
constexpr float LOG2E = 1.4426950408889634f;
constexpr int NWAVES = 8, NTHR = 512;
constexpr int HIDROWS = 2 * SEQ + NEXP * 256;

constexpr size_t KiB = 1024, MiB = 1u << 20;
constexpr size_t WS_CTL = 0, CTL_ZERO_BYTES = 1 * MiB;
constexpr size_t WS_MOD = 1 * MiB;
constexpr size_t WS_FLOC = WS_MOD + 128 * KiB;
constexpr size_t WS_TOT = WS_FLOC + 256 * KiB;
constexpr size_t WS_FKL = WS_TOT + 8 * KiB;
constexpr size_t WS_TOKE = WS_FKL + 256 * KiB;
constexpr size_t WS_TOKP = WS_TOKE + 64 * KiB;
constexpr size_t WS_TOKW = WS_TOKP + 64 * KiB;
constexpr size_t WS_NCH = 7 * MiB;
constexpr size_t WS_LIST = WS_TOKW + 64 * KiB;
constexpr size_t WS_WM = 4 * MiB;
constexpr size_t WS_BWT = WS_WM + 256 * KiB;
constexpr size_t WS_MODP = 6 * MiB;
constexpr size_t WS_WIN = 8 * MiB;
constexpr size_t WS_WOUT = WS_WIN + 2 * 18 * MiB;
constexpr size_t WS_WGU = WS_WOUT + 2 * 8 * MiB;
constexpr size_t WS_WD = WS_WGU + 2 * 16 * 8 * MiB;
constexpr size_t WS_H = WS_WD + 2 * 16 * 4 * MiB;
constexpr size_t WS_Z = WS_H + 32 * MiB;
constexpr size_t WS_QN = WS_Z + 72 * MiB;
constexpr size_t WS_KN = WS_QN + 16 * MiB;
constexpr size_t WS_VN = WS_KN + 16 * MiB;
constexpr size_t WS_DP = WS_VN + 8 * MiB;
constexpr size_t WS_YCAT = WS_DP + 8 * MiB;
constexpr size_t WS_X1 = WS_YCAT + 32 * MiB;
constexpr size_t WS_X2 = WS_X1 + 64 * MiB;
constexpr size_t WS_HID = WS_X2 + 64 * MiB;
constexpr size_t WS_YB = WS_HID + 40 * MiB;
constexpr size_t WS_PART = WS_YB + 80 * MiB;
constexpr size_t WS_ML = WS_PART + 128 * MiB;
constexpr size_t WS_HID1 = WS_ML + 4 * MiB;
constexpr size_t WS_END = WS_HID1 + 40 * MiB;
constexpr int CW_TMO = 0, CW_CODE = 1;
constexpr int CW_CNT = 64;
constexpr int CW_Q = 512;
constexpr int CW_BGT = 640;
constexpr int CW_ARR = 1024;
constexpr int CW_MT = 768;
constexpr int CW_BAR = 4096;
constexpr int CW_PC = 32768;
constexpr int CW_RDY = 8192;

constexpr int RING_BYTES = 131072;
constexpr int MISC_OFF = RING_BYTES + 320;
constexpr int AUX_OFF = RING_BYTES + 1024;
constexpr int LDS_BYTES = 163840;

template <class T> __device__ __forceinline__ T* opq(T* p) { asm volatile("" : "+s"(p)); return p; }
__device__ __forceinline__ int opq_tid(int wave) { int t = (wave << 6) | (int)__builtin_amdgcn_mbcnt_hi(~0u, __builtin_amdgcn_mbcnt_lo(~0u, 0u)); asm volatile("" : "+v"(t)); return t; }
__device__ __forceinline__ unsigned cvt_pk_bf16(float lo, float hi) { unsigned r; asm volatile("v_cvt_pk_bf16_f32 %0, %1, %2" : "=v"(r) : "v"(lo), "v"(hi)); return r; }
__device__ __forceinline__ unsigned cvt_pk4_fp8(float a, float b, float c, float d) {
    a = fminf(fmaxf(a, -440.f), 440.f); b = fminf(fmaxf(b, -440.f), 440.f); c = fminf(fmaxf(c, -440.f), 440.f); d = fminf(fmaxf(d, -440.f), 440.f);
    unsigned w; asm volatile("v_cvt_pk_fp8_f32 %0, %1, %2" : "=v"(w) : "v"(a), "v"(b)); asm volatile("v_cvt_pk_fp8_f32 %0, %1, %2 op_sel:[0,0,1]" : "+v"(w) : "v"(c), "v"(d)); return w; }
constexpr float H8_SCALE = 4.f, HID8_SCALE = 4.f, W8_SCALE = 64.f;
constexpr int SC_H8 = 0x7b7b7b7b, SC_HID8 = 0x7b7b7b7b, SC_W8 = 0x7b7b7b7b;
__device__ __forceinline__ float bf_lo(unsigned w) { return __uint_as_float(w << 16); }
__device__ __forceinline__ float bf_hi(unsigned w) { return __uint_as_float(w & 0xffff0000u); }
template <int M> __device__ __forceinline__ float xor_f(float v) {
    static_assert(M < 32, "xor_f: masks below 32 only");
    return __uint_as_float((unsigned)__builtin_amdgcn_ds_swizzle((int)__float_as_uint(v), (M << 10) | 0x1f));
}
__device__ __forceinline__ float wave_sum(float v) {
    v += __uint_as_float((unsigned)__builtin_amdgcn_update_dpp(0, (int)__float_as_uint(v), 0xb1, 0xf, 0xf, true));
    v += __uint_as_float((unsigned)__builtin_amdgcn_update_dpp(0, (int)__float_as_uint(v), 0x4e, 0xf, 0xf, true));
    v += __uint_as_float((unsigned)__builtin_amdgcn_update_dpp(0, (int)__float_as_uint(v), 0x141, 0xf, 0xf, true));
    v += __uint_as_float((unsigned)__builtin_amdgcn_update_dpp(0, (int)__float_as_uint(v), 0x140, 0xf, 0xf, true));
    v += xor_f<16>(v);
    { auto rr = __builtin_amdgcn_permlane32_swap(__float_as_uint(v), __float_as_uint(v), false, false); v = __uint_as_float(rr[0]) + __uint_as_float(rr[1]); }
    return v;
}
__device__ __forceinline__ float wave_max(float v) {
    v = fmaxf(v, xor_f<1>(v)); v = fmaxf(v, xor_f<2>(v)); v = fmaxf(v, xor_f<4>(v)); v = fmaxf(v, xor_f<8>(v)); v = fmaxf(v, xor_f<16>(v));
    { auto rr = __builtin_amdgcn_permlane32_swap(__float_as_uint(v), __float_as_uint(v), false, false); v = fmaxf(__uint_as_float(rr[0]), __uint_as_float(rr[1])); }
    return v;
}
__device__ __forceinline__ float gelu_t(float x) {
    const float u2 = x * (1.5957691216057308f + 0.0713548162726f * x * x);
    return x * __builtin_amdgcn_rcpf(1.f + __builtin_amdgcn_exp2f(-LOG2E * u2));
}
__device__ __forceinline__ float silu_f(float x) { return x * __builtin_amdgcn_rcpf(1.f + __builtin_amdgcn_exp2f(-LOG2E * x)); }

#define XB_TMO      128
#define XB_XCNT(j)  (256  + 64 * (j))
#define XB_XSUB(j)  (1280 + 64 * (j))
#define XB_XGEN(j)  (2304 + 64 * (j))
#define XB_TOP      3328
#define XB_TOPGEN   3392
#define XCD_BAR_WORDS 3456
#define XB_SPIN_CAP (1u << 18)
__device__ __forceinline__ unsigned xb_ld(unsigned* p)              { return __hip_atomic_load(p, __ATOMIC_RELAXED, __HIP_MEMORY_SCOPE_AGENT); }
__device__ __forceinline__ unsigned xb_add(unsigned* p, unsigned v) { return __hip_atomic_fetch_add(p, v, __ATOMIC_RELAXED, __HIP_MEMORY_SCOPE_AGENT); }
__device__ __forceinline__ unsigned xb_xcc_id() { return (unsigned)__builtin_amdgcn_s_getreg((3 << 11) | 20) & 0xFu; }
#define XB_SPIN(cond, bar) do { unsigned _sp = 0; while (cond) { __builtin_amdgcn_s_sleep(1); \
    if ((++_sp & 255u) == 0u) { if (xb_ld(&(bar)[XB_TMO])) break; if (_sp > XB_SPIN_CAP) { atomicAdd(&(bar)[XB_TMO], 1u); break; } } } } while (0)
struct XcdBarrier { unsigned* bar; unsigned x; volatile LAS unsigned* st; };
__device__ __forceinline__ XcdBarrier xcd_barrier_post(unsigned* bar, volatile LAS unsigned* st) {
    XcdBarrier b; b.bar = bar; b.x = xb_xcc_id(); b.st = st;
    if (threadIdx.x == 0) (void)xb_add(&bar[XB_XCNT(b.x)], 1u);
    return b;
}
__device__ __forceinline__ void xcd_barrier_complete(unsigned* bar, unsigned x, unsigned& nloc, unsigned& nx) {
    const unsigned G = gridDim.x * gridDim.y * gridDim.z;
    unsigned sum, cnt, mine, sp = 0u;
    for (;;) {
        sum = 0u; cnt = 0u; mine = 0u;
#pragma unroll
        for (unsigned j = 0; j < 16; ++j) { const unsigned c = xb_ld(&bar[XB_XCNT(j)]); sum += c; cnt += (c > 0u) ? 1u : 0u; mine = (j == x) ? c : mine; }
        if (sum == G) break;
        __builtin_amdgcn_s_sleep(1);
        if ((++sp & 255u) == 0u) { if (xb_ld(&bar[XB_TMO])) break; if (sp > XB_SPIN_CAP) { atomicAdd(&bar[XB_TMO], 1u); break; } }
    }
    nloc = mine > 0u ? mine : 1u; nx = cnt > 0u ? cnt : 1u;
}
__device__ __forceinline__ void xcd_barrier(const XcdBarrier& b) {
    asm volatile("s_waitcnt vmcnt(0)" ::: "memory");
    __syncthreads();
    if (threadIdx.x == 0) {
        unsigned* bar = b.bar; asm volatile("" : "+s"(bar));
        __builtin_amdgcn_s_waitcnt(0);
        unsigned nloc = b.st[0], nx = b.st[1];
        if (nloc == 0u) { xcd_barrier_complete(bar, b.x, nloc, nx); b.st[0] = nloc; b.st[1] = nx; }
        const unsigned old = xb_add(&bar[XB_XSUB(b.x)], 1u);
        const unsigned gen = old / nloc;
        if (old + 1u == (gen + 1u) * nloc) {
            __builtin_amdgcn_fence(__ATOMIC_RELEASE, "agent");
            asm volatile("s_waitcnt vmcnt(0)" ::: "memory");
            const unsigned og = xb_add(&bar[XB_TOP], 1u);
            const unsigned tg = og / nx;
            if (og + 1u == (tg + 1u) * nx) xb_add(&bar[XB_TOPGEN], 1u);
            else XB_SPIN(xb_ld(&bar[XB_TOPGEN]) == tg, bar);
            __builtin_amdgcn_fence(__ATOMIC_ACQUIRE, "agent");
            xb_add(&bar[XB_XGEN(b.x)], 1u);
            asm volatile("s_waitcnt vmcnt(0)" ::: "memory");
        } else {
            XB_SPIN(xb_ld(&bar[XB_XGEN(b.x)]) == gen, bar);
            __builtin_amdgcn_fence(__ATOMIC_ACQUIRE, "agent");
            asm volatile("s_waitcnt vmcnt(0)" ::: "memory");
        }
    }
    __syncthreads();
}

namespace gm {
constexpr int BM = 256, BK = 64, HALF = 128, HTB = HALF * BK * 2, STAGE_BYTES = 8 * HTB, NXCD = 8, WGM = 8;
__host__ __device__ __forceinline__ int lds_byte(int r, int c) { const int st = (r >> 4) * 2 + (c >> 5), rr = r & 15, cc = c & 31, ob = rr * 64 + cc * 2; return st * 1024 + (ob ^ (((ob >> 9) & 1) << 5)); }
__host__ __device__ __forceinline__ void stage_rc(int b, int& R, int& C) { const int st = b / 1024, sb = b % 1024, swz = sb ^ (((sb >> 9) & 1) << 5); R = (st >> 1) * 16 + swz / 64; C = (st & 1) * 32 + (swz % 64) / 2; }
__host__ __device__ __forceinline__ int perm32(int rho) { const int n = rho >> 4, i = rho & 15; return 8 * (i >> 2) + 4 * n + (i & 3); }

struct Unit { int arow, orow, ocol, e, rt; const char* Bp; };

template <class Epi, class Sched, bool GATHER, bool ALIGN_EPI, bool FP8 = false, int SCA = 0x7f7f7f7f, int SCB = 0x7f7f7f7f>
__device__ __forceinline__ void gemm_phase(LAS unsigned char* lds, const char* Abase, const int Kel, const Sched& S, const Epi& E, const int wv) {
    const int K = FP8 ? (Kel >> 1) : Kel;
    const int tid = opq_tid(wv), wid = wv, lane = tid & 63, wr = wid >> 2, wc = wid & 3, fr = lane & 15, fq = lane >> 4;
    const int nt = K / BK;
    unsigned voffA[2], voffB[2];
#pragma unroll
    for (int i = 0; i < 2; ++i) { int R, C; stage_rc(tid * 16 + i * 8192, R, C); const int Rb = Epi::PERM ? ((R & ~31) + perm32(R & 31)) : R;
        voffA[i] = (unsigned)(R * K + C) * 2u; voffB[i] = (unsigned)(Rb * K + C) * 2u; }
    const size_t kstep = (size_t)(BK * 2);
    const size_t hstep = (size_t)HALF * K * 2;
    const unsigned ldsw = (unsigned)wid * 1024u;
    const int aoff = FP8 ? lds_byte(wr * 64 + fr, fq * 16) : lds_byte(wr * 64 + fr, fq * 8), boff = FP8 ? lds_byte(wc * 32 + fr, fq * 16) : lds_byte(wc * 32 + fr, fq * 8);
#define PG8_SA(b, h) (((b) * 2 + (h)) * HTB)
#define PG8_SB(b, h) ((4 + (b) * 2 + (h)) * HTB)
#define PG8_STAGE(bufoff, gbase, voff) do { _Pragma("unroll") for (int _i = 0; _i < 2; ++_i) { unsigned vo_ = (voff)[_i]; asm volatile("" : "+v"(vo_));     \
        __builtin_amdgcn_global_load_lds((const unsigned*)((const char*)(gbase) + vo_), (LAS unsigned*)(lds + (bufoff) + ldsw + _i * 8192), 16, 0, 0); } } while (0)
#define PG8_STAGE_A(bufoff, ubase, h, kb, vg) do { if constexpr (GATHER) { PG8_STAGE(bufoff, Abase + (kb), (vg)[h]); } else { PG8_STAGE(bufoff, (ubase) + (h) * hstep + (kb), voffA); } } while (0)
#define PG8_STAGE_A2(bufoff, ubase, h, kb) PG8_STAGE_A(bufoff, ubase, h, kb, vgc)
#define PG8_LDA(dst, b, h) do { _Pragma("unroll") for (int m = 0; m < 4; ++m) { if constexpr (FP8) { dst##8[m].lo = *(const LAS i32x4*)(lds + PG8_SA(b, h) + aoff + m * 2048); dst##8[m].hi = *(const LAS i32x4*)(lds + PG8_SA(b, h) + aoff + 16 + m * 2048); } \
        else { dst[m][0] = *(const LAS bf16x8*)(lds + PG8_SA(b, h) + aoff + m * 2048); dst[m][1] = *(const LAS bf16x8*)(lds + PG8_SA(b, h) + aoff + 1024 + m * 2048); } } } while (0)
#define PG8_LDB(dst, b, h) do { _Pragma("unroll") for (int n = 0; n < 2; ++n) { if constexpr (FP8) { dst##8[n].lo = *(const LAS i32x4*)(lds + PG8_SB(b, h) + boff + n * 2048); dst##8[n].hi = *(const LAS i32x4*)(lds + PG8_SB(b, h) + boff + 16 + n * 2048); } \
        else { dst[n][0] = *(const LAS bf16x8*)(lds + PG8_SB(b, h) + boff + n * 2048); dst[n][1] = *(const LAS bf16x8*)(lds + PG8_SB(b, h) + boff + 1024 + n * 2048); } } } while (0)
#define PG8_F8(x) __builtin_shufflevector(__builtin_bit_cast(i32x4, (x)[0]), __builtin_bit_cast(i32x4, (x)[1]), 0, 1, 2, 3, 4, 5, 6, 7)
#define PG8_MMA(ai, bj, At, Bt) do { __builtin_amdgcn_s_setprio(1); _Pragma("unroll") for (int m = 0; m < 4; ++m) _Pragma("unroll") for (int n = 0; n < 2; ++n) { \
        if constexpr (FP8) { acc[ai][bj][m][n] = __builtin_amdgcn_mfma_scale_f32_16x16x128_f8f6f4(Bt##8[n], At##8[m], acc[ai][bj][m][n], 0, 0, 0, SCB, 0, SCA); } \
        else { _Pragma("unroll") for (int k = 0; k < 2; ++k) acc[ai][bj][m][n] = __builtin_amdgcn_mfma_f32_16x16x32_bf16(Bt[n][k], At[m][k], acc[ai][bj][m][n], 0, 0, 0); } } \
        __builtin_amdgcn_s_setprio(0); } while (0)
#define PG8_WAIT_V(n) asm volatile("s_waitcnt vmcnt(" #n ")" ::: "memory")
#define PG8_WAIT_L(n) asm volatile("s_waitcnt lgkmcnt(" #n ")" ::: "memory")
#define PG8_BAR __builtin_amdgcn_s_barrier()
#define PG8_SCHED __builtin_amdgcn_sched_barrier(0)
    Unit cur, nxt; int ui = 0;
    if (!S.next(0, cur)) return;
    f32x4 acc[2][2][4][2];
#pragma unroll
    for (int a = 0; a < 2; ++a)
#pragma unroll
        for (int b = 0; b < 2; ++b)
#pragma unroll
            for (int m = 0; m < 4; ++m)
#pragma unroll
                for (int n = 0; n < 2; ++n) acc[a][b][m][n] = (f32x4){0.f, 0.f, 0.f, 0.f};
    bf16x8 At[4][2], B0[2][2], B1[2][2];
    i32x8 At8[4], B08[2], B18[2];
    unsigned vgc[2][2];
    if constexpr (GATHER) {
#pragma unroll
        for (int h = 0; h < 2; ++h)
#pragma unroll
            for (int i = 0; i < 2; ++i) { int R_, C_; stage_rc(opq_tid(wv) * 16 + i * 8192, R_, C_); vgc[h][i] = ((unsigned)S.row_of(cur, h * HALF + R_) * (unsigned)K + (unsigned)C_) * 2u; }
    }
    const char* cA = GATHER ? Abase : Abase + (size_t)cur.arow * K * 2; const char* cB = cur.Bp;
    PG8_STAGE(PG8_SB(0, 0), cB, voffB); PG8_STAGE(PG8_SB(0, 1), cB + hstep, voffB); PG8_STAGE_A(PG8_SA(0, 0), cA, 0, 0, vgc); PG8_STAGE_A(PG8_SA(0, 1), cA, 1, 0, vgc);
    if (wr == 1) PG8_BAR;
    PG8_WAIT_V(2); PG8_BAR;
    PG8_STAGE(PG8_SB(1, 0), cB + kstep, voffB); PG8_STAGE_A(PG8_SA(1, 0), cA, 0, kstep, vgc); PG8_STAGE(PG8_SB(1, 1), cB + hstep + kstep, voffB);
    PG8_WAIT_V(6); PG8_BAR;
    for (;;) {
        bool has_next = false;
        const char* nA = cA; const char* nB = cB;
        for (int t = 0; t < nt; t += 2) {
            const bool last = (t == nt - 2);
            if (last) { has_next = S.next(ui + 1, nxt); if (has_next) { nA = GATHER ? Abase : Abase + (size_t)nxt.arow * K * 2; nB = nxt.Bp; } }
            const size_t k1 = (size_t)(t + 1) * kstep;
            const char* a2 = last ? nA : cA; const char* b2 = last ? nB : cB + (size_t)(t + 2) * kstep;
            const size_t k2 = last ? 0 : (size_t)(t + 2) * kstep, k3 = k2 + kstep;
            const char* b3 = b2 + kstep;
            PG8_LDB(B0, 0, 0); PG8_LDB(B1, 0, 1); PG8_SCHED; PG8_LDA(At, 0, 0); PG8_STAGE_A(PG8_SA(1, 1), cA, 1, k1, vgc);
            if constexpr (GATHER) { if (last && has_next) {
#pragma unroll
                for (int h = 0; h < 2; ++h)
#pragma unroll
                    for (int i = 0; i < 2; ++i) { int R_, C_; stage_rc(opq_tid(wv) * 16 + i * 8192, R_, C_); vgc[h][i] = ((unsigned)S.row_of(nxt, h * HALF + R_) * (unsigned)K + (unsigned)C_) * 2u; } } }
            PG8_WAIT_V(8); PG8_WAIT_L(0); PG8_BAR; PG8_MMA(0, 0, At, B0); PG8_MMA(0, 1, At, B1); PG8_BAR; PG8_SCHED;
            PG8_LDA(At, 0, 1); PG8_STAGE(PG8_SB(0, 0), b2, voffB); PG8_STAGE(PG8_SB(0, 1), b2 + hstep, voffB); PG8_STAGE_A2(PG8_SA(0, 0), a2, 0, k2);
            PG8_WAIT_V(8); PG8_WAIT_L(0); PG8_BAR; PG8_MMA(1, 0, At, B0); PG8_MMA(1, 1, At, B1); PG8_BAR; PG8_SCHED;
            PG8_LDB(B0, 1, 0); PG8_LDB(B1, 1, 1); PG8_SCHED; PG8_LDA(At, 1, 0); PG8_STAGE_A2(PG8_SA(0, 1), a2, 1, k2);
            PG8_WAIT_V(8); PG8_WAIT_L(0); PG8_BAR; PG8_MMA(0, 0, At, B0); PG8_MMA(0, 1, At, B1); PG8_BAR; PG8_SCHED;
            PG8_LDA(At, 1, 1); PG8_STAGE(PG8_SB(1, 0), b3, voffB); PG8_STAGE(PG8_SB(1, 1), b3 + hstep, voffB); PG8_STAGE_A2(PG8_SA(1, 0), a2, 0, k3);
            PG8_WAIT_V(8); PG8_WAIT_L(0); PG8_BAR; PG8_MMA(1, 0, At, B0); PG8_MMA(1, 1, At, B1); PG8_BAR; PG8_SCHED;
        }
        if constexpr (ALIGN_EPI) { if (wr == 0) PG8_BAR; }
        E(acc, cur, wr, wc, fr, fq);
        if (!has_next) break;
#pragma unroll
        for (int a = 0; a < 2; ++a)
#pragma unroll
            for (int b = 0; b < 2; ++b)
#pragma unroll
                for (int m = 0; m < 4; ++m)
#pragma unroll
                    for (int n = 0; n < 2; ++n) acc[a][b][m][n] = (f32x4){0.f, 0.f, 0.f, 0.f};
        cur = nxt; cA = nA; cB = nB; ++ui;
        if constexpr (ALIGN_EPI) { if (wr == 1) PG8_BAR; }
    }
    PG8_WAIT_V(0);
    if constexpr (!ALIGN_EPI) { if (wr == 0) PG8_BAR; }
    PG8_BAR;
#undef PG8_SA
#undef PG8_SB
#undef PG8_STAGE
#undef PG8_STAGE_A
#undef PG8_STAGE_A2
#undef PG8_LDA
#undef PG8_LDB
#undef PG8_MMA
#undef PG8_F8
#undef PG8_WAIT_V
#undef PG8_WAIT_L
#undef PG8_BAR
#undef PG8_SCHED
}

struct RegOrder {
    int nM, nN, nwg, G, c, K; const char* Bt;
    __device__ __forceinline__ void init(int M, int N, int K_, const void* Bt_, int G_, int c_) { nM = M / BM; nN = N / BM; nwg = nM * nN; G = G_; c = c_; K = K_; Bt = (const char*)Bt_; }
    __device__ __forceinline__ bool next(int i, Unit& u) const {
        const long L = (long)i * G + c; if (L >= nwg) return false;
        int wgid = (int)L; { const int q = nwg / NXCD, r = nwg % NXCD, xcd = wgid % NXCD, off = wgid / NXCD; wgid = (xcd < r ? xcd * (q + 1) : r * (q + 1) + (xcd - r) * q) + off; }
        const int nig = WGM * nN, gid = wgid / nig, fm = gid * WGM, gsz = (nM - fm) < WGM ? (nM - fm) : WGM;
        const int pm = fm + ((wgid % nig) % gsz), pn = (wgid % nig) / gsz;
        u.arow = pm * BM; u.orow = pm * BM; u.ocol = pn * BM; u.e = 0; u.rt = 0; u.Bp = Bt + (size_t)pn * BM * K * 2; return true;
    }
    __device__ __forceinline__ int row_of(const Unit&, int) const { return 0; }
};
}
namespace at {
constexpr int NW = 8, QBLK = 32, KVBLK = 64, QB = NW * QBLK, D = 128;
constexpr int SHM_V = KVBLK * D * 2, SHM_K = KVBLK * D * 2;
constexpr int OFF_WS = 2 * SHM_V + 2 * SHM_K, OFF_NF = OFF_WS + NW * 64 * 4, ATT_LDS = OFF_NF + 2 * 64 * 4;
constexpr float SCALE = 0.08838834764831845f, C2 = 1.4426950408889634f * SCALE, THR = 8.f;
constexpr float ISCALE = 11.313708498984761f;
constexpr int QS = 128, KS = 128, VS = NZ, OS = DM;

#define KSWZ(row, colB) ((row) * 256 + ((colB) ^ (((row) & 7) << 4)))
#define SBAR() __builtin_amdgcn_sched_barrier(0)
__device__ __forceinline__ int v_st(int k, int c) { const int kk = (k & ~0xC) | ((k & 4) << 1) | ((k & 8) >> 1); return ((kk >> 3) * 4 + (c >> 5)) * 512 + ((kk & 7) * 32 + (c & 31)) * 2; }
__device__ __forceinline__ int v_rd_base(int lane) { return ((lane & 3) << 3) | (((lane >> 2) & 3) << 6) | (((lane >> 4) & 1) << 5) | (((lane >> 5) & 1) << 8); }
constexpr int v_rd_off(int d0, int ks, int half) { return d0 * 512 + ks * 4096 + half * 2048; }
__device__ __forceinline__ int crow(int r, int hi) { return (r & 3) + 8 * (r >> 2) + 4 * hi; }
__device__ __forceinline__ unsigned cvtpk(float lo, float hi) { unsigned r; asm volatile("v_cvt_pk_bf16_f32 %0, %1, %2" : "=v"(r) : "v"(lo), "v"(hi)); return r; }
__device__ __forceinline__ bf16x8 load8(const bf16* p) { return *(const GAS bf16x8*)p; }

__device__ __forceinline__ void mask_tile(f32x16& p0, f32x16& p1, int dq) {
    const float NEG = -__builtin_inff();
#pragma unroll
    for (int r = 0; r < 16; ++r) {
        const int c = (r & 3) + 8 * (r >> 2);
        if (dq - c < 0) p0[r] = NEG;
        if (dq - c - 32 < 0) p1[r] = NEG;
    }
}
__device__ __forceinline__ void partialSM(f32x16& p0, f32x16& p1, float& m_reg, float& mn, float& alpha) {
    float pmax = p0[0]; for (int r = 1; r < 16; ++r) pmax = fmaxf(pmax, p0[r]); for (int r = 0; r < 16; ++r) pmax = fmaxf(pmax, p1[r]);
    { auto rr = __builtin_amdgcn_permlane32_swap(__float_as_uint(pmax), __float_as_uint(pmax), false, false);
      pmax = fmaxf(__uint_as_float(rr[0]), __uint_as_float(rr[1])); }
    if (__builtin_expect(__all((pmax - m_reg) * SCALE <= THR), 1)) { mn = m_reg; alpha = 1.f; }
    else { mn = fmaxf(m_reg, pmax); alpha = __builtin_amdgcn_exp2f((m_reg - mn) * C2); m_reg = mn; }
    const float mnL = -mn * C2;
    for (int r = 0; r < 16; ++r) p0[r] = fmaf(p0[r], C2, mnL); for (int r = 0; r < 16; ++r) p1[r] = fmaf(p1[r], C2, mnL);
    for (int r = 0; r < 16; ++r) p0[r] = __builtin_amdgcn_exp2f(p0[r]);
}
__device__ __forceinline__ void finishSM(f32x16& p0, f32x16& p1, float alpha, float& l_reg, bf16x8& pa0, bf16x8& pa1, bf16x8& pa2, bf16x8& pa3) {
    for (int r = 0; r < 16; ++r) p1[r] = __builtin_amdgcn_exp2f(p1[r]);
    float ps = 0; for (int r = 0; r < 16; ++r) ps += p0[r]; for (int r = 0; r < 16; ++r) ps += p1[r];
    { auto rr = __builtin_amdgcn_permlane32_swap(__float_as_uint(ps), __float_as_uint(ps), false, false);
      ps = __uint_as_float(rr[0]) + __uint_as_float(rr[1]); }
    l_reg = l_reg * alpha + ps;
#define PK4(P, B_, OUT) do { unsigned a0 = cvtpk(P[B_+0], P[B_+1]), a1 = cvtpk(P[B_+2], P[B_+3]);                          \
        unsigned b0 = cvtpk(P[B_+4], P[B_+5]), b1 = cvtpk(P[B_+6], P[B_+7]);                                             \
        auto r0 = __builtin_amdgcn_permlane32_swap(a0, b0, false, false); auto r1 = __builtin_amdgcn_permlane32_swap(a1, b1, false, false); \
        u32x4 w = {r0[0], r1[0], r0[1], r1[1]}; OUT = *reinterpret_cast<bf16x8*>(&w); } while (0)
    PK4(p0, 0, pa0); PK4(p0, 8, pa1); PK4(p1, 0, pa2); PK4(p1, 8, pa3);
#undef PK4
}
template <int KB>
__device__ __forceinline__ void qkt(f32x16& p0, f32x16& p1, const char* K_lds, int r32, int hi, const bf16x8* qr) {
    { const float* nf = (const float*)(K_lds + 2 * SHM_K + NW * 64 * 4) + KB * 64 + 4 * hi;
#pragma unroll
      for (int g = 0; g < 4; ++g) { const f32x4 a = *(const f32x4*)(nf + 8 * g), b = *(const f32x4*)(nf + 32 + 8 * g);
#pragma unroll
          for (int j = 0; j < 4; ++j) { p0[4 * g + j] = a[j]; p1[4 * g + j] = b[j]; } } }
    const char* kb[4];
#pragma unroll
    for (int dd = 0; dd < 4; ++dd) kb[dd] = K_lds + KB * SHM_K + KSWZ(r32, (dd * 16 + hi * 8) * 2);
#pragma unroll
    for (int d0 = 0; d0 < 8; ++d0) { const char* a = kb[d0 & 3] + (d0 >> 2) * 128;
        bf16x8 b0 = *reinterpret_cast<const bf16x8*>(a);
        bf16x8 b1 = *reinterpret_cast<const bf16x8*>(a + 32 * 256);
        p0 = __builtin_amdgcn_mfma_f32_32x32x16_bf16(b0, qr[d0], p0, 0, 0, 0);
        p1 = __builtin_amdgcn_mfma_f32_32x32x16_bf16(b1, qr[d0], p1, 0, 0, 0); }
}
template <int VB>
__device__ __forceinline__ void pv_tile(f32x16* o, int vb0, bf16x8 pa0, bf16x8 pa1, bf16x8 pa2, bf16x8 pa3) {
#define TRRD(dst, off) asm volatile("ds_read_b64_tr_b16 %0, %1 offset:%2" : "=&v"(dst) : "v"(vb0), "i"(off) : "memory")
#define PV_D0(d0) do { s16x4 l0, l1, l2, l3, h0, h1, h2, h3; constexpr int b_ = VB * SHM_V + v_rd_off(d0, 0, 0); \
        TRRD(l0, b_); TRRD(h0, b_ + 2048); TRRD(l1, b_ + 4096); TRRD(h1, b_ + 6144); TRRD(l2, b_ + 8192); TRRD(h2, b_ + 10240); TRRD(l3, b_ + 12288); TRRD(h3, b_ + 14336); \
        asm volatile("s_waitcnt lgkmcnt(0)" ::: "memory"); SBAR();   \
        o[d0] = __builtin_amdgcn_mfma_f32_32x32x16_bf16(pa0, (bf16x8){l0[0], l0[1], l0[2], l0[3], h0[0], h0[1], h0[2], h0[3]}, o[d0], 0, 0, 0);   \
        o[d0] = __builtin_amdgcn_mfma_f32_32x32x16_bf16(pa1, (bf16x8){l1[0], l1[1], l1[2], l1[3], h1[0], h1[1], h1[2], h1[3]}, o[d0], 0, 0, 0);   \
        o[d0] = __builtin_amdgcn_mfma_f32_32x32x16_bf16(pa2, (bf16x8){l2[0], l2[1], l2[2], l2[3], h2[0], h2[1], h2[2], h2[3]}, o[d0], 0, 0, 0);   \
        o[d0] = __builtin_amdgcn_mfma_f32_32x32x16_bf16(pa3, (bf16x8){l3[0], l3[1], l3[2], l3[3], h3[0], h3[1], h3[2], h3[3]}, o[d0], 0, 0, 0); } while (0)
    PV_D0(0); PV_D0(1); PV_D0(2); PV_D0(3);
#undef PV_D0
#undef TRRD
}

struct BlockRef { const bf16* Q; const bf16* K; const bf16* V; unsigned char* O; const float* FK; int P0; };
#define ROWV(p, k0, rr) ((p) + (size_t)((k0) + (rr)) * VS + sc)
#define VMW() asm volatile("s_waitcnt vmcnt(0)" ::: "memory")
__device__ __forceinline__ void attn_block(const BlockRef& cur, int ja, int nt, bool fin, bf16* Opart, float* ML, char* lds, LAS unsigned char* ldsL, const int wv) {
    const int tid = opq_tid(wv), wid = wv, lane = tid & 63, r32 = lane & 31, hi = lane >> 5;
    const int NT = nt;
    const int qlo = cur.P0 + wid * QBLK, qm = qlo + r32 - 4 * hi;
    char* V_lds = lds; char* K_lds = lds + 2 * SHM_V;
    float* ws = (float*)(lds + OFF_WS) + wid * 64; float* li_l = ws, * al_l = ws + 32;
    float m_reg = -1e30f, l_reg = 0; f32x16 o[4] = {};
    const int vb0 = (int)(uintptr_t)V_lds + v_rd_base(lane);
    const bf16* Kh = cur.K; const bf16* Vh = cur.V; const float* Fh = cur.FK;
    bf16x8 st_v0, st_v1; bf16x8 qr[8];
#define KDMA(bf, k0) do { int t_ = tid; asm volatile("" : "+v"(t_)); _Pragma("unroll") for (int i_ = 0; i_ < 2; ++i_) { const int p_ = i_ * 512 + t_, r_ = p_ >> 4, c_ = (p_ & 15) ^ (r_ & 7); \
        __builtin_amdgcn_global_load_lds((const unsigned*)((const char*)Kh + (size_t)(k0) * KS * 2 + (unsigned)(r_ * KS * 2 + c_ * 16)), (LAS unsigned*)(ldsL + 2 * SHM_V + (bf) * SHM_K + i_ * 8192 + wid * 1024), 16, 0, 0); } \
        if (wid == 0) __builtin_amdgcn_global_load_lds((const unsigned*)(Fh + (k0) + lane), (LAS unsigned*)(ldsL + OFF_NF + (bf) * 256), 4, 0, 0); } while (0)
#define SLOADV(k0) do { int t_ = tid; asm volatile("" : "+v"(t_)); const int sr = t_ >> 4, sc = (t_ & 15) * 8; st_v0 = load8(ROWV(Vh, k0, sr)); st_v1 = load8(ROWV(Vh, k0, 32 + sr)); } while (0)
#define SWRITE_HV(bf) do { int t_ = tid; asm volatile("" : "+v"(t_)); const int sr = t_ >> 4, sc = (t_ & 15) * 8; *(bf16x8*)(V_lds + (bf) * SHM_V + v_st(sr, sc)) = st_v0; *(bf16x8*)(V_lds + (bf) * SHM_V + v_st(32 + sr, sc)) = st_v1; } while (0)
#define RESC(a) do { if (__any((a) < 1.f)) { if (hi == 0) al_l[r32] = (a); asm volatile("s_waitcnt lgkmcnt(0)" ::: "memory");              \
                     for (int d_ = 0; d_ < 4; ++d_) for (int r = 0; r < 16; ++r) o[d_][r] *= al_l[crow(r, hi)]; } } while (0)
#define KBASE(t) ((ja + (t)) * KVBLK)
#define MASKT(P0_, P1_, t) do { const int kb_ = KBASE(t); if (kb_ + KVBLK - 1 > qlo) mask_tile(P0_, P1_, qm - kb_); } while (0)
    f32x16 pA0, pA1, pB0, pB1; float mnA, mnB, alA, alB; bf16x8 pa0, pa1, pa2, pa3;
    KDMA(0, KBASE(0)); SLOADV(KBASE(0));
#pragma unroll
    for (int d0 = 0; d0 < 8; ++d0) qr[d0] = load8(cur.Q + (size_t)(wid * QBLK + r32) * QS + d0 * 16 + hi * 8);
    VMW(); SWRITE_HV(0);
    __syncthreads();
    if (NT > 1) { KDMA(1, KBASE(1)); SLOADV(KBASE(1)); }
    SBAR(); qkt<0>(pA0, pA1, K_lds, r32, hi, qr);
    MASKT(pA0, pA1, 0); partialSM(pA0, pA1, m_reg, mnA, alA);
    if (NT > 1) { VMW(); SWRITE_HV(1); }
    __syncthreads();
#define HALF_STEP(PX0, PX1, mnX, alX, PY0, PY1, alY, t, KB, VB, SB) do {                                                      \
        SBAR(); qkt<KB>(PX0, PX1, K_lds, r32, hi, qr);                                                                        \
        finishSM(PY0, PY1, alY, l_reg, pa0, pa1, pa2, pa3); SBAR();                                                           \
        if ((t) + 1 < NT) { KDMA(SB, KBASE((t) + 1)); SLOADV(KBASE((t) + 1)); SBAR(); }                                       \
        pv_tile<VB>(o, vb0, pa0, pa1, pa2, pa3); MASKT(PX0, PX1, (t)); partialSM(PX0, PX1, m_reg, mnX, alX);                  \
        VMW(); __syncthreads();                                                                                               \
        if ((t) + 1 < NT) { SWRITE_HV(SB); }                                                                                  \
        RESC(alX); __syncthreads(); } while (0)
    for (int t = 1; t + 1 < NT; t += 2) {
        HALF_STEP(pB0, pB1, mnB, alB, pA0, pA1, alA, t, 1, 0, 0);
        HALF_STEP(pA0, pA1, mnA, alA, pB0, pB1, alB, t + 1, 0, 1, 1);
    }
    const bool even = (NT & 1) == 0;
    if (even) { SBAR(); qkt<1>(pB0, pB1, K_lds, r32, hi, qr); SBAR(); }
    finishSM(pA0, pA1, alA, l_reg, pa0, pa1, pa2, pa3); SBAR();
    pv_tile<0>(o, vb0, pa0, pa1, pa2, pa3);
    if (even) { MASKT(pB0, pB1, NT - 1); partialSM(pB0, pB1, m_reg, mnB, alB); __syncthreads(); RESC(alB);
        finishSM(pB0, pB1, alB, l_reg, pa0, pa1, pa2, pa3); SBAR(); pv_tile<1>(o, vb0, pa0, pa1, pa2, pa3); }
    SBAR();
    if (hi == 0) li_l[r32] = l_reg; asm volatile("s_waitcnt lgkmcnt(0)" ::: "memory");
    float rli[16];
#pragma unroll
    for (int r = 0; r < 16; ++r) rli[r] = __builtin_amdgcn_rcpf(li_l[crow(r, hi)]);
    if (fin) {
        unsigned char* Ow = cur.O + (size_t)(wid * QBLK) * OS;
#pragma unroll
        for (int r = 0; r < 16; ++r) { const int orow = crow(r, hi);
#pragma unroll
            for (int d0 = 0; d0 < 4; ++d0) { const float v = o[d0][r] * rli[r] * H8_SCALE; const int vi = (int)__float_as_uint(v);
                const float v1 = __uint_as_float((unsigned)__builtin_amdgcn_mov_dpp(vi, 0x55, 0xf, 0xf, true)), v2 = __uint_as_float((unsigned)__builtin_amdgcn_mov_dpp(vi, 0xaa, 0xf, 0xf, true)), v3 = __uint_as_float((unsigned)__builtin_amdgcn_mov_dpp(vi, 0xff, 0xf, 0xf, true));
                const unsigned w = cvt_pk4_fp8(v, v1, v2, v3);
                if ((r32 & 3) == 0) *(GAS unsigned*)(Ow + (size_t)orow * OS + d0 * 32 + r32) = w; } }
    } else {
        bf16* Ow = Opart + (size_t)(wid * QBLK) * D;
#pragma unroll
        for (int r = 0; r < 16; ++r) { const int orow = crow(r, hi);
#pragma unroll
            for (int d0 = 0; d0 < 4; ++d0) { const float v = o[d0][r] * rli[r];
                const float vn = xor_f<1>(v);
                if ((r32 & 1) == 0) __hip_atomic_store((unsigned*)(Ow + (size_t)orow * D + d0 * 32 + r32), cvtpk(v, vn), RLX_AGENT); } }
    }
    if (!fin) { if (hi == 0) { float* const pm = ML + (size_t)(wid * QBLK + r32) * 2; __hip_atomic_store(pm, m_reg, RLX_AGENT); __hip_atomic_store(pm + 1, l_reg, RLX_AGENT); }
        asm volatile("s_waitcnt vmcnt(0)" ::: "memory"); }
    __syncthreads();
#undef KDMA
#undef SLOADV
#undef SWRITE_HV
#undef RESC
#undef KBASE
#undef MASKT
#undef HALF_STEP
}
#undef ROWV
#undef VMW
}
struct Frame {
    LAS unsigned char* lds; volatile LAS unsigned* MISC; gu32* ctl;
    int tid, lane, wave, vcu, G;
    unsigned char* ws;
};
#define CAS __attribute__((address_space(4)))
__device__ __forceinline__ const float* karg(int k) { const CAS char* p = (const CAS char*)__builtin_amdgcn_kernarg_segment_ptr(); asm volatile("" : "+s"(p)); return *(const float* const CAS*)(p + 8 * k); }

__device__ __forceinline__ void tr_item(const float* W, size_t ldw, bf16* WT, size_t ldk, LAS float* scr, int lane) {
    const int kr = lane >> 3, c4 = (lane & 7) * 4;
    f32x4 v[8];
#pragma unroll
    for (int i = 0; i < 8; ++i) v[i] = __builtin_nontemporal_load((const GAS f32x4*)(W + (size_t)(8 * i + kr) * ldw + c4));
#pragma unroll
    for (int i = 0; i < 8; ++i) { LAS float* s = scr + (8 * i + kr) * 33 + c4; s[0] = v[i].x; s[1] = v[i].y; s[2] = v[i].z; s[3] = v[i].w; }
    LDS_WAIT();
    const int c = lane & 7;
#pragma unroll
    for (int j = 0; j < 4; ++j) { const int n = (lane >> 3) + 8 * j; const LAS float* s = scr + (8 * c) * 33 + n;
        u32x4 o; o.x = cvt_pk_bf16(s[0 * 33], s[1 * 33]); o.y = cvt_pk_bf16(s[2 * 33], s[3 * 33]); o.z = cvt_pk_bf16(s[4 * 33], s[5 * 33]); o.w = cvt_pk_bf16(s[6 * 33], s[7 * 33]);
        *(GAS u32x4*)(WT + (size_t)n * ldk + 8 * c) = o; }
    LDS_WAIT();
}
__device__ __forceinline__ void tr_item8(const float* W, size_t ldw, unsigned char* WT, size_t ldk, LAS float* scr, int lane) {
    const int kr = lane >> 3, c4 = (lane & 7) * 4;
    f32x4 v[2][8];
#pragma unroll
    for (int hh = 0; hh < 2; ++hh)
#pragma unroll
        for (int i = 0; i < 8; ++i) v[hh][i] = __builtin_nontemporal_load((const GAS f32x4*)(W + (size_t)(8 * i + kr) * ldw + 32 * hh + c4));
#pragma unroll
    for (int hh = 0; hh < 2; ++hh) {
#pragma unroll
        for (int i = 0; i < 8; ++i) { LAS float* s = scr + (8 * i + kr) * 33 + c4; s[0] = v[hh][i].x; s[1] = v[hh][i].y; s[2] = v[hh][i].z; s[3] = v[hh][i].w; }
        LDS_WAIT();
        const int c = lane & 3;
#pragma unroll
        for (int j = 0; j < 2; ++j) { const int n = (lane >> 2) + 16 * j; const LAS float* s = scr + (16 * c) * 33 + n;
            u32x4 o;
            o.x = cvt_pk4_fp8(s[0 * 33] * W8_SCALE, s[1 * 33] * W8_SCALE, s[2 * 33] * W8_SCALE, s[3 * 33] * W8_SCALE); o.y = cvt_pk4_fp8(s[4 * 33] * W8_SCALE, s[5 * 33] * W8_SCALE, s[6 * 33] * W8_SCALE, s[7 * 33] * W8_SCALE);
            o.z = cvt_pk4_fp8(s[8 * 33] * W8_SCALE, s[9 * 33] * W8_SCALE, s[10 * 33] * W8_SCALE, s[11 * 33] * W8_SCALE); o.w = cvt_pk4_fp8(s[12 * 33] * W8_SCALE, s[13 * 33] * W8_SCALE, s[14 * 33] * W8_SCALE, s[15 * 33] * W8_SCALE);
            *(GAS u32x4*)(WT + (size_t)(32 * hh + n) * ldk + 16 * c) = o; }
        LDS_WAIT();
    }
}
constexpr int I_IN = (DM / 64) * (NZ / 32), I_OUT = (DM / 64) * (DM / 32), I_GU = (DM / 64) * (DEX / 32), I_D = (DEX / 64) * (DM / 32);
constexpr int GV_FIRST = 43;
constexpr int BGI_SMALL = (NLAYER * 4 * 8) / 8, BGI_IN = I_IN / 16, BGI_GV0 = (128 - GV_FIRST) * 4, BGI_GV1 = 128 * 4, BGI_OUT = I_OUT / 16, BGI_GU = NEXP * 2 * I_GU / 16, BGI_D = NEXP * I_D / 16;
constexpr int BG_C0 = BGI_SMALL + BGI_IN;
constexpr int BG_C1 = BG_C0 + BGI_GV0 + BGI_OUT;
constexpr int BG_C2 = BG_C1 + BGI_GU;
constexpr int BG_C3 = BG_C2 + BGI_D;
constexpr int BG_C3B = BG_C3 + BGI_GV1;
constexpr int BG_C4 = BG_C3B + BGI_IN;
constexpr int BG_C5 = BG_C4 + BGI_OUT;
constexpr int BG_C6 = BG_C5 + BGI_GU;
constexpr int BG_C7 = BG_C6 + BGI_D;
__device__ __forceinline__ float mod_at(const unsigned char* ws, const float* b_ada, int l, int j) {
    const float* p = (const float*)(ws + WS_MODP) + (size_t)l * 6 * DM + j;
    return *(const GAS float*)(b_ada + (size_t)l * 6 * DM + j) + ((*(const GAS float*)p + *(const GAS float*)(p + 2 * 6 * DM)) + (*(const GAS float*)(p + 4 * 6 * DM) + *(const GAS float*)(p + 6 * 6 * DM)));
}
__device__ __forceinline__ void mod_ld(const unsigned char* ws, const float* b_ada, int l, int j, float (&r)[5]) {
    const float* p = (const float*)(ws + WS_MODP) + (size_t)l * 6 * DM + j;
    r[0] = *(const GAS float*)(b_ada + (size_t)l * 6 * DM + j); r[1] = *(const GAS float*)p; r[2] = *(const GAS float*)(p + 2 * 6 * DM); r[3] = *(const GAS float*)(p + 4 * 6 * DM); r[4] = *(const GAS float*)(p + 6 * 6 * DM);
}
__device__ __forceinline__ float mod_sum(const float (&r)[5]) { return r[0] + ((r[1] + r[2]) + (r[3] + r[4])); }
__device__ __forceinline__ void gemv_item(const Frame& F, unsigned char* ws, int w) {
    LAS float* sc = (LAS float*)F.lds; LAS f32x4* red = (LAS f32x4*)(F.lds + 8192);
    const int kq = w & 3, l = w >> 9, cb = (w >> 2) & 127, c4 = F.tid % 24, kg = F.tid / 24;
    if (F.tid < 512) sc[F.tid] = silu_f(*(const GAS float*)(karg(1) + kq * 512 + F.tid));
    __syncthreads();
    f32x4 acc = (f32x4){0.f, 0.f, 0.f, 0.f};
    if (kg < 21) {
        const float* wp = karg(2) + (size_t)l * DM * 6 * DM + (size_t)(kq * 512) * 6 * DM + cb * 96 + c4 * 4;
#pragma unroll
        for (int b0 = 0; b0 < 24; b0 += 8) { f32x4 wq[8];
#pragma unroll
            for (int it = 0; it < 8; ++it) wq[it] = __builtin_nontemporal_load((const GAS f32x4*)(wp + (size_t)(kg + 21 * (b0 + it)) * 6 * DM));
#pragma unroll
            for (int it = 0; it < 8; ++it) acc += wq[it] * sc[kg + 21 * (b0 + it)]; }
        if (kg < 8) { const f32x4 wv = __builtin_nontemporal_load((const GAS f32x4*)(wp + (size_t)(kg + 504) * 6 * DM)); acc += wv * sc[kg + 504]; }
        red[kg * 24 + c4] = acc;
    }
    __syncthreads();
    if (F.tid < 24) { f32x4 s = red[F.tid];
        for (int g = 1; g < 21; ++g) s += red[g * 24 + F.tid];
        *(GAS f32x4*)((float*)(ws + WS_MODP) + (size_t)kq * 2 * 6 * DM + (size_t)l * 6 * DM + cb * 96 + F.tid * 4) = s; }
    __syncthreads();
}
__device__ __forceinline__ void conv_wave_item(const Frame& F, unsigned char* ws, int r, int l, LAS float* scr) {
    if (r < I_IN) { const int kb = r / (NZ / 32), nb = r % (NZ / 32);
        tr_item8(karg(6) + (size_t)l * DM * NIN + (size_t)(64 * kb) * NIN + 32 * nb, NIN, ws + WS_WIN + (size_t)l * NZ * DM + (size_t)(32 * nb) * DM + 64 * kb, DM, scr, F.lane); return; }
    r -= I_IN;
    if (r < I_OUT) { const int kb = r / (DM / 32), nb = r % (DM / 32);
        tr_item8(karg(15) + (size_t)l * DM * DM + (size_t)(64 * kb) * DM + 32 * nb, DM, ws + WS_WOUT + (size_t)l * DM * DM + (size_t)(32 * nb) * DM + 64 * kb, DM, scr, F.lane); return; }
    r -= I_OUT;
    if (r < NEXP * 2 * I_GU) { const int e = r / (2 * I_GU); r -= e * 2 * I_GU; const int up = r >= I_GU; if (up) r -= I_GU; const int kb = r / (DEX / 32), nb = r % (DEX / 32), n0 = 32 * nb;
        const float* src = (up ? karg(19) : karg(18)) + ((size_t)l * NEXP + e) * DM * DEX + (size_t)(64 * kb) * DEX + n0;
        const int drow = (n0 >> 7) * 256 + (up ? 128 : 0) + (n0 & 127);
        tr_item8(src, DEX, ws + WS_WGU + ((size_t)l * NEXP + e) * DM * DM + (size_t)drow * DM + 64 * kb, DM, scr, F.lane); return; }
    r -= NEXP * 2 * I_GU;
    { const int e = r / I_D; r -= e * I_D; const int kb = r / (DM / 32), nb = r % (DM / 32);
      tr_item8(karg(20) + ((size_t)l * NEXP + e) * DEX * DM + (size_t)(64 * kb) * DM + 32 * nb, DM, ws + WS_WD + ((size_t)l * NEXP + e) * DM * DEX + (size_t)(32 * nb) * DEX + 64 * kb, DEX, scr, F.lane); }
}
__device__ __forceinline__ void bg_item(const Frame& F, unsigned char* ws, int t) {
    LAS float* scr = (LAS float*)(F.lds + 16384 + F.wave * 9216);
    if (t < BGI_SMALL) { const int r = t * 8 + F.wave, mat = r >> 3, q = r & 7, kb = q >> 2, nb = q & 3;
        tr_item(karg(10) + (size_t)mat * 128 * 128 + (size_t)(64 * kb) * 128 + 32 * nb, 128, (bf16*)(ws + WS_BWT) + (size_t)mat * 128 * 128 + (size_t)(32 * nb) * 128 + 64 * kb, 128, scr, F.lane); return; }
    t -= BGI_SMALL;
    if (t < BGI_IN) { conv_wave_item(F, ws, (t * 8 + F.wave) * 2, 0, scr); return; }
    t -= BGI_IN;
    if (t < BGI_GV0) { gemv_item(F, ws, GV_FIRST * 4 + t); return; }
    t -= BGI_GV0;
    if (t < BGI_OUT) { conv_wave_item(F, ws, I_IN + (t * 8 + F.wave) * 2, 0, scr); return; }
    t -= BGI_OUT;
    if (t < BGI_GU + BGI_D) { conv_wave_item(F, ws, I_IN + I_OUT + (t * 8 + F.wave) * 2, 0, scr); return; }
    t -= BGI_GU + BGI_D;
    if (t < BGI_GV1) { gemv_item(F, ws, 512 + t); return; }
    t -= BGI_GV1;
    if (t < BGI_IN) { conv_wave_item(F, ws, (t * 8 + F.wave) * 2, 1, scr); return; }
    t -= BGI_IN;
    if (t < BGI_OUT) { conv_wave_item(F, ws, I_IN + (t * 8 + F.wave) * 2, 1, scr); return; }
    t -= BGI_OUT;
    conv_wave_item(F, ws, I_IN + I_OUT + (t * 8 + F.wave) * 2, 1, scr);
}
__device__ __forceinline__ void bg_fill(const Frame& F0, int seam, int need, int expect, bool self) {
    unsigned char* const ws = opq(F0.ws); Frame F = F0; F.tid = opq_tid(F0.wave); F.lane = F.tid & 63; F.lds = opq(F0.lds);
    LAS unsigned* slot = (LAS unsigned*)(F.lds + AUX_OFF + 24576);
    gu32* const ctl_ = opq(F0.ctl); gu32* ticket = ctl_ + CW_BGT; gu32* arr = ctl_ + CW_ARR + 64 * seam;
    unsigned tn = 0xffffffffu; bool pre = false;
    if (F.tid == 0) { const unsigned kept = slot[3];
        if (kept != 0u) { slot[3] = 0u; tn = kept - 1u; if (self) (void)__hip_atomic_fetch_add(arr, 1u, RLX_AGENT); }
        else if (slot[1] == 0u) {
            const unsigned a0 = self ? __hip_atomic_fetch_add(arr, 1u, RLX_AGENT) + 1u : __hip_atomic_load(arr, RLX_AGENT); const unsigned cur = __hip_atomic_load(ticket, RLX_AGENT);
            if (cur >= (unsigned)BG_C7) slot[1] = 1u;
            else if (cur < (unsigned)need || a0 < (unsigned)expect) tn = __hip_atomic_fetch_add(ticket, 1u, RLX_AGENT); } }
    for (;;) {
        if (F.tid == 0) slot[0] = tn;
        __syncthreads();
        const unsigned t = __builtin_amdgcn_readfirstlane(slot[0]);
        __syncthreads();
        if (t >= (unsigned)BG_C7) { if (F.tid == 0 && t != 0xffffffffu) slot[1] = 1u; break; }
        if (F.tid == 0) { tn = 0xffffffffu; pre = (t + 2u < (unsigned)need);
            if (pre) tn = __hip_atomic_fetch_add(ticket, 1u, RLX_AGENT); }
        bg_item(F, ws, (int)t);
        if (F.tid == 0 && !pre) {
            if (t + 1u < (unsigned)need) tn = __hip_atomic_fetch_add(ticket, 1u, RLX_AGENT);
            else { const unsigned tc = __hip_atomic_fetch_add(ticket, 1u, RLX_AGENT), a = __hip_atomic_load(arr, RLX_AGENT);
                if (a < (unsigned)expect || tc < (unsigned)need) tn = tc;
                else if (tc < (unsigned)BG_C7) slot[3] = tc + 1u;
                else slot[1] = 1u; } }
    }
}
__device__ __forceinline__ void p0_prologue(const Frame& F0) {
    unsigned char* const ws = opq(F0.ws); Frame F = F0; F.tid = opq_tid(F0.wave); F.lane = F.tid & 63; F.lds = opq(F0.lds);
    for (int w = F.vcu; w < GV_FIRST * 4; w += F.G) gemv_item(F, ws, w);
    const float* const a_ws_ = karg(7);
    for (int i = (F.vcu * NTHR + F.tid) * 2; i < NLAYER * 4 * 128 * 128; i += F.G * NTHR * 2) {
        const int t = (i >> 7) & 127, s = i & 127;
        const f32x2 w = *(const GAS f32x2*)(a_ws_ + i);
        const bool keep = (s >> 6) <= (t >> 6);
        *(GAS unsigned*)((bf16*)(ws + WS_WM) + i) = keep ? cvt_pk_bf16(w.x, w.y) : 0u;
    }
}

template <int MODE>
__device__ __forceinline__ void phase_norm1(const Frame& F0, int l, const void* xin, void* xout, int lprev) {
    unsigned char* const ws = opq(F0.ws); Frame F = F0; F.tid = opq_tid(F0.wave); F.lane = F.tid & 63; F.lds = opq(F0.lds);
    LAS float* wfT = (LAS float*)F.lds;
    LAS float* gaL = (LAS float*)(F.lds + 65536);
    LAS float* gbL = (LAS float*)(F.lds + 73728);
    LAS float* g2L = (LAS float*)(F.lds + 81920);
    LAS float* lf = (LAS float*)(F.lds + 90112);
    LAS int* hb = (LAS int*)(F.lds + 91136);
    const float* const b_ada_ = karg(3); const float* const c_bf_ = karg(14);
    if (MODE != 2) {
        const float* const w_in_ = karg(6); const float* const g_mix_ = karg(4);
        f32x4 wq[8]; float gm_[4], ms_[4][5], mh_[4][5];
#pragma unroll
        for (int it = 0; it < 8; ++it) { const int i = F.tid + it * NTHR, d = i >> 1, half = i & 1; wq[it] = *(const GAS f32x4*)(w_in_ + (size_t)l * DM * NIN + (size_t)d * NIN + NZ + half * 4); }
#pragma unroll
        for (int it = 0; it < 4; ++it) { const int d = F.tid + it * NTHR; gm_[it] = *(const GAS float*)(g_mix_ + (size_t)l * DM + d); mod_ld(ws, b_ada_, l, DM + d, ms_[it]); mod_ld(ws, b_ada_, l, d, mh_[it]); }
#pragma unroll
        for (int it = 0; it < 8; ++it) { const int i = F.tid + it * NTHR, d = i >> 1, half = i & 1; const f32x4 w = wq[it];
            wfT[(half * 4 + 0) * DM + d] = w.x; wfT[(half * 4 + 1) * DM + d] = w.y; wfT[(half * 4 + 2) * DM + d] = w.z; wfT[(half * 4 + 3) * DM + d] = w.w; }
#pragma unroll
        for (int it = 0; it < 4; ++it) { const int d = F.tid + it * NTHR; gaL[d] = gm_[it] * (1.f + mod_sum(ms_[it])); gbL[d] = mod_sum(mh_[it]); }
    }
    if (MODE != 0) {
        { float m2_[4][5];
#pragma unroll
          for (int it = 0; it < 4; ++it) mod_ld(ws, b_ada_, lprev, 5 * DM + F.tid + it * NTHR, m2_[it]);
#pragma unroll
          for (int it = 0; it < 4; ++it) g2L[F.tid + it * NTHR] = mod_sum(m2_[it]); }
        if (F.tid < NEXP) hb[16 + F.tid] = ((int)__hip_atomic_load(F.ctl + CW_CNT + 64 * lprev + F.tid, RLX_AGENT) + 255) & ~255;
        __syncthreads();
        if (F.tid == 0) { int a = 0; for (int e = 0; e < NEXP; ++e) { hb[e] = a; a += hb[16 + e]; } }
    }
    __syncthreads();
    const bf16* YB = (const bf16*)(ws + WS_YB);
    f32x4 vA[8], vB[8]; u32x2 xA[8], xB[8], yA0[8], yA1[8], yB0[8], yB1[8];
#define N1_LOAD(V, XR, Y0, Y1, rr) do { const int t_ = c * 32 + F.wave * 4 + (rr);                                                             \
        if (MODE == 0) { _Pragma("unroll") for (int j = 0; j < 8; ++j) V[j] = *(const GAS f32x4*)((const float*)xin + (size_t)t_ * DM + 256 * j + 4 * F.lane); }   \
        else { _Pragma("unroll") for (int j = 0; j < 8; ++j) XR[j] = *(const GAS u32x2*)((const bf16*)xin + (size_t)t_ * DM + 256 * j + 4 * F.lane); }              \
        if (MODE != 0) { const int r0_ = __builtin_amdgcn_readlane(rowA, (rr)), r1_ = __builtin_amdgcn_readlane(rowB, (rr));                      \
            _Pragma("unroll") for (int j = 0; j < 8; ++j) { const int d = 256 * j + 4 * F.lane;                                                    \
                Y0[j] = *(const GAS u32x2*)(YB + (size_t)r0_ * DM + d); Y1[j] = *(const GAS u32x2*)(YB + (size_t)r1_ * DM + d); } } } while (0)
#define N1_PROC(V, XR, Y0, Y1, rr) do { const int rl = F.wave * 4 + (rr), t = c * 32 + rl;                                                      \
        if (MODE != 0) { _Pragma("unroll") for (int j = 0; j < 8; ++j) { V[j].x = bf_lo(XR[j].x); V[j].y = bf_hi(XR[j].x); V[j].z = bf_lo(XR[j].y); V[j].w = bf_hi(XR[j].y); } }   \
        if (MODE != 0) { const float w0 = __builtin_bit_cast(float, __builtin_amdgcn_readlane(__builtin_bit_cast(int, gwA), (rr))), w1 = __builtin_bit_cast(float, __builtin_amdgcn_readlane(__builtin_bit_cast(int, gwB), (rr))); \
            _Pragma("unroll") for (int j = 0; j < 8; ++j) { const int d = 256 * j + 4 * F.lane;                                                    \
                const f32x4 g2 = *(const LAS f32x4*)(g2L + d); const u32x2 y0 = Y0[j], y1 = Y1[j];                                                 \
                f32x4 y; y.x = w0 * bf_lo(y0.x) + w1 * bf_lo(y1.x); y.y = w0 * bf_hi(y0.x) + w1 * bf_hi(y1.x); y.z = w0 * bf_lo(y0.y) + w1 * bf_lo(y1.y); y.w = w0 * bf_hi(y0.y) + w1 * bf_hi(y1.y); \
                V[j] = V[j] + g2 * y;                                                                                                               \
                if (MODE == 2) *(GAS f32x4*)((float*)xout + (size_t)t * DM + d) = V[j];                                                            \
                else { u32x2 o_; o_.x = cvt_pk_bf16(V[j].x, V[j].y); o_.y = cvt_pk_bf16(V[j].z, V[j].w); *(GAS u32x2*)((bf16*)xout + (size_t)t * DM + d) = o_; } } }   \
        if (MODE != 2) {                                                                                                                           \
            float ss = 0.f;                                                                                                                        \
            _Pragma("unroll") for (int j = 0; j < 8; ++j) ss += (V[j].x * V[j].x + V[j].y * V[j].y) + (V[j].z * V[j].z + V[j].w * V[j].w);         \
            const float rs = rsqrtf(wave_sum(ss) * (1.f / DM) + EPSN);                                                                             \
            float fz[8] = {0.f, 0.f, 0.f, 0.f, 0.f, 0.f, 0.f, 0.f};                                                                                \
            unsigned char* hrow = ws + WS_H + (size_t)t * DM;                                   \
            _Pragma("unroll") for (int j = 0; j < 8; ++j) { const int d = 256 * j + 4 * F.lane;                                                    \
                const f32x4 h = V[j] * rs * *(const LAS f32x4*)(gaL + d) + *(const LAS f32x4*)(gbL + d);                                           \
                *(GAS unsigned*)(hrow + d) = cvt_pk4_fp8(h.x * H8_SCALE, h.y * H8_SCALE, h.z * H8_SCALE, h.w * H8_SCALE);                          \
                _Pragma("unroll") for (int q = 0; q < 8; ++q) { const f32x4 w = *(const LAS f32x4*)(wfT + q * DM + d); fz[q] += (h.x * w.x + h.y * w.y) + (h.z * w.z + h.w * w.w); } } \
            _Pragma("unroll") for (int q = 0; q < 8; ++q) fz[q] = wave_sum(fz[q]);                                                                 \
            if (F.lane < 8) { float z = fz[0];                                                                                                     \
                _Pragma("unroll") for (int q = 1; q < 8; ++q) z = (F.lane == q) ? fz[q] : z;                                                       \
                z += *(const GAS float*)(c_bf_ + l * 8 + F.lane);                                                                                  \
                lf[rl * 8 + F.lane] = fminf(z, 0.f) - 0.6931471805599453f * __builtin_amdgcn_logf(1.f + __builtin_amdgcn_exp2f(-LOG2E * fabsf(z))); } } } while (0)
    for (int c = F.vcu; c < SEQ / 32; c += F.G) {
        int rowA = 0, rowB = 0; float gwA = 0.f, gwB = 0.f;
        if (MODE != 0) { const int t_ = c * 32 + F.wave * 4 + (F.lane & 3);
            const int* te = (const int*)(ws + WS_TOKE) + 2 * t_; const int* tp = (const int*)(ws + WS_TOKP) + 2 * t_; const float* tw = (const float*)(ws + WS_TOKW) + 2 * t_;
            rowA = hb[*(const GAS int*)te] + *(const GAS int*)tp; rowB = hb[*(const GAS int*)(te + 1)] + *(const GAS int*)(tp + 1); gwA = *(const GAS float*)tw; gwB = *(const GAS float*)(tw + 1); }
        N1_LOAD(vA, xA, yA0, yA1, 0); N1_LOAD(vB, xB, yB0, yB1, 1);
        N1_PROC(vA, xA, yA0, yA1, 0); N1_LOAD(vA, xA, yA0, yA1, 2);
        N1_PROC(vB, xB, yB0, yB1, 1); N1_LOAD(vB, xB, yB0, yB1, 3);
        N1_PROC(vA, xA, yA0, yA1, 2); N1_PROC(vB, xB, yB0, yB1, 3);
        if (MODE != 2) {
            __syncthreads();
            if (F.tid < 8) { float a = 0.f; float* floc = (float*)(ws + WS_FLOC);
                for (int r = 0; r < 32; ++r) { a += lf[r * 8 + F.tid]; *(GAS float*)(floc + (size_t)(c * 32 + r) * 8 + F.tid) = a; }
                *(GAS float*)((float*)(ws + WS_TOT) + c * 8 + F.tid) = a; }
            __syncthreads();
        }
    }
#undef N1_LOAD
#undef N1_PROC
}

__device__ __forceinline__ void fkl_fixup(const Frame& F0) {
    unsigned char* const ws = opq(F0.ws); Frame F = F0; F.tid = opq_tid(F0.wave); F.lane = F.tid & 63; F.lds = opq(F0.lds);
    LAS float* preL = (LAS float*)(F.lds + AUX_OFF + 8192);
    const float* tot = (const float*)(ws + WS_TOT);
    for (int c = F.vcu; c < SEQ / 32; c += F.G) {
        { const int h = F.wave; double s = 0.0;
#pragma unroll
            for (int q = 0; q < 4; ++q) { const int cc = 4 * F.lane + q; if (cc < c) s += (double)*(const GAS float*)(tot + cc * 8 + h); }
            float hi_ = (float)s, lo_ = (float)(s - (double)hi_);
            hi_ = wave_sum(hi_); lo_ = wave_sum(lo_);
            if (F.lane == 0) preL[h] = hi_ + lo_; }
        __syncthreads();
        if (F.tid < 256) { const int r = F.tid >> 3, h = F.tid & 7, t = c * 32 + r;
            *(GAS float*)((float*)(ws + WS_FKL) + (size_t)h * SEQ + t) = (preL[h] + *(const GAS float*)((const float*)(ws + WS_FLOC) + (size_t)t * 8 + h)) * -11.313708498984761f; }
        __syncthreads();
    }
}

__device__ __forceinline__ void phase_small_item(const Frame& F0, int l, int item) {
    unsigned char* const ws = opq(F0.ws); Frame F = F0; F.tid = opq_tid(F0.wave); F.lane = F.tid & 63; F.lds = opq(F0.lds);
    const int fr = F.lane & 15, fq = F.lane >> 4, w = F.wave;
    const bf16* Z = (const bf16*)(ws + WS_Z); unsigned char* YC = ws + WS_YCAT;
    f32x4 acc[8];
#pragma unroll
    for (int m = 0; m < 8; ++m) acc[m] = (f32x4){0.f, 0.f, 0.f, 0.f};
    const float* a_bs_ = opq(karg(8)); const float* b_scale_ = opq(karg(11));
    if (item < 256) {
        const int blk = item >> 2, h = item & 3;
        const bf16* VN = (const bf16*)(ws + WS_VN) + (size_t)(blk * 128) * 512 + h * 128 + 16 * w + fr;
        const bf16* WM = (const bf16*)(ws + WS_WM) + ((size_t)(l * 4 + h) * 128) * 128;
        bf16x8 yb[4]; u32x2 ue[8]; float bse[8];
#pragma unroll
        for (int m = 0; m < 8; ++m) { const int tl = 16 * m + fr; bse[m] = *(const GAS float*)(a_bs_ + l * 512 + h * 128 + tl); ue[m] = *(const GAS u32x2*)(Z + (size_t)(blk * 128 + tl) * NZ + h * 128 + 16 * w + 4 * fq); }
#pragma unroll
        for (int ks = 0; ks < 4; ++ks)
#pragma unroll
            for (int j = 0; j < 8; ++j) yb[ks][j] = (short)*(const GAS bf16*)(VN + (size_t)(ks * 32 + 8 * fq + j) * 512);
#pragma unroll
        for (int m = 0; m < 8; ++m)
#pragma unroll
            for (int ks = 0; ks < 4; ++ks) { const bf16x8 xa = *(const GAS bf16x8*)(WM + (size_t)(16 * m + fr) * 128 + ks * 32 + 8 * fq);
                acc[m] = __builtin_amdgcn_mfma_f32_16x16x32_bf16(yb[ks], xa, acc[m], 0, 0, 0); }
#pragma unroll
        for (int m = 0; m < 8; ++m) { const int tl = 16 * m + fr, t = blk * 128 + tl, col = h * 128 + 16 * w + 4 * fq;
            const float bsv = bse[m]; const u32x2 u = ue[m];
            *(GAS unsigned*)(YC + (size_t)t * DM + col) = cvt_pk4_fp8(H8_SCALE * bf_lo(u.x) * (acc[m][0] + bsv), H8_SCALE * bf_hi(u.x) * (acc[m][1] + bsv), H8_SCALE * bf_lo(u.y) * (acc[m][2] + bsv), H8_SCALE * bf_hi(u.y) * (acc[m][3] + bsv)); }
    } else {
        const int rb = (item - 256) >> 2, g = (item - 256) & 3;
        const int wnd = 2 << g, r0 = rb * 128;
        LAS bf16* pt = (LAS bf16*)(F.lds + 86016);
        LAS bf16* dt = (LAS bf16*)F.lds;
        const bf16* BWT = (const bf16*)(ws + WS_BWT) + ((size_t)(l * 4 + g) * 128) * 128;
        bf16x8 yb[4];
#pragma unroll
        for (int ks = 0; ks < 4; ++ks) yb[ks] = *(const GAS bf16x8*)(BWT + (size_t)(16 * w + fr) * 128 + ks * 32 + 8 * fq);
        const f32x4 bsc = *(const GAS f32x4*)(b_scale_ + l * 512 + g * 128 + 16 * w + 4 * fq);
        u32x4 pv[5];
#pragma unroll
        for (int it = 0; it < 5; ++it) { const int i = F.tid + it * NTHR, rr = i >> 4, cc = (i & 15) * 8, tg = r0 - 16 + rr;
            pv[it] = (u32x4){0u, 0u, 0u, 0u}; if (i < 144 * 16 && tg >= 0) pv[it] = *(const GAS u32x4*)(Z + (size_t)tg * NZ + 1024 + g * 128 + cc); }
        __syncthreads();
#pragma unroll
        for (int it = 0; it < 5; ++it) { const int i = F.tid + it * NTHR, rr = i >> 4, cc = (i & 15) * 8;
            if (i < 144 * 16) *(LAS u32x4*)(pt + rr * 128 + cc) = pv[it]; }
        __syncthreads();
        { const int c = F.tid & 127, rg = F.tid >> 7;
            float sum = 0.f;
            for (int j = 1; j < wnd; ++j) sum += bf_lo((unsigned)pt[(16 + 32 * rg - j) * 128 + c]);
            for (int i = 0; i < 32; ++i) { const int tl = 32 * rg + i, tg = r0 + tl; const float pv = bf_lo((unsigned)pt[(16 + tl) * 128 + c]);
                sum += pv;
                const float cnt = (float)((tg + 1 < wnd) ? (tg + 1) : wnd);
                const float dv = sum / cnt - pv;
                dt[tl * 136 + c] = (bf16)(cvt_pk_bf16(dv, 0.f) & 0xffffu);
                sum -= bf_lo((unsigned)pt[(16 + tl - (wnd - 1)) * 128 + c]); } }
        __syncthreads();
#pragma unroll
        for (int m = 0; m < 8; ++m)
#pragma unroll
            for (int ks = 0; ks < 4; ++ks) { const bf16x8 xa = *(const LAS bf16x8*)(dt + (16 * m + fr) * 136 + ks * 32 + 8 * fq);
                acc[m] = __builtin_amdgcn_mfma_f32_16x16x32_bf16(yb[ks], xa, acc[m], 0, 0, 0); }
        __syncthreads();
#pragma unroll
        for (int m = 0; m < 8; ++m) { const int t = rb * 128 + 16 * m + fr, col = 512 + g * 128 + 16 * w + 4 * fq;
            *(GAS unsigned*)(YC + (size_t)t * DM + col) = cvt_pk4_fp8(H8_SCALE * acc[m][0] * bsc.x, H8_SCALE * acc[m][1] * bsc.y, H8_SCALE * acc[m][2] * bsc.z, H8_SCALE * acc[m][3] * bsc.w); }
    }
}

__device__ __forceinline__ void phase_norm2_route(const Frame& F0, int l) {
    unsigned char* const ws = opq(F0.ws); Frame F = F0; F.tid = opq_tid(F0.wave); F.lane = F.tid & 63; F.lds = opq(F0.lds);
    LAS float* wrT = (LAS float*)F.lds;
    LAS float* gaL = (LAS float*)(F.lds + AUX_OFF);
    LAS float* gbL = (LAS float*)(F.lds + AUX_OFF + 8192);
    LAS int* lcnt = (LAS int*)(F.lds + AUX_OFF + 16384);
    const float* const w_router_ = karg(16); const float* const g_ffn_ = karg(5); const float* const b_ada_ = karg(3); const float* const b_router_ = karg(17);
    {
        f32x4 wq[16]; float gm_[4], ms_[4][5], mh_[4][5];
#pragma unroll
        for (int it = 0; it < 16; ++it) { const int i = F.tid + it * NTHR, d = i >> 2, q = i & 3; wq[it] = *(const GAS f32x4*)(w_router_ + (size_t)d * 16 + q * 4); }
#pragma unroll
        for (int it = 0; it < 4; ++it) { const int d = F.tid + it * NTHR; gm_[it] = *(const GAS float*)(g_ffn_ + (size_t)l * DM + d); mod_ld(ws, b_ada_, l, 4 * DM + d, ms_[it]); mod_ld(ws, b_ada_, l, 3 * DM + d, mh_[it]); }
#pragma unroll
        for (int it = 0; it < 16; ++it) { const int i = F.tid + it * NTHR, d = i >> 2, q = i & 3; const f32x4 w = wq[it];
            wrT[(q * 4 + 0) * DM + d] = w.x; wrT[(q * 4 + 1) * DM + d] = w.y; wrT[(q * 4 + 2) * DM + d] = w.z; wrT[(q * 4 + 3) * DM + d] = w.w; }
#pragma unroll
        for (int it = 0; it < 4; ++it) { const int d = F.tid + it * NTHR; gaL[d] = gm_[it] * (1.f + mod_sum(ms_[it])); gbL[d] = mod_sum(mh_[it]); }
    }
    const bf16* X1 = (const bf16*)(ws + WS_X1);
    float brt[16];
#pragma unroll
    for (int e = 0; e < 16; ++e) brt[e] = *(const GAS float*)(b_router_ + e);
    for (int c = F.vcu; c < SEQ / 32; c += F.G) {
        if (F.tid < 32) lcnt[F.tid] = 0;
        __syncthreads();
        int my_e0 = 0, my_e1 = 0, my_r0 = 0, my_r1 = 0; float my_w0 = 0.f, my_w1 = 0.f;
        f32x4 vA[8], vB[8]; u32x2 xA[8], xB[8];
#define N2_LOAD(V, rr) do { const int t_ = c * 32 + F.wave * 4 + (rr); _Pragma("unroll") for (int j = 0; j < 8; ++j) x##V[j] = *(const GAS u32x2*)(X1 + (size_t)t_ * DM + 256 * j + 4 * F.lane); } while (0)
#define N2_CVT(V) do { _Pragma("unroll") for (int j = 0; j < 8; ++j) { v##V[j].x = bf_lo(x##V[j].x); v##V[j].y = bf_hi(x##V[j].x); v##V[j].z = bf_lo(x##V[j].y); v##V[j].w = bf_hi(x##V[j].y); } } while (0)
#define N2_ROUTE(LG, rr) do {                                                                                                                      \
            float sc[16], sel[16];                                                                                                                 \
            _Pragma("unroll") for (int e = 0; e < 16; ++e) { sc[e] = __builtin_amdgcn_rcpf(1.f + __builtin_amdgcn_exp2f(-LOG2E * LG[e])); sel[e] = sc[e] + brt[e]; }                      \
            int bg = 0; float bgs = -INFINITY;                                                                                                     \
            _Pragma("unroll") for (int g = 0; g < 4; ++g) { float a = -INFINITY, b = -INFINITY;                                                    \
                _Pragma("unroll") for (int i = 0; i < 4; ++i) { const float x = sel[g * 4 + i]; if (x > a) { b = a; a = x; } else if (x > b) b = x; } \
                if (a + b > bgs) { bgs = a + b; bg = g; } }                                                                                        \
            int e0 = 0, e1 = 0; float a = -INFINITY, b = -INFINITY, s0 = 0.f, s1 = 0.f;                                                            \
            _Pragma("unroll") for (int g = 0; g < 4; ++g)                                                                                          \
                _Pragma("unroll") for (int i = 0; i < 4; ++i) { const int e = g * 4 + i; const float x = sel[e];                                   \
                    if (g == bg) { if (x > a) { b = a; e1 = e0; s1 = s0; a = x; e0 = e; s0 = sc[e]; } else if (x > b) { b = x; e1 = e; s1 = sc[e]; } } } \
            const float inv = 1.f / (s0 + s1);                                                                                                     \
            if (F.lane == (rr)) { my_e0 = e0; my_e1 = e1; my_w0 = s0 * inv; my_w1 = s1 * inv; } } while (0)
#define N2_PROC2(V, W, rr, NEXT_LOADS) do { const int t = c * 32 + F.wave * 4 + (rr);                                                                       \
            N2_CVT(A); N2_CVT(B);                                                                                                                  \
            float ss0 = 0.f, ss1 = 0.f;                                                                                                            \
            _Pragma("unroll") for (int j = 0; j < 8; ++j) { ss0 += (V[j].x * V[j].x + V[j].y * V[j].y) + (V[j].z * V[j].z + V[j].w * V[j].w); ss1 += (W[j].x * W[j].x + W[j].y * W[j].y) + (W[j].z * W[j].z + W[j].w * W[j].w); } \
            const float rs0 = rsqrtf(wave_sum(ss0) * (1.f / DM) + EPSN), rs1 = rsqrtf(wave_sum(ss1) * (1.f / DM) + EPSN);                           \
            float lg0[16], lg1[16];                                                                                                                \
            _Pragma("unroll") for (int e = 0; e < 16; ++e) { lg0[e] = 0.f; lg1[e] = 0.f; }                                                         \
            unsigned char* hrow = ws + WS_H + (size_t)t * DM;                          \
            _Pragma("unroll") for (int j = 0; j < 8; ++j) { const int d = 256 * j + 4 * F.lane;                                                    \
                const f32x4 ga_ = *(const LAS f32x4*)(gaL + d), gb_ = *(const LAS f32x4*)(gbL + d);                                                 \
                const f32x4 h0 = V[j] * rs0 * ga_ + gb_, h1 = W[j] * rs1 * ga_ + gb_;                                                              \
                *(GAS unsigned*)(hrow + d) = cvt_pk4_fp8(h0.x * H8_SCALE, h0.y * H8_SCALE, h0.z * H8_SCALE, h0.w * H8_SCALE);                      \
                *(GAS unsigned*)(hrow + DM + d) = cvt_pk4_fp8(h1.x * H8_SCALE, h1.y * H8_SCALE, h1.z * H8_SCALE, h1.w * H8_SCALE);                 \
                _Pragma("unroll") for (int e = 0; e < 16; ++e) { const f32x4 w = *(const LAS f32x4*)(wrT + e * DM + d);                            \
                    lg0[e] += (h0.x * w.x + h0.y * w.y) + (h0.z * w.z + h0.w * w.w); lg1[e] += (h1.x * w.x + h1.y * w.y) + (h1.z * w.z + h1.w * w.w); } } \
            NEXT_LOADS;                                                              \
            _Pragma("unroll") for (int e = 0; e < 16; ++e) { lg0[e] = wave_sum(lg0[e]); lg1[e] = wave_sum(lg1[e]); }                               \
            N2_ROUTE(lg0, (rr)); N2_ROUTE(lg1, (rr) + 1); } while (0)
        N2_LOAD(A, 0); N2_LOAD(B, 1);
        N2_PROC2(vA, vB, 0, N2_LOAD(A, 2); N2_LOAD(B, 3));
        N2_PROC2(vA, vB, 2, (void)0);
        if (F.lane < 4) { my_r0 = __hip_atomic_fetch_add(&lcnt[my_e0], 1, __ATOMIC_RELAXED, __HIP_MEMORY_SCOPE_WORKGROUP); my_r1 = __hip_atomic_fetch_add(&lcnt[my_e1], 1, __ATOMIC_RELAXED, __HIP_MEMORY_SCOPE_WORKGROUP); }
        __syncthreads();
        if (F.tid < 16) lcnt[16 + F.tid] = (int)__hip_atomic_fetch_add(F.ctl + CW_CNT + 64 * l + F.tid, (unsigned)lcnt[F.tid], RLX_AGENT);
        __syncthreads();
        if (F.lane < 4) { const int t = c * 32 + F.wave * 4 + F.lane;
            const int p0 = lcnt[16 + my_e0] + my_r0, p1 = lcnt[16 + my_e1] + my_r1;
            int* list = (int*)(ws + WS_LIST);
            *(GAS int*)(list + my_e0 * SEQ + p0) = t; *(GAS int*)(list + my_e1 * SEQ + p1) = t;
            *(GAS int*)((int*)(ws + WS_TOKE) + 2 * t) = my_e0; *(GAS int*)((int*)(ws + WS_TOKE) + 2 * t + 1) = my_e1;
            *(GAS int*)((int*)(ws + WS_TOKP) + 2 * t) = p0; *(GAS int*)((int*)(ws + WS_TOKP) + 2 * t + 1) = p1;
            *(GAS float*)((float*)(ws + WS_TOKW) + 2 * t) = my_w0; *(GAS float*)((float*)(ws + WS_TOKW) + 2 * t + 1) = my_w1; }
        __syncthreads();
    }
#undef N2_LOAD
#undef N2_CVT
#undef N2_PROC2
#undef N2_ROUTE
}

struct MoeOrder {
    int G, c, total, K, nct; const char* Bt; size_t estride; const int* list; LAS int* tab; LAS int* rows;
    __device__ __forceinline__ bool next(int i, gm::Unit& u) const {
        const int L = i * G + c; if (L >= total) return false;
        const int q = L / nct, ct = L - q * nct;
        int e = 0;
#pragma unroll
        for (int k = 1; k < NEXP; ++k) e += (q >= tab[k]) ? 1 : 0;
        e = __builtin_amdgcn_readfirstlane(e);
        const int rt = q - __builtin_amdgcn_readfirstlane(tab[e]);
        u.e = e; u.rt = i; u.arow = (__builtin_amdgcn_readfirstlane(tab[e]) + rt) * 256; u.orow = u.arow; u.ocol = ct * 256;
        u.Bp = Bt + (size_t)e * estride + (size_t)ct * 256 * K * 2; return true;
    }
    __device__ __forceinline__ int row_of(const gm::Unit& u, int r) const { return rows[u.rt * 256 + r]; }
    __device__ __forceinline__ void stage_rows(int tid) const {
        int v[4] = {0, 0, 0, 0};
#pragma unroll
        for (int i = 0; i < 4; ++i) { const int L = i * G + c;
            if (L < total && tid < 256) { const int q = L / nct; int e = 0;
#pragma unroll
                for (int k = 1; k < NEXP; ++k) e += (q >= tab[k]) ? 1 : 0;
                const int rt = q - tab[e], p = rt * 256 + tid, n = tab[32 + e], pc = p < n ? p : n - 1;
                const int w = *(const GAS int*)(list + e * SEQ + pc); v[i] = (p < n) ? w : 0; } }
        if (tid < 256) {
#pragma unroll
            for (int i = 0; i < 4; ++i) rows[i * 256 + tid] = v[i]; }
        __syncthreads();
    }
};
__device__ __forceinline__ void moe_table(const Frame& F, int l, LAS int* tab) {
    const int tid = opq_tid(F.wave);
    __syncthreads();
    if (tid < NEXP) tab[32 + tid] = (int)__hip_atomic_load(F.ctl + CW_CNT + 64 * l + tid, RLX_AGENT);
    __syncthreads();
    if (tid == 0) { int a = 0;
        for (int e = 0; e < NEXP; ++e) { tab[e] = a; a += (tab[32 + e] + 255) >> 8; }
        tab[16] = a; }
    __syncthreads();
}

constexpr int ATT_CH = 24;
struct MixTab { LAS int* jlo; LAS int* items; LAS int* nitems; LAS float* fend; LAS int* scan; };
__device__ __forceinline__ MixTab mix_tab_ptrs(LAS unsigned char* lds) {
    MixTab T; T.jlo = (LAS int*)(lds + 69632); T.items = (LAS int*)(lds + 69632 + 1024); T.nitems = (LAS int*)(lds + 69632 + 1024 + 8192); T.fend = (LAS float*)(lds + 69632 + 1024 + 8192 + 64);
    T.scan = (LAS int*)(lds + 69632 + 1024 + 8192 + 64 + 4096); return T;
}
__device__ __forceinline__ void mix_build_table(const Frame& F0, int l, const MixTab& T) {
    unsigned char* const ws = opq(F0.ws); const int tid = opq_tid(F0.wave);
    const float* FKL = (const float*)(ws + WS_FKL);
    for (int i = tid; i < 1024; i += NTHR) T.fend[i] = *(const GAS float*)(FKL + (size_t)(i >> 7) * SEQ + (i & 127) * 64 + 63);
    float gq = 0.f, gk = 0.f; const float* const c_qg_ = karg(12); const float* const c_kg_ = karg(13);
    { const int ln = tid & 63; gq = fmaxf(fabsf(*(const GAS float*)(c_qg_ + l * 128 + ln)), fabsf(*(const GAS float*)(c_qg_ + l * 128 + 64 + ln))); gk = fmaxf(fabsf(*(const GAS float*)(c_kg_ + l * 128 + ln)), fabsf(*(const GAS float*)(c_kg_ + l * 128 + 64 + ln)));
      gq = wave_max(gq); gk = wave_max(gk); }
    const float thr = (2.f * 1.01f * 11.313708498984761f * gq * gk + 22.f) * 11.313708498984761f;
    __syncthreads();
    int nfull = 0, nrem = 0, jl = 0, nt = 0;
    if (tid < 256) { const int h = tid >> 5, qb = tid & 31; const float f0 = *(const GAS float*)(FKL + (size_t)h * SEQ + qb * 256);
        for (int j = 0; j < 4 * qb; ++j) jl += (T.fend[h * 128 + j] - f0 <= -thr) ? 1 : 0;
        nt = 4 * (qb + 1) - jl; nfull = nt / ATT_CH; nrem = (nt % ATT_CH) ? 1 : 0; T.jlo[tid] = jl | ((nfull + nrem) << 8); }
    if (tid < 256) { T.scan[tid] = nfull; T.scan[256 + tid] = nrem; }
    __syncthreads();
    for (int o = 1; o < 256; o <<= 1) { int a = 0, b = 0; if (tid < 256 && tid >= o) { a = T.scan[tid - o]; b = T.scan[256 + tid - o]; } __syncthreads();
        if (tid < 256) { T.scan[tid] += a; T.scan[256 + tid] += b; } __syncthreads(); }
    if (tid < 256) { const int totf = T.scan[255], pf = T.scan[tid] - nfull, pr = totf + T.scan[256 + tid] - nrem, jb = 4 * ((tid & 31) + 1);
        for (int c = 0; c < nfull; ++c) T.items[pf + c] = tid | (c << 8) | ((jb - (c + 1) * ATT_CH) << 12) | (ATT_CH << 20);
        if (nrem) T.items[pr] = tid | (nfull << 8) | (jl << 12) | ((nt - nfull * ATT_CH) << 20);
        if (tid == 255) T.nitems[0] = totf + T.scan[511]; }
    __syncthreads();
}
__device__ __forceinline__ void attn_combine_block(const Frame& F0, const int b, const int nch) {
    unsigned char* const ws = opq(F0.ws); const int tid = opq_tid(F0.wave);
    const bf16* PART = (const bf16*)(ws + WS_PART); const float* MLb = (const float*)(ws + WS_ML); unsigned char* YC = ws + WS_YCAT;
    {
        const int h = b >> 5, qb = b & 31, row = tid >> 1, half = tid & 1;
        float m[8], w[8], mx = -3.0e38f, ws_ = 0.f;
#pragma unroll
        for (int c = 0; c < 8; ++c) { if (c < nch) { const f32x2 v = *(const GAS f32x2*)(MLb + ((size_t)(b * 8 + c) * 256 + row) * 2); m[c] = v.x; w[c] = v.y; mx = fmaxf(mx, v.x); } else { m[c] = -3.0e38f; w[c] = 0.f; } }
#pragma unroll
        for (int c = 0; c < 8; ++c) { w[c] = (c < nch) ? w[c] * __builtin_amdgcn_exp2f((m[c] - mx) * at::C2) : 0.f; ws_ += w[c]; }
        const float inv = 1.f / ws_;
        float acc[64];
#pragma unroll
        for (int i = 0; i < 64; ++i) acc[i] = 0.f;
#pragma unroll
        for (int c = 0; c < 8; ++c) { if (c < nch) { const bf16* p = PART + ((size_t)(b * 8 + c) * 256 + row) * 128 + half * 64; const float wc = w[c] * inv;
#pragma unroll
            for (int q = 0; q < 8; ++q) { const u32x4 v = *(const GAS u32x4*)(p + q * 8);
                acc[q * 8 + 0] += wc * bf_lo(v.x); acc[q * 8 + 1] += wc * bf_hi(v.x); acc[q * 8 + 2] += wc * bf_lo(v.y); acc[q * 8 + 3] += wc * bf_hi(v.y);
                acc[q * 8 + 4] += wc * bf_lo(v.z); acc[q * 8 + 5] += wc * bf_hi(v.z); acc[q * 8 + 6] += wc * bf_lo(v.w); acc[q * 8 + 7] += wc * bf_hi(v.w); } } }
        unsigned char* o = YC + (size_t)(qb * 256 + row) * DM + 1024 + h * 128 + half * 64;
#pragma unroll
        for (int q = 0; q < 4; ++q) { u32x4 v;
            v.x = cvt_pk4_fp8(H8_SCALE * acc[q * 16 + 0], H8_SCALE * acc[q * 16 + 1], H8_SCALE * acc[q * 16 + 2], H8_SCALE * acc[q * 16 + 3]); v.y = cvt_pk4_fp8(H8_SCALE * acc[q * 16 + 4], H8_SCALE * acc[q * 16 + 5], H8_SCALE * acc[q * 16 + 6], H8_SCALE * acc[q * 16 + 7]);
            v.z = cvt_pk4_fp8(H8_SCALE * acc[q * 16 + 8], H8_SCALE * acc[q * 16 + 9], H8_SCALE * acc[q * 16 + 10], H8_SCALE * acc[q * 16 + 11]); v.w = cvt_pk4_fp8(H8_SCALE * acc[q * 16 + 12], H8_SCALE * acc[q * 16 + 13], H8_SCALE * acc[q * 16 + 14], H8_SCALE * acc[q * 16 + 15]);
            *(GAS u32x4*)(o + q * 16) = v; }
    }
}

struct MoeDynOrder {
    int total, K; const char* Bt; size_t estride; LAS int* tab; gu32* ticket; gu32* ready; gu32* tmo; LAS unsigned* slot;
    __device__ __forceinline__ bool next(int, gm::Unit& u) const {
        if (__builtin_amdgcn_readfirstlane(threadIdx.x >> 6) == 0) {
            unsigned T = 0u;
            if ((threadIdx.x & 63) == 0) T = __hip_atomic_fetch_add(ticket, 1u, RLX_AGENT);
            T = __builtin_amdgcn_readfirstlane(T);
            if (T < (unsigned)total) {
                gu32* w = ready + 16 * (T >> 3); unsigned sp = 0u;
                while ((unsigned)__builtin_amdgcn_readfirstlane(__hip_atomic_load(w, RLX_AGENT)) < 64u) {
                    __builtin_amdgcn_s_sleep(2);
                    if ((++sp & 255u) == 0u) { if (__hip_atomic_load(tmo, RLX_AGENT) != 0u) break; if (sp > (1u << 20)) { __hip_atomic_store(tmo, 1u, RLX_AGENT); break; } } }
                __builtin_amdgcn_fence(__ATOMIC_ACQUIRE, "agent");
                asm volatile("s_waitcnt vmcnt(0)" ::: "memory");
            }
            if ((threadIdx.x & 63) == 0) slot[0] = T;
        }
        asm volatile("s_waitcnt lgkmcnt(0)" ::: "memory"); __builtin_amdgcn_s_barrier(); asm volatile("" ::: "memory");
        const unsigned T = (unsigned)__builtin_amdgcn_readfirstlane((int)slot[0]);
        if (T >= (unsigned)total) return false;
        const int q = (int)(T >> 3), ct = (int)(T & 7);
        int e = 0;
#pragma unroll
        for (int k = 1; k < NEXP; ++k) e += (q >= tab[k]) ? 1 : 0;
        e = __builtin_amdgcn_readfirstlane(e);
        u.e = e; u.rt = q - __builtin_amdgcn_readfirstlane(tab[e]); u.arow = q * 256; u.orow = u.arow; u.ocol = ct * 256;
        u.Bp = Bt + (size_t)e * estride + (size_t)ct * 256 * K * 2; return true;
    }
    __device__ __forceinline__ int row_of(const gm::Unit&, int) const { return 0; }
};
struct EpiZ {
    static constexpr bool PERM = true;
    unsigned char* wsb; int l; LAS float* Pt0;
    __device__ __forceinline__ void operator()(f32x4 (&acc)[2][2][4][2], const gm::Unit& u, int wr, int wc, int fr0, int fq0) const {
        int fr = fr0, fq = fq0; asm volatile("" : "+v"(fr), "+v"(fq));
        unsigned char* const ws = opq(wsb); LAS float* const Pt = opq(Pt0);
        bf16* const O = (bf16*)(ws + WS_Z); bf16* const QN = (bf16*)(ws + WS_QN); bf16* const KN = (bf16*)(ws + WS_KN); bf16* const VN = (bf16*)(ws + WS_VN);
        const int row0 = u.orow + wr * 64 + fr, col0 = u.ocol + wc * 32 + 8 * fq;
        const bool isv = (u.ocol >= 512 && u.ocol < 1024), isq = (u.ocol >= 1536 && u.ocol < 2560), isk = (u.ocol >= 2560 && u.ocol < 3584);
        if (u.ocol < 1024) {
#pragma unroll
            for (int ai = 0; ai < 2; ++ai)
#pragma unroll
                for (int bj = 0; bj < 2; ++bj)
#pragma unroll
                    for (int m = 0; m < 4; ++m)
#pragma unroll
                        for (int n = 0; n < 2; ++n)
#pragma unroll
                            for (int j = 0; j < 4; ++j) acc[ai][bj][m][n][j] = gelu_t(acc[ai][bj][m][n][j]);
        }
        if (isv || isq || isk) {
#pragma unroll
            for (int ai = 0; ai < 2; ++ai)
#pragma unroll
                for (int m = 0; m < 4; ++m)
#pragma unroll
                    for (int bj = 0; bj < 2; ++bj) { const f32x4 a = acc[ai][bj][m][0], b = acc[ai][bj][m][1];
                        float ss = (a[0] * a[0] + a[1] * a[1]) + (a[2] * a[2] + a[3] * a[3]) + (b[0] * b[0] + b[1] * b[1]) + (b[2] * b[2] + b[3] * b[3]);
                        ss += xor_f<16>(ss);
                        { auto rr = __builtin_amdgcn_permlane32_swap(__float_as_uint(ss), __float_as_uint(ss), false, false); ss = __uint_as_float(rr[0]) + __uint_as_float(rr[1]); }
                        if (fq == 0) Pt[((ai * 128 + wr * 64 + m * 16 + fr) * 2 + bj) * 4 + wc] = ss; }
            asm volatile("s_waitcnt lgkmcnt(0)" ::: "memory"); __builtin_amdgcn_s_barrier(); asm volatile("" ::: "memory");
            const float* gp = isv ? karg(9) + l * 512 + (u.ocol - 512) + wc * 32 + 8 * fq : karg(isq ? 12 : 13) + l * 128 + wc * 32 + 8 * fq;
#pragma unroll
            for (int bj = 0; bj < 2; ++bj) {
                const f32x4 g0 = *(const GAS f32x4*)(gp + (isv ? bj * 128 : 0)), g1 = *(const GAS f32x4*)(gp + (isv ? bj * 128 : 0) + 4);
#pragma unroll
                for (int ai = 0; ai < 2; ++ai)
#pragma unroll
                    for (int m = 0; m < 4; ++m) { const int rl = ai * 128 + wr * 64 + m * 16 + fr, row = u.orow + rl;
                        const f32x4 p4 = *(const LAS f32x4*)(Pt + (rl * 2 + bj) * 4);
                        const float rs = rsqrtf(((p4[0] + p4[1]) + (p4[2] + p4[3])) * (1.f / 128.f) + EPSN);
                        const f32x4 v0 = acc[ai][bj][m][0] * rs * g0, v1 = acc[ai][bj][m][1] * rs * g1;
                        u32x4 w; w.x = cvt_pk_bf16(v0[0], v0[1]); w.y = cvt_pk_bf16(v0[2], v0[3]); w.z = cvt_pk_bf16(v1[0], v1[1]); w.w = cvt_pk_bf16(v1[2], v1[3]);
                        bf16* dst;
                        if (isv) dst = VN + (size_t)row * 512 + (u.ocol - 512) + bj * 128 + wc * 32 + 8 * fq;
                        else { const int h = ((u.ocol - (isq ? 1536 : 2560)) >> 7) + bj; dst = (isq ? QN : KN) + ((size_t)h * SEQ + row) * 128 + wc * 32 + 8 * fq; }
                        *(GAS u32x4*)dst = w; } }
            return;
        }
#pragma unroll
        for (int ai = 0; ai < 2; ++ai)
#pragma unroll
            for (int m = 0; m < 4; ++m) { bf16* rowp = O + (size_t)(row0 + ai * 128 + m * 16) * NZ + col0;
#pragma unroll
                for (int bj = 0; bj < 2; ++bj) { const f32x4 v0 = acc[ai][bj][m][0], v1 = acc[ai][bj][m][1];
                    u32x4 w; w.x = cvt_pk_bf16(v0[0], v0[1]); w.y = cvt_pk_bf16(v0[2], v0[3]); w.z = cvt_pk_bf16(v1[0], v1[1]); w.w = cvt_pk_bf16(v1[2], v1[3]);
                    *(GAS u32x4*)(rowp + bj * 128) = w; } }
    }
};
template <bool XBF> struct EpiRes {
    static constexpr bool PERM = false;
    const void* xin; const LAS float* gate; bf16* out;
    __device__ __forceinline__ void operator()(const f32x4 (&acc)[2][2][4][2], const gm::Unit& u, int wr, int wc, int fr, int fq) const {
        const int row0 = u.orow + wr * 64 + fr, col0 = u.ocol + wc * 32 + 4 * fq;
        f32x4 gv[2][2];
#pragma unroll
        for (int bj = 0; bj < 2; ++bj)
#pragma unroll
            for (int n = 0; n < 2; ++n) gv[bj][n] = *(const LAS f32x4*)(gate + col0 + bj * 128 + n * 16);
#pragma unroll
        for (int ai = 0; ai < 2; ++ai) {
            f32x4 xf[XBF ? 1 : 4][2][2]; u32x2 xh[XBF ? 4 : 1][2][2];
#pragma unroll
            for (int m = 0; m < 4; ++m) { const size_t off = (size_t)(row0 + ai * 128 + m * 16) * DM + col0;
#pragma unroll
                for (int bj = 0; bj < 2; ++bj)
#pragma unroll
                    for (int n = 0; n < 2; ++n) {
                        if constexpr (XBF) xh[m][bj][n] = *(const GAS u32x2*)((const bf16*)xin + off + bj * 128 + n * 16);
                        else xf[m][bj][n] = *(const GAS f32x4*)((const float*)xin + off + bj * 128 + n * 16); } }
#pragma unroll
            for (int m = 0; m < 4; ++m) { const size_t off = (size_t)(row0 + ai * 128 + m * 16) * DM + col0;
#pragma unroll
                for (int bj = 0; bj < 2; ++bj)
#pragma unroll
                    for (int n = 0; n < 2; ++n) { f32x4 xv;
                        if constexpr (XBF) { const u32x2 xb = xh[m][bj][n]; xv.x = bf_lo(xb.x); xv.y = bf_hi(xb.x); xv.z = bf_lo(xb.y); xv.w = bf_hi(xb.y); }
                        else xv = xf[m][bj][n];
                        const f32x4 r = xv + gv[bj][n] * acc[ai][bj][m][n]; u32x2 o; o.x = cvt_pk_bf16(r.x, r.y); o.y = cvt_pk_bf16(r.z, r.w);
                        *(GAS u32x2*)(out + off + bj * 128 + n * 16) = o; } }
        }
    }
};
struct EpiHid {
    static constexpr bool PERM = true;
    bf16* O;
    __device__ __forceinline__ void operator()(const f32x4 (&acc)[2][2][4][2], const gm::Unit& u, int wr, int wc, int fr, int fq) const {
        const int row0 = u.orow + wr * 64 + fr, col0 = (u.ocol >> 1) + wc * 32 + 8 * fq;
#pragma unroll
        for (int ai = 0; ai < 2; ++ai)
#pragma unroll
            for (int m = 0; m < 4; ++m) { bf16* rowp = O + (size_t)(row0 + ai * 128 + m * 16) * DEX + col0;
                f32x4 h0, h1;
#pragma unroll
                for (int j = 0; j < 4; ++j) { h0[j] = silu_f(acc[ai][0][m][0][j]) * acc[ai][1][m][0][j]; h1[j] = silu_f(acc[ai][0][m][1][j]) * acc[ai][1][m][1][j]; }
                u32x4 w; w.x = cvt_pk_bf16(h0[0], h0[1]); w.y = cvt_pk_bf16(h0[2], h0[3]); w.z = cvt_pk_bf16(h1[0], h1[1]); w.w = cvt_pk_bf16(h1[2], h1[3]);
                *(GAS u32x4*)rowp = w; }
    }
};
struct EpiHidPub {
    static constexpr bool PERM = true;
    unsigned char* O; gu32* ready;
    __device__ __forceinline__ void operator()(const f32x4 (&acc)[2][2][4][2], const gm::Unit& u, int wr, int wc, int fr, int fq) const {
        const __amdgpu_buffer_rsrc_t rs = __builtin_amdgcn_make_buffer_rsrc(O, (short)0, (int)(HIDROWS * DEX), 0x00020000);
        const int row0 = u.orow + wr * 64 + fr, col0 = (u.ocol >> 1) + wc * 32 + 8 * fq;
#pragma unroll
        for (int ai = 0; ai < 2; ++ai)
#pragma unroll
            for (int m = 0; m < 4; ++m) { const int off = (row0 + ai * 128 + m * 16) * DEX + col0;
                f32x4 h0, h1;
#pragma unroll
                for (int j = 0; j < 4; ++j) { h0[j] = HID8_SCALE * silu_f(acc[ai][0][m][0][j]) * acc[ai][1][m][0][j]; h1[j] = HID8_SCALE * silu_f(acc[ai][0][m][1][j]) * acc[ai][1][m][1][j]; }
                u32x2 w; w.x = cvt_pk4_fp8(h0[0], h0[1], h0[2], h0[3]); w.y = cvt_pk4_fp8(h1[0], h1[1], h1[2], h1[3]);
                __builtin_amdgcn_raw_buffer_store_b64(w, rs, off, 0, 16); }
        asm volatile("s_waitcnt vmcnt(0)" ::: "memory");
        if (fr == 0 && fq == 0) (void)__hip_atomic_fetch_add(ready + 16 * (u.orow >> 8), 1u, RLX_AGENT);
    }
};
struct EpiYB {
    static constexpr bool PERM = true;
    bf16* O;
    __device__ __forceinline__ void operator()(const f32x4 (&acc)[2][2][4][2], const gm::Unit& u, int wr, int wc, int fr, int fq) const {
        const int row0 = u.orow + wr * 64 + fr, col0 = u.ocol + wc * 32 + 8 * fq;
#pragma unroll
        for (int ai = 0; ai < 2; ++ai)
#pragma unroll
            for (int m = 0; m < 4; ++m) { bf16* rowp = O + (size_t)(row0 + ai * 128 + m * 16) * DM + col0;
#pragma unroll
                for (int bj = 0; bj < 2; ++bj) { const f32x4 v0 = acc[ai][bj][m][0], v1 = acc[ai][bj][m][1];
                    u32x4 w; w.x = cvt_pk_bf16(v0[0], v0[1]); w.y = cvt_pk_bf16(v0[2], v0[3]); w.z = cvt_pk_bf16(v1[0], v1[1]); w.w = cvt_pk_bf16(v1[2], v1[3]);
                    *(GAS u32x4*)(rowp + bj * 128) = w; } }
    }
};

#ifdef MK_SELFTEST
#include "selftest.h"
#endif
__device__ __forceinline__ int bg_need(int p) {
    if (p <= 1) return 0;
    if (p <= 4) return BG_C0;
    if (p <= 7) return BG_C1;
    if (p == 8) return BG_C3;
    if (p <= 10) return BG_C3B;
    if (p <= 13) return BG_C4;
    if (p <= 16) return BG_C5;
    return BG_C7;
}
__device__ __forceinline__ bool bg_seam(int k) { if (k == 0) return true; const int j = (k - 1) % 9; return j != 2 && j != 5 && j != 8; }
struct Args { const float* in[21]; float* out; unsigned char* ws; int ph_lo, ph_hi; };
constexpr int N_PHASES = 1 + 9 * NLAYER + 1;

#ifdef MK_ONLY
#define IN(k) (((k) == 0 ? 0 : (((k) - 1) % 9) + 1) == MK_ONLY && lo <= (k) && (k) < hi)
#else
#define IN(k) (lo <= (k) && (k) < hi)
#endif
#ifndef MK_REPEAT
#define MK_REPEAT -1
#endif
#define REPS(kind) ((MK_REPEAT == (kind)) ? 2 : 1)
#define SEAM(k) do { if (IN(k)) { if (bg_seam(k)) bg_fill(F, (k), bg_need((k) + 1), F.G, true); if (IN((k) + 1)) xcd_barrier(bar); } } while (0)


#ifdef MK_TPROBE
#define TP_B(kind) do { if (MK_TPROBE == (kind) && blockIdx.x == 0 && threadIdx.x == 0) ((volatile LAS unsigned*)(F.lds + AUX_OFF + 24576 + 128))[0] = (unsigned)__builtin_amdgcn_s_memrealtime(); } while (0)
#define TP_E(kind) do { if (MK_TPROBE == (kind) && blockIdx.x == 0 && threadIdx.x == 0) { volatile LAS unsigned* tp_ = (volatile LAS unsigned*)(F.lds + AUX_OFF + 24576 + 128); tp_[1] += (unsigned)__builtin_amdgcn_s_memrealtime() - tp_[0]; } } while (0)
#else
#define TP_B(kind) do { } while (0)
#define TP_E(kind) do { } while (0)
#endif
template <int l> __device__ __forceinline__ void layer_body(const Frame& F, const XcdBarrier& bar, const int lo, const int hi) {
    constexpr int pb = 1 + 9 * l;

        TP_B(1);
        for (int rep_ = 0; rep_ < REPS(1); ++rep_) if (IN(pb)) { if (rep_) xcd_barrier(bar); unsigned char* const wsl = opq(F.ws); LAS unsigned char* const ldl = opq(F.lds); if (l == 0) phase_norm1<0>(F, l, karg(0), nullptr, 0); else phase_norm1<1>(F, l, (const void*)(wsl + WS_X1), (void*)(wsl + WS_X2), l - 1); }
        SEAM(pb);
        TP_E(1);
        TP_B(2);
        for (int rep_ = 0; rep_ < REPS(2); ++rep_) if (IN(pb + 1)) { if (rep_) xcd_barrier(bar); unsigned char* const wsl = opq(F.ws); LAS unsigned char* const ldl = opq(F.lds);
            const int Gg = (F.G == 256) ? (l == 0 ? 144 : 192) : F.G;
            gm::RegOrder S; S.init(SEQ, NZ, DM / 2, wsl + WS_WIN + (size_t)l * NZ * DM, Gg, (int)blockIdx.x);
            fkl_fixup(F);
            EpiZ E{wsl, l, (LAS float*)(ldl + AUX_OFF)};
            if ((int)blockIdx.x < Gg) gm::gemm_phase<EpiZ, gm::RegOrder, false, true, true, SC_H8, SC_W8>(ldl, (const char*)(wsl + WS_H), DM, S, E, F.wave); }
        SEAM(pb + 1);
        TP_E(2);
        TP_B(4);
        for (int rep_ = 0; rep_ < REPS(4); ++rep_) if (IN(pb + 3)) { if (rep_) xcd_barrier(bar); unsigned char* const wsl = opq(F.ws); LAS unsigned char* const ldl = opq(F.lds);
            const MixTab T = mix_tab_ptrs(ldl);
            TP_B(15); mix_build_table(F, l, T); TP_E(15);
#if defined(MK_TPROBE) && MK_TPROBE == 16
            if (blockIdx.x == 0 && threadIdx.x == 0) { unsigned tot_ = 0; for (int i_ = 0; i_ < 256; ++i_) { const int qb_ = i_ & 31; tot_ += 4 * (qb_ + 1) - (T.jlo[i_] & 255); }
                ((volatile LAS unsigned*)(F.lds + AUX_OFF + 24576 + 128))[1] += tot_; }
#endif
#if defined(MK_TPROBE) && (MK_TPROBE == 17 || MK_TPROBE == 18)
            const unsigned tpd0_ = (unsigned)__builtin_amdgcn_s_memrealtime();
#endif
            const int natt = __builtin_amdgcn_readfirstlane(T.nitems[0]), ntot = natt + 512;
            LAS int* qslot = T.nitems + 1;
            int it = F.vcu;
            while (it < ntot) {
                int pub = -1, pubn = 0;
                if (it >= natt) { TP_B(14); phase_small_item(F, l, it - natt); TP_E(14); }
                else {
                    const int rec = __builtin_amdgcn_readfirstlane(T.items[it]), b = rec & 255, c = (rec >> 8) & 15, ja = (rec >> 12) & 255, n = (rec >> 20) & 31, h = b >> 5, qb = b & 31;
                    const bool fin = (__builtin_amdgcn_readfirstlane(T.jlo[b]) >> 8) <= 1; unsigned char* const ws = opq(wsl);
                    at::BlockRef cur;
                    cur.Q = (const bf16*)(ws + WS_QN) + ((size_t)h * SEQ + qb * 256) * 128; cur.K = (const bf16*)(ws + WS_KN) + (size_t)h * SEQ * 128;
                    cur.V = (const bf16*)(ws + WS_Z) + 3584 + h * 128; cur.O = ws + WS_YCAT + (size_t)(qb * 256) * DM + 1024 + h * 128;
                    cur.FK = (const float*)(ws + WS_FKL) + (size_t)h * SEQ; cur.P0 = qb * 256;
                    TP_B(13); at::attn_block(cur, ja, n, fin, (bf16*)(ws + WS_PART) + (size_t)(b * 8 + c) * 256 * 128, (float*)(ws + WS_ML) + (size_t)(b * 8 + c) * 256 * 2, (char*)ldl, ldl, F.wave); TP_E(13);
                    if (!fin) { pub = b; pubn = __builtin_amdgcn_readfirstlane(T.jlo[b]) >> 8; }
                }
                if (opq_tid(F.wave) == 0) { qslot[0] = F.G + (int)__hip_atomic_fetch_add(F.ctl + CW_Q + 64 * l + 32 * rep_, 1u, RLX_AGENT);
                    qslot[1] = (pub >= 0) ? (int)__hip_atomic_fetch_add(F.ctl + CW_PC + 8192 * l + 4096 * rep_ + 16 * pub, 1u, RLX_AGENT) : -2; }
                __syncthreads();
                it = __builtin_amdgcn_readfirstlane(qslot[0]);
                const int arrived = __builtin_amdgcn_readfirstlane(qslot[1]);
                __syncthreads();
                if (pub >= 0 && arrived == pubn - 1) {
                    __builtin_amdgcn_fence(__ATOMIC_ACQUIRE, "agent");
                    attn_combine_block(F, pub, pubn); }
            }
#if defined(MK_TPROBE) && (MK_TPROBE == 17 || MK_TPROBE == 18)
            if (threadIdx.x == 0) { const unsigned el_ = (unsigned)__builtin_amdgcn_s_memrealtime() - tpd0_;
                if (MK_TPROBE == 17) atomicMax((unsigned*)(F.ctl + 3000 + l), el_); else atomicMax((unsigned*)(F.ctl + 3000 + l), 0x7fffffffu - el_); }
#endif
        }
        SEAM(pb + 3);
        TP_E(4);
        TP_B(6);
        for (int rep_ = 0; rep_ < REPS(6); ++rep_) if (IN(pb + 5)) { if (rep_) xcd_barrier(bar); unsigned char* const wsl = opq(F.ws); LAS unsigned char* const ldl = opq(F.lds); gm::RegOrder S; S.init(SEQ, DM, DM / 2, wsl + WS_WOUT + (size_t)l * DM * DM, F.G, (int)blockIdx.x);
            LAS float* g1L = (LAS float*)(ldl + AUX_OFF);
            { const float* const b_ada_ = karg(3); const int t_ = opq_tid(F.wave); float m1_[4][5];
#pragma unroll
              for (int it = 0; it < 4; ++it) mod_ld(wsl, b_ada_, l, 2 * DM + t_ + it * NTHR, m1_[it]);
#pragma unroll
              for (int it = 0; it < 4; ++it) g1L[t_ + it * NTHR] = mod_sum(m1_[it]); }
            __syncthreads();
            EpiRes<(l != 0)> E{(l == 0) ? (const void*)karg(0) : (const void*)(wsl + WS_X2), g1L, (bf16*)(wsl + WS_X1)};
            gm::gemm_phase<EpiRes<(l != 0)>, gm::RegOrder, false, true, true, SC_H8, SC_W8>(ldl, (const char*)(wsl + WS_YCAT), DM, S, E, F.wave); }
        SEAM(pb + 5);
        TP_E(6);
        TP_B(7);
        for (int rep_ = 0; rep_ < REPS(7); ++rep_) if (IN(pb + 6)) { if (rep_) xcd_barrier(bar); unsigned char* const wsl = opq(F.ws); LAS unsigned char* const ldl = opq(F.lds); phase_norm2_route(F, l); }
        SEAM(pb + 6);
        TP_E(7);
        TP_B(8);
        for (int rep_ = 0; rep_ < REPS(8); ++rep_) if (IN(pb + 7)) { if (rep_) xcd_barrier(bar); unsigned char* const wsl = opq(F.ws); LAS unsigned char* const ldl = opq(F.lds); LAS int* tab = (LAS int*)(ldl + AUX_OFF + 20480); moe_table(F, l, tab);
            gu32* const rdy = F.ctl + CW_RDY + 4096 * l + 2048 * rep_;
            TP_B(11);
            const int tot1 = 8 * tab[16];
            const bool split = (F.G == 256) && (tot1 <= 576) && (l == 0);
            const int Gm = split ? 192 : F.G, cm = split ? (F.vcu >> 5) * 24 + (F.vcu & 31) : F.vcu;
            if (split && (F.vcu & 31) >= 24) bg_fill(F, 20 + l, 0, Gm, false);
            else { MoeOrder S; S.G = Gm; S.c = cm; S.total = 8 * tab[16]; S.K = DM / 2; S.nct = 8; S.Bt = (const char*)(wsl + WS_WGU) + (size_t)l * NEXP * DM * DM; S.estride = (size_t)DM * DM;
              S.list = (const int*)(wsl + WS_LIST); S.tab = tab; S.rows = (LAS int*)(ldl + AUX_OFF + 4096); S.stage_rows(opq_tid(F.wave));
              EpiHidPub E{wsl + (l ? WS_HID1 : WS_HID), rdy};
              gm::gemm_phase<EpiHidPub, MoeOrder, true, true, true, SC_H8, SC_W8>(ldl, (const char*)(wsl + WS_H), DM, S, E, F.wave);
              if (split && opq_tid(F.wave) == 0) (void)__hip_atomic_fetch_add(F.ctl + CW_ARR + 64 * (20 + l), 1u, RLX_AGENT); }
            TP_E(11); TP_B(12);
            { MoeDynOrder S; S.total = 8 * tab[16]; S.K = DEX / 2; S.Bt = (const char*)(wsl + WS_WD) + (size_t)l * NEXP * DM * DEX; S.estride = (size_t)DM * DEX; S.tab = tab;
              S.ticket = F.ctl + CW_MT + 64 * l + 32 * rep_; S.ready = rdy; S.tmo = F.ctl + CW_TMO; S.slot = (LAS unsigned*)(ldl + AUX_OFF + 24576 + 64);
              EpiYB E{(bf16*)(wsl + WS_YB)};
              gm::gemm_phase<EpiYB, MoeDynOrder, false, true, true, SC_HID8, SC_W8>(ldl, (const char*)(wsl + (l ? WS_HID1 : WS_HID)), DEX, S, E, F.wave); }
            TP_E(12);
        }
        SEAM(pb + 7);
        TP_E(8);
    }

__global__ void __launch_bounds__(NTHR, 2) mk_fwd(Args args) {
    extern __shared__ __attribute__((aligned(16))) unsigned char lds[];
    Frame F;
    F.lds = (LAS unsigned char*)lds; F.MISC = (volatile LAS unsigned*)(F.lds + MISC_OFF);
    F.tid = 0; F.lane = 0; F.wave = __builtin_amdgcn_readfirstlane((int)threadIdx.x >> 6);
    F.G = gridDim.x; { const int bx = blockIdx.x; F.vcu = (F.G % 8 == 0) ? (bx % 8) * (F.G / 8) + bx / 8 : bx; }
    F.ws = args.ws; F.ctl = (gu32*)(args.ws + WS_CTL);
    for (int u = threadIdx.x; u < (LDS_BYTES - RING_BYTES) / 4; u += NTHR) ((LAS unsigned*)(F.lds + RING_BYTES))[u] = 0u;
    __syncthreads();
    const int lo = args.ph_lo, hi = args.ph_hi;
    const bool multi = (hi - lo) > 1;
    XcdBarrier bar; bar.bar = (unsigned*)(F.ctl + CW_BAR); bar.x = 0; bar.st = nullptr;
    if (multi) bar = xcd_barrier_post((unsigned*)(F.ctl + CW_BAR), F.MISC + 8);
    TP_B(0); for (int rep_ = 0; rep_ < REPS(0); ++rep_) if (IN(0)) { if (rep_) xcd_barrier(bar); p0_prologue(F); } SEAM(0); TP_E(0);

    layer_body<0>(F, bar, lo, hi);
    layer_body<1>(F, bar, lo, hi);
    TP_B(10);
    for (int rep_ = 0; rep_ < REPS(10); ++rep_) if (IN(N_PHASES - 1)) { if (rep_) xcd_barrier(bar); phase_norm1<2>(F, NLAYER - 1, (const void*)(F.ws + WS_X1), (void*)karg(21), NLAYER - 1); }
    TP_E(10);
#ifdef MK_TPROBE
    if (blockIdx.x == 0 && threadIdx.x == 0) { unsigned d_ = ((volatile LAS unsigned*)(F.lds + AUX_OFF + 24576 + 128))[1];
        if (MK_TPROBE == 17) d_ = __hip_atomic_load(F.ctl + 3000, RLX_AGENT) + __hip_atomic_load(F.ctl + 3001, RLX_AGENT);
        if (MK_TPROBE == 18) d_ = (0x7fffffffu - __hip_atomic_load(F.ctl + 3000, RLX_AGENT)) + (0x7fffffffu - __hip_atomic_load(F.ctl + 3001, RLX_AGENT)); const unsigned t0_ = (unsigned)__builtin_amdgcn_s_memrealtime(); while ((unsigned)__builtin_amdgcn_s_memrealtime() - t0_ < d_) __builtin_amdgcn_s_sleep(8); }
#endif
#ifdef MK_SELFTEST
    {
        const bool h0 = st_run(0, 1.f, 0x7f7f7f7f), h0s = st_run(0, 64.f, 0x79797979), h1 = st_run(1, 1.f, 0x7f7f7f7f);
        xcd_barrier(bar);
        float* o = (float*)karg(21);
        if (!(h0 && h0s)) { const float val = h0 ? 0.f : (h1 ? 1000.f : __builtin_nanf(""));
            for (size_t i = (size_t)blockIdx.x * NTHR + threadIdx.x; i < (size_t)SEQ * DM; i += (size_t)gridDim.x * NTHR) o[i] = val; }
    }
#endif
#undef IN
#undef SEAM
}

#ifndef MK_LAUNCHES
#define MK_LAUNCHES 1
#endif
extern "C" void kernel_launch(void* const* d_in, const int* in_sizes, int n_in, void* d_out, int out_size, void* d_ws, size_t ws_size, hipStream_t stream) {
    static int grid = 0;
    if (grid == 0) {
        int dev = 0, cus = 0, per_cu = 0;
        if (n_in != 21 || ws_size < WS_END) { fprintf(stderr, "kernel_launch: unexpected inputs (n_in %d, ws %zu)\n", n_in, ws_size); grid = -1; return; }
        if (hipGetDevice(&dev) != hipSuccess || hipDeviceGetAttribute(&cus, hipDeviceAttributeMultiprocessorCount, dev) != hipSuccess) { grid = -1; return; }
        if (hipFuncSetAttribute((const void*)mk_fwd, hipFuncAttributeMaxDynamicSharedMemorySize, LDS_BYTES) != hipSuccess) { fprintf(stderr, "kernel_launch: hipFuncSetAttribute failed\n"); grid = -1; return; }
        if (hipOccupancyMaxActiveBlocksPerMultiprocessor(&per_cu, (const void*)mk_fwd, NTHR, LDS_BYTES) != hipSuccess || per_cu < 1) fprintf(stderr, "kernel_launch: occupancy query says %d\n", per_cu);
        (void)hipGetLastError();
        grid = cus;
    }
    if (grid < 0) return;
    (void)hipMemsetAsync((char*)d_ws + WS_CTL, 0, CTL_ZERO_BYTES, stream);
    Args a{};
    for (int i = 0; i < 21; ++i) a.in[i] = (const float*)d_in[i];
    a.out = (float*)d_out; a.ws = (unsigned char*)d_ws;
#if MK_LAUNCHES == 1
    a.ph_lo = 0; a.ph_hi = N_PHASES;
    hipLaunchKernelGGL(mk_fwd, dim3(grid), dim3(NTHR), LDS_BYTES, stream, a);
#else
    for (int p = 0; p < N_PHASES; ++p) { a.ph_lo = p; a.ph_hi = p + 1; hipLaunchKernelGGL(mk_fwd, dim3(grid), dim3(NTHR), LDS_BYTES, stream, a); }
#endif
}
```
